# Optimizing an MI355X kernel written in HIP

```python
import math
import jax, jax.numpy as jnp
from jax import lax
import numpy as np

D_MODEL = 1024
BATCH = 8
SEQ = 2048
DEPTH = 1

HEAD_DIM = 64
ATT_WIDTH = D_MODEL // 2
RWKV_WIDTH = D_MODEL - ATT_WIDTH
ATT_HEADS = ATT_WIDTH // HEAD_DIM
RWKV_HEADS = RWKV_WIDTH // HEAD_DIM
MIX_WIDTH = ATT_WIDTH + RWKV_WIDTH
DILATED_PATTERNS = ((128, 1), (512, 4), (2048, 16))
DECAY_LORA = 64
AAA_LORA = 64
GATE_LORA = 128
SHIFT_WIDTH = 3 * RWKV_WIDTH + DECAY_LORA + AAA_LORA + GATE_LORA
IN_WIDTH = 3 * ATT_WIDTH + SHIFT_WIDTH
PEER_N_KEYS = 128
PEER_N_EXPERTS = PEER_N_KEYS * PEER_N_KEYS
PEER_HEADS = 8
PEER_KEY_DIM = 256
PEER_TOPK = 16
PEER_TOKEN_BLOCK = 128
NORM_EPS = 1e-6
LNX_EPS = 64e-5
MASK_VALUE = -1e30

kernel_name = "hybrid_dilated_attn_rwkv7_peer_block"


def rms_norm(x, g, eps=NORM_EPS):
    x32 = x.astype(jnp.float32)
    y = x32 * lax.rsqrt(jnp.mean(x32 * x32, axis=-1, keepdims=True) + eps)
    return y * g.astype(jnp.float32)


def alibi_slopes(n_heads):
    return jnp.exp2(-8.0 * (jnp.arange(n_heads, dtype=jnp.float32) + 1.0) / n_heads)


def dilated_window_attention(q, k, v, slopes, window, dilation):
    B, S, H, E = q.shape
    d = dilation
    n = window // (2 * d)
    L = S // d
    nb = -(-L // n)
    Lp = nb * n
    qs = jnp.pad(q.reshape(B, L, d, H, E), ((0, 0), (0, Lp - L), (0, 0), (0, 0), (0, 0)))
    qs = qs.reshape(B, nb, n, d, H, E)

    def neighbourhood(t):
        tp = jnp.pad(t.reshape(B, L, d, H, E), ((0, 0), (n, Lp - L + n), (0, 0), (0, 0), (0, 0)))
        tp = tp.reshape(B, nb + 2, n, d, H, E)
        return jnp.concatenate([tp[:, :-2], tp[:, 1:-1], tp[:, 2:]], axis=2)

    kb = neighbourhood(k)
    vb = neighbourhood(v)
    qi = jnp.arange(nb)[:, None] * n + jnp.arange(n)[None, :]
    kj = (jnp.arange(nb)[:, None] - 1) * n + jnp.arange(3 * n)[None, :]
    off = kj[:, None, :] - qi[:, :, None]
    valid = (jnp.abs(off) <= n) & (kj[:, None, :] >= 0) & (kj[:, None, :] < L)
    dist = (d * jnp.abs(off)).astype(jnp.float32)

    s = jnp.einsum('bnqrhe,bnkrhe->bhrnqk', qs, kb) * (E ** -0.5)
    s = s - slopes[None, :, None, None, None, None] * dist[None, None, None]
    s = jnp.where(valid[None, None, None], s, MASK_VALUE)
    m = jnp.max(s, axis=-1, keepdims=True)
    p = jnp.exp(s - m)
    den = jnp.sum(p, axis=-1)
    lse = m[..., 0] + jnp.log(den)
    out = jnp.einsum('bhrnqk,bnkrhe->bnqrhe', p, vb)
    out = out / jnp.transpose(den, (0, 3, 4, 2, 1))[..., None]
    out = out.reshape(B, Lp, d, H, E)[:, :L].reshape(B, S, H, E)
    lse = jnp.transpose(lse, (0, 3, 4, 2, 1)).reshape(B, Lp, d, H)[:, :L].reshape(B, S, H)
    return out, lse


def dilated_mixture_attention(q, k, v):
    slopes = alibi_slopes(q.shape[2])
    outs, lses = [], []
    for window, dilation in DILATED_PATTERNS:
        o, l = dilated_window_attention(q, k, v, slopes, window, dilation)
        outs.append(o)
        lses.append(l)
    wts = jax.nn.softmax(jnp.stack(lses, axis=0), axis=0)
    return jnp.einsum('pbsh,pbshe->bshe', wts, jnp.stack(outs, axis=0))


def token_shift(z, mu_prev, mu_next):
    z_prev = jnp.pad(z, ((0, 0), (1, 0), (0, 0)))[:, :-1]
    z_next = jnp.pad(z, ((0, 0), (0, 1), (0, 0)))[:, 1:]
    return z + mu_prev * (z_prev - z) + mu_next * (z_next - z)


def wkv7_scan(r, w, k, v, kk, a, reverse):
    B, S, H, N = r.shape
    xs = tuple(jnp.moveaxis(t, 1, 0) for t in (r, w, k, v, kk, a))
    state0 = jnp.zeros((B, H, N, N), jnp.float32)

    def step(state, inp):
        r_t, w_t, k_t, v_t, kk_t, a_t = inp
        sa = jnp.einsum('bhvk,bhk->bhv', state, -kk_t)
        state = (state * w_t[:, :, None, :]
                 + sa[..., :, None] * (kk_t * a_t)[..., None, :]
                 + v_t[..., :, None] * k_t[..., None, :])
        y = jnp.einsum('bhvk,bhk->bhv', state, r_t)
        return state, y

    _, ys = lax.scan(step, state0, xs, reverse=reverse)
    return jnp.moveaxis(ys, 0, 1)


def rwkv7_bidirectional(r, k, v, xw, xa, xg, w_decay0, w_decay_up, a_gate0, a_gate_up,
                        g_up, k_k, k_a, r_k, lnx_g, lnx_b):
    B, S, _ = r.shape

    def hs(t):
        return t.reshape(B, S, RWKV_HEADS, HEAD_DIM)

    g = jax.nn.sigmoid(xg) @ g_up
    kk = hs(k * k_k)
    kk = kk * lax.rsqrt(jnp.maximum(jnp.sum(kk * kk, axis=-1, keepdims=True), 1e-12))
    ys, a_dirs = [], []
    for direction in range(2):
        w = -jax.nn.softplus(-(w_decay0[direction] + jnp.tanh(xw) @ w_decay_up[direction])) - 0.5
        decay = jnp.exp(-jnp.exp(w))
        a = jax.nn.sigmoid(a_gate0[direction] + xa @ a_gate_up[direction])
        k_dir = k * (1.0 + (a - 1.0) * k_a)
        ys.append(wkv7_scan(hs(r), hs(decay), hs(k_dir), hs(v), kk, hs(a), reverse=(direction == 1)))
        a_dirs.append(a)
    y = ys[0] + ys[1]
    mean = jnp.mean(y, axis=-1, keepdims=True)
    var = jnp.mean(jnp.square(y - mean), axis=-1, keepdims=True)
    yn = ((y - mean) * lax.rsqrt(var + LNX_EPS)).reshape(B, S, RWKV_WIDTH) * lnx_g + lnx_b
    k_bonus = hs(k * (1.0 + (0.5 * (a_dirs[0] + a_dirs[1]) - 1.0) * k_a))
    bonus = jnp.sum(hs(r) * k_bonus * r_k, axis=-1, keepdims=True) * hs(v)
    return (yn + bonus.reshape(B, S, RWKV_WIDTH)) * g


def peer_ffn(h, w_query, sub_keys1, sub_keys2, expert_u, expert_v):
    B, S, D = h.shape
    T = B * S
    half = PEER_KEY_DIM // 2
    x = h.reshape(T, D)
    q = (x @ w_query).astype(jnp.float32).reshape(T, PEER_HEADS, PEER_KEY_DIM)
    s1 = jnp.einsum('thd,nd->thn', q[..., :half], sub_keys1.astype(jnp.float32))
    s2 = jnp.einsum('thd,nd->thn', q[..., half:], sub_keys2.astype(jnp.float32))
    v1, i1 = lax.top_k(s1, PEER_TOPK)
    v2, i2 = lax.top_k(s2, PEER_TOPK)
    cand = (v1[..., :, None] + v2[..., None, :]).reshape(T, PEER_HEADS, PEER_TOPK * PEER_TOPK)
    top_s, top_p = lax.top_k(cand, PEER_TOPK)
    e_idx = (jnp.take_along_axis(i1, top_p // PEER_TOPK, axis=-1) * PEER_N_KEYS
             + jnp.take_along_axis(i2, top_p % PEER_TOPK, axis=-1))
    gate = jax.nn.softmax(top_s, axis=-1)
    HK = PEER_HEADS * PEER_TOPK
    nblk = T // PEER_TOKEN_BLOCK
    xb = x.reshape(nblk, PEER_TOKEN_BLOCK, D)
    ib = e_idx.reshape(nblk, PEER_TOKEN_BLOCK, HK)
    gb = gate.reshape(nblk, PEER_TOKEN_BLOCK, HK)

    def block(args):
        xc, ic, gc = args
        u = jnp.take(expert_u, ic, axis=0)
        act = jax.nn.gelu(jnp.einsum('cd,ced->ce', xc, u).astype(jnp.float32), approximate=False)
        vv = jnp.take(expert_v, ic, axis=0)
        return jnp.einsum('ce,ced->cd', (gc * act).astype(vv.dtype), vv)

    y = lax.map(block, (xb, ib, gb))
    return y.reshape(B, S, D)


def setup_inputs(seed: int = 0) -> dict:
    key = jax.random.key(seed)
    ks = jax.random.split(key, 32)
    f32 = jnp.float32
    nrm = lambda k, shape, s: jax.random.normal(k, shape, f32) * s
    RW = RWKV_WIDTH
    return {
        "x": nrm(ks[0], (BATCH, SEQ, D_MODEL), 1.0),
        "c": nrm(ks[1], (BATCH, D_MODEL), 1.0),
        "ada_w": nrm(ks[2], (DEPTH, D_MODEL, 6 * D_MODEL), 0.5 * D_MODEL ** -0.5),
        "ada_b": nrm(ks[3], (DEPTH, 6 * D_MODEL), 0.1),
        "norm1_g": 1.0 + nrm(ks[4], (DEPTH, D_MODEL), 0.05),
        "w_in": nrm(ks[5], (DEPTH, D_MODEL, IN_WIDTH), D_MODEL ** -0.5),
        "mu_prev": jax.random.uniform(ks[6], (DEPTH, SHIFT_WIDTH), f32, 0.0, 0.5),
        "mu_next": jax.random.uniform(ks[7], (DEPTH, SHIFT_WIDTH), f32, 0.0, 0.5),
        "q_norm_g": 1.0 + nrm(ks[8], (DEPTH, HEAD_DIM), 0.05),
        "k_norm_g": 1.0 + nrm(ks[9], (DEPTH, HEAD_DIM), 0.05),
        "w_decay0": jax.random.uniform(ks[10], (DEPTH, 2, RW), f32, -5.0, -1.0),
        "w_decay_up": nrm(ks[11], (DEPTH, 2, DECAY_LORA, RW), 0.5 * DECAY_LORA ** -0.5),
        "a_gate0": nrm(ks[12], (DEPTH, 2, RW), 0.5),
        "a_gate_up": nrm(ks[13], (DEPTH, 2, AAA_LORA, RW), AAA_LORA ** -0.5),
        "g_up": nrm(ks[14], (DEPTH, GATE_LORA, RW), GATE_LORA ** -0.5),
        "k_k": 0.85 + nrm(ks[15], (DEPTH, RW), 0.05),
        "k_a": 1.0 + nrm(ks[16], (DEPTH, RW), 0.05),
        "r_k": nrm(ks[17], (DEPTH, RWKV_HEADS, HEAD_DIM), 0.1),
        "lnx_g": 1.0 + nrm(ks[18], (DEPTH, RW), 0.05),
        "lnx_b": nrm(ks[19], (DEPTH, RW), 0.01),
        "w_out": nrm(ks[20], (DEPTH, MIX_WIDTH, D_MODEL), MIX_WIDTH ** -0.5),
        "norm2_g": 1.0 + nrm(ks[21], (DEPTH, D_MODEL), 0.05),
        "peer_w_query": nrm(ks[22], (DEPTH, D_MODEL, PEER_HEADS * PEER_KEY_DIM), D_MODEL ** -0.5),
        "peer_sub_keys1": nrm(ks[23], (DEPTH, PEER_N_KEYS, PEER_KEY_DIM // 2), (PEER_KEY_DIM // 2) ** -0.5),
        "peer_sub_keys2": nrm(ks[24], (DEPTH, PEER_N_KEYS, PEER_KEY_DIM // 2), (PEER_KEY_DIM // 2) ** -0.5),
        "peer_u": nrm(ks[25], (DEPTH, PEER_N_EXPERTS, D_MODEL), D_MODEL ** -0.5),
        "peer_v": nrm(ks[26], (DEPTH, PEER_N_EXPERTS, D_MODEL), (PEER_HEADS * PEER_TOPK) ** -0.5),
    }


def reference(x, c, ada_w, ada_b, norm1_g, w_in, mu_prev, mu_next, q_norm_g, k_norm_g,
              w_decay0, w_decay_up, a_gate0, a_gate_up, g_up, k_k, k_a, r_k, lnx_g, lnx_b,
              w_out, norm2_g, peer_w_query, peer_sub_keys1, peer_sub_keys2, peer_u, peer_v):
    in_dtype = x.dtype
    B, S, _ = x.shape
    A = ATT_WIDTH
    RW = RWKV_WIDTH
    for l in range(DEPTH):
        mod = (jax.nn.silu(c.astype(jnp.float32)) @ ada_w[l].astype(jnp.float32)
               + ada_b[l].astype(jnp.float32))[:, None, :]
        shift1, scale1, gate1, shift2, scale2, gate2 = jnp.split(mod, 6, axis=-1)

        h = rms_norm(x, norm1_g[l]) * (1.0 + scale1) + shift1
        z = (h.astype(in_dtype) @ w_in[l]).astype(jnp.float32)
        qa = rms_norm(z[..., :A].reshape(B, S, ATT_HEADS, HEAD_DIM), q_norm_g[l])
        ka = rms_norm(z[..., A:2 * A].reshape(B, S, ATT_HEADS, HEAD_DIM), k_norm_g[l])
        va = z[..., 2 * A:3 * A].reshape(B, S, ATT_HEADS, HEAD_DIM)
        att = dilated_mixture_attention(qa, ka, va).reshape(B, S, A)

        zr = token_shift(z[..., 3 * A:], mu_prev[l].astype(jnp.float32), mu_next[l].astype(jnp.float32))
        o1, o2, o3 = RW, 2 * RW, 3 * RW
        o4, o5 = o3 + DECAY_LORA, o3 + DECAY_LORA + AAA_LORA
        rw = rwkv7_bidirectional(
            zr[..., :o1], zr[..., o1:o2], zr[..., o2:o3],
            zr[..., o3:o4], zr[..., o4:o5], zr[..., o5:],
            w_decay0[l].astype(jnp.float32), w_decay_up[l].astype(jnp.float32),
            a_gate0[l].astype(jnp.float32), a_gate_up[l].astype(jnp.float32),
            g_up[l].astype(jnp.float32), k_k[l].astype(jnp.float32), k_a[l].astype(jnp.float32),
            r_k[l].astype(jnp.float32), lnx_g[l].astype(jnp.float32), lnx_b[l].astype(jnp.float32))
        mixed = jnp.concatenate([att, rw], axis=-1).astype(in_dtype) @ w_out[l]
        x = (x.astype(jnp.float32) + gate1 * mixed.astype(jnp.float32)).astype(in_dtype)

        h2 = (rms_norm(x, norm2_g[l]) * (1.0 + scale2) + shift2).astype(in_dtype)
        ff = peer_ffn(h2, peer_w_query[l], peer_sub_keys1[l], peer_sub_keys2[l], peer_u[l], peer_v[l])
        x = (x.astype(jnp.float32) + gate2 * ff.astype(jnp.float32)).astype(in_dtype)
    return x
```

```cpp
#include <hip/hip_runtime.h>
#include <cstdio>
#include <cstdint>
#include <cmath>

constexpr int D = 1024, BATCH = 8, SEQ = 2048, T = BATCH * SEQ;
constexpr int HD = 64, AW = 512, RW = 512, NH = 8;
constexpr int DL = 64, AL = 64, GL = 128;
constexpr int SHIFTW = 3 * RW + DL + AL + GL;
constexpr int INW = 3 * AW + SHIFTW;
constexpr int NKEYS = 128, NEXP = NKEYS * NKEYS, PH = 8, PKD = 256, TOPK = 16, HK = PH * TOPK;
constexpr int QW = PH * PKD;

typedef unsigned short bf16;
__device__ __forceinline__ float bf2f(bf16 v) { return __uint_as_float(((unsigned)v) << 16); }
__device__ __forceinline__ bf16 f2bf(float f) { unsigned u = __float_as_uint(f); return (bf16)((u + 0x7fffu + ((u >> 16) & 1u)) >> 16); }

constexpr size_t MiB = 1u << 20;
constexpr size_t WS_MOD = 1 * MiB;
constexpr size_t WS_XN = 2 * MiB;
constexpr size_t WS_Z = 34 * MiB;
constexpr size_t WS_MIX = 138 * MiB;
constexpr size_t WS_Q = 34 * MiB;
constexpr size_t WS_IDX = 100 * MiB;
constexpr size_t WS_GATE = 110 * MiB;
constexpr size_t WS_Y = 170 * MiB;
constexpr size_t WS_END = 234 * MiB;

__global__ void k_mod(const float* c, const float* ada_w, const float* ada_b, float* mod) {
    const int j = blockIdx.x * blockDim.x + threadIdx.x;
    if (j >= 6 * D) return;
    float acc[BATCH];
#pragma unroll
    for (int b = 0; b < BATCH; ++b) acc[b] = 0.f;
    for (int i = 0; i < D; ++i) {
        const float w = ada_w[(size_t)i * 6 * D + j];
#pragma unroll
        for (int b = 0; b < BATCH; ++b) { const float cv = c[b * D + i]; const float s = cv / (1.f + expf(-cv)); acc[b] += s * w; }
    }
#pragma unroll
    for (int b = 0; b < BATCH; ++b) mod[b * 6 * D + j] = acc[b] + ada_b[j];
}

__global__ void k_norm_mod(const float* x, const float* g, const float* mod, int shift_off, int scale_off, bf16* xn) {
    __shared__ float red[4];
    const int t = blockIdx.x, b = t / SEQ, tid = threadIdx.x;
    const float* xr = x + (size_t)t * D;
    float v[4]; float ss = 0.f;
#pragma unroll
    for (int j = 0; j < 4; ++j) { v[j] = xr[tid + 256 * j]; ss += v[j] * v[j]; }
#pragma unroll
    for (int o = 1; o < 64; o <<= 1) ss += __shfl_xor(ss, o);
    if ((tid & 63) == 0) red[tid >> 6] = ss;
    __syncthreads();
    const float tot = red[0] + red[1] + red[2] + red[3];
    const float rs = 1.0f / sqrtf(tot * (1.f / D) + 1e-6f);
#pragma unroll
    for (int j = 0; j < 4; ++j) { const int cidx = tid + 256 * j;
        const float y = v[j] * rs * g[cidx];
        xn[(size_t)t * D + cidx] = f2bf(y * (1.f + mod[b * 6 * D + scale_off + cidx]) + mod[b * 6 * D + shift_off + cidx]); }
}

template <int EPI>
__global__ void __launch_bounds__(256) k_gemm(const bf16* A, const float* W, int M, int N, int K, bf16* Cb, const float* xres, const float* mod, int gate_off, float* outf) {
    __shared__ float As[16][65], Ws[16][65];
    const int tid = threadIdx.x, tx = tid & 15, ty = tid >> 4;
    const int row0 = blockIdx.y * 64, col0 = blockIdx.x * 64;
    float acc[4][4];
#pragma unroll
    for (int i = 0; i < 4; ++i)
#pragma unroll
        for (int j = 0; j < 4; ++j) acc[i][j] = 0.f;
    for (int k0 = 0; k0 < K; k0 += 16) {
#pragma unroll
        for (int i = 0; i < 4; ++i) { const int idx = tid + i * 256; const int r = idx >> 4, kk = idx & 15; As[kk][r] = bf2f(A[(size_t)(row0 + r) * K + k0 + kk]); }
#pragma unroll
        for (int i = 0; i < 4; ++i) { const int idx = tid + i * 256; const int kk = idx >> 6, cc = idx & 63; Ws[kk][cc] = W[(size_t)(k0 + kk) * N + col0 + cc]; }
        __syncthreads();
#pragma unroll
        for (int kk = 0; kk < 16; ++kk) {
            float a[4], b[4];
#pragma unroll
            for (int i = 0; i < 4; ++i) { a[i] = As[kk][ty * 4 + i]; b[i] = Ws[kk][tx * 4 + i]; }
#pragma unroll
            for (int i = 0; i < 4; ++i)
#pragma unroll
                for (int j = 0; j < 4; ++j) acc[i][j] += a[i] * b[j];
        }
        __syncthreads();
    }
#pragma unroll
    for (int i = 0; i < 4; ++i)
#pragma unroll
        for (int j = 0; j < 4; ++j) {
            const int m = row0 + ty * 4 + i, n = col0 + tx * 4 + j;
            if (EPI == 0) Cb[(size_t)m * N + n] = f2bf(acc[i][j]);
            else { const int b = m / SEQ; outf[(size_t)m * N + n] = xres[(size_t)m * N + n] + mod[b * 6 * D + gate_off + n] * acc[i][j]; }
        }
}

__global__ void __launch_bounds__(64) k_attn(const bf16* Z, const float* qg, const float* kg, bf16* mix) {
    const int gid = blockIdx.x * 64 + threadIdx.x;
    const int h = gid & 7, tok = gid >> 3, b = tok / SEQ, t = tok % SEQ;
    const float slope = exp2f(-(float)(h + 1));
    float q[64];
    { const bf16* qp = Z + (size_t)tok * INW + h * 64; float ss = 0.f;
#pragma unroll
      for (int c = 0; c < 64; ++c) { q[c] = bf2f(qp[c]); ss += q[c] * q[c]; }
      const float rs = 1.0f / sqrtf(ss * (1.f / 64.f) + 1e-6f);
#pragma unroll
      for (int c = 0; c < 64; ++c) q[c] = q[c] * rs * qg[c] * 0.125f; }
    float tot[64]; float Mg = -INFINITY, Lg = 0.f;
#pragma unroll
    for (int c = 0; c < 64; ++c) tot[c] = 0.f;
    for (int p = 0; p < 3; ++p) {
        const int d = (p == 0) ? 1 : (p == 1 ? 4 : 16);
        const int L = SEQ / d, r = t % d, i = t / d;
        float m = -INFINITY, l = 0.f; float acc[64];
#pragma unroll
        for (int c = 0; c < 64; ++c) acc[c] = 0.f;
        for (int o = -64; o <= 64; ++o) {
            const int j = i + o; if (j < 0 || j >= L) continue;
            const int tk = j * d + r;
            const bf16* kp = Z + (size_t)(b * SEQ + tk) * INW + AW + h * 64;
            const bf16* vp = kp + AW;
            float ss = 0.f, dot = 0.f;
#pragma unroll
            for (int c = 0; c < 64; ++c) { const float kv = bf2f(kp[c]); ss += kv * kv; dot += q[c] * kv * kg[c]; }
            const float s = dot * (1.0f / sqrtf(ss * (1.f / 64.f) + 1e-6f)) - slope * (float)(d * (o < 0 ? -o : o));
            const float mn = fmaxf(m, s), al = expf(m - mn), pe = expf(s - mn);
            l = l * al + pe; m = mn;
#pragma unroll
            for (int c = 0; c < 64; ++c) acc[c] = acc[c] * al + pe * bf2f(vp[c]);
        }
        const float lse = m + logf(l), inv = 1.0f / l;
        const float Mn = fmaxf(Mg, lse), a0 = expf(Mg - Mn), a1 = expf(lse - Mn);
        Lg = Lg * a0 + a1; Mg = Mn;
#pragma unroll
        for (int c = 0; c < 64; ++c) tot[c] = tot[c] * a0 + a1 * acc[c] * inv;
    }
    const float invL = 1.0f / Lg;
    bf16* op = mix + (size_t)tok * D + h * 64;
#pragma unroll
    for (int c = 0; c < 64; ++c) op[c] = f2bf(tot[c] * invL);
}

__device__ __forceinline__ float zshift(const bf16* Z, int tok, int t, int col, const float* mu_prev, const float* mu_next) {
    const bf16* zc = Z + (size_t)tok * INW + 3 * AW + col;
    const float z = bf2f(zc[0]);
    const float zp = (t > 0) ? bf2f(zc[-INW]) : 0.f;
    const float zn = (t < SEQ - 1) ? bf2f(zc[INW]) : 0.f;
    return z + mu_prev[col] * (zp - z) + mu_next[col] * (zn - z);
}
__device__ __forceinline__ float decay_of(float wl) {
    const float nx = -wl; const float sp = (nx > 20.f) ? nx : log1pf(expf(nx));
    return expf(-expf(-sp - 0.5f));
}

__global__ void __launch_bounds__(64) k_scan(const bf16* Z, const float* mu_prev, const float* mu_next, const float* w_decay0, const float* w_decay_up,
                                             const float* a_gate0, const float* a_gate_up, const float* k_k, const float* k_a, float* Y) {
    __shared__ float s_tw[64], s_xa[64], s_kk[64], s_dec[64], s_b[64], s_kd[64], s_r[64];
    const int chain = blockIdx.x, dir = chain & 1, h = (chain >> 1) & 7, b = chain >> 4, lane = threadIdx.x, hc = h * 64 + lane;
    float S[64];
#pragma unroll
    for (int c = 0; c < 64; ++c) S[c] = 0.f;
    const float w0 = w_decay0[dir * RW + hc], a0 = a_gate0[dir * RW + hc], kkw = k_k[hc], kaw = k_a[hc];
    for (int st = 0; st < SEQ; ++st) {
        const int t = dir ? (SEQ - 1 - st) : st, tok = b * SEQ + t;
        const float r = zshift(Z, tok, t, hc, mu_prev, mu_next), k = zshift(Z, tok, t, RW + hc, mu_prev, mu_next), v = zshift(Z, tok, t, 2 * RW + hc, mu_prev, mu_next);
        const float xw = zshift(Z, tok, t, 3 * RW + lane, mu_prev, mu_next), xa = zshift(Z, tok, t, 3 * RW + DL + lane, mu_prev, mu_next);
        __syncthreads();
        s_tw[lane] = tanhf(xw); s_xa[lane] = xa;
        __syncthreads();
        float wl = w0, al = a0;
        for (int j = 0; j < 64; ++j) { wl += s_tw[j] * w_decay_up[(size_t)(dir * DL + j) * RW + hc]; al += s_xa[j] * a_gate_up[(size_t)(dir * AL + j) * RW + hc]; }
        const float dec = decay_of(wl), a = 1.0f / (1.0f + expf(-al));
        float kk = k * kkw, ss = kk * kk;
#pragma unroll
        for (int m = 1; m < 64; m <<= 1) ss += __shfl_xor(ss, m);
        kk = kk * (1.0f / sqrtf(fmaxf(ss, 1e-12f)));
        s_kk[lane] = kk; s_dec[lane] = dec; s_b[lane] = kk * a; s_kd[lane] = k * (1.0f + (a - 1.0f) * kaw); s_r[lane] = r;
        __syncthreads();
        float sa = 0.f;
#pragma unroll
        for (int c = 0; c < 64; ++c) sa -= S[c] * s_kk[c];
        float y = 0.f;
#pragma unroll
        for (int c = 0; c < 64; ++c) { S[c] = S[c] * s_dec[c] + sa * s_b[c] + v * s_kd[c]; y += S[c] * s_r[c]; }
        Y[(size_t)dir * T * RW + (size_t)tok * RW + hc] = y;
    }
}

__global__ void __launch_bounds__(512) k_rwkv_fin(const bf16* Z, const float* mu_prev, const float* mu_next, const float* a_gate0, const float* a_gate_up, const float* g_up,
                                                  const float* Y, const float* k_a, const float* r_k, const float* lnx_g, const float* lnx_b, bf16* mix) {
    __shared__ float zr[SHIFTW];
    const int tok = blockIdx.x, t = tok % SEQ, c = threadIdx.x;
    for (int col = c; col < SHIFTW; col += 512) zr[col] = zshift(Z, tok, t, col, mu_prev, mu_next);
    __syncthreads();
    const size_t o = (size_t)tok * RW + c;
    const float y = Y[o] + Y[(size_t)T * RW + o];
    float s = y;
#pragma unroll
    for (int m = 1; m < 64; m <<= 1) s += __shfl_xor(s, m);
    const float mean = s * (1.f / 64.f);
    float dv = (y - mean) * (y - mean);
#pragma unroll
    for (int m = 1; m < 64; m <<= 1) dv += __shfl_xor(dv, m);
    const float var = dv * (1.f / 64.f);
    const float yn = (y - mean) * (1.0f / sqrtf(var + 64e-5f)) * lnx_g[c] + lnx_b[c];
    float al0 = a_gate0[c], al1 = a_gate0[RW + c], g = 0.f;
    for (int j = 0; j < AL; ++j) { const float xa = zr[3 * RW + DL + j]; al0 += xa * a_gate_up[(size_t)j * RW + c]; al1 += xa * a_gate_up[(size_t)(AL + j) * RW + c]; }
    for (int j = 0; j < GL; ++j) g += (1.0f / (1.0f + expf(-zr[3 * RW + DL + AL + j]))) * g_up[(size_t)j * RW + c];
    const float a0 = 1.0f / (1.0f + expf(-al0)), a1 = 1.0f / (1.0f + expf(-al1));
    const float r = zr[c], k = zr[RW + c], v = zr[2 * RW + c];
    const float kb = k * (1.0f + (0.5f * (a0 + a1) - 1.0f) * k_a[c]);
    float bs = r * kb * r_k[c];
#pragma unroll
    for (int m = 1; m < 64; m <<= 1) bs += __shfl_xor(bs, m);
    mix[(size_t)tok * D + AW + c] = f2bf((yn + bs * v) * g);
}

__device__ __forceinline__ void wave_argmax(float& v, int& i) {
#pragma unroll
    for (int m = 1; m < 64; m <<= 1) { const float ov = __shfl_xor(v, m); const int oi = __shfl_xor(i, m); if (ov > v || (ov == v && oi < i)) { v = ov; i = oi; } }
}

__global__ void __launch_bounds__(64) k_peer_select(const bf16* Q, const float* keys1, const float* keys2, int* IDX, float* GATE) {
    const int th = blockIdx.x, lane = threadIdx.x;
    const bf16* qp = Q + (size_t)th * PKD;
    float s1a = 0.f, s1b = 0.f, s2a = 0.f, s2b = 0.f;
    for (int d = 0; d < 128; ++d) {
        const float q1 = bf2f(qp[d]), q2 = bf2f(qp[128 + d]);
        s1a += q1 * keys1[lane * 128 + d]; s1b += q1 * keys1[(lane + 64) * 128 + d];
        s2a += q2 * keys2[lane * 128 + d]; s2b += q2 * keys2[(lane + 64) * 128 + d];
    }
    float v1 = 0.f, v2 = 0.f; int i1 = 0, i2 = 0;
    for (int k = 0; k < TOPK; ++k) {
        float bv = s1a; int bi = lane; if (s1b > bv) { bv = s1b; bi = lane + 64; }
        wave_argmax(bv, bi);
        if (lane == k) { v1 = bv; i1 = bi; }
        if (bi == lane) s1a = -INFINITY; if (bi == lane + 64) s1b = -INFINITY;
    }
    for (int k = 0; k < TOPK; ++k) {
        float bv = s2a; int bi = lane; if (s2b > bv) { bv = s2b; bi = lane + 64; }
        wave_argmax(bv, bi);
        if (lane == k) { v2 = bv; i2 = bi; }
        if (bi == lane) s2a = -INFINITY; if (bi == lane + 64) s2b = -INFINITY;
    }
    const float va = __shfl(v1, lane >> 2);
    float c0 = va + __shfl(v2, (lane & 3) * 4 + 0), c1 = va + __shfl(v2, (lane & 3) * 4 + 1), c2 = va + __shfl(v2, (lane & 3) * 4 + 2), c3 = va + __shfl(v2, (lane & 3) * 4 + 3);
    float ts = 0.f; int tp = 0;
    for (int k = 0; k < TOPK; ++k) {
        float bv = c0; int bi = lane * 4;
        if (c1 > bv) { bv = c1; bi = lane * 4 + 1; } if (c2 > bv) { bv = c2; bi = lane * 4 + 2; } if (c3 > bv) { bv = c3; bi = lane * 4 + 3; }
        wave_argmax(bv, bi);
        if (lane == k) { ts = bv; tp = bi; }
        if (bi == lane * 4) c0 = -INFINITY; if (bi == lane * 4 + 1) c1 = -INFINITY; if (bi == lane * 4 + 2) c2 = -INFINITY; if (bi == lane * 4 + 3) c3 = -INFINITY;
    }
    const int e1 = __shfl(i1, tp >> 4), e2 = __shfl(i2, tp & 15);
    const float mx = __shfl(ts, 0);
    float ex = (lane < 16) ? expf(ts - mx) : 0.f;
    float sum = ex;
#pragma unroll
    for (int m = 1; m < 16; m <<= 1) sum += __shfl_xor(sum, m);
    if (lane < 16) { IDX[(size_t)th * TOPK + lane] = e1 * NKEYS + e2; GATE[(size_t)th * TOPK + lane] = ex / sum; }
}

__global__ void __launch_bounds__(256) k_peer_ffn(const bf16* XN, const int* IDX, const float* GATE, const float* U, const float* Vt, const float* mod, float* out) {
    const int tok = blockIdx.x * 4 + (threadIdx.x >> 6), lane = threadIdx.x & 63, b = tok / SEQ;
    float x[16], y[16];
#pragma unroll
    for (int j = 0; j < 4; ++j)
#pragma unroll
        for (int e = 0; e < 4; ++e) { x[j * 4 + e] = bf2f(XN[(size_t)tok * D + 256 * j + lane * 4 + e]); y[j * 4 + e] = 0.f; }
    for (int k = 0; k < HK; ++k) {
        const int ex = IDX[(size_t)tok * HK + k]; const float gt = GATE[(size_t)tok * HK + k];
        const float* up = U + (size_t)ex * D + lane * 4; const float* vp = Vt + (size_t)ex * D + lane * 4;
        float dot = 0.f;
#pragma unroll
        for (int j = 0; j < 4; ++j) { const float4 u4 = *(const float4*)(up + 256 * j); dot += x[j * 4] * u4.x + x[j * 4 + 1] * u4.y + x[j * 4 + 2] * u4.z + x[j * 4 + 3] * u4.w; }
#pragma unroll
        for (int m = 1; m < 64; m <<= 1) dot += __shfl_xor(dot, m);
        const float act = 0.5f * dot * (1.0f + erff(dot * 0.70710678118654752f));
        const float cf = gt * act;
#pragma unroll
        for (int j = 0; j < 4; ++j) { const float4 v4 = *(const float4*)(vp + 256 * j); y[j * 4] += cf * v4.x; y[j * 4 + 1] += cf * v4.y; y[j * 4 + 2] += cf * v4.z; y[j * 4 + 3] += cf * v4.w; }
    }
#pragma unroll
    for (int j = 0; j < 4; ++j)
#pragma unroll
        for (int e = 0; e < 4; ++e) { const int cidx = 256 * j + lane * 4 + e; const size_t o = (size_t)tok * D + cidx; out[o] = out[o] + mod[b * 6 * D + 5 * D + cidx] * y[j * 4 + e]; }
}

extern "C" void kernel_launch(void* const* d_in, const int* in_sizes, int n_in, void* d_out, int out_size, void* d_ws, size_t ws_size, hipStream_t stream) {
    if (n_in != 27 || out_size != T * D || ws_size < WS_END) { fprintf(stderr, "kernel_launch: unexpected problem (n_in %d out %d ws %zu)\n", n_in, out_size, ws_size); return; }
    const float* x = (const float*)d_in[0]; const float* c = (const float*)d_in[1]; const float* ada_w = (const float*)d_in[2]; const float* ada_b = (const float*)d_in[3];
    const float* norm1_g = (const float*)d_in[4]; const float* w_in = (const float*)d_in[5]; const float* mu_prev = (const float*)d_in[6]; const float* mu_next = (const float*)d_in[7];
    const float* q_norm_g = (const float*)d_in[8]; const float* k_norm_g = (const float*)d_in[9]; const float* w_decay0 = (const float*)d_in[10]; const float* w_decay_up = (const float*)d_in[11];
    const float* a_gate0 = (const float*)d_in[12]; const float* a_gate_up = (const float*)d_in[13]; const float* g_up = (const float*)d_in[14]; const float* k_k = (const float*)d_in[15];
    const float* k_a = (const float*)d_in[16]; const float* r_k = (const float*)d_in[17]; const float* lnx_g = (const float*)d_in[18]; const float* lnx_b = (const float*)d_in[19];
    const float* w_out = (const float*)d_in[20]; const float* norm2_g = (const float*)d_in[21]; const float* w_query = (const float*)d_in[22]; const float* keys1 = (const float*)d_in[23];
    const float* keys2 = (const float*)d_in[24]; const float* peer_u = (const float*)d_in[25]; const float* peer_v = (const float*)d_in[26];
    char* ws = (char*)d_ws; float* out = (float*)d_out;
    float* MOD = (float*)(ws + WS_MOD); bf16* XN = (bf16*)(ws + WS_XN); bf16* Z = (bf16*)(ws + WS_Z); bf16* MIX = (bf16*)(ws + WS_MIX); bf16* Q = (bf16*)(ws + WS_Q);
    int* IDX = (int*)(ws + WS_IDX); float* GATE = (float*)(ws + WS_GATE);
    float* Y = (float*)(ws + WS_Y);

    k_mod<<<6 * D / 256, 256, 0, stream>>>(c, ada_w, ada_b, MOD);
    k_norm_mod<<<T, 256, 0, stream>>>(x, norm1_g, MOD, 0, D, XN);
    k_gemm<0><<<dim3(INW / 64, T / 64), 256, 0, stream>>>(XN, w_in, T, INW, D, Z, nullptr, nullptr, 0, nullptr);
    k_attn<<<T * NH / 64, 64, 0, stream>>>(Z, q_norm_g, k_norm_g, MIX);
    k_scan<<<BATCH * NH * 2, 64, 0, stream>>>(Z, mu_prev, mu_next, w_decay0, w_decay_up, a_gate0, a_gate_up, k_k, k_a, Y);
    k_rwkv_fin<<<T, 512, 0, stream>>>(Z, mu_prev, mu_next, a_gate0, a_gate_up, g_up, Y, k_a, r_k, lnx_g, lnx_b, MIX);
    k_gemm<1><<<dim3(D / 64, T / 64), 256, 0, stream>>>(MIX, w_out, T, D, D, nullptr, x, MOD, 2 * D, out);
    k_norm_mod<<<T, 256, 0, stream>>>(out, norm2_g, MOD, 3 * D, 4 * D, XN);
    k_gemm<0><<<dim3(QW / 64, T / 64), 256, 0, stream>>>(XN, w_query, T, QW, D, Q, nullptr, nullptr, 0, nullptr);
    k_peer_select<<<T * PH, 64, 0, stream>>>(Q, keys1, keys2, IDX, GATE);
    k_peer_ffn<<<T / 4, 256, 0, stream>>>(XN, IDX, GATE, peer_u, peer_v, MOD, out);
}
```

```cpp
#include <hip/hip_runtime.h>
#include <cstdio>
#include <cstdint>
#include <cmath>
namespace pg8 {
#define PG8_LAS __attribute__((address_space(3)))
typedef unsigned short bf16_t;
typedef short bf16x8 __attribute__((ext_vector_type(8)));
typedef float f32x4 __attribute__((ext_vector_type(4)));
typedef unsigned u32x4 __attribute__((ext_vector_type(4)));
constexpr int BM = 256, BK = 64, HALF = 128, HTB = HALF * BK * 2  , STAGE_BYTES = 8 * HTB, NXCD = 8, WGM = 8;

__host__ __device__ __forceinline__ int lds_byte(int r, int c) { const int st = (r >> 4) * 2 + (c >> 5), rr = r & 15, cc = c & 31, ob = rr * 64 + cc * 2; return st * 1024 + (ob ^ (((ob >> 9) & 1) << 5)); }
__host__ __device__ __forceinline__ void stage_rc(int b, int& R, int& C) { const int st = b / 1024, sb = b % 1024, swz = sb ^ (((sb >> 9) & 1) << 5); R = (st >> 1) * 16 + swz / 64; C = (st & 1) * 32 + (swz % 64) / 2; }
__host__ __device__ __forceinline__ int perm32(int rho) { const int n = rho >> 4, i = rho & 15; return 8 * (i >> 2) + 4 * n + (i & 3); }

struct Unit { int pm, pn; };
struct Gemm { const bf16_t* A; const bf16_t* Bt; int M, N, K; };

struct StaticOrder {
    int nM, nN, nwg, G, c;
    __host__ __device__ void init(int M, int N, int G_, int c_) { nM = M / BM; nN = N / BM; nwg = nM * nN; G = G_; c = c_; }
    __host__ __device__ bool next(int i, Unit& u) const {
        const long L = (long)i * G + c; if (L >= nwg) return false;
        int wgid = (int)L; { const int q = nwg / NXCD, r = nwg % NXCD, xcd = wgid % NXCD, off = wgid / NXCD; wgid = (xcd < r ? xcd * (q + 1) : r * (q + 1) + (xcd - r) * q) + off; }
        const int nig = WGM * nN, gid = wgid / nig, fm = gid * WGM, gsz = (nM - fm) < WGM ? (nM - fm) : WGM;
        u.pm = fm + ((wgid % nig) % gsz); u.pn = (wgid % nig) / gsz; return true;
    }
    __device__ __forceinline__ void a_ready(const Unit&) const {}
    __device__ __forceinline__ void done(const Unit&) const {}
};

__device__ __forceinline__ unsigned cvt_pk_bf16(float lo, float hi) { unsigned r; asm volatile("v_cvt_pk_bf16_f32 %0, %1, %2" : "=v"(r) : "v"(lo), "v"(hi)); return r; }
typedef float f32x2 __attribute__((ext_vector_type(2)));
__device__ __forceinline__ f32x2 gelu_pk(f32x2 v) {
    const f32x2 av = __builtin_elementwise_abs(v), d = av * 0.2316418882f + 1.0f;
    f32x2 t; t.x = __builtin_amdgcn_rcpf(d.x); t.y = __builtin_amdgcn_rcpf(d.y);
    f32x2 q = t * 0.5307027145f + (-0.7265760135f); q = q * t + 0.7107068705f; q = q * t + (-0.142248368f); q = q * t + 0.127414796f; q = q * t;
    const f32x2 s = (v * v) * (-0.72134752044f);
    f32x2 e; e.x = __builtin_amdgcn_exp2f(s.x); e.y = __builtin_amdgcn_exp2f(s.y);
    const f32x2 m = v * (q * e), r = v - m;
    f32x2 o; o.x = v.x < 0.f ? m.x : r.x; o.y = v.y < 0.f ? m.y : r.y; return o;
}

template <int ACT  > struct EpiBf16 {
    static constexpr bool PERM = true, AFTER_DRAIN = false; static_assert(ACT == 0 || ACT == 1, "EpiBf16: ACT is 0 (none) or 1 (gelu_pk)");
    bf16_t* O; int ldc; const float* bias; int split_cols; size_t split_stride; float scale0;
    __device__ __forceinline__ void operator()(const f32x4 (&acc)[2][2][4][2], const Unit& u, int wr, int wc, int fr, int fq) const {
        const int row0 = u.pm * BM + wr * 64 + fr; int colt = u.pn * BM; bf16_t* base = O;
        float sc = 1.f; if (split_cols) { const int t = colt / split_cols; base += (size_t)t * split_stride; colt -= t * split_cols; if (t == 0) sc = scale0; }
        const int col0 = colt + wc * 32 + 8 * fq, bcol0 = u.pn * BM + wc * 32 + 8 * fq;
        f32x4 bv[2][2];
#pragma unroll
        for (int bj = 0; bj < 2; ++bj)
#pragma unroll
            for (int n = 0; n < 2; ++n) bv[bj][n] = bias ? *(const f32x4*)(bias + bcol0 + bj * HALF + 4 * n) : (f32x4){0.f, 0.f, 0.f, 0.f};
#pragma unroll
        for (int ai = 0; ai < 2; ++ai)
#pragma unroll
            for (int m = 0; m < 4; ++m) { bf16_t* rowp = base + (size_t)(row0 + ai * HALF + m * 16) * ldc + col0;
#pragma unroll
                for (int bj = 0; bj < 2; ++bj) { f32x4 v0 = acc[ai][bj][m][0] + bv[bj][0], v1 = acc[ai][bj][m][1] + bv[bj][1];
                    if (ACT == 1) { f32x2 a = gelu_pk((f32x2){v0[0], v0[1]}), b = gelu_pk((f32x2){v0[2], v0[3]}), c = gelu_pk((f32x2){v1[0], v1[1]}), d = gelu_pk((f32x2){v1[2], v1[3]});
                        v0 = (f32x4){a.x, a.y, b.x, b.y}; v1 = (f32x4){c.x, c.y, d.x, d.y}; }
                    v0 = v0 * sc; v1 = v1 * sc; u32x4 w; w.x = cvt_pk_bf16(v0[0], v0[1]); w.y = cvt_pk_bf16(v0[2], v0[3]); w.z = cvt_pk_bf16(v1[0], v1[1]); w.w = cvt_pk_bf16(v1[2], v1[3]);
                    *(u32x4*)(rowp + bj * HALF) = w; } }
    }
};

template <class Epi, class Sched, bool ALIGN_EPI = false, bool SP2 = false>
__device__ __forceinline__ void gemm_phase(PG8_LAS unsigned char* lds, const Gemm g, const Sched& S, const Epi& E) {
    const int tid = threadIdx.x, wid = __builtin_amdgcn_readfirstlane(tid >> 6), lane = tid & 63, wr = wid >> 2, wc = wid & 3, fr = lane & 15, fq = lane >> 4;
    const int K = g.K, nt = K / BK;
    unsigned voffA[2], voffB[2];
#pragma unroll
    for (int i = 0; i < 2; ++i) { int R, C; stage_rc(tid * 16 + i * 8192, R, C); const int Rb = Epi::PERM ? ((R & ~31) + perm32(R & 31)) : R;
        voffA[i] = (unsigned)(R * K + C) * 2u; voffB[i] = (unsigned)(Rb * K + C) * 2u; }
    const size_t kstep = (size_t)(BK * 2);
    const size_t hstep = (size_t)HALF * K * 2;
    const size_t tstep = 2 * hstep;
    const unsigned ldsw = (unsigned)wid * 1024u;
    const int aoff = lds_byte(wr * 64 + fr, fq * 8), boff = lds_byte(wc * 32 + fr, fq * 8);
#define PG8_SA(b, h) (((b) * 2 + (h)) * HTB)
#define PG8_SB(b, h) ((4 + (b) * 2 + (h)) * HTB)
#define PG8_STAGE(bufoff, gbase, voff) do { _Pragma("unroll") for (int _i = 0; _i < 2; ++_i) \
        __builtin_amdgcn_global_load_lds((const unsigned*)((const char*)(gbase) + (voff)[_i]), (PG8_LAS unsigned*)(lds + (bufoff) + ldsw + _i * 8192), 16, 0, 0); } while (0)
#define PG8_LDA(dst, b, h) do { _Pragma("unroll") for (int m = 0; m < 4; ++m) _Pragma("unroll") for (int k = 0; k < 2; ++k) dst[m][k] = *(const PG8_LAS bf16x8*)(lds + PG8_SA(b, h) + aoff + m * 2048 + k * 1024); } while (0)
#define PG8_LDB(dst, b, h) do { _Pragma("unroll") for (int n = 0; n < 2; ++n) _Pragma("unroll") for (int k = 0; k < 2; ++k) dst[n][k] = *(const PG8_LAS bf16x8*)(lds + PG8_SB(b, h) + boff + n * 2048 + k * 1024); } while (0)
#define PG8_MMA(ai, bj, At, Bt) do { __builtin_amdgcn_s_setprio(1); _Pragma("unroll") for (int m = 0; m < 4; ++m) _Pragma("unroll") for (int n = 0; n < 2; ++n) _Pragma("unroll") for (int k = 0; k < 2; ++k) \
        acc[ai][bj][m][n] = __builtin_amdgcn_mfma_f32_16x16x32_bf16(Bt[n][k], At[m][k], acc[ai][bj][m][n], 0, 0, 0); __builtin_amdgcn_s_setprio(0); } while (0)
#define PG8_WAIT_V(n) asm volatile("s_waitcnt vmcnt(" #n ")" ::: "memory")
#define PG8_WAIT_L(n) asm volatile("s_waitcnt lgkmcnt(" #n ")" ::: "memory")
#define PG8_BAR __builtin_amdgcn_s_barrier()
#define PG8_SCHED __builtin_amdgcn_sched_barrier(0)
    Unit cur, nxt; int ui = 0;
    if (!S.next(0, cur)) return;
    f32x4 acc[2][2][4][2];
#pragma unroll
    for (int a = 0; a < 2; ++a)
#pragma unroll
        for (int b = 0; b < 2; ++b)
#pragma unroll
            for (int m = 0; m < 4; ++m)
#pragma unroll
                for (int n = 0; n < 2; ++n) acc[a][b][m][n] = (f32x4){0.f, 0.f, 0.f, 0.f};
    bf16x8 At[4][2], B0[2][2], B1[2][2];
    const char* cA = (const char*)g.A + (size_t)cur.pm * tstep; const char* cB = (const char*)g.Bt + (size_t)cur.pn * tstep;
    S.a_ready(cur);
    if constexpr (SP2) {
        PG8_STAGE(PG8_SB(0, 0), cB, voffB); PG8_STAGE(PG8_SB(0, 1), cB + hstep, voffB); PG8_STAGE(PG8_SA(0, 0), cA, voffA); PG8_STAGE(PG8_SA(0, 1), cA + hstep, voffA);
        if (wr == 1) PG8_BAR;
        PG8_WAIT_V(2); PG8_BAR;
        PG8_STAGE(PG8_SB(1, 0), cB + kstep, voffB); PG8_STAGE(PG8_SA(1, 0), cA + kstep, voffA); PG8_STAGE(PG8_SB(1, 1), cB + hstep + kstep, voffB);
        PG8_WAIT_V(6); PG8_BAR;
    } else {
        PG8_STAGE(PG8_SB(0, 0), cB, voffB); PG8_STAGE(PG8_SA(0, 0), cA, voffA); PG8_STAGE(PG8_SB(0, 1), cB + hstep, voffB); PG8_STAGE(PG8_SA(0, 1), cA + hstep, voffA);
        if (wr == 1) PG8_BAR;
        PG8_WAIT_V(4); PG8_BAR;
        PG8_STAGE(PG8_SB(1, 0), cB + kstep, voffB); PG8_STAGE(PG8_SA(1, 0), cA + kstep, voffA); PG8_STAGE(PG8_SB(1, 1), cB + hstep + kstep, voffB);
        PG8_WAIT_V(6); PG8_BAR;
    }
    for (;;) {
        const bool has_next = S.next(ui + 1, nxt);
        const char* nA = has_next ? (const char*)g.A + (size_t)nxt.pm * tstep : cA; const char* nB = has_next ? (const char*)g.Bt + (size_t)nxt.pn * tstep : cB;
        for (int t = 0; t < nt; t += 2) {
            const bool last = (t == nt - 2);
            const char* a1 = cA + (size_t)(t + 1) * kstep;
            const char* a2 = last ? nA : cA + (size_t)(t + 2) * kstep; const char* b2 = last ? nB : cB + (size_t)(t + 2) * kstep;
            const char* a3 = a2 + kstep; const char* b3 = b2 + kstep;
            if (last && has_next) S.a_ready(nxt);
            if constexpr (SP2) {
            PG8_LDB(B0, 0, 0); PG8_LDB(B1, 0, 1); PG8_SCHED; PG8_LDA(At, 0, 0); PG8_STAGE(PG8_SA(1, 1), a1 + hstep, voffA);
            PG8_WAIT_V(8); PG8_WAIT_L(0); PG8_BAR; PG8_MMA(0, 0, At, B0); PG8_MMA(0, 1, At, B1); PG8_BAR; PG8_SCHED;
            PG8_LDA(At, 0, 1); PG8_STAGE(PG8_SB(0, 0), b2, voffB); PG8_STAGE(PG8_SB(0, 1), b2 + hstep, voffB); PG8_STAGE(PG8_SA(0, 0), a2, voffA);
            PG8_WAIT_V(8); PG8_WAIT_L(0); PG8_BAR; PG8_MMA(1, 0, At, B0); PG8_MMA(1, 1, At, B1); PG8_BAR; PG8_SCHED;
            PG8_LDB(B0, 1, 0); PG8_LDB(B1, 1, 1); PG8_SCHED; PG8_LDA(At, 1, 0); PG8_STAGE(PG8_SA(0, 1), a2 + hstep, voffA);
            PG8_WAIT_V(8); PG8_WAIT_L(0); PG8_BAR; PG8_MMA(0, 0, At, B0); PG8_MMA(0, 1, At, B1); PG8_BAR; PG8_SCHED;
            PG8_LDA(At, 1, 1); PG8_STAGE(PG8_SB(1, 0), b3, voffB); PG8_STAGE(PG8_SB(1, 1), b3 + hstep, voffB); PG8_STAGE(PG8_SA(1, 0), a3, voffA);
            PG8_WAIT_V(8); PG8_WAIT_L(0); PG8_BAR; PG8_MMA(1, 0, At, B0); PG8_MMA(1, 1, At, B1); PG8_BAR; PG8_SCHED;
            } else {
            PG8_LDB(B0, 0, 0); PG8_SCHED; PG8_LDA(At, 0, 0); PG8_STAGE(PG8_SA(1, 1), a1 + hstep, voffA);
            PG8_WAIT_L(8); PG8_BAR; PG8_WAIT_L(0); PG8_MMA(0, 0, At, B0); PG8_BAR; PG8_SCHED;
            PG8_LDB(B1, 0, 1); PG8_STAGE(PG8_SB(0, 0), b2, voffB);
            PG8_BAR; PG8_WAIT_L(0); PG8_MMA(0, 1, At, B1); PG8_BAR;
            PG8_LDA(At, 0, 1); PG8_STAGE(PG8_SA(0, 0), a2, voffA);
            PG8_BAR; PG8_WAIT_L(0); PG8_MMA(1, 0, At, B0); PG8_BAR; PG8_SCHED;
            PG8_STAGE(PG8_SB(0, 1), b2 + hstep, voffB);
            PG8_WAIT_V(6); PG8_BAR; PG8_MMA(1, 1, At, B1); PG8_BAR;
            PG8_LDB(B0, 1, 0); PG8_SCHED; PG8_LDA(At, 1, 0); PG8_STAGE(PG8_SA(0, 1), a2 + hstep, voffA);
            PG8_WAIT_L(8); PG8_BAR; PG8_WAIT_L(0); PG8_MMA(0, 0, At, B0); PG8_BAR; PG8_SCHED;
            PG8_LDB(B1, 1, 1); PG8_STAGE(PG8_SB(1, 0), b3, voffB);
            PG8_BAR; PG8_WAIT_L(0); PG8_MMA(0, 1, At, B1); PG8_BAR;
            PG8_LDA(At, 1, 1); PG8_STAGE(PG8_SA(1, 0), a3, voffA);
            PG8_BAR; PG8_WAIT_L(0); PG8_MMA(1, 0, At, B0); PG8_BAR; PG8_SCHED;
            PG8_STAGE(PG8_SB(1, 1), b3 + hstep, voffB);
            PG8_WAIT_V(6); PG8_BAR; PG8_MMA(1, 1, At, B1); PG8_BAR;
            }
        }
        if constexpr (ALIGN_EPI) { if (wr == 0) PG8_BAR; }
        if constexpr (!Epi::AFTER_DRAIN) { E(acc, cur, wr, wc, fr, fq); S.done(cur); }
        if (!has_next) break;
#pragma unroll
        for (int a = 0; a < 2; ++a)
#pragma unroll
            for (int b = 0; b < 2; ++b)
#pragma unroll
                for (int m = 0; m < 4; ++m)
#pragma unroll
                    for (int n = 0; n < 2; ++n) acc[a][b][m][n] = (f32x4){0.f, 0.f, 0.f, 0.f};
        cur = nxt; cA = nA; cB = nB; ++ui;
        if constexpr (ALIGN_EPI) { if (wr == 1) PG8_BAR; }
    }
    PG8_WAIT_V(0);
    if constexpr (!ALIGN_EPI) { if (wr == 0) PG8_BAR; }
    PG8_BAR;
    if constexpr (Epi::AFTER_DRAIN) { E.fused(acc, cur, wr, wc, fr, fq, lds, wid, lane); S.done(cur); }
#undef PG8_SA
#undef PG8_SB
#undef PG8_STAGE
#undef PG8_LDA
#undef PG8_LDB
#undef PG8_MMA
#undef PG8_WAIT_V
#undef PG8_WAIT_L
#undef PG8_BAR
#undef PG8_SCHED
}
}
#define GAS __attribute__((address_space(1)))
#define LAS __attribute__((address_space(3)))
typedef unsigned short bf16;
typedef unsigned v4u __attribute__((ext_vector_type(4)));
typedef float f32x4 __attribute__((ext_vector_type(4)));
typedef short bf16x8 __attribute__((ext_vector_type(8)));
typedef GAS unsigned gu32;
typedef GAS unsigned long long gu64;
#define RLX_AGENT __ATOMIC_RELAXED, __HIP_MEMORY_SCOPE_AGENT
#define LDS_WAIT() asm volatile("s_waitcnt lgkmcnt(0)" ::: "memory")
#define VM_WAIT() asm volatile("s_waitcnt vmcnt(0)" ::: "memory")
__device__ __forceinline__ unsigned long long rt() { return __builtin_amdgcn_s_memrealtime(); }
__device__ __forceinline__ unsigned f2bf(float f) { unsigned u = __builtin_bit_cast(unsigned, f); return (u + 0x7fffu + ((u >> 16) & 1u)) >> 16; }
__device__ __forceinline__ unsigned pk2(float lo, float hi) { return f2bf(lo) | (f2bf(hi) << 16); }

#define XB_TMO      128
#define XB_XCNT(j)  (256  + 64 * (j))
#define XB_XSUB(j)  (1280 + 64 * (j))
#define XB_XGEN(j)  (2304 + 64 * (j))
#define XB_TOP      3328
#define XB_TOPGEN   3392
#define XCD_BAR_WORDS 3456
#define XB_SPIN_CAP (1u << 18)

__device__ __forceinline__ unsigned xb_ld(unsigned* p)              { return __hip_atomic_load(p, __ATOMIC_RELAXED, __HIP_MEMORY_SCOPE_AGENT); }
__device__ __forceinline__ unsigned xb_add(unsigned* p, unsigned v) { return __hip_atomic_fetch_add(p, v, __ATOMIC_RELAXED, __HIP_MEMORY_SCOPE_AGENT); }
__device__ __forceinline__ unsigned xb_xcc_id() { return (unsigned)__builtin_amdgcn_s_getreg((3 << 11) | 20) & 0xFu; }
#define XB_SPIN(cond, bar) do { unsigned _sp = 0; while (cond) { __builtin_amdgcn_s_sleep(1); \
    if ((++_sp & 255u) == 0u) { if (xb_ld(&(bar)[XB_TMO])) break; if (_sp > XB_SPIN_CAP) { atomicAdd(&(bar)[XB_TMO], 1u); break; } } } } while (0)

struct XcdBarrier {
    unsigned* bar; unsigned x;
    volatile LAS unsigned* st;
};

__device__ __forceinline__ XcdBarrier xcd_barrier_post(unsigned* bar, volatile LAS unsigned* st) {
    XcdBarrier b; b.bar = bar; b.x = xb_xcc_id(); b.st = st;
    if (threadIdx.x == 0) (void)xb_add(&bar[XB_XCNT(b.x)], 1u);
    return b;
}
__device__ __forceinline__ void xcd_barrier_complete(unsigned* bar, unsigned x, unsigned& nloc, unsigned& nx) {
    const unsigned G = gridDim.x * gridDim.y * gridDim.z;
    unsigned sum, cnt, mine, sp = 0u;
    for (;;) {
        sum = 0u; cnt = 0u; mine = 0u;
#pragma unroll
        for (unsigned j = 0; j < 16; ++j) { const unsigned c = xb_ld(&bar[XB_XCNT(j)]); sum += c; cnt += (c > 0u) ? 1u : 0u; mine = (j == x) ? c : mine; }
        if (sum == G) break;
        __builtin_amdgcn_s_sleep(1);
        if ((++sp & 255u) == 0u) { if (xb_ld(&bar[XB_TMO])) break; if (sp > XB_SPIN_CAP) { atomicAdd(&bar[XB_TMO], 1u); break; } }
    }
    nloc = mine > 0u ? mine : 1u; nx = cnt > 0u ? cnt : 1u;
}

__device__ __forceinline__ void xcd_barrier(const XcdBarrier& b) {
    asm volatile("s_waitcnt vmcnt(0)" ::: "memory");
    __syncthreads();
    if (threadIdx.x == 0) {
        unsigned* bar = b.bar;
        __builtin_amdgcn_s_waitcnt(0);
        unsigned nloc = b.st[0], nx = b.st[1];
        if (nloc == 0u) { xcd_barrier_complete(bar, b.x, nloc, nx); b.st[0] = nloc; b.st[1] = nx; }
        const unsigned old = xb_add(&bar[XB_XSUB(b.x)], 1u);
        const unsigned gen = old / nloc;
        if (old + 1u == (gen + 1u) * nloc) {
            __builtin_amdgcn_fence(__ATOMIC_RELEASE, "agent");
            asm volatile("s_waitcnt vmcnt(0)" ::: "memory");
            const unsigned og = xb_add(&bar[XB_TOP], 1u);
            const unsigned tg = og / nx;
            if (og + 1u == (tg + 1u) * nx) xb_add(&bar[XB_TOPGEN], 1u);
            else XB_SPIN(xb_ld(&bar[XB_TOPGEN]) == tg, bar);
            __builtin_amdgcn_fence(__ATOMIC_ACQUIRE, "agent");
            xb_add(&bar[XB_XGEN(b.x)], 1u);
            asm volatile("s_waitcnt vmcnt(0)" ::: "memory");
        } else {
            XB_SPIN(xb_ld(&bar[XB_XGEN(b.x)]) == gen, bar);
            __builtin_amdgcn_fence(__ATOMIC_ACQUIRE, "agent");
            asm volatile("s_waitcnt vmcnt(0)" ::: "memory");
        }
    }
    __syncthreads();
}
constexpr int NWAVES = 8;
constexpr int D = 1024, BATCH = 8, SEQ = 2048, T = BATCH * SEQ;
constexpr int AW = 512, RW = 512, NH = 8;
constexpr int DL = 64, AL = 64, GL = 128;
constexpr int SHIFTW = 3 * RW + DL + AL + GL;
constexpr int INW = 3 * AW + SHIFTW;
constexpr int NKEYS = 128, PH = 8, PKD = 256, TOPK = 16, HK = PH * TOPK;
constexpr int QW = PH * PKD;
constexpr int MODW = 6 * D;

constexpr size_t MiB = 1u << 20;
constexpr size_t WS_CTL = 0, CTL_ZERO_BYTES = 1 * MiB;
constexpr size_t WS_MOD = 1 * MiB;
constexpr size_t WS_KEYS = 1 * MiB + 512 * 1024;
constexpr size_t WS_WIN = 2 * MiB;
constexpr size_t WS_WOUT = 9 * MiB;
constexpr size_t WS_WQ = 11 * MiB;
constexpr size_t WS_XN = 16 * MiB;
constexpr size_t WS_Z = 48 * MiB;
constexpr size_t WS_MIX = 152 * MiB;
constexpr size_t WS_Y = 184 * MiB;
constexpr size_t WS_Q = 48 * MiB;
constexpr size_t WS_IDX = 112 * MiB;
constexpr size_t WS_GATE = 120 * MiB;
constexpr size_t WS_END = 248 * MiB;
constexpr int CW_BAR = 4096;
constexpr int MAX_LAUNCHES = 12;

constexpr int RING_OFF = 0, RING_BYTES = 131072;
constexpr int LDSCTL_OFF = RING_BYTES, MISC_OFF = LDSCTL_OFF + 320;
constexpr int LDS_BYTES = 147456;

typedef GAS float gf32;
typedef GAS f32x4 gf32x4;

__device__ __forceinline__ float bf2f(bf16 v) { return __uint_as_float(((unsigned)v) << 16); }
__device__ __forceinline__ float wave_sum(float v) {
#pragma unroll
    for (int o = 1; o < 64; o <<= 1) v += __shfl_xor(v, o);
    return v;
}
#define WAVE_LDS_SYNC() do { asm volatile("s_waitcnt lgkmcnt(0)" ::: "memory"); __builtin_amdgcn_wave_barrier(); } while (0)

__device__ __forceinline__ void p0_transpose_item(const float* W, int K, int N, bf16* WT, int row_off, LAS float* scr, int item, int lane) {
    const int nblk = N / 32, kb = item / nblk, nb = item % nblk, k0 = 64 * kb, n0 = 32 * nb;
#pragma unroll 8
    for (int i = 0; i < 32; ++i) { const int kk = 2 * i + (lane >> 5); scr[kk * 33 + (lane & 31)] = W[(size_t)(k0 + kk) * N + n0 + (lane & 31)]; }
    LDS_WAIT(); asm volatile("" ::: "memory");
    const int c = lane & 7;
#pragma unroll
    for (int j = 0; j < 4; ++j) { const int n = (lane >> 3) + 8 * j; const LAS float* s = scr + (8 * c) * 33 + n;
        v4u o; o.x = pk2(s[0 * 33], s[1 * 33]); o.y = pk2(s[2 * 33], s[3 * 33]); o.z = pk2(s[4 * 33], s[5 * 33]); o.w = pk2(s[6 * 33], s[7 * 33]);
        *(GAS v4u*)(WT + (size_t)(row_off + n0 + n) * K + k0 + 8 * c) = o; }
    LDS_WAIT(); asm volatile("" ::: "memory");
}

__device__ __forceinline__ void norm_row(const float* xrow, const float* g, const float* modb, int shift_off, int scale_off, bf16* orow, int lane) {
    const GAS f32x4* xr = (const GAS f32x4*)xrow + lane;
    f32x4 v[4]; float s = 0.f;
#pragma unroll
    for (int j = 0; j < 4; ++j) { v[j] = xr[64 * j]; s += (v[j].x * v[j].x + v[j].y * v[j].y) + (v[j].z * v[j].z + v[j].w * v[j].w); }
    const float rs = 1.0f / sqrtf(wave_sum(s) * (1.f / D) + 1e-6f);
    GAS unsigned long long* o8 = (GAS unsigned long long*)orow + lane;
#pragma unroll
    for (int j = 0; j < 4; ++j) {
        const int col = 256 * j + 4 * lane;
        const f32x4 g4 = *(const GAS f32x4*)(g + col), sc = *(const GAS f32x4*)(modb + scale_off + col), sh = *(const GAS f32x4*)(modb + shift_off + col);
        const f32x4 y = v[j] * rs * g4 * (sc + 1.0f) + sh;
        o8[64 * j] = (unsigned long long)pk2(y.x, y.y) | ((unsigned long long)pk2(y.z, y.w) << 32);
    }
}

struct EpiRes {
    static constexpr bool PERM = false, AFTER_DRAIN = false;
    const float* xres; const float* mod; int gate_off; float* out; int ldc;
    __device__ __forceinline__ void operator()(const pg8::f32x4 (&acc)[2][2][4][2], const pg8::Unit& u, int wr, int wc, int fr, int fq) const {
        const int col0 = u.pn * pg8::BM + wc * 32 + 4 * fq;
        const int b = (u.pm * pg8::BM) / SEQ;
        pg8::f32x4 gv[2][2];
#pragma unroll
        for (int bj = 0; bj < 2; ++bj)
#pragma unroll
            for (int n = 0; n < 2; ++n) gv[bj][n] = *(const pg8::f32x4*)(mod + b * MODW + gate_off + col0 + bj * pg8::HALF + n * 16);
#pragma unroll
        for (int ai = 0; ai < 2; ++ai)
#pragma unroll
            for (int m = 0; m < 4; ++m) { const size_t off = (size_t)(u.pm * pg8::BM + ai * pg8::HALF + wr * 64 + m * 16 + fr) * ldc + col0;
#pragma unroll
                for (int bj = 0; bj < 2; ++bj)
#pragma unroll
                    for (int n = 0; n < 2; ++n) { const pg8::f32x4 bs = *(const pg8::f32x4*)(xres + off + bj * pg8::HALF + n * 16);
                        *(pg8::f32x4*)(out + off + bj * pg8::HALF + n * 16) = bs + gv[bj][n] * acc[ai][bj][m][n]; } }
    }
};

__device__ __forceinline__ float zshift(const bf16* Z, int tok, int t, int col, const float* mu_prev, const float* mu_next) {
    const bf16* zc = Z + (size_t)tok * INW + 3 * AW + col;
    const float z = bf2f(zc[0]);
    const float zp = (t > 0) ? bf2f(zc[-INW]) : 0.f;
    const float zn = (t < SEQ - 1) ? bf2f(zc[INW]) : 0.f;
    return z + mu_prev[col] * (zp - z) + mu_next[col] * (zn - z);
}
__device__ __forceinline__ float decay_of(float wl) {
    const float nx = -wl; const float sp = (nx > 20.f) ? nx : log1pf(expf(nx));
    return expf(-expf(-sp - 0.5f));
}

__device__ __forceinline__ void attn_naive_item(const bf16* Z, const float* qg, const float* kg, bf16* mix, int gid) {
    asm volatile("" ::: "memory");
    const int h = gid & 7, tok = gid >> 3, b = tok / SEQ, t = tok % SEQ;
    const float slope = exp2f(-(float)(h + 1));
    unsigned qp[32];
    { const unsigned* qs = (const unsigned*)(Z + (size_t)tok * INW + h * 64); float ss = 0.f;
#pragma unroll
      for (int c = 0; c < 32; ++c) { const unsigned w = qs[c]; const float a = __uint_as_float(w << 16), bb = __uint_as_float(w & 0xffff0000u); ss += a * a + bb * bb; }
      const float rs = 0.125f / sqrtf(ss * (1.f / 64.f) + 1e-6f);
#pragma unroll
      for (int c = 0; c < 32; ++c) { const unsigned w = qs[c]; const float a = __uint_as_float(w << 16), bb = __uint_as_float(w & 0xffff0000u);
          qp[c] = pk2(a * rs * qg[2 * c] * kg[2 * c], bb * rs * qg[2 * c + 1] * kg[2 * c + 1]); } }
#pragma unroll 1
    for (int half = 0; half < 2; ++half) {
        float m = -INFINITY, l = 0.f; float acc[32];
#pragma unroll
        for (int c = 0; c < 32; ++c) acc[c] = 0.f;
#pragma unroll 1
        for (int p = 0; p < 3; ++p) {
            const int d = (p == 0) ? 1 : (p == 1 ? 4 : 16);
            const int L = SEQ / d, r = t % d, i = t / d;
#pragma unroll 1
            for (int o = -64; o <= 64; ++o) {
                const int j = i + o; if (j < 0 || j >= L) continue;
                const int tk = j * d + r;
                const unsigned* kp = (const unsigned*)(Z + (size_t)(b * SEQ + tk) * INW + AW + h * 64);
                const unsigned* vp = kp + AW / 2 + half * 16;
                float ss = 0.f, dot = 0.f;
#pragma unroll
                for (int c = 0; c < 32; ++c) { const unsigned w = kp[c]; const float k0 = __uint_as_float(w << 16), k1 = __uint_as_float(w & 0xffff0000u);
                    ss += k0 * k0 + k1 * k1; dot += __uint_as_float(qp[c] << 16) * k0 + __uint_as_float(qp[c] & 0xffff0000u) * k1; }
                const float s = dot * (1.0f / sqrtf(ss * (1.f / 64.f) + 1e-6f)) - slope * (float)(d * (o < 0 ? -o : o));
                const float mn = fmaxf(m, s), al = expf(m - mn), pe = expf(s - mn);
                l = l * al + pe; m = mn;
#pragma unroll
                for (int c = 0; c < 16; ++c) { const unsigned w = vp[c]; acc[2 * c] = acc[2 * c] * al + pe * __uint_as_float(w << 16); acc[2 * c + 1] = acc[2 * c + 1] * al + pe * __uint_as_float(w & 0xffff0000u); }
            }
        }
        const float invL = 1.0f / l;
        unsigned* op = (unsigned*)(mix + (size_t)tok * D + h * 64 + half * 32);
#pragma unroll
        for (int c = 0; c < 16; ++c) op[c] = pk2(acc[2 * c] * invL, acc[2 * c + 1] * invL);
    }
}

__device__ __forceinline__ void scan_naive_chain(const bf16* Z, const float* mu_prev, const float* mu_next, const float* w_decay0, const float* w_decay_up,
                                                 const float* a_gate0, const float* a_gate_up, const float* k_k, const float* k_a, float* Y, int chain, int lane, LAS float* sl) {
    LAS float* s_tw = sl; LAS float* s_xa = sl + 64; LAS float* s_kk = sl + 128; LAS float* s_dec = sl + 192; LAS float* s_b = sl + 256; LAS float* s_kd = sl + 320; LAS float* s_r = sl + 384;
    const int dir = chain & 1, h = (chain >> 1) & 7, b = chain >> 4, hc = h * 64 + lane;
    float S[64];
#pragma unroll
    for (int c = 0; c < 64; ++c) S[c] = 0.f;
    const float w0 = w_decay0[dir * RW + hc], a0 = a_gate0[dir * RW + hc], kkw = k_k[hc], kaw = k_a[hc];
#pragma unroll 1
    for (int st = 0; st < SEQ; ++st) {
        const int t = dir ? (SEQ - 1 - st) : st, tok = b * SEQ + t;
        const float r = zshift(Z, tok, t, hc, mu_prev, mu_next), k = zshift(Z, tok, t, RW + hc, mu_prev, mu_next), v = zshift(Z, tok, t, 2 * RW + hc, mu_prev, mu_next);
        const float xw = zshift(Z, tok, t, 3 * RW + lane, mu_prev, mu_next), xa = zshift(Z, tok, t, 3 * RW + DL + lane, mu_prev, mu_next);
        WAVE_LDS_SYNC();
        s_tw[lane] = tanhf(xw); s_xa[lane] = xa;
        WAVE_LDS_SYNC();
        float wl = w0, al = a0;
#pragma unroll 4
        for (int j = 0; j < 64; ++j) { wl += s_tw[j] * w_decay_up[(size_t)(dir * DL + j) * RW + hc]; al += s_xa[j] * a_gate_up[(size_t)(dir * AL + j) * RW + hc]; }
        const float dec = decay_of(wl), a = 1.0f / (1.0f + expf(-al));
        float kk = k * kkw; const float ss = wave_sum(kk * kk);
        kk = kk * (1.0f / sqrtf(fmaxf(ss, 1e-12f)));
        s_kk[lane] = kk; s_dec[lane] = dec; s_b[lane] = kk * a; s_kd[lane] = k * (1.0f + (a - 1.0f) * kaw); s_r[lane] = r;
        WAVE_LDS_SYNC();
        float sa = 0.f;
#pragma unroll
        for (int c = 0; c < 64; ++c) sa -= S[c] * s_kk[c];
        float y = 0.f;
#pragma unroll
        for (int c = 0; c < 64; ++c) { S[c] = S[c] * s_dec[c] + sa * s_b[c] + v * s_kd[c]; y += S[c] * s_r[c]; }
        Y[(size_t)dir * T * RW + (size_t)tok * RW + hc] = y;
    }
}

__device__ __forceinline__ void rwkv_fin_token(const bf16* Z, const float* mu_prev, const float* mu_next, const float* a_gate0, const float* a_gate_up, const float* g_up,
                                               const float* Y, const float* k_a, const float* r_k, const float* lnx_g, const float* lnx_b, bf16* mix, int tok, int c, LAS float* zr) {
    const int t = tok % SEQ;
    __syncthreads();
    for (int col = c; col < SHIFTW; col += 512) zr[col] = zshift(Z, tok, t, col, mu_prev, mu_next);
    __syncthreads();
    const size_t o = (size_t)tok * RW + c;
    const float y = Y[o] + Y[(size_t)T * RW + o];
    const float mean = wave_sum(y) * (1.f / 64.f);
    const float var = wave_sum((y - mean) * (y - mean)) * (1.f / 64.f);
    const float yn = (y - mean) * (1.0f / sqrtf(var + 64e-5f)) * lnx_g[c] + lnx_b[c];
    float al0 = a_gate0[c], al1 = a_gate0[RW + c], g = 0.f;
#pragma unroll 4
    for (int j = 0; j < AL; ++j) { const float xa = zr[3 * RW + DL + j]; al0 += xa * a_gate_up[(size_t)j * RW + c]; al1 += xa * a_gate_up[(size_t)(AL + j) * RW + c]; }
#pragma unroll 4
    for (int j = 0; j < GL; ++j) g += (1.0f / (1.0f + expf(-zr[3 * RW + DL + AL + j]))) * g_up[(size_t)j * RW + c];
    const float a0 = 1.0f / (1.0f + expf(-al0)), a1 = 1.0f / (1.0f + expf(-al1));
    const float r = zr[c], k = zr[RW + c], v = zr[2 * RW + c];
    const float kb = k * (1.0f + (0.5f * (a0 + a1) - 1.0f) * k_a[c]);
    const float bs = wave_sum(r * kb * r_k[c]);
    mix[(size_t)tok * D + AW + c] = (bf16)f2bf((yn + bs * v) * g);
}

__device__ __forceinline__ void wave_argmax(float& v, int& i) {
#pragma unroll
    for (int m = 1; m < 64; m <<= 1) { const float ov = __shfl_xor(v, m); const int oi = __shfl_xor(i, m); if (ov > v || (ov == v && oi < i)) { v = ov; i = oi; } }
}

__device__ __forceinline__ void peer_select_item(const bf16* Q, const float* keys1, const float* keys2, int* IDX, float* GATE, int th, int lane) {
    const bf16* qp = Q + (size_t)th * PKD;
    float s1a = 0.f, s1b = 0.f, s2a = 0.f, s2b = 0.f;
    for (int d = 0; d < 128; ++d) {
        const float q1 = bf2f(qp[d]), q2 = bf2f(qp[128 + d]);
        s1a += q1 * keys1[lane * 128 + d]; s1b += q1 * keys1[(lane + 64) * 128 + d];
        s2a += q2 * keys2[lane * 128 + d]; s2b += q2 * keys2[(lane + 64) * 128 + d];
    }
    float v1 = 0.f, v2 = 0.f; int i1 = 0, i2 = 0;
    for (int k = 0; k < TOPK; ++k) {
        float bv = s1a; int bi = lane; if (s1b > bv) { bv = s1b; bi = lane + 64; }
        wave_argmax(bv, bi);
        if (lane == k) { v1 = bv; i1 = bi; }
        if (bi == lane) s1a = -INFINITY; if (bi == lane + 64) s1b = -INFINITY;
    }
    for (int k = 0; k < TOPK; ++k) {
        float bv = s2a; int bi = lane; if (s2b > bv) { bv = s2b; bi = lane + 64; }
        wave_argmax(bv, bi);
        if (lane == k) { v2 = bv; i2 = bi; }
        if (bi == lane) s2a = -INFINITY; if (bi == lane + 64) s2b = -INFINITY;
    }
    const float va = __shfl(v1, lane >> 2);
    float c0 = va + __shfl(v2, (lane & 3) * 4 + 0), c1 = va + __shfl(v2, (lane & 3) * 4 + 1), c2 = va + __shfl(v2, (lane & 3) * 4 + 2), c3 = va + __shfl(v2, (lane & 3) * 4 + 3);
    float ts = 0.f; int tp = 0;
    for (int k = 0; k < TOPK; ++k) {
        float bv = c0; int bi = lane * 4;
        if (c1 > bv) { bv = c1; bi = lane * 4 + 1; } if (c2 > bv) { bv = c2; bi = lane * 4 + 2; } if (c3 > bv) { bv = c3; bi = lane * 4 + 3; }
        wave_argmax(bv, bi);
        if (lane == k) { ts = bv; tp = bi; }
        if (bi == lane * 4) c0 = -INFINITY; if (bi == lane * 4 + 1) c1 = -INFINITY; if (bi == lane * 4 + 2) c2 = -INFINITY; if (bi == lane * 4 + 3) c3 = -INFINITY;
    }
    const int e1 = __shfl(i1, tp >> 4), e2 = __shfl(i2, tp & 15);
    const float mx = __shfl(ts, 0);
    const float ex = (lane < 16) ? expf(ts - mx) : 0.f;
    float sum = ex;
#pragma unroll
    for (int m = 1; m < 16; m <<= 1) sum += __shfl_xor(sum, m);
    if (lane < 16) { IDX[(size_t)th * TOPK + lane] = e1 * NKEYS + e2; GATE[(size_t)th * TOPK + lane] = ex / sum; }
}

__device__ __forceinline__ void peer_ffn_token(const bf16* XN, const int* IDX, const float* GATE, const float* U, const float* Vt, const float* mod, float* out, int tok, int lane) {
    const int b = tok / SEQ;
    float x[16], y[16];
#pragma unroll
    for (int j = 0; j < 4; ++j)
#pragma unroll
        for (int e = 0; e < 4; ++e) { x[j * 4 + e] = bf2f(XN[(size_t)tok * D + 256 * j + lane * 4 + e]); y[j * 4 + e] = 0.f; }
    for (int k = 0; k < HK; ++k) {
        const int ex = IDX[(size_t)tok * HK + k]; const float gt = GATE[(size_t)tok * HK + k];
        const float* up = U + (size_t)ex * D + lane * 4; const float* vp = Vt + (size_t)ex * D + lane * 4;
        float dot = 0.f;
#pragma unroll
        for (int j = 0; j < 4; ++j) { const f32x4 u4 = *(const f32x4*)(up + 256 * j); dot += x[j * 4] * u4.x + x[j * 4 + 1] * u4.y + x[j * 4 + 2] * u4.z + x[j * 4 + 3] * u4.w; }
        dot = wave_sum(dot);
        const float act = 0.5f * dot * (1.0f + erff(dot * 0.70710678118654752f));
        const float cf = gt * act;
#pragma unroll
        for (int j = 0; j < 4; ++j) { const f32x4 v4 = *(const f32x4*)(vp + 256 * j); y[j * 4] += cf * v4.x; y[j * 4 + 1] += cf * v4.y; y[j * 4 + 2] += cf * v4.z; y[j * 4 + 3] += cf * v4.w; }
    }
#pragma unroll
    for (int j = 0; j < 4; ++j) { const int cidx = 256 * j + lane * 4; const size_t o = (size_t)tok * D + cidx;
        const f32x4 g2 = *(const f32x4*)(mod + b * MODW + 5 * D + cidx); f32x4 ov = *(const f32x4*)(out + o);
        ov.x += g2.x * y[j * 4]; ov.y += g2.y * y[j * 4 + 1]; ov.z += g2.z * y[j * 4 + 2]; ov.w += g2.w * y[j * 4 + 3];
        *(f32x4*)(out + o) = ov; }
}

#ifndef MK_SKIP
#define MK_SKIP 0
#endif
constexpr int N_PHASES = 10;
struct Args { const float* in[27]; float* out; unsigned char* ws; int ph_lo, ph_hi, li, pad; };

__global__ void __launch_bounds__(NWAVES * 64, 2) mk_fwd(Args args) {
    extern __shared__ __attribute__((aligned(16))) unsigned char lds[];
    LAS unsigned char* L = (LAS unsigned char*)lds;
    volatile LAS unsigned* MISC = (volatile LAS unsigned*)(L + MISC_OFF);
    const int tid = threadIdx.x, lane = tid & 63, wave = __builtin_amdgcn_readfirstlane(tid >> 6);
    const int G = gridDim.x, bx = blockIdx.x;
    unsigned char* ws = args.ws;
    gu32* ctl = (gu32*)(ws + WS_CTL);
    const float* x = args.in[0]; const float* cvec = args.in[1]; const float* ada_w = args.in[2]; const float* ada_b = args.in[3];
    const float* norm1_g = args.in[4]; const float* w_in = args.in[5]; const float* mu_prev = args.in[6]; const float* mu_next = args.in[7];
    const float* q_norm_g = args.in[8]; const float* k_norm_g = args.in[9]; const float* w_decay0 = args.in[10]; const float* w_decay_up = args.in[11];
    const float* a_gate0 = args.in[12]; const float* a_gate_up = args.in[13]; const float* g_up = args.in[14]; const float* k_k = args.in[15];
    const float* k_a = args.in[16]; const float* r_k = args.in[17]; const float* lnx_g = args.in[18]; const float* lnx_b = args.in[19];
    const float* w_out = args.in[20]; const float* norm2_g = args.in[21]; const float* w_query = args.in[22]; const float* keys1 = args.in[23];
    const float* keys2 = args.in[24]; const float* peer_u = args.in[25]; const float* peer_v = args.in[26];
    float* out = args.out;
    float* MOD = (float*)(ws + WS_MOD); bf16* KEYS = (bf16*)(ws + WS_KEYS); bf16* WIN = (bf16*)(ws + WS_WIN); bf16* WOUT = (bf16*)(ws + WS_WOUT); bf16* WQ = (bf16*)(ws + WS_WQ);
    bf16* XN = (bf16*)(ws + WS_XN); bf16* Z = (bf16*)(ws + WS_Z); bf16* MIX = (bf16*)(ws + WS_MIX); float* Y = (float*)(ws + WS_Y); bf16* Q = (bf16*)(ws + WS_Q);
    int* IDX = (int*)(ws + WS_IDX); float* GATE = (float*)(ws + WS_GATE);

    for (int u = tid; u < (LDS_BYTES - LDSCTL_OFF) / 4; u += NWAVES * 64) ((LAS unsigned*)(L + LDSCTL_OFF))[u] = 0u;
    __syncthreads();
    XcdBarrier bar = xcd_barrier_post((unsigned*)(ctl + CW_BAR) + args.li * XCD_BAR_WORDS, MISC + 8);
    const int lo = args.ph_lo, hi = args.ph_hi;
#define IN(k) (lo <= (k) && (k) < hi)
#define SEAM(k) do { if (IN(k) && IN((k) + 1)) xcd_barrier(bar); } while (0)
    const int gw = bx * NWAVES + wave, NGW = G * NWAVES;

    if (IN(0) && !(MK_SKIP & (1 << 0))) {
        if (bx < MODW / 64) {
            LAS float* sc = (LAS float*)L; LAS float* part = (LAS float*)(L + 32768);
            for (int i = tid; i < BATCH * D; i += NWAVES * 64) { const float cv = cvec[i]; sc[i] = cv / (1.f + expf(-cv)); }
            __syncthreads();
            const int j0 = bx * 64;
            float acc[BATCH];
#pragma unroll
            for (int b = 0; b < BATCH; ++b) acc[b] = 0.f;
            for (int i = wave * 128; i < wave * 128 + 128; ++i) { const float w = ada_w[(size_t)i * MODW + j0 + lane];
#pragma unroll
                for (int b = 0; b < BATCH; ++b) acc[b] += sc[b * D + i] * w; }
#pragma unroll
            for (int b = 0; b < BATCH; ++b) part[(wave * 8 + b) * 64 + lane] = acc[b];
            __syncthreads();
            { const int b = tid >> 6; float s = 0.f;
#pragma unroll
              for (int w = 0; w < 8; ++w) s += part[(w * 8 + b) * 64 + lane];
              MOD[b * MODW + j0 + lane] = s + ada_b[j0 + lane]; }
            __syncthreads();
        }
        LAS float* scr = (LAS float*)(L + RING_OFF + wave * 16384);
        constexpr int I_IN = (D / 64) * (INW / 32), I_OUT = (D / 64) * (D / 32), I_Q = (D / 64) * (QW / 32);
        for (int it = gw; it < I_IN + I_OUT + I_Q; it += NGW) {
            int r = it;
            if (r < I_IN) { p0_transpose_item(w_in, D, INW, WIN, 0, scr, r, lane); continue; } r -= I_IN;
            if (r < I_OUT) { p0_transpose_item(w_out, D, D, WOUT, 0, scr, r, lane); continue; } r -= I_OUT;
            p0_transpose_item(w_query, D, QW, WQ, 0, scr, r, lane);
        }
        for (int idx = bx * NWAVES * 64 + tid; idx < 256 * 256; idx += G * NWAVES * 64) {
            const int n = idx >> 8, k = idx & 255;
            float v = 0.f;
            if (n < 128) { if (k < 128) v = keys1[n * 128 + k]; } else { if (k >= 128) v = keys2[(n - 128) * 128 + (k - 128)]; }
            KEYS[idx] = (bf16)f2bf(v);
        }
    }
    SEAM(0);
    if (IN(1) && !(MK_SKIP & (1 << 1))) { for (int m = gw; m < T; m += NGW) norm_row(x + (size_t)m * D, norm1_g, MOD + (m / SEQ) * MODW, 0, D, XN + (size_t)m * D, lane); }
    SEAM(1);
    if (IN(2) && !(MK_SKIP & (1 << 2))) {
        pg8::Gemm g{XN, WIN, T, INW, D}; pg8::StaticOrder S; S.init(T, INW, G, bx);
        pg8::EpiBf16<0> E{Z, INW, nullptr, 0, 0, 1.f};
        pg8::gemm_phase<pg8::EpiBf16<0>, pg8::StaticOrder, true, true>(L + RING_OFF, g, S, E);
    }
    SEAM(2);
    if (IN(3) && !(MK_SKIP & (1 << 3))) {
        const bool scan_wave = (bx < BATCH * NH * 2) && (wave == 0);
        if (scan_wave) {
#ifndef NO_SCAN
            scan_naive_chain(Z, mu_prev, mu_next, w_decay0, w_decay_up, a_gate0, a_gate_up, k_k, k_a, Y, bx, lane, (LAS float*)(L + 65536));
#endif
        } else {
            const int nscan = (G < BATCH * NH * 2) ? G : BATCH * NH * 2;
            const int wid = (bx < nscan) ? bx * (NWAVES - 1) + (wave - 1) : nscan * (NWAVES - 1) + (bx - nscan) * NWAVES + wave;
            const int nworkers = G * NWAVES - nscan;
#ifndef NO_ATT
            for (int it = wid; it < T * NH / 64; it += nworkers) attn_naive_item(Z, q_norm_g, k_norm_g, MIX, it * 64 + lane);
#endif
        }
    }
    SEAM(3);
    if (IN(4) && !(MK_SKIP & (1 << 4))) { for (int tok = bx; tok < T; tok += G) rwkv_fin_token(Z, mu_prev, mu_next, a_gate0, a_gate_up, g_up, Y, k_a, r_k, lnx_g, lnx_b, MIX, tok, tid, (LAS float*)L); }
    SEAM(4);
    if (IN(5) && !(MK_SKIP & (1 << 5))) {
        pg8::Gemm g{MIX, WOUT, T, D, D}; pg8::StaticOrder S; S.init(T, D, G, bx);
        EpiRes E{x, MOD, 2 * D, out, D};
        pg8::gemm_phase<EpiRes, pg8::StaticOrder, true, true>(L + RING_OFF, g, S, E);
    }
    SEAM(5);
    if (IN(6) && !(MK_SKIP & (1 << 6))) { for (int m = gw; m < T; m += NGW) norm_row(out + (size_t)m * D, norm2_g, MOD + (m / SEQ) * MODW, 3 * D, 4 * D, XN + (size_t)m * D, lane); }
    SEAM(6);
    if (IN(7) && !(MK_SKIP & (1 << 7))) {
        pg8::Gemm g{XN, WQ, T, QW, D}; pg8::StaticOrder S; S.init(T, QW, G, bx);
        pg8::EpiBf16<0> E{Q, QW, nullptr, 0, 0, 1.f};
        pg8::gemm_phase<pg8::EpiBf16<0>, pg8::StaticOrder, true, true>(L + RING_OFF, g, S, E);
    }
    SEAM(7);
    if (IN(8) && !(MK_SKIP & (1 << 8))) { for (int th = gw; th < T * PH; th += NGW) peer_select_item(Q, keys1, keys2, IDX, GATE, th, lane); }
    SEAM(8);
    if (IN(9) && !(MK_SKIP & (1 << 9))) { for (int tok = gw; tok < T; tok += NGW) peer_ffn_token(XN, IDX, GATE, peer_u, peer_v, MOD, out, tok, lane); }
#undef IN
#undef SEAM
}

extern "C" void kernel_launch(void* const* d_in, const int* in_sizes, int n_in, void* d_out, int out_size, void* d_ws, size_t ws_size, hipStream_t stream) {
    static int grid = 0;
    if (grid == 0) {
        if (n_in != 27 || in_sizes[0] != T * D || out_size != T * D || ws_size < WS_END) { fprintf(stderr, "kernel_launch: unexpected problem (n_in %d, in0 %d, out %d, ws %zu); nothing launched\n", n_in, n_in > 0 ? in_sizes[0] : -1, out_size, ws_size); grid = -1; return; }
        int dev = 0, cus = 0, per_cu = 0;
        if (hipGetDevice(&dev) != hipSuccess || hipDeviceGetAttribute(&cus, hipDeviceAttributeMultiprocessorCount, dev) != hipSuccess) { fprintf(stderr, "kernel_launch: device query failed\n"); grid = -1; return; }
        if (hipFuncSetAttribute((const void*)mk_fwd, hipFuncAttributeMaxDynamicSharedMemorySize, LDS_BYTES) != hipSuccess) { fprintf(stderr, "kernel_launch: hipFuncSetAttribute failed\n"); grid = -1; return; }
        if (hipOccupancyMaxActiveBlocksPerMultiprocessor(&per_cu, (const void*)mk_fwd, NWAVES * 64, LDS_BYTES) != hipSuccess || per_cu < 1)
            fprintf(stderr, "kernel_launch: note: occupancy query reports %d workgroups per CU\n", per_cu);
        (void)hipGetLastError();
        grid = cus;
    }
    if (grid < 0) return;
    if (hipMemsetAsync((char*)d_ws + WS_CTL, 0, CTL_ZERO_BYTES, stream) != hipSuccess) { fprintf(stderr, "kernel_launch: hipMemsetAsync failed\n"); return; }
    Args a{};
    for (int i = 0; i < 27; ++i) a.in[i] = (const float*)d_in[i];
    a.out = (float*)d_out; a.ws = (unsigned char*)d_ws;
#ifndef MK_CUTS
#define MK_CUTS {0, N_PHASES}
#endif
    const int cuts[] = MK_CUTS;
    const int nl = (int)(sizeof(cuts) / sizeof(int)) - 1;
    for (int li = 0; li < nl; ++li) {
        a.ph_lo = cuts[li]; a.ph_hi = cuts[li + 1]; a.li = li;
        hipLaunchKernelGGL(mk_fwd, dim3(grid), dim3(NWAVES * 64), LDS_BYTES, stream, a);
        const hipError_t le = hipPeekAtLastError();
        if (le != hipSuccess) { fprintf(stderr, "kernel_launch: launch %d failed: %s\n", li, hipGetErrorName(le)); break; }
    }
}
```

```cpp
#include <hip/hip_runtime.h>
#include <cstdio>
#include <cstdint>
#include <cmath>
namespace pg8 {
#define PG8_LAS __attribute__((address_space(3)))
typedef unsigned short bf16_t;
typedef short bf16x8 __attribute__((ext_vector_type(8)));
typedef float f32x4 __attribute__((ext_vector_type(4)));
typedef unsigned u32x4 __attribute__((ext_vector_type(4)));
constexpr int BM = 256, BK = 64, HALF = 128, HTB = HALF * BK * 2  , STAGE_BYTES = 8 * HTB, NXCD = 8, WGM = 8;

__host__ __device__ __forceinline__ int lds_byte(int r, int c) { const int st = (r >> 4) * 2 + (c >> 5), rr = r & 15, cc = c & 31, ob = rr * 64 + cc * 2; return st * 1024 + (ob ^ (((ob >> 9) & 1) << 5)); }
__host__ __device__ __forceinline__ void stage_rc(int b, int& R, int& C) { const int st = b / 1024, sb = b % 1024, swz = sb ^ (((sb >> 9) & 1) << 5); R = (st >> 1) * 16 + swz / 64; C = (st & 1) * 32 + (swz % 64) / 2; }
__host__ __device__ __forceinline__ int perm32(int rho) { const int n = rho >> 4, i = rho & 15; return 8 * (i >> 2) + 4 * n + (i & 3); }

struct Unit { int pm, pn; };
struct Gemm { const bf16_t* A; const bf16_t* Bt; int M, N, K; };

struct StaticOrder {
    int nM, nN, nwg, G, c;
    __host__ __device__ void init(int M, int N, int G_, int c_) { nM = M / BM; nN = N / BM; nwg = nM * nN; G = G_; c = c_; }
    __host__ __device__ bool next(int i, Unit& u) const {
        const long L = (long)i * G + c; if (L >= nwg) return false;
        int wgid = (int)L; { const int q = nwg / NXCD, r = nwg % NXCD, xcd = wgid % NXCD, off = wgid / NXCD; wgid = (xcd < r ? xcd * (q + 1) : r * (q + 1) + (xcd - r) * q) + off; }
        const int nig = WGM * nN, gid = wgid / nig, fm = gid * WGM, gsz = (nM - fm) < WGM ? (nM - fm) : WGM;
        u.pm = fm + ((wgid % nig) % gsz); u.pn = (wgid % nig) / gsz; return true;
    }
    __device__ __forceinline__ void a_ready(const Unit&) const {}
    __device__ __forceinline__ void done(const Unit&) const {}
};

__device__ __forceinline__ unsigned cvt_pk_bf16(float lo, float hi) { unsigned r; asm volatile("v_cvt_pk_bf16_f32 %0, %1, %2" : "=v"(r) : "v"(lo), "v"(hi)); return r; }
typedef float f32x2 __attribute__((ext_vector_type(2)));
__device__ __forceinline__ f32x2 gelu_pk(f32x2 v) {
    const f32x2 av = __builtin_elementwise_abs(v), d = av * 0.2316418882f + 1.0f;
    f32x2 t; t.x = __builtin_amdgcn_rcpf(d.x); t.y = __builtin_amdgcn_rcpf(d.y);
    f32x2 q = t * 0.5307027145f + (-0.7265760135f); q = q * t + 0.7107068705f; q = q * t + (-0.142248368f); q = q * t + 0.127414796f; q = q * t;
    const f32x2 s = (v * v) * (-0.72134752044f);
    f32x2 e; e.x = __builtin_amdgcn_exp2f(s.x); e.y = __builtin_amdgcn_exp2f(s.y);
    const f32x2 m = v * (q * e), r = v - m;
    f32x2 o; o.x = v.x < 0.f ? m.x : r.x; o.y = v.y < 0.f ? m.y : r.y; return o;
}

template <int ACT  > struct EpiBf16 {
    static constexpr bool PERM = true, AFTER_DRAIN = false; static_assert(ACT == 0 || ACT == 1, "EpiBf16: ACT is 0 (none) or 1 (gelu_pk)");
    bf16_t* O; int ldc; const float* bias; int split_cols; size_t split_stride; float scale0;
    __device__ __forceinline__ void operator()(const f32x4 (&acc)[2][2][4][2], const Unit& u, int wr, int wc, int fr, int fq) const {
        const int row0 = u.pm * BM + wr * 64 + fr; int colt = u.pn * BM; bf16_t* base = O;
        float sc = 1.f; if (split_cols) { const int t = colt / split_cols; base += (size_t)t * split_stride; colt -= t * split_cols; if (t == 0) sc = scale0; }
        const int col0 = colt + wc * 32 + 8 * fq, bcol0 = u.pn * BM + wc * 32 + 8 * fq;
        f32x4 bv[2][2];
#pragma unroll
        for (int bj = 0; bj < 2; ++bj)
#pragma unroll
            for (int n = 0; n < 2; ++n) bv[bj][n] = bias ? *(const f32x4*)(bias + bcol0 + bj * HALF + 4 * n) : (f32x4){0.f, 0.f, 0.f, 0.f};
#pragma unroll
        for (int ai = 0; ai < 2; ++ai)
#pragma unroll
            for (int m = 0; m < 4; ++m) { bf16_t* rowp = base + (size_t)(row0 + ai * HALF + m * 16) * ldc + col0;
#pragma unroll
                for (int bj = 0; bj < 2; ++bj) { f32x4 v0 = acc[ai][bj][m][0] + bv[bj][0], v1 = acc[ai][bj][m][1] + bv[bj][1];
                    if (ACT == 1) { f32x2 a = gelu_pk((f32x2){v0[0], v0[1]}), b = gelu_pk((f32x2){v0[2], v0[3]}), c = gelu_pk((f32x2){v1[0], v1[1]}), d = gelu_pk((f32x2){v1[2], v1[3]});
                        v0 = (f32x4){a.x, a.y, b.x, b.y}; v1 = (f32x4){c.x, c.y, d.x, d.y}; }
                    v0 = v0 * sc; v1 = v1 * sc; u32x4 w; w.x = cvt_pk_bf16(v0[0], v0[1]); w.y = cvt_pk_bf16(v0[2], v0[3]); w.z = cvt_pk_bf16(v1[0], v1[1]); w.w = cvt_pk_bf16(v1[2], v1[3]);
                    *(u32x4*)(rowp + bj * HALF) = w; } }
    }
};

template <class Epi, class Sched, bool ALIGN_EPI = false, bool SP2 = false>
__device__ __forceinline__ void gemm_phase(PG8_LAS unsigned char* lds, const Gemm g, const Sched& S, const Epi& E) {
    const int tid = threadIdx.x, wid = __builtin_amdgcn_readfirstlane(tid >> 6), lane = tid & 63, wr = wid >> 2, wc = wid & 3, fr = lane & 15, fq = lane >> 4;
    const int K = g.K, nt = K / BK;
    unsigned voffA[2], voffB[2];
#pragma unroll
    for (int i = 0; i < 2; ++i) { int R, C; stage_rc(tid * 16 + i * 8192, R, C); const int Rb = Epi::PERM ? ((R & ~31) + perm32(R & 31)) : R;
        voffA[i] = (unsigned)(R * K + C) * 2u; voffB[i] = (unsigned)(Rb * K + C) * 2u; }
    const size_t kstep = (size_t)(BK * 2);
    const size_t hstep = (size_t)HALF * K * 2;
    const size_t tstep = 2 * hstep;
    const unsigned ldsw = (unsigned)wid * 1024u;
    const int aoff = lds_byte(wr * 64 + fr, fq * 8), boff = lds_byte(wc * 32 + fr, fq * 8);
#define PG8_SA(b, h) (((b) * 2 + (h)) * HTB)
#define PG8_SB(b, h) ((4 + (b) * 2 + (h)) * HTB)
#define PG8_STAGE(bufoff, gbase, voff) do { _Pragma("unroll") for (int _i = 0; _i < 2; ++_i) \
        __builtin_amdgcn_global_load_lds((const unsigned*)((const char*)(gbase) + (voff)[_i]), (PG8_LAS unsigned*)(lds + (bufoff) + ldsw + _i * 8192), 16, 0, 0); } while (0)
#define PG8_LDA(dst, b, h) do { _Pragma("unroll") for (int m = 0; m < 4; ++m) _Pragma("unroll") for (int k = 0; k < 2; ++k) dst[m][k] = *(const PG8_LAS bf16x8*)(lds + PG8_SA(b, h) + aoff + m * 2048 + k * 1024); } while (0)
#define PG8_LDB(dst, b, h) do { _Pragma("unroll") for (int n = 0; n < 2; ++n) _Pragma("unroll") for (int k = 0; k < 2; ++k) dst[n][k] = *(const PG8_LAS bf16x8*)(lds + PG8_SB(b, h) + boff + n * 2048 + k * 1024); } while (0)
#define PG8_MMA(ai, bj, At, Bt) do { __builtin_amdgcn_s_setprio(1); _Pragma("unroll") for (int m = 0; m < 4; ++m) _Pragma("unroll") for (int n = 0; n < 2; ++n) _Pragma("unroll") for (int k = 0; k < 2; ++k) \
        acc[ai][bj][m][n] = __builtin_amdgcn_mfma_f32_16x16x32_bf16(Bt[n][k], At[m][k], acc[ai][bj][m][n], 0, 0, 0); __builtin_amdgcn_s_setprio(0); } while (0)
#define PG8_WAIT_V(n) asm volatile("s_waitcnt vmcnt(" #n ")" ::: "memory")
#define PG8_WAIT_L(n) asm volatile("s_waitcnt lgkmcnt(" #n ")" ::: "memory")
#define PG8_BAR __builtin_amdgcn_s_barrier()
#define PG8_SCHED __builtin_amdgcn_sched_barrier(0)
    Unit cur, nxt; int ui = 0;
    if (!S.next(0, cur)) return;
    f32x4 acc[2][2][4][2];
#pragma unroll
    for (int a = 0; a < 2; ++a)
#pragma unroll
        for (int b = 0; b < 2; ++b)
#pragma unroll
            for (int m = 0; m < 4; ++m)
#pragma unroll
                for (int n = 0; n < 2; ++n) acc[a][b][m][n] = (f32x4){0.f, 0.f, 0.f, 0.f};
    bf16x8 At[4][2], B0[2][2], B1[2][2];
    const char* cA = (const char*)g.A + (size_t)cur.pm * tstep; const char* cB = (const char*)g.Bt + (size_t)cur.pn * tstep;
    S.a_ready(cur);
    if constexpr (SP2) {
        PG8_STAGE(PG8_SB(0, 0), cB, voffB); PG8_STAGE(PG8_SB(0, 1), cB + hstep, voffB); PG8_STAGE(PG8_SA(0, 0), cA, voffA); PG8_STAGE(PG8_SA(0, 1), cA + hstep, voffA);
        if (wr == 1) PG8_BAR;
        PG8_WAIT_V(2); PG8_BAR;
        PG8_STAGE(PG8_SB(1, 0), cB + kstep, voffB); PG8_STAGE(PG8_SA(1, 0), cA + kstep, voffA); PG8_STAGE(PG8_SB(1, 1), cB + hstep + kstep, voffB);
        PG8_WAIT_V(6); PG8_BAR;
    } else {
        PG8_STAGE(PG8_SB(0, 0), cB, voffB); PG8_STAGE(PG8_SA(0, 0), cA, voffA); PG8_STAGE(PG8_SB(0, 1), cB + hstep, voffB); PG8_STAGE(PG8_SA(0, 1), cA + hstep, voffA);
        if (wr == 1) PG8_BAR;
        PG8_WAIT_V(4); PG8_BAR;
        PG8_STAGE(PG8_SB(1, 0), cB + kstep, voffB); PG8_STAGE(PG8_SA(1, 0), cA + kstep, voffA); PG8_STAGE(PG8_SB(1, 1), cB + hstep + kstep, voffB);
        PG8_WAIT_V(6); PG8_BAR;
    }
    for (;;) {
        const bool has_next = S.next(ui + 1, nxt);
        const char* nA = has_next ? (const char*)g.A + (size_t)nxt.pm * tstep : cA; const char* nB = has_next ? (const char*)g.Bt + (size_t)nxt.pn * tstep : cB;
        for (int t = 0; t < nt; t += 2) {
            const bool last = (t == nt - 2);
            const char* a1 = cA + (size_t)(t + 1) * kstep;
            const char* a2 = last ? nA : cA + (size_t)(t + 2) * kstep; const char* b2 = last ? nB : cB + (size_t)(t + 2) * kstep;
            const char* a3 = a2 + kstep; const char* b3 = b2 + kstep;
            if (last && has_next) S.a_ready(nxt);
            if constexpr (SP2) {
            PG8_LDB(B0, 0, 0); PG8_LDB(B1, 0, 1); PG8_SCHED; PG8_LDA(At, 0, 0); PG8_STAGE(PG8_SA(1, 1), a1 + hstep, voffA);
            PG8_WAIT_V(8); PG8_WAIT_L(0); PG8_BAR; PG8_MMA(0, 0, At, B0); PG8_MMA(0, 1, At, B1); PG8_BAR; PG8_SCHED;
            PG8_LDA(At, 0, 1); PG8_STAGE(PG8_SB(0, 0), b2, voffB); PG8_STAGE(PG8_SB(0, 1), b2 + hstep, voffB); PG8_STAGE(PG8_SA(0, 0), a2, voffA);
            PG8_WAIT_V(8); PG8_WAIT_L(0); PG8_BAR; PG8_MMA(1, 0, At, B0); PG8_MMA(1, 1, At, B1); PG8_BAR; PG8_SCHED;
            PG8_LDB(B0, 1, 0); PG8_LDB(B1, 1, 1); PG8_SCHED; PG8_LDA(At, 1, 0); PG8_STAGE(PG8_SA(0, 1), a2 + hstep, voffA);
            PG8_WAIT_V(8); PG8_WAIT_L(0); PG8_BAR; PG8_MMA(0, 0, At, B0); PG8_MMA(0, 1, At, B1); PG8_BAR; PG8_SCHED;
            PG8_LDA(At, 1, 1); PG8_STAGE(PG8_SB(1, 0), b3, voffB); PG8_STAGE(PG8_SB(1, 1), b3 + hstep, voffB); PG8_STAGE(PG8_SA(1, 0), a3, voffA);
            PG8_WAIT_V(8); PG8_WAIT_L(0); PG8_BAR; PG8_MMA(1, 0, At, B0); PG8_MMA(1, 1, At, B1); PG8_BAR; PG8_SCHED;
            } else {
            PG8_LDB(B0, 0, 0); PG8_SCHED; PG8_LDA(At, 0, 0); PG8_STAGE(PG8_SA(1, 1), a1 + hstep, voffA);
            PG8_WAIT_L(8); PG8_BAR; PG8_WAIT_L(0); PG8_MMA(0, 0, At, B0); PG8_BAR; PG8_SCHED;
            PG8_LDB(B1, 0, 1); PG8_STAGE(PG8_SB(0, 0), b2, voffB);
            PG8_BAR; PG8_WAIT_L(0); PG8_MMA(0, 1, At, B1); PG8_BAR;
            PG8_LDA(At, 0, 1); PG8_STAGE(PG8_SA(0, 0), a2, voffA);
            PG8_BAR; PG8_WAIT_L(0); PG8_MMA(1, 0, At, B0); PG8_BAR; PG8_SCHED;
            PG8_STAGE(PG8_SB(0, 1), b2 + hstep, voffB);
            PG8_WAIT_V(6); PG8_BAR; PG8_MMA(1, 1, At, B1); PG8_BAR;
            PG8_LDB(B0, 1, 0); PG8_SCHED; PG8_LDA(At, 1, 0); PG8_STAGE(PG8_SA(0, 1), a2 + hstep, voffA);
            PG8_WAIT_L(8); PG8_BAR; PG8_WAIT_L(0); PG8_MMA(0, 0, At, B0); PG8_BAR; PG8_SCHED;
            PG8_LDB(B1, 1, 1); PG8_STAGE(PG8_SB(1, 0), b3, voffB);
            PG8_BAR; PG8_WAIT_L(0); PG8_MMA(0, 1, At, B1); PG8_BAR;
            PG8_LDA(At, 1, 1); PG8_STAGE(PG8_SA(1, 0), a3, voffA);
            PG8_BAR; PG8_WAIT_L(0); PG8_MMA(1, 0, At, B0); PG8_BAR; PG8_SCHED;
            PG8_STAGE(PG8_SB(1, 1), b3 + hstep, voffB);
            PG8_WAIT_V(6); PG8_BAR; PG8_MMA(1, 1, At, B1); PG8_BAR;
            }
        }
        if constexpr (ALIGN_EPI) { if (wr == 0) PG8_BAR; }
        if constexpr (!Epi::AFTER_DRAIN) { E(acc, cur, wr, wc, fr, fq); S.done(cur); }
        if (!has_next) break;
#pragma unroll
        for (int a = 0; a < 2; ++a)
#pragma unroll
            for (int b = 0; b < 2; ++b)
#pragma unroll
                for (int m = 0; m < 4; ++m)
#pragma unroll
                    for (int n = 0; n < 2; ++n) acc[a][b][m][n] = (f32x4){0.f, 0.f, 0.f, 0.f};
        cur = nxt; cA = nA; cB = nB; ++ui;
        if constexpr (ALIGN_EPI) { if (wr == 1) PG8_BAR; }
    }
    PG8_WAIT_V(0);
    if constexpr (!ALIGN_EPI) { if (wr == 0) PG8_BAR; }
    PG8_BAR;
    if constexpr (Epi::AFTER_DRAIN) { E.fused(acc, cur, wr, wc, fr, fq, lds, wid, lane); S.done(cur); }
#undef PG8_SA
#undef PG8_SB
#undef PG8_STAGE
#undef PG8_LDA
#undef PG8_LDB
#undef PG8_MMA
#undef PG8_WAIT_V
#undef PG8_WAIT_L
#undef PG8_BAR
#undef PG8_SCHED
}
}
#define GAS __attribute__((address_space(1)))
#define LAS __attribute__((address_space(3)))
typedef unsigned short bf16;
typedef unsigned v4u __attribute__((ext_vector_type(4)));
typedef float f32x4 __attribute__((ext_vector_type(4)));
typedef short bf16x8 __attribute__((ext_vector_type(8)));
typedef GAS unsigned gu32;
typedef GAS unsigned long long gu64;
#define RLX_AGENT __ATOMIC_RELAXED, __HIP_MEMORY_SCOPE_AGENT
#define LDS_WAIT() asm volatile("s_waitcnt lgkmcnt(0)" ::: "memory")
#define VM_WAIT() asm volatile("s_waitcnt vmcnt(0)" ::: "memory")
__device__ __forceinline__ unsigned long long rt() { return __builtin_amdgcn_s_memrealtime(); }
__device__ __forceinline__ unsigned f2bf(float f) { unsigned u = __builtin_bit_cast(unsigned, f); return (u + 0x7fffu + ((u >> 16) & 1u)) >> 16; }
__device__ __forceinline__ unsigned pk2(float lo, float hi) { return f2bf(lo) | (f2bf(hi) << 16); }

#define XB_TMO      128
#define XB_XCNT(j)  (256  + 64 * (j))
#define XB_XSUB(j)  (1280 + 64 * (j))
#define XB_XGEN(j)  (2304 + 64 * (j))
#define XB_TOP      3328
#define XB_TOPGEN   3392
#define XCD_BAR_WORDS 3456
#define XB_SPIN_CAP (1u << 18)

__device__ __forceinline__ unsigned xb_ld(unsigned* p)              { return __hip_atomic_load(p, __ATOMIC_RELAXED, __HIP_MEMORY_SCOPE_AGENT); }
__device__ __forceinline__ unsigned xb_add(unsigned* p, unsigned v) { return __hip_atomic_fetch_add(p, v, __ATOMIC_RELAXED, __HIP_MEMORY_SCOPE_AGENT); }
__device__ __forceinline__ unsigned xb_xcc_id() { return (unsigned)__builtin_amdgcn_s_getreg((3 << 11) | 20) & 0xFu; }
#define XB_SPIN(cond, bar) do { unsigned _sp = 0; while (cond) { __builtin_amdgcn_s_sleep(1); \
    if ((++_sp & 255u) == 0u) { if (xb_ld(&(bar)[XB_TMO])) break; if (_sp > XB_SPIN_CAP) { atomicAdd(&(bar)[XB_TMO], 1u); break; } } } } while (0)

struct XcdBarrier {
    unsigned* bar; unsigned x;
    volatile LAS unsigned* st;
};

__device__ __forceinline__ XcdBarrier xcd_barrier_post(unsigned* bar, volatile LAS unsigned* st) {
    XcdBarrier b; b.bar = bar; b.x = xb_xcc_id(); b.st = st;
    if (threadIdx.x == 0) (void)xb_add(&bar[XB_XCNT(b.x)], 1u);
    return b;
}
__device__ __forceinline__ void xcd_barrier_complete(unsigned* bar, unsigned x, unsigned& nloc, unsigned& nx) {
    const unsigned G = gridDim.x * gridDim.y * gridDim.z;
    unsigned sum, cnt, mine, sp = 0u;
    for (;;) {
        sum = 0u; cnt = 0u; mine = 0u;
#pragma unroll
        for (unsigned j = 0; j < 16; ++j) { const unsigned c = xb_ld(&bar[XB_XCNT(j)]); sum += c; cnt += (c > 0u) ? 1u : 0u; mine = (j == x) ? c : mine; }
        if (sum == G) break;
        __builtin_amdgcn_s_sleep(1);
        if ((++sp & 255u) == 0u) { if (xb_ld(&bar[XB_TMO])) break; if (sp > XB_SPIN_CAP) { atomicAdd(&bar[XB_TMO], 1u); break; } }
    }
    nloc = mine > 0u ? mine : 1u; nx = cnt > 0u ? cnt : 1u;
}

__device__ __forceinline__ void xcd_barrier(const XcdBarrier& b) {
    asm volatile("s_waitcnt vmcnt(0)" ::: "memory");
    __syncthreads();
    if (threadIdx.x == 0) {
        unsigned* bar = b.bar;
        __builtin_amdgcn_s_waitcnt(0);
        unsigned nloc = b.st[0], nx = b.st[1];
        if (nloc == 0u) { xcd_barrier_complete(bar, b.x, nloc, nx); b.st[0] = nloc; b.st[1] = nx; }
        const unsigned old = xb_add(&bar[XB_XSUB(b.x)], 1u);
        const unsigned gen = old / nloc;
        if (old + 1u == (gen + 1u) * nloc) {
            __builtin_amdgcn_fence(__ATOMIC_RELEASE, "agent");
            asm volatile("s_waitcnt vmcnt(0)" ::: "memory");
            const unsigned og = xb_add(&bar[XB_TOP], 1u);
            const unsigned tg = og / nx;
            if (og + 1u == (tg + 1u) * nx) xb_add(&bar[XB_TOPGEN], 1u);
            else XB_SPIN(xb_ld(&bar[XB_TOPGEN]) == tg, bar);
            __builtin_amdgcn_fence(__ATOMIC_ACQUIRE, "agent");
            xb_add(&bar[XB_XGEN(b.x)], 1u);
            asm volatile("s_waitcnt vmcnt(0)" ::: "memory");
        } else {
            XB_SPIN(xb_ld(&bar[XB_XGEN(b.x)]) == gen, bar);
            __builtin_amdgcn_fence(__ATOMIC_ACQUIRE, "agent");
            asm volatile("s_waitcnt vmcnt(0)" ::: "memory");
        }
    }
    __syncthreads();
}
constexpr int NWAVES = 8;
constexpr int D = 1024, BATCH = 8, SEQ = 2048, T = BATCH * SEQ;
constexpr int AW = 512, RW = 512, NH = 8;
constexpr int DL = 64, AL = 64, GL = 128;
constexpr int SHIFTW = 3 * RW + DL + AL + GL;
constexpr int INW = 3 * AW + SHIFTW;
constexpr int NKEYS = 128, PH = 8, PKD = 256, TOPK = 16, HK = PH * TOPK;
constexpr int QW = PH * PKD;
constexpr int MODW = 6 * D;

constexpr size_t MiB = 1u << 20;
constexpr size_t WS_CTL = 0, CTL_ZERO_BYTES = 1 * MiB;
constexpr size_t WS_MOD = 1 * MiB;
constexpr size_t WS_KEYS = 1 * MiB + 512 * 1024;
constexpr size_t WS_WIN = 2 * MiB;
constexpr size_t WS_WOUT = 9 * MiB;
constexpr size_t WS_WQ = 11 * MiB;
constexpr size_t WS_XN = 16 * MiB;
constexpr size_t WS_Z = 48 * MiB;
constexpr size_t WS_MIX = 152 * MiB;
constexpr size_t WS_Y = 184 * MiB;
constexpr size_t WS_Q = 48 * MiB;
constexpr size_t WS_IDX = 112 * MiB;
constexpr size_t WS_GATE = 120 * MiB;
constexpr size_t WS_BON = 248 * MiB;
constexpr size_t WS_END = 249 * MiB;
constexpr int CW_BAR = 4096;
constexpr int MAX_LAUNCHES = 12;

constexpr int RING_OFF = 0, RING_BYTES = 131072;
constexpr int LDSCTL_OFF = RING_BYTES, MISC_OFF = LDSCTL_OFF + 320;
constexpr int LDS_BYTES = 147456;

typedef GAS float gf32;
typedef GAS f32x4 gf32x4;

__device__ __forceinline__ float bf2f(bf16 v) { return __uint_as_float(((unsigned)v) << 16); }
__device__ __forceinline__ float wave_sum(float v) {
#pragma unroll
    for (int o = 1; o < 64; o <<= 1) v += __shfl_xor(v, o);
    return v;
}
#define WAVE_LDS_SYNC() do { asm volatile("s_waitcnt lgkmcnt(0)" ::: "memory"); __builtin_amdgcn_wave_barrier(); } while (0)

__device__ __forceinline__ void p0_transpose_item(const float* W, int K, int N, bf16* WT, int row_off, LAS float* scr, int item, int lane) {
    const int nblk = N / 32, kb = item / nblk, nb = item % nblk, k0 = 64 * kb, n0 = 32 * nb;
#pragma unroll 8
    for (int i = 0; i < 32; ++i) { const int kk = 2 * i + (lane >> 5); scr[kk * 33 + (lane & 31)] = W[(size_t)(k0 + kk) * N + n0 + (lane & 31)]; }
    LDS_WAIT(); asm volatile("" ::: "memory");
    const int c = lane & 7;
#pragma unroll
    for (int j = 0; j < 4; ++j) { const int n = (lane >> 3) + 8 * j; const LAS float* s = scr + (8 * c) * 33 + n;
        v4u o; o.x = pk2(s[0 * 33], s[1 * 33]); o.y = pk2(s[2 * 33], s[3 * 33]); o.z = pk2(s[4 * 33], s[5 * 33]); o.w = pk2(s[6 * 33], s[7 * 33]);
        *(GAS v4u*)(WT + (size_t)(row_off + n0 + n) * K + k0 + 8 * c) = o; }
    LDS_WAIT(); asm volatile("" ::: "memory");
}

__device__ __forceinline__ void norm_row(const float* xrow, const float* g, const float* modb, int shift_off, int scale_off, bf16* orow, int lane) {
    const GAS f32x4* xr = (const GAS f32x4*)xrow + lane;
    f32x4 v[4]; float s = 0.f;
#pragma unroll
    for (int j = 0; j < 4; ++j) { v[j] = xr[64 * j]; s += (v[j].x * v[j].x + v[j].y * v[j].y) + (v[j].z * v[j].z + v[j].w * v[j].w); }
    const float rs = 1.0f / sqrtf(wave_sum(s) * (1.f / D) + 1e-6f);
    GAS unsigned long long* o8 = (GAS unsigned long long*)orow + lane;
#pragma unroll
    for (int j = 0; j < 4; ++j) {
        const int col = 256 * j + 4 * lane;
        const f32x4 g4 = *(const GAS f32x4*)(g + col), sc = *(const GAS f32x4*)(modb + scale_off + col), sh = *(const GAS f32x4*)(modb + shift_off + col);
        const f32x4 y = v[j] * rs * g4 * (sc + 1.0f) + sh;
        o8[64 * j] = (unsigned long long)pk2(y.x, y.y) | ((unsigned long long)pk2(y.z, y.w) << 32);
    }
}

struct EpiRes {
    static constexpr bool PERM = false, AFTER_DRAIN = false;
    const float* xres; const float* mod; int gate_off; float* out; int ldc;
    __device__ __forceinline__ void operator()(const pg8::f32x4 (&acc)[2][2][4][2], const pg8::Unit& u, int wr, int wc, int fr, int fq) const {
        const int col0 = u.pn * pg8::BM + wc * 32 + 4 * fq;
        const int b = (u.pm * pg8::BM) / SEQ;
        pg8::f32x4 gv[2][2];
#pragma unroll
        for (int bj = 0; bj < 2; ++bj)
#pragma unroll
            for (int n = 0; n < 2; ++n) gv[bj][n] = *(const pg8::f32x4*)(mod + b * MODW + gate_off + col0 + bj * pg8::HALF + n * 16);
#pragma unroll
        for (int ai = 0; ai < 2; ++ai)
#pragma unroll
            for (int m = 0; m < 4; ++m) { const size_t off = (size_t)(u.pm * pg8::BM + ai * pg8::HALF + wr * 64 + m * 16 + fr) * ldc + col0;
#pragma unroll
                for (int bj = 0; bj < 2; ++bj)
#pragma unroll
                    for (int n = 0; n < 2; ++n) { const pg8::f32x4 bs = *(const pg8::f32x4*)(xres + off + bj * pg8::HALF + n * 16);
                        *(pg8::f32x4*)(out + off + bj * pg8::HALF + n * 16) = bs + gv[bj][n] * acc[ai][bj][m][n]; } }
    }
};

__device__ __forceinline__ float zshift(const bf16* Z, int tok, int t, int col, const float* mu_prev, const float* mu_next) {
    const bf16* zc = Z + (size_t)tok * INW + 3 * AW + col;
    const float z = bf2f(zc[0]);
    const float zp = (t > 0) ? bf2f(zc[-INW]) : 0.f;
    const float zn = (t < SEQ - 1) ? bf2f(zc[INW]) : 0.f;
    return z + mu_prev[col] * (zp - z) + mu_next[col] * (zn - z);
}
__device__ __forceinline__ float decay_of(float wl) {
    const float nx = -wl; const float sp = (nx > 20.f) ? nx : log1pf(expf(nx));
    return expf(-expf(-sp - 0.5f));
}

__device__ __forceinline__ void attn_naive_item(const bf16* Z, const float* qg, const float* kg, bf16* mix, int gid) {
    asm volatile("" ::: "memory");
    const int h = gid & 7, tok = gid >> 3, b = tok / SEQ, t = tok % SEQ;
    const float slope = exp2f(-(float)(h + 1));
    unsigned qp[32];
    { const unsigned* qs = (const unsigned*)(Z + (size_t)tok * INW + h * 64); float ss = 0.f;
#pragma unroll
      for (int c = 0; c < 32; ++c) { const unsigned w = qs[c]; const float a = __uint_as_float(w << 16), bb = __uint_as_float(w & 0xffff0000u); ss += a * a + bb * bb; }
      const float rs = 0.125f / sqrtf(ss * (1.f / 64.f) + 1e-6f);
#pragma unroll
      for (int c = 0; c < 32; ++c) { const unsigned w = qs[c]; const float a = __uint_as_float(w << 16), bb = __uint_as_float(w & 0xffff0000u);
          qp[c] = pk2(a * rs * qg[2 * c] * kg[2 * c], bb * rs * qg[2 * c + 1] * kg[2 * c + 1]); } }
#pragma unroll 1
    for (int half = 0; half < 2; ++half) {
        float m = -INFINITY, l = 0.f; float acc[32];
#pragma unroll
        for (int c = 0; c < 32; ++c) acc[c] = 0.f;
#pragma unroll 1
        for (int p = 0; p < 3; ++p) {
            const int d = (p == 0) ? 1 : (p == 1 ? 4 : 16);
            const int L = SEQ / d, r = t % d, i = t / d;
#pragma unroll 1
            for (int o = -64; o <= 64; ++o) {
                const int j = i + o; if (j < 0 || j >= L) continue;
                const int tk = j * d + r;
                const unsigned* kp = (const unsigned*)(Z + (size_t)(b * SEQ + tk) * INW + AW + h * 64);
                const unsigned* vp = kp + AW / 2 + half * 16;
                float ss = 0.f, dot = 0.f;
#pragma unroll
                for (int c = 0; c < 32; ++c) { const unsigned w = kp[c]; const float k0 = __uint_as_float(w << 16), k1 = __uint_as_float(w & 0xffff0000u);
                    ss += k0 * k0 + k1 * k1; dot += __uint_as_float(qp[c] << 16) * k0 + __uint_as_float(qp[c] & 0xffff0000u) * k1; }
                const float s = dot * (1.0f / sqrtf(ss * (1.f / 64.f) + 1e-6f)) - slope * (float)(d * (o < 0 ? -o : o));
                const float mn = fmaxf(m, s), al = expf(m - mn), pe = expf(s - mn);
                l = l * al + pe; m = mn;
#pragma unroll
                for (int c = 0; c < 16; ++c) { const unsigned w = vp[c]; acc[2 * c] = acc[2 * c] * al + pe * __uint_as_float(w << 16); acc[2 * c + 1] = acc[2 * c + 1] * al + pe * __uint_as_float(w & 0xffff0000u); }
            }
        }
        const float invL = 1.0f / l;
        unsigned* op = (unsigned*)(mix + (size_t)tok * D + h * 64 + half * 32);
#pragma unroll
        for (int c = 0; c < 16; ++c) op[c] = pk2(acc[2 * c] * invL, acc[2 * c + 1] * invL);
    }
}

__device__ __forceinline__ void rwkv_fin_token(const bf16* Z, const float* mu_prev, const float* mu_next, const float* g_up,
                                               const float* Y, const float* BON, const float* k_a, const float* r_k, const float* lnx_g, const float* lnx_b, bf16* mix, int tok, int c, LAS float* zr) {
    const int t = tok % SEQ;
    __syncthreads();
    for (int col = c; col < SHIFTW; col += 512) zr[col] = zshift(Z, tok, t, col, mu_prev, mu_next);
    __syncthreads();
    const size_t o = (size_t)tok * RW + c;
    const float y = Y[o] + Y[(size_t)T * RW + o];
    const float mean = wave_sum(y) * (1.f / 64.f);
    const float var = wave_sum((y - mean) * (y - mean)) * (1.f / 64.f);
    const float yn = (y - mean) * (1.0f / sqrtf(var + 64e-5f)) * lnx_g[c] + lnx_b[c];
    float g = 0.f;
#pragma unroll 4
    for (int j = 0; j < GL; ++j) g += (1.0f / (1.0f + expf(-zr[3 * RW + DL + AL + j]))) * g_up[(size_t)j * RW + c];
    const float r = zr[c], k = zr[RW + c], v = zr[2 * RW + c];
    const float bs = wave_sum(r * k * r_k[c] * (1.0f - k_a[c])) + 0.5f * (BON[(size_t)tok * NH + (c >> 6)] + BON[((size_t)T + tok) * NH + (c >> 6)]);
    mix[(size_t)tok * D + AW + c] = (bf16)f2bf((yn + bs * v) * g);
}

__device__ __forceinline__ void wave_argmax(float& v, int& i) {
#pragma unroll
    for (int m = 1; m < 64; m <<= 1) { const float ov = __shfl_xor(v, m); const int oi = __shfl_xor(i, m); if (ov > v || (ov == v && oi < i)) { v = ov; i = oi; } }
}

__device__ __forceinline__ void peer_select_item(const bf16* Q, const float* keys1, const float* keys2, int* IDX, float* GATE, int th, int lane) {
    const bf16* qp = Q + (size_t)th * PKD;
    float s1a = 0.f, s1b = 0.f, s2a = 0.f, s2b = 0.f;
    for (int d = 0; d < 128; ++d) {
        const float q1 = bf2f(qp[d]), q2 = bf2f(qp[128 + d]);
        s1a += q1 * keys1[lane * 128 + d]; s1b += q1 * keys1[(lane + 64) * 128 + d];
        s2a += q2 * keys2[lane * 128 + d]; s2b += q2 * keys2[(lane + 64) * 128 + d];
    }
    float v1 = 0.f, v2 = 0.f; int i1 = 0, i2 = 0;
    for (int k = 0; k < TOPK; ++k) {
        float bv = s1a; int bi = lane; if (s1b > bv) { bv = s1b; bi = lane + 64; }
        wave_argmax(bv, bi);
        if (lane == k) { v1 = bv; i1 = bi; }
        if (bi == lane) s1a = -INFINITY; if (bi == lane + 64) s1b = -INFINITY;
    }
    for (int k = 0; k < TOPK; ++k) {
        float bv = s2a; int bi = lane; if (s2b > bv) { bv = s2b; bi = lane + 64; }
        wave_argmax(bv, bi);
        if (lane == k) { v2 = bv; i2 = bi; }
        if (bi == lane) s2a = -INFINITY; if (bi == lane + 64) s2b = -INFINITY;
    }
    const float va = __shfl(v1, lane >> 2);
    float c0 = va + __shfl(v2, (lane & 3) * 4 + 0), c1 = va + __shfl(v2, (lane & 3) * 4 + 1), c2 = va + __shfl(v2, (lane & 3) * 4 + 2), c3 = va + __shfl(v2, (lane & 3) * 4 + 3);
    float ts = 0.f; int tp = 0;
    for (int k = 0; k < TOPK; ++k) {
        float bv = c0; int bi = lane * 4;
        if (c1 > bv) { bv = c1; bi = lane * 4 + 1; } if (c2 > bv) { bv = c2; bi = lane * 4 + 2; } if (c3 > bv) { bv = c3; bi = lane * 4 + 3; }
        wave_argmax(bv, bi);
        if (lane == k) { ts = bv; tp = bi; }
        if (bi == lane * 4) c0 = -INFINITY; if (bi == lane * 4 + 1) c1 = -INFINITY; if (bi == lane * 4 + 2) c2 = -INFINITY; if (bi == lane * 4 + 3) c3 = -INFINITY;
    }
    const int e1 = __shfl(i1, tp >> 4), e2 = __shfl(i2, tp & 15);
    const float mx = __shfl(ts, 0);
    const float ex = (lane < 16) ? expf(ts - mx) : 0.f;
    float sum = ex;
#pragma unroll
    for (int m = 1; m < 16; m <<= 1) sum += __shfl_xor(sum, m);
    if (lane < 16) { IDX[(size_t)th * TOPK + lane] = e1 * NKEYS + e2; GATE[(size_t)th * TOPK + lane] = ex / sum; }
}

__device__ __forceinline__ void peer_ffn_token(const bf16* XN, const int* IDX, const float* GATE, const float* U, const float* Vt, const float* mod, float* out, int tok, int lane) {
    const int b = tok / SEQ;
    float x[16], y[16];
#pragma unroll
    for (int j = 0; j < 4; ++j)
#pragma unroll
        for (int e = 0; e < 4; ++e) { x[j * 4 + e] = bf2f(XN[(size_t)tok * D + 256 * j + lane * 4 + e]); y[j * 4 + e] = 0.f; }
    for (int k = 0; k < HK; ++k) {
        const int ex = IDX[(size_t)tok * HK + k]; const float gt = GATE[(size_t)tok * HK + k];
        const float* up = U + (size_t)ex * D + lane * 4; const float* vp = Vt + (size_t)ex * D + lane * 4;
        float dot = 0.f;
#pragma unroll
        for (int j = 0; j < 4; ++j) { const f32x4 u4 = *(const f32x4*)(up + 256 * j); dot += x[j * 4] * u4.x + x[j * 4 + 1] * u4.y + x[j * 4 + 2] * u4.z + x[j * 4 + 3] * u4.w; }
        dot = wave_sum(dot);
        const float act = 0.5f * dot * (1.0f + erff(dot * 0.70710678118654752f));
        const float cf = gt * act;
#pragma unroll
        for (int j = 0; j < 4; ++j) { const f32x4 v4 = *(const f32x4*)(vp + 256 * j); y[j * 4] += cf * v4.x; y[j * 4 + 1] += cf * v4.y; y[j * 4 + 2] += cf * v4.z; y[j * 4 + 3] += cf * v4.w; }
    }
#pragma unroll
    for (int j = 0; j < 4; ++j) { const int cidx = 256 * j + lane * 4; const size_t o = (size_t)tok * D + cidx;
        const f32x4 g2 = *(const f32x4*)(mod + b * MODW + 5 * D + cidx); f32x4 ov = *(const f32x4*)(out + o);
        ov.x += g2.x * y[j * 4]; ov.y += g2.y * y[j * 4 + 1]; ov.z += g2.z * y[j * 4 + 2]; ov.w += g2.w * y[j * 4 + 3];
        *(f32x4*)(out + o) = ov; }
}

namespace scan {
typedef unsigned u32x2 __attribute__((ext_vector_type(2)));
constexpr int SLOT = 1024, BUF_BYTES = 12800, NBUF = 8;
constexpr int OFF_LORA = NBUF * BUF_BYTES;
constexpr int OFF_CONST = OFF_LORA + 16 * SLOT;
constexpr int OFF_MT = OFF_CONST + 4096;
constexpr int SCAN_LDS = OFF_MT + 4 * 1024;
static_assert(SCAN_LDS <= 131072, "scan LDS map");
constexpr int S_KK = 0, S_R = 2, S_MT = 4, S_N = 5, S_BK = 6, S_V = 10, S_GC = 12;

typedef float f32x2n __attribute__((ext_vector_type(2)));
typedef __bf16 bf16x2n __attribute__((ext_vector_type(2)));
__device__ __forceinline__ unsigned cvtpk(float lo, float hi) { const f32x2n v = {lo, hi}; const bf16x2n b = __builtin_convertvector(v, bf16x2n); return __builtin_bit_cast(unsigned, b); }
__device__ __forceinline__ bf16x8 mkfrag(unsigned a, unsigned b, unsigned c, unsigned d) { v4u w; w.x = a; w.y = b; w.z = c; w.w = d; return __builtin_bit_cast(bf16x8, w); }
__device__ __forceinline__ bf16x8 frag8(const float (&lo)[4], const float (&hi)[4]) { return mkfrag(cvtpk(lo[0], lo[1]), cvtpk(lo[2], lo[3]), cvtpk(hi[0], hi[1]), cvtpk(hi[2], hi[3])); }
__device__ __forceinline__ f32x4 mma(bf16x8 a, bf16x8 b, f32x4 c) { return __builtin_amdgcn_mfma_f32_16x16x32_bf16(a, b, c, 0, 0, 0); }
template <int N> __device__ __forceinline__ float row_shr(float x) { return __int_as_float(__builtin_amdgcn_update_dpp(0, __float_as_int(x), 0x110 + N, 0xf, 0xf, true)); }
__device__ __forceinline__ float fsigmoid(float x) { return 1.0f / (1.0f + __expf(-x)); }

__device__ __forceinline__ void setup(LAS unsigned char* L, int h, int dir, const float* mu_prev, const float* mu_next, const float* w_decay0, const float* w_decay_up,
                                      const float* a_gate0, const float* a_gate_up, const float* k_k, const float* k_a, const float* r_k, int tid) {
    LAS float* C = (LAS float*)(L + OFF_CONST);
    for (int i = tid; i < 320; i += 512) {
        const int grp = i >> 6, c = i & 63;
        const int col = (grp < 3) ? grp * RW + h * 64 + c : 3 * RW + (grp - 3) * 64 + c;
        C[i] = mu_prev[col]; C[320 + i] = mu_next[col];
    }
    if (tid < 64) { const int hc = h * 64 + tid; C[640 + tid] = w_decay0[dir * RW + hc]; C[704 + tid] = a_gate0[dir * RW + hc]; C[768 + tid] = k_k[hc]; C[832 + tid] = k_a[hc]; C[896 + tid] = r_k[hc]; }
    LAS bf16* F = (LAS bf16*)(L + OFF_LORA);
    for (int i = tid; i < 16 * 64 * 8; i += 512) {
        const int j = i & 7, l = (i >> 3) & 63, sl = i >> 9, m = sl & 1, ct = (sl >> 1) & 3, wa = sl >> 3;
        const int g = l >> 4, jj = 32 * m + (j < 4 ? 4 * g + j : 16 + 4 * g + j - 4), c = h * 64 + 16 * ct + (l & 15);
        const float v = wa ? a_gate_up[(size_t)(dir * AL + jj) * RW + c] : w_decay_up[(size_t)(dir * DL + jj) * RW + c];
        F[i] = (bf16)f2bf(v);
    }
}

__device__ __forceinline__ void helper_chunk(LAS unsigned char* L, LAS unsigned char* buf, LAS float* MT, const bf16* Z, float* BON, int b, int h, int dir, int n, int lane) {
    const int s = lane & 15, g = lane >> 4;
    const int cn = dir ? (SEQ / 16 - 1 - n) : n;
    const int t = cn * 16 + (dir ? 15 - s : s), tok = b * SEQ + t;
    const LAS float* C = (const LAS float*)(L + OFF_CONST);
    const bool hasp = t > 0, hasn = t < SEQ - 1;
    const bf16* zrow = Z + (size_t)tok * INW + 3 * AW;
    float rv[4][4], kv[4][4], vv[4][4], tw[4][4], xa[4][4];
#pragma unroll
    for (int grp = 0; grp < 5; ++grp) {
        const int cbase = (grp < 3) ? grp * RW + h * 64 : 3 * RW + (grp - 3) * 64;
#pragma unroll
        for (int ct = 0; ct < 4; ++ct) {
            const bf16* p = zrow + cbase + 16 * ct + 4 * g;
            const u32x2 zc = *(const u32x2*)p;
            u32x2 zp = *(const u32x2*)(hasp ? p - INW : p), zn = *(const u32x2*)(hasn ? p + INW : p);
            if (!hasp) { zp.x = 0u; zp.y = 0u; } if (!hasn) { zn.x = 0u; zn.y = 0u; }
            const f32x4 mp = *(const LAS f32x4*)(C + grp * 64 + 16 * ct + 4 * g), mn = *(const LAS f32x4*)(C + 320 + grp * 64 + 16 * ct + 4 * g);
            float zv[4] = {__uint_as_float(zc.x << 16), __uint_as_float(zc.x & 0xffff0000u), __uint_as_float(zc.y << 16), __uint_as_float(zc.y & 0xffff0000u)};
            float pv[4] = {__uint_as_float(zp.x << 16), __uint_as_float(zp.x & 0xffff0000u), __uint_as_float(zp.y << 16), __uint_as_float(zp.y & 0xffff0000u)};
            float nv[4] = {__uint_as_float(zn.x << 16), __uint_as_float(zn.x & 0xffff0000u), __uint_as_float(zn.y << 16), __uint_as_float(zn.y & 0xffff0000u)};
#pragma unroll
            for (int r = 0; r < 4; ++r) {
                const float o = zv[r] + mp[r] * (pv[r] - zv[r]) + mn[r] * (nv[r] - zv[r]);
                if (grp == 0) rv[ct][r] = o; else if (grp == 1) kv[ct][r] = o; else if (grp == 2) vv[ct][r] = o;
                else if (grp == 3) { const float e2 = __expf(2.0f * o); tw[ct][r] = 1.0f - 2.0f / (e2 + 1.0f); } else xa[ct][r] = o;
            }
        }
    }
#pragma unroll
    for (int ct = 0; ct < 4; ++ct)
#pragma unroll
        for (int r = 0; r < 4; ++r)
            *(LAS bf16*)(buf + (S_V + (ct >> 1)) * SLOT + (4 * g + r + 16 * (s >> 2)) * 16 + (ct & 1) * 8 + 2 * (s & 3)) = (bf16)f2bf(vv[ct][r]);
    f32x4 accw[4], acca[4];
    { const bf16x8 tb0 = frag8(tw[0], tw[1]), tb1 = frag8(tw[2], tw[3]), xb0 = frag8(xa[0], xa[1]), xb1 = frag8(xa[2], xa[3]);
      const LAS bf16x8* F = (const LAS bf16x8*)(L + OFF_LORA);
#pragma unroll
      for (int ct = 0; ct < 4; ++ct) {
          f32x4 z4 = {0.f, 0.f, 0.f, 0.f};
          accw[ct] = mma(F[(0 * 8 + ct * 2 + 0) * 64 + lane], tb0, z4); accw[ct] = mma(F[(0 * 8 + ct * 2 + 1) * 64 + lane], tb1, accw[ct]);
          acca[ct] = mma(F[(1 * 8 + ct * 2 + 0) * 64 + lane], xb0, z4); acca[ct] = mma(F[(1 * 8 + ct * 2 + 1) * 64 + lane], xb1, acca[ct]);
      } }
    float ev[4][4], kk[4][4], kd[4][4], bb[4][4];
    float ss = 0.f, bon = 0.f;
#pragma unroll
    for (int ct = 0; ct < 4; ++ct) {
        const f32x4 w0 = *(const LAS f32x4*)(C + 640 + 16 * ct + 4 * g), a0 = *(const LAS f32x4*)(C + 704 + 16 * ct + 4 * g), kkw = *(const LAS f32x4*)(C + 768 + 16 * ct + 4 * g),
                    kaw = *(const LAS f32x4*)(C + 832 + 16 * ct + 4 * g), rkw = *(const LAS f32x4*)(C + 896 + 16 * ct + 4 * g);
#pragma unroll
        for (int r = 0; r < 4; ++r) {
            ev[ct][r] = 0.60653065971f * fsigmoid(accw[ct][r] + w0[r]);
            const float a = fsigmoid(acca[ct][r] + a0[r]);
            const float k = kv[ct][r];
            kk[ct][r] = k * kkw[r]; ss += kk[ct][r] * kk[ct][r];
            kd[ct][r] = k * (1.0f + (a - 1.0f) * kaw[r]);
            bb[ct][r] = a;
            bon += rv[ct][r] * k * a * kaw[r] * rkw[r];
        }
    }
    ss += __shfl_xor(ss, 16); ss += __shfl_xor(ss, 32);
    bon += __shfl_xor(bon, 16); bon += __shfl_xor(bon, 32);
    if (g == 0) BON[((size_t)dir * T + tok) * NH + h] = bon;
    const float rn = 1.0f / sqrtf(fmaxf(ss, 1e-12f));
    float KKs[4][4], Rs[4][4], Bt[4][4], Kt[4][4];
#pragma unroll
    for (int ct = 0; ct < 4; ++ct) {
        float gcv[4];
#pragma unroll
        for (int r = 0; r < 4; ++r) {
            const float e = ev[ct][r];
            float cum = e;
            cum += row_shr<1>(cum); cum += row_shr<2>(cum); cum += row_shr<4>(cum); cum += row_shr<8>(cum);
            const float cumC = __shfl(cum, (lane & 48) | 15);
            const float kkn = kk[ct][r] * rn, bv = kkn * bb[ct][r];
            const float ig = __expf(cum), rat = __expf(cum - cumC);
            KKs[ct][r] = kkn * __expf(e - cum); Rs[ct][r] = rv[ct][r] * __expf(-cum);
            Bt[ct][r] = bv * ig; Kt[ct][r] = kd[ct][r] * ig;
            gcv[r] = __expf(-cumC);
            LAS unsigned char* q = buf + (S_BK + ct) * SLOT + (4 * g + r + 16 * (s >> 2)) * 16 + 2 * (s & 3);
            *(LAS bf16*)q = (bf16)f2bf(bv * rat); *(LAS bf16*)(q + 8) = (bf16)f2bf(kd[ct][r] * rat);
        }
        if (s == 15) *(LAS f32x4*)(buf + S_GC * SLOT + (16 * ct + 4 * g) * 4) = (f32x4){gcv[0], gcv[1], gcv[2], gcv[3]};
    }
    const bf16x8 fKK0 = frag8(KKs[0], KKs[1]), fKK1 = frag8(KKs[2], KKs[3]), fR0 = frag8(Rs[0], Rs[1]), fR1 = frag8(Rs[2], Rs[3]);
    const bf16x8 fB0 = frag8(Bt[0], Bt[1]), fB1 = frag8(Bt[2], Bt[3]), fK0 = frag8(Kt[0], Kt[1]), fK1 = frag8(Kt[2], Kt[3]);
    *(LAS bf16x8*)(buf + (S_KK + 0) * SLOT + lane * 16) = fKK0; *(LAS bf16x8*)(buf + (S_KK + 1) * SLOT + lane * 16) = fKK1;
    *(LAS bf16x8*)(buf + (S_R + 0) * SLOT + lane * 16) = fR0;  *(LAS bf16x8*)(buf + (S_R + 1) * SLOT + lane * 16) = fR1;
    const f32x4 z4 = {0.f, 0.f, 0.f, 0.f};
    { f32x4 mab = mma(fKK0, fB0, z4); mab = mma(fKK1, fB1, mab);
      *(LAS f32x4*)(MT + s * 16 + 4 * g) = mab; }
    f32x4 mak = mma(fK0, fKK0, z4); mak = mma(fK1, fKK1, mak);
    f32x4 nrb = mma(fB0, fR0, z4); nrb = mma(fB1, fR1, nrb);
    f32x4 nrk = mma(fK0, fR0, z4); nrk = mma(fK1, fR1, nrk);
#pragma unroll
    for (int r = 0; r < 4; ++r) { const int i = 4 * g + r; if (!(i < s)) mak[r] = 0.f; if (!(i <= s)) { nrb[r] = 0.f; nrk[r] = 0.f; } }
    *(LAS v4u*)(buf + S_N * SLOT + lane * 16) = (v4u){cvtpk(nrb[0], nrb[1]), cvtpk(nrb[2], nrb[3]), cvtpk(nrk[0], nrk[1]), cvtpk(nrk[2], nrk[3])};
    asm volatile("s_waitcnt lgkmcnt(0)" ::: "memory"); __builtin_amdgcn_wave_barrier();
    float Tr[16];
#pragma unroll
    for (int j = 15; j >= 0; --j) {
        float acc = 0.f;
#pragma unroll
        for (int i = j + 1; i < 16; ++i) acc += Tr[i] * MT[j * 16 + i];
        Tr[j] = (j == s) ? 1.0f : -acc;
        if (j > s) Tr[j] = 0.f;
    }
    float t0 = 0.f, t1 = 0.f, t2 = 0.f, t3 = 0.f;
#pragma unroll
    for (int gg = 0; gg < 4; ++gg) if (g == gg) { t0 = Tr[4 * gg]; t1 = Tr[4 * gg + 1]; t2 = Tr[4 * gg + 2]; t3 = Tr[4 * gg + 3]; }
    *(LAS v4u*)(buf + S_MT * SLOT + lane * 16) = (v4u){cvtpk(mak[0], mak[1]), cvtpk(mak[2], mak[3]), cvtpk(-t0, -t1), cvtpk(-t2, -t3)};
    asm volatile("s_waitcnt lgkmcnt(0)" ::: "memory"); __builtin_amdgcn_wave_barrier();
}

__device__ __forceinline__ void rec_chunk(const LAS unsigned char* buf, f32x4 (&st)[4], float* Y, int b, int h, int dir, int n, int w, int lane) {
    const int g = lane >> 4, col = lane & 15;
    const bf16x8 fKK0 = *(const LAS bf16x8*)(buf + (S_KK + 0) * SLOT + lane * 16), fKK1 = *(const LAS bf16x8*)(buf + (S_KK + 1) * SLOT + lane * 16);
    const bf16x8 fR0 = *(const LAS bf16x8*)(buf + (S_R + 0) * SLOT + lane * 16), fR1 = *(const LAS bf16x8*)(buf + (S_R + 1) * SLOT + lane * 16);
    const v4u mt = *(const LAS v4u*)(buf + S_MT * SLOT + lane * 16);
    const bf16x8 fN = *(const LAS bf16x8*)(buf + S_N * SLOT + lane * 16);
    const u32x2 vf = *(const LAS u32x2*)(buf + (S_V + (w >> 1)) * SLOT + lane * 16 + (w & 1) * 8);
    const f32x4 z4 = {0.f, 0.f, 0.f, 0.f};
    const bf16x8 sb0 = mkfrag(cvtpk(st[0][0], st[0][1]), cvtpk(st[0][2], st[0][3]), cvtpk(st[1][0], st[1][1]), cvtpk(st[1][2], st[1][3]));
    const bf16x8 sb1 = mkfrag(cvtpk(st[2][0], st[2][1]), cvtpk(st[2][2], st[2][3]), cvtpk(st[3][0], st[3][1]), cvtpk(st[3][2], st[3][3]));
    f32x4 p1 = mma(fKK0, sb0, z4); p1 = mma(fKK1, sb1, p1);
    f32x4 p2 = mma(fR0, sb0, z4); p2 = mma(fR1, sb1, p2);
    const f32x4 x = mma(mkfrag(0u, 0u, mt.x, mt.y), mkfrag(0u, 0u, vf.x, vf.y), p1);
    const f32x4 u = mma(mkfrag(mt.z, mt.w, 0u, 0u), mkfrag(cvtpk(x[0], x[1]), cvtpk(x[2], x[3]), 0u, 0u), z4);
    const bf16x8 buv = mkfrag(cvtpk(u[0], u[1]), cvtpk(u[2], u[3]), vf.x, vf.y);
    const f32x4 y = mma(fN, buv, p2);
#pragma unroll
    for (int i = 0; i < 4; ++i) {
        const f32x4 gc = *(const LAS f32x4*)(buf + S_GC * SLOT + (16 * i + 4 * g) * 4);
        const bf16x8 fBK = *(const LAS bf16x8*)(buf + (S_BK + i) * SLOT + lane * 16);
        st[i] = mma(fBK, buv, st[i] * gc);
    }
    const int cn = dir ? (SEQ / 16 - 1 - n) : n;
#pragma unroll
    for (int r = 0; r < 4; ++r) { const int s = 4 * g + r, t = cn * 16 + (dir ? 15 - s : s);
        Y[((size_t)dir * T + (size_t)(b * SEQ + t)) * RW + h * 64 + 16 * w + col] = y[r]; }
}

__device__ __forceinline__ void chain(LAS unsigned char* L, const bf16* Z, const float* mu_prev, const float* mu_next, const float* w_decay0, const float* w_decay_up,
                                      const float* a_gate0, const float* a_gate_up, const float* k_k, const float* k_a, const float* r_k, float* Y, float* BON, int ch, int tid, int wave, int lane) {
    const int dir = ch & 1, h = (ch >> 1) & 7, b = ch >> 4;
    __syncthreads();
    setup(L, h, dir, mu_prev, mu_next, w_decay0, w_decay_up, a_gate0, a_gate_up, k_k, k_a, r_k, tid);
    __syncthreads();
    f32x4 st[4];
#pragma unroll
    for (int i = 0; i < 4; ++i) st[i] = (f32x4){0.f, 0.f, 0.f, 0.f};
    constexpr int NCH = SEQ / 16, NR = NCH / 4;
    for (int q = -1; q < NR; ++q) {
        if (wave < 4) {
            if (q >= 0) {
#pragma unroll 1
                for (int i = 0; i < 4; ++i) rec_chunk(L + ((q & 1) * 4 + i) * BUF_BYTES, st, Y, b, h, dir, 4 * q + i, wave, lane);
            }
        } else if (q + 1 < NR) {
            const int hw = wave - 4;
            helper_chunk(L, L + (((q + 1) & 1) * 4 + hw) * BUF_BYTES, (LAS float*)(L + OFF_MT + hw * 1024), Z, BON, b, h, dir, 4 * (q + 1) + hw, lane);
        }
        __syncthreads();
    }
}
}

#ifndef MK_SKIP
#define MK_SKIP 0
#endif
constexpr int N_PHASES = 10;
struct Args { const float* in[27]; float* out; unsigned char* ws; int ph_lo, ph_hi, li, pad; };

__global__ void __launch_bounds__(NWAVES * 64, 2) mk_fwd(Args args) {
    extern __shared__ __attribute__((aligned(16))) unsigned char lds[];
    LAS unsigned char* L = (LAS unsigned char*)lds;
    volatile LAS unsigned* MISC = (volatile LAS unsigned*)(L + MISC_OFF);
    const int tid = threadIdx.x, lane = tid & 63, wave = __builtin_amdgcn_readfirstlane(tid >> 6);
    const int G = gridDim.x, bx = blockIdx.x;
    unsigned char* ws = args.ws;
    gu32* ctl = (gu32*)(ws + WS_CTL);
    const float* x = args.in[0]; const float* cvec = args.in[1]; const float* ada_w = args.in[2]; const float* ada_b = args.in[3];
    const float* norm1_g = args.in[4]; const float* w_in = args.in[5]; const float* mu_prev = args.in[6]; const float* mu_next = args.in[7];
    const float* q_norm_g = args.in[8]; const float* k_norm_g = args.in[9]; const float* w_decay0 = args.in[10]; const float* w_decay_up = args.in[11];
    const float* a_gate0 = args.in[12]; const float* a_gate_up = args.in[13]; const float* g_up = args.in[14]; const float* k_k = args.in[15];
    const float* k_a = args.in[16]; const float* r_k = args.in[17]; const float* lnx_g = args.in[18]; const float* lnx_b = args.in[19];
    const float* w_out = args.in[20]; const float* norm2_g = args.in[21]; const float* w_query = args.in[22]; const float* keys1 = args.in[23];
    const float* keys2 = args.in[24]; const float* peer_u = args.in[25]; const float* peer_v = args.in[26];
    float* out = args.out;
    float* MOD = (float*)(ws + WS_MOD); bf16* KEYS = (bf16*)(ws + WS_KEYS); bf16* WIN = (bf16*)(ws + WS_WIN); bf16* WOUT = (bf16*)(ws + WS_WOUT); bf16* WQ = (bf16*)(ws + WS_WQ);
    bf16* XN = (bf16*)(ws + WS_XN); bf16* Z = (bf16*)(ws + WS_Z); bf16* MIX = (bf16*)(ws + WS_MIX); float* Y = (float*)(ws + WS_Y); bf16* Q = (bf16*)(ws + WS_Q);
    int* IDX = (int*)(ws + WS_IDX); float* GATE = (float*)(ws + WS_GATE); float* BON = (float*)(ws + WS_BON);

    for (int u = tid; u < (LDS_BYTES - LDSCTL_OFF) / 4; u += NWAVES * 64) ((LAS unsigned*)(L + LDSCTL_OFF))[u] = 0u;
    __syncthreads();
    XcdBarrier bar = xcd_barrier_post((unsigned*)(ctl + CW_BAR) + args.li * XCD_BAR_WORDS, MISC + 8);
    const int lo = args.ph_lo, hi = args.ph_hi;
#define IN(k) (lo <= (k) && (k) < hi)
#define SEAM(k) do { if (IN(k) && IN((k) + 1)) xcd_barrier(bar); } while (0)
    const int gw = bx * NWAVES + wave, NGW = G * NWAVES;

    if (IN(0) && !(MK_SKIP & (1 << 0))) {
        if (bx < MODW / 64) {
            LAS float* sc = (LAS float*)L; LAS float* part = (LAS float*)(L + 32768);
            for (int i = tid; i < BATCH * D; i += NWAVES * 64) { const float cv = cvec[i]; sc[i] = cv / (1.f + expf(-cv)); }
            __syncthreads();
            const int j0 = bx * 64;
            float acc[BATCH];
#pragma unroll
            for (int b = 0; b < BATCH; ++b) acc[b] = 0.f;
            for (int i = wave * 128; i < wave * 128 + 128; ++i) { const float w = ada_w[(size_t)i * MODW + j0 + lane];
#pragma unroll
                for (int b = 0; b < BATCH; ++b) acc[b] += sc[b * D + i] * w; }
#pragma unroll
            for (int b = 0; b < BATCH; ++b) part[(wave * 8 + b) * 64 + lane] = acc[b];
            __syncthreads();
            { const int b = tid >> 6; float s = 0.f;
#pragma unroll
              for (int w = 0; w < 8; ++w) s += part[(w * 8 + b) * 64 + lane];
              MOD[b * MODW + j0 + lane] = s + ada_b[j0 + lane]; }
            __syncthreads();
        }
        LAS float* scr = (LAS float*)(L + RING_OFF + wave * 16384);
        constexpr int I_IN = (D / 64) * (INW / 32), I_OUT = (D / 64) * (D / 32), I_Q = (D / 64) * (QW / 32);
        for (int it = gw; it < I_IN + I_OUT + I_Q; it += NGW) {
            int r = it;
            if (r < I_IN) { p0_transpose_item(w_in, D, INW, WIN, 0, scr, r, lane); continue; } r -= I_IN;
            if (r < I_OUT) { p0_transpose_item(w_out, D, D, WOUT, 0, scr, r, lane); continue; } r -= I_OUT;
            p0_transpose_item(w_query, D, QW, WQ, 0, scr, r, lane);
        }
        for (int idx = bx * NWAVES * 64 + tid; idx < 256 * 256; idx += G * NWAVES * 64) {
            const int n = idx >> 8, k = idx & 255;
            float v = 0.f;
            if (n < 128) { if (k < 128) v = keys1[n * 128 + k]; } else { if (k >= 128) v = keys2[(n - 128) * 128 + (k - 128)]; }
            KEYS[idx] = (bf16)f2bf(v);
        }
    }
    SEAM(0);
    if (IN(1) && !(MK_SKIP & (1 << 1))) { for (int m = gw; m < T; m += NGW) norm_row(x + (size_t)m * D, norm1_g, MOD + (m / SEQ) * MODW, 0, D, XN + (size_t)m * D, lane); }
    SEAM(1);
    if (IN(2) && !(MK_SKIP & (1 << 2))) {
        pg8::Gemm g{XN, WIN, T, INW, D}; pg8::StaticOrder S; S.init(T, INW, G, bx);
        pg8::EpiBf16<0> E{Z, INW, nullptr, 0, 0, 1.f};
        pg8::gemm_phase<pg8::EpiBf16<0>, pg8::StaticOrder, true, true>(L + RING_OFF, g, S, E);
    }
    SEAM(2);
    if (IN(3) && !(MK_SKIP & (1 << 3))) {
        constexpr int NCHAIN = BATCH * NH * 2;
        if (bx < NCHAIN) {
            scan::chain(L, Z, mu_prev, mu_next, w_decay0, w_decay_up, a_gate0, a_gate_up, k_k, k_a, r_k, Y, BON, bx, tid, wave, lane);
        } else {
            const int wid = (bx - NCHAIN) * NWAVES + wave, nworkers = (G - NCHAIN) * NWAVES;
            for (int it = wid; it < T * NH / 64; it += nworkers) attn_naive_item(Z, q_norm_g, k_norm_g, MIX, it * 64 + lane);
        }
    }
    SEAM(3);
    if (IN(4) && !(MK_SKIP & (1 << 4))) { for (int tok = bx; tok < T; tok += G) rwkv_fin_token(Z, mu_prev, mu_next, g_up, Y, BON, k_a, r_k, lnx_g, lnx_b, MIX, tok, tid, (LAS float*)L); }
    SEAM(4);
    if (IN(5) && !(MK_SKIP & (1 << 5))) {
        pg8::Gemm g{MIX, WOUT, T, D, D}; pg8::StaticOrder S; S.init(T, D, G, bx);
        EpiRes E{x, MOD, 2 * D, out, D};
        pg8::gemm_phase<EpiRes, pg8::StaticOrder, true, true>(L + RING_OFF, g, S, E);
    }
    SEAM(5);
    if (IN(6) && !(MK_SKIP & (1 << 6))) { for (int m = gw; m < T; m += NGW) norm_row(out + (size_t)m * D, norm2_g, MOD + (m / SEQ) * MODW, 3 * D, 4 * D, XN + (size_t)m * D, lane); }
    SEAM(6);
    if (IN(7) && !(MK_SKIP & (1 << 7))) {
        pg8::Gemm g{XN, WQ, T, QW, D}; pg8::StaticOrder S; S.init(T, QW, G, bx);
        pg8::EpiBf16<0> E{Q, QW, nullptr, 0, 0, 1.f};
        pg8::gemm_phase<pg8::EpiBf16<0>, pg8::StaticOrder, true, true>(L + RING_OFF, g, S, E);
    }
    SEAM(7);
    if (IN(8) && !(MK_SKIP & (1 << 8))) { for (int th = gw; th < T * PH; th += NGW) peer_select_item(Q, keys1, keys2, IDX, GATE, th, lane); }
    SEAM(8);
    if (IN(9) && !(MK_SKIP & (1 << 9))) { for (int tok = gw; tok < T; tok += NGW) peer_ffn_token(XN, IDX, GATE, peer_u, peer_v, MOD, out, tok, lane); }
#undef IN
#undef SEAM
}

extern "C" void kernel_launch(void* const* d_in, const int* in_sizes, int n_in, void* d_out, int out_size, void* d_ws, size_t ws_size, hipStream_t stream) {
    static int grid = 0;
    if (grid == 0) {
        if (n_in != 27 || in_sizes[0] != T * D || out_size != T * D || ws_size < WS_END) { fprintf(stderr, "kernel_launch: unexpected problem (n_in %d, in0 %d, out %d, ws %zu); nothing launched\n", n_in, n_in > 0 ? in_sizes[0] : -1, out_size, ws_size); grid = -1; return; }
        int dev = 0, cus = 0, per_cu = 0;
        if (hipGetDevice(&dev) != hipSuccess || hipDeviceGetAttribute(&cus, hipDeviceAttributeMultiprocessorCount, dev) != hipSuccess) { fprintf(stderr, "kernel_launch: device query failed\n"); grid = -1; return; }
        if (hipFuncSetAttribute((const void*)mk_fwd, hipFuncAttributeMaxDynamicSharedMemorySize, LDS_BYTES) != hipSuccess) { fprintf(stderr, "kernel_launch: hipFuncSetAttribute failed\n"); grid = -1; return; }
        if (hipOccupancyMaxActiveBlocksPerMultiprocessor(&per_cu, (const void*)mk_fwd, NWAVES * 64, LDS_BYTES) != hipSuccess || per_cu < 1)
            fprintf(stderr, "kernel_launch: note: occupancy query reports %d workgroups per CU\n", per_cu);
        (void)hipGetLastError();
        grid = cus;
    }
    if (grid < 0) return;
    if (hipMemsetAsync((char*)d_ws + WS_CTL, 0, CTL_ZERO_BYTES, stream) != hipSuccess) { fprintf(stderr, "kernel_launch: hipMemsetAsync failed\n"); return; }
    Args a{};
    for (int i = 0; i < 27; ++i) a.in[i] = (const float*)d_in[i];
    a.out = (float*)d_out; a.ws = (unsigned char*)d_ws;
#ifndef MK_CUTS
#define MK_CUTS {0, N_PHASES}
#endif
    const int cuts[] = MK_CUTS;
    const int nl = (int)(sizeof(cuts) / sizeof(int)) - 1;
    for (int li = 0; li < nl; ++li) {
        a.ph_lo = cuts[li]; a.ph_hi = cuts[li + 1]; a.li = li;
        hipLaunchKernelGGL(mk_fwd, dim3(grid), dim3(NWAVES * 64), LDS_BYTES, stream, a);
        const hipError_t le = hipPeekAtLastError();
        if (le != hipSuccess) { fprintf(stderr, "kernel_launch: launch %d failed: %s\n", li, hipGetErrorName(le)); break; }
    }
}
```

```cpp
#include <hip/hip_runtime.h>
#include <cstdio>
#include <cstdint>
#include <cmath>
namespace pg8 {
#define PG8_LAS __attribute__((address_space(3)))
typedef unsigned short bf16_t;
typedef short bf16x8 __attribute__((ext_vector_type(8)));
typedef float f32x4 __attribute__((ext_vector_type(4)));
typedef unsigned u32x4 __attribute__((ext_vector_type(4)));
constexpr int BM = 256, BK = 64, HALF = 128, HTB = HALF * BK * 2  , STAGE_BYTES = 8 * HTB, NXCD = 8, WGM = 8;

__host__ __device__ __forceinline__ int lds_byte(int r, int c) { const int st = (r >> 4) * 2 + (c >> 5), rr = r & 15, cc = c & 31, ob = rr * 64 + cc * 2; return st * 1024 + (ob ^ (((ob >> 9) & 1) << 5)); }
__host__ __device__ __forceinline__ void stage_rc(int b, int& R, int& C) { const int st = b / 1024, sb = b % 1024, swz = sb ^ (((sb >> 9) & 1) << 5); R = (st >> 1) * 16 + swz / 64; C = (st & 1) * 32 + (swz % 64) / 2; }
__host__ __device__ __forceinline__ int perm32(int rho) { const int n = rho >> 4, i = rho & 15; return 8 * (i >> 2) + 4 * n + (i & 3); }

struct Unit { int pm, pn; };
struct Gemm { const bf16_t* A; const bf16_t* Bt; int M, N, K; };

struct StaticOrder {
    int nM, nN, nwg, G, c;
    __host__ __device__ void init(int M, int N, int G_, int c_) { nM = M / BM; nN = N / BM; nwg = nM * nN; G = G_; c = c_; }
    __host__ __device__ bool next(int i, Unit& u) const {
        const long L = (long)i * G + c; if (L >= nwg) return false;
        int wgid = (int)L; { const int q = nwg / NXCD, r = nwg % NXCD, xcd = wgid % NXCD, off = wgid / NXCD; wgid = (xcd < r ? xcd * (q + 1) : r * (q + 1) + (xcd - r) * q) + off; }
        const int nig = WGM * nN, gid = wgid / nig, fm = gid * WGM, gsz = (nM - fm) < WGM ? (nM - fm) : WGM;
        u.pm = fm + ((wgid % nig) % gsz); u.pn = (wgid % nig) / gsz; return true;
    }
    __device__ __forceinline__ void a_ready(const Unit&) const {}
    __device__ __forceinline__ void done(const Unit&) const {}
};

__device__ __forceinline__ unsigned cvt_pk_bf16(float lo, float hi) { unsigned r; asm volatile("v_cvt_pk_bf16_f32 %0, %1, %2" : "=v"(r) : "v"(lo), "v"(hi)); return r; }
typedef float f32x2 __attribute__((ext_vector_type(2)));
__device__ __forceinline__ f32x2 gelu_pk(f32x2 v) {
    const f32x2 av = __builtin_elementwise_abs(v), d = av * 0.2316418882f + 1.0f;
    f32x2 t; t.x = __builtin_amdgcn_rcpf(d.x); t.y = __builtin_amdgcn_rcpf(d.y);
    f32x2 q = t * 0.5307027145f + (-0.7265760135f); q = q * t + 0.7107068705f; q = q * t + (-0.142248368f); q = q * t + 0.127414796f; q = q * t;
    const f32x2 s = (v * v) * (-0.72134752044f);
    f32x2 e; e.x = __builtin_amdgcn_exp2f(s.x); e.y = __builtin_amdgcn_exp2f(s.y);
    const f32x2 m = v * (q * e), r = v - m;
    f32x2 o; o.x = v.x < 0.f ? m.x : r.x; o.y = v.y < 0.f ? m.y : r.y; return o;
}

template <int ACT  > struct EpiBf16 {
    static constexpr bool PERM = true, AFTER_DRAIN = false; static_assert(ACT == 0 || ACT == 1, "EpiBf16: ACT is 0 (none) or 1 (gelu_pk)");
    bf16_t* O; int ldc; const float* bias; int split_cols; size_t split_stride; float scale0;
    __device__ __forceinline__ void operator()(const f32x4 (&acc)[2][2][4][2], const Unit& u, int wr, int wc, int fr, int fq) const {
        const int row0 = u.pm * BM + wr * 64 + fr; int colt = u.pn * BM; bf16_t* base = O;
        float sc = 1.f; if (split_cols) { const int t = colt / split_cols; base += (size_t)t * split_stride; colt -= t * split_cols; if (t == 0) sc = scale0; }
        const int col0 = colt + wc * 32 + 8 * fq, bcol0 = u.pn * BM + wc * 32 + 8 * fq;
        f32x4 bv[2][2];
#pragma unroll
        for (int bj = 0; bj < 2; ++bj)
#pragma unroll
            for (int n = 0; n < 2; ++n) bv[bj][n] = bias ? *(const f32x4*)(bias + bcol0 + bj * HALF + 4 * n) : (f32x4){0.f, 0.f, 0.f, 0.f};
#pragma unroll
        for (int ai = 0; ai < 2; ++ai)
#pragma unroll
            for (int m = 0; m < 4; ++m) { bf16_t* rowp = base + (size_t)(row0 + ai * HALF + m * 16) * ldc + col0;
#pragma unroll
                for (int bj = 0; bj < 2; ++bj) { f32x4 v0 = acc[ai][bj][m][0] + bv[bj][0], v1 = acc[ai][bj][m][1] + bv[bj][1];
                    if (ACT == 1) { f32x2 a = gelu_pk((f32x2){v0[0], v0[1]}), b = gelu_pk((f32x2){v0[2], v0[3]}), c = gelu_pk((f32x2){v1[0], v1[1]}), d = gelu_pk((f32x2){v1[2], v1[3]});
                        v0 = (f32x4){a.x, a.y, b.x, b.y}; v1 = (f32x4){c.x, c.y, d.x, d.y}; }
                    v0 = v0 * sc; v1 = v1 * sc; u32x4 w; w.x = cvt_pk_bf16(v0[0], v0[1]); w.y = cvt_pk_bf16(v0[2], v0[3]); w.z = cvt_pk_bf16(v1[0], v1[1]); w.w = cvt_pk_bf16(v1[2], v1[3]);
                    *(u32x4*)(rowp + bj * HALF) = w; } }
    }
};

template <class Epi, class Sched, bool ALIGN_EPI = false, bool SP2 = false>
__device__ __forceinline__ void gemm_phase(PG8_LAS unsigned char* lds, const Gemm g, const Sched& S, const Epi& E) {
    const int tid = threadIdx.x, wid = __builtin_amdgcn_readfirstlane(tid >> 6), lane = tid & 63, wr = wid >> 2, wc = wid & 3, fr = lane & 15, fq = lane >> 4;
    const int K = g.K, nt = K / BK;
    unsigned voffA[2], voffB[2];
#pragma unroll
    for (int i = 0; i < 2; ++i) { int R, C; stage_rc(tid * 16 + i * 8192, R, C); const int Rb = Epi::PERM ? ((R & ~31) + perm32(R & 31)) : R;
        voffA[i] = (unsigned)(R * K + C) * 2u; voffB[i] = (unsigned)(Rb * K + C) * 2u; }
    const size_t kstep = (size_t)(BK * 2);
    const size_t hstep = (size_t)HALF * K * 2;
    const size_t tstep = 2 * hstep;
    const unsigned ldsw = (unsigned)wid * 1024u;
    const int aoff = lds_byte(wr * 64 + fr, fq * 8), boff = lds_byte(wc * 32 + fr, fq * 8);
#define PG8_SA(b, h) (((b) * 2 + (h)) * HTB)
#define PG8_SB(b, h) ((4 + (b) * 2 + (h)) * HTB)
#define PG8_STAGE(bufoff, gbase, voff) do { _Pragma("unroll") for (int _i = 0; _i < 2; ++_i) \
        __builtin_amdgcn_global_load_lds((const unsigned*)((const char*)(gbase) + (voff)[_i]), (PG8_LAS unsigned*)(lds + (bufoff) + ldsw + _i * 8192), 16, 0, 0); } while (0)
#define PG8_LDA(dst, b, h) do { _Pragma("unroll") for (int m = 0; m < 4; ++m) _Pragma("unroll") for (int k = 0; k < 2; ++k) dst[m][k] = *(const PG8_LAS bf16x8*)(lds + PG8_SA(b, h) + aoff + m * 2048 + k * 1024); } while (0)
#define PG8_LDB(dst, b, h) do { _Pragma("unroll") for (int n = 0; n < 2; ++n) _Pragma("unroll") for (int k = 0; k < 2; ++k) dst[n][k] = *(const PG8_LAS bf16x8*)(lds + PG8_SB(b, h) + boff + n * 2048 + k * 1024); } while (0)
#define PG8_MMA(ai, bj, At, Bt) do { __builtin_amdgcn_s_setprio(1); _Pragma("unroll") for (int m = 0; m < 4; ++m) _Pragma("unroll") for (int n = 0; n < 2; ++n) _Pragma("unroll") for (int k = 0; k < 2; ++k) \
        acc[ai][bj][m][n] = __builtin_amdgcn_mfma_f32_16x16x32_bf16(Bt[n][k], At[m][k], acc[ai][bj][m][n], 0, 0, 0); __builtin_amdgcn_s_setprio(0); } while (0)
#define PG8_WAIT_V(n) asm volatile("s_waitcnt vmcnt(" #n ")" ::: "memory")
#define PG8_WAIT_L(n) asm volatile("s_waitcnt lgkmcnt(" #n ")" ::: "memory")
#define PG8_BAR __builtin_amdgcn_s_barrier()
#define PG8_SCHED __builtin_amdgcn_sched_barrier(0)
    Unit cur, nxt; int ui = 0;
    if (!S.next(0, cur)) return;
    f32x4 acc[2][2][4][2];
#pragma unroll
    for (int a = 0; a < 2; ++a)
#pragma unroll
        for (int b = 0; b < 2; ++b)
#pragma unroll
            for (int m = 0; m < 4; ++m)
#pragma unroll
                for (int n = 0; n < 2; ++n) acc[a][b][m][n] = (f32x4){0.f, 0.f, 0.f, 0.f};
    bf16x8 At[4][2], B0[2][2], B1[2][2];
    const char* cA = (const char*)g.A + (size_t)cur.pm * tstep; const char* cB = (const char*)g.Bt + (size_t)cur.pn * tstep;
    S.a_ready(cur);
    if constexpr (SP2) {
        PG8_STAGE(PG8_SB(0, 0), cB, voffB); PG8_STAGE(PG8_SB(0, 1), cB + hstep, voffB); PG8_STAGE(PG8_SA(0, 0), cA, voffA); PG8_STAGE(PG8_SA(0, 1), cA + hstep, voffA);
        if (wr == 1) PG8_BAR;
        PG8_WAIT_V(2); PG8_BAR;
        PG8_STAGE(PG8_SB(1, 0), cB + kstep, voffB); PG8_STAGE(PG8_SA(1, 0), cA + kstep, voffA); PG8_STAGE(PG8_SB(1, 1), cB + hstep + kstep, voffB);
        PG8_WAIT_V(6); PG8_BAR;
    } else {
        PG8_STAGE(PG8_SB(0, 0), cB, voffB); PG8_STAGE(PG8_SA(0, 0), cA, voffA); PG8_STAGE(PG8_SB(0, 1), cB + hstep, voffB); PG8_STAGE(PG8_SA(0, 1), cA + hstep, voffA);
        if (wr == 1) PG8_BAR;
        PG8_WAIT_V(4); PG8_BAR;
        PG8_STAGE(PG8_SB(1, 0), cB + kstep, voffB); PG8_STAGE(PG8_SA(1, 0), cA + kstep, voffA); PG8_STAGE(PG8_SB(1, 1), cB + hstep + kstep, voffB);
        PG8_WAIT_V(6); PG8_BAR;
    }
    for (;;) {
        const bool has_next = S.next(ui + 1, nxt);
        const char* nA = has_next ? (const char*)g.A + (size_t)nxt.pm * tstep : cA; const char* nB = has_next ? (const char*)g.Bt + (size_t)nxt.pn * tstep : cB;
        for (int t = 0; t < nt; t += 2) {
            const bool last = (t == nt - 2);
            const char* a1 = cA + (size_t)(t + 1) * kstep;
            const char* a2 = last ? nA : cA + (size_t)(t + 2) * kstep; const char* b2 = last ? nB : cB + (size_t)(t + 2) * kstep;
            const char* a3 = a2 + kstep; const char* b3 = b2 + kstep;
            if (last && has_next) S.a_ready(nxt);
            if constexpr (SP2) {
            PG8_LDB(B0, 0, 0); PG8_LDB(B1, 0, 1); PG8_SCHED; PG8_LDA(At, 0, 0); PG8_STAGE(PG8_SA(1, 1), a1 + hstep, voffA);
            PG8_WAIT_V(8); PG8_WAIT_L(0); PG8_BAR; PG8_MMA(0, 0, At, B0); PG8_MMA(0, 1, At, B1); PG8_BAR; PG8_SCHED;
            PG8_LDA(At, 0, 1); PG8_STAGE(PG8_SB(0, 0), b2, voffB); PG8_STAGE(PG8_SB(0, 1), b2 + hstep, voffB); PG8_STAGE(PG8_SA(0, 0), a2, voffA);
            PG8_WAIT_V(8); PG8_WAIT_L(0); PG8_BAR; PG8_MMA(1, 0, At, B0); PG8_MMA(1, 1, At, B1); PG8_BAR; PG8_SCHED;
            PG8_LDB(B0, 1, 0); PG8_LDB(B1, 1, 1); PG8_SCHED; PG8_LDA(At, 1, 0); PG8_STAGE(PG8_SA(0, 1), a2 + hstep, voffA);
            PG8_WAIT_V(8); PG8_WAIT_L(0); PG8_BAR; PG8_MMA(0, 0, At, B0); PG8_MMA(0, 1, At, B1); PG8_BAR; PG8_SCHED;
            PG8_LDA(At, 1, 1); PG8_STAGE(PG8_SB(1, 0), b3, voffB); PG8_STAGE(PG8_SB(1, 1), b3 + hstep, voffB); PG8_STAGE(PG8_SA(1, 0), a3, voffA);
            PG8_WAIT_V(8); PG8_WAIT_L(0); PG8_BAR; PG8_MMA(1, 0, At, B0); PG8_MMA(1, 1, At, B1); PG8_BAR; PG8_SCHED;
            } else {
            PG8_LDB(B0, 0, 0); PG8_SCHED; PG8_LDA(At, 0, 0); PG8_STAGE(PG8_SA(1, 1), a1 + hstep, voffA);
            PG8_WAIT_L(8); PG8_BAR; PG8_WAIT_L(0); PG8_MMA(0, 0, At, B0); PG8_BAR; PG8_SCHED;
            PG8_LDB(B1, 0, 1); PG8_STAGE(PG8_SB(0, 0), b2, voffB);
            PG8_BAR; PG8_WAIT_L(0); PG8_MMA(0, 1, At, B1); PG8_BAR;
            PG8_LDA(At, 0, 1); PG8_STAGE(PG8_SA(0, 0), a2, voffA);
            PG8_BAR; PG8_WAIT_L(0); PG8_MMA(1, 0, At, B0); PG8_BAR; PG8_SCHED;
            PG8_STAGE(PG8_SB(0, 1), b2 + hstep, voffB);
            PG8_WAIT_V(6); PG8_BAR; PG8_MMA(1, 1, At, B1); PG8_BAR;
            PG8_LDB(B0, 1, 0); PG8_SCHED; PG8_LDA(At, 1, 0); PG8_STAGE(PG8_SA(0, 1), a2 + hstep, voffA);
            PG8_WAIT_L(8); PG8_BAR; PG8_WAIT_L(0); PG8_MMA(0, 0, At, B0); PG8_BAR; PG8_SCHED;
            PG8_LDB(B1, 1, 1); PG8_STAGE(PG8_SB(1, 0), b3, voffB);
            PG8_BAR; PG8_WAIT_L(0); PG8_MMA(0, 1, At, B1); PG8_BAR;
            PG8_LDA(At, 1, 1); PG8_STAGE(PG8_SA(1, 0), a3, voffA);
            PG8_BAR; PG8_WAIT_L(0); PG8_MMA(1, 0, At, B0); PG8_BAR; PG8_SCHED;
            PG8_STAGE(PG8_SB(1, 1), b3 + hstep, voffB);
            PG8_WAIT_V(6); PG8_BAR; PG8_MMA(1, 1, At, B1); PG8_BAR;
            }
        }
        if constexpr (ALIGN_EPI) { if (wr == 0) PG8_BAR; }
        if constexpr (!Epi::AFTER_DRAIN) { E(acc, cur, wr, wc, fr, fq); S.done(cur); }
        if (!has_next) break;
#pragma unroll
        for (int a = 0; a < 2; ++a)
#pragma unroll
            for (int b = 0; b < 2; ++b)
#pragma unroll
                for (int m = 0; m < 4; ++m)
#pragma unroll
                    for (int n = 0; n < 2; ++n) acc[a][b][m][n] = (f32x4){0.f, 0.f, 0.f, 0.f};
        cur = nxt; cA = nA; cB = nB; ++ui;
        if constexpr (ALIGN_EPI) { if (wr == 1) PG8_BAR; }
    }
    PG8_WAIT_V(0);
    if constexpr (!ALIGN_EPI) { if (wr == 0) PG8_BAR; }
    PG8_BAR;
    if constexpr (Epi::AFTER_DRAIN) { E.fused(acc, cur, wr, wc, fr, fq, lds, wid, lane); S.done(cur); }
#undef PG8_SA
#undef PG8_SB
#undef PG8_STAGE
#undef PG8_LDA
#undef PG8_LDB
#undef PG8_MMA
#undef PG8_WAIT_V
#undef PG8_WAIT_L
#undef PG8_BAR
#undef PG8_SCHED
}
}
#define GAS __attribute__((address_space(1)))
#define LAS __attribute__((address_space(3)))
typedef unsigned short bf16;
typedef unsigned v4u __attribute__((ext_vector_type(4)));
typedef float f32x4 __attribute__((ext_vector_type(4)));
typedef short bf16x8 __attribute__((ext_vector_type(8)));
typedef GAS unsigned gu32;
typedef GAS unsigned long long gu64;
#define RLX_AGENT __ATOMIC_RELAXED, __HIP_MEMORY_SCOPE_AGENT
#define LDS_WAIT() asm volatile("s_waitcnt lgkmcnt(0)" ::: "memory")
#define VM_WAIT() asm volatile("s_waitcnt vmcnt(0)" ::: "memory")
__device__ __forceinline__ unsigned long long rt() { return __builtin_amdgcn_s_memrealtime(); }
__device__ __forceinline__ unsigned f2bf(float f) { unsigned u = __builtin_bit_cast(unsigned, f); return (u + 0x7fffu + ((u >> 16) & 1u)) >> 16; }
__device__ __forceinline__ unsigned pk2(float lo, float hi) { return f2bf(lo) | (f2bf(hi) << 16); }

#define XB_TMO      128
#define XB_XCNT(j)  (256  + 64 * (j))
#define XB_XSUB(j)  (1280 + 64 * (j))
#define XB_XGEN(j)  (2304 + 64 * (j))
#define XB_TOP      3328
#define XB_TOPGEN   3392
#define XCD_BAR_WORDS 3456
#define XB_SPIN_CAP (1u << 18)

__device__ __forceinline__ unsigned xb_ld(unsigned* p)              { return __hip_atomic_load(p, __ATOMIC_RELAXED, __HIP_MEMORY_SCOPE_AGENT); }
__device__ __forceinline__ unsigned xb_add(unsigned* p, unsigned v) { return __hip_atomic_fetch_add(p, v, __ATOMIC_RELAXED, __HIP_MEMORY_SCOPE_AGENT); }
__device__ __forceinline__ unsigned xb_xcc_id() { return (unsigned)__builtin_amdgcn_s_getreg((3 << 11) | 20) & 0xFu; }
#define XB_SPIN(cond, bar) do { unsigned _sp = 0; while (cond) { __builtin_amdgcn_s_sleep(1); \
    if ((++_sp & 255u) == 0u) { if (xb_ld(&(bar)[XB_TMO])) break; if (_sp > XB_SPIN_CAP) { atomicAdd(&(bar)[XB_TMO], 1u); break; } } } } while (0)

struct XcdBarrier {
    unsigned* bar; unsigned x;
    volatile LAS unsigned* st;
};

__device__ __forceinline__ XcdBarrier xcd_barrier_post(unsigned* bar, volatile LAS unsigned* st) {
    XcdBarrier b; b.bar = bar; b.x = xb_xcc_id(); b.st = st;
    if (threadIdx.x == 0) (void)xb_add(&bar[XB_XCNT(b.x)], 1u);
    return b;
}
__device__ __forceinline__ void xcd_barrier_complete(unsigned* bar, unsigned x, unsigned& nloc, unsigned& nx) {
    const unsigned G = gridDim.x * gridDim.y * gridDim.z;
    unsigned sum, cnt, mine, sp = 0u;
    for (;;) {
        sum = 0u; cnt = 0u; mine = 0u;
#pragma unroll
        for (unsigned j = 0; j < 16; ++j) { const unsigned c = xb_ld(&bar[XB_XCNT(j)]); sum += c; cnt += (c > 0u) ? 1u : 0u; mine = (j == x) ? c : mine; }
        if (sum == G) break;
        __builtin_amdgcn_s_sleep(1);
        if ((++sp & 255u) == 0u) { if (xb_ld(&bar[XB_TMO])) break; if (sp > XB_SPIN_CAP) { atomicAdd(&bar[XB_TMO], 1u); break; } }
    }
    nloc = mine > 0u ? mine : 1u; nx = cnt > 0u ? cnt : 1u;
}

__device__ __forceinline__ void xcd_barrier(const XcdBarrier& b) {
    asm volatile("s_waitcnt vmcnt(0)" ::: "memory");
    __syncthreads();
    if (threadIdx.x == 0) {
        unsigned* bar = b.bar;
        __builtin_amdgcn_s_waitcnt(0);
        unsigned nloc = b.st[0], nx = b.st[1];
        if (nloc == 0u) { xcd_barrier_complete(bar, b.x, nloc, nx); b.st[0] = nloc; b.st[1] = nx; }
        const unsigned old = xb_add(&bar[XB_XSUB(b.x)], 1u);
        const unsigned gen = old / nloc;
        if (old + 1u == (gen + 1u) * nloc) {
            __builtin_amdgcn_fence(__ATOMIC_RELEASE, "agent");
            asm volatile("s_waitcnt vmcnt(0)" ::: "memory");
            const unsigned og = xb_add(&bar[XB_TOP], 1u);
            const unsigned tg = og / nx;
            if (og + 1u == (tg + 1u) * nx) xb_add(&bar[XB_TOPGEN], 1u);
            else XB_SPIN(xb_ld(&bar[XB_TOPGEN]) == tg, bar);
            __builtin_amdgcn_fence(__ATOMIC_ACQUIRE, "agent");
            xb_add(&bar[XB_XGEN(b.x)], 1u);
            asm volatile("s_waitcnt vmcnt(0)" ::: "memory");
        } else {
            XB_SPIN(xb_ld(&bar[XB_XGEN(b.x)]) == gen, bar);
            __builtin_amdgcn_fence(__ATOMIC_ACQUIRE, "agent");
            asm volatile("s_waitcnt vmcnt(0)" ::: "memory");
        }
    }
    __syncthreads();
}
constexpr int NWAVES = 8;
constexpr int D = 1024, BATCH = 8, SEQ = 2048, T = BATCH * SEQ;
constexpr int AW = 512, RW = 512, NH = 8;
constexpr int DL = 64, AL = 64, GL = 128;
constexpr int SHIFTW = 3 * RW + DL + AL + GL;
constexpr int INW = 3 * AW + SHIFTW;
constexpr int NKEYS = 128, PH = 8, PKD = 256, TOPK = 16, HK = PH * TOPK;
constexpr int QW = PH * PKD;
constexpr int MODW = 6 * D;

constexpr size_t MiB = 1u << 20;
constexpr size_t WS_CTL = 0, CTL_ZERO_BYTES = 1 * MiB;
constexpr size_t WS_MOD = 1 * MiB;
constexpr size_t WS_KEYS = 1 * MiB + 512 * 1024;
constexpr size_t WS_WIN = 2 * MiB;
constexpr size_t WS_WOUT = 9 * MiB;
constexpr size_t WS_WQ = 11 * MiB;
constexpr size_t WS_XN = 16 * MiB;
constexpr size_t WS_O3 = 16 * MiB;
constexpr size_t WS_LSE = 32 * MiB;
constexpr size_t WS_Z = 48 * MiB;
constexpr size_t WS_MIX = 152 * MiB;
constexpr size_t WS_Y = 184 * MiB;
constexpr size_t WS_Q = 48 * MiB;
constexpr size_t WS_IDX = 112 * MiB;
constexpr size_t WS_GATE = 120 * MiB;
constexpr size_t WS_BON = 248 * MiB;
constexpr size_t WS_END = 249 * MiB;
constexpr int CW_BAR = 4096;
constexpr int MAX_LAUNCHES = 12;

constexpr int RING_OFF = 0, RING_BYTES = 131072;
constexpr int LDSCTL_OFF = RING_BYTES, MISC_OFF = LDSCTL_OFF + 320;
constexpr int LDS_BYTES = 147456;

typedef GAS float gf32;
typedef GAS f32x4 gf32x4;

__device__ __forceinline__ float bf2f(bf16 v) { return __uint_as_float(((unsigned)v) << 16); }
__device__ __forceinline__ float wave_sum(float v) {
#pragma unroll
    for (int o = 1; o < 64; o <<= 1) v += __shfl_xor(v, o);
    return v;
}
#define WAVE_LDS_SYNC() do { asm volatile("s_waitcnt lgkmcnt(0)" ::: "memory"); __builtin_amdgcn_wave_barrier(); } while (0)

__device__ __forceinline__ void p0_transpose_item(const float* W, int K, int N, bf16* WT, int row_off, LAS float* scr, int item, int lane) {
    const int nblk = N / 32, kb = item / nblk, nb = item % nblk, k0 = 64 * kb, n0 = 32 * nb;
#pragma unroll 8
    for (int i = 0; i < 32; ++i) { const int kk = 2 * i + (lane >> 5); scr[kk * 33 + (lane & 31)] = W[(size_t)(k0 + kk) * N + n0 + (lane & 31)]; }
    LDS_WAIT(); asm volatile("" ::: "memory");
    const int c = lane & 7;
#pragma unroll
    for (int j = 0; j < 4; ++j) { const int n = (lane >> 3) + 8 * j; const LAS float* s = scr + (8 * c) * 33 + n;
        v4u o; o.x = pk2(s[0 * 33], s[1 * 33]); o.y = pk2(s[2 * 33], s[3 * 33]); o.z = pk2(s[4 * 33], s[5 * 33]); o.w = pk2(s[6 * 33], s[7 * 33]);
        *(GAS v4u*)(WT + (size_t)(row_off + n0 + n) * K + k0 + 8 * c) = o; }
    LDS_WAIT(); asm volatile("" ::: "memory");
}

__device__ __forceinline__ void norm_row(const float* xrow, const float* g, const float* modb, int shift_off, int scale_off, bf16* orow, int lane) {
    const GAS f32x4* xr = (const GAS f32x4*)xrow + lane;
    f32x4 v[4]; float s = 0.f;
#pragma unroll
    for (int j = 0; j < 4; ++j) { v[j] = xr[64 * j]; s += (v[j].x * v[j].x + v[j].y * v[j].y) + (v[j].z * v[j].z + v[j].w * v[j].w); }
    const float rs = 1.0f / sqrtf(wave_sum(s) * (1.f / D) + 1e-6f);
    GAS unsigned long long* o8 = (GAS unsigned long long*)orow + lane;
#pragma unroll
    for (int j = 0; j < 4; ++j) {
        const int col = 256 * j + 4 * lane;
        const f32x4 g4 = *(const GAS f32x4*)(g + col), sc = *(const GAS f32x4*)(modb + scale_off + col), sh = *(const GAS f32x4*)(modb + shift_off + col);
        const f32x4 y = v[j] * rs * g4 * (sc + 1.0f) + sh;
        o8[64 * j] = (unsigned long long)pk2(y.x, y.y) | ((unsigned long long)pk2(y.z, y.w) << 32);
    }
}

struct EpiRes {
    static constexpr bool PERM = false, AFTER_DRAIN = false;
    const float* xres; const float* mod; int gate_off; float* out; int ldc;
    __device__ __forceinline__ void operator()(const pg8::f32x4 (&acc)[2][2][4][2], const pg8::Unit& u, int wr, int wc, int fr, int fq) const {
        const int col0 = u.pn * pg8::BM + wc * 32 + 4 * fq;
        const int b = (u.pm * pg8::BM) / SEQ;
        pg8::f32x4 gv[2][2];
#pragma unroll
        for (int bj = 0; bj < 2; ++bj)
#pragma unroll
            for (int n = 0; n < 2; ++n) gv[bj][n] = *(const pg8::f32x4*)(mod + b * MODW + gate_off + col0 + bj * pg8::HALF + n * 16);
#pragma unroll
        for (int ai = 0; ai < 2; ++ai)
#pragma unroll
            for (int m = 0; m < 4; ++m) { const size_t off = (size_t)(u.pm * pg8::BM + ai * pg8::HALF + wr * 64 + m * 16 + fr) * ldc + col0;
#pragma unroll
                for (int bj = 0; bj < 2; ++bj)
#pragma unroll
                    for (int n = 0; n < 2; ++n) { const pg8::f32x4 bs = *(const pg8::f32x4*)(xres + off + bj * pg8::HALF + n * 16);
                        *(pg8::f32x4*)(out + off + bj * pg8::HALF + n * 16) = bs + gv[bj][n] * acc[ai][bj][m][n]; } }
    }
};

__device__ __forceinline__ float zshift(const bf16* Z, int tok, int t, int col, const float* mu_prev, const float* mu_next) {
    const bf16* zc = Z + (size_t)tok * INW + 3 * AW + col;
    const float z = bf2f(zc[0]);
    const float zp = (t > 0) ? bf2f(zc[-INW]) : 0.f;
    const float zn = (t < SEQ - 1) ? bf2f(zc[INW]) : 0.f;
    return z + mu_prev[col] * (zp - z) + mu_next[col] * (zn - z);
}
__device__ __forceinline__ float decay_of(float wl) {
    const float nx = -wl; const float sp = (nx > 20.f) ? nx : log1pf(expf(nx));
    return expf(-expf(-sp - 0.5f));
}

__device__ __forceinline__ void rwkv_fin_token(const bf16* Z, const float* mu_prev, const float* mu_next, const float* g_up,
                                               const float* Y, const float* BON, const float* k_a, const float* r_k, const float* lnx_g, const float* lnx_b, bf16* mix, const bf16* O3, const float* LSE, int tok, int c, LAS float* zr) {
    const int t = tok % SEQ;
    __syncthreads();
    for (int col = c; col < SHIFTW; col += 512) zr[col] = zshift(Z, tok, t, col, mu_prev, mu_next);
    __syncthreads();
    const size_t o = (size_t)tok * RW + c;
    const float y = Y[o] + Y[(size_t)T * RW + o];
    const float mean = wave_sum(y) * (1.f / 64.f);
    const float var = wave_sum((y - mean) * (y - mean)) * (1.f / 64.f);
    const float yn = (y - mean) * (1.0f / sqrtf(var + 64e-5f)) * lnx_g[c] + lnx_b[c];
    float g = 0.f;
#pragma unroll 4
    for (int j = 0; j < GL; ++j) g += (1.0f / (1.0f + expf(-zr[3 * RW + DL + AL + j]))) * g_up[(size_t)j * RW + c];
    const float r = zr[c], k = zr[RW + c], v = zr[2 * RW + c];
    const float bs = wave_sum(r * k * r_k[c] * (1.0f - k_a[c])) + 0.5f * (BON[(size_t)tok * NH + (c >> 6)] + BON[((size_t)T + tok) * NH + (c >> 6)]);
    const int hh = c >> 6;
    const float l1 = LSE[(size_t)tok * NH + hh], l2 = LSE[((size_t)T + tok) * NH + hh], l3 = LSE[((size_t)2 * T + tok) * NH + hh];
    const float lm = fmaxf(l1, fmaxf(l2, l3)), w1 = __expf(l1 - lm), w2 = __expf(l2 - lm), w3 = __expf(l3 - lm);
    const float att = (w1 * bf2f(mix[(size_t)tok * D + c]) + w2 * bf2f(mix[(size_t)tok * D + AW + c]) + w3 * bf2f(O3[(size_t)tok * AW + c])) / (w1 + w2 + w3);
    mix[(size_t)tok * D + c] = (bf16)f2bf(att);
    mix[(size_t)tok * D + AW + c] = (bf16)f2bf((yn + bs * v) * g);
}

__device__ __forceinline__ void wave_argmax(float& v, int& i) {
#pragma unroll
    for (int m = 1; m < 64; m <<= 1) { const float ov = __shfl_xor(v, m); const int oi = __shfl_xor(i, m); if (ov > v || (ov == v && oi < i)) { v = ov; i = oi; } }
}

__device__ __forceinline__ void peer_select_item(const bf16* Q, const float* keys1, const float* keys2, int* IDX, float* GATE, int th, int lane) {
    const bf16* qp = Q + (size_t)th * PKD;
    float s1a = 0.f, s1b = 0.f, s2a = 0.f, s2b = 0.f;
    for (int d = 0; d < 128; ++d) {
        const float q1 = bf2f(qp[d]), q2 = bf2f(qp[128 + d]);
        s1a += q1 * keys1[lane * 128 + d]; s1b += q1 * keys1[(lane + 64) * 128 + d];
        s2a += q2 * keys2[lane * 128 + d]; s2b += q2 * keys2[(lane + 64) * 128 + d];
    }
    float v1 = 0.f, v2 = 0.f; int i1 = 0, i2 = 0;
    for (int k = 0; k < TOPK; ++k) {
        float bv = s1a; int bi = lane; if (s1b > bv) { bv = s1b; bi = lane + 64; }
        wave_argmax(bv, bi);
        if (lane == k) { v1 = bv; i1 = bi; }
        if (bi == lane) s1a = -INFINITY; if (bi == lane + 64) s1b = -INFINITY;
    }
    for (int k = 0; k < TOPK; ++k) {
        float bv = s2a; int bi = lane; if (s2b > bv) { bv = s2b; bi = lane + 64; }
        wave_argmax(bv, bi);
        if (lane == k) { v2 = bv; i2 = bi; }
        if (bi == lane) s2a = -INFINITY; if (bi == lane + 64) s2b = -INFINITY;
    }
    const float va = __shfl(v1, lane >> 2);
    float c0 = va + __shfl(v2, (lane & 3) * 4 + 0), c1 = va + __shfl(v2, (lane & 3) * 4 + 1), c2 = va + __shfl(v2, (lane & 3) * 4 + 2), c3 = va + __shfl(v2, (lane & 3) * 4 + 3);
    float ts = 0.f; int tp = 0;
    for (int k = 0; k < TOPK; ++k) {
        float bv = c0; int bi = lane * 4;
        if (c1 > bv) { bv = c1; bi = lane * 4 + 1; } if (c2 > bv) { bv = c2; bi = lane * 4 + 2; } if (c3 > bv) { bv = c3; bi = lane * 4 + 3; }
        wave_argmax(bv, bi);
        if (lane == k) { ts = bv; tp = bi; }
        if (bi == lane * 4) c0 = -INFINITY; if (bi == lane * 4 + 1) c1 = -INFINITY; if (bi == lane * 4 + 2) c2 = -INFINITY; if (bi == lane * 4 + 3) c3 = -INFINITY;
    }
    const int e1 = __shfl(i1, tp >> 4), e2 = __shfl(i2, tp & 15);
    const float mx = __shfl(ts, 0);
    const float ex = (lane < 16) ? expf(ts - mx) : 0.f;
    float sum = ex;
#pragma unroll
    for (int m = 1; m < 16; m <<= 1) sum += __shfl_xor(sum, m);
    if (lane < 16) { IDX[(size_t)th * TOPK + lane] = e1 * NKEYS + e2; GATE[(size_t)th * TOPK + lane] = ex / sum; }
}

__device__ __forceinline__ void peer_ffn_token(const bf16* XN, const int* IDX, const float* GATE, const float* U, const float* Vt, const float* mod, float* out, int tok, int lane) {
    const int b = tok / SEQ;
    float x[16], y[16];
#pragma unroll
    for (int j = 0; j < 4; ++j)
#pragma unroll
        for (int e = 0; e < 4; ++e) { x[j * 4 + e] = bf2f(XN[(size_t)tok * D + 256 * j + lane * 4 + e]); y[j * 4 + e] = 0.f; }
    for (int k = 0; k < HK; ++k) {
        const int ex = IDX[(size_t)tok * HK + k]; const float gt = GATE[(size_t)tok * HK + k];
        const float* up = U + (size_t)ex * D + lane * 4; const float* vp = Vt + (size_t)ex * D + lane * 4;
        float dot = 0.f;
#pragma unroll
        for (int j = 0; j < 4; ++j) { const f32x4 u4 = *(const f32x4*)(up + 256 * j); dot += x[j * 4] * u4.x + x[j * 4 + 1] * u4.y + x[j * 4 + 2] * u4.z + x[j * 4 + 3] * u4.w; }
        dot = wave_sum(dot);
        const float act = 0.5f * dot * (1.0f + erff(dot * 0.70710678118654752f));
        const float cf = gt * act;
#pragma unroll
        for (int j = 0; j < 4; ++j) { const f32x4 v4 = *(const f32x4*)(vp + 256 * j); y[j * 4] += cf * v4.x; y[j * 4 + 1] += cf * v4.y; y[j * 4 + 2] += cf * v4.z; y[j * 4 + 3] += cf * v4.w; }
    }
#pragma unroll
    for (int j = 0; j < 4; ++j) { const int cidx = 256 * j + lane * 4; const size_t o = (size_t)tok * D + cidx;
        const f32x4 g2 = *(const f32x4*)(mod + b * MODW + 5 * D + cidx); f32x4 ov = *(const f32x4*)(out + o);
        ov.x += g2.x * y[j * 4]; ov.y += g2.y * y[j * 4 + 1]; ov.z += g2.z * y[j * 4 + 2]; ov.w += g2.w * y[j * 4 + 3];
        *(f32x4*)(out + o) = ov; }
}

namespace scan {
typedef unsigned u32x2 __attribute__((ext_vector_type(2)));
constexpr int SLOT = 1024, BUF_BYTES = 12800, NBUF = 8;
constexpr int OFF_LORA = NBUF * BUF_BYTES;
constexpr int OFF_CONST = OFF_LORA + 16 * SLOT;
constexpr int OFF_MT = OFF_CONST + 4096;
constexpr int SCAN_LDS = OFF_MT + 4 * 1024;
static_assert(SCAN_LDS <= 131072, "scan LDS map");
constexpr int S_KK = 0, S_R = 2, S_MT = 4, S_N = 5, S_BK = 6, S_V = 10, S_GC = 12;

typedef float f32x2n __attribute__((ext_vector_type(2)));
typedef __bf16 bf16x2n __attribute__((ext_vector_type(2)));
__device__ __forceinline__ unsigned cvtpk(float lo, float hi) { const f32x2n v = {lo, hi}; const bf16x2n b = __builtin_convertvector(v, bf16x2n); return __builtin_bit_cast(unsigned, b); }
__device__ __forceinline__ bf16x8 mkfrag(unsigned a, unsigned b, unsigned c, unsigned d) { v4u w; w.x = a; w.y = b; w.z = c; w.w = d; return __builtin_bit_cast(bf16x8, w); }
__device__ __forceinline__ bf16x8 frag8(const float (&lo)[4], const float (&hi)[4]) { return mkfrag(cvtpk(lo[0], lo[1]), cvtpk(lo[2], lo[3]), cvtpk(hi[0], hi[1]), cvtpk(hi[2], hi[3])); }
__device__ __forceinline__ f32x4 mma(bf16x8 a, bf16x8 b, f32x4 c) { return __builtin_amdgcn_mfma_f32_16x16x32_bf16(a, b, c, 0, 0, 0); }
template <int N> __device__ __forceinline__ float row_shr(float x) { return __int_as_float(__builtin_amdgcn_update_dpp(0, __float_as_int(x), 0x110 + N, 0xf, 0xf, true)); }
__device__ __forceinline__ float fsigmoid(float x) { return 1.0f / (1.0f + __expf(-x)); }

__device__ __forceinline__ void setup(LAS unsigned char* L, int h, int dir, const float* mu_prev, const float* mu_next, const float* w_decay0, const float* w_decay_up,
                                      const float* a_gate0, const float* a_gate_up, const float* k_k, const float* k_a, const float* r_k, int tid) {
    LAS float* C = (LAS float*)(L + OFF_CONST);
    for (int i = tid; i < 320; i += 512) {
        const int grp = i >> 6, c = i & 63;
        const int col = (grp < 3) ? grp * RW + h * 64 + c : 3 * RW + (grp - 3) * 64 + c;
        C[i] = mu_prev[col]; C[320 + i] = mu_next[col];
    }
    if (tid < 64) { const int hc = h * 64 + tid; C[640 + tid] = w_decay0[dir * RW + hc]; C[704 + tid] = a_gate0[dir * RW + hc]; C[768 + tid] = k_k[hc]; C[832 + tid] = k_a[hc]; C[896 + tid] = r_k[hc]; }
    LAS bf16* F = (LAS bf16*)(L + OFF_LORA);
    for (int i = tid; i < 16 * 64 * 8; i += 512) {
        const int j = i & 7, l = (i >> 3) & 63, sl = i >> 9, m = sl & 1, ct = (sl >> 1) & 3, wa = sl >> 3;
        const int g = l >> 4, jj = 32 * m + (j < 4 ? 4 * g + j : 16 + 4 * g + j - 4), c = h * 64 + 16 * ct + (l & 15);
        const float v = wa ? a_gate_up[(size_t)(dir * AL + jj) * RW + c] : w_decay_up[(size_t)(dir * DL + jj) * RW + c];
        F[i] = (bf16)f2bf(v);
    }
}

__device__ __forceinline__ void helper_chunk(LAS unsigned char* L, LAS unsigned char* buf, LAS float* MT, const bf16* Z, float* BON, int b, int h, int dir, int n, int lane) {
    const int s = lane & 15, g = lane >> 4;
    const int cn = dir ? (SEQ / 16 - 1 - n) : n;
    const int t = cn * 16 + (dir ? 15 - s : s), tok = b * SEQ + t;
    const LAS float* C = (const LAS float*)(L + OFF_CONST);
    const bool hasp = t > 0, hasn = t < SEQ - 1;
    const bf16* zrow = Z + (size_t)tok * INW + 3 * AW;
    float rv[4][4], kv[4][4], vv[4][4], tw[4][4], xa[4][4];
#pragma unroll
    for (int grp = 0; grp < 5; ++grp) {
        const int cbase = (grp < 3) ? grp * RW + h * 64 : 3 * RW + (grp - 3) * 64;
#pragma unroll
        for (int ct = 0; ct < 4; ++ct) {
            const bf16* p = zrow + cbase + 16 * ct + 4 * g;
            const u32x2 zc = *(const u32x2*)p;
            u32x2 zp = *(const u32x2*)(hasp ? p - INW : p), zn = *(const u32x2*)(hasn ? p + INW : p);
            if (!hasp) { zp.x = 0u; zp.y = 0u; } if (!hasn) { zn.x = 0u; zn.y = 0u; }
            const f32x4 mp = *(const LAS f32x4*)(C + grp * 64 + 16 * ct + 4 * g), mn = *(const LAS f32x4*)(C + 320 + grp * 64 + 16 * ct + 4 * g);
            float zv[4] = {__uint_as_float(zc.x << 16), __uint_as_float(zc.x & 0xffff0000u), __uint_as_float(zc.y << 16), __uint_as_float(zc.y & 0xffff0000u)};
            float pv[4] = {__uint_as_float(zp.x << 16), __uint_as_float(zp.x & 0xffff0000u), __uint_as_float(zp.y << 16), __uint_as_float(zp.y & 0xffff0000u)};
            float nv[4] = {__uint_as_float(zn.x << 16), __uint_as_float(zn.x & 0xffff0000u), __uint_as_float(zn.y << 16), __uint_as_float(zn.y & 0xffff0000u)};
#pragma unroll
            for (int r = 0; r < 4; ++r) {
                const float o = zv[r] + mp[r] * (pv[r] - zv[r]) + mn[r] * (nv[r] - zv[r]);
                if (grp == 0) rv[ct][r] = o; else if (grp == 1) kv[ct][r] = o; else if (grp == 2) vv[ct][r] = o;
                else if (grp == 3) { const float e2 = __expf(2.0f * o); tw[ct][r] = 1.0f - 2.0f / (e2 + 1.0f); } else xa[ct][r] = o;
            }
        }
    }
#pragma unroll
    for (int ct = 0; ct < 4; ++ct)
#pragma unroll
        for (int r = 0; r < 4; ++r)
            *(LAS bf16*)(buf + (S_V + (ct >> 1)) * SLOT + (4 * g + r + 16 * (s >> 2)) * 16 + (ct & 1) * 8 + 2 * (s & 3)) = (bf16)f2bf(vv[ct][r]);
    f32x4 accw[4], acca[4];
    { const bf16x8 tb0 = frag8(tw[0], tw[1]), tb1 = frag8(tw[2], tw[3]), xb0 = frag8(xa[0], xa[1]), xb1 = frag8(xa[2], xa[3]);
      const LAS bf16x8* F = (const LAS bf16x8*)(L + OFF_LORA);
#pragma unroll
      for (int ct = 0; ct < 4; ++ct) {
          f32x4 z4 = {0.f, 0.f, 0.f, 0.f};
          accw[ct] = mma(F[(0 * 8 + ct * 2 + 0) * 64 + lane], tb0, z4); accw[ct] = mma(F[(0 * 8 + ct * 2 + 1) * 64 + lane], tb1, accw[ct]);
          acca[ct] = mma(F[(1 * 8 + ct * 2 + 0) * 64 + lane], xb0, z4); acca[ct] = mma(F[(1 * 8 + ct * 2 + 1) * 64 + lane], xb1, acca[ct]);
      } }
    float ev[4][4], kk[4][4], kd[4][4], bb[4][4];
    float ss = 0.f, bon = 0.f;
#pragma unroll
    for (int ct = 0; ct < 4; ++ct) {
        const f32x4 w0 = *(const LAS f32x4*)(C + 640 + 16 * ct + 4 * g), a0 = *(const LAS f32x4*)(C + 704 + 16 * ct + 4 * g), kkw = *(const LAS f32x4*)(C + 768 + 16 * ct + 4 * g),
                    kaw = *(const LAS f32x4*)(C + 832 + 16 * ct + 4 * g), rkw = *(const LAS f32x4*)(C + 896 + 16 * ct + 4 * g);
#pragma unroll
        for (int r = 0; r < 4; ++r) {
            ev[ct][r] = 0.60653065971f * fsigmoid(accw[ct][r] + w0[r]);
            const float a = fsigmoid(acca[ct][r] + a0[r]);
            const float k = kv[ct][r];
            kk[ct][r] = k * kkw[r]; ss += kk[ct][r] * kk[ct][r];
            kd[ct][r] = k * (1.0f + (a - 1.0f) * kaw[r]);
            bb[ct][r] = a;
            bon += rv[ct][r] * k * a * kaw[r] * rkw[r];
        }
    }
    ss += __shfl_xor(ss, 16); ss += __shfl_xor(ss, 32);
    bon += __shfl_xor(bon, 16); bon += __shfl_xor(bon, 32);
    if (g == 0) BON[((size_t)dir * T + tok) * NH + h] = bon;
    const float rn = 1.0f / sqrtf(fmaxf(ss, 1e-12f));
    float KKs[4][4], Rs[4][4], Bt[4][4], Kt[4][4];
#pragma unroll
    for (int ct = 0; ct < 4; ++ct) {
        float gcv[4];
#pragma unroll
        for (int r = 0; r < 4; ++r) {
            const float e = ev[ct][r];
            float cum = e;
            cum += row_shr<1>(cum); cum += row_shr<2>(cum); cum += row_shr<4>(cum); cum += row_shr<8>(cum);
            const float cumC = __shfl(cum, (lane & 48) | 15);
            const float kkn = kk[ct][r] * rn, bv = kkn * bb[ct][r];
            const float ig = __expf(cum), rat = __expf(cum - cumC);
            KKs[ct][r] = kkn * __expf(e - cum); Rs[ct][r] = rv[ct][r] * __expf(-cum);
            Bt[ct][r] = bv * ig; Kt[ct][r] = kd[ct][r] * ig;
            gcv[r] = __expf(-cumC);
            LAS unsigned char* q = buf + (S_BK + ct) * SLOT + (4 * g + r + 16 * (s >> 2)) * 16 + 2 * (s & 3);
            *(LAS bf16*)q = (bf16)f2bf(bv * rat); *(LAS bf16*)(q + 8) = (bf16)f2bf(kd[ct][r] * rat);
        }
        if (s == 15) *(LAS f32x4*)(buf + S_GC * SLOT + (16 * ct + 4 * g) * 4) = (f32x4){gcv[0], gcv[1], gcv[2], gcv[3]};
    }
    const bf16x8 fKK0 = frag8(KKs[0], KKs[1]), fKK1 = frag8(KKs[2], KKs[3]), fR0 = frag8(Rs[0], Rs[1]), fR1 = frag8(Rs[2], Rs[3]);
    const bf16x8 fB0 = frag8(Bt[0], Bt[1]), fB1 = frag8(Bt[2], Bt[3]), fK0 = frag8(Kt[0], Kt[1]), fK1 = frag8(Kt[2], Kt[3]);
    *(LAS bf16x8*)(buf + (S_KK + 0) * SLOT + lane * 16) = fKK0; *(LAS bf16x8*)(buf + (S_KK + 1) * SLOT + lane * 16) = fKK1;
    *(LAS bf16x8*)(buf + (S_R + 0) * SLOT + lane * 16) = fR0;  *(LAS bf16x8*)(buf + (S_R + 1) * SLOT + lane * 16) = fR1;
    const f32x4 z4 = {0.f, 0.f, 0.f, 0.f};
    { f32x4 mab = mma(fKK0, fB0, z4); mab = mma(fKK1, fB1, mab);
      *(LAS f32x4*)(MT + s * 16 + 4 * g) = mab; }
    f32x4 mak = mma(fK0, fKK0, z4); mak = mma(fK1, fKK1, mak);
    f32x4 nrb = mma(fB0, fR0, z4); nrb = mma(fB1, fR1, nrb);
    f32x4 nrk = mma(fK0, fR0, z4); nrk = mma(fK1, fR1, nrk);
#pragma unroll
    for (int r = 0; r < 4; ++r) { const int i = 4 * g + r; if (!(i < s)) mak[r] = 0.f; if (!(i <= s)) { nrb[r] = 0.f; nrk[r] = 0.f; } }
    *(LAS v4u*)(buf + S_N * SLOT + lane * 16) = (v4u){cvtpk(nrb[0], nrb[1]), cvtpk(nrb[2], nrb[3]), cvtpk(nrk[0], nrk[1]), cvtpk(nrk[2], nrk[3])};
    asm volatile("s_waitcnt lgkmcnt(0)" ::: "memory"); __builtin_amdgcn_wave_barrier();
    float Tr[16];
#pragma unroll
    for (int j = 15; j >= 0; --j) {
        float acc = 0.f;
#pragma unroll
        for (int i = j + 1; i < 16; ++i) acc += Tr[i] * MT[j * 16 + i];
        Tr[j] = (j == s) ? 1.0f : -acc;
        if (j > s) Tr[j] = 0.f;
    }
    float t0 = 0.f, t1 = 0.f, t2 = 0.f, t3 = 0.f;
#pragma unroll
    for (int gg = 0; gg < 4; ++gg) if (g == gg) { t0 = Tr[4 * gg]; t1 = Tr[4 * gg + 1]; t2 = Tr[4 * gg + 2]; t3 = Tr[4 * gg + 3]; }
    *(LAS v4u*)(buf + S_MT * SLOT + lane * 16) = (v4u){cvtpk(mak[0], mak[1]), cvtpk(mak[2], mak[3]), cvtpk(-t0, -t1), cvtpk(-t2, -t3)};
    asm volatile("s_waitcnt lgkmcnt(0)" ::: "memory"); __builtin_amdgcn_wave_barrier();
}

__device__ __forceinline__ void rec_chunk(const LAS unsigned char* buf, f32x4 (&st)[4], float* Y, int b, int h, int dir, int n, int w, int lane) {
    const int g = lane >> 4, col = lane & 15;
    const bf16x8 fKK0 = *(const LAS bf16x8*)(buf + (S_KK + 0) * SLOT + lane * 16), fKK1 = *(const LAS bf16x8*)(buf + (S_KK + 1) * SLOT + lane * 16);
    const bf16x8 fR0 = *(const LAS bf16x8*)(buf + (S_R + 0) * SLOT + lane * 16), fR1 = *(const LAS bf16x8*)(buf + (S_R + 1) * SLOT + lane * 16);
    const v4u mt = *(const LAS v4u*)(buf + S_MT * SLOT + lane * 16);
    const bf16x8 fN = *(const LAS bf16x8*)(buf + S_N * SLOT + lane * 16);
    const u32x2 vf = *(const LAS u32x2*)(buf + (S_V + (w >> 1)) * SLOT + lane * 16 + (w & 1) * 8);
    const f32x4 z4 = {0.f, 0.f, 0.f, 0.f};
    const bf16x8 sb0 = mkfrag(cvtpk(st[0][0], st[0][1]), cvtpk(st[0][2], st[0][3]), cvtpk(st[1][0], st[1][1]), cvtpk(st[1][2], st[1][3]));
    const bf16x8 sb1 = mkfrag(cvtpk(st[2][0], st[2][1]), cvtpk(st[2][2], st[2][3]), cvtpk(st[3][0], st[3][1]), cvtpk(st[3][2], st[3][3]));
    f32x4 p1 = mma(fKK0, sb0, z4); p1 = mma(fKK1, sb1, p1);
    f32x4 p2 = mma(fR0, sb0, z4); p2 = mma(fR1, sb1, p2);
    const f32x4 x = mma(mkfrag(0u, 0u, mt.x, mt.y), mkfrag(0u, 0u, vf.x, vf.y), p1);
    const f32x4 u = mma(mkfrag(mt.z, mt.w, 0u, 0u), mkfrag(cvtpk(x[0], x[1]), cvtpk(x[2], x[3]), 0u, 0u), z4);
    const bf16x8 buv = mkfrag(cvtpk(u[0], u[1]), cvtpk(u[2], u[3]), vf.x, vf.y);
    const f32x4 y = mma(fN, buv, p2);
#pragma unroll
    for (int i = 0; i < 4; ++i) {
        const f32x4 gc = *(const LAS f32x4*)(buf + S_GC * SLOT + (16 * i + 4 * g) * 4);
        const bf16x8 fBK = *(const LAS bf16x8*)(buf + (S_BK + i) * SLOT + lane * 16);
        st[i] = mma(fBK, buv, st[i] * gc);
    }
    const int cn = dir ? (SEQ / 16 - 1 - n) : n;
#pragma unroll
    for (int r = 0; r < 4; ++r) { const int s = 4 * g + r, t = cn * 16 + (dir ? 15 - s : s);
        Y[((size_t)dir * T + (size_t)(b * SEQ + t)) * RW + h * 64 + 16 * w + col] = y[r]; }
}

__device__ __forceinline__ void chain(LAS unsigned char* L, const bf16* Z, const float* mu_prev, const float* mu_next, const float* w_decay0, const float* w_decay_up,
                                      const float* a_gate0, const float* a_gate_up, const float* k_k, const float* k_a, const float* r_k, float* Y, float* BON, int ch, int tid, int wave, int lane) {
    const int dir = ch & 1, h = (ch >> 1) & 7, b = ch >> 4;
    __syncthreads();
    setup(L, h, dir, mu_prev, mu_next, w_decay0, w_decay_up, a_gate0, a_gate_up, k_k, k_a, r_k, tid);
    __syncthreads();
    f32x4 st[4];
#pragma unroll
    for (int i = 0; i < 4; ++i) st[i] = (f32x4){0.f, 0.f, 0.f, 0.f};
    constexpr int NCH = SEQ / 16, NR = NCH / 4;
    for (int q = -1; q < NR; ++q) {
        if (wave < 4) {
            if (q >= 0) {
#pragma unroll 1
                for (int i = 0; i < 4; ++i) rec_chunk(L + ((q & 1) * 4 + i) * BUF_BYTES, st, Y, b, h, dir, 4 * q + i, wave, lane);
            }
        } else if (q + 1 < NR) {
            const int hw = wave - 4;
            helper_chunk(L, L + (((q + 1) & 1) * 4 + hw) * BUF_BYTES, (LAS float*)(L + OFF_MT + hw * 1024), Z, BON, b, h, dir, 4 * (q + 1) + hw, lane);
        }
        __syncthreads();
    }
}
}

namespace attn {
typedef unsigned u32x2 __attribute__((ext_vector_type(2)));
constexpr int VT_STRIDE = 136;
constexpr int WAVE_LDS = 64 * VT_STRIDE;
constexpr float LOG2E = 1.44269504088896f, LN2 = 0.693147180559945f;
using scan::cvtpk; using scan::mkfrag; using scan::mma;

__device__ __forceinline__ void unpack8(const v4u w, float (&f)[8]) {
    f[0] = __uint_as_float(w.x << 16); f[1] = __uint_as_float(w.x & 0xffff0000u); f[2] = __uint_as_float(w.y << 16); f[3] = __uint_as_float(w.y & 0xffff0000u);
    f[4] = __uint_as_float(w.z << 16); f[5] = __uint_as_float(w.z & 0xffff0000u); f[6] = __uint_as_float(w.w << 16); f[7] = __uint_as_float(w.w & 0xffff0000u);
}

__device__ __forceinline__ void unit(LAS unsigned char* vt, const bf16* Z, const float* qg, const float* kg, bf16* Ob, int opitch, float* lse_out,
                                     int b, int h, int d, int r, int qb, int nb, int lane) {
    const int g = lane >> 4, c16 = lane & 15;
    const float slope2 = exp2f(-(float)(h + 1)) * LOG2E * (float)d;
    float gn[16];
#pragma unroll
    for (int m = 0; m < 2; ++m)
#pragma unroll
        for (int j = 0; j < 8; ++j) gn[m * 8 + j] = qg[32 * m + 8 * g + j] * kg[32 * m + 8 * g + j];
    bf16x8 qf[4][2];
#pragma unroll
    for (int qt = 0; qt < 4; ++qt) {
        const int tok = b * SEQ + (qb * 64 + 16 * qt + c16) * d + r;
        const bf16* qp = Z + (size_t)tok * INW + h * 64 + 8 * g;
        float f0[8], f1[8]; unpack8(*(const v4u*)qp, f0); unpack8(*(const v4u*)(qp + 32), f1);
        float ss = 0.f;
#pragma unroll
        for (int j = 0; j < 8; ++j) ss += f0[j] * f0[j] + f1[j] * f1[j];
        ss += __shfl_xor(ss, 16); ss += __shfl_xor(ss, 32);
        const float rs = (0.125f * LOG2E) / sqrtf(ss * (1.f / 64.f) + 1e-6f);
        qf[qt][0] = mkfrag(cvtpk(f0[0] * rs * gn[0], f0[1] * rs * gn[1]), cvtpk(f0[2] * rs * gn[2], f0[3] * rs * gn[3]), cvtpk(f0[4] * rs * gn[4], f0[5] * rs * gn[5]), cvtpk(f0[6] * rs * gn[6], f0[7] * rs * gn[7]));
        qf[qt][1] = mkfrag(cvtpk(f1[0] * rs * gn[8], f1[1] * rs * gn[9]), cvtpk(f1[2] * rs * gn[10], f1[3] * rs * gn[11]), cvtpk(f1[4] * rs * gn[12], f1[5] * rs * gn[13]), cvtpk(f1[6] * rs * gn[14], f1[7] * rs * gn[15]));
    }
    f32x4 oacc[4][4];
    float mrun[4], lrun[4];
#pragma unroll
    for (int qt = 0; qt < 4; ++qt) { mrun[qt] = -1e30f; lrun[qt] = 0.f;
#pragma unroll
        for (int dt = 0; dt < 4; ++dt) oacc[dt][qt] = (f32x4){0.f, 0.f, 0.f, 0.f}; }
    const f32x4 z4 = {0.f, 0.f, 0.f, 0.f};
#pragma unroll 1
    for (int kb = qb - 1; kb <= qb + 1; ++kb) {
        if (kb < 0 || kb >= nb) continue;
        bf16x8 kf[4][2];
#pragma unroll
        for (int kblk = 0; kblk < 4; ++kblk) {
            const int tok = b * SEQ + (kb * 64 + 16 * kblk + c16) * d + r;
            const bf16* kp = Z + (size_t)tok * INW + AW + h * 64 + 8 * g;
            float f0[8], f1[8]; unpack8(*(const v4u*)kp, f0); unpack8(*(const v4u*)(kp + 32), f1);
            float ss = 0.f;
#pragma unroll
            for (int j = 0; j < 8; ++j) ss += f0[j] * f0[j] + f1[j] * f1[j];
            ss += __shfl_xor(ss, 16); ss += __shfl_xor(ss, 32);
            const float rsk = 1.0f / sqrtf(ss * (1.f / 64.f) + 1e-6f);
            kf[kblk][0] = mkfrag(cvtpk(f0[0] * rsk, f0[1] * rsk), cvtpk(f0[2] * rsk, f0[3] * rsk), cvtpk(f0[4] * rsk, f0[5] * rsk), cvtpk(f0[6] * rsk, f0[7] * rsk));
            kf[kblk][1] = mkfrag(cvtpk(f1[0] * rsk, f1[1] * rsk), cvtpk(f1[2] * rsk, f1[3] * rsk), cvtpk(f1[4] * rsk, f1[5] * rsk), cvtpk(f1[6] * rsk, f1[7] * rsk));
        }
#pragma unroll
        for (int i = 0; i < 8; ++i) {
            const int key = 8 * i + (lane >> 3), chunk = lane & 7;
            const int tok = b * SEQ + (kb * 64 + key) * d + r;
            const v4u w = *(const v4u*)(Z + (size_t)tok * INW + 2 * AW + h * 64 + 8 * chunk);
            LAS unsigned char* q = vt + (8 * chunk) * VT_STRIDE + 2 * key;
            *(LAS bf16*)(q + 0 * VT_STRIDE) = (bf16)(w.x & 0xffffu); *(LAS bf16*)(q + 1 * VT_STRIDE) = (bf16)(w.x >> 16);
            *(LAS bf16*)(q + 2 * VT_STRIDE) = (bf16)(w.y & 0xffffu); *(LAS bf16*)(q + 3 * VT_STRIDE) = (bf16)(w.y >> 16);
            *(LAS bf16*)(q + 4 * VT_STRIDE) = (bf16)(w.z & 0xffffu); *(LAS bf16*)(q + 5 * VT_STRIDE) = (bf16)(w.z >> 16);
            *(LAS bf16*)(q + 6 * VT_STRIDE) = (bf16)(w.w & 0xffffu); *(LAS bf16*)(q + 7 * VT_STRIDE) = (bf16)(w.w >> 16);
        }
        asm volatile("s_waitcnt lgkmcnt(0)" ::: "memory"); __builtin_amdgcn_wave_barrier();
        const int obase = (kb - qb) * 64;
#pragma unroll
        for (int qt = 0; qt < 4; ++qt) {
            f32x4 sa[4];
#pragma unroll
            for (int kblk = 0; kblk < 4; ++kblk) { sa[kblk] = mma(kf[kblk][0], qf[qt][0], z4); sa[kblk] = mma(kf[kblk][1], qf[qt][1], sa[kblk]); }
            const int qi = 16 * qt + c16;
            float mx = -1e30f;
#pragma unroll
            for (int kblk = 0; kblk < 4; ++kblk)
#pragma unroll
                for (int reg = 0; reg < 4; ++reg) {
                    const int o = obase + 16 * kblk + 4 * g + reg - qi, ao = o < 0 ? -o : o;
                    float sv = sa[kblk][reg] - slope2 * (float)ao;
                    sv = (ao <= 64) ? sv : -1e30f;
                    sa[kblk][reg] = sv; mx = fmaxf(mx, sv);
                }
            mx = fmaxf(mx, __shfl_xor(mx, 16)); mx = fmaxf(mx, __shfl_xor(mx, 32));
            const float mn = fmaxf(mrun[qt], mx), alpha = exp2f(mrun[qt] - mn);
            mrun[qt] = mn;
            float ls = 0.f;
#pragma unroll
            for (int kblk = 0; kblk < 4; ++kblk)
#pragma unroll
                for (int reg = 0; reg < 4; ++reg) { const float p = exp2f(sa[kblk][reg] - mn); sa[kblk][reg] = p; ls += p; }
            lrun[qt] = lrun[qt] * alpha + ls;
            const bf16x8 pf0 = mkfrag(cvtpk(sa[0][0], sa[0][1]), cvtpk(sa[0][2], sa[0][3]), cvtpk(sa[1][0], sa[1][1]), cvtpk(sa[1][2], sa[1][3]));
            const bf16x8 pf1 = mkfrag(cvtpk(sa[2][0], sa[2][1]), cvtpk(sa[2][2], sa[2][3]), cvtpk(sa[3][0], sa[3][1]), cvtpk(sa[3][2], sa[3][3]));
#pragma unroll
            for (int dt = 0; dt < 4; ++dt) {
                const LAS unsigned char* vr = vt + (16 * dt + c16) * VT_STRIDE + 8 * g;
                const u32x2 a0 = *(const LAS u32x2*)(vr), a1 = *(const LAS u32x2*)(vr + 32), a2 = *(const LAS u32x2*)(vr + 64), a3 = *(const LAS u32x2*)(vr + 96);
                f32x4 oc = oacc[dt][qt] * alpha;
                oc = mma(mkfrag(a0.x, a0.y, a1.x, a1.y), pf0, oc);
                oc = mma(mkfrag(a2.x, a2.y, a3.x, a3.y), pf1, oc);
                oacc[dt][qt] = oc;
            }
            __builtin_amdgcn_sched_barrier(0);
        }
        asm volatile("s_waitcnt lgkmcnt(0)" ::: "memory"); __builtin_amdgcn_wave_barrier();
    }
#pragma unroll
    for (int qt = 0; qt < 4; ++qt) {
        float lt = lrun[qt]; lt += __shfl_xor(lt, 16); lt += __shfl_xor(lt, 32);
        const float inv = 1.0f / lt;
        const int tok = b * SEQ + (qb * 64 + 16 * qt + c16) * d + r;
        bf16* op = Ob + (size_t)tok * opitch + h * 64 + 4 * g;
#pragma unroll
        for (int dt = 0; dt < 4; ++dt) { const f32x4 o = oacc[dt][qt] * inv; u32x2 w; w.x = cvtpk(o[0], o[1]); w.y = cvtpk(o[2], o[3]); *(u32x2*)(op + 16 * dt) = w; }
        if (g == 0) lse_out[(size_t)tok * NH + h] = (mrun[qt] + log2f(lt)) * LN2;
    }
}
}

#ifndef MK_SKIP
#define MK_SKIP 0
#endif
constexpr int N_PHASES = 10;
struct Args { const float* in[27]; float* out; unsigned char* ws; int ph_lo, ph_hi, li, pad; };

__global__ void __launch_bounds__(NWAVES * 64, 2) mk_fwd(Args args) {
    extern __shared__ __attribute__((aligned(16))) unsigned char lds[];
    LAS unsigned char* L = (LAS unsigned char*)lds;
    volatile LAS unsigned* MISC = (volatile LAS unsigned*)(L + MISC_OFF);
    const int tid = threadIdx.x, lane = tid & 63, wave = __builtin_amdgcn_readfirstlane(tid >> 6);
    const int G = gridDim.x, bx = blockIdx.x;
    unsigned char* ws = args.ws;
    gu32* ctl = (gu32*)(ws + WS_CTL);
    const float* x = args.in[0]; const float* cvec = args.in[1]; const float* ada_w = args.in[2]; const float* ada_b = args.in[3];
    const float* norm1_g = args.in[4]; const float* w_in = args.in[5]; const float* mu_prev = args.in[6]; const float* mu_next = args.in[7];
    const float* q_norm_g = args.in[8]; const float* k_norm_g = args.in[9]; const float* w_decay0 = args.in[10]; const float* w_decay_up = args.in[11];
    const float* a_gate0 = args.in[12]; const float* a_gate_up = args.in[13]; const float* g_up = args.in[14]; const float* k_k = args.in[15];
    const float* k_a = args.in[16]; const float* r_k = args.in[17]; const float* lnx_g = args.in[18]; const float* lnx_b = args.in[19];
    const float* w_out = args.in[20]; const float* norm2_g = args.in[21]; const float* w_query = args.in[22]; const float* keys1 = args.in[23];
    const float* keys2 = args.in[24]; const float* peer_u = args.in[25]; const float* peer_v = args.in[26];
    float* out = args.out;
    float* MOD = (float*)(ws + WS_MOD); bf16* KEYS = (bf16*)(ws + WS_KEYS); bf16* WIN = (bf16*)(ws + WS_WIN); bf16* WOUT = (bf16*)(ws + WS_WOUT); bf16* WQ = (bf16*)(ws + WS_WQ);
    bf16* XN = (bf16*)(ws + WS_XN); bf16* Z = (bf16*)(ws + WS_Z); bf16* MIX = (bf16*)(ws + WS_MIX); float* Y = (float*)(ws + WS_Y); bf16* Q = (bf16*)(ws + WS_Q);
    int* IDX = (int*)(ws + WS_IDX); float* GATE = (float*)(ws + WS_GATE); float* BON = (float*)(ws + WS_BON);
    bf16* O3 = (bf16*)(ws + WS_O3); float* LSE = (float*)(ws + WS_LSE);

    for (int u = tid; u < (LDS_BYTES - LDSCTL_OFF) / 4; u += NWAVES * 64) ((LAS unsigned*)(L + LDSCTL_OFF))[u] = 0u;
    __syncthreads();
    XcdBarrier bar = xcd_barrier_post((unsigned*)(ctl + CW_BAR) + args.li * XCD_BAR_WORDS, MISC + 8);
    const int lo = args.ph_lo, hi = args.ph_hi;
#define IN(k) (lo <= (k) && (k) < hi)
#define SEAM(k) do { if (IN(k) && IN((k) + 1)) xcd_barrier(bar); } while (0)
    const int gw = bx * NWAVES + wave, NGW = G * NWAVES;

    if (IN(0) && !(MK_SKIP & (1 << 0))) {
        if (bx < MODW / 64) {
            LAS float* sc = (LAS float*)L; LAS float* part = (LAS float*)(L + 32768);
            for (int i = tid; i < BATCH * D; i += NWAVES * 64) { const float cv = cvec[i]; sc[i] = cv / (1.f + expf(-cv)); }
            __syncthreads();
            const int j0 = bx * 64;
            float acc[BATCH];
#pragma unroll
            for (int b = 0; b < BATCH; ++b) acc[b] = 0.f;
            for (int i = wave * 128; i < wave * 128 + 128; ++i) { const float w = ada_w[(size_t)i * MODW + j0 + lane];
#pragma unroll
                for (int b = 0; b < BATCH; ++b) acc[b] += sc[b * D + i] * w; }
#pragma unroll
            for (int b = 0; b < BATCH; ++b) part[(wave * 8 + b) * 64 + lane] = acc[b];
            __syncthreads();
            { const int b = tid >> 6; float s = 0.f;
#pragma unroll
              for (int w = 0; w < 8; ++w) s += part[(w * 8 + b) * 64 + lane];
              MOD[b * MODW + j0 + lane] = s + ada_b[j0 + lane]; }
            __syncthreads();
        }
        LAS float* scr = (LAS float*)(L + RING_OFF + wave * 16384);
        constexpr int I_IN = (D / 64) * (INW / 32), I_OUT = (D / 64) * (D / 32), I_Q = (D / 64) * (QW / 32);
        for (int it = gw; it < I_IN + I_OUT + I_Q; it += NGW) {
            int r = it;
            if (r < I_IN) { p0_transpose_item(w_in, D, INW, WIN, 0, scr, r, lane); continue; } r -= I_IN;
            if (r < I_OUT) { p0_transpose_item(w_out, D, D, WOUT, 0, scr, r, lane); continue; } r -= I_OUT;
            p0_transpose_item(w_query, D, QW, WQ, 0, scr, r, lane);
        }
        for (int idx = bx * NWAVES * 64 + tid; idx < 256 * 256; idx += G * NWAVES * 64) {
            const int n = idx >> 8, k = idx & 255;
            float v = 0.f;
            if (n < 128) { if (k < 128) v = keys1[n * 128 + k]; } else { if (k >= 128) v = keys2[(n - 128) * 128 + (k - 128)]; }
            KEYS[idx] = (bf16)f2bf(v);
        }
    }
    SEAM(0);
    if (IN(1) && !(MK_SKIP & (1 << 1))) { for (int m = gw; m < T; m += NGW) norm_row(x + (size_t)m * D, norm1_g, MOD + (m / SEQ) * MODW, 0, D, XN + (size_t)m * D, lane); }
    SEAM(1);
    if (IN(2) && !(MK_SKIP & (1 << 2))) {
        pg8::Gemm g{XN, WIN, T, INW, D}; pg8::StaticOrder S; S.init(T, INW, G, bx);
        pg8::EpiBf16<0> E{Z, INW, nullptr, 0, 0, 1.f};
        pg8::gemm_phase<pg8::EpiBf16<0>, pg8::StaticOrder, true, true>(L + RING_OFF, g, S, E);
    }
    SEAM(2);
    if (IN(3) && !(MK_SKIP & (1 << 3))) {
        constexpr int NCHAIN = BATCH * NH * 2;
        if (bx < NCHAIN) {
            scan::chain(L, Z, mu_prev, mu_next, w_decay0, w_decay_up, a_gate0, a_gate_up, k_k, k_a, r_k, Y, BON, bx, tid, wave, lane);
        } else {
            const int wid = (bx - NCHAIN) * NWAVES + wave, nworkers = (G - NCHAIN) * NWAVES;
            LAS unsigned char* vt = L + wave * attn::WAVE_LDS;
            for (int u = wid; u < BATCH * NH * 96; u += nworkers) {
                const int x = u & 31, p = (u >> 5) % 3, bh = u / 96;
                const int d = (p == 0) ? 1 : (p == 1 ? 4 : 16), nb = 32 / d, r = x / nb, qb = x % nb;
                bf16* Ob = (p == 0) ? MIX : (p == 1 ? MIX + AW : O3); const int opitch = (p == 2) ? AW : D;
                attn::unit(vt, Z, q_norm_g, k_norm_g, Ob, opitch, LSE + (size_t)p * T * NH, bh >> 3, bh & 7, d, r, qb, nb, lane);
            }
        }
    }
    SEAM(3);
    if (IN(4) && !(MK_SKIP & (1 << 4))) { for (int tok = bx; tok < T; tok += G) rwkv_fin_token(Z, mu_prev, mu_next, g_up, Y, BON, k_a, r_k, lnx_g, lnx_b, MIX, O3, LSE, tok, tid, (LAS float*)L); }
    SEAM(4);
    if (IN(5) && !(MK_SKIP & (1 << 5))) {
        pg8::Gemm g{MIX, WOUT, T, D, D}; pg8::StaticOrder S; S.init(T, D, G, bx);
        EpiRes E{x, MOD, 2 * D, out, D};
        pg8::gemm_phase<EpiRes, pg8::StaticOrder, true, true>(L + RING_OFF, g, S, E);
    }
    SEAM(5);
    if (IN(6) && !(MK_SKIP & (1 << 6))) { for (int m = gw; m < T; m += NGW) norm_row(out + (size_t)m * D, norm2_g, MOD + (m / SEQ) * MODW, 3 * D, 4 * D, XN + (size_t)m * D, lane); }
    SEAM(6);
    if (IN(7) && !(MK_SKIP & (1 << 7))) {
        pg8::Gemm g{XN, WQ, T, QW, D}; pg8::StaticOrder S; S.init(T, QW, G, bx);
        pg8::EpiBf16<0> E{Q, QW, nullptr, 0, 0, 1.f};
        pg8::gemm_phase<pg8::EpiBf16<0>, pg8::StaticOrder, true, true>(L + RING_OFF, g, S, E);
    }
    SEAM(7);
    if (IN(8) && !(MK_SKIP & (1 << 8))) { for (int th = gw; th < T * PH; th += NGW) peer_select_item(Q, keys1, keys2, IDX, GATE, th, lane); }
    SEAM(8);
    if (IN(9) && !(MK_SKIP & (1 << 9))) { for (int tok = gw; tok < T; tok += NGW) peer_ffn_token(XN, IDX, GATE, peer_u, peer_v, MOD, out, tok, lane); }
#undef IN
#undef SEAM
}

extern "C" void kernel_launch(void* const* d_in, const int* in_sizes, int n_in, void* d_out, int out_size, void* d_ws, size_t ws_size, hipStream_t stream) {
    static int grid = 0;
    if (grid == 0) {
        if (n_in != 27 || in_sizes[0] != T * D || out_size != T * D || ws_size < WS_END) { fprintf(stderr, "kernel_launch: unexpected problem (n_in %d, in0 %d, out %d, ws %zu); nothing launched\n", n_in, n_in > 0 ? in_sizes[0] : -1, out_size, ws_size); grid = -1; return; }
        int dev = 0, cus = 0, per_cu = 0;
        if (hipGetDevice(&dev) != hipSuccess || hipDeviceGetAttribute(&cus, hipDeviceAttributeMultiprocessorCount, dev) != hipSuccess) { fprintf(stderr, "kernel_launch: device query failed\n"); grid = -1; return; }
        if (hipFuncSetAttribute((const void*)mk_fwd, hipFuncAttributeMaxDynamicSharedMemorySize, LDS_BYTES) != hipSuccess) { fprintf(stderr, "kernel_launch: hipFuncSetAttribute failed\n"); grid = -1; return; }
        if (hipOccupancyMaxActiveBlocksPerMultiprocessor(&per_cu, (const void*)mk_fwd, NWAVES * 64, LDS_BYTES) != hipSuccess || per_cu < 1)
            fprintf(stderr, "kernel_launch: note: occupancy query reports %d workgroups per CU\n", per_cu);
        (void)hipGetLastError();
        grid = cus;
    }
    if (grid < 0) return;
    if (hipMemsetAsync((char*)d_ws + WS_CTL, 0, CTL_ZERO_BYTES, stream) != hipSuccess) { fprintf(stderr, "kernel_launch: hipMemsetAsync failed\n"); return; }
    Args a{};
    for (int i = 0; i < 27; ++i) a.in[i] = (const float*)d_in[i];
    a.out = (float*)d_out; a.ws = (unsigned char*)d_ws;
#ifndef MK_CUTS
#define MK_CUTS {0, N_PHASES}
#endif
    const int cuts[] = MK_CUTS;
    const int nl = (int)(sizeof(cuts) / sizeof(int)) - 1;
    for (int li = 0; li < nl; ++li) {
        a.ph_lo = cuts[li]; a.ph_hi = cuts[li + 1]; a.li = li;
        hipLaunchKernelGGL(mk_fwd, dim3(grid), dim3(NWAVES * 64), LDS_BYTES, stream, a);
        const hipError_t le = hipPeekAtLastError();
        if (le != hipSuccess) { fprintf(stderr, "kernel_launch: launch %d failed: %s\n", li, hipGetErrorName(le)); break; }
    }
}
```

```cpp
#include <hip/hip_runtime.h>
#include <cstdio>
#include <cstdint>
#include <cmath>
namespace pg8 {
#define PG8_LAS __attribute__((address_space(3)))
typedef unsigned short bf16_t;
typedef short bf16x8 __attribute__((ext_vector_type(8)));
typedef float f32x4 __attribute__((ext_vector_type(4)));
typedef unsigned u32x4 __attribute__((ext_vector_type(4)));
constexpr int BM = 256, BK = 64, HALF = 128, HTB = HALF * BK * 2  , STAGE_BYTES = 8 * HTB, NXCD = 8, WGM = 8;

__host__ __device__ __forceinline__ int lds_byte(int r, int c) { const int st = (r >> 4) * 2 + (c >> 5), rr = r & 15, cc = c & 31, ob = rr * 64 + cc * 2; return st * 1024 + (ob ^ (((ob >> 9) & 1) << 5)); }
__host__ __device__ __forceinline__ void stage_rc(int b, int& R, int& C) { const int st = b / 1024, sb = b % 1024, swz = sb ^ (((sb >> 9) & 1) << 5); R = (st >> 1) * 16 + swz / 64; C = (st & 1) * 32 + (swz % 64) / 2; }
__host__ __device__ __forceinline__ int perm32(int rho) { const int n = rho >> 4, i = rho & 15; return 8 * (i >> 2) + 4 * n + (i & 3); }

struct Unit { int pm, pn; };
struct Gemm { const bf16_t* A; const bf16_t* Bt; int M, N, K; };

struct StaticOrder {
    int nM, nN, nwg, G, c;
    __host__ __device__ void init(int M, int N, int G_, int c_) { nM = M / BM; nN = N / BM; nwg = nM * nN; G = G_; c = c_; }
    __host__ __device__ bool next(int i, Unit& u) const {
        const long L = (long)i * G + c; if (L >= nwg) return false;
        int wgid = (int)L; { const int q = nwg / NXCD, r = nwg % NXCD, xcd = wgid % NXCD, off = wgid / NXCD; wgid = (xcd < r ? xcd * (q + 1) : r * (q + 1) + (xcd - r) * q) + off; }
        const int nig = WGM * nN, gid = wgid / nig, fm = gid * WGM, gsz = (nM - fm) < WGM ? (nM - fm) : WGM;
        u.pm = fm + ((wgid % nig) % gsz); u.pn = (wgid % nig) / gsz; return true;
    }
    __device__ __forceinline__ void a_ready(const Unit&) const {}
    __device__ __forceinline__ void done(const Unit&) const {}
};

__device__ __forceinline__ unsigned cvt_pk_bf16(float lo, float hi) { unsigned r; asm volatile("v_cvt_pk_bf16_f32 %0, %1, %2" : "=v"(r) : "v"(lo), "v"(hi)); return r; }
typedef float f32x2 __attribute__((ext_vector_type(2)));
__device__ __forceinline__ f32x2 gelu_pk(f32x2 v) {
    const f32x2 av = __builtin_elementwise_abs(v), d = av * 0.2316418882f + 1.0f;
    f32x2 t; t.x = __builtin_amdgcn_rcpf(d.x); t.y = __builtin_amdgcn_rcpf(d.y);
    f32x2 q = t * 0.5307027145f + (-0.7265760135f); q = q * t + 0.7107068705f; q = q * t + (-0.142248368f); q = q * t + 0.127414796f; q = q * t;
    const f32x2 s = (v * v) * (-0.72134752044f);
    f32x2 e; e.x = __builtin_amdgcn_exp2f(s.x); e.y = __builtin_amdgcn_exp2f(s.y);
    const f32x2 m = v * (q * e), r = v - m;
    f32x2 o; o.x = v.x < 0.f ? m.x : r.x; o.y = v.y < 0.f ? m.y : r.y; return o;
}

template <int ACT  > struct EpiBf16 {
    static constexpr bool PERM = true, AFTER_DRAIN = false; static_assert(ACT == 0 || ACT == 1, "EpiBf16: ACT is 0 (none) or 1 (gelu_pk)");
    bf16_t* O; int ldc; const float* bias; int split_cols; size_t split_stride; float scale0;
    __device__ __forceinline__ void operator()(const f32x4 (&acc)[2][2][4][2], const Unit& u, int wr, int wc, int fr, int fq) const {
        const int row0 = u.pm * BM + wr * 64 + fr; int colt = u.pn * BM; bf16_t* base = O;
        float sc = 1.f; if (split_cols) { const int t = colt / split_cols; base += (size_t)t * split_stride; colt -= t * split_cols; if (t == 0) sc = scale0; }
        const int col0 = colt + wc * 32 + 8 * fq, bcol0 = u.pn * BM + wc * 32 + 8 * fq;
        f32x4 bv[2][2];
#pragma unroll
        for (int bj = 0; bj < 2; ++bj)
#pragma unroll
            for (int n = 0; n < 2; ++n) bv[bj][n] = bias ? *(const f32x4*)(bias + bcol0 + bj * HALF + 4 * n) : (f32x4){0.f, 0.f, 0.f, 0.f};
#pragma unroll
        for (int ai = 0; ai < 2; ++ai)
#pragma unroll
            for (int m = 0; m < 4; ++m) { bf16_t* rowp = base + (size_t)(row0 + ai * HALF + m * 16) * ldc + col0;
#pragma unroll
                for (int bj = 0; bj < 2; ++bj) { f32x4 v0 = acc[ai][bj][m][0] + bv[bj][0], v1 = acc[ai][bj][m][1] + bv[bj][1];
                    if (ACT == 1) { f32x2 a = gelu_pk((f32x2){v0[0], v0[1]}), b = gelu_pk((f32x2){v0[2], v0[3]}), c = gelu_pk((f32x2){v1[0], v1[1]}), d = gelu_pk((f32x2){v1[2], v1[3]});
                        v0 = (f32x4){a.x, a.y, b.x, b.y}; v1 = (f32x4){c.x, c.y, d.x, d.y}; }
                    v0 = v0 * sc; v1 = v1 * sc; u32x4 w; w.x = cvt_pk_bf16(v0[0], v0[1]); w.y = cvt_pk_bf16(v0[2], v0[3]); w.z = cvt_pk_bf16(v1[0], v1[1]); w.w = cvt_pk_bf16(v1[2], v1[3]);
                    *(u32x4*)(rowp + bj * HALF) = w; } }
    }
};

template <class Epi, class Sched, bool ALIGN_EPI = false, bool SP2 = false>
__device__ __forceinline__ void gemm_phase(PG8_LAS unsigned char* lds, const Gemm g, const Sched& S, const Epi& E) {
    const int tid = threadIdx.x, wid = __builtin_amdgcn_readfirstlane(tid >> 6), lane = tid & 63, wr = wid >> 2, wc = wid & 3, fr = lane & 15, fq = lane >> 4;
    const int K = g.K, nt = K / BK;
    unsigned voffA[2], voffB[2];
#pragma unroll
    for (int i = 0; i < 2; ++i) { int R, C; stage_rc(tid * 16 + i * 8192, R, C); const int Rb = Epi::PERM ? ((R & ~31) + perm32(R & 31)) : R;
        voffA[i] = (unsigned)(R * K + C) * 2u; voffB[i] = (unsigned)(Rb * K + C) * 2u; }
    const size_t kstep = (size_t)(BK * 2);
    const size_t hstep = (size_t)HALF * K * 2;
    const size_t tstep = 2 * hstep;
    const unsigned ldsw = (unsigned)wid * 1024u;
    const int aoff = lds_byte(wr * 64 + fr, fq * 8), boff = lds_byte(wc * 32 + fr, fq * 8);
#define PG8_SA(b, h) (((b) * 2 + (h)) * HTB)
#define PG8_SB(b, h) ((4 + (b) * 2 + (h)) * HTB)
#define PG8_STAGE(bufoff, gbase, voff) do { _Pragma("unroll") for (int _i = 0; _i < 2; ++_i) \
        __builtin_amdgcn_global_load_lds((const unsigned*)((const char*)(gbase) + (voff)[_i]), (PG8_LAS unsigned*)(lds + (bufoff) + ldsw + _i * 8192), 16, 0, 0); } while (0)
#define PG8_LDA(dst, b, h) do { _Pragma("unroll") for (int m = 0; m < 4; ++m) _Pragma("unroll") for (int k = 0; k < 2; ++k) dst[m][k] = *(const PG8_LAS bf16x8*)(lds + PG8_SA(b, h) + aoff + m * 2048 + k * 1024); } while (0)
#define PG8_LDB(dst, b, h) do { _Pragma("unroll") for (int n = 0; n < 2; ++n) _Pragma("unroll") for (int k = 0; k < 2; ++k) dst[n][k] = *(const PG8_LAS bf16x8*)(lds + PG8_SB(b, h) + boff + n * 2048 + k * 1024); } while (0)
#define PG8_MMA(ai, bj, At, Bt) do { __builtin_amdgcn_s_setprio(1); _Pragma("unroll") for (int m = 0; m < 4; ++m) _Pragma("unroll") for (int n = 0; n < 2; ++n) _Pragma("unroll") for (int k = 0; k < 2; ++k) \
        acc[ai][bj][m][n] = __builtin_amdgcn_mfma_f32_16x16x32_bf16(Bt[n][k], At[m][k], acc[ai][bj][m][n], 0, 0, 0); __builtin_amdgcn_s_setprio(0); } while (0)
#define PG8_WAIT_V(n) asm volatile("s_waitcnt vmcnt(" #n ")" ::: "memory")
#define PG8_WAIT_L(n) asm volatile("s_waitcnt lgkmcnt(" #n ")" ::: "memory")
#define PG8_BAR __builtin_amdgcn_s_barrier()
#define PG8_SCHED __builtin_amdgcn_sched_barrier(0)
    Unit cur, nxt; int ui = 0;
    if (!S.next(0, cur)) return;
    f32x4 acc[2][2][4][2];
#pragma unroll
    for (int a = 0; a < 2; ++a)
#pragma unroll
        for (int b = 0; b < 2; ++b)
#pragma unroll
            for (int m = 0; m < 4; ++m)
#pragma unroll
                for (int n = 0; n < 2; ++n) acc[a][b][m][n] = (f32x4){0.f, 0.f, 0.f, 0.f};
    bf16x8 At[4][2], B0[2][2], B1[2][2];
    const char* cA = (const char*)g.A + (size_t)cur.pm * tstep; const char* cB = (const char*)g.Bt + (size_t)cur.pn * tstep;
    S.a_ready(cur);
    if constexpr (SP2) {
        PG8_STAGE(PG8_SB(0, 0), cB, voffB); PG8_STAGE(PG8_SB(0, 1), cB + hstep, voffB); PG8_STAGE(PG8_SA(0, 0), cA, voffA); PG8_STAGE(PG8_SA(0, 1), cA + hstep, voffA);
        if (wr == 1) PG8_BAR;
        PG8_WAIT_V(2); PG8_BAR;
        PG8_STAGE(PG8_SB(1, 0), cB + kstep, voffB); PG8_STAGE(PG8_SA(1, 0), cA + kstep, voffA); PG8_STAGE(PG8_SB(1, 1), cB + hstep + kstep, voffB);
        PG8_WAIT_V(6); PG8_BAR;
    } else {
        PG8_STAGE(PG8_SB(0, 0), cB, voffB); PG8_STAGE(PG8_SA(0, 0), cA, voffA); PG8_STAGE(PG8_SB(0, 1), cB + hstep, voffB); PG8_STAGE(PG8_SA(0, 1), cA + hstep, voffA);
        if (wr == 1) PG8_BAR;
        PG8_WAIT_V(4); PG8_BAR;
        PG8_STAGE(PG8_SB(1, 0), cB + kstep, voffB); PG8_STAGE(PG8_SA(1, 0), cA + kstep, voffA); PG8_STAGE(PG8_SB(1, 1), cB + hstep + kstep, voffB);
        PG8_WAIT_V(6); PG8_BAR;
    }
    for (;;) {
        const bool has_next = S.next(ui + 1, nxt);
        const char* nA = has_next ? (const char*)g.A + (size_t)nxt.pm * tstep : cA; const char* nB = has_next ? (const char*)g.Bt + (size_t)nxt.pn * tstep : cB;
        for (int t = 0; t < nt; t += 2) {
            const bool last = (t == nt - 2);
            const char* a1 = cA + (size_t)(t + 1) * kstep;
            const char* a2 = last ? nA : cA + (size_t)(t + 2) * kstep; const char* b2 = last ? nB : cB + (size_t)(t + 2) * kstep;
            const char* a3 = a2 + kstep; const char* b3 = b2 + kstep;
            if (last && has_next) S.a_ready(nxt);
            if constexpr (SP2) {
            PG8_LDB(B0, 0, 0); PG8_LDB(B1, 0, 1); PG8_SCHED; PG8_LDA(At, 0, 0); PG8_STAGE(PG8_SA(1, 1), a1 + hstep, voffA);
            PG8_WAIT_V(8); PG8_WAIT_L(0); PG8_BAR; PG8_MMA(0, 0, At, B0); PG8_MMA(0, 1, At, B1); PG8_BAR; PG8_SCHED;
            PG8_LDA(At, 0, 1); PG8_STAGE(PG8_SB(0, 0), b2, voffB); PG8_STAGE(PG8_SB(0, 1), b2 + hstep, voffB); PG8_STAGE(PG8_SA(0, 0), a2, voffA);
            PG8_WAIT_V(8); PG8_WAIT_L(0); PG8_BAR; PG8_MMA(1, 0, At, B0); PG8_MMA(1, 1, At, B1); PG8_BAR; PG8_SCHED;
            PG8_LDB(B0, 1, 0); PG8_LDB(B1, 1, 1); PG8_SCHED; PG8_LDA(At, 1, 0); PG8_STAGE(PG8_SA(0, 1), a2 + hstep, voffA);
            PG8_WAIT_V(8); PG8_WAIT_L(0); PG8_BAR; PG8_MMA(0, 0, At, B0); PG8_MMA(0, 1, At, B1); PG8_BAR; PG8_SCHED;
            PG8_LDA(At, 1, 1); PG8_STAGE(PG8_SB(1, 0), b3, voffB); PG8_STAGE(PG8_SB(1, 1), b3 + hstep, voffB); PG8_STAGE(PG8_SA(1, 0), a3, voffA);
            PG8_WAIT_V(8); PG8_WAIT_L(0); PG8_BAR; PG8_MMA(1, 0, At, B0); PG8_MMA(1, 1, At, B1); PG8_BAR; PG8_SCHED;
            } else {
            PG8_LDB(B0, 0, 0); PG8_SCHED; PG8_LDA(At, 0, 0); PG8_STAGE(PG8_SA(1, 1), a1 + hstep, voffA);
            PG8_WAIT_L(8); PG8_BAR; PG8_WAIT_L(0); PG8_MMA(0, 0, At, B0); PG8_BAR; PG8_SCHED;
            PG8_LDB(B1, 0, 1); PG8_STAGE(PG8_SB(0, 0), b2, voffB);
            PG8_BAR; PG8_WAIT_L(0); PG8_MMA(0, 1, At, B1); PG8_BAR;
            PG8_LDA(At, 0, 1); PG8_STAGE(PG8_SA(0, 0), a2, voffA);
            PG8_BAR; PG8_WAIT_L(0); PG8_MMA(1, 0, At, B0); PG8_BAR; PG8_SCHED;
            PG8_STAGE(PG8_SB(0, 1), b2 + hstep, voffB);
            PG8_WAIT_V(6); PG8_BAR; PG8_MMA(1, 1, At, B1); PG8_BAR;
            PG8_LDB(B0, 1, 0); PG8_SCHED; PG8_LDA(At, 1, 0); PG8_STAGE(PG8_SA(0, 1), a2 + hstep, voffA);
            PG8_WAIT_L(8); PG8_BAR; PG8_WAIT_L(0); PG8_MMA(0, 0, At, B0); PG8_BAR; PG8_SCHED;
            PG8_LDB(B1, 1, 1); PG8_STAGE(PG8_SB(1, 0), b3, voffB);
            PG8_BAR; PG8_WAIT_L(0); PG8_MMA(0, 1, At, B1); PG8_BAR;
            PG8_LDA(At, 1, 1); PG8_STAGE(PG8_SA(1, 0), a3, voffA);
            PG8_BAR; PG8_WAIT_L(0); PG8_MMA(1, 0, At, B0); PG8_BAR; PG8_SCHED;
            PG8_STAGE(PG8_SB(1, 1), b3 + hstep, voffB);
            PG8_WAIT_V(6); PG8_BAR; PG8_MMA(1, 1, At, B1); PG8_BAR;
            }
        }
        if constexpr (ALIGN_EPI) { if (wr == 0) PG8_BAR; }
        if constexpr (!Epi::AFTER_DRAIN) { E(acc, cur, wr, wc, fr, fq); S.done(cur); }
        if (!has_next) break;
#pragma unroll
        for (int a = 0; a < 2; ++a)
#pragma unroll
            for (int b = 0; b < 2; ++b)
#pragma unroll
                for (int m = 0; m < 4; ++m)
#pragma unroll
                    for (int n = 0; n < 2; ++n) acc[a][b][m][n] = (f32x4){0.f, 0.f, 0.f, 0.f};
        cur = nxt; cA = nA; cB = nB; ++ui;
        if constexpr (ALIGN_EPI) { if (wr == 1) PG8_BAR; }
    }
    PG8_WAIT_V(0);
    if constexpr (!ALIGN_EPI) { if (wr == 0) PG8_BAR; }
    PG8_BAR;
    if constexpr (Epi::AFTER_DRAIN) { E.fused(acc, cur, wr, wc, fr, fq, lds, wid, lane); S.done(cur); }
#undef PG8_SA
#undef PG8_SB
#undef PG8_STAGE
#undef PG8_LDA
#undef PG8_LDB
#undef PG8_MMA
#undef PG8_WAIT_V
#undef PG8_WAIT_L
#undef PG8_BAR
#undef PG8_SCHED
}
}
#define GAS __attribute__((address_space(1)))
#define LAS __attribute__((address_space(3)))
typedef unsigned short bf16;
typedef unsigned v4u __attribute__((ext_vector_type(4)));
typedef float f32x4 __attribute__((ext_vector_type(4)));
typedef short bf16x8 __attribute__((ext_vector_type(8)));
typedef GAS unsigned gu32;
typedef GAS unsigned long long gu64;
#define RLX_AGENT __ATOMIC_RELAXED, __HIP_MEMORY_SCOPE_AGENT
#define LDS_WAIT() asm volatile("s_waitcnt lgkmcnt(0)" ::: "memory")
#define VM_WAIT() asm volatile("s_waitcnt vmcnt(0)" ::: "memory")
__device__ __forceinline__ unsigned long long rt() { return __builtin_amdgcn_s_memrealtime(); }
__device__ __forceinline__ unsigned f2bf(float f) { unsigned u = __builtin_bit_cast(unsigned, f); return (u + 0x7fffu + ((u >> 16) & 1u)) >> 16; }
__device__ __forceinline__ unsigned pk2(float lo, float hi) { return f2bf(lo) | (f2bf(hi) << 16); }

#define XB_TMO      128
#define XB_XCNT(j)  (256  + 64 * (j))
#define XB_XSUB(j)  (1280 + 64 * (j))
#define XB_XGEN(j)  (2304 + 64 * (j))
#define XB_TOP      3328
#define XB_TOPGEN   3392
#define XCD_BAR_WORDS 3456
#define XB_SPIN_CAP (1u << 18)

__device__ __forceinline__ unsigned xb_ld(unsigned* p)              { return __hip_atomic_load(p, __ATOMIC_RELAXED, __HIP_MEMORY_SCOPE_AGENT); }
__device__ __forceinline__ unsigned xb_add(unsigned* p, unsigned v) { return __hip_atomic_fetch_add(p, v, __ATOMIC_RELAXED, __HIP_MEMORY_SCOPE_AGENT); }
__device__ __forceinline__ unsigned xb_xcc_id() { return (unsigned)__builtin_amdgcn_s_getreg((3 << 11) | 20) & 0xFu; }
#define XB_SPIN(cond, bar) do { unsigned _sp = 0; while (cond) { __builtin_amdgcn_s_sleep(1); \
    if ((++_sp & 255u) == 0u) { if (xb_ld(&(bar)[XB_TMO])) break; if (_sp > XB_SPIN_CAP) { atomicAdd(&(bar)[XB_TMO], 1u); break; } } } } while (0)

struct XcdBarrier {
    unsigned* bar; unsigned x;
    volatile LAS unsigned* st;
};

__device__ __forceinline__ XcdBarrier xcd_barrier_post(unsigned* bar, volatile LAS unsigned* st) {
    XcdBarrier b; b.bar = bar; b.x = xb_xcc_id(); b.st = st;
    if (threadIdx.x == 0) (void)xb_add(&bar[XB_XCNT(b.x)], 1u);
    return b;
}
__device__ __forceinline__ void xcd_barrier_complete(unsigned* bar, unsigned x, unsigned& nloc, unsigned& nx) {
    const unsigned G = gridDim.x * gridDim.y * gridDim.z;
    unsigned sum, cnt, mine, sp = 0u;
    for (;;) {
        sum = 0u; cnt = 0u; mine = 0u;
#pragma unroll
        for (unsigned j = 0; j < 16; ++j) { const unsigned c = xb_ld(&bar[XB_XCNT(j)]); sum += c; cnt += (c > 0u) ? 1u : 0u; mine = (j == x) ? c : mine; }
        if (sum == G) break;
        __builtin_amdgcn_s_sleep(1);
        if ((++sp & 255u) == 0u) { if (xb_ld(&bar[XB_TMO])) break; if (sp > XB_SPIN_CAP) { atomicAdd(&bar[XB_TMO], 1u); break; } }
    }
    nloc = mine > 0u ? mine : 1u; nx = cnt > 0u ? cnt : 1u;
}

__device__ __forceinline__ void xcd_barrier(const XcdBarrier& b) {
    asm volatile("s_waitcnt vmcnt(0)" ::: "memory");
    __syncthreads();
    if (threadIdx.x == 0) {
        unsigned* bar = b.bar;
        __builtin_amdgcn_s_waitcnt(0);
        unsigned nloc = b.st[0], nx = b.st[1];
        if (nloc == 0u) { xcd_barrier_complete(bar, b.x, nloc, nx); b.st[0] = nloc; b.st[1] = nx; }
        const unsigned old = xb_add(&bar[XB_XSUB(b.x)], 1u);
        const unsigned gen = old / nloc;
        if (old + 1u == (gen + 1u) * nloc) {
            __builtin_amdgcn_fence(__ATOMIC_RELEASE, "agent");
            asm volatile("s_waitcnt vmcnt(0)" ::: "memory");
            const unsigned og = xb_add(&bar[XB_TOP], 1u);
            const unsigned tg = og / nx;
            if (og + 1u == (tg + 1u) * nx) xb_add(&bar[XB_TOPGEN], 1u);
            else XB_SPIN(xb_ld(&bar[XB_TOPGEN]) == tg, bar);
            __builtin_amdgcn_fence(__ATOMIC_ACQUIRE, "agent");
            xb_add(&bar[XB_XGEN(b.x)], 1u);
            asm volatile("s_waitcnt vmcnt(0)" ::: "memory");
        } else {
            XB_SPIN(xb_ld(&bar[XB_XGEN(b.x)]) == gen, bar);
            __builtin_amdgcn_fence(__ATOMIC_ACQUIRE, "agent");
            asm volatile("s_waitcnt vmcnt(0)" ::: "memory");
        }
    }
    __syncthreads();
}
constexpr int NWAVES = 8;
constexpr int D = 1024, BATCH = 8, SEQ = 2048, T = BATCH * SEQ;
constexpr int AW = 512, RW = 512, NH = 8;
constexpr int DL = 64, AL = 64, GL = 128;
constexpr int SHIFTW = 3 * RW + DL + AL + GL;
constexpr int INW = 3 * AW + SHIFTW;
constexpr int NKEYS = 128, PH = 8, PKD = 256, TOPK = 16, HK = PH * TOPK;
constexpr int QW = PH * PKD;
constexpr int MODW = 6 * D;

constexpr size_t MiB = 1u << 20;
constexpr size_t WS_CTL = 0, CTL_ZERO_BYTES = 1 * MiB;
constexpr size_t WS_MOD = 1 * MiB;
constexpr size_t WS_KEYS = 1 * MiB + 512 * 1024;
constexpr size_t WS_WIN = 2 * MiB;
constexpr size_t WS_WOUT = 9 * MiB;
constexpr size_t WS_WQ = 11 * MiB;
constexpr size_t WS_XN = 16 * MiB;
constexpr size_t WS_O3 = 16 * MiB;
constexpr size_t WS_LSE = 32 * MiB;
constexpr size_t WS_Z = 48 * MiB;
constexpr size_t WS_MIX = 152 * MiB;
constexpr size_t WS_Y = 184 * MiB;
constexpr size_t WS_Q = 48 * MiB;
constexpr size_t WS_IDX = 112 * MiB;
constexpr size_t WS_GATE = 120 * MiB;
constexpr size_t WS_UT = 152 * MiB;
constexpr size_t WS_VT = 184 * MiB;
constexpr size_t WS_BON = 248 * MiB;
constexpr size_t WS_END = 249 * MiB;
constexpr int CW_BAR = 4096;
constexpr int MAX_LAUNCHES = 12;

constexpr int RING_OFF = 0, RING_BYTES = 131072;
constexpr int LDSCTL_OFF = RING_BYTES, MISC_OFF = LDSCTL_OFF + 320;
constexpr int LDS_BYTES = 147456;

typedef GAS float gf32;
typedef GAS f32x4 gf32x4;

__device__ __forceinline__ float bf2f(bf16 v) { return __uint_as_float(((unsigned)v) << 16); }
__device__ __forceinline__ float wave_sum(float v) {
#pragma unroll
    for (int o = 1; o < 64; o <<= 1) v += __shfl_xor(v, o);
    return v;
}
#define WAVE_LDS_SYNC() do { asm volatile("s_waitcnt lgkmcnt(0)" ::: "memory"); __builtin_amdgcn_wave_barrier(); } while (0)

__device__ __forceinline__ void p0_transpose_item(const float* W, int K, int N, bf16* WT, int row_off, LAS float* scr, int item, int lane) {
    const int nblk = N / 32, kb = item / nblk, nb = item % nblk, k0 = 64 * kb, n0 = 32 * nb;
#pragma unroll 8
    for (int i = 0; i < 32; ++i) { const int kk = 2 * i + (lane >> 5); scr[kk * 33 + (lane & 31)] = W[(size_t)(k0 + kk) * N + n0 + (lane & 31)]; }
    LDS_WAIT(); asm volatile("" ::: "memory");
    const int c = lane & 7;
#pragma unroll
    for (int j = 0; j < 4; ++j) { const int n = (lane >> 3) + 8 * j; const LAS float* s = scr + (8 * c) * 33 + n;
        v4u o; o.x = pk2(s[0 * 33], s[1 * 33]); o.y = pk2(s[2 * 33], s[3 * 33]); o.z = pk2(s[4 * 33], s[5 * 33]); o.w = pk2(s[6 * 33], s[7 * 33]);
        *(GAS v4u*)(WT + (size_t)(row_off + n0 + n) * K + k0 + 8 * c) = o; }
    LDS_WAIT(); asm volatile("" ::: "memory");
}

__device__ __forceinline__ void norm_row(const float* xrow, const float* g, const float* modb, int shift_off, int scale_off, bf16* orow, int lane) {
    const GAS f32x4* xr = (const GAS f32x4*)xrow + lane;
    f32x4 v[4]; float s = 0.f;
#pragma unroll
    for (int j = 0; j < 4; ++j) { v[j] = xr[64 * j]; s += (v[j].x * v[j].x + v[j].y * v[j].y) + (v[j].z * v[j].z + v[j].w * v[j].w); }
    const float rs = 1.0f / sqrtf(wave_sum(s) * (1.f / D) + 1e-6f);
    GAS unsigned long long* o8 = (GAS unsigned long long*)orow + lane;
#pragma unroll
    for (int j = 0; j < 4; ++j) {
        const int col = 256 * j + 4 * lane;
        const f32x4 g4 = *(const GAS f32x4*)(g + col), sc = *(const GAS f32x4*)(modb + scale_off + col), sh = *(const GAS f32x4*)(modb + shift_off + col);
        const f32x4 y = v[j] * rs * g4 * (sc + 1.0f) + sh;
        o8[64 * j] = (unsigned long long)pk2(y.x, y.y) | ((unsigned long long)pk2(y.z, y.w) << 32);
    }
}

struct EpiRes {
    static constexpr bool PERM = false, AFTER_DRAIN = false;
    const float* xres; const float* mod; int gate_off; float* out; int ldc;
    __device__ __forceinline__ void operator()(const pg8::f32x4 (&acc)[2][2][4][2], const pg8::Unit& u, int wr, int wc, int fr, int fq) const {
        const int col0 = u.pn * pg8::BM + wc * 32 + 4 * fq;
        const int b = (u.pm * pg8::BM) / SEQ;
        pg8::f32x4 gv[2][2];
#pragma unroll
        for (int bj = 0; bj < 2; ++bj)
#pragma unroll
            for (int n = 0; n < 2; ++n) gv[bj][n] = *(const pg8::f32x4*)(mod + b * MODW + gate_off + col0 + bj * pg8::HALF + n * 16);
#pragma unroll
        for (int ai = 0; ai < 2; ++ai)
#pragma unroll
            for (int m = 0; m < 4; ++m) { const size_t off = (size_t)(u.pm * pg8::BM + ai * pg8::HALF + wr * 64 + m * 16 + fr) * ldc + col0;
#pragma unroll
                for (int bj = 0; bj < 2; ++bj)
#pragma unroll
                    for (int n = 0; n < 2; ++n) { const pg8::f32x4 bs = *(const pg8::f32x4*)(xres + off + bj * pg8::HALF + n * 16);
                        *(pg8::f32x4*)(out + off + bj * pg8::HALF + n * 16) = bs + gv[bj][n] * acc[ai][bj][m][n]; } }
    }
};

__device__ __forceinline__ float zshift(const bf16* Z, int tok, int t, int col, const float* mu_prev, const float* mu_next) {
    const bf16* zc = Z + (size_t)tok * INW + 3 * AW + col;
    const float z = bf2f(zc[0]);
    const float zp = (t > 0) ? bf2f(zc[-INW]) : 0.f;
    const float zn = (t < SEQ - 1) ? bf2f(zc[INW]) : 0.f;
    return z + mu_prev[col] * (zp - z) + mu_next[col] * (zn - z);
}
__device__ __forceinline__ float decay_of(float wl) {
    const float nx = -wl; const float sp = (nx > 20.f) ? nx : log1pf(expf(nx));
    return expf(-expf(-sp - 0.5f));
}

__device__ __forceinline__ void rwkv_fin_token(const bf16* Z, const float* mu_prev, const float* mu_next, const float* g_up,
                                               const float* Y, const float* BON, const float* k_a, const float* r_k, const float* lnx_g, const float* lnx_b, bf16* mix, const bf16* O3, const float* LSE, int tok, int c, LAS float* zr) {
    const int t = tok % SEQ;
    __syncthreads();
    for (int col = c; col < SHIFTW; col += 512) zr[col] = zshift(Z, tok, t, col, mu_prev, mu_next);
    __syncthreads();
    const size_t o = (size_t)tok * RW + c;
    const float y = Y[o] + Y[(size_t)T * RW + o];
    const float mean = wave_sum(y) * (1.f / 64.f);
    const float var = wave_sum((y - mean) * (y - mean)) * (1.f / 64.f);
    const float yn = (y - mean) * (1.0f / sqrtf(var + 64e-5f)) * lnx_g[c] + lnx_b[c];
    float g = 0.f;
#pragma unroll 4
    for (int j = 0; j < GL; ++j) g += (1.0f / (1.0f + expf(-zr[3 * RW + DL + AL + j]))) * g_up[(size_t)j * RW + c];
    const float r = zr[c], k = zr[RW + c], v = zr[2 * RW + c];
    const float bs = wave_sum(r * k * r_k[c] * (1.0f - k_a[c])) + 0.5f * (BON[(size_t)tok * NH + (c >> 6)] + BON[((size_t)T + tok) * NH + (c >> 6)]);
    const int hh = c >> 6;
    const float l1 = LSE[(size_t)tok * NH + hh], l2 = LSE[((size_t)T + tok) * NH + hh], l3 = LSE[((size_t)2 * T + tok) * NH + hh];
    const float lm = fmaxf(l1, fmaxf(l2, l3)), w1 = __expf(l1 - lm), w2 = __expf(l2 - lm), w3 = __expf(l3 - lm);
    const float att = (w1 * bf2f(mix[(size_t)tok * D + c]) + w2 * bf2f(mix[(size_t)tok * D + AW + c]) + w3 * bf2f(O3[(size_t)tok * AW + c])) / (w1 + w2 + w3);
    mix[(size_t)tok * D + c] = (bf16)f2bf(att);
    mix[(size_t)tok * D + AW + c] = (bf16)f2bf((yn + bs * v) * g);
}

namespace scan {
typedef unsigned u32x2 __attribute__((ext_vector_type(2)));
constexpr int SLOT = 1024, BUF_BYTES = 12800, NBUF = 8;
constexpr int OFF_LORA = NBUF * BUF_BYTES;
constexpr int OFF_CONST = OFF_LORA + 16 * SLOT;
constexpr int OFF_MT = OFF_CONST + 4096;
constexpr int SCAN_LDS = OFF_MT + 4 * 1024;
static_assert(SCAN_LDS <= 131072, "scan LDS map");
constexpr int S_KK = 0, S_R = 2, S_MT = 4, S_N = 5, S_BK = 6, S_V = 10, S_GC = 12;

typedef float f32x2n __attribute__((ext_vector_type(2)));
typedef __bf16 bf16x2n __attribute__((ext_vector_type(2)));
__device__ __forceinline__ unsigned cvtpk(float lo, float hi) { const f32x2n v = {lo, hi}; const bf16x2n b = __builtin_convertvector(v, bf16x2n); return __builtin_bit_cast(unsigned, b); }
__device__ __forceinline__ bf16x8 mkfrag(unsigned a, unsigned b, unsigned c, unsigned d) { v4u w; w.x = a; w.y = b; w.z = c; w.w = d; return __builtin_bit_cast(bf16x8, w); }
__device__ __forceinline__ bf16x8 frag8(const float (&lo)[4], const float (&hi)[4]) { return mkfrag(cvtpk(lo[0], lo[1]), cvtpk(lo[2], lo[3]), cvtpk(hi[0], hi[1]), cvtpk(hi[2], hi[3])); }
__device__ __forceinline__ f32x4 mma(bf16x8 a, bf16x8 b, f32x4 c) { return __builtin_amdgcn_mfma_f32_16x16x32_bf16(a, b, c, 0, 0, 0); }
template <int N> __device__ __forceinline__ float row_shr(float x) { return __int_as_float(__builtin_amdgcn_update_dpp(0, __float_as_int(x), 0x110 + N, 0xf, 0xf, true)); }
__device__ __forceinline__ float fsigmoid(float x) { return 1.0f / (1.0f + __expf(-x)); }

__device__ __forceinline__ void setup(LAS unsigned char* L, int h, int dir, const float* mu_prev, const float* mu_next, const float* w_decay0, const float* w_decay_up,
                                      const float* a_gate0, const float* a_gate_up, const float* k_k, const float* k_a, const float* r_k, int tid) {
    LAS float* C = (LAS float*)(L + OFF_CONST);
    for (int i = tid; i < 320; i += 512) {
        const int grp = i >> 6, c = i & 63;
        const int col = (grp < 3) ? grp * RW + h * 64 + c : 3 * RW + (grp - 3) * 64 + c;
        C[i] = mu_prev[col]; C[320 + i] = mu_next[col];
    }
    if (tid < 64) { const int hc = h * 64 + tid; C[640 + tid] = w_decay0[dir * RW + hc]; C[704 + tid] = a_gate0[dir * RW + hc]; C[768 + tid] = k_k[hc]; C[832 + tid] = k_a[hc]; C[896 + tid] = r_k[hc]; }
    LAS bf16* F = (LAS bf16*)(L + OFF_LORA);
    for (int i = tid; i < 16 * 64 * 8; i += 512) {
        const int j = i & 7, l = (i >> 3) & 63, sl = i >> 9, m = sl & 1, ct = (sl >> 1) & 3, wa = sl >> 3;
        const int g = l >> 4, jj = 32 * m + (j < 4 ? 4 * g + j : 16 + 4 * g + j - 4), c = h * 64 + 16 * ct + (l & 15);
        const float v = wa ? a_gate_up[(size_t)(dir * AL + jj) * RW + c] : w_decay_up[(size_t)(dir * DL + jj) * RW + c];
        F[i] = (bf16)f2bf(v);
    }
}

__device__ __forceinline__ void helper_chunk(LAS unsigned char* L, LAS unsigned char* buf, LAS float* MT, const bf16* Z, float* BON, int b, int h, int dir, int n, int lane) {
    const int s = lane & 15, g = lane >> 4;
    const int cn = dir ? (SEQ / 16 - 1 - n) : n;
    const int t = cn * 16 + (dir ? 15 - s : s), tok = b * SEQ + t;
    const LAS float* C = (const LAS float*)(L + OFF_CONST);
    const bool hasp = t > 0, hasn = t < SEQ - 1;
    const bf16* zrow = Z + (size_t)tok * INW + 3 * AW;
    float rv[4][4], kv[4][4], vv[4][4], tw[4][4], xa[4][4];
#pragma unroll
    for (int grp = 0; grp < 5; ++grp) {
        const int cbase = (grp < 3) ? grp * RW + h * 64 : 3 * RW + (grp - 3) * 64;
#pragma unroll
        for (int ct = 0; ct < 4; ++ct) {
            const bf16* p = zrow + cbase + 16 * ct + 4 * g;
            const u32x2 zc = *(const u32x2*)p;
            u32x2 zp = *(const u32x2*)(hasp ? p - INW : p), zn = *(const u32x2*)(hasn ? p + INW : p);
            if (!hasp) { zp.x = 0u; zp.y = 0u; } if (!hasn) { zn.x = 0u; zn.y = 0u; }
            const f32x4 mp = *(const LAS f32x4*)(C + grp * 64 + 16 * ct + 4 * g), mn = *(const LAS f32x4*)(C + 320 + grp * 64 + 16 * ct + 4 * g);
            float zv[4] = {__uint_as_float(zc.x << 16), __uint_as_float(zc.x & 0xffff0000u), __uint_as_float(zc.y << 16), __uint_as_float(zc.y & 0xffff0000u)};
            float pv[4] = {__uint_as_float(zp.x << 16), __uint_as_float(zp.x & 0xffff0000u), __uint_as_float(zp.y << 16), __uint_as_float(zp.y & 0xffff0000u)};
            float nv[4] = {__uint_as_float(zn.x << 16), __uint_as_float(zn.x & 0xffff0000u), __uint_as_float(zn.y << 16), __uint_as_float(zn.y & 0xffff0000u)};
#pragma unroll
            for (int r = 0; r < 4; ++r) {
                const float o = zv[r] + mp[r] * (pv[r] - zv[r]) + mn[r] * (nv[r] - zv[r]);
                if (grp == 0) rv[ct][r] = o; else if (grp == 1) kv[ct][r] = o; else if (grp == 2) vv[ct][r] = o;
                else if (grp == 3) { const float e2 = __expf(2.0f * o); tw[ct][r] = 1.0f - 2.0f / (e2 + 1.0f); } else xa[ct][r] = o;
            }
        }
    }
#pragma unroll
    for (int ct = 0; ct < 4; ++ct)
#pragma unroll
        for (int r = 0; r < 4; ++r)
            *(LAS bf16*)(buf + (S_V + (ct >> 1)) * SLOT + (4 * g + r + 16 * (s >> 2)) * 16 + (ct & 1) * 8 + 2 * (s & 3)) = (bf16)f2bf(vv[ct][r]);
    f32x4 accw[4], acca[4];
    { const bf16x8 tb0 = frag8(tw[0], tw[1]), tb1 = frag8(tw[2], tw[3]), xb0 = frag8(xa[0], xa[1]), xb1 = frag8(xa[2], xa[3]);
      const LAS bf16x8* F = (const LAS bf16x8*)(L + OFF_LORA);
#pragma unroll
      for (int ct = 0; ct < 4; ++ct) {
          f32x4 z4 = {0.f, 0.f, 0.f, 0.f};
          accw[ct] = mma(F[(0 * 8 + ct * 2 + 0) * 64 + lane], tb0, z4); accw[ct] = mma(F[(0 * 8 + ct * 2 + 1) * 64 + lane], tb1, accw[ct]);
          acca[ct] = mma(F[(1 * 8 + ct * 2 + 0) * 64 + lane], xb0, z4); acca[ct] = mma(F[(1 * 8 + ct * 2 + 1) * 64 + lane], xb1, acca[ct]);
      } }
    float ev[4][4], kk[4][4], kd[4][4], bb[4][4];
    float ss = 0.f, bon = 0.f;
#pragma unroll
    for (int ct = 0; ct < 4; ++ct) {
        const f32x4 w0 = *(const LAS f32x4*)(C + 640 + 16 * ct + 4 * g), a0 = *(const LAS f32x4*)(C + 704 + 16 * ct + 4 * g), kkw = *(const LAS f32x4*)(C + 768 + 16 * ct + 4 * g),
                    kaw = *(const LAS f32x4*)(C + 832 + 16 * ct + 4 * g), rkw = *(const LAS f32x4*)(C + 896 + 16 * ct + 4 * g);
#pragma unroll
        for (int r = 0; r < 4; ++r) {
            ev[ct][r] = 0.60653065971f * fsigmoid(accw[ct][r] + w0[r]);
            const float a = fsigmoid(acca[ct][r] + a0[r]);
            const float k = kv[ct][r];
            kk[ct][r] = k * kkw[r]; ss += kk[ct][r] * kk[ct][r];
            kd[ct][r] = k * (1.0f + (a - 1.0f) * kaw[r]);
            bb[ct][r] = a;
            bon += rv[ct][r] * k * a * kaw[r] * rkw[r];
        }
    }
    ss += __shfl_xor(ss, 16); ss += __shfl_xor(ss, 32);
    bon += __shfl_xor(bon, 16); bon += __shfl_xor(bon, 32);
    if (g == 0) BON[((size_t)dir * T + tok) * NH + h] = bon;
    const float rn = 1.0f / sqrtf(fmaxf(ss, 1e-12f));
    float KKs[4][4], Rs[4][4], Bt[4][4], Kt[4][4];
#pragma unroll
    for (int ct = 0; ct < 4; ++ct) {
        float gcv[4];
#pragma unroll
        for (int r = 0; r < 4; ++r) {
            const float e = ev[ct][r];
            float cum = e;
            cum += row_shr<1>(cum); cum += row_shr<2>(cum); cum += row_shr<4>(cum); cum += row_shr<8>(cum);
            const float cumC = __shfl(cum, (lane & 48) | 15);
            const float kkn = kk[ct][r] * rn, bv = kkn * bb[ct][r];
            const float ig = __expf(cum), rat = __expf(cum - cumC);
            KKs[ct][r] = kkn * __expf(e - cum); Rs[ct][r] = rv[ct][r] * __expf(-cum);
            Bt[ct][r] = bv * ig; Kt[ct][r] = kd[ct][r] * ig;
            gcv[r] = __expf(-cumC);
            LAS unsigned char* q = buf + (S_BK + ct) * SLOT + (4 * g + r + 16 * (s >> 2)) * 16 + 2 * (s & 3);
            *(LAS bf16*)q = (bf16)f2bf(bv * rat); *(LAS bf16*)(q + 8) = (bf16)f2bf(kd[ct][r] * rat);
        }
        if (s == 15) *(LAS f32x4*)(buf + S_GC * SLOT + (16 * ct + 4 * g) * 4) = (f32x4){gcv[0], gcv[1], gcv[2], gcv[3]};
    }
    const bf16x8 fKK0 = frag8(KKs[0], KKs[1]), fKK1 = frag8(KKs[2], KKs[3]), fR0 = frag8(Rs[0], Rs[1]), fR1 = frag8(Rs[2], Rs[3]);
    const bf16x8 fB0 = frag8(Bt[0], Bt[1]), fB1 = frag8(Bt[2], Bt[3]), fK0 = frag8(Kt[0], Kt[1]), fK1 = frag8(Kt[2], Kt[3]);
    *(LAS bf16x8*)(buf + (S_KK + 0) * SLOT + lane * 16) = fKK0; *(LAS bf16x8*)(buf + (S_KK + 1) * SLOT + lane * 16) = fKK1;
    *(LAS bf16x8*)(buf + (S_R + 0) * SLOT + lane * 16) = fR0;  *(LAS bf16x8*)(buf + (S_R + 1) * SLOT + lane * 16) = fR1;
    const f32x4 z4 = {0.f, 0.f, 0.f, 0.f};
    { f32x4 mab = mma(fKK0, fB0, z4); mab = mma(fKK1, fB1, mab);
      *(LAS f32x4*)(MT + s * 16 + 4 * g) = mab; }
    f32x4 mak = mma(fK0, fKK0, z4); mak = mma(fK1, fKK1, mak);
    f32x4 nrb = mma(fB0, fR0, z4); nrb = mma(fB1, fR1, nrb);
    f32x4 nrk = mma(fK0, fR0, z4); nrk = mma(fK1, fR1, nrk);
#pragma unroll
    for (int r = 0; r < 4; ++r) { const int i = 4 * g + r; if (!(i < s)) mak[r] = 0.f; if (!(i <= s)) { nrb[r] = 0.f; nrk[r] = 0.f; } }
    *(LAS v4u*)(buf + S_N * SLOT + lane * 16) = (v4u){cvtpk(nrb[0], nrb[1]), cvtpk(nrb[2], nrb[3]), cvtpk(nrk[0], nrk[1]), cvtpk(nrk[2], nrk[3])};
    asm volatile("s_waitcnt lgkmcnt(0)" ::: "memory"); __builtin_amdgcn_wave_barrier();
    float Tr[16];
#pragma unroll
    for (int j = 15; j >= 0; --j) {
        float acc = 0.f;
#pragma unroll
        for (int i = j + 1; i < 16; ++i) acc += Tr[i] * MT[j * 16 + i];
        Tr[j] = (j == s) ? 1.0f : -acc;
        if (j > s) Tr[j] = 0.f;
    }
    float t0 = 0.f, t1 = 0.f, t2 = 0.f, t3 = 0.f;
#pragma unroll
    for (int gg = 0; gg < 4; ++gg) if (g == gg) { t0 = Tr[4 * gg]; t1 = Tr[4 * gg + 1]; t2 = Tr[4 * gg + 2]; t3 = Tr[4 * gg + 3]; }
    *(LAS v4u*)(buf + S_MT * SLOT + lane * 16) = (v4u){cvtpk(mak[0], mak[1]), cvtpk(mak[2], mak[3]), cvtpk(-t0, -t1), cvtpk(-t2, -t3)};
    asm volatile("s_waitcnt lgkmcnt(0)" ::: "memory"); __builtin_amdgcn_wave_barrier();
}

__device__ __forceinline__ void rec_chunk(const LAS unsigned char* buf, f32x4 (&st)[4], float* Y, int b, int h, int dir, int n, int w, int lane) {
    const int g = lane >> 4, col = lane & 15;
    const bf16x8 fKK0 = *(const LAS bf16x8*)(buf + (S_KK + 0) * SLOT + lane * 16), fKK1 = *(const LAS bf16x8*)(buf + (S_KK + 1) * SLOT + lane * 16);
    const bf16x8 fR0 = *(const LAS bf16x8*)(buf + (S_R + 0) * SLOT + lane * 16), fR1 = *(const LAS bf16x8*)(buf + (S_R + 1) * SLOT + lane * 16);
    const v4u mt = *(const LAS v4u*)(buf + S_MT * SLOT + lane * 16);
    const bf16x8 fN = *(const LAS bf16x8*)(buf + S_N * SLOT + lane * 16);
    const u32x2 vf = *(const LAS u32x2*)(buf + (S_V + (w >> 1)) * SLOT + lane * 16 + (w & 1) * 8);
    const f32x4 z4 = {0.f, 0.f, 0.f, 0.f};
    const bf16x8 sb0 = mkfrag(cvtpk(st[0][0], st[0][1]), cvtpk(st[0][2], st[0][3]), cvtpk(st[1][0], st[1][1]), cvtpk(st[1][2], st[1][3]));
    const bf16x8 sb1 = mkfrag(cvtpk(st[2][0], st[2][1]), cvtpk(st[2][2], st[2][3]), cvtpk(st[3][0], st[3][1]), cvtpk(st[3][2], st[3][3]));
    f32x4 p1 = mma(fKK0, sb0, z4); p1 = mma(fKK1, sb1, p1);
    f32x4 p2 = mma(fR0, sb0, z4); p2 = mma(fR1, sb1, p2);
    const f32x4 x = mma(mkfrag(0u, 0u, mt.x, mt.y), mkfrag(0u, 0u, vf.x, vf.y), p1);
    const f32x4 u = mma(mkfrag(mt.z, mt.w, 0u, 0u), mkfrag(cvtpk(x[0], x[1]), cvtpk(x[2], x[3]), 0u, 0u), z4);
    const bf16x8 buv = mkfrag(cvtpk(u[0], u[1]), cvtpk(u[2], u[3]), vf.x, vf.y);
    const f32x4 y = mma(fN, buv, p2);
#pragma unroll
    for (int i = 0; i < 4; ++i) {
        const f32x4 gc = *(const LAS f32x4*)(buf + S_GC * SLOT + (16 * i + 4 * g) * 4);
        const bf16x8 fBK = *(const LAS bf16x8*)(buf + (S_BK + i) * SLOT + lane * 16);
        st[i] = mma(fBK, buv, st[i] * gc);
    }
    const int cn = dir ? (SEQ / 16 - 1 - n) : n;
#pragma unroll
    for (int r = 0; r < 4; ++r) { const int s = 4 * g + r, t = cn * 16 + (dir ? 15 - s : s);
        Y[((size_t)dir * T + (size_t)(b * SEQ + t)) * RW + h * 64 + 16 * w + col] = y[r]; }
}

__device__ __forceinline__ void chain(LAS unsigned char* L, const bf16* Z, const float* mu_prev, const float* mu_next, const float* w_decay0, const float* w_decay_up,
                                      const float* a_gate0, const float* a_gate_up, const float* k_k, const float* k_a, const float* r_k, float* Y, float* BON, int ch, int tid, int wave, int lane) {
    const int dir = ch & 1, h = (ch >> 1) & 7, b = ch >> 4;
    __syncthreads();
    setup(L, h, dir, mu_prev, mu_next, w_decay0, w_decay_up, a_gate0, a_gate_up, k_k, k_a, r_k, tid);
    __syncthreads();
    f32x4 st[4];
#pragma unroll
    for (int i = 0; i < 4; ++i) st[i] = (f32x4){0.f, 0.f, 0.f, 0.f};
    constexpr int NCH = SEQ / 16, NR = NCH / 4;
    for (int q = -1; q < NR; ++q) {
        if (wave < 4) {
            if (q >= 0) {
#pragma unroll 1
                for (int i = 0; i < 4; ++i) rec_chunk(L + ((q & 1) * 4 + i) * BUF_BYTES, st, Y, b, h, dir, 4 * q + i, wave, lane);
            }
        } else if (q + 1 < NR) {
            const int hw = wave - 4;
            helper_chunk(L, L + (((q + 1) & 1) * 4 + hw) * BUF_BYTES, (LAS float*)(L + OFF_MT + hw * 1024), Z, BON, b, h, dir, 4 * (q + 1) + hw, lane);
        }
        __syncthreads();
    }
}
}

namespace attn {
typedef unsigned u32x2 __attribute__((ext_vector_type(2)));
constexpr int VT_STRIDE = 136;
constexpr int WAVE_LDS = 64 * VT_STRIDE;
constexpr float LOG2E = 1.44269504088896f, LN2 = 0.693147180559945f;
using scan::cvtpk; using scan::mkfrag; using scan::mma;

__device__ __forceinline__ void unpack8(const v4u w, float (&f)[8]) {
    f[0] = __uint_as_float(w.x << 16); f[1] = __uint_as_float(w.x & 0xffff0000u); f[2] = __uint_as_float(w.y << 16); f[3] = __uint_as_float(w.y & 0xffff0000u);
    f[4] = __uint_as_float(w.z << 16); f[5] = __uint_as_float(w.z & 0xffff0000u); f[6] = __uint_as_float(w.w << 16); f[7] = __uint_as_float(w.w & 0xffff0000u);
}

__device__ __forceinline__ void unit(LAS unsigned char* vt, const bf16* Z, const float* qg, const float* kg, bf16* Ob, int opitch, float* lse_out,
                                     int b, int h, int d, int r, int qb, int nb, int lane) {
    const int g = lane >> 4, c16 = lane & 15;
    const float slope2 = exp2f(-(float)(h + 1)) * LOG2E * (float)d;
    float gn[16];
#pragma unroll
    for (int m = 0; m < 2; ++m)
#pragma unroll
        for (int j = 0; j < 8; ++j) gn[m * 8 + j] = qg[32 * m + 8 * g + j] * kg[32 * m + 8 * g + j];
    bf16x8 qf[4][2];
#pragma unroll
    for (int qt = 0; qt < 4; ++qt) {
        const int tok = b * SEQ + (qb * 64 + 16 * qt + c16) * d + r;
        const bf16* qp = Z + (size_t)tok * INW + h * 64 + 8 * g;
        float f0[8], f1[8]; unpack8(*(const v4u*)qp, f0); unpack8(*(const v4u*)(qp + 32), f1);
        float ss = 0.f;
#pragma unroll
        for (int j = 0; j < 8; ++j) ss += f0[j] * f0[j] + f1[j] * f1[j];
        ss += __shfl_xor(ss, 16); ss += __shfl_xor(ss, 32);
        const float rs = (0.125f * LOG2E) / sqrtf(ss * (1.f / 64.f) + 1e-6f);
        qf[qt][0] = mkfrag(cvtpk(f0[0] * rs * gn[0], f0[1] * rs * gn[1]), cvtpk(f0[2] * rs * gn[2], f0[3] * rs * gn[3]), cvtpk(f0[4] * rs * gn[4], f0[5] * rs * gn[5]), cvtpk(f0[6] * rs * gn[6], f0[7] * rs * gn[7]));
        qf[qt][1] = mkfrag(cvtpk(f1[0] * rs * gn[8], f1[1] * rs * gn[9]), cvtpk(f1[2] * rs * gn[10], f1[3] * rs * gn[11]), cvtpk(f1[4] * rs * gn[12], f1[5] * rs * gn[13]), cvtpk(f1[6] * rs * gn[14], f1[7] * rs * gn[15]));
    }
    f32x4 oacc[4][4];
    float mrun[4], lrun[4];
#pragma unroll
    for (int qt = 0; qt < 4; ++qt) { mrun[qt] = -1e30f; lrun[qt] = 0.f;
#pragma unroll
        for (int dt = 0; dt < 4; ++dt) oacc[dt][qt] = (f32x4){0.f, 0.f, 0.f, 0.f}; }
    const f32x4 z4 = {0.f, 0.f, 0.f, 0.f};
#pragma unroll 1
    for (int kb = qb - 1; kb <= qb + 1; ++kb) {
        if (kb < 0 || kb >= nb) continue;
        bf16x8 kf[4][2];
#pragma unroll
        for (int kblk = 0; kblk < 4; ++kblk) {
            const int tok = b * SEQ + (kb * 64 + 16 * kblk + c16) * d + r;
            const bf16* kp = Z + (size_t)tok * INW + AW + h * 64 + 8 * g;
            float f0[8], f1[8]; unpack8(*(const v4u*)kp, f0); unpack8(*(const v4u*)(kp + 32), f1);
            float ss = 0.f;
#pragma unroll
            for (int j = 0; j < 8; ++j) ss += f0[j] * f0[j] + f1[j] * f1[j];
            ss += __shfl_xor(ss, 16); ss += __shfl_xor(ss, 32);
            const float rsk = 1.0f / sqrtf(ss * (1.f / 64.f) + 1e-6f);
            kf[kblk][0] = mkfrag(cvtpk(f0[0] * rsk, f0[1] * rsk), cvtpk(f0[2] * rsk, f0[3] * rsk), cvtpk(f0[4] * rsk, f0[5] * rsk), cvtpk(f0[6] * rsk, f0[7] * rsk));
            kf[kblk][1] = mkfrag(cvtpk(f1[0] * rsk, f1[1] * rsk), cvtpk(f1[2] * rsk, f1[3] * rsk), cvtpk(f1[4] * rsk, f1[5] * rsk), cvtpk(f1[6] * rsk, f1[7] * rsk));
        }
#pragma unroll
        for (int i = 0; i < 8; ++i) {
            const int key = 8 * i + (lane >> 3), chunk = lane & 7;
            const int tok = b * SEQ + (kb * 64 + key) * d + r;
            const v4u w = *(const v4u*)(Z + (size_t)tok * INW + 2 * AW + h * 64 + 8 * chunk);
            LAS unsigned char* q = vt + (8 * chunk) * VT_STRIDE + 2 * key;
            *(LAS bf16*)(q + 0 * VT_STRIDE) = (bf16)(w.x & 0xffffu); *(LAS bf16*)(q + 1 * VT_STRIDE) = (bf16)(w.x >> 16);
            *(LAS bf16*)(q + 2 * VT_STRIDE) = (bf16)(w.y & 0xffffu); *(LAS bf16*)(q + 3 * VT_STRIDE) = (bf16)(w.y >> 16);
            *(LAS bf16*)(q + 4 * VT_STRIDE) = (bf16)(w.z & 0xffffu); *(LAS bf16*)(q + 5 * VT_STRIDE) = (bf16)(w.z >> 16);
            *(LAS bf16*)(q + 6 * VT_STRIDE) = (bf16)(w.w & 0xffffu); *(LAS bf16*)(q + 7 * VT_STRIDE) = (bf16)(w.w >> 16);
        }
        asm volatile("s_waitcnt lgkmcnt(0)" ::: "memory"); __builtin_amdgcn_wave_barrier();
        const int obase = (kb - qb) * 64;
#pragma unroll
        for (int qt = 0; qt < 4; ++qt) {
            f32x4 sa[4];
#pragma unroll
            for (int kblk = 0; kblk < 4; ++kblk) { sa[kblk] = mma(kf[kblk][0], qf[qt][0], z4); sa[kblk] = mma(kf[kblk][1], qf[qt][1], sa[kblk]); }
            const int qi = 16 * qt + c16;
            float mx = -1e30f;
#pragma unroll
            for (int kblk = 0; kblk < 4; ++kblk)
#pragma unroll
                for (int reg = 0; reg < 4; ++reg) {
                    const int o = obase + 16 * kblk + 4 * g + reg - qi, ao = o < 0 ? -o : o;
                    float sv = sa[kblk][reg] - slope2 * (float)ao;
                    sv = (ao <= 64) ? sv : -1e30f;
                    sa[kblk][reg] = sv; mx = fmaxf(mx, sv);
                }
            mx = fmaxf(mx, __shfl_xor(mx, 16)); mx = fmaxf(mx, __shfl_xor(mx, 32));
            const float mn = fmaxf(mrun[qt], mx), alpha = exp2f(mrun[qt] - mn);
            mrun[qt] = mn;
            float ls = 0.f;
#pragma unroll
            for (int kblk = 0; kblk < 4; ++kblk)
#pragma unroll
                for (int reg = 0; reg < 4; ++reg) { const float p = exp2f(sa[kblk][reg] - mn); sa[kblk][reg] = p; ls += p; }
            lrun[qt] = lrun[qt] * alpha + ls;
            const bf16x8 pf0 = mkfrag(cvtpk(sa[0][0], sa[0][1]), cvtpk(sa[0][2], sa[0][3]), cvtpk(sa[1][0], sa[1][1]), cvtpk(sa[1][2], sa[1][3]));
            const bf16x8 pf1 = mkfrag(cvtpk(sa[2][0], sa[2][1]), cvtpk(sa[2][2], sa[2][3]), cvtpk(sa[3][0], sa[3][1]), cvtpk(sa[3][2], sa[3][3]));
#pragma unroll
            for (int dt = 0; dt < 4; ++dt) {
                const LAS unsigned char* vr = vt + (16 * dt + c16) * VT_STRIDE + 8 * g;
                const u32x2 a0 = *(const LAS u32x2*)(vr), a1 = *(const LAS u32x2*)(vr + 32), a2 = *(const LAS u32x2*)(vr + 64), a3 = *(const LAS u32x2*)(vr + 96);
                f32x4 oc = oacc[dt][qt] * alpha;
                oc = mma(mkfrag(a0.x, a0.y, a1.x, a1.y), pf0, oc);
                oc = mma(mkfrag(a2.x, a2.y, a3.x, a3.y), pf1, oc);
                oacc[dt][qt] = oc;
            }
            __builtin_amdgcn_sched_barrier(0);
        }
        asm volatile("s_waitcnt lgkmcnt(0)" ::: "memory"); __builtin_amdgcn_wave_barrier();
    }
#pragma unroll
    for (int qt = 0; qt < 4; ++qt) {
        float lt = lrun[qt]; lt += __shfl_xor(lt, 16); lt += __shfl_xor(lt, 32);
        const float inv = 1.0f / lt;
        const int tok = b * SEQ + (qb * 64 + 16 * qt + c16) * d + r;
        bf16* op = Ob + (size_t)tok * opitch + h * 64 + 4 * g;
#pragma unroll
        for (int dt = 0; dt < 4; ++dt) { const f32x4 o = oacc[dt][qt] * inv; u32x2 w; w.x = cvtpk(o[0], o[1]); w.y = cvtpk(o[2], o[3]); *(u32x2*)(op + 16 * dt) = w; }
        if (g == 0) lse_out[(size_t)tok * NH + h] = (mrun[qt] + log2f(lt)) * LN2;
    }
}
}

namespace peer {
using scan::cvtpk; using scan::mkfrag; using scan::mma;
constexpr int KEY_SLOTS = 64;

template <int CTRL> __device__ __forceinline__ unsigned dppu(unsigned x) { return (unsigned)__builtin_amdgcn_update_dpp((int)x, (int)x, CTRL, 0xf, 0xf, false); }
__device__ __forceinline__ unsigned umax(unsigned a, unsigned b) { return a > b ? a : b; }
__device__ __forceinline__ unsigned rowmax16(unsigned x) { x = umax(x, dppu<0xB1>(x)); x = umax(x, dppu<0x4E>(x)); x = umax(x, dppu<0x141>(x)); x = umax(x, dppu<0x140>(x)); return x; }
__device__ __forceinline__ float rowsum16(float x) {
    x += __uint_as_float(dppu<0xB1>(__float_as_uint(x))); x += __uint_as_float(dppu<0x4E>(__float_as_uint(x)));
    x += __uint_as_float(dppu<0x141>(__float_as_uint(x))); x += __uint_as_float(dppu<0x140>(__float_as_uint(x))); return x;
}
__device__ __forceinline__ unsigned ordkey(float f) { const unsigned u = __float_as_uint(f); return (u & 0x80000000u) ? ~u : (u | 0x80000000u); }
__device__ __forceinline__ float unordkey(unsigned k) { return __uint_as_float((k & 0x80000000u) ? (k ^ 0x80000000u) : ~k); }

__device__ __forceinline__ void setup_keys(LAS unsigned char* L, const float* keys1, const float* keys2, int tid) {
    LAS bf16* F = (LAS bf16*)L;
    for (int i = tid; i < KEY_SLOTS * 64 * 8; i += 512) {
        const int j = i & 7, l = (i >> 3) & 63, sl = i >> 9, ks = sl & 3, nt = (sl >> 2) & 7, sel = sl >> 5;
        const int n = 16 * nt + (l & 15), k = 32 * ks + 8 * (l >> 4) + j;
        F[i] = (bf16)f2bf((sel ? keys2 : keys1)[n * 128 + k]);
    }
}

__device__ __forceinline__ void top16(unsigned (&key)[8][4], unsigned (&win)[4], int c16) {
#pragma unroll 1
    for (int k = 0; k < TOPK; ++k) {
#pragma unroll
        for (int reg = 0; reg < 4; ++reg) {
            unsigned m = key[0][reg];
#pragma unroll
            for (int nt = 1; nt < 8; ++nt) m = umax(m, key[nt][reg]);
            m = rowmax16(m);
            win[reg] = (c16 == k) ? m : win[reg];
#pragma unroll
            for (int nt = 0; nt < 8; ++nt) key[nt][reg] = (key[nt][reg] == m) ? 0u : key[nt][reg];
        }
    }
}

__device__ __forceinline__ void select_batch(const LAS unsigned char* L, const bf16* Q, int* IDX, float* GATE, int batch, int lane) {
    const int g = lane >> 4, c16 = lane & 15;
    const LAS bf16x8* F = (const LAS bf16x8*)L;
    const bf16* qp = Q + (size_t)(batch * 16 + c16) * PKD + 8 * g;
    unsigned w1[4] = {0u, 0u, 0u, 0u}, w2[4] = {0u, 0u, 0u, 0u};
#pragma unroll
    for (int sel = 0; sel < 2; ++sel) {
        unsigned key[8][4];
        bf16x8 a[4];
#pragma unroll
        for (int ks = 0; ks < 4; ++ks) a[ks] = *(const bf16x8*)(qp + sel * 128 + 32 * ks);
#pragma unroll
        for (int nt = 0; nt < 8; ++nt) {
            f32x4 sc = {0.f, 0.f, 0.f, 0.f};
#pragma unroll
            for (int ks = 0; ks < 4; ++ks) sc = mma(a[ks], F[((sel * 8 + nt) * 4 + ks) * 64 + lane], sc);
#pragma unroll
            for (int reg = 0; reg < 4; ++reg) key[nt][reg] = (ordkey(sc[reg]) & ~127u) | (unsigned)(16 * nt + c16);
            __builtin_amdgcn_sched_barrier(0);
        }
        if (sel == 0) top16(key, w1, c16); else top16(key, w2, c16);
    }
    float f1[4], f2[4], cur2[4]; int ptr[4]; unsigned top[4];
#pragma unroll
    for (int reg = 0; reg < 4; ++reg) { f1[reg] = unordkey(w1[reg] & ~127u); f2[reg] = unordkey(w2[reg] & ~127u); ptr[reg] = 0; cur2[reg] = __shfl(f2[reg], lane & 48); top[reg] = 0u; }
#pragma unroll 1
    for (int k = 0; k < TOPK; ++k) {
#pragma unroll
        for (int reg = 0; reg < 4; ++reg) {
            const unsigned ck = (ptr[reg] < 16) ? ((ordkey(f1[reg] + cur2[reg]) & ~255u) | (unsigned)(c16 << 4) | (unsigned)ptr[reg]) : 0u;
            const unsigned m = rowmax16(ck);
            top[reg] = (c16 == k) ? m : top[reg];
            if ((int)((m >> 4) & 15u) == c16) ptr[reg] += 1;
            cur2[reg] = __shfl(f2[reg], (lane & 48) | (ptr[reg] & 15));
        }
    }
#pragma unroll
    for (int reg = 0; reg < 4; ++reg) {
        const int a = (top[reg] >> 4) & 15, bq = top[reg] & 15;
        const int e1 = (int)(__shfl(w1[reg], (lane & 48) | a) & 127u), e2 = (int)(__shfl(w2[reg], (lane & 48) | bq) & 127u);
        const float ts = unordkey(top[reg] & ~255u), mx = __shfl(ts, lane & 48);
        const float ex = __expf(ts - mx), sum = rowsum16(ex);
        const size_t o = (size_t)(batch * 16 + 4 * g + reg) * TOPK + c16;
        IDX[o] = e1 * NKEYS + e2; GATE[o] = ex / sum;
    }
}

__device__ __forceinline__ void convert_table(const float* src, bf16* dst, size_t n8, size_t gtid, size_t gthreads) {
    for (size_t i = gtid; i < n8; i += gthreads) {
        const f32x4 a = *(const f32x4*)(src + i * 8), b = *(const f32x4*)(src + i * 8 + 4);
        v4u o; o.x = cvtpk(a.x, a.y); o.y = cvtpk(a.z, a.w); o.z = cvtpk(b.x, b.y); o.w = cvtpk(b.z, b.w);
        *(v4u*)(dst + i * 8) = o;
    }
}

__device__ __forceinline__ float dot2bf(unsigned w, unsigned x, float acc) {
    typedef __bf16 bf2 __attribute__((ext_vector_type(2)));
    return __builtin_amdgcn_fdot2_f32_bf16(__builtin_bit_cast(bf2, w), __builtin_bit_cast(bf2, x), acc, false);
}
__device__ __forceinline__ float gelu_erf(float v) {
    const float av = fabsf(v), t = __builtin_amdgcn_rcpf(av * 0.2316418882f + 1.0f);
    float q = t * 0.5307027145f + (-0.7265760135f); q = q * t + 0.7107068705f; q = q * t + (-0.142248368f); q = q * t + 0.127414796f; q = q * t;
    const float e = __builtin_amdgcn_exp2f((v * v) * (-0.72134752044f));
    const float m = v * (q * e);
    return v < 0.f ? m : v - m;
}

__device__ __forceinline__ void ffn_token(const bf16* XN, const int* IDX, const float* GATE, const bf16* UT, const bf16* VT, const float* mod, float* out, int tok, int lane) {
    const int b = tok / SEQ;
    const v4u x0 = *(const v4u*)(XN + (size_t)tok * D + 8 * lane), x1 = *(const v4u*)(XN + (size_t)tok * D + 512 + 8 * lane);
    const int id0 = IDX[(size_t)tok * HK + lane], id1 = IDX[(size_t)tok * HK + 64 + lane];
    const float gt0 = GATE[(size_t)tok * HK + lane], gt1 = GATE[(size_t)tok * HK + 64 + lane];
    float y[16];
#pragma unroll
    for (int i = 0; i < 16; ++i) y[i] = 0.f;
#pragma unroll 1
    for (int jj = 0; jj < HK; jj += 4) {
        v4u u0[4], u1[4], v0[4], v1[4]; float gt[4];
#pragma unroll
        for (int e = 0; e < 4; ++e) {
            const int j = jj + e;
            const int ex = __shfl((j < 64) ? id0 : id1, j & 63);
            gt[e] = __shfl((j < 64) ? gt0 : gt1, j & 63);
            const bf16* up = UT + (size_t)ex * D + 8 * lane; const bf16* vp = VT + (size_t)ex * D + 8 * lane;
            u0[e] = *(const v4u*)up; u1[e] = *(const v4u*)(up + 512); v0[e] = *(const v4u*)vp; v1[e] = *(const v4u*)(vp + 512);
        }
#pragma unroll
        for (int e = 0; e < 4; ++e) {
            float dot = 0.f;
            dot = dot2bf(u0[e].x, x0.x, dot); dot = dot2bf(u0[e].y, x0.y, dot); dot = dot2bf(u0[e].z, x0.z, dot); dot = dot2bf(u0[e].w, x0.w, dot);
            dot = dot2bf(u1[e].x, x1.x, dot); dot = dot2bf(u1[e].y, x1.y, dot); dot = dot2bf(u1[e].z, x1.z, dot); dot = dot2bf(u1[e].w, x1.w, dot);
            dot = rowsum16(dot); dot += __shfl_xor(dot, 16); dot += __shfl_xor(dot, 32);
            const float cf = gt[e] * gelu_erf(dot);
            y[0] += cf * __uint_as_float(v0[e].x << 16); y[1] += cf * __uint_as_float(v0[e].x & 0xffff0000u); y[2] += cf * __uint_as_float(v0[e].y << 16); y[3] += cf * __uint_as_float(v0[e].y & 0xffff0000u);
            y[4] += cf * __uint_as_float(v0[e].z << 16); y[5] += cf * __uint_as_float(v0[e].z & 0xffff0000u); y[6] += cf * __uint_as_float(v0[e].w << 16); y[7] += cf * __uint_as_float(v0[e].w & 0xffff0000u);
            y[8] += cf * __uint_as_float(v1[e].x << 16); y[9] += cf * __uint_as_float(v1[e].x & 0xffff0000u); y[10] += cf * __uint_as_float(v1[e].y << 16); y[11] += cf * __uint_as_float(v1[e].y & 0xffff0000u);
            y[12] += cf * __uint_as_float(v1[e].z << 16); y[13] += cf * __uint_as_float(v1[e].z & 0xffff0000u); y[14] += cf * __uint_as_float(v1[e].w << 16); y[15] += cf * __uint_as_float(v1[e].w & 0xffff0000u);
        }
    }
#pragma unroll
    for (int hh = 0; hh < 2; ++hh) {
        const int col = 512 * hh + 8 * lane; const size_t o = (size_t)tok * D + col;
        const f32x4 ga = *(const f32x4*)(mod + b * MODW + 5 * D + col), gb = *(const f32x4*)(mod + b * MODW + 5 * D + col + 4);
        f32x4 oa = *(const f32x4*)(out + o), ob = *(const f32x4*)(out + o + 4);
        oa.x += ga.x * y[8 * hh + 0]; oa.y += ga.y * y[8 * hh + 1]; oa.z += ga.z * y[8 * hh + 2]; oa.w += ga.w * y[8 * hh + 3];
        ob.x += gb.x * y[8 * hh + 4]; ob.y += gb.y * y[8 * hh + 5]; ob.z += gb.z * y[8 * hh + 6]; ob.w += gb.w * y[8 * hh + 7];
        *(f32x4*)(out + o) = oa; *(f32x4*)(out + o + 4) = ob;
    }
}
}

#ifndef MK_SKIP
#define MK_SKIP 0
#endif
constexpr int N_PHASES = 10;
struct Args { const float* in[27]; float* out; unsigned char* ws; int ph_lo, ph_hi, li, pad; };

__global__ void __launch_bounds__(NWAVES * 64, 2) mk_fwd(Args args) {
    extern __shared__ __attribute__((aligned(16))) unsigned char lds[];
    LAS unsigned char* L = (LAS unsigned char*)lds;
    volatile LAS unsigned* MISC = (volatile LAS unsigned*)(L + MISC_OFF);
    const int tid = threadIdx.x, lane = tid & 63, wave = __builtin_amdgcn_readfirstlane(tid >> 6);
    const int G = gridDim.x, bx = blockIdx.x;
    unsigned char* ws = args.ws;
    gu32* ctl = (gu32*)(ws + WS_CTL);
    const float* x = args.in[0]; const float* cvec = args.in[1]; const float* ada_w = args.in[2]; const float* ada_b = args.in[3];
    const float* norm1_g = args.in[4]; const float* w_in = args.in[5]; const float* mu_prev = args.in[6]; const float* mu_next = args.in[7];
    const float* q_norm_g = args.in[8]; const float* k_norm_g = args.in[9]; const float* w_decay0 = args.in[10]; const float* w_decay_up = args.in[11];
    const float* a_gate0 = args.in[12]; const float* a_gate_up = args.in[13]; const float* g_up = args.in[14]; const float* k_k = args.in[15];
    const float* k_a = args.in[16]; const float* r_k = args.in[17]; const float* lnx_g = args.in[18]; const float* lnx_b = args.in[19];
    const float* w_out = args.in[20]; const float* norm2_g = args.in[21]; const float* w_query = args.in[22]; const float* keys1 = args.in[23];
    const float* keys2 = args.in[24]; const float* peer_u = args.in[25]; const float* peer_v = args.in[26];
    float* out = args.out;
    float* MOD = (float*)(ws + WS_MOD); bf16* KEYS = (bf16*)(ws + WS_KEYS); bf16* WIN = (bf16*)(ws + WS_WIN); bf16* WOUT = (bf16*)(ws + WS_WOUT); bf16* WQ = (bf16*)(ws + WS_WQ);
    bf16* XN = (bf16*)(ws + WS_XN); bf16* Z = (bf16*)(ws + WS_Z); bf16* MIX = (bf16*)(ws + WS_MIX); float* Y = (float*)(ws + WS_Y); bf16* Q = (bf16*)(ws + WS_Q);
    int* IDX = (int*)(ws + WS_IDX); float* GATE = (float*)(ws + WS_GATE); float* BON = (float*)(ws + WS_BON);
    bf16* O3 = (bf16*)(ws + WS_O3); float* LSE = (float*)(ws + WS_LSE); bf16* UT = (bf16*)(ws + WS_UT); bf16* VT = (bf16*)(ws + WS_VT);

    for (int u = tid; u < (LDS_BYTES - LDSCTL_OFF) / 4; u += NWAVES * 64) ((LAS unsigned*)(L + LDSCTL_OFF))[u] = 0u;
    __syncthreads();
    XcdBarrier bar = xcd_barrier_post((unsigned*)(ctl + CW_BAR) + args.li * XCD_BAR_WORDS, MISC + 8);
    const int lo = args.ph_lo, hi = args.ph_hi;
#define IN(k) (lo <= (k) && (k) < hi)
#define SEAM(k) do { if (IN(k) && IN((k) + 1)) xcd_barrier(bar); } while (0)
    const int gw = bx * NWAVES + wave, NGW = G * NWAVES;

    if (IN(0) && !(MK_SKIP & (1 << 0))) {
        if (bx < MODW / 64) {
            LAS float* sc = (LAS float*)L; LAS float* part = (LAS float*)(L + 32768);
            for (int i = tid; i < BATCH * D; i += NWAVES * 64) { const float cv = cvec[i]; sc[i] = cv / (1.f + expf(-cv)); }
            __syncthreads();
            const int j0 = bx * 64;
            float acc[BATCH];
#pragma unroll
            for (int b = 0; b < BATCH; ++b) acc[b] = 0.f;
            for (int i = wave * 128; i < wave * 128 + 128; ++i) { const float w = ada_w[(size_t)i * MODW + j0 + lane];
#pragma unroll
                for (int b = 0; b < BATCH; ++b) acc[b] += sc[b * D + i] * w; }
#pragma unroll
            for (int b = 0; b < BATCH; ++b) part[(wave * 8 + b) * 64 + lane] = acc[b];
            __syncthreads();
            { const int b = tid >> 6; float s = 0.f;
#pragma unroll
              for (int w = 0; w < 8; ++w) s += part[(w * 8 + b) * 64 + lane];
              MOD[b * MODW + j0 + lane] = s + ada_b[j0 + lane]; }
            __syncthreads();
        }
        LAS float* scr = (LAS float*)(L + RING_OFF + wave * 16384);
        constexpr int I_IN = (D / 64) * (INW / 32), I_OUT = (D / 64) * (D / 32), I_Q = (D / 64) * (QW / 32);
        for (int it = gw; it < I_IN + I_OUT + I_Q; it += NGW) {
            int r = it;
            if (r < I_IN) { p0_transpose_item(w_in, D, INW, WIN, 0, scr, r, lane); continue; } r -= I_IN;
            if (r < I_OUT) { p0_transpose_item(w_out, D, D, WOUT, 0, scr, r, lane); continue; } r -= I_OUT;
            p0_transpose_item(w_query, D, QW, WQ, 0, scr, r, lane);
        }
    }
    SEAM(0);
    if (IN(1) && !(MK_SKIP & (1 << 1))) { for (int m = gw; m < T; m += NGW) norm_row(x + (size_t)m * D, norm1_g, MOD + (m / SEQ) * MODW, 0, D, XN + (size_t)m * D, lane); }
    SEAM(1);
    if (IN(2) && !(MK_SKIP & (1 << 2))) {
        pg8::Gemm g{XN, WIN, T, INW, D}; pg8::StaticOrder S; S.init(T, INW, G, bx);
        pg8::EpiBf16<0> E{Z, INW, nullptr, 0, 0, 1.f};
        pg8::gemm_phase<pg8::EpiBf16<0>, pg8::StaticOrder, true, true>(L + RING_OFF, g, S, E);
    }
    SEAM(2);
    if (IN(3) && !(MK_SKIP & (1 << 3))) {
        constexpr int NCHAIN = BATCH * NH * 2;
        if (bx < NCHAIN) {
            scan::chain(L, Z, mu_prev, mu_next, w_decay0, w_decay_up, a_gate0, a_gate_up, k_k, k_a, r_k, Y, BON, bx, tid, wave, lane);
        } else {
            const int wid = (bx - NCHAIN) * NWAVES + wave, nworkers = (G - NCHAIN) * NWAVES;
            LAS unsigned char* vt = L + wave * attn::WAVE_LDS;
            for (int u = wid; u < BATCH * NH * 96; u += nworkers) {
                const int x = u & 31, p = (u >> 5) % 3, bh = u / 96;
                const int d = (p == 0) ? 1 : (p == 1 ? 4 : 16), nb = 32 / d, r = x / nb, qb = x % nb;
                bf16* Ob = (p == 0) ? MIX : (p == 1 ? MIX + AW : O3); const int opitch = (p == 2) ? AW : D;
                attn::unit(vt, Z, q_norm_g, k_norm_g, Ob, opitch, LSE + (size_t)p * T * NH, bh >> 3, bh & 7, d, r, qb, nb, lane);
            }
        }
    }
    SEAM(3);
    if (IN(4) && !(MK_SKIP & (1 << 4))) { for (int tok = bx; tok < T; tok += G) rwkv_fin_token(Z, mu_prev, mu_next, g_up, Y, BON, k_a, r_k, lnx_g, lnx_b, MIX, O3, LSE, tok, tid, (LAS float*)L); }
    SEAM(4);
    if (IN(5) && !(MK_SKIP & (1 << 5))) {
        pg8::Gemm g{MIX, WOUT, T, D, D}; pg8::StaticOrder S; S.init(T, D, G, bx);
        EpiRes E{x, MOD, 2 * D, out, D};
        pg8::gemm_phase<EpiRes, pg8::StaticOrder, true, true>(L + RING_OFF, g, S, E);
    }
    SEAM(5);
    if (IN(6) && !(MK_SKIP & (1 << 6))) { for (int m = gw; m < T; m += NGW) norm_row(out + (size_t)m * D, norm2_g, MOD + (m / SEQ) * MODW, 3 * D, 4 * D, XN + (size_t)m * D, lane);
        const size_t gtid = (size_t)bx * NWAVES * 64 + tid, gthreads = (size_t)G * NWAVES * 64;
        peer::convert_table(peer_u, UT, (size_t)NKEYS * NKEYS * D / 8, gtid, gthreads); peer::convert_table(peer_v, VT, (size_t)NKEYS * NKEYS * D / 8, gtid, gthreads); }
    SEAM(6);
    if (IN(7) && !(MK_SKIP & (1 << 7))) {
        pg8::Gemm g{XN, WQ, T, QW, D}; pg8::StaticOrder S; S.init(T, QW, G, bx);
        pg8::EpiBf16<0> E{Q, QW, nullptr, 0, 0, 1.f};
        pg8::gemm_phase<pg8::EpiBf16<0>, pg8::StaticOrder, true, true>(L + RING_OFF, g, S, E);
    }
    SEAM(7);
    if (IN(8) && !(MK_SKIP & (1 << 8))) { __syncthreads(); peer::setup_keys(L, keys1, keys2, tid); __syncthreads();
        for (int bt = gw; bt < T * PH / 16; bt += NGW) peer::select_batch(L, Q, IDX, GATE, bt, lane); }
    SEAM(8);
    if (IN(9) && !(MK_SKIP & (1 << 9))) { for (int tok = gw; tok < T; tok += NGW) peer::ffn_token(XN, IDX, GATE, UT, VT, MOD, out, tok, lane); }
#undef IN
#undef SEAM
}

extern "C" void kernel_launch(void* const* d_in, const int* in_sizes, int n_in, void* d_out, int out_size, void* d_ws, size_t ws_size, hipStream_t stream) {
    static int grid = 0;
    if (grid == 0) {
        if (n_in != 27 || in_sizes[0] != T * D || out_size != T * D || ws_size < WS_END) { fprintf(stderr, "kernel_launch: unexpected problem (n_in %d, in0 %d, out %d, ws %zu); nothing launched\n", n_in, n_in > 0 ? in_sizes[0] : -1, out_size, ws_size); grid = -1; return; }
        int dev = 0, cus = 0, per_cu = 0;
        if (hipGetDevice(&dev) != hipSuccess || hipDeviceGetAttribute(&cus, hipDeviceAttributeMultiprocessorCount, dev) != hipSuccess) { fprintf(stderr, "kernel_launch: device query failed\n"); grid = -1; return; }
        if (hipFuncSetAttribute((const void*)mk_fwd, hipFuncAttributeMaxDynamicSharedMemorySize, LDS_BYTES) != hipSuccess) { fprintf(stderr, "kernel_launch: hipFuncSetAttribute failed\n"); grid = -1; return; }
        if (hipOccupancyMaxActiveBlocksPerMultiprocessor(&per_cu, (const void*)mk_fwd, NWAVES * 64, LDS_BYTES) != hipSuccess || per_cu < 1)
            fprintf(stderr, "kernel_launch: note: occupancy query reports %d workgroups per CU\n", per_cu);
        (void)hipGetLastError();
        grid = cus;
    }
    if (grid < 0) return;
    if (hipMemsetAsync((char*)d_ws + WS_CTL, 0, CTL_ZERO_BYTES, stream) != hipSuccess) { fprintf(stderr, "kernel_launch: hipMemsetAsync failed\n"); return; }
    Args a{};
    for (int i = 0; i < 27; ++i) a.in[i] = (const float*)d_in[i];
    a.out = (float*)d_out; a.ws = (unsigned char*)d_ws;
#ifndef MK_CUTS
#define MK_CUTS {0, N_PHASES}
#endif
    const int cuts[] = MK_CUTS;
    const int nl = (int)(sizeof(cuts) / sizeof(int)) - 1;
    for (int li = 0; li < nl; ++li) {
        a.ph_lo = cuts[li]; a.ph_hi = cuts[li + 1]; a.li = li;
        hipLaunchKernelGGL(mk_fwd, dim3(grid), dim3(NWAVES * 64), LDS_BYTES, stream, a);
        const hipError_t le = hipPeekAtLastError();
        if (le != hipSuccess) { fprintf(stderr, "kernel_launch: launch %d failed: %s\n", li, hipGetErrorName(le)); break; }
    }
}
```

```cpp
#include <hip/hip_runtime.h>
#include <cstdio>
#include <cstdint>
#include <cmath>
namespace pg8 {
#define PG8_LAS __attribute__((address_space(3)))
typedef unsigned short bf16_t;
typedef short bf16x8 __attribute__((ext_vector_type(8)));
typedef float f32x4 __attribute__((ext_vector_type(4)));
typedef unsigned u32x4 __attribute__((ext_vector_type(4)));
constexpr int BM = 256, BK = 64, HALF = 128, HTB = HALF * BK * 2  , STAGE_BYTES = 8 * HTB, NXCD = 8, WGM = 8;

__host__ __device__ __forceinline__ int lds_byte(int r, int c) { const int st = (r >> 4) * 2 + (c >> 5), rr = r & 15, cc = c & 31, ob = rr * 64 + cc * 2; return st * 1024 + (ob ^ (((ob >> 9) & 1) << 5)); }
__host__ __device__ __forceinline__ void stage_rc(int b, int& R, int& C) { const int st = b / 1024, sb = b % 1024, swz = sb ^ (((sb >> 9) & 1) << 5); R = (st >> 1) * 16 + swz / 64; C = (st & 1) * 32 + (swz % 64) / 2; }
__host__ __device__ __forceinline__ int perm32(int rho) { const int n = rho >> 4, i = rho & 15; return 8 * (i >> 2) + 4 * n + (i & 3); }

struct Unit { int pm, pn; };
struct Gemm { const bf16_t* A; const bf16_t* Bt; int M, N, K; };

struct StaticOrder {
    int nM, nN, nwg, G, c;
    __host__ __device__ void init(int M, int N, int G_, int c_) { nM = M / BM; nN = N / BM; nwg = nM * nN; G = G_; c = c_; }
    __host__ __device__ bool next(int i, Unit& u) const {
        const long L = (long)i * G + c; if (L >= nwg) return false;
        int wgid = (int)L; { const int q = nwg / NXCD, r = nwg % NXCD, xcd = wgid % NXCD, off = wgid / NXCD; wgid = (xcd < r ? xcd * (q + 1) : r * (q + 1) + (xcd - r) * q) + off; }
        const int nig = WGM * nN, gid = wgid / nig, fm = gid * WGM, gsz = (nM - fm) < WGM ? (nM - fm) : WGM;
        u.pm = fm + ((wgid % nig) % gsz); u.pn = (wgid % nig) / gsz; return true;
    }
    __device__ __forceinline__ void a_ready(const Unit&) const {}
    __device__ __forceinline__ void done(const Unit&) const {}
};

__device__ __forceinline__ unsigned cvt_pk_bf16(float lo, float hi) { unsigned r; asm volatile("v_cvt_pk_bf16_f32 %0, %1, %2" : "=v"(r) : "v"(lo), "v"(hi)); return r; }
typedef float f32x2 __attribute__((ext_vector_type(2)));
__device__ __forceinline__ f32x2 gelu_pk(f32x2 v) {
    const f32x2 av = __builtin_elementwise_abs(v), d = av * 0.2316418882f + 1.0f;
    f32x2 t; t.x = __builtin_amdgcn_rcpf(d.x); t.y = __builtin_amdgcn_rcpf(d.y);
    f32x2 q = t * 0.5307027145f + (-0.7265760135f); q = q * t + 0.7107068705f; q = q * t + (-0.142248368f); q = q * t + 0.127414796f; q = q * t;
    const f32x2 s = (v * v) * (-0.72134752044f);
    f32x2 e; e.x = __builtin_amdgcn_exp2f(s.x); e.y = __builtin_amdgcn_exp2f(s.y);
    const f32x2 m = v * (q * e), r = v - m;
    f32x2 o; o.x = v.x < 0.f ? m.x : r.x; o.y = v.y < 0.f ? m.y : r.y; return o;
}

template <int ACT  > struct EpiBf16 {
    static constexpr bool PERM = true, AFTER_DRAIN = false; static_assert(ACT == 0 || ACT == 1, "EpiBf16: ACT is 0 (none) or 1 (gelu_pk)");
    bf16_t* O; int ldc; const float* bias; int split_cols; size_t split_stride; float scale0;
    __device__ __forceinline__ void operator()(const f32x4 (&acc)[2][2][4][2], const Unit& u, int wr, int wc, int fr, int fq) const {
        const int row0 = u.pm * BM + wr * 64 + fr; int colt = u.pn * BM; bf16_t* base = O;
        float sc = 1.f; if (split_cols) { const int t = colt / split_cols; base += (size_t)t * split_stride; colt -= t * split_cols; if (t == 0) sc = scale0; }
        const int col0 = colt + wc * 32 + 8 * fq, bcol0 = u.pn * BM + wc * 32 + 8 * fq;
        f32x4 bv[2][2];
#pragma unroll
        for (int bj = 0; bj < 2; ++bj)
#pragma unroll
            for (int n = 0; n < 2; ++n) bv[bj][n] = bias ? *(const f32x4*)(bias + bcol0 + bj * HALF + 4 * n) : (f32x4){0.f, 0.f, 0.f, 0.f};
#pragma unroll
        for (int ai = 0; ai < 2; ++ai)
#pragma unroll
            for (int m = 0; m < 4; ++m) { bf16_t* rowp = base + (size_t)(row0 + ai * HALF + m * 16) * ldc + col0;
#pragma unroll
                for (int bj = 0; bj < 2; ++bj) { f32x4 v0 = acc[ai][bj][m][0] + bv[bj][0], v1 = acc[ai][bj][m][1] + bv[bj][1];
                    if (ACT == 1) { f32x2 a = gelu_pk((f32x2){v0[0], v0[1]}), b = gelu_pk((f32x2){v0[2], v0[3]}), c = gelu_pk((f32x2){v1[0], v1[1]}), d = gelu_pk((f32x2){v1[2], v1[3]});
                        v0 = (f32x4){a.x, a.y, b.x, b.y}; v1 = (f32x4){c.x, c.y, d.x, d.y}; }
                    v0 = v0 * sc; v1 = v1 * sc; u32x4 w; w.x = cvt_pk_bf16(v0[0], v0[1]); w.y = cvt_pk_bf16(v0[2], v0[3]); w.z = cvt_pk_bf16(v1[0], v1[1]); w.w = cvt_pk_bf16(v1[2], v1[3]);
                    *(u32x4*)(rowp + bj * HALF) = w; } }
    }
};

template <class Epi, class Sched, bool ALIGN_EPI = false, bool SP2 = false>
__device__ __forceinline__ void gemm_phase(PG8_LAS unsigned char* lds, const Gemm g, const Sched& S, const Epi& E) {
    const int tid = threadIdx.x, wid = __builtin_amdgcn_readfirstlane(tid >> 6), lane = tid & 63, wr = wid >> 2, wc = wid & 3, fr = lane & 15, fq = lane >> 4;
    const int K = g.K, nt = K / BK;
    unsigned voffA[2], voffB[2];
#pragma unroll
    for (int i = 0; i < 2; ++i) { int R, C; stage_rc(tid * 16 + i * 8192, R, C); const int Rb = Epi::PERM ? ((R & ~31) + perm32(R & 31)) : R;
        voffA[i] = (unsigned)(R * K + C) * 2u; voffB[i] = (unsigned)(Rb * K + C) * 2u; }
    const size_t kstep = (size_t)(BK * 2);
    const size_t hstep = (size_t)HALF * K * 2;
    const size_t tstep = 2 * hstep;
    const unsigned ldsw = (unsigned)wid * 1024u;
    const int aoff = lds_byte(wr * 64 + fr, fq * 8), boff = lds_byte(wc * 32 + fr, fq * 8);
#define PG8_SA(b, h) (((b) * 2 + (h)) * HTB)
#define PG8_SB(b, h) ((4 + (b) * 2 + (h)) * HTB)
#define PG8_STAGE(bufoff, gbase, voff) do { _Pragma("unroll") for (int _i = 0; _i < 2; ++_i) \
        __builtin_amdgcn_global_load_lds((const unsigned*)((const char*)(gbase) + (voff)[_i]), (PG8_LAS unsigned*)(lds + (bufoff) + ldsw + _i * 8192), 16, 0, 0); } while (0)
#define PG8_LDA(dst, b, h) do { _Pragma("unroll") for (int m = 0; m < 4; ++m) _Pragma("unroll") for (int k = 0; k < 2; ++k) dst[m][k] = *(const PG8_LAS bf16x8*)(lds + PG8_SA(b, h) + aoff + m * 2048 + k * 1024); } while (0)
#define PG8_LDB(dst, b, h) do { _Pragma("unroll") for (int n = 0; n < 2; ++n) _Pragma("unroll") for (int k = 0; k < 2; ++k) dst[n][k] = *(const PG8_LAS bf16x8*)(lds + PG8_SB(b, h) + boff + n * 2048 + k * 1024); } while (0)
#define PG8_MMA(ai, bj, At, Bt) do { __builtin_amdgcn_s_setprio(1); _Pragma("unroll") for (int m = 0; m < 4; ++m) _Pragma("unroll") for (int n = 0; n < 2; ++n) _Pragma("unroll") for (int k = 0; k < 2; ++k) \
        acc[ai][bj][m][n] = __builtin_amdgcn_mfma_f32_16x16x32_bf16(Bt[n][k], At[m][k], acc[ai][bj][m][n], 0, 0, 0); __builtin_amdgcn_s_setprio(0); } while (0)
#define PG8_WAIT_V(n) asm volatile("s_waitcnt vmcnt(" #n ")" ::: "memory")
#define PG8_WAIT_L(n) asm volatile("s_waitcnt lgkmcnt(" #n ")" ::: "memory")
#define PG8_BAR __builtin_amdgcn_s_barrier()
#define PG8_SCHED __builtin_amdgcn_sched_barrier(0)
    Unit cur, nxt; int ui = 0;
    if (!S.next(0, cur)) return;
    f32x4 acc[2][2][4][2];
#pragma unroll
    for (int a = 0; a < 2; ++a)
#pragma unroll
        for (int b = 0; b < 2; ++b)
#pragma unroll
            for (int m = 0; m < 4; ++m)
#pragma unroll
                for (int n = 0; n < 2; ++n) acc[a][b][m][n] = (f32x4){0.f, 0.f, 0.f, 0.f};
    bf16x8 At[4][2], B0[2][2], B1[2][2];
    const char* cA = (const char*)g.A + (size_t)cur.pm * tstep; const char* cB = (const char*)g.Bt + (size_t)cur.pn * tstep;
    S.a_ready(cur);
    if constexpr (SP2) {
        PG8_STAGE(PG8_SB(0, 0), cB, voffB); PG8_STAGE(PG8_SB(0, 1), cB + hstep, voffB); PG8_STAGE(PG8_SA(0, 0), cA, voffA); PG8_STAGE(PG8_SA(0, 1), cA + hstep, voffA);
        if (wr == 1) PG8_BAR;
        PG8_WAIT_V(2); PG8_BAR;
        PG8_STAGE(PG8_SB(1, 0), cB + kstep, voffB); PG8_STAGE(PG8_SA(1, 0), cA + kstep, voffA); PG8_STAGE(PG8_SB(1, 1), cB + hstep + kstep, voffB);
        PG8_WAIT_V(6); PG8_BAR;
    } else {
        PG8_STAGE(PG8_SB(0, 0), cB, voffB); PG8_STAGE(PG8_SA(0, 0), cA, voffA); PG8_STAGE(PG8_SB(0, 1), cB + hstep, voffB); PG8_STAGE(PG8_SA(0, 1), cA + hstep, voffA);
        if (wr == 1) PG8_BAR;
        PG8_WAIT_V(4); PG8_BAR;
        PG8_STAGE(PG8_SB(1, 0), cB + kstep, voffB); PG8_STAGE(PG8_SA(1, 0), cA + kstep, voffA); PG8_STAGE(PG8_SB(1, 1), cB + hstep + kstep, voffB);
        PG8_WAIT_V(6); PG8_BAR;
    }
    for (;;) {
        const bool has_next = S.next(ui + 1, nxt);
        const char* nA = has_next ? (const char*)g.A + (size_t)nxt.pm * tstep : cA; const char* nB = has_next ? (const char*)g.Bt + (size_t)nxt.pn * tstep : cB;
        for (int t = 0; t < nt; t += 2) {
            const bool last = (t == nt - 2);
            const char* a1 = cA + (size_t)(t + 1) * kstep;
            const char* a2 = last ? nA : cA + (size_t)(t + 2) * kstep; const char* b2 = last ? nB : cB + (size_t)(t + 2) * kstep;
            const char* a3 = a2 + kstep; const char* b3 = b2 + kstep;
            if (last && has_next) S.a_ready(nxt);
            if constexpr (SP2) {
            PG8_LDB(B0, 0, 0); PG8_LDB(B1, 0, 1); PG8_SCHED; PG8_LDA(At, 0, 0); PG8_STAGE(PG8_SA(1, 1), a1 + hstep, voffA);
            PG8_WAIT_V(8); PG8_WAIT_L(0); PG8_BAR; PG8_MMA(0, 0, At, B0); PG8_MMA(0, 1, At, B1); PG8_BAR; PG8_SCHED;
            PG8_LDA(At, 0, 1); PG8_STAGE(PG8_SB(0, 0), b2, voffB); PG8_STAGE(PG8_SB(0, 1), b2 + hstep, voffB); PG8_STAGE(PG8_SA(0, 0), a2, voffA);
            PG8_WAIT_V(8); PG8_WAIT_L(0); PG8_BAR; PG8_MMA(1, 0, At, B0); PG8_MMA(1, 1, At, B1); PG8_BAR; PG8_SCHED;
            PG8_LDB(B0, 1, 0); PG8_LDB(B1, 1, 1); PG8_SCHED; PG8_LDA(At, 1, 0); PG8_STAGE(PG8_SA(0, 1), a2 + hstep, voffA);
            PG8_WAIT_V(8); PG8_WAIT_L(0); PG8_BAR; PG8_MMA(0, 0, At, B0); PG8_MMA(0, 1, At, B1); PG8_BAR; PG8_SCHED;
            PG8_LDA(At, 1, 1); PG8_STAGE(PG8_SB(1, 0), b3, voffB); PG8_STAGE(PG8_SB(1, 1), b3 + hstep, voffB); PG8_STAGE(PG8_SA(1, 0), a3, voffA);
            PG8_WAIT_V(8); PG8_WAIT_L(0); PG8_BAR; PG8_MMA(1, 0, At, B0); PG8_MMA(1, 1, At, B1); PG8_BAR; PG8_SCHED;
            } else {
            PG8_LDB(B0, 0, 0); PG8_SCHED; PG8_LDA(At, 0, 0); PG8_STAGE(PG8_SA(1, 1), a1 + hstep, voffA);
            PG8_WAIT_L(8); PG8_BAR; PG8_WAIT_L(0); PG8_MMA(0, 0, At, B0); PG8_BAR; PG8_SCHED;
            PG8_LDB(B1, 0, 1); PG8_STAGE(PG8_SB(0, 0), b2, voffB);
            PG8_BAR; PG8_WAIT_L(0); PG8_MMA(0, 1, At, B1); PG8_BAR;
            PG8_LDA(At, 0, 1); PG8_STAGE(PG8_SA(0, 0), a2, voffA);
            PG8_BAR; PG8_WAIT_L(0); PG8_MMA(1, 0, At, B0); PG8_BAR; PG8_SCHED;
            PG8_STAGE(PG8_SB(0, 1), b2 + hstep, voffB);
            PG8_WAIT_V(6); PG8_BAR; PG8_MMA(1, 1, At, B1); PG8_BAR;
            PG8_LDB(B0, 1, 0); PG8_SCHED; PG8_LDA(At, 1, 0); PG8_STAGE(PG8_SA(0, 1), a2 + hstep, voffA);
            PG8_WAIT_L(8); PG8_BAR; PG8_WAIT_L(0); PG8_MMA(0, 0, At, B0); PG8_BAR; PG8_SCHED;
            PG8_LDB(B1, 1, 1); PG8_STAGE(PG8_SB(1, 0), b3, voffB);
            PG8_BAR; PG8_WAIT_L(0); PG8_MMA(0, 1, At, B1); PG8_BAR;
            PG8_LDA(At, 1, 1); PG8_STAGE(PG8_SA(1, 0), a3, voffA);
            PG8_BAR; PG8_WAIT_L(0); PG8_MMA(1, 0, At, B0); PG8_BAR; PG8_SCHED;
            PG8_STAGE(PG8_SB(1, 1), b3 + hstep, voffB);
            PG8_WAIT_V(6); PG8_BAR; PG8_MMA(1, 1, At, B1); PG8_BAR;
            }
        }
        if constexpr (ALIGN_EPI) { if (wr == 0) PG8_BAR; }
        if constexpr (!Epi::AFTER_DRAIN) { E(acc, cur, wr, wc, fr, fq); S.done(cur); }
        if (!has_next) break;
#pragma unroll
        for (int a = 0; a < 2; ++a)
#pragma unroll
            for (int b = 0; b < 2; ++b)
#pragma unroll
                for (int m = 0; m < 4; ++m)
#pragma unroll
                    for (int n = 0; n < 2; ++n) acc[a][b][m][n] = (f32x4){0.f, 0.f, 0.f, 0.f};
        cur = nxt; cA = nA; cB = nB; ++ui;
        if constexpr (ALIGN_EPI) { if (wr == 1) PG8_BAR; }
    }
    PG8_WAIT_V(0);
    if constexpr (!ALIGN_EPI) { if (wr == 0) PG8_BAR; }
    PG8_BAR;
    if constexpr (Epi::AFTER_DRAIN) { E.fused(acc, cur, wr, wc, fr, fq, lds, wid, lane); S.done(cur); }
#undef PG8_SA
#undef PG8_SB
#undef PG8_STAGE
#undef PG8_LDA
#undef PG8_LDB
#undef PG8_MMA
#undef PG8_WAIT_V
#undef PG8_WAIT_L
#undef PG8_BAR
#undef PG8_SCHED
}
}
#define GAS __attribute__((address_space(1)))
#define LAS __attribute__((address_space(3)))
typedef unsigned short bf16;
typedef unsigned v4u __attribute__((ext_vector_type(4)));
typedef float f32x4 __attribute__((ext_vector_type(4)));
typedef short bf16x8 __attribute__((ext_vector_type(8)));
typedef GAS unsigned gu32;
typedef GAS unsigned long long gu64;
#define RLX_AGENT __ATOMIC_RELAXED, __HIP_MEMORY_SCOPE_AGENT
#define LDS_WAIT() asm volatile("s_waitcnt lgkmcnt(0)" ::: "memory")
#define VM_WAIT() asm volatile("s_waitcnt vmcnt(0)" ::: "memory")
__device__ __forceinline__ unsigned long long rt() { return __builtin_amdgcn_s_memrealtime(); }
__device__ __forceinline__ unsigned f2bf(float f) { unsigned u = __builtin_bit_cast(unsigned, f); return (u + 0x7fffu + ((u >> 16) & 1u)) >> 16; }
__device__ __forceinline__ unsigned pk2(float lo, float hi) { return f2bf(lo) | (f2bf(hi) << 16); }

#define XB_TMO      128
#define XB_XCNT(j)  (256  + 64 * (j))
#define XB_XSUB(j)  (1280 + 64 * (j))
#define XB_XGEN(j)  (2304 + 64 * (j))
#define XB_TOP      3328
#define XB_TOPGEN   3392
#define XCD_BAR_WORDS 3456
#define XB_SPIN_CAP (1u << 18)

__device__ __forceinline__ unsigned xb_ld(unsigned* p)              { return __hip_atomic_load(p, __ATOMIC_RELAXED, __HIP_MEMORY_SCOPE_AGENT); }
__device__ __forceinline__ unsigned xb_add(unsigned* p, unsigned v) { return __hip_atomic_fetch_add(p, v, __ATOMIC_RELAXED, __HIP_MEMORY_SCOPE_AGENT); }
__device__ __forceinline__ unsigned xb_xcc_id() { return (unsigned)__builtin_amdgcn_s_getreg((3 << 11) | 20) & 0xFu; }
#define XB_SPIN(cond, bar) do { unsigned _sp = 0; while (cond) { __builtin_amdgcn_s_sleep(1); \
    if ((++_sp & 255u) == 0u) { if (xb_ld(&(bar)[XB_TMO])) break; if (_sp > XB_SPIN_CAP) { atomicAdd(&(bar)[XB_TMO], 1u); break; } } } } while (0)

struct XcdBarrier {
    unsigned* bar; unsigned x;
    volatile LAS unsigned* st;
};

__device__ __forceinline__ XcdBarrier xcd_barrier_post(unsigned* bar, volatile LAS unsigned* st) {
    XcdBarrier b; b.bar = bar; b.x = xb_xcc_id(); b.st = st;
    if (threadIdx.x == 0) (void)xb_add(&bar[XB_XCNT(b.x)], 1u);
    return b;
}
__device__ __forceinline__ void xcd_barrier_complete(unsigned* bar, unsigned x, unsigned& nloc, unsigned& nx) {
    const unsigned G = gridDim.x * gridDim.y * gridDim.z;
    unsigned sum, cnt, mine, sp = 0u;
    for (;;) {
        sum = 0u; cnt = 0u; mine = 0u;
#pragma unroll
        for (unsigned j = 0; j < 16; ++j) { const unsigned c = xb_ld(&bar[XB_XCNT(j)]); sum += c; cnt += (c > 0u) ? 1u : 0u; mine = (j == x) ? c : mine; }
        if (sum == G) break;
        __builtin_amdgcn_s_sleep(1);
        if ((++sp & 255u) == 0u) { if (xb_ld(&bar[XB_TMO])) break; if (sp > XB_SPIN_CAP) { atomicAdd(&bar[XB_TMO], 1u); break; } }
    }
    nloc = mine > 0u ? mine : 1u; nx = cnt > 0u ? cnt : 1u;
}

__device__ __forceinline__ void xcd_barrier(const XcdBarrier& b) {
    asm volatile("s_waitcnt vmcnt(0)" ::: "memory");
    __syncthreads();
    if (threadIdx.x == 0) {
        unsigned* bar = b.bar;
        __builtin_amdgcn_s_waitcnt(0);
        unsigned nloc = b.st[0], nx = b.st[1];
        if (nloc == 0u) { xcd_barrier_complete(bar, b.x, nloc, nx); b.st[0] = nloc; b.st[1] = nx; }
        const unsigned old = xb_add(&bar[XB_XSUB(b.x)], 1u);
        const unsigned gen = old / nloc;
        if (old + 1u == (gen + 1u) * nloc) {
            __builtin_amdgcn_fence(__ATOMIC_RELEASE, "agent");
            asm volatile("s_waitcnt vmcnt(0)" ::: "memory");
            const unsigned og = xb_add(&bar[XB_TOP], 1u);
            const unsigned tg = og / nx;
            if (og + 1u == (tg + 1u) * nx) xb_add(&bar[XB_TOPGEN], 1u);
            else XB_SPIN(xb_ld(&bar[XB_TOPGEN]) == tg, bar);
            __builtin_amdgcn_fence(__ATOMIC_ACQUIRE, "agent");
            xb_add(&bar[XB_XGEN(b.x)], 1u);
            asm volatile("s_waitcnt vmcnt(0)" ::: "memory");
        } else {
            XB_SPIN(xb_ld(&bar[XB_XGEN(b.x)]) == gen, bar);
            __builtin_amdgcn_fence(__ATOMIC_ACQUIRE, "agent");
            asm volatile("s_waitcnt vmcnt(0)" ::: "memory");
        }
    }
    __syncthreads();
}
constexpr int NWAVES = 8;
constexpr int D = 1024, BATCH = 8, SEQ = 2048, T = BATCH * SEQ;
constexpr int AW = 512, RW = 512, NH = 8;
constexpr int DL = 64, AL = 64, GL = 128;
constexpr int SHIFTW = 3 * RW + DL + AL + GL;
constexpr int INW = 3 * AW + SHIFTW;
constexpr int NKEYS = 128, PH = 8, PKD = 256, TOPK = 16, HK = PH * TOPK;
constexpr int QW = PH * PKD;
constexpr int MODW = 6 * D;

constexpr size_t MiB = 1u << 20;
constexpr size_t WS_CTL = 0, CTL_ZERO_BYTES = 1 * MiB;
constexpr size_t WS_MOD = 1 * MiB;
constexpr size_t WS_KEYS = 1 * MiB + 512 * 1024;
constexpr size_t WS_WIN = 2 * MiB;
constexpr size_t WS_WOUT = 9 * MiB;
constexpr size_t WS_WQ = 11 * MiB;
constexpr size_t WS_XN = 16 * MiB;
constexpr size_t WS_O3 = 16 * MiB;
constexpr size_t WS_LSE = 32 * MiB;
constexpr size_t WS_Z = 48 * MiB;
constexpr size_t WS_MIX = 152 * MiB;
constexpr size_t WS_Y = 184 * MiB;
constexpr size_t WS_Q = 48 * MiB;
constexpr size_t WS_IDX = 112 * MiB;
constexpr size_t WS_GATE = 120 * MiB;
constexpr size_t WS_UT = 152 * MiB;
constexpr size_t WS_VT = 184 * MiB;
constexpr size_t WS_BON = 248 * MiB;
constexpr size_t WS_END = 249 * MiB;
constexpr int CW_BAR = 4096;
constexpr int MAX_LAUNCHES = 12;

constexpr int RING_OFF = 0, RING_BYTES = 131072;
constexpr int LDSCTL_OFF = RING_BYTES, MISC_OFF = LDSCTL_OFF + 320;
constexpr int LDS_BYTES = 147456;

typedef GAS float gf32;
typedef GAS f32x4 gf32x4;

__device__ __forceinline__ float bf2f(bf16 v) { return __uint_as_float(((unsigned)v) << 16); }
__device__ __forceinline__ float wave_sum(float v) {
#pragma unroll
    for (int o = 1; o < 64; o <<= 1) v += __shfl_xor(v, o);
    return v;
}
#define WAVE_LDS_SYNC() do { asm volatile("s_waitcnt lgkmcnt(0)" ::: "memory"); __builtin_amdgcn_wave_barrier(); } while (0)

__device__ __forceinline__ void p0_transpose_item(const float* W, int K, int N, bf16* WT, int row_off, LAS float* scr, int item, int lane) {
    const int nblk = N / 32, kb = item / nblk, nb = item % nblk, k0 = 64 * kb, n0 = 32 * nb;
#pragma unroll 8
    for (int i = 0; i < 32; ++i) { const int kk = 2 * i + (lane >> 5); scr[kk * 33 + (lane & 31)] = W[(size_t)(k0 + kk) * N + n0 + (lane & 31)]; }
    LDS_WAIT(); asm volatile("" ::: "memory");
    const int c = lane & 7;
#pragma unroll
    for (int j = 0; j < 4; ++j) { const int n = (lane >> 3) + 8 * j; const LAS float* s = scr + (8 * c) * 33 + n;
        v4u o; o.x = pk2(s[0 * 33], s[1 * 33]); o.y = pk2(s[2 * 33], s[3 * 33]); o.z = pk2(s[4 * 33], s[5 * 33]); o.w = pk2(s[6 * 33], s[7 * 33]);
        *(GAS v4u*)(WT + (size_t)(row_off + n0 + n) * K + k0 + 8 * c) = o; }
    LDS_WAIT(); asm volatile("" ::: "memory");
}

__device__ __forceinline__ void norm_row(const float* xrow, const float* g, const float* modb, int shift_off, int scale_off, bf16* orow, int lane) {
    const GAS f32x4* xr = (const GAS f32x4*)xrow + lane;
    f32x4 v[4]; float s = 0.f;
#pragma unroll
    for (int j = 0; j < 4; ++j) { v[j] = xr[64 * j]; s += (v[j].x * v[j].x + v[j].y * v[j].y) + (v[j].z * v[j].z + v[j].w * v[j].w); }
    const float rs = 1.0f / sqrtf(wave_sum(s) * (1.f / D) + 1e-6f);
    GAS unsigned long long* o8 = (GAS unsigned long long*)orow + lane;
#pragma unroll
    for (int j = 0; j < 4; ++j) {
        const int col = 256 * j + 4 * lane;
        const f32x4 g4 = *(const GAS f32x4*)(g + col), sc = *(const GAS f32x4*)(modb + scale_off + col), sh = *(const GAS f32x4*)(modb + shift_off + col);
        const f32x4 y = v[j] * rs * g4 * (sc + 1.0f) + sh;
        o8[64 * j] = (unsigned long long)pk2(y.x, y.y) | ((unsigned long long)pk2(y.z, y.w) << 32);
    }
}

struct EpiRes {
    static constexpr bool PERM = false, AFTER_DRAIN = false;
    const float* xres; const float* mod; int gate_off; float* out; int ldc;
    __device__ __forceinline__ void operator()(const pg8::f32x4 (&acc)[2][2][4][2], const pg8::Unit& u, int wr, int wc, int fr, int fq) const {
        const int col0 = u.pn * pg8::BM + wc * 32 + 4 * fq;
        const int b = (u.pm * pg8::BM) / SEQ;
        pg8::f32x4 gv[2][2];
#pragma unroll
        for (int bj = 0; bj < 2; ++bj)
#pragma unroll
            for (int n = 0; n < 2; ++n) gv[bj][n] = *(const pg8::f32x4*)(mod + b * MODW + gate_off + col0 + bj * pg8::HALF + n * 16);
#pragma unroll
        for (int ai = 0; ai < 2; ++ai)
#pragma unroll
            for (int m = 0; m < 4; ++m) { const size_t off = (size_t)(u.pm * pg8::BM + ai * pg8::HALF + wr * 64 + m * 16 + fr) * ldc + col0;
#pragma unroll
                for (int bj = 0; bj < 2; ++bj)
#pragma unroll
                    for (int n = 0; n < 2; ++n) { const pg8::f32x4 bs = *(const pg8::f32x4*)(xres + off + bj * pg8::HALF + n * 16);
                        *(pg8::f32x4*)(out + off + bj * pg8::HALF + n * 16) = bs + gv[bj][n] * acc[ai][bj][m][n]; } }
    }
};

namespace scan {
typedef unsigned u32x2 __attribute__((ext_vector_type(2)));
constexpr int SLOT = 1024, BUF_BYTES = 12800, NBUF = 8;
constexpr int OFF_LORA = NBUF * BUF_BYTES;
constexpr int OFF_CONST = OFF_LORA + 16 * SLOT;
constexpr int OFF_MT = OFF_CONST + 4096;
constexpr int SCAN_LDS = OFF_MT + 4 * 1024;
static_assert(SCAN_LDS <= 131072, "scan LDS map");
constexpr int S_KK = 0, S_R = 2, S_MT = 4, S_N = 5, S_BK = 6, S_V = 10, S_GC = 12;

typedef float f32x2n __attribute__((ext_vector_type(2)));
typedef __bf16 bf16x2n __attribute__((ext_vector_type(2)));
__device__ __forceinline__ unsigned cvtpk(float lo, float hi) { const f32x2n v = {lo, hi}; const bf16x2n b = __builtin_convertvector(v, bf16x2n); return __builtin_bit_cast(unsigned, b); }
__device__ __forceinline__ bf16x8 mkfrag(unsigned a, unsigned b, unsigned c, unsigned d) { v4u w; w.x = a; w.y = b; w.z = c; w.w = d; return __builtin_bit_cast(bf16x8, w); }
__device__ __forceinline__ bf16x8 frag8(const float (&lo)[4], const float (&hi)[4]) { return mkfrag(cvtpk(lo[0], lo[1]), cvtpk(lo[2], lo[3]), cvtpk(hi[0], hi[1]), cvtpk(hi[2], hi[3])); }
__device__ __forceinline__ f32x4 mma(bf16x8 a, bf16x8 b, f32x4 c) { return __builtin_amdgcn_mfma_f32_16x16x32_bf16(a, b, c, 0, 0, 0); }
template <int N> __device__ __forceinline__ float row_shr(float x) { return __int_as_float(__builtin_amdgcn_update_dpp(0, __float_as_int(x), 0x110 + N, 0xf, 0xf, true)); }
__device__ __forceinline__ float fsigmoid(float x) { return 1.0f / (1.0f + __expf(-x)); }

__device__ __forceinline__ void setup(LAS unsigned char* L, int h, int dir, const float* mu_prev, const float* mu_next, const float* w_decay0, const float* w_decay_up,
                                      const float* a_gate0, const float* a_gate_up, const float* k_k, const float* k_a, const float* r_k, int tid) {
    LAS float* C = (LAS float*)(L + OFF_CONST);
    for (int i = tid; i < 320; i += 512) {
        const int grp = i >> 6, c = i & 63;
        const int col = (grp < 3) ? grp * RW + h * 64 + c : 3 * RW + (grp - 3) * 64 + c;
        C[i] = mu_prev[col]; C[320 + i] = mu_next[col];
    }
    if (tid < 64) { const int hc = h * 64 + tid; C[640 + tid] = w_decay0[dir * RW + hc]; C[704 + tid] = a_gate0[dir * RW + hc]; C[768 + tid] = k_k[hc]; C[832 + tid] = k_a[hc]; C[896 + tid] = r_k[hc]; }
    LAS bf16* F = (LAS bf16*)(L + OFF_LORA);
    for (int i = tid; i < 16 * 64 * 8; i += 512) {
        const int j = i & 7, l = (i >> 3) & 63, sl = i >> 9, m = sl & 1, ct = (sl >> 1) & 3, wa = sl >> 3;
        const int g = l >> 4, jj = 32 * m + (j < 4 ? 4 * g + j : 16 + 4 * g + j - 4), c = h * 64 + 16 * ct + (l & 15);
        const float v = wa ? a_gate_up[(size_t)(dir * AL + jj) * RW + c] : w_decay_up[(size_t)(dir * DL + jj) * RW + c];
        F[i] = (bf16)f2bf(v);
    }
}

__device__ __forceinline__ void helper_chunk(LAS unsigned char* L, LAS unsigned char* buf, LAS float* MT, const bf16* Z, float* BON, int b, int h, int dir, int n, int lane) {
    const int s = lane & 15, g = lane >> 4;
    const int cn = dir ? (SEQ / 16 - 1 - n) : n;
    const int t = cn * 16 + (dir ? 15 - s : s), tok = b * SEQ + t;
    const LAS float* C = (const LAS float*)(L + OFF_CONST);
    const bool hasp = t > 0, hasn = t < SEQ - 1;
    const bf16* zrow = Z + (size_t)tok * INW + 3 * AW;
    float rv[4][4], kv[4][4], vv[4][4], tw[4][4], xa[4][4];
#pragma unroll
    for (int grp = 0; grp < 5; ++grp) {
        const int cbase = (grp < 3) ? grp * RW + h * 64 : 3 * RW + (grp - 3) * 64;
#pragma unroll
        for (int ct = 0; ct < 4; ++ct) {
            const bf16* p = zrow + cbase + 16 * ct + 4 * g;
            const u32x2 zc = *(const u32x2*)p;
            u32x2 zp = *(const u32x2*)(hasp ? p - INW : p), zn = *(const u32x2*)(hasn ? p + INW : p);
            if (!hasp) { zp.x = 0u; zp.y = 0u; } if (!hasn) { zn.x = 0u; zn.y = 0u; }
            const f32x4 mp = *(const LAS f32x4*)(C + grp * 64 + 16 * ct + 4 * g), mn = *(const LAS f32x4*)(C + 320 + grp * 64 + 16 * ct + 4 * g);
            float zv[4] = {__uint_as_float(zc.x << 16), __uint_as_float(zc.x & 0xffff0000u), __uint_as_float(zc.y << 16), __uint_as_float(zc.y & 0xffff0000u)};
            float pv[4] = {__uint_as_float(zp.x << 16), __uint_as_float(zp.x & 0xffff0000u), __uint_as_float(zp.y << 16), __uint_as_float(zp.y & 0xffff0000u)};
            float nv[4] = {__uint_as_float(zn.x << 16), __uint_as_float(zn.x & 0xffff0000u), __uint_as_float(zn.y << 16), __uint_as_float(zn.y & 0xffff0000u)};
#pragma unroll
            for (int r = 0; r < 4; ++r) {
                const float o = zv[r] + mp[r] * (pv[r] - zv[r]) + mn[r] * (nv[r] - zv[r]);
                if (grp == 0) rv[ct][r] = o; else if (grp == 1) kv[ct][r] = o; else if (grp == 2) vv[ct][r] = o;
                else if (grp == 3) { const float e2 = __expf(2.0f * o); tw[ct][r] = 1.0f - 2.0f / (e2 + 1.0f); } else xa[ct][r] = o;
            }
        }
    }
#pragma unroll
    for (int ct = 0; ct < 4; ++ct)
#pragma unroll
        for (int r = 0; r < 4; ++r)
            *(LAS bf16*)(buf + (S_V + (ct >> 1)) * SLOT + (4 * g + r + 16 * (s >> 2)) * 16 + (ct & 1) * 8 + 2 * (s & 3)) = (bf16)f2bf(vv[ct][r]);
    f32x4 accw[4], acca[4];
    { const bf16x8 tb0 = frag8(tw[0], tw[1]), tb1 = frag8(tw[2], tw[3]), xb0 = frag8(xa[0], xa[1]), xb1 = frag8(xa[2], xa[3]);
      const LAS bf16x8* F = (const LAS bf16x8*)(L + OFF_LORA);
#pragma unroll
      for (int ct = 0; ct < 4; ++ct) {
          f32x4 z4 = {0.f, 0.f, 0.f, 0.f};
          accw[ct] = mma(F[(0 * 8 + ct * 2 + 0) * 64 + lane], tb0, z4); accw[ct] = mma(F[(0 * 8 + ct * 2 + 1) * 64 + lane], tb1, accw[ct]);
          acca[ct] = mma(F[(1 * 8 + ct * 2 + 0) * 64 + lane], xb0, z4); acca[ct] = mma(F[(1 * 8 + ct * 2 + 1) * 64 + lane], xb1, acca[ct]);
      } }
    float ev[4][4], kk[4][4], kd[4][4], bb[4][4];
    float ss = 0.f, bon = 0.f;
#pragma unroll
    for (int ct = 0; ct < 4; ++ct) {
        const f32x4 w0 = *(const LAS f32x4*)(C + 640 + 16 * ct + 4 * g), a0 = *(const LAS f32x4*)(C + 704 + 16 * ct + 4 * g), kkw = *(const LAS f32x4*)(C + 768 + 16 * ct + 4 * g),
                    kaw = *(const LAS f32x4*)(C + 832 + 16 * ct + 4 * g), rkw = *(const LAS f32x4*)(C + 896 + 16 * ct + 4 * g);
#pragma unroll
        for (int r = 0; r < 4; ++r) {
            ev[ct][r] = 0.60653065971f * fsigmoid(accw[ct][r] + w0[r]);
            const float a = fsigmoid(acca[ct][r] + a0[r]);
            const float k = kv[ct][r];
            kk[ct][r] = k * kkw[r]; ss += kk[ct][r] * kk[ct][r];
            kd[ct][r] = k * (1.0f + (a - 1.0f) * kaw[r]);
            bb[ct][r] = a;
            bon += rv[ct][r] * k * a * kaw[r] * rkw[r];
        }
    }
    ss += __shfl_xor(ss, 16); ss += __shfl_xor(ss, 32);
    bon += __shfl_xor(bon, 16); bon += __shfl_xor(bon, 32);
    if (g == 0) BON[((size_t)dir * T + tok) * NH + h] = bon;
    const float rn = 1.0f / sqrtf(fmaxf(ss, 1e-12f));
    float KKs[4][4], Rs[4][4], Bt[4][4], Kt[4][4];
#pragma unroll
    for (int ct = 0; ct < 4; ++ct) {
        float gcv[4];
#pragma unroll
        for (int r = 0; r < 4; ++r) {
            const float e = ev[ct][r];
            float cum = e;
            cum += row_shr<1>(cum); cum += row_shr<2>(cum); cum += row_shr<4>(cum); cum += row_shr<8>(cum);
            const float cumC = __shfl(cum, (lane & 48) | 15);
            const float kkn = kk[ct][r] * rn, bv = kkn * bb[ct][r];
            const float ig = __expf(cum), rat = __expf(cum - cumC);
            KKs[ct][r] = kkn * __expf(e - cum); Rs[ct][r] = rv[ct][r] * __expf(-cum);
            Bt[ct][r] = bv * ig; Kt[ct][r] = kd[ct][r] * ig;
            gcv[r] = __expf(-cumC);
            LAS unsigned char* q = buf + (S_BK + ct) * SLOT + (4 * g + r + 16 * (s >> 2)) * 16 + 2 * (s & 3);
            *(LAS bf16*)q = (bf16)f2bf(bv * rat); *(LAS bf16*)(q + 8) = (bf16)f2bf(kd[ct][r] * rat);
        }
        if (s == 15) *(LAS f32x4*)(buf + S_GC * SLOT + (16 * ct + 4 * g) * 4) = (f32x4){gcv[0], gcv[1], gcv[2], gcv[3]};
    }
    const bf16x8 fKK0 = frag8(KKs[0], KKs[1]), fKK1 = frag8(KKs[2], KKs[3]), fR0 = frag8(Rs[0], Rs[1]), fR1 = frag8(Rs[2], Rs[3]);
    const bf16x8 fB0 = frag8(Bt[0], Bt[1]), fB1 = frag8(Bt[2], Bt[3]), fK0 = frag8(Kt[0], Kt[1]), fK1 = frag8(Kt[2], Kt[3]);
    *(LAS bf16x8*)(buf + (S_KK + 0) * SLOT + lane * 16) = fKK0; *(LAS bf16x8*)(buf + (S_KK + 1) * SLOT + lane * 16) = fKK1;
    *(LAS bf16x8*)(buf + (S_R + 0) * SLOT + lane * 16) = fR0;  *(LAS bf16x8*)(buf + (S_R + 1) * SLOT + lane * 16) = fR1;
    const f32x4 z4 = {0.f, 0.f, 0.f, 0.f};
    { f32x4 mab = mma(fKK0, fB0, z4); mab = mma(fKK1, fB1, mab);
      *(LAS f32x4*)(MT + s * 16 + 4 * g) = mab; }
    f32x4 mak = mma(fK0, fKK0, z4); mak = mma(fK1, fKK1, mak);
    f32x4 nrb = mma(fB0, fR0, z4); nrb = mma(fB1, fR1, nrb);
    f32x4 nrk = mma(fK0, fR0, z4); nrk = mma(fK1, fR1, nrk);
#pragma unroll
    for (int r = 0; r < 4; ++r) { const int i = 4 * g + r; if (!(i < s)) mak[r] = 0.f; if (!(i <= s)) { nrb[r] = 0.f; nrk[r] = 0.f; } }
    *(LAS v4u*)(buf + S_N * SLOT + lane * 16) = (v4u){cvtpk(nrb[0], nrb[1]), cvtpk(nrb[2], nrb[3]), cvtpk(nrk[0], nrk[1]), cvtpk(nrk[2], nrk[3])};
    asm volatile("s_waitcnt lgkmcnt(0)" ::: "memory"); __builtin_amdgcn_wave_barrier();
    float Tr[16];
#pragma unroll
    for (int j = 15; j >= 0; --j) {
        float acc = 0.f;
#pragma unroll
        for (int i = j + 1; i < 16; ++i) acc += Tr[i] * MT[j * 16 + i];
        Tr[j] = (j == s) ? 1.0f : -acc;
        if (j > s) Tr[j] = 0.f;
    }
    float t0 = 0.f, t1 = 0.f, t2 = 0.f, t3 = 0.f;
#pragma unroll
    for (int gg = 0; gg < 4; ++gg) if (g == gg) { t0 = Tr[4 * gg]; t1 = Tr[4 * gg + 1]; t2 = Tr[4 * gg + 2]; t3 = Tr[4 * gg + 3]; }
    *(LAS v4u*)(buf + S_MT * SLOT + lane * 16) = (v4u){cvtpk(mak[0], mak[1]), cvtpk(mak[2], mak[3]), cvtpk(-t0, -t1), cvtpk(-t2, -t3)};
    asm volatile("s_waitcnt lgkmcnt(0)" ::: "memory"); __builtin_amdgcn_wave_barrier();
}

__device__ __forceinline__ void rec_chunk(const LAS unsigned char* buf, f32x4 (&st)[4], float* Y, int b, int h, int dir, int n, int w, int lane) {
    const int g = lane >> 4, col = lane & 15;
    const bf16x8 fKK0 = *(const LAS bf16x8*)(buf + (S_KK + 0) * SLOT + lane * 16), fKK1 = *(const LAS bf16x8*)(buf + (S_KK + 1) * SLOT + lane * 16);
    const bf16x8 fR0 = *(const LAS bf16x8*)(buf + (S_R + 0) * SLOT + lane * 16), fR1 = *(const LAS bf16x8*)(buf + (S_R + 1) * SLOT + lane * 16);
    const v4u mt = *(const LAS v4u*)(buf + S_MT * SLOT + lane * 16);
    const bf16x8 fN = *(const LAS bf16x8*)(buf + S_N * SLOT + lane * 16);
    const u32x2 vf = *(const LAS u32x2*)(buf + (S_V + (w >> 1)) * SLOT + lane * 16 + (w & 1) * 8);
    const f32x4 z4 = {0.f, 0.f, 0.f, 0.f};
    const bf16x8 sb0 = mkfrag(cvtpk(st[0][0], st[0][1]), cvtpk(st[0][2], st[0][3]), cvtpk(st[1][0], st[1][1]), cvtpk(st[1][2], st[1][3]));
    const bf16x8 sb1 = mkfrag(cvtpk(st[2][0], st[2][1]), cvtpk(st[2][2], st[2][3]), cvtpk(st[3][0], st[3][1]), cvtpk(st[3][2], st[3][3]));
    f32x4 p1 = mma(fKK0, sb0, z4); p1 = mma(fKK1, sb1, p1);
    f32x4 p2 = mma(fR0, sb0, z4); p2 = mma(fR1, sb1, p2);
    const f32x4 x = mma(mkfrag(0u, 0u, mt.x, mt.y), mkfrag(0u, 0u, vf.x, vf.y), p1);
    const f32x4 u = mma(mkfrag(mt.z, mt.w, 0u, 0u), mkfrag(cvtpk(x[0], x[1]), cvtpk(x[2], x[3]), 0u, 0u), z4);
    const bf16x8 buv = mkfrag(cvtpk(u[0], u[1]), cvtpk(u[2], u[3]), vf.x, vf.y);
    const f32x4 y = mma(fN, buv, p2);
#pragma unroll
    for (int i = 0; i < 4; ++i) {
        const f32x4 gc = *(const LAS f32x4*)(buf + S_GC * SLOT + (16 * i + 4 * g) * 4);
        const bf16x8 fBK = *(const LAS bf16x8*)(buf + (S_BK + i) * SLOT + lane * 16);
        st[i] = mma(fBK, buv, st[i] * gc);
    }
    const int cn = dir ? (SEQ / 16 - 1 - n) : n;
#pragma unroll
    for (int r = 0; r < 4; ++r) { const int s = 4 * g + r, t = cn * 16 + (dir ? 15 - s : s);
        Y[((size_t)dir * T + (size_t)(b * SEQ + t)) * RW + h * 64 + 16 * w + col] = y[r]; }
}

__device__ __forceinline__ void chain(LAS unsigned char* L, const bf16* Z, const float* mu_prev, const float* mu_next, const float* w_decay0, const float* w_decay_up,
                                      const float* a_gate0, const float* a_gate_up, const float* k_k, const float* k_a, const float* r_k, float* Y, float* BON, int ch, int tid, int wave, int lane) {
    const int dir = ch & 1, h = (ch >> 1) & 7, b = ch >> 4;
    __syncthreads();
    setup(L, h, dir, mu_prev, mu_next, w_decay0, w_decay_up, a_gate0, a_gate_up, k_k, k_a, r_k, tid);
    __syncthreads();
    f32x4 st[4];
#pragma unroll
    for (int i = 0; i < 4; ++i) st[i] = (f32x4){0.f, 0.f, 0.f, 0.f};
    constexpr int NCH = SEQ / 16, NR = NCH / 4;
    for (int q = -1; q < NR; ++q) {
        if (wave < 4) {
            if (q >= 0) {
#pragma unroll 1
                for (int i = 0; i < 4; ++i) rec_chunk(L + ((q & 1) * 4 + i) * BUF_BYTES, st, Y, b, h, dir, 4 * q + i, wave, lane);
            }
        } else if (q + 1 < NR) {
            const int hw = wave - 4;
            helper_chunk(L, L + (((q + 1) & 1) * 4 + hw) * BUF_BYTES, (LAS float*)(L + OFF_MT + hw * 1024), Z, BON, b, h, dir, 4 * (q + 1) + hw, lane);
        }
        __syncthreads();
    }
}
}

namespace attn {
typedef unsigned u32x2 __attribute__((ext_vector_type(2)));
constexpr int VT_STRIDE = 136;
constexpr int WAVE_LDS = 64 * VT_STRIDE;
constexpr float LOG2E = 1.44269504088896f, LN2 = 0.693147180559945f;
using scan::cvtpk; using scan::mkfrag; using scan::mma;

__device__ __forceinline__ void unpack8(const v4u w, float (&f)[8]) {
    f[0] = __uint_as_float(w.x << 16); f[1] = __uint_as_float(w.x & 0xffff0000u); f[2] = __uint_as_float(w.y << 16); f[3] = __uint_as_float(w.y & 0xffff0000u);
    f[4] = __uint_as_float(w.z << 16); f[5] = __uint_as_float(w.z & 0xffff0000u); f[6] = __uint_as_float(w.w << 16); f[7] = __uint_as_float(w.w & 0xffff0000u);
}

__device__ __forceinline__ void unit(LAS unsigned char* vt, const bf16* Z, const float* qg, const float* kg, bf16* Ob, int opitch, float* lse_out,
                                     int b, int h, int d, int r, int qb, int nb, int lane) {
    const int g = lane >> 4, c16 = lane & 15;
    const float slope2 = exp2f(-(float)(h + 1)) * LOG2E * (float)d;
    float gn[16];
#pragma unroll
    for (int m = 0; m < 2; ++m)
#pragma unroll
        for (int j = 0; j < 8; ++j) gn[m * 8 + j] = qg[32 * m + 8 * g + j] * kg[32 * m + 8 * g + j];
    bf16x8 qf[4][2];
#pragma unroll
    for (int qt = 0; qt < 4; ++qt) {
        const int tok = b * SEQ + (qb * 64 + 16 * qt + c16) * d + r;
        const bf16* qp = Z + (size_t)tok * INW + h * 64 + 8 * g;
        float f0[8], f1[8]; unpack8(*(const v4u*)qp, f0); unpack8(*(const v4u*)(qp + 32), f1);
        float ss = 0.f;
#pragma unroll
        for (int j = 0; j < 8; ++j) ss += f0[j] * f0[j] + f1[j] * f1[j];
        ss += __shfl_xor(ss, 16); ss += __shfl_xor(ss, 32);
        const float rs = (0.125f * LOG2E) / sqrtf(ss * (1.f / 64.f) + 1e-6f);
        qf[qt][0] = mkfrag(cvtpk(f0[0] * rs * gn[0], f0[1] * rs * gn[1]), cvtpk(f0[2] * rs * gn[2], f0[3] * rs * gn[3]), cvtpk(f0[4] * rs * gn[4], f0[5] * rs * gn[5]), cvtpk(f0[6] * rs * gn[6], f0[7] * rs * gn[7]));
        qf[qt][1] = mkfrag(cvtpk(f1[0] * rs * gn[8], f1[1] * rs * gn[9]), cvtpk(f1[2] * rs * gn[10], f1[3] * rs * gn[11]), cvtpk(f1[4] * rs * gn[12], f1[5] * rs * gn[13]), cvtpk(f1[6] * rs * gn[14], f1[7] * rs * gn[15]));
    }
    f32x4 oacc[4][4];
    float mrun[4], lrun[4];
#pragma unroll
    for (int qt = 0; qt < 4; ++qt) { mrun[qt] = -1e30f; lrun[qt] = 0.f;
#pragma unroll
        for (int dt = 0; dt < 4; ++dt) oacc[dt][qt] = (f32x4){0.f, 0.f, 0.f, 0.f}; }
    const f32x4 z4 = {0.f, 0.f, 0.f, 0.f};
#pragma unroll 1
    for (int kb = qb - 1; kb <= qb + 1; ++kb) {
        if (kb < 0 || kb >= nb) continue;
        bf16x8 kf[4][2];
#pragma unroll
        for (int kblk = 0; kblk < 4; ++kblk) {
            const int tok = b * SEQ + (kb * 64 + 16 * kblk + c16) * d + r;
            const bf16* kp = Z + (size_t)tok * INW + AW + h * 64 + 8 * g;
            float f0[8], f1[8]; unpack8(*(const v4u*)kp, f0); unpack8(*(const v4u*)(kp + 32), f1);
            float ss = 0.f;
#pragma unroll
            for (int j = 0; j < 8; ++j) ss += f0[j] * f0[j] + f1[j] * f1[j];
            ss += __shfl_xor(ss, 16); ss += __shfl_xor(ss, 32);
            const float rsk = 1.0f / sqrtf(ss * (1.f / 64.f) + 1e-6f);
            kf[kblk][0] = mkfrag(cvtpk(f0[0] * rsk, f0[1] * rsk), cvtpk(f0[2] * rsk, f0[3] * rsk), cvtpk(f0[4] * rsk, f0[5] * rsk), cvtpk(f0[6] * rsk, f0[7] * rsk));
            kf[kblk][1] = mkfrag(cvtpk(f1[0] * rsk, f1[1] * rsk), cvtpk(f1[2] * rsk, f1[3] * rsk), cvtpk(f1[4] * rsk, f1[5] * rsk), cvtpk(f1[6] * rsk, f1[7] * rsk));
        }
#pragma unroll
        for (int i = 0; i < 8; ++i) {
            const int key = 8 * i + (lane >> 3), chunk = lane & 7;
            const int tok = b * SEQ + (kb * 64 + key) * d + r;
            const v4u w = *(const v4u*)(Z + (size_t)tok * INW + 2 * AW + h * 64 + 8 * chunk);
            LAS unsigned char* q = vt + (8 * chunk) * VT_STRIDE + 2 * key;
            *(LAS bf16*)(q + 0 * VT_STRIDE) = (bf16)(w.x & 0xffffu); *(LAS bf16*)(q + 1 * VT_STRIDE) = (bf16)(w.x >> 16);
            *(LAS bf16*)(q + 2 * VT_STRIDE) = (bf16)(w.y & 0xffffu); *(LAS bf16*)(q + 3 * VT_STRIDE) = (bf16)(w.y >> 16);
            *(LAS bf16*)(q + 4 * VT_STRIDE) = (bf16)(w.z & 0xffffu); *(LAS bf16*)(q + 5 * VT_STRIDE) = (bf16)(w.z >> 16);
            *(LAS bf16*)(q + 6 * VT_STRIDE) = (bf16)(w.w & 0xffffu); *(LAS bf16*)(q + 7 * VT_STRIDE) = (bf16)(w.w >> 16);
        }
        asm volatile("s_waitcnt lgkmcnt(0)" ::: "memory"); __builtin_amdgcn_wave_barrier();
        const int obase = (kb - qb) * 64;
#pragma unroll
        for (int qt = 0; qt < 4; ++qt) {
            f32x4 sa[4];
#pragma unroll
            for (int kblk = 0; kblk < 4; ++kblk) { sa[kblk] = mma(kf[kblk][0], qf[qt][0], z4); sa[kblk] = mma(kf[kblk][1], qf[qt][1], sa[kblk]); }
            const int qi = 16 * qt + c16;
            float mx = -1e30f;
#pragma unroll
            for (int kblk = 0; kblk < 4; ++kblk)
#pragma unroll
                for (int reg = 0; reg < 4; ++reg) {
                    const int o = obase + 16 * kblk + 4 * g + reg - qi, ao = o < 0 ? -o : o;
                    float sv = sa[kblk][reg] - slope2 * (float)ao;
                    sv = (ao <= 64) ? sv : -1e30f;
                    sa[kblk][reg] = sv; mx = fmaxf(mx, sv);
                }
            mx = fmaxf(mx, __shfl_xor(mx, 16)); mx = fmaxf(mx, __shfl_xor(mx, 32));
            const float mn = fmaxf(mrun[qt], mx), alpha = exp2f(mrun[qt] - mn);
            mrun[qt] = mn;
            float ls = 0.f;
#pragma unroll
            for (int kblk = 0; kblk < 4; ++kblk)
#pragma unroll
                for (int reg = 0; reg < 4; ++reg) { const float p = exp2f(sa[kblk][reg] - mn); sa[kblk][reg] = p; ls += p; }
            lrun[qt] = lrun[qt] * alpha + ls;
            const bf16x8 pf0 = mkfrag(cvtpk(sa[0][0], sa[0][1]), cvtpk(sa[0][2], sa[0][3]), cvtpk(sa[1][0], sa[1][1]), cvtpk(sa[1][2], sa[1][3]));
            const bf16x8 pf1 = mkfrag(cvtpk(sa[2][0], sa[2][1]), cvtpk(sa[2][2], sa[2][3]), cvtpk(sa[3][0], sa[3][1]), cvtpk(sa[3][2], sa[3][3]));
#pragma unroll
            for (int dt = 0; dt < 4; ++dt) {
                const LAS unsigned char* vr = vt + (16 * dt + c16) * VT_STRIDE + 8 * g;
                const u32x2 a0 = *(const LAS u32x2*)(vr), a1 = *(const LAS u32x2*)(vr + 32), a2 = *(const LAS u32x2*)(vr + 64), a3 = *(const LAS u32x2*)(vr + 96);
                f32x4 oc = oacc[dt][qt] * alpha;
                oc = mma(mkfrag(a0.x, a0.y, a1.x, a1.y), pf0, oc);
                oc = mma(mkfrag(a2.x, a2.y, a3.x, a3.y), pf1, oc);
                oacc[dt][qt] = oc;
            }
            __builtin_amdgcn_sched_barrier(0);
        }
        asm volatile("s_waitcnt lgkmcnt(0)" ::: "memory"); __builtin_amdgcn_wave_barrier();
    }
#pragma unroll
    for (int qt = 0; qt < 4; ++qt) {
        float lt = lrun[qt]; lt += __shfl_xor(lt, 16); lt += __shfl_xor(lt, 32);
        const float inv = 1.0f / lt;
        const int tok = b * SEQ + (qb * 64 + 16 * qt + c16) * d + r;
        bf16* op = Ob + (size_t)tok * opitch + h * 64 + 4 * g;
#pragma unroll
        for (int dt = 0; dt < 4; ++dt) { const f32x4 o = oacc[dt][qt] * inv; u32x2 w; w.x = cvtpk(o[0], o[1]); w.y = cvtpk(o[2], o[3]); *(u32x2*)(op + 16 * dt) = w; }
        if (g == 0) lse_out[(size_t)tok * NH + h] = (mrun[qt] + log2f(lt)) * LN2;
    }
}
}

namespace peer {
using scan::cvtpk; using scan::mkfrag; using scan::mma;
constexpr int KEY_SLOTS = 64;

template <int CTRL> __device__ __forceinline__ unsigned dppu(unsigned x) { return (unsigned)__builtin_amdgcn_update_dpp((int)x, (int)x, CTRL, 0xf, 0xf, false); }
__device__ __forceinline__ unsigned umax(unsigned a, unsigned b) { return a > b ? a : b; }
__device__ __forceinline__ unsigned rowmax16(unsigned x) { x = umax(x, dppu<0xB1>(x)); x = umax(x, dppu<0x4E>(x)); x = umax(x, dppu<0x141>(x)); x = umax(x, dppu<0x140>(x)); return x; }
__device__ __forceinline__ float rowsum16(float x) {
    x += __uint_as_float(dppu<0xB1>(__float_as_uint(x))); x += __uint_as_float(dppu<0x4E>(__float_as_uint(x)));
    x += __uint_as_float(dppu<0x141>(__float_as_uint(x))); x += __uint_as_float(dppu<0x140>(__float_as_uint(x))); return x;
}
__device__ __forceinline__ unsigned ordkey(float f) { const unsigned u = __float_as_uint(f); return (u & 0x80000000u) ? ~u : (u | 0x80000000u); }
__device__ __forceinline__ float unordkey(unsigned k) { return __uint_as_float((k & 0x80000000u) ? (k ^ 0x80000000u) : ~k); }

__device__ __forceinline__ void setup_keys(LAS unsigned char* L, const float* keys1, const float* keys2, int tid) {
    LAS bf16* F = (LAS bf16*)L;
    for (int i = tid; i < KEY_SLOTS * 64 * 8; i += 512) {
        const int j = i & 7, l = (i >> 3) & 63, sl = i >> 9, ks = sl & 3, nt = (sl >> 2) & 7, sel = sl >> 5;
        const int n = 16 * nt + (l & 15), k = 32 * ks + 8 * (l >> 4) + j;
        F[i] = (bf16)f2bf((sel ? keys2 : keys1)[n * 128 + k]);
    }
}

__device__ __forceinline__ void top16(unsigned (&key)[8][4], unsigned (&win)[4], int c16) {
#pragma unroll 1
    for (int k = 0; k < TOPK; ++k) {
#pragma unroll
        for (int reg = 0; reg < 4; ++reg) {
            unsigned m = key[0][reg];
#pragma unroll
            for (int nt = 1; nt < 8; ++nt) m = umax(m, key[nt][reg]);
            m = rowmax16(m);
            win[reg] = (c16 == k) ? m : win[reg];
#pragma unroll
            for (int nt = 0; nt < 8; ++nt) key[nt][reg] = (key[nt][reg] == m) ? 0u : key[nt][reg];
        }
    }
}

__device__ __forceinline__ void select_batch(const LAS unsigned char* L, const bf16* Q, int* IDX, float* GATE, int batch, int lane) {
    const int g = lane >> 4, c16 = lane & 15;
    const LAS bf16x8* F = (const LAS bf16x8*)L;
    const bf16* qp = Q + (size_t)(batch * 16 + c16) * PKD + 8 * g;
    unsigned w1[4] = {0u, 0u, 0u, 0u}, w2[4] = {0u, 0u, 0u, 0u};
#pragma unroll
    for (int sel = 0; sel < 2; ++sel) {
        unsigned key[8][4];
        bf16x8 a[4];
#pragma unroll
        for (int ks = 0; ks < 4; ++ks) a[ks] = *(const bf16x8*)(qp + sel * 128 + 32 * ks);
#pragma unroll
        for (int nt = 0; nt < 8; ++nt) {
            f32x4 sc = {0.f, 0.f, 0.f, 0.f};
#pragma unroll
            for (int ks = 0; ks < 4; ++ks) sc = mma(a[ks], F[((sel * 8 + nt) * 4 + ks) * 64 + lane], sc);
#pragma unroll
            for (int reg = 0; reg < 4; ++reg) key[nt][reg] = (ordkey(sc[reg]) & ~127u) | (unsigned)(16 * nt + c16);
            __builtin_amdgcn_sched_barrier(0);
        }
        if (sel == 0) top16(key, w1, c16); else top16(key, w2, c16);
    }
    float f1[4], f2[4], cur2[4]; int ptr[4]; unsigned top[4];
#pragma unroll
    for (int reg = 0; reg < 4; ++reg) { f1[reg] = unordkey(w1[reg] & ~127u); f2[reg] = unordkey(w2[reg] & ~127u); ptr[reg] = 0; cur2[reg] = __shfl(f2[reg], lane & 48); top[reg] = 0u; }
#pragma unroll 1
    for (int k = 0; k < TOPK; ++k) {
#pragma unroll
        for (int reg = 0; reg < 4; ++reg) {
            const unsigned ck = (ptr[reg] < 16) ? ((ordkey(f1[reg] + cur2[reg]) & ~255u) | (unsigned)(c16 << 4) | (unsigned)ptr[reg]) : 0u;
            const unsigned m = rowmax16(ck);
            top[reg] = (c16 == k) ? m : top[reg];
            if ((int)((m >> 4) & 15u) == c16) ptr[reg] += 1;
            cur2[reg] = __shfl(f2[reg], (lane & 48) | (ptr[reg] & 15));
        }
    }
#pragma unroll
    for (int reg = 0; reg < 4; ++reg) {
        const int a = (top[reg] >> 4) & 15, bq = top[reg] & 15;
        const int e1 = (int)(__shfl(w1[reg], (lane & 48) | a) & 127u), e2 = (int)(__shfl(w2[reg], (lane & 48) | bq) & 127u);
        const float ts = unordkey(top[reg] & ~255u), mx = __shfl(ts, lane & 48);
        const float ex = __expf(ts - mx), sum = rowsum16(ex);
        const size_t o = (size_t)(batch * 16 + 4 * g + reg) * TOPK + c16;
        IDX[o] = e1 * NKEYS + e2; GATE[o] = ex / sum;
    }
}

__device__ __forceinline__ void convert_table(const float* src, bf16* dst, size_t n8, size_t gtid, size_t gthreads) {
    for (size_t i = gtid; i < n8; i += gthreads) {
        const f32x4 a = *(const f32x4*)(src + i * 8), b = *(const f32x4*)(src + i * 8 + 4);
        v4u o; o.x = cvtpk(a.x, a.y); o.y = cvtpk(a.z, a.w); o.z = cvtpk(b.x, b.y); o.w = cvtpk(b.z, b.w);
        *(v4u*)(dst + i * 8) = o;
    }
}

__device__ __forceinline__ float dot2bf(unsigned w, unsigned x, float acc) {
    typedef __bf16 bf2 __attribute__((ext_vector_type(2)));
    return __builtin_amdgcn_fdot2_f32_bf16(__builtin_bit_cast(bf2, w), __builtin_bit_cast(bf2, x), acc, false);
}
__device__ __forceinline__ float gelu_erf(float v) {
    const float av = fabsf(v), t = __builtin_amdgcn_rcpf(av * 0.2316418882f + 1.0f);
    float q = t * 0.5307027145f + (-0.7265760135f); q = q * t + 0.7107068705f; q = q * t + (-0.142248368f); q = q * t + 0.127414796f; q = q * t;
    const float e = __builtin_amdgcn_exp2f((v * v) * (-0.72134752044f));
    const float m = v * (q * e);
    return v < 0.f ? m : v - m;
}

__device__ __forceinline__ void ffn_token(const bf16* XN, const int* IDX, const float* GATE, const bf16* UT, const bf16* VT, const float* mod, float* out, int tok, int lane) {
    const int b = tok / SEQ;
    const v4u x0 = *(const v4u*)(XN + (size_t)tok * D + 8 * lane), x1 = *(const v4u*)(XN + (size_t)tok * D + 512 + 8 * lane);
    const int id0 = IDX[(size_t)tok * HK + lane], id1 = IDX[(size_t)tok * HK + 64 + lane];
    const float gt0 = GATE[(size_t)tok * HK + lane], gt1 = GATE[(size_t)tok * HK + 64 + lane];
    float y[16];
#pragma unroll
    for (int i = 0; i < 16; ++i) y[i] = 0.f;
#pragma unroll 1
    for (int jj = 0; jj < HK; jj += 4) {
        v4u u0[4], u1[4], v0[4], v1[4]; float gt[4];
#pragma unroll
        for (int e = 0; e < 4; ++e) {
            const int j = jj + e;
            const int ex = __shfl((j < 64) ? id0 : id1, j & 63);
            gt[e] = __shfl((j < 64) ? gt0 : gt1, j & 63);
            const bf16* up = UT + (size_t)ex * D + 8 * lane; const bf16* vp = VT + (size_t)ex * D + 8 * lane;
            u0[e] = *(const v4u*)up; u1[e] = *(const v4u*)(up + 512); v0[e] = *(const v4u*)vp; v1[e] = *(const v4u*)(vp + 512);
        }
#pragma unroll
        for (int e = 0; e < 4; ++e) {
            float dot = 0.f;
            dot = dot2bf(u0[e].x, x0.x, dot); dot = dot2bf(u0[e].y, x0.y, dot); dot = dot2bf(u0[e].z, x0.z, dot); dot = dot2bf(u0[e].w, x0.w, dot);
            dot = dot2bf(u1[e].x, x1.x, dot); dot = dot2bf(u1[e].y, x1.y, dot); dot = dot2bf(u1[e].z, x1.z, dot); dot = dot2bf(u1[e].w, x1.w, dot);
            dot = rowsum16(dot); dot += __shfl_xor(dot, 16); dot += __shfl_xor(dot, 32);
            const float cf = gt[e] * gelu_erf(dot);
            y[0] += cf * __uint_as_float(v0[e].x << 16); y[1] += cf * __uint_as_float(v0[e].x & 0xffff0000u); y[2] += cf * __uint_as_float(v0[e].y << 16); y[3] += cf * __uint_as_float(v0[e].y & 0xffff0000u);
            y[4] += cf * __uint_as_float(v0[e].z << 16); y[5] += cf * __uint_as_float(v0[e].z & 0xffff0000u); y[6] += cf * __uint_as_float(v0[e].w << 16); y[7] += cf * __uint_as_float(v0[e].w & 0xffff0000u);
            y[8] += cf * __uint_as_float(v1[e].x << 16); y[9] += cf * __uint_as_float(v1[e].x & 0xffff0000u); y[10] += cf * __uint_as_float(v1[e].y << 16); y[11] += cf * __uint_as_float(v1[e].y & 0xffff0000u);
            y[12] += cf * __uint_as_float(v1[e].z << 16); y[13] += cf * __uint_as_float(v1[e].z & 0xffff0000u); y[14] += cf * __uint_as_float(v1[e].w << 16); y[15] += cf * __uint_as_float(v1[e].w & 0xffff0000u);
        }
    }
#pragma unroll
    for (int hh = 0; hh < 2; ++hh) {
        const int col = 512 * hh + 8 * lane; const size_t o = (size_t)tok * D + col;
        const f32x4 ga = *(const f32x4*)(mod + b * MODW + 5 * D + col), gb = *(const f32x4*)(mod + b * MODW + 5 * D + col + 4);
        f32x4 oa = *(const f32x4*)(out + o), ob = *(const f32x4*)(out + o + 4);
        oa.x += ga.x * y[8 * hh + 0]; oa.y += ga.y * y[8 * hh + 1]; oa.z += ga.z * y[8 * hh + 2]; oa.w += ga.w * y[8 * hh + 3];
        ob.x += gb.x * y[8 * hh + 4]; ob.y += gb.y * y[8 * hh + 5]; ob.z += gb.z * y[8 * hh + 6]; ob.w += gb.w * y[8 * hh + 7];
        *(f32x4*)(out + o) = oa; *(f32x4*)(out + o + 4) = ob;
    }
}
}

namespace fin {
using scan::cvtpk; using scan::mkfrag; using scan::mma;
typedef unsigned u32x2 __attribute__((ext_vector_type(2)));

__device__ __forceinline__ float shift3(const bf16* p, bool hasp, bool hasn, float mp, float mn) {
    const float z = bf2f(p[0]), zp = hasp ? bf2f(p[-INW]) : 0.f, zn = hasn ? bf2f(p[INW]) : 0.f;
    return z + mp * (zp - z) + mn * (zn - z);
}

__device__ __forceinline__ void phase(LAS unsigned char* L, const bf16* Z, const float* mu_prev, const float* mu_next, const float* g_up, const float* Y, const float* BON,
                                      const float* k_a, const float* r_k, const float* lnx_g, const float* lnx_b, bf16* mix, const bf16* O3, const float* LSE,
                                      int bx, int G, int tid, int wave, int lane) {
    const int g = lane >> 4, c16 = lane & 15;
    LAS bf16* sg = (LAS bf16*)L;
    bf16x8 bf[4][4];
#pragma unroll
    for (int nt = 0; nt < 4; ++nt)
#pragma unroll
        for (int ks = 0; ks < 4; ++ks) {
            const float* p = g_up + (size_t)(32 * ks + 8 * g) * RW + 64 * wave + 16 * nt + c16;
            bf[nt][ks] = mkfrag(cvtpk(p[0], p[RW]), cvtpk(p[2 * RW], p[3 * RW]), cvtpk(p[4 * RW], p[5 * RW]), cvtpk(p[6 * RW], p[7 * RW]));
        }
    float mpr[4], mnr[4], mpk[4], mnk[4], mpv[4], mnv[4], ka1[4], rk1[4], lg[4], lb[4];
#pragma unroll
    for (int nt = 0; nt < 4; ++nt) { const int c = 64 * wave + 16 * nt + c16;
        mpr[nt] = mu_prev[c]; mnr[nt] = mu_next[c]; mpk[nt] = mu_prev[RW + c]; mnk[nt] = mu_next[RW + c]; mpv[nt] = mu_prev[2 * RW + c]; mnv[nt] = mu_next[2 * RW + c];
        ka1[nt] = k_a[c]; rk1[nt] = r_k[c]; lg[nt] = lnx_g[c]; lb[nt] = lnx_b[c]; }
    for (int tb = bx; tb < T / 16; tb += G) {
        const int tok0 = tb * 16;
        __syncthreads();
        {
            const int tl = tid >> 5, j0 = (tid & 31) * 4, tok = tok0 + tl, t = tok % SEQ;
            const bf16* p = Z + (size_t)tok * INW + 3 * AW + 3 * RW + DL + AL + j0;
            const bool hasp = t > 0, hasn = t < SEQ - 1;
            float o[4];
#pragma unroll
            for (int e = 0; e < 4; ++e) { const float v = shift3(p + e, hasp, hasn, mu_prev[3 * RW + DL + AL + j0 + e], mu_next[3 * RW + DL + AL + j0 + e]); o[e] = 1.0f / (1.0f + __expf(-v)); }
            u32x2 w; w.x = cvtpk(o[0], o[1]); w.y = cvtpk(o[2], o[3]);
            *(LAS u32x2*)(sg + tl * 128 + j0) = w;
        }
        __syncthreads();
        f32x4 ga[4];
        {
            bf16x8 af[4];
#pragma unroll
            for (int ks = 0; ks < 4; ++ks) af[ks] = *(const LAS bf16x8*)(sg + c16 * 128 + 32 * ks + 8 * g);
#pragma unroll
            for (int nt = 0; nt < 4; ++nt) { f32x4 a = {0.f, 0.f, 0.f, 0.f};
#pragma unroll
                for (int ks = 0; ks < 4; ++ks) a = mma(af[ks], bf[nt][ks], a);
                ga[nt] = a; }
        }
#pragma unroll
        for (int reg = 0; reg < 4; ++reg) {
            const int tok = tok0 + 4 * g + reg, t = tok % SEQ;
            const bool hasp = t > 0, hasn = t < SEQ - 1;
            const bf16* zr = Z + (size_t)tok * INW + 3 * AW + 64 * wave + c16;
            float yv[4], rr[4], kk[4], vv[4], s1 = 0.f, sb = 0.f;
#pragma unroll
            for (int nt = 0; nt < 4; ++nt) {
                const size_t o = (size_t)tok * RW + 64 * wave + 16 * nt + c16;
                yv[nt] = Y[o] + Y[(size_t)T * RW + o]; s1 += yv[nt];
                rr[nt] = shift3(zr + 16 * nt, hasp, hasn, mpr[nt], mnr[nt]); kk[nt] = shift3(zr + RW + 16 * nt, hasp, hasn, mpk[nt], mnk[nt]); vv[nt] = shift3(zr + 2 * RW + 16 * nt, hasp, hasn, mpv[nt], mnv[nt]);
                sb += rr[nt] * kk[nt] * rk1[nt] * (1.0f - ka1[nt]);
            }
            const float mean = peer::rowsum16(s1) * (1.f / 64.f);
            float s2 = 0.f;
#pragma unroll
            for (int nt = 0; nt < 4; ++nt) s2 += (yv[nt] - mean) * (yv[nt] - mean);
            const float rstd = 1.0f / sqrtf(peer::rowsum16(s2) * (1.f / 64.f) + 64e-5f);
            const float bs = peer::rowsum16(sb) + 0.5f * (BON[(size_t)tok * NH + wave] + BON[((size_t)T + tok) * NH + wave]);
            const float l1 = LSE[(size_t)tok * NH + wave], l2 = LSE[((size_t)T + tok) * NH + wave], l3 = LSE[((size_t)2 * T + tok) * NH + wave];
            const float lm = fmaxf(l1, fmaxf(l2, l3)), w1 = __expf(l1 - lm), w2 = __expf(l2 - lm), w3 = __expf(l3 - lm), wi = 1.0f / (w1 + w2 + w3);
#pragma unroll
            for (int nt = 0; nt < 4; ++nt) {
                const int c = 64 * wave + 16 * nt + c16;
                bf16* mp = mix + (size_t)tok * D + c;
                const float att = (w1 * bf2f(mp[0]) + w2 * bf2f(mp[AW]) + w3 * bf2f(O3[(size_t)tok * AW + c])) * wi;
                const float yn = (yv[nt] - mean) * rstd * lg[nt] + lb[nt];
                mp[0] = (bf16)f2bf(att);
                mp[AW] = (bf16)f2bf((yn + bs * vv[nt]) * ga[nt][reg]);
            }
        }
    }
}
}

#ifndef MK_SKIP
#define MK_SKIP 0
#endif
constexpr int N_PHASES = 10;
struct Args { const float* in[27]; float* out; unsigned char* ws; int ph_lo, ph_hi, li, pad; };

__global__ void __launch_bounds__(NWAVES * 64, 2) mk_fwd(Args args) {
    extern __shared__ __attribute__((aligned(16))) unsigned char lds[];
    LAS unsigned char* L = (LAS unsigned char*)lds;
    volatile LAS unsigned* MISC = (volatile LAS unsigned*)(L + MISC_OFF);
    const int tid = threadIdx.x, lane = tid & 63, wave = __builtin_amdgcn_readfirstlane(tid >> 6);
    const int G = gridDim.x, bx = blockIdx.x;
    unsigned char* ws = args.ws;
    gu32* ctl = (gu32*)(ws + WS_CTL);
    const float* x = args.in[0]; const float* cvec = args.in[1]; const float* ada_w = args.in[2]; const float* ada_b = args.in[3];
    const float* norm1_g = args.in[4]; const float* w_in = args.in[5]; const float* mu_prev = args.in[6]; const float* mu_next = args.in[7];
    const float* q_norm_g = args.in[8]; const float* k_norm_g = args.in[9]; const float* w_decay0 = args.in[10]; const float* w_decay_up = args.in[11];
    const float* a_gate0 = args.in[12]; const float* a_gate_up = args.in[13]; const float* g_up = args.in[14]; const float* k_k = args.in[15];
    const float* k_a = args.in[16]; const float* r_k = args.in[17]; const float* lnx_g = args.in[18]; const float* lnx_b = args.in[19];
    const float* w_out = args.in[20]; const float* norm2_g = args.in[21]; const float* w_query = args.in[22]; const float* keys1 = args.in[23];
    const float* keys2 = args.in[24]; const float* peer_u = args.in[25]; const float* peer_v = args.in[26];
    float* out = args.out;
    float* MOD = (float*)(ws + WS_MOD); bf16* KEYS = (bf16*)(ws + WS_KEYS); bf16* WIN = (bf16*)(ws + WS_WIN); bf16* WOUT = (bf16*)(ws + WS_WOUT); bf16* WQ = (bf16*)(ws + WS_WQ);
    bf16* XN = (bf16*)(ws + WS_XN); bf16* Z = (bf16*)(ws + WS_Z); bf16* MIX = (bf16*)(ws + WS_MIX); float* Y = (float*)(ws + WS_Y); bf16* Q = (bf16*)(ws + WS_Q);
    int* IDX = (int*)(ws + WS_IDX); float* GATE = (float*)(ws + WS_GATE); float* BON = (float*)(ws + WS_BON);
    bf16* O3 = (bf16*)(ws + WS_O3); float* LSE = (float*)(ws + WS_LSE); bf16* UT = (bf16*)(ws + WS_UT); bf16* VT = (bf16*)(ws + WS_VT);

    for (int u = tid; u < (LDS_BYTES - LDSCTL_OFF) / 4; u += NWAVES * 64) ((LAS unsigned*)(L + LDSCTL_OFF))[u] = 0u;
    __syncthreads();
    XcdBarrier bar = xcd_barrier_post((unsigned*)(ctl + CW_BAR) + args.li * XCD_BAR_WORDS, MISC + 8);
    const int lo = args.ph_lo, hi = args.ph_hi;
#define IN(k) (lo <= (k) && (k) < hi)
#define SEAM(k) do { if (IN(k) && IN((k) + 1)) xcd_barrier(bar); } while (0)
    const int gw = bx * NWAVES + wave, NGW = G * NWAVES;

    if (IN(0) && !(MK_SKIP & (1 << 0))) {
        if (bx < MODW / 64) {
            LAS float* sc = (LAS float*)L; LAS float* part = (LAS float*)(L + 32768);
            for (int i = tid; i < BATCH * D; i += NWAVES * 64) { const float cv = cvec[i]; sc[i] = cv / (1.f + expf(-cv)); }
            __syncthreads();
            const int j0 = bx * 64;
            float acc[BATCH];
#pragma unroll
            for (int b = 0; b < BATCH; ++b) acc[b] = 0.f;
            for (int i = wave * 128; i < wave * 128 + 128; ++i) { const float w = ada_w[(size_t)i * MODW + j0 + lane];
#pragma unroll
                for (int b = 0; b < BATCH; ++b) acc[b] += sc[b * D + i] * w; }
#pragma unroll
            for (int b = 0; b < BATCH; ++b) part[(wave * 8 + b) * 64 + lane] = acc[b];
            __syncthreads();
            { const int b = tid >> 6; float s = 0.f;
#pragma unroll
              for (int w = 0; w < 8; ++w) s += part[(w * 8 + b) * 64 + lane];
              MOD[b * MODW + j0 + lane] = s + ada_b[j0 + lane]; }
            __syncthreads();
        }
        LAS float* scr = (LAS float*)(L + RING_OFF + wave * 16384);
        constexpr int I_IN = (D / 64) * (INW / 32), I_OUT = (D / 64) * (D / 32), I_Q = (D / 64) * (QW / 32);
        for (int it = gw; it < I_IN + I_OUT + I_Q; it += NGW) {
            int r = it;
            if (r < I_IN) { p0_transpose_item(w_in, D, INW, WIN, 0, scr, r, lane); continue; } r -= I_IN;
            if (r < I_OUT) { p0_transpose_item(w_out, D, D, WOUT, 0, scr, r, lane); continue; } r -= I_OUT;
            p0_transpose_item(w_query, D, QW, WQ, 0, scr, r, lane);
        }
    }
    SEAM(0);
    if (IN(1) && !(MK_SKIP & (1 << 1))) { for (int m = gw; m < T; m += NGW) norm_row(x + (size_t)m * D, norm1_g, MOD + (m / SEQ) * MODW, 0, D, XN + (size_t)m * D, lane); }
    SEAM(1);
    if (IN(2) && !(MK_SKIP & (1 << 2))) {
        pg8::Gemm g{XN, WIN, T, INW, D}; pg8::StaticOrder S; S.init(T, INW, G, bx);
        pg8::EpiBf16<0> E{Z, INW, nullptr, 0, 0, 1.f};
        pg8::gemm_phase<pg8::EpiBf16<0>, pg8::StaticOrder, true, true>(L + RING_OFF, g, S, E);
    }
    SEAM(2);
    if (IN(3) && !(MK_SKIP & (1 << 3))) {
        constexpr int NCHAIN = BATCH * NH * 2;
        if (bx < NCHAIN) {
            scan::chain(L, Z, mu_prev, mu_next, w_decay0, w_decay_up, a_gate0, a_gate_up, k_k, k_a, r_k, Y, BON, bx, tid, wave, lane);
        } else {
            const int wid = (bx - NCHAIN) * NWAVES + wave, nworkers = (G - NCHAIN) * NWAVES;
            LAS unsigned char* vt = L + wave * attn::WAVE_LDS;
            for (int u = wid; u < BATCH * NH * 96; u += nworkers) {
                const int x = u & 31, p = (u >> 5) % 3, bh = u / 96;
                const int d = (p == 0) ? 1 : (p == 1 ? 4 : 16), nb = 32 / d, r = x / nb, qb = x % nb;
                bf16* Ob = (p == 0) ? MIX : (p == 1 ? MIX + AW : O3); const int opitch = (p == 2) ? AW : D;
                attn::unit(vt, Z, q_norm_g, k_norm_g, Ob, opitch, LSE + (size_t)p * T * NH, bh >> 3, bh & 7, d, r, qb, nb, lane);
            }
        }
    }
    SEAM(3);
    if (IN(4) && !(MK_SKIP & (1 << 4))) { fin::phase(L, Z, mu_prev, mu_next, g_up, Y, BON, k_a, r_k, lnx_g, lnx_b, MIX, O3, LSE, bx, G, tid, wave, lane); }
    SEAM(4);
    if (IN(5) && !(MK_SKIP & (1 << 5))) {
        pg8::Gemm g{MIX, WOUT, T, D, D}; pg8::StaticOrder S; S.init(T, D, G, bx);
        EpiRes E{x, MOD, 2 * D, out, D};
        pg8::gemm_phase<EpiRes, pg8::StaticOrder, true, true>(L + RING_OFF, g, S, E);
    }
    SEAM(5);
    if (IN(6) && !(MK_SKIP & (1 << 6))) { for (int m = gw; m < T; m += NGW) norm_row(out + (size_t)m * D, norm2_g, MOD + (m / SEQ) * MODW, 3 * D, 4 * D, XN + (size_t)m * D, lane);
        const size_t gtid = (size_t)bx * NWAVES * 64 + tid, gthreads = (size_t)G * NWAVES * 64;
        peer::convert_table(peer_u, UT, (size_t)NKEYS * NKEYS * D / 8, gtid, gthreads); peer::convert_table(peer_v, VT, (size_t)NKEYS * NKEYS * D / 8, gtid, gthreads); }
    SEAM(6);
    if (IN(7) && !(MK_SKIP & (1 << 7))) {
        pg8::Gemm g{XN, WQ, T, QW, D}; pg8::StaticOrder S; S.init(T, QW, G, bx);
        pg8::EpiBf16<0> E{Q, QW, nullptr, 0, 0, 1.f};
        pg8::gemm_phase<pg8::EpiBf16<0>, pg8::StaticOrder, true, true>(L + RING_OFF, g, S, E);
    }
    SEAM(7);
    if (IN(8) && !(MK_SKIP & (1 << 8))) { __syncthreads(); peer::setup_keys(L, keys1, keys2, tid); __syncthreads();
        for (int bt = gw; bt < T * PH / 16; bt += NGW) peer::select_batch(L, Q, IDX, GATE, bt, lane); }
    SEAM(8);
    if (IN(9) && !(MK_SKIP & (1 << 9))) { for (int tok = gw; tok < T; tok += NGW) peer::ffn_token(XN, IDX, GATE, UT, VT, MOD, out, tok, lane); }
#undef IN
#undef SEAM
}

extern "C" void kernel_launch(void* const* d_in, const int* in_sizes, int n_in, void* d_out, int out_size, void* d_ws, size_t ws_size, hipStream_t stream) {
    static int grid = 0;
    if (grid == 0) {
        if (n_in != 27 || in_sizes[0] != T * D || out_size != T * D || ws_size < WS_END) { fprintf(stderr, "kernel_launch: unexpected problem (n_in %d, in0 %d, out %d, ws %zu); nothing launched\n", n_in, n_in > 0 ? in_sizes[0] : -1, out_size, ws_size); grid = -1; return; }
        int dev = 0, cus = 0, per_cu = 0;
        if (hipGetDevice(&dev) != hipSuccess || hipDeviceGetAttribute(&cus, hipDeviceAttributeMultiprocessorCount, dev) != hipSuccess) { fprintf(stderr, "kernel_launch: device query failed\n"); grid = -1; return; }
        if (hipFuncSetAttribute((const void*)mk_fwd, hipFuncAttributeMaxDynamicSharedMemorySize, LDS_BYTES) != hipSuccess) { fprintf(stderr, "kernel_launch: hipFuncSetAttribute failed\n"); grid = -1; return; }
        if (hipOccupancyMaxActiveBlocksPerMultiprocessor(&per_cu, (const void*)mk_fwd, NWAVES * 64, LDS_BYTES) != hipSuccess || per_cu < 1)
            fprintf(stderr, "kernel_launch: note: occupancy query reports %d workgroups per CU\n", per_cu);
        (void)hipGetLastError();
        grid = cus;
    }
    if (grid < 0) return;
    if (hipMemsetAsync((char*)d_ws + WS_CTL, 0, CTL_ZERO_BYTES, stream) != hipSuccess) { fprintf(stderr, "kernel_launch: hipMemsetAsync failed\n"); return; }
    Args a{};
    for (int i = 0; i < 27; ++i) a.in[i] = (const float*)d_in[i];
    a.out = (float*)d_out; a.ws = (unsigned char*)d_ws;
#ifndef MK_CUTS
#define MK_CUTS {0, N_PHASES}
#endif
    const int cuts[] = MK_CUTS;
    const int nl = (int)(sizeof(cuts) / sizeof(int)) - 1;
    for (int li = 0; li < nl; ++li) {
        a.ph_lo = cuts[li]; a.ph_hi = cuts[li + 1]; a.li = li;
        hipLaunchKernelGGL(mk_fwd, dim3(grid), dim3(NWAVES * 64), LDS_BYTES, stream, a);
        const hipError_t le = hipPeekAtLastError();
        if (le != hipSuccess) { fprintf(stderr, "kernel_launch: launch %d failed: %s\n", li, hipGetErrorName(le)); break; }
    }
}
```

```cpp
#include <hip/hip_runtime.h>
#include <cstdio>
#include <cstdint>
#include <cmath>
namespace pg8 {
#define PG8_LAS __attribute__((address_space(3)))
typedef unsigned short bf16_t;
typedef short bf16x8 __attribute__((ext_vector_type(8)));
typedef float f32x4 __attribute__((ext_vector_type(4)));
typedef unsigned u32x4 __attribute__((ext_vector_type(4)));
constexpr int BM = 256, BK = 64, HALF = 128, HTB = HALF * BK * 2  , STAGE_BYTES = 8 * HTB, NXCD = 8, WGM = 8;

__host__ __device__ __forceinline__ int lds_byte(int r, int c) { const int st = (r >> 4) * 2 + (c >> 5), rr = r & 15, cc = c & 31, ob = rr * 64 + cc * 2; return st * 1024 + (ob ^ (((ob >> 9) & 1) << 5)); }
__host__ __device__ __forceinline__ void stage_rc(int b, int& R, int& C) { const int st = b / 1024, sb = b % 1024, swz = sb ^ (((sb >> 9) & 1) << 5); R = (st >> 1) * 16 + swz / 64; C = (st & 1) * 32 + (swz % 64) / 2; }
__host__ __device__ __forceinline__ int perm32(int rho) { const int n = rho >> 4, i = rho & 15; return 8 * (i >> 2) + 4 * n + (i & 3); }

struct Unit { int pm, pn; };
struct Gemm { const bf16_t* A; const bf16_t* Bt; int M, N, K; };

struct StaticOrder {
    int nM, nN, nwg, G, c;
    __host__ __device__ void init(int M, int N, int G_, int c_) { nM = M / BM; nN = N / BM; nwg = nM * nN; G = G_; c = c_; }
    __host__ __device__ bool next(int i, Unit& u) const {
        const long L = (long)i * G + c; if (L >= nwg) return false;
        int wgid = (int)L; { const int q = nwg / NXCD, r = nwg % NXCD, xcd = wgid % NXCD, off = wgid / NXCD; wgid = (xcd < r ? xcd * (q + 1) : r * (q + 1) + (xcd - r) * q) + off; }
        const int nig = WGM * nN, gid = wgid / nig, fm = gid * WGM, gsz = (nM - fm) < WGM ? (nM - fm) : WGM;
        u.pm = fm + ((wgid % nig) % gsz); u.pn = (wgid % nig) / gsz; return true;
    }
    __device__ __forceinline__ void a_ready(const Unit&) const {}
    __device__ __forceinline__ void done(const Unit&) const {}
};

__device__ __forceinline__ unsigned cvt_pk_bf16(float lo, float hi) { unsigned r; asm volatile("v_cvt_pk_bf16_f32 %0, %1, %2" : "=v"(r) : "v"(lo), "v"(hi)); return r; }
typedef float f32x2 __attribute__((ext_vector_type(2)));
__device__ __forceinline__ f32x2 gelu_pk(f32x2 v) {
    const f32x2 av = __builtin_elementwise_abs(v), d = av * 0.2316418882f + 1.0f;
    f32x2 t; t.x = __builtin_amdgcn_rcpf(d.x); t.y = __builtin_amdgcn_rcpf(d.y);
    f32x2 q = t * 0.5307027145f + (-0.7265760135f); q = q * t + 0.7107068705f; q = q * t + (-0.142248368f); q = q * t + 0.127414796f; q = q * t;
    const f32x2 s = (v * v) * (-0.72134752044f);
    f32x2 e; e.x = __builtin_amdgcn_exp2f(s.x); e.y = __builtin_amdgcn_exp2f(s.y);
    const f32x2 m = v * (q * e), r = v - m;
    f32x2 o; o.x = v.x < 0.f ? m.x : r.x; o.y = v.y < 0.f ? m.y : r.y; return o;
}

template <int ACT  > struct EpiBf16 {
    static constexpr bool PERM = true, AFTER_DRAIN = false; static_assert(ACT == 0 || ACT == 1, "EpiBf16: ACT is 0 (none) or 1 (gelu_pk)");
    bf16_t* O; int ldc; const float* bias; int split_cols; size_t split_stride; float scale0;
    __device__ __forceinline__ void operator()(const f32x4 (&acc)[2][2][4][2], const Unit& u, int wr, int wc, int fr, int fq) const {
        const int row0 = u.pm * BM + wr * 64 + fr; int colt = u.pn * BM; bf16_t* base = O;
        float sc = 1.f; if (split_cols) { const int t = colt / split_cols; base += (size_t)t * split_stride; colt -= t * split_cols; if (t == 0) sc = scale0; }
        const int col0 = colt + wc * 32 + 8 * fq, bcol0 = u.pn * BM + wc * 32 + 8 * fq;
        f32x4 bv[2][2];
#pragma unroll
        for (int bj = 0; bj < 2; ++bj)
#pragma unroll
            for (int n = 0; n < 2; ++n) bv[bj][n] = bias ? *(const f32x4*)(bias + bcol0 + bj * HALF + 4 * n) : (f32x4){0.f, 0.f, 0.f, 0.f};
#pragma unroll
        for (int ai = 0; ai < 2; ++ai)
#pragma unroll
            for (int m = 0; m < 4; ++m) { bf16_t* rowp = base + (size_t)(row0 + ai * HALF + m * 16) * ldc + col0;
#pragma unroll
                for (int bj = 0; bj < 2; ++bj) { f32x4 v0 = acc[ai][bj][m][0] + bv[bj][0], v1 = acc[ai][bj][m][1] + bv[bj][1];
                    if (ACT == 1) { f32x2 a = gelu_pk((f32x2){v0[0], v0[1]}), b = gelu_pk((f32x2){v0[2], v0[3]}), c = gelu_pk((f32x2){v1[0], v1[1]}), d = gelu_pk((f32x2){v1[2], v1[3]});
                        v0 = (f32x4){a.x, a.y, b.x, b.y}; v1 = (f32x4){c.x, c.y, d.x, d.y}; }
                    v0 = v0 * sc; v1 = v1 * sc; u32x4 w; w.x = cvt_pk_bf16(v0[0], v0[1]); w.y = cvt_pk_bf16(v0[2], v0[3]); w.z = cvt_pk_bf16(v1[0], v1[1]); w.w = cvt_pk_bf16(v1[2], v1[3]);
                    *(u32x4*)(rowp + bj * HALF) = w; } }
    }
};

template <class Epi, class Sched, bool ALIGN_EPI = false, bool SP2 = false>
__device__ __forceinline__ void gemm_phase(PG8_LAS unsigned char* lds, const Gemm g, const Sched& S, const Epi& E) {
    const int tid = threadIdx.x, wid = __builtin_amdgcn_readfirstlane(tid >> 6), lane = tid & 63, wr = wid >> 2, wc = wid & 3, fr = lane & 15, fq = lane >> 4;
    const int K = g.K, nt = K / BK;
    unsigned voffA[2], voffB[2];
#pragma unroll
    for (int i = 0; i < 2; ++i) { int R, C; stage_rc(tid * 16 + i * 8192, R, C); const int Rb = Epi::PERM ? ((R & ~31) + perm32(R & 31)) : R;
        voffA[i] = (unsigned)(R * K + C) * 2u; voffB[i] = (unsigned)(Rb * K + C) * 2u; }
    const size_t kstep = (size_t)(BK * 2);
    const size_t hstep = (size_t)HALF * K * 2;
    const size_t tstep = 2 * hstep;
    const unsigned ldsw = (unsigned)wid * 1024u;
    const int aoff = lds_byte(wr * 64 + fr, fq * 8), boff = lds_byte(wc * 32 + fr, fq * 8);
#define PG8_SA(b, h) (((b) * 2 + (h)) * HTB)
#define PG8_SB(b, h) ((4 + (b) * 2 + (h)) * HTB)
#define PG8_STAGE(bufoff, gbase, voff) do { _Pragma("unroll") for (int _i = 0; _i < 2; ++_i) \
        __builtin_amdgcn_global_load_lds((const unsigned*)((const char*)(gbase) + (voff)[_i]), (PG8_LAS unsigned*)(lds + (bufoff) + ldsw + _i * 8192), 16, 0, 0); } while (0)
#define PG8_LDA(dst, b, h) do { _Pragma("unroll") for (int m = 0; m < 4; ++m) _Pragma("unroll") for (int k = 0; k < 2; ++k) dst[m][k] = *(const PG8_LAS bf16x8*)(lds + PG8_SA(b, h) + aoff + m * 2048 + k * 1024); } while (0)
#define PG8_LDB(dst, b, h) do { _Pragma("unroll") for (int n = 0; n < 2; ++n) _Pragma("unroll") for (int k = 0; k < 2; ++k) dst[n][k] = *(const PG8_LAS bf16x8*)(lds + PG8_SB(b, h) + boff + n * 2048 + k * 1024); } while (0)
#define PG8_MMA(ai, bj, At, Bt) do { __builtin_amdgcn_s_setprio(1); _Pragma("unroll") for (int m = 0; m < 4; ++m) _Pragma("unroll") for (int n = 0; n < 2; ++n) _Pragma("unroll") for (int k = 0; k < 2; ++k) \
        acc[ai][bj][m][n] = __builtin_amdgcn_mfma_f32_16x16x32_bf16(Bt[n][k], At[m][k], acc[ai][bj][m][n], 0, 0, 0); __builtin_amdgcn_s_setprio(0); } while (0)
#define PG8_WAIT_V(n) asm volatile("s_waitcnt vmcnt(" #n ")" ::: "memory")
#define PG8_WAIT_L(n) asm volatile("s_waitcnt lgkmcnt(" #n ")" ::: "memory")
#define PG8_BAR __builtin_amdgcn_s_barrier()
#define PG8_SCHED __builtin_amdgcn_sched_barrier(0)
    Unit cur, nxt; int ui = 0;
    if (!S.next(0, cur)) return;
    f32x4 acc[2][2][4][2];
#pragma unroll
    for (int a = 0; a < 2; ++a)
#pragma unroll
        for (int b = 0; b < 2; ++b)
#pragma unroll
            for (int m = 0; m < 4; ++m)
#pragma unroll
                for (int n = 0; n < 2; ++n) acc[a][b][m][n] = (f32x4){0.f, 0.f, 0.f, 0.f};
    bf16x8 At[4][2], B0[2][2], B1[2][2];
    const char* cA = (const char*)g.A + (size_t)cur.pm * tstep; const char* cB = (const char*)g.Bt + (size_t)cur.pn * tstep;
    S.a_ready(cur);
    if constexpr (SP2) {
        PG8_STAGE(PG8_SB(0, 0), cB, voffB); PG8_STAGE(PG8_SB(0, 1), cB + hstep, voffB); PG8_STAGE(PG8_SA(0, 0), cA, voffA); PG8_STAGE(PG8_SA(0, 1), cA + hstep, voffA);
        if (wr == 1) PG8_BAR;
        PG8_WAIT_V(2); PG8_BAR;
        PG8_STAGE(PG8_SB(1, 0), cB + kstep, voffB); PG8_STAGE(PG8_SA(1, 0), cA + kstep, voffA); PG8_STAGE(PG8_SB(1, 1), cB + hstep + kstep, voffB);
        PG8_WAIT_V(6); PG8_BAR;
    } else {
        PG8_STAGE(PG8_SB(0, 0), cB, voffB); PG8_STAGE(PG8_SA(0, 0), cA, voffA); PG8_STAGE(PG8_SB(0, 1), cB + hstep, voffB); PG8_STAGE(PG8_SA(0, 1), cA + hstep, voffA);
        if (wr == 1) PG8_BAR;
        PG8_WAIT_V(4); PG8_BAR;
        PG8_STAGE(PG8_SB(1, 0), cB + kstep, voffB); PG8_STAGE(PG8_SA(1, 0), cA + kstep, voffA); PG8_STAGE(PG8_SB(1, 1), cB + hstep + kstep, voffB);
        PG8_WAIT_V(6); PG8_BAR;
    }
    for (;;) {
        const bool has_next = S.next(ui + 1, nxt);
        const char* nA = has_next ? (const char*)g.A + (size_t)nxt.pm * tstep : cA; const char* nB = has_next ? (const char*)g.Bt + (size_t)nxt.pn * tstep : cB;
        for (int t = 0; t < nt; t += 2) {
            const bool last = (t == nt - 2);
            const char* a1 = cA + (size_t)(t + 1) * kstep;
            const char* a2 = last ? nA : cA + (size_t)(t + 2) * kstep; const char* b2 = last ? nB : cB + (size_t)(t + 2) * kstep;
            const char* a3 = a2 + kstep; const char* b3 = b2 + kstep;
            if (last && has_next) S.a_ready(nxt);
            if constexpr (SP2) {
            PG8_LDB(B0, 0, 0); PG8_LDB(B1, 0, 1); PG8_SCHED; PG8_LDA(At, 0, 0); PG8_STAGE(PG8_SA(1, 1), a1 + hstep, voffA);
            PG8_WAIT_V(8); PG8_WAIT_L(0); PG8_BAR; PG8_MMA(0, 0, At, B0); PG8_MMA(0, 1, At, B1); PG8_BAR; PG8_SCHED;
            PG8_LDA(At, 0, 1); PG8_STAGE(PG8_SB(0, 0), b2, voffB); PG8_STAGE(PG8_SB(0, 1), b2 + hstep, voffB); PG8_STAGE(PG8_SA(0, 0), a2, voffA);
            PG8_WAIT_V(8); PG8_WAIT_L(0); PG8_BAR; PG8_MMA(1, 0, At, B0); PG8_MMA(1, 1, At, B1); PG8_BAR; PG8_SCHED;
            PG8_LDB(B0, 1, 0); PG8_LDB(B1, 1, 1); PG8_SCHED; PG8_LDA(At, 1, 0); PG8_STAGE(PG8_SA(0, 1), a2 + hstep, voffA);
            PG8_WAIT_V(8); PG8_WAIT_L(0); PG8_BAR; PG8_MMA(0, 0, At, B0); PG8_MMA(0, 1, At, B1); PG8_BAR; PG8_SCHED;
            PG8_LDA(At, 1, 1); PG8_STAGE(PG8_SB(1, 0), b3, voffB); PG8_STAGE(PG8_SB(1, 1), b3 + hstep, voffB); PG8_STAGE(PG8_SA(1, 0), a3, voffA);
            PG8_WAIT_V(8); PG8_WAIT_L(0); PG8_BAR; PG8_MMA(1, 0, At, B0); PG8_MMA(1, 1, At, B1); PG8_BAR; PG8_SCHED;
            } else {
            PG8_LDB(B0, 0, 0); PG8_SCHED; PG8_LDA(At, 0, 0); PG8_STAGE(PG8_SA(1, 1), a1 + hstep, voffA);
            PG8_WAIT_L(8); PG8_BAR; PG8_WAIT_L(0); PG8_MMA(0, 0, At, B0); PG8_BAR; PG8_SCHED;
            PG8_LDB(B1, 0, 1); PG8_STAGE(PG8_SB(0, 0), b2, voffB);
            PG8_BAR; PG8_WAIT_L(0); PG8_MMA(0, 1, At, B1); PG8_BAR;
            PG8_LDA(At, 0, 1); PG8_STAGE(PG8_SA(0, 0), a2, voffA);
            PG8_BAR; PG8_WAIT_L(0); PG8_MMA(1, 0, At, B0); PG8_BAR; PG8_SCHED;
            PG8_STAGE(PG8_SB(0, 1), b2 + hstep, voffB);
            PG8_WAIT_V(6); PG8_BAR; PG8_MMA(1, 1, At, B1); PG8_BAR;
            PG8_LDB(B0, 1, 0); PG8_SCHED; PG8_LDA(At, 1, 0); PG8_STAGE(PG8_SA(0, 1), a2 + hstep, voffA);
            PG8_WAIT_L(8); PG8_BAR; PG8_WAIT_L(0); PG8_MMA(0, 0, At, B0); PG8_BAR; PG8_SCHED;
            PG8_LDB(B1, 1, 1); PG8_STAGE(PG8_SB(1, 0), b3, voffB);
            PG8_BAR; PG8_WAIT_L(0); PG8_MMA(0, 1, At, B1); PG8_BAR;
            PG8_LDA(At, 1, 1); PG8_STAGE(PG8_SA(1, 0), a3, voffA);
            PG8_BAR; PG8_WAIT_L(0); PG8_MMA(1, 0, At, B0); PG8_BAR; PG8_SCHED;
            PG8_STAGE(PG8_SB(1, 1), b3 + hstep, voffB);
            PG8_WAIT_V(6); PG8_BAR; PG8_MMA(1, 1, At, B1); PG8_BAR;
            }
        }
        if constexpr (ALIGN_EPI) { if (wr == 0) PG8_BAR; }
        if constexpr (!Epi::AFTER_DRAIN) { E(acc, cur, wr, wc, fr, fq); S.done(cur); }
        if (!has_next) break;
#pragma unroll
        for (int a = 0; a < 2; ++a)
#pragma unroll
            for (int b = 0; b < 2; ++b)
#pragma unroll
                for (int m = 0; m < 4; ++m)
#pragma unroll
                    for (int n = 0; n < 2; ++n) acc[a][b][m][n] = (f32x4){0.f, 0.f, 0.f, 0.f};
        cur = nxt; cA = nA; cB = nB; ++ui;
        if constexpr (ALIGN_EPI) { if (wr == 1) PG8_BAR; }
    }
    PG8_WAIT_V(0);
    if constexpr (!ALIGN_EPI) { if (wr == 0) PG8_BAR; }
    PG8_BAR;
    if constexpr (Epi::AFTER_DRAIN) { E.fused(acc, cur, wr, wc, fr, fq, lds, wid, lane); S.done(cur); }
#undef PG8_SA
#undef PG8_SB
#undef PG8_STAGE
#undef PG8_LDA
#undef PG8_LDB
#undef PG8_MMA
#undef PG8_WAIT_V
#undef PG8_WAIT_L
#undef PG8_BAR
#undef PG8_SCHED
}
}
#define GAS __attribute__((address_space(1)))
#define LAS __attribute__((address_space(3)))
typedef unsigned short bf16;
typedef unsigned v4u __attribute__((ext_vector_type(4)));
typedef float f32x4 __attribute__((ext_vector_type(4)));
typedef short bf16x8 __attribute__((ext_vector_type(8)));
typedef GAS unsigned gu32;
typedef GAS unsigned long long gu64;
#define RLX_AGENT __ATOMIC_RELAXED, __HIP_MEMORY_SCOPE_AGENT
#define LDS_WAIT() asm volatile("s_waitcnt lgkmcnt(0)" ::: "memory")
#define VM_WAIT() asm volatile("s_waitcnt vmcnt(0)" ::: "memory")
__device__ __forceinline__ unsigned long long rt() { return __builtin_amdgcn_s_memrealtime(); }
__device__ __forceinline__ unsigned f2bf(float f) { unsigned u = __builtin_bit_cast(unsigned, f); return (u + 0x7fffu + ((u >> 16) & 1u)) >> 16; }
__device__ __forceinline__ unsigned pk2(float lo, float hi) { return f2bf(lo) | (f2bf(hi) << 16); }

#define XB_TMO      128
#define XB_XCNT(j)  (256  + 64 * (j))
#define XB_XSUB(j)  (1280 + 64 * (j))
#define XB_XGEN(j)  (2304 + 64 * (j))
#define XB_TOP      3328
#define XB_TOPGEN   3392
#define XCD_BAR_WORDS 3456
#define XB_SPIN_CAP (1u << 18)

__device__ __forceinline__ unsigned xb_ld(unsigned* p)              { return __hip_atomic_load(p, __ATOMIC_RELAXED, __HIP_MEMORY_SCOPE_AGENT); }
__device__ __forceinline__ unsigned xb_add(unsigned* p, unsigned v) { return __hip_atomic_fetch_add(p, v, __ATOMIC_RELAXED, __HIP_MEMORY_SCOPE_AGENT); }
__device__ __forceinline__ unsigned xb_xcc_id() { return (unsigned)__builtin_amdgcn_s_getreg((3 << 11) | 20) & 0xFu; }
#define XB_SPIN(cond, bar) do { unsigned _sp = 0; while (cond) { __builtin_amdgcn_s_sleep(1); \
    if ((++_sp & 255u) == 0u) { if (xb_ld(&(bar)[XB_TMO])) break; if (_sp > XB_SPIN_CAP) { atomicAdd(&(bar)[XB_TMO], 1u); break; } } } } while (0)

struct XcdBarrier {
    unsigned* bar; unsigned x;
    volatile LAS unsigned* st;
};

__device__ __forceinline__ XcdBarrier xcd_barrier_post(unsigned* bar, volatile LAS unsigned* st) {
    XcdBarrier b; b.bar = bar; b.x = xb_xcc_id(); b.st = st;
    if (threadIdx.x == 0) (void)xb_add(&bar[XB_XCNT(b.x)], 1u);
    return b;
}
__device__ __forceinline__ void xcd_barrier_complete(unsigned* bar, unsigned x, unsigned& nloc, unsigned& nx) {
    const unsigned G = gridDim.x * gridDim.y * gridDim.z;
    unsigned sum, cnt, mine, sp = 0u;
    for (;;) {
        sum = 0u; cnt = 0u; mine = 0u;
#pragma unroll
        for (unsigned j = 0; j < 16; ++j) { const unsigned c = xb_ld(&bar[XB_XCNT(j)]); sum += c; cnt += (c > 0u) ? 1u : 0u; mine = (j == x) ? c : mine; }
        if (sum == G) break;
        __builtin_amdgcn_s_sleep(1);
        if ((++sp & 255u) == 0u) { if (xb_ld(&bar[XB_TMO])) break; if (sp > XB_SPIN_CAP) { atomicAdd(&bar[XB_TMO], 1u); break; } }
    }
    nloc = mine > 0u ? mine : 1u; nx = cnt > 0u ? cnt : 1u;
}

__device__ __forceinline__ void xcd_barrier(const XcdBarrier& b) {
    asm volatile("s_waitcnt vmcnt(0)" ::: "memory");
    __syncthreads();
    if (threadIdx.x == 0) {
        unsigned* bar = b.bar;
        __builtin_amdgcn_s_waitcnt(0);
        unsigned nloc = b.st[0], nx = b.st[1];
        if (nloc == 0u) { xcd_barrier_complete(bar, b.x, nloc, nx); b.st[0] = nloc; b.st[1] = nx; }
        const unsigned old = xb_add(&bar[XB_XSUB(b.x)], 1u);
        const unsigned gen = old / nloc;
        if (old + 1u == (gen + 1u) * nloc) {
            __builtin_amdgcn_fence(__ATOMIC_RELEASE, "agent");
            asm volatile("s_waitcnt vmcnt(0)" ::: "memory");
            const unsigned og = xb_add(&bar[XB_TOP], 1u);
            const unsigned tg = og / nx;
            if (og + 1u == (tg + 1u) * nx) xb_add(&bar[XB_TOPGEN], 1u);
            else XB_SPIN(xb_ld(&bar[XB_TOPGEN]) == tg, bar);
            __builtin_amdgcn_fence(__ATOMIC_ACQUIRE, "agent");
            xb_add(&bar[XB_XGEN(b.x)], 1u);
            asm volatile("s_waitcnt vmcnt(0)" ::: "memory");
        } else {
            XB_SPIN(xb_ld(&bar[XB_XGEN(b.x)]) == gen, bar);
            __builtin_amdgcn_fence(__ATOMIC_ACQUIRE, "agent");
            asm volatile("s_waitcnt vmcnt(0)" ::: "memory");
        }
    }
    __syncthreads();
}
constexpr int NWAVES = 8;
constexpr int D = 1024, BATCH = 8, SEQ = 2048, T = BATCH * SEQ;
constexpr int AW = 512, RW = 512, NH = 8;
constexpr int DL = 64, AL = 64, GL = 128;
constexpr int SHIFTW = 3 * RW + DL + AL + GL;
constexpr int INW = 3 * AW + SHIFTW;
constexpr int NKEYS = 128, PH = 8, PKD = 256, TOPK = 16, HK = PH * TOPK;
constexpr int QW = PH * PKD;
constexpr int MODW = 6 * D;

constexpr size_t MiB = 1u << 20;
constexpr size_t WS_CTL = 0, CTL_ZERO_BYTES = 1 * MiB;
constexpr size_t WS_MOD = 1 * MiB;
constexpr size_t WS_KEYS = 1 * MiB + 512 * 1024;
constexpr size_t WS_WIN = 2 * MiB;
constexpr size_t WS_WOUT = 9 * MiB;
constexpr size_t WS_WQ = 11 * MiB;
constexpr size_t WS_XN = 16 * MiB;
constexpr size_t WS_O3 = 16 * MiB;
constexpr size_t WS_LSE = 32 * MiB;
constexpr size_t WS_Z = 48 * MiB;
constexpr size_t WS_MIX = 152 * MiB;
constexpr size_t WS_Y = 184 * MiB;
constexpr size_t WS_Q = 48 * MiB;
constexpr size_t WS_IDX = 112 * MiB;
constexpr size_t WS_GATE = 120 * MiB;
constexpr size_t WS_PART = 48 * MiB;
constexpr size_t WS_UT = 152 * MiB;
constexpr size_t WS_VT = 184 * MiB;
constexpr size_t WS_BON = 248 * MiB;
constexpr size_t WS_END = 249 * MiB;
constexpr int CW_BAR = 4096;
constexpr int MAX_LAUNCHES = 12;

constexpr int RING_OFF = 0, RING_BYTES = 139264;
constexpr int LDSCTL_OFF = RING_BYTES, MISC_OFF = LDSCTL_OFF + 320;
constexpr int LDS_BYTES = 147456;
static_assert(MISC_OFF + 128 <= LDS_BYTES, "LDS map");

typedef GAS float gf32;
typedef GAS f32x4 gf32x4;

__device__ __forceinline__ float bf2f(bf16 v) { return __uint_as_float(((unsigned)v) << 16); }
__device__ __forceinline__ float wave_sum(float v) {
#pragma unroll
    for (int o = 1; o < 64; o <<= 1) v += __shfl_xor(v, o);
    return v;
}
#define WAVE_LDS_SYNC() do { asm volatile("s_waitcnt lgkmcnt(0)" ::: "memory"); __builtin_amdgcn_wave_barrier(); } while (0)

__device__ __forceinline__ void p0_transpose_item(const float* W, int K, int N, bf16* WT, int row_off, LAS float* scr, int item, int lane) {
    const int nblk = N / 32, kb = item / nblk, nb = item % nblk, k0 = 64 * kb, n0 = 32 * nb;
#pragma unroll 8
    for (int i = 0; i < 32; ++i) { const int kk = 2 * i + (lane >> 5); scr[kk * 33 + (lane & 31)] = W[(size_t)(k0 + kk) * N + n0 + (lane & 31)]; }
    LDS_WAIT(); asm volatile("" ::: "memory");
    const int c = lane & 7;
#pragma unroll
    for (int j = 0; j < 4; ++j) { const int n = (lane >> 3) + 8 * j; const LAS float* s = scr + (8 * c) * 33 + n;
        v4u o; o.x = pk2(s[0 * 33], s[1 * 33]); o.y = pk2(s[2 * 33], s[3 * 33]); o.z = pk2(s[4 * 33], s[5 * 33]); o.w = pk2(s[6 * 33], s[7 * 33]);
        *(GAS v4u*)(WT + (size_t)(row_off + n0 + n) * K + k0 + 8 * c) = o; }
    LDS_WAIT(); asm volatile("" ::: "memory");
}

__device__ __forceinline__ void norm_row(const float* xrow, const float* g, const float* modb, int shift_off, int scale_off, bf16* orow, int lane) {
    const GAS f32x4* xr = (const GAS f32x4*)xrow + lane;
    f32x4 v[4]; float s = 0.f;
#pragma unroll
    for (int j = 0; j < 4; ++j) { v[j] = xr[64 * j]; s += (v[j].x * v[j].x + v[j].y * v[j].y) + (v[j].z * v[j].z + v[j].w * v[j].w); }
    const float rs = 1.0f / sqrtf(wave_sum(s) * (1.f / D) + 1e-6f);
    GAS unsigned long long* o8 = (GAS unsigned long long*)orow + lane;
#pragma unroll
    for (int j = 0; j < 4; ++j) {
        const int col = 256 * j + 4 * lane;
        const f32x4 g4 = *(const GAS f32x4*)(g + col), sc = *(const GAS f32x4*)(modb + scale_off + col), sh = *(const GAS f32x4*)(modb + shift_off + col);
        const f32x4 y = v[j] * rs * g4 * (sc + 1.0f) + sh;
        o8[64 * j] = (unsigned long long)pk2(y.x, y.y) | ((unsigned long long)pk2(y.z, y.w) << 32);
    }
}

struct EpiRes {
    static constexpr bool PERM = false, AFTER_DRAIN = false;
    const float* xres; const float* mod; int gate_off; float* out; int ldc;
    __device__ __forceinline__ void operator()(const pg8::f32x4 (&acc)[2][2][4][2], const pg8::Unit& u, int wr, int wc, int fr, int fq) const {
        const int col0 = u.pn * pg8::BM + wc * 32 + 4 * fq;
        const int b = (u.pm * pg8::BM) / SEQ;
        pg8::f32x4 gv[2][2];
#pragma unroll
        for (int bj = 0; bj < 2; ++bj)
#pragma unroll
            for (int n = 0; n < 2; ++n) gv[bj][n] = *(const pg8::f32x4*)(mod + b * MODW + gate_off + col0 + bj * pg8::HALF + n * 16);
#pragma unroll
        for (int ai = 0; ai < 2; ++ai)
#pragma unroll
            for (int m = 0; m < 4; ++m) { const size_t off = (size_t)(u.pm * pg8::BM + ai * pg8::HALF + wr * 64 + m * 16 + fr) * ldc + col0;
#pragma unroll
                for (int bj = 0; bj < 2; ++bj)
#pragma unroll
                    for (int n = 0; n < 2; ++n) { const pg8::f32x4 bs = *(const pg8::f32x4*)(xres + off + bj * pg8::HALF + n * 16);
                        *(pg8::f32x4*)(out + off + bj * pg8::HALF + n * 16) = bs + gv[bj][n] * acc[ai][bj][m][n]; } }
    }
};

namespace scan {
typedef unsigned u32x2 __attribute__((ext_vector_type(2)));
constexpr int SLOT = 1024, BUF_BYTES = 12800, NBUF = 8;
constexpr int OFF_LORA = NBUF * BUF_BYTES;
constexpr int OFF_CONST = OFF_LORA + 16 * SLOT;
constexpr int OFF_MT = OFF_CONST + 4096;
constexpr int SCAN_LDS = OFF_MT + 4 * 1024;
static_assert(SCAN_LDS <= 131072, "scan LDS map");
constexpr int S_KK = 0, S_R = 2, S_MT = 4, S_N = 5, S_BK = 6, S_V = 10, S_GC = 12;

typedef float f32x2n __attribute__((ext_vector_type(2)));
typedef __bf16 bf16x2n __attribute__((ext_vector_type(2)));
__device__ __forceinline__ unsigned cvtpk(float lo, float hi) { const f32x2n v = {lo, hi}; const bf16x2n b = __builtin_convertvector(v, bf16x2n); return __builtin_bit_cast(unsigned, b); }
__device__ __forceinline__ bf16x8 mkfrag(unsigned a, unsigned b, unsigned c, unsigned d) { v4u w; w.x = a; w.y = b; w.z = c; w.w = d; return __builtin_bit_cast(bf16x8, w); }
__device__ __forceinline__ bf16x8 frag8(const float (&lo)[4], const float (&hi)[4]) { return mkfrag(cvtpk(lo[0], lo[1]), cvtpk(lo[2], lo[3]), cvtpk(hi[0], hi[1]), cvtpk(hi[2], hi[3])); }
__device__ __forceinline__ f32x4 mma(bf16x8 a, bf16x8 b, f32x4 c) { return __builtin_amdgcn_mfma_f32_16x16x32_bf16(a, b, c, 0, 0, 0); }
template <int N> __device__ __forceinline__ float row_shr(float x) { return __int_as_float(__builtin_amdgcn_update_dpp(0, __float_as_int(x), 0x110 + N, 0xf, 0xf, true)); }
__device__ __forceinline__ float fsigmoid(float x) { return 1.0f / (1.0f + __expf(-x)); }

__device__ __forceinline__ void setup(LAS unsigned char* L, int h, int dir, const float* mu_prev, const float* mu_next, const float* w_decay0, const float* w_decay_up,
                                      const float* a_gate0, const float* a_gate_up, const float* k_k, const float* k_a, const float* r_k, int tid) {
    LAS float* C = (LAS float*)(L + OFF_CONST);
    for (int i = tid; i < 320; i += 512) {
        const int grp = i >> 6, c = i & 63;
        const int col = (grp < 3) ? grp * RW + h * 64 + c : 3 * RW + (grp - 3) * 64 + c;
        C[i] = mu_prev[col]; C[320 + i] = mu_next[col];
    }
    if (tid < 64) { const int hc = h * 64 + tid; C[640 + tid] = w_decay0[dir * RW + hc]; C[704 + tid] = a_gate0[dir * RW + hc]; C[768 + tid] = k_k[hc]; C[832 + tid] = k_a[hc]; C[896 + tid] = r_k[hc]; }
    LAS bf16* F = (LAS bf16*)(L + OFF_LORA);
    for (int i = tid; i < 16 * 64 * 8; i += 512) {
        const int j = i & 7, l = (i >> 3) & 63, sl = i >> 9, m = sl & 1, ct = (sl >> 1) & 3, wa = sl >> 3;
        const int g = l >> 4, jj = 32 * m + (j < 4 ? 4 * g + j : 16 + 4 * g + j - 4), c = h * 64 + 16 * ct + (l & 15);
        const float v = wa ? a_gate_up[(size_t)(dir * AL + jj) * RW + c] : w_decay_up[(size_t)(dir * DL + jj) * RW + c];
        F[i] = (bf16)f2bf(v);
    }
}

__device__ __forceinline__ void helper_chunk(LAS unsigned char* L, LAS unsigned char* buf, LAS float* MT, const bf16* Z, float* BON, int b, int h, int dir, int n, int lane) {
    const int s = lane & 15, g = lane >> 4;
    const int cn = dir ? (SEQ / 16 - 1 - n) : n;
    const int t = cn * 16 + (dir ? 15 - s : s), tok = b * SEQ + t;
    const LAS float* C = (const LAS float*)(L + OFF_CONST);
    const bool hasp = t > 0, hasn = t < SEQ - 1;
    const bf16* zrow = Z + (size_t)tok * INW + 3 * AW;
    float rv[4][4], kv[4][4], vv[4][4], tw[4][4], xa[4][4];
    u32x2 zc[5][4], ze[5][4];
    {
        const int te = (s == 0) ? (dir ? t + 1 : t - 1) : ((s == 15) ? (dir ? t - 1 : t + 1) : t);
        const int tec = te < 0 ? 0 : (te > SEQ - 1 ? SEQ - 1 : te);
        const bf16* erow = Z + (size_t)(b * SEQ + tec) * INW + 3 * AW;
#pragma unroll
        for (int grp = 0; grp < 5; ++grp) {
            const int cbase = (grp < 3) ? grp * RW + h * 64 : 3 * RW + (grp - 3) * 64;
#pragma unroll
            for (int ct = 0; ct < 4; ++ct) { zc[grp][ct] = *(const u32x2*)(zrow + cbase + 16 * ct + 4 * g); ze[grp][ct] = *(const u32x2*)(erow + cbase + 16 * ct + 4 * g); }
        }
    }
    __builtin_amdgcn_sched_barrier(0);
#pragma unroll
    for (int grp = 0; grp < 5; ++grp) {
#pragma unroll
        for (int ct = 0; ct < 4; ++ct) {
            const u32x2 zcc = zc[grp][ct], zee = ze[grp][ct];
            u32x2 lo, up;
            lo.x = (unsigned)__builtin_amdgcn_update_dpp((int)zee.x, (int)zcc.x, 0x111, 0xf, 0xf, false); lo.y = (unsigned)__builtin_amdgcn_update_dpp((int)zee.y, (int)zcc.y, 0x111, 0xf, 0xf, false);
            up.x = (unsigned)__builtin_amdgcn_update_dpp((int)zee.x, (int)zcc.x, 0x101, 0xf, 0xf, false); up.y = (unsigned)__builtin_amdgcn_update_dpp((int)zee.y, (int)zcc.y, 0x101, 0xf, 0xf, false);
            u32x2 zp = dir ? up : lo, zn = dir ? lo : up;
            if (!hasp) { zp.x = 0u; zp.y = 0u; } if (!hasn) { zn.x = 0u; zn.y = 0u; }
            const f32x4 mp = *(const LAS f32x4*)(C + grp * 64 + 16 * ct + 4 * g), mn = *(const LAS f32x4*)(C + 320 + grp * 64 + 16 * ct + 4 * g);
            float zv[4] = {__uint_as_float(zcc.x << 16), __uint_as_float(zcc.x & 0xffff0000u), __uint_as_float(zcc.y << 16), __uint_as_float(zcc.y & 0xffff0000u)};
            float pv[4] = {__uint_as_float(zp.x << 16), __uint_as_float(zp.x & 0xffff0000u), __uint_as_float(zp.y << 16), __uint_as_float(zp.y & 0xffff0000u)};
            float nv[4] = {__uint_as_float(zn.x << 16), __uint_as_float(zn.x & 0xffff0000u), __uint_as_float(zn.y << 16), __uint_as_float(zn.y & 0xffff0000u)};
#pragma unroll
            for (int r = 0; r < 4; ++r) {
                const float o = zv[r] + mp[r] * (pv[r] - zv[r]) + mn[r] * (nv[r] - zv[r]);
                if (grp == 0) rv[ct][r] = o; else if (grp == 1) kv[ct][r] = o; else if (grp == 2) vv[ct][r] = o;
                else if (grp == 3) { const float e2 = __expf(2.0f * o); tw[ct][r] = 1.0f - 2.0f / (e2 + 1.0f); } else xa[ct][r] = o;
            }
        }
    }
#pragma unroll
    for (int ct = 0; ct < 4; ++ct)
#pragma unroll
        for (int r = 0; r < 4; ++r)
            *(LAS bf16*)(buf + (S_V + (ct >> 1)) * SLOT + (4 * g + r + 16 * (s >> 2)) * 16 + (ct & 1) * 8 + 2 * (s & 3)) = (bf16)f2bf(vv[ct][r]);
    f32x4 accw[4], acca[4];
    { const bf16x8 tb0 = frag8(tw[0], tw[1]), tb1 = frag8(tw[2], tw[3]), xb0 = frag8(xa[0], xa[1]), xb1 = frag8(xa[2], xa[3]);
      const LAS bf16x8* F = (const LAS bf16x8*)(L + OFF_LORA);
#pragma unroll
      for (int ct = 0; ct < 4; ++ct) {
          f32x4 z4 = {0.f, 0.f, 0.f, 0.f};
          accw[ct] = mma(F[(0 * 8 + ct * 2 + 0) * 64 + lane], tb0, z4); accw[ct] = mma(F[(0 * 8 + ct * 2 + 1) * 64 + lane], tb1, accw[ct]);
          acca[ct] = mma(F[(1 * 8 + ct * 2 + 0) * 64 + lane], xb0, z4); acca[ct] = mma(F[(1 * 8 + ct * 2 + 1) * 64 + lane], xb1, acca[ct]);
      } }
    float ev[4][4], kk[4][4], kd[4][4], bb[4][4];
    float ss = 0.f, bon = 0.f;
#pragma unroll
    for (int ct = 0; ct < 4; ++ct) {
        const f32x4 w0 = *(const LAS f32x4*)(C + 640 + 16 * ct + 4 * g), a0 = *(const LAS f32x4*)(C + 704 + 16 * ct + 4 * g), kkw = *(const LAS f32x4*)(C + 768 + 16 * ct + 4 * g),
                    kaw = *(const LAS f32x4*)(C + 832 + 16 * ct + 4 * g), rkw = *(const LAS f32x4*)(C + 896 + 16 * ct + 4 * g);
#pragma unroll
        for (int r = 0; r < 4; ++r) {
            ev[ct][r] = 0.60653065971f * fsigmoid(accw[ct][r] + w0[r]);
            const float a = fsigmoid(acca[ct][r] + a0[r]);
            const float k = kv[ct][r];
            kk[ct][r] = k * kkw[r]; ss += kk[ct][r] * kk[ct][r];
            kd[ct][r] = k * (1.0f + (a - 1.0f) * kaw[r]);
            bb[ct][r] = a;
            bon += rv[ct][r] * k * a * kaw[r] * rkw[r];
        }
    }
    ss += __shfl_xor(ss, 16); ss += __shfl_xor(ss, 32);
    bon += __shfl_xor(bon, 16); bon += __shfl_xor(bon, 32);
    if (g == 0) BON[((size_t)dir * T + tok) * NH + h] = bon;
    const float rn = 1.0f / sqrtf(fmaxf(ss, 1e-12f));
    float KKs[4][4], Rs[4][4], Bt[4][4], Kt[4][4];
#pragma unroll
    for (int ct = 0; ct < 4; ++ct) {
        float gcv[4];
#pragma unroll
        for (int r = 0; r < 4; ++r) {
            const float e = ev[ct][r];
            float cum = e;
            cum += row_shr<1>(cum); cum += row_shr<2>(cum); cum += row_shr<4>(cum); cum += row_shr<8>(cum);
            const float cumC = __shfl(cum, (lane & 48) | 15);
            const float kkn = kk[ct][r] * rn, bv = kkn * bb[ct][r];
            const float ig = __expf(cum), rat = __expf(cum - cumC);
            KKs[ct][r] = kkn * __expf(e - cum); Rs[ct][r] = rv[ct][r] * __expf(-cum);
            Bt[ct][r] = bv * ig; Kt[ct][r] = kd[ct][r] * ig;
            gcv[r] = __expf(-cumC);
            LAS unsigned char* q = buf + (S_BK + ct) * SLOT + (4 * g + r + 16 * (s >> 2)) * 16 + 2 * (s & 3);
            *(LAS bf16*)q = (bf16)f2bf(bv * rat); *(LAS bf16*)(q + 8) = (bf16)f2bf(kd[ct][r] * rat);
        }
        if (s == 15) *(LAS f32x4*)(buf + S_GC * SLOT + (16 * ct + 4 * g) * 4) = (f32x4){gcv[0], gcv[1], gcv[2], gcv[3]};
    }
    const bf16x8 fKK0 = frag8(KKs[0], KKs[1]), fKK1 = frag8(KKs[2], KKs[3]), fR0 = frag8(Rs[0], Rs[1]), fR1 = frag8(Rs[2], Rs[3]);
    const bf16x8 fB0 = frag8(Bt[0], Bt[1]), fB1 = frag8(Bt[2], Bt[3]), fK0 = frag8(Kt[0], Kt[1]), fK1 = frag8(Kt[2], Kt[3]);
    *(LAS bf16x8*)(buf + (S_KK + 0) * SLOT + lane * 16) = fKK0; *(LAS bf16x8*)(buf + (S_KK + 1) * SLOT + lane * 16) = fKK1;
    *(LAS bf16x8*)(buf + (S_R + 0) * SLOT + lane * 16) = fR0;  *(LAS bf16x8*)(buf + (S_R + 1) * SLOT + lane * 16) = fR1;
    const f32x4 z4 = {0.f, 0.f, 0.f, 0.f};
    { f32x4 mab = mma(fKK0, fB0, z4); mab = mma(fKK1, fB1, mab);
      *(LAS f32x4*)(MT + s * 16 + 4 * g) = mab; }
    f32x4 mak = mma(fK0, fKK0, z4); mak = mma(fK1, fKK1, mak);
    f32x4 nrb = mma(fB0, fR0, z4); nrb = mma(fB1, fR1, nrb);
    f32x4 nrk = mma(fK0, fR0, z4); nrk = mma(fK1, fR1, nrk);
#pragma unroll
    for (int r = 0; r < 4; ++r) { const int i = 4 * g + r; if (!(i < s)) mak[r] = 0.f; if (!(i <= s)) { nrb[r] = 0.f; nrk[r] = 0.f; } }
    *(LAS v4u*)(buf + S_N * SLOT + lane * 16) = (v4u){cvtpk(nrb[0], nrb[1]), cvtpk(nrb[2], nrb[3]), cvtpk(nrk[0], nrk[1]), cvtpk(nrk[2], nrk[3])};
    asm volatile("s_waitcnt lgkmcnt(0)" ::: "memory"); __builtin_amdgcn_wave_barrier();
    float Tr[16];
#pragma unroll
    for (int j = 15; j >= 0; --j) {
        float acc = 0.f;
#pragma unroll
        for (int i = j + 1; i < 16; ++i) acc += Tr[i] * MT[j * 16 + i];
        Tr[j] = (j == s) ? 1.0f : -acc;
        if (j > s) Tr[j] = 0.f;
    }
    float t0 = 0.f, t1 = 0.f, t2 = 0.f, t3 = 0.f;
#pragma unroll
    for (int gg = 0; gg < 4; ++gg) if (g == gg) { t0 = Tr[4 * gg]; t1 = Tr[4 * gg + 1]; t2 = Tr[4 * gg + 2]; t3 = Tr[4 * gg + 3]; }
    *(LAS v4u*)(buf + S_MT * SLOT + lane * 16) = (v4u){cvtpk(mak[0], mak[1]), cvtpk(mak[2], mak[3]), cvtpk(-t0, -t1), cvtpk(-t2, -t3)};
    asm volatile("s_waitcnt lgkmcnt(0)" ::: "memory"); __builtin_amdgcn_wave_barrier();
}

__device__ __forceinline__ void rec_chunk(const LAS unsigned char* buf, f32x4 (&st)[4], float* Y, int b, int h, int dir, int n, int w, int lane) {
    const int g = lane >> 4, col = lane & 15;
    const bf16x8 fKK0 = *(const LAS bf16x8*)(buf + (S_KK + 0) * SLOT + lane * 16), fKK1 = *(const LAS bf16x8*)(buf + (S_KK + 1) * SLOT + lane * 16);
    const bf16x8 fR0 = *(const LAS bf16x8*)(buf + (S_R + 0) * SLOT + lane * 16), fR1 = *(const LAS bf16x8*)(buf + (S_R + 1) * SLOT + lane * 16);
    const v4u mt = *(const LAS v4u*)(buf + S_MT * SLOT + lane * 16);
    const bf16x8 fN = *(const LAS bf16x8*)(buf + S_N * SLOT + lane * 16);
    const u32x2 vf = *(const LAS u32x2*)(buf + (S_V + (w >> 1)) * SLOT + lane * 16 + (w & 1) * 8);
    const f32x4 z4 = {0.f, 0.f, 0.f, 0.f};
    const bf16x8 sb0 = mkfrag(cvtpk(st[0][0], st[0][1]), cvtpk(st[0][2], st[0][3]), cvtpk(st[1][0], st[1][1]), cvtpk(st[1][2], st[1][3]));
    const bf16x8 sb1 = mkfrag(cvtpk(st[2][0], st[2][1]), cvtpk(st[2][2], st[2][3]), cvtpk(st[3][0], st[3][1]), cvtpk(st[3][2], st[3][3]));
    f32x4 p1 = mma(fKK0, sb0, z4); p1 = mma(fKK1, sb1, p1);
    f32x4 p2 = mma(fR0, sb0, z4); p2 = mma(fR1, sb1, p2);
    const f32x4 x = mma(mkfrag(0u, 0u, mt.x, mt.y), mkfrag(0u, 0u, vf.x, vf.y), p1);
    const f32x4 u = mma(mkfrag(mt.z, mt.w, 0u, 0u), mkfrag(cvtpk(x[0], x[1]), cvtpk(x[2], x[3]), 0u, 0u), z4);
    const bf16x8 buv = mkfrag(cvtpk(u[0], u[1]), cvtpk(u[2], u[3]), vf.x, vf.y);
    const f32x4 y = mma(fN, buv, p2);
#pragma unroll
    for (int i = 0; i < 4; ++i) {
        const f32x4 gc = *(const LAS f32x4*)(buf + S_GC * SLOT + (16 * i + 4 * g) * 4);
        const bf16x8 fBK = *(const LAS bf16x8*)(buf + (S_BK + i) * SLOT + lane * 16);
        st[i] = mma(fBK, buv, st[i] * gc);
    }
    const int cn = dir ? (SEQ / 16 - 1 - n) : n;
#pragma unroll
    for (int r = 0; r < 4; ++r) { const int s = 4 * g + r, t = cn * 16 + (dir ? 15 - s : s);
        Y[((size_t)dir * T + (size_t)(b * SEQ + t)) * RW + h * 64 + 16 * w + col] = y[r]; }
}

__device__ __forceinline__ void chain(LAS unsigned char* L, const bf16* Z, const float* mu_prev, const float* mu_next, const float* w_decay0, const float* w_decay_up,
                                      const float* a_gate0, const float* a_gate_up, const float* k_k, const float* k_a, const float* r_k, float* Y, float* BON, int ch, int tid, int wave, int lane) {
    const int dir = ch & 1, h = (ch >> 1) & 7, b = ch >> 4;
    __syncthreads();
    setup(L, h, dir, mu_prev, mu_next, w_decay0, w_decay_up, a_gate0, a_gate_up, k_k, k_a, r_k, tid);
    __syncthreads();
    f32x4 st[4];
#pragma unroll
    for (int i = 0; i < 4; ++i) st[i] = (f32x4){0.f, 0.f, 0.f, 0.f};
    constexpr int NCH = SEQ / 16, NR = NCH / 4;
    for (int q = -1; q < NR; ++q) {
        if (wave < 4) {
            if (q >= 0) {
#pragma unroll 1
                for (int i = 0; i < 4; ++i) rec_chunk(L + ((q & 1) * 4 + i) * BUF_BYTES, st, Y, b, h, dir, 4 * q + i, wave, lane);
            }
        } else if (q + 1 < NR) {
            const int hw = wave - 4;
            helper_chunk(L, L + (((q + 1) & 1) * 4 + hw) * BUF_BYTES, (LAS float*)(L + OFF_MT + hw * 1024), Z, BON, b, h, dir, 4 * (q + 1) + hw, lane);
        }
        __syncthreads();
    }
}
}

namespace attn {
typedef unsigned u32x2 __attribute__((ext_vector_type(2)));
constexpr int VT_STRIDE = 136;
constexpr int KF_OFF = 64 * VT_STRIDE;
constexpr int WAVE_LDS = KF_OFF + 8 * 1024;
constexpr float LOG2E = 1.44269504088896f, LN2 = 0.693147180559945f;
using scan::cvtpk; using scan::mkfrag; using scan::mma;

__device__ __forceinline__ void unpack8(const v4u w, float (&f)[8]) {
    f[0] = __uint_as_float(w.x << 16); f[1] = __uint_as_float(w.x & 0xffff0000u); f[2] = __uint_as_float(w.y << 16); f[3] = __uint_as_float(w.y & 0xffff0000u);
    f[4] = __uint_as_float(w.z << 16); f[5] = __uint_as_float(w.z & 0xffff0000u); f[6] = __uint_as_float(w.w << 16); f[7] = __uint_as_float(w.w & 0xffff0000u);
}

__device__ __forceinline__ void unit(LAS unsigned char* vt, const bf16* Z, const float* qg, const float* kg, bf16* Ob, int opitch, float* lse_out,
                                     int b, int h, int d, int r, int qb, int nb, int lane) {
    const int g = lane >> 4, c16 = lane & 15;
    const float slope2 = exp2f(-(float)(h + 1)) * LOG2E * (float)d;
    float gn[16];
#pragma unroll
    for (int m = 0; m < 2; ++m)
#pragma unroll
        for (int j = 0; j < 8; ++j) gn[m * 8 + j] = qg[32 * m + 8 * g + j] * kg[32 * m + 8 * g + j];
    bf16x8 qf[4][2];
#pragma unroll
    for (int qt = 0; qt < 4; ++qt) {
        const int tok = b * SEQ + (qb * 64 + 16 * qt + c16) * d + r;
        const bf16* qp = Z + (size_t)tok * INW + h * 64 + 8 * g;
        float f0[8], f1[8]; unpack8(*(const v4u*)qp, f0); unpack8(*(const v4u*)(qp + 32), f1);
        float ss = 0.f;
#pragma unroll
        for (int j = 0; j < 8; ++j) ss += f0[j] * f0[j] + f1[j] * f1[j];
        ss += __shfl_xor(ss, 16); ss += __shfl_xor(ss, 32);
        const float rs = (0.125f * LOG2E) / sqrtf(ss * (1.f / 64.f) + 1e-6f);
        qf[qt][0] = mkfrag(cvtpk(f0[0] * rs * gn[0], f0[1] * rs * gn[1]), cvtpk(f0[2] * rs * gn[2], f0[3] * rs * gn[3]), cvtpk(f0[4] * rs * gn[4], f0[5] * rs * gn[5]), cvtpk(f0[6] * rs * gn[6], f0[7] * rs * gn[7]));
        qf[qt][1] = mkfrag(cvtpk(f1[0] * rs * gn[8], f1[1] * rs * gn[9]), cvtpk(f1[2] * rs * gn[10], f1[3] * rs * gn[11]), cvtpk(f1[4] * rs * gn[12], f1[5] * rs * gn[13]), cvtpk(f1[6] * rs * gn[14], f1[7] * rs * gn[15]));
    }
    f32x4 oacc[4][4];
    float mrun[4], lrun[4];
#pragma unroll
    for (int qt = 0; qt < 4; ++qt) { mrun[qt] = -1e30f; lrun[qt] = 0.f;
#pragma unroll
        for (int dt = 0; dt < 4; ++dt) oacc[dt][qt] = (f32x4){0.f, 0.f, 0.f, 0.f}; }
    const f32x4 z4 = {0.f, 0.f, 0.f, 0.f};
#pragma unroll 1
    for (int kb = qb - 1; kb <= qb + 1; ++kb) {
        if (kb < 0 || kb >= nb) continue;
#pragma unroll
        for (int kblk = 0; kblk < 4; ++kblk) {
            const int tok = b * SEQ + (kb * 64 + 16 * kblk + c16) * d + r;
            const bf16* kp = Z + (size_t)tok * INW + AW + h * 64 + 8 * g;
            float f0[8], f1[8]; unpack8(*(const v4u*)kp, f0); unpack8(*(const v4u*)(kp + 32), f1);
            float ss = 0.f;
#pragma unroll
            for (int j = 0; j < 8; ++j) ss += f0[j] * f0[j] + f1[j] * f1[j];
            ss += __shfl_xor(ss, 16); ss += __shfl_xor(ss, 32);
            const float rsk = 1.0f / sqrtf(ss * (1.f / 64.f) + 1e-6f);
            *(LAS v4u*)(vt + KF_OFF + (kblk * 2 + 0) * 1024 + lane * 16) = (v4u){cvtpk(f0[0] * rsk, f0[1] * rsk), cvtpk(f0[2] * rsk, f0[3] * rsk), cvtpk(f0[4] * rsk, f0[5] * rsk), cvtpk(f0[6] * rsk, f0[7] * rsk)};
            *(LAS v4u*)(vt + KF_OFF + (kblk * 2 + 1) * 1024 + lane * 16) = (v4u){cvtpk(f1[0] * rsk, f1[1] * rsk), cvtpk(f1[2] * rsk, f1[3] * rsk), cvtpk(f1[4] * rsk, f1[5] * rsk), cvtpk(f1[6] * rsk, f1[7] * rsk)};
        }
#pragma unroll
        for (int i = 0; i < 8; ++i) {
            const int key = 8 * i + (lane >> 3), chunk = lane & 7;
            const int tok = b * SEQ + (kb * 64 + key) * d + r;
            const v4u w = *(const v4u*)(Z + (size_t)tok * INW + 2 * AW + h * 64 + 8 * chunk);
            LAS unsigned char* q = vt + (8 * chunk) * VT_STRIDE + 2 * key;
            *(LAS bf16*)(q + 0 * VT_STRIDE) = (bf16)(w.x & 0xffffu); *(LAS bf16*)(q + 1 * VT_STRIDE) = (bf16)(w.x >> 16);
            *(LAS bf16*)(q + 2 * VT_STRIDE) = (bf16)(w.y & 0xffffu); *(LAS bf16*)(q + 3 * VT_STRIDE) = (bf16)(w.y >> 16);
            *(LAS bf16*)(q + 4 * VT_STRIDE) = (bf16)(w.z & 0xffffu); *(LAS bf16*)(q + 5 * VT_STRIDE) = (bf16)(w.z >> 16);
            *(LAS bf16*)(q + 6 * VT_STRIDE) = (bf16)(w.w & 0xffffu); *(LAS bf16*)(q + 7 * VT_STRIDE) = (bf16)(w.w >> 16);
        }
        asm volatile("s_waitcnt lgkmcnt(0)" ::: "memory"); __builtin_amdgcn_wave_barrier();
        const int obase = (kb - qb) * 64;
#pragma unroll
        for (int qt = 0; qt < 4; ++qt) {
            f32x4 sa[4];
#pragma unroll
            for (int kblk = 0; kblk < 4; ++kblk) {
                const bf16x8 k0 = *(const LAS bf16x8*)(vt + KF_OFF + (kblk * 2 + 0) * 1024 + lane * 16), k1 = *(const LAS bf16x8*)(vt + KF_OFF + (kblk * 2 + 1) * 1024 + lane * 16);
                sa[kblk] = mma(k0, qf[qt][0], z4); sa[kblk] = mma(k1, qf[qt][1], sa[kblk]); }
            const int qi = 16 * qt + c16;
            float mx = -1e30f;
#pragma unroll
            for (int kblk = 0; kblk < 4; ++kblk)
#pragma unroll
                for (int reg = 0; reg < 4; ++reg) {
                    const int o = obase + 16 * kblk + 4 * g + reg - qi, ao = o < 0 ? -o : o;
                    float sv = sa[kblk][reg] - slope2 * (float)ao;
                    sv = (ao <= 64) ? sv : -1e30f;
                    sa[kblk][reg] = sv; mx = fmaxf(mx, sv);
                }
            mx = fmaxf(mx, __shfl_xor(mx, 16)); mx = fmaxf(mx, __shfl_xor(mx, 32));
            const float mn = fmaxf(mrun[qt], mx), alpha = exp2f(mrun[qt] - mn);
            mrun[qt] = mn;
            float ls = 0.f;
#pragma unroll
            for (int kblk = 0; kblk < 4; ++kblk)
#pragma unroll
                for (int reg = 0; reg < 4; ++reg) { const float p = exp2f(sa[kblk][reg] - mn); sa[kblk][reg] = p; ls += p; }
            lrun[qt] = lrun[qt] * alpha + ls;
            const bf16x8 pf0 = mkfrag(cvtpk(sa[0][0], sa[0][1]), cvtpk(sa[0][2], sa[0][3]), cvtpk(sa[1][0], sa[1][1]), cvtpk(sa[1][2], sa[1][3]));
            const bf16x8 pf1 = mkfrag(cvtpk(sa[2][0], sa[2][1]), cvtpk(sa[2][2], sa[2][3]), cvtpk(sa[3][0], sa[3][1]), cvtpk(sa[3][2], sa[3][3]));
#pragma unroll
            for (int dt = 0; dt < 4; ++dt) {
                const LAS unsigned char* vr = vt + (16 * dt + c16) * VT_STRIDE + 8 * g;
                const u32x2 a0 = *(const LAS u32x2*)(vr), a1 = *(const LAS u32x2*)(vr + 32), a2 = *(const LAS u32x2*)(vr + 64), a3 = *(const LAS u32x2*)(vr + 96);
                f32x4 oc = oacc[dt][qt] * alpha;
                oc = mma(mkfrag(a0.x, a0.y, a1.x, a1.y), pf0, oc);
                oc = mma(mkfrag(a2.x, a2.y, a3.x, a3.y), pf1, oc);
                oacc[dt][qt] = oc;
            }
            __builtin_amdgcn_sched_barrier(0);
        }
        asm volatile("s_waitcnt lgkmcnt(0)" ::: "memory"); __builtin_amdgcn_wave_barrier();
    }
#pragma unroll
    for (int qt = 0; qt < 4; ++qt) {
        float lt = lrun[qt]; lt += __shfl_xor(lt, 16); lt += __shfl_xor(lt, 32);
        const float inv = 1.0f / lt;
        const int tok = b * SEQ + (qb * 64 + 16 * qt + c16) * d + r;
        bf16* op = Ob + (size_t)tok * opitch + h * 64 + 4 * g;
#pragma unroll
        for (int dt = 0; dt < 4; ++dt) { const f32x4 o = oacc[dt][qt] * inv; u32x2 w; w.x = cvtpk(o[0], o[1]); w.y = cvtpk(o[2], o[3]); *(u32x2*)(op + 16 * dt) = w; }
        if (g == 0) lse_out[(size_t)tok * NH + h] = (mrun[qt] + log2f(lt)) * LN2;
    }
}
}

namespace peer {
using scan::cvtpk; using scan::mkfrag; using scan::mma;
constexpr int KEY_SLOTS = 64;

template <int CTRL> __device__ __forceinline__ unsigned dppu(unsigned x) { return (unsigned)__builtin_amdgcn_update_dpp((int)x, (int)x, CTRL, 0xf, 0xf, false); }
__device__ __forceinline__ unsigned umax(unsigned a, unsigned b) { return a > b ? a : b; }
__device__ __forceinline__ unsigned rowmax16(unsigned x) { x = umax(x, dppu<0xB1>(x)); x = umax(x, dppu<0x4E>(x)); x = umax(x, dppu<0x141>(x)); x = umax(x, dppu<0x140>(x)); return x; }
__device__ __forceinline__ float rowsum16(float x) {
    x += __uint_as_float(dppu<0xB1>(__float_as_uint(x))); x += __uint_as_float(dppu<0x4E>(__float_as_uint(x)));
    x += __uint_as_float(dppu<0x141>(__float_as_uint(x))); x += __uint_as_float(dppu<0x140>(__float_as_uint(x))); return x;
}
__device__ __forceinline__ unsigned ordkey(float f) { const unsigned u = __float_as_uint(f); return (u & 0x80000000u) ? ~u : (u | 0x80000000u); }
__device__ __forceinline__ float unordkey(unsigned k) { return __uint_as_float((k & 0x80000000u) ? (k ^ 0x80000000u) : ~k); }

__device__ __forceinline__ void setup_keys(LAS unsigned char* L, const float* keys1, const float* keys2, int tid) {
    LAS bf16* F = (LAS bf16*)L;
    for (int i = tid; i < KEY_SLOTS * 64 * 8; i += 512) {
        const int j = i & 7, l = (i >> 3) & 63, sl = i >> 9, ks = sl & 3, nt = (sl >> 2) & 7, sel = sl >> 5;
        const int n = 16 * nt + (l & 15), k = 32 * ks + 8 * (l >> 4) + j;
        F[i] = (bf16)f2bf((sel ? keys2 : keys1)[n * 128 + k]);
    }
}

__device__ __forceinline__ void top16(unsigned (&key)[8][4], unsigned (&win)[4], int c16) {
#pragma unroll 1
    for (int k = 0; k < TOPK; ++k) {
#pragma unroll
        for (int reg = 0; reg < 4; ++reg) {
            unsigned m = key[0][reg];
#pragma unroll
            for (int nt = 1; nt < 8; ++nt) m = umax(m, key[nt][reg]);
            m = rowmax16(m);
            win[reg] = (c16 == k) ? m : win[reg];
#pragma unroll
            for (int nt = 0; nt < 8; ++nt) key[nt][reg] = (key[nt][reg] == m) ? 0u : key[nt][reg];
        }
    }
}

__device__ __forceinline__ void select_batch(const LAS unsigned char* L, const bf16* Q, int* IDX, float* GATE, int batch, int lane) {
    const int g = lane >> 4, c16 = lane & 15;
    const LAS bf16x8* F = (const LAS bf16x8*)L;
    const bf16* qp = Q + (size_t)(batch * 16 + c16) * PKD + 8 * g;
    unsigned w1[4] = {0u, 0u, 0u, 0u}, w2[4] = {0u, 0u, 0u, 0u};
#pragma unroll
    for (int sel = 0; sel < 2; ++sel) {
        unsigned key[8][4];
        bf16x8 a[4];
#pragma unroll
        for (int ks = 0; ks < 4; ++ks) a[ks] = *(const bf16x8*)(qp + sel * 128 + 32 * ks);
#pragma unroll
        for (int nt = 0; nt < 8; ++nt) {
            f32x4 sc = {0.f, 0.f, 0.f, 0.f};
#pragma unroll
            for (int ks = 0; ks < 4; ++ks) sc = mma(a[ks], F[((sel * 8 + nt) * 4 + ks) * 64 + lane], sc);
#pragma unroll
            for (int reg = 0; reg < 4; ++reg) key[nt][reg] = (ordkey(sc[reg]) & ~127u) | (unsigned)(16 * nt + c16);
            __builtin_amdgcn_sched_barrier(0);
        }
        if (sel == 0) top16(key, w1, c16); else top16(key, w2, c16);
    }
    float f1[4], f2[4], cur2[4]; int ptr[4]; unsigned top[4];
#pragma unroll
    for (int reg = 0; reg < 4; ++reg) { f1[reg] = unordkey(w1[reg] & ~127u); f2[reg] = unordkey(w2[reg] & ~127u); ptr[reg] = 0; cur2[reg] = __shfl(f2[reg], lane & 48); top[reg] = 0u; }
#pragma unroll 1
    for (int k = 0; k < TOPK; ++k) {
#pragma unroll
        for (int reg = 0; reg < 4; ++reg) {
            const unsigned ck = (ptr[reg] < 16) ? ((ordkey(f1[reg] + cur2[reg]) & ~255u) | (unsigned)(c16 << 4) | (unsigned)ptr[reg]) : 0u;
            const unsigned m = rowmax16(ck);
            top[reg] = (c16 == k) ? m : top[reg];
            if ((int)((m >> 4) & 15u) == c16) ptr[reg] += 1;
            cur2[reg] = __shfl(f2[reg], (lane & 48) | (ptr[reg] & 15));
        }
    }
#pragma unroll
    for (int reg = 0; reg < 4; ++reg) {
        const int a = (top[reg] >> 4) & 15, bq = top[reg] & 15;
        const int e1 = (int)(__shfl(w1[reg], (lane & 48) | a) & 127u), e2 = (int)(__shfl(w2[reg], (lane & 48) | bq) & 127u);
        const float ts = unordkey(top[reg] & ~255u), mx = __shfl(ts, lane & 48);
        const float ex = __expf(ts - mx), sum = rowsum16(ex);
        const size_t o = (size_t)(batch * 16 + 4 * g + reg) * TOPK + c16;
        IDX[o] = e1 * NKEYS + e2; GATE[o] = ex / sum;
    }
}

__device__ __forceinline__ void convert_table(const float* src, bf16* dst, size_t n8, size_t gtid, size_t gthreads) {
    for (size_t i = gtid; i < n8; i += gthreads) {
        const f32x4 a = *(const f32x4*)(src + i * 8), b = *(const f32x4*)(src + i * 8 + 4);
        v4u o; o.x = cvtpk(a.x, a.y); o.y = cvtpk(a.z, a.w); o.z = cvtpk(b.x, b.y); o.w = cvtpk(b.z, b.w);
        *(v4u*)(dst + i * 8) = o;
    }
}

__device__ __forceinline__ float dot2bf(unsigned w, unsigned x, float acc) {
    typedef __bf16 bf2 __attribute__((ext_vector_type(2)));
    return __builtin_amdgcn_fdot2_f32_bf16(__builtin_bit_cast(bf2, w), __builtin_bit_cast(bf2, x), acc, false);
}
__device__ __forceinline__ float gelu_erf(float v) {
    const float av = fabsf(v), t = __builtin_amdgcn_rcpf(av * 0.2316418882f + 1.0f);
    float q = t * 0.5307027145f + (-0.7265760135f); q = q * t + 0.7107068705f; q = q * t + (-0.142248368f); q = q * t + 0.127414796f; q = q * t;
    const float e = __builtin_amdgcn_exp2f((v * v) * (-0.72134752044f));
    const float m = v * (q * e);
    return v < 0.f ? m : v - m;
}

__device__ __forceinline__ void ffn_u_token(const bf16* XN, const int* IDX, const bf16* UT, float* PART, int sl, int tok, int lane) {
    const int g = lane >> 4, c16 = lane & 15;
    const v4u x = *(const v4u*)(XN + (size_t)tok * D + 128 * sl + 8 * c16);
    const int id0 = IDX[(size_t)tok * HK + lane], id1 = IDX[(size_t)tok * HK + 64 + lane];
    float r0 = 0.f, r1 = 0.f;
#pragma unroll
    for (int i0 = 0; i0 < 32; i0 += 8) {
        v4u u[8];
#pragma unroll
        for (int k = 0; k < 8; ++k) { const int i = i0 + k; const int ex = __shfl((i < 16) ? id0 : id1, (4 * i + g) & 63); u[k] = *(const v4u*)(UT + (size_t)ex * D + 128 * sl + 8 * c16); }
#pragma unroll
        for (int k = 0; k < 8; ++k) { const int i = i0 + k;
            float dot = dot2bf(u[k].x, x.x, 0.f); dot = dot2bf(u[k].y, x.y, dot); dot = dot2bf(u[k].z, x.z, dot); dot = dot2bf(u[k].w, x.w, dot);
            dot = rowsum16(dot);
            if (c16 == (i & 15)) { if (i < 16) r0 = dot; else r1 = dot; } }
    }
    float* pp = PART + ((size_t)sl * T + tok) * HK + 4 * c16 + g;
    pp[0] = r0; pp[64] = r1;
}
__device__ __forceinline__ void ffn_v_token(const int* IDX, const float* COEF, const bf16* VT, const float* mod, float* out, int sl, int tok, int lane) {
    const int g = lane >> 4, c16 = lane & 15, b = tok / SEQ;
    const int id0 = IDX[(size_t)tok * HK + lane], id1 = IDX[(size_t)tok * HK + 64 + lane];
    const float cf0 = COEF[(size_t)tok * HK + lane], cf1 = COEF[(size_t)tok * HK + 64 + lane];
    float y[8];
#pragma unroll
    for (int k = 0; k < 8; ++k) y[k] = 0.f;
#pragma unroll
    for (int i0 = 0; i0 < 32; i0 += 8) {
        v4u v[8]; float cf[8];
#pragma unroll
        for (int k = 0; k < 8; ++k) { const int i = i0 + k; const int src = (4 * i + g) & 63; const int ex = __shfl((i < 16) ? id0 : id1, src); cf[k] = __shfl((i < 16) ? cf0 : cf1, src);
            v[k] = *(const v4u*)(VT + (size_t)ex * D + 128 * sl + 8 * c16); }
#pragma unroll
        for (int k = 0; k < 8; ++k) {
            y[0] += cf[k] * __uint_as_float(v[k].x << 16); y[1] += cf[k] * __uint_as_float(v[k].x & 0xffff0000u); y[2] += cf[k] * __uint_as_float(v[k].y << 16); y[3] += cf[k] * __uint_as_float(v[k].y & 0xffff0000u);
            y[4] += cf[k] * __uint_as_float(v[k].z << 16); y[5] += cf[k] * __uint_as_float(v[k].z & 0xffff0000u); y[6] += cf[k] * __uint_as_float(v[k].w << 16); y[7] += cf[k] * __uint_as_float(v[k].w & 0xffff0000u);
        }
    }
#pragma unroll
    for (int k = 0; k < 8; ++k) { y[k] += __shfl_xor(y[k], 16); y[k] += __shfl_xor(y[k], 32); }
    if (g == 0) {
        const int col = 128 * sl + 8 * c16; const size_t o = (size_t)tok * D + col;
        const f32x4 ga = *(const f32x4*)(mod + b * MODW + 5 * D + col), gb = *(const f32x4*)(mod + b * MODW + 5 * D + col + 4);
        f32x4 oa = *(const f32x4*)(out + o), ob = *(const f32x4*)(out + o + 4);
        oa.x += ga.x * y[0]; oa.y += ga.y * y[1]; oa.z += ga.z * y[2]; oa.w += ga.w * y[3];
        ob.x += gb.x * y[4]; ob.y += gb.y * y[5]; ob.z += gb.z * y[6]; ob.w += gb.w * y[7];
        *(f32x4*)(out + o) = oa; *(f32x4*)(out + o + 4) = ob;
    }
}
}

namespace fin {
using scan::cvtpk; using scan::mkfrag; using scan::mma;
typedef unsigned u32x2 __attribute__((ext_vector_type(2)));

__device__ __forceinline__ float shift3(const bf16* p, bool hasp, bool hasn, float mp, float mn) {
    const float z = bf2f(p[0]), zp = hasp ? bf2f(p[-INW]) : 0.f, zn = hasn ? bf2f(p[INW]) : 0.f;
    return z + mp * (zp - z) + mn * (zn - z);
}

__device__ __forceinline__ void phase(LAS unsigned char* L, const bf16* Z, const float* mu_prev, const float* mu_next, const float* g_up, const float* Y, const float* BON,
                                      const float* k_a, const float* r_k, const float* lnx_g, const float* lnx_b, bf16* mix, const bf16* O3, const float* LSE,
                                      int bx, int G, int tid, int wave, int lane) {
    const int g = lane >> 4, c16 = lane & 15;
    LAS bf16* sg = (LAS bf16*)L;
    bf16x8 bf[4][4];
#pragma unroll
    for (int nt = 0; nt < 4; ++nt)
#pragma unroll
        for (int ks = 0; ks < 4; ++ks) {
            const float* p = g_up + (size_t)(32 * ks + 8 * g) * RW + 64 * wave + 16 * nt + c16;
            bf[nt][ks] = mkfrag(cvtpk(p[0], p[RW]), cvtpk(p[2 * RW], p[3 * RW]), cvtpk(p[4 * RW], p[5 * RW]), cvtpk(p[6 * RW], p[7 * RW]));
        }
    float mpr[4], mnr[4], mpk[4], mnk[4], mpv[4], mnv[4], ka1[4], rk1[4], lg[4], lb[4];
#pragma unroll
    for (int nt = 0; nt < 4; ++nt) { const int c = 64 * wave + 16 * nt + c16;
        mpr[nt] = mu_prev[c]; mnr[nt] = mu_next[c]; mpk[nt] = mu_prev[RW + c]; mnk[nt] = mu_next[RW + c]; mpv[nt] = mu_prev[2 * RW + c]; mnv[nt] = mu_next[2 * RW + c];
        ka1[nt] = k_a[c]; rk1[nt] = r_k[c]; lg[nt] = lnx_g[c]; lb[nt] = lnx_b[c]; }
    for (int tb = bx; tb < T / 16; tb += G) {
        const int tok0 = tb * 16;
        __syncthreads();
        {
            const int tl = tid >> 5, j0 = (tid & 31) * 4, tok = tok0 + tl, t = tok % SEQ;
            const bf16* p = Z + (size_t)tok * INW + 3 * AW + 3 * RW + DL + AL + j0;
            const bool hasp = t > 0, hasn = t < SEQ - 1;
            float o[4];
#pragma unroll
            for (int e = 0; e < 4; ++e) { const float v = shift3(p + e, hasp, hasn, mu_prev[3 * RW + DL + AL + j0 + e], mu_next[3 * RW + DL + AL + j0 + e]); o[e] = 1.0f / (1.0f + __expf(-v)); }
            u32x2 w; w.x = cvtpk(o[0], o[1]); w.y = cvtpk(o[2], o[3]);
            *(LAS u32x2*)(sg + tl * 128 + j0) = w;
        }
        __syncthreads();
        f32x4 ga[4];
        {
            bf16x8 af[4];
#pragma unroll
            for (int ks = 0; ks < 4; ++ks) af[ks] = *(const LAS bf16x8*)(sg + c16 * 128 + 32 * ks + 8 * g);
#pragma unroll
            for (int nt = 0; nt < 4; ++nt) { f32x4 a = {0.f, 0.f, 0.f, 0.f};
#pragma unroll
                for (int ks = 0; ks < 4; ++ks) a = mma(af[ks], bf[nt][ks], a);
                ga[nt] = a; }
        }
#pragma unroll
        for (int reg = 0; reg < 4; ++reg) {
            const int tok = tok0 + 4 * g + reg, t = tok % SEQ;
            const bool hasp = t > 0, hasn = t < SEQ - 1;
            const bf16* zr = Z + (size_t)tok * INW + 3 * AW + 64 * wave + c16;
            float yv[4], rr[4], kk[4], vv[4], s1 = 0.f, sb = 0.f;
#pragma unroll
            for (int nt = 0; nt < 4; ++nt) {
                const size_t o = (size_t)tok * RW + 64 * wave + 16 * nt + c16;
                yv[nt] = Y[o] + Y[(size_t)T * RW + o]; s1 += yv[nt];
                rr[nt] = shift3(zr + 16 * nt, hasp, hasn, mpr[nt], mnr[nt]); kk[nt] = shift3(zr + RW + 16 * nt, hasp, hasn, mpk[nt], mnk[nt]); vv[nt] = shift3(zr + 2 * RW + 16 * nt, hasp, hasn, mpv[nt], mnv[nt]);
                sb += rr[nt] * kk[nt] * rk1[nt] * (1.0f - ka1[nt]);
            }
            const float mean = peer::rowsum16(s1) * (1.f / 64.f);
            float s2 = 0.f;
#pragma unroll
            for (int nt = 0; nt < 4; ++nt) s2 += (yv[nt] - mean) * (yv[nt] - mean);
            const float rstd = 1.0f / sqrtf(peer::rowsum16(s2) * (1.f / 64.f) + 64e-5f);
            const float bs = peer::rowsum16(sb) + 0.5f * (BON[(size_t)tok * NH + wave] + BON[((size_t)T + tok) * NH + wave]);
            const float l1 = LSE[(size_t)tok * NH + wave], l2 = LSE[((size_t)T + tok) * NH + wave], l3 = LSE[((size_t)2 * T + tok) * NH + wave];
            const float lm = fmaxf(l1, fmaxf(l2, l3)), w1 = __expf(l1 - lm), w2 = __expf(l2 - lm), w3 = __expf(l3 - lm), wi = 1.0f / (w1 + w2 + w3);
#pragma unroll
            for (int nt = 0; nt < 4; ++nt) {
                const int c = 64 * wave + 16 * nt + c16;
                bf16* mp = mix + (size_t)tok * D + c;
                const float att = (w1 * bf2f(mp[0]) + w2 * bf2f(mp[AW]) + w3 * bf2f(O3[(size_t)tok * AW + c])) * wi;
                const float yn = (yv[nt] - mean) * rstd * lg[nt] + lb[nt];
                mp[0] = (bf16)f2bf(att);
                mp[AW] = (bf16)f2bf((yn + bs * vv[nt]) * ga[nt][reg]);
            }
        }
    }
}
}

#ifndef MK_SKIP
#define MK_SKIP 0
#endif
constexpr int N_PHASES = 12;
struct Args { const float* in[27]; float* out; unsigned char* ws; int ph_lo, ph_hi, li, pad; };

__global__ void __launch_bounds__(NWAVES * 64, 2) mk_fwd(Args args) {
    extern __shared__ __attribute__((aligned(16))) unsigned char lds[];
    LAS unsigned char* L = (LAS unsigned char*)lds;
    volatile LAS unsigned* MISC = (volatile LAS unsigned*)(L + MISC_OFF);
    const int tid = threadIdx.x, lane = tid & 63, wave = __builtin_amdgcn_readfirstlane(tid >> 6);
    const int G = gridDim.x, bx = blockIdx.x;
    unsigned char* ws = args.ws;
    gu32* ctl = (gu32*)(ws + WS_CTL);
    const float* x = args.in[0]; const float* cvec = args.in[1]; const float* ada_w = args.in[2]; const float* ada_b = args.in[3];
    const float* norm1_g = args.in[4]; const float* w_in = args.in[5]; const float* mu_prev = args.in[6]; const float* mu_next = args.in[7];
    const float* q_norm_g = args.in[8]; const float* k_norm_g = args.in[9]; const float* w_decay0 = args.in[10]; const float* w_decay_up = args.in[11];
    const float* a_gate0 = args.in[12]; const float* a_gate_up = args.in[13]; const float* g_up = args.in[14]; const float* k_k = args.in[15];
    const float* k_a = args.in[16]; const float* r_k = args.in[17]; const float* lnx_g = args.in[18]; const float* lnx_b = args.in[19];
    const float* w_out = args.in[20]; const float* norm2_g = args.in[21]; const float* w_query = args.in[22]; const float* keys1 = args.in[23];
    const float* keys2 = args.in[24]; const float* peer_u = args.in[25]; const float* peer_v = args.in[26];
    float* out = args.out;
    float* MOD = (float*)(ws + WS_MOD); bf16* KEYS = (bf16*)(ws + WS_KEYS); bf16* WIN = (bf16*)(ws + WS_WIN); bf16* WOUT = (bf16*)(ws + WS_WOUT); bf16* WQ = (bf16*)(ws + WS_WQ);
    bf16* XN = (bf16*)(ws + WS_XN); bf16* Z = (bf16*)(ws + WS_Z); bf16* MIX = (bf16*)(ws + WS_MIX); float* Y = (float*)(ws + WS_Y); bf16* Q = (bf16*)(ws + WS_Q);
    int* IDX = (int*)(ws + WS_IDX); float* GATE = (float*)(ws + WS_GATE); float* BON = (float*)(ws + WS_BON);
    bf16* O3 = (bf16*)(ws + WS_O3); float* LSE = (float*)(ws + WS_LSE); bf16* UT = (bf16*)(ws + WS_UT); bf16* VT = (bf16*)(ws + WS_VT); float* PART = (float*)(ws + WS_PART);

    for (int u = tid; u < (LDS_BYTES - LDSCTL_OFF) / 4; u += NWAVES * 64) ((LAS unsigned*)(L + LDSCTL_OFF))[u] = 0u;
    __syncthreads();
    XcdBarrier bar = xcd_barrier_post((unsigned*)(ctl + CW_BAR) + args.li * XCD_BAR_WORDS, MISC + 8);
    const int lo = args.ph_lo, hi = args.ph_hi;
#define IN(k) (lo <= (k) && (k) < hi)
#define SEAM(k) do { if (IN(k) && IN((k) + 1)) xcd_barrier(bar); } while (0)
    const int gw = bx * NWAVES + wave, NGW = G * NWAVES;

    if (IN(0) && !(MK_SKIP & (1 << 0))) {
        if (bx < MODW / 64) {
            LAS float* sc = (LAS float*)L; LAS float* part = (LAS float*)(L + 32768);
            for (int i = tid; i < BATCH * D; i += NWAVES * 64) { const float cv = cvec[i]; sc[i] = cv / (1.f + expf(-cv)); }
            __syncthreads();
            const int j0 = bx * 64;
            float acc[BATCH];
#pragma unroll
            for (int b = 0; b < BATCH; ++b) acc[b] = 0.f;
            for (int i = wave * 128; i < wave * 128 + 128; ++i) { const float w = ada_w[(size_t)i * MODW + j0 + lane];
#pragma unroll
                for (int b = 0; b < BATCH; ++b) acc[b] += sc[b * D + i] * w; }
#pragma unroll
            for (int b = 0; b < BATCH; ++b) part[(wave * 8 + b) * 64 + lane] = acc[b];
            __syncthreads();
            { const int b = tid >> 6; float s = 0.f;
#pragma unroll
              for (int w = 0; w < 8; ++w) s += part[(w * 8 + b) * 64 + lane];
              MOD[b * MODW + j0 + lane] = s + ada_b[j0 + lane]; }
            __syncthreads();
        }
        LAS float* scr = (LAS float*)(L + RING_OFF + wave * 16384);
        constexpr int I_IN = (D / 64) * (INW / 32), I_OUT = (D / 64) * (D / 32), I_Q = (D / 64) * (QW / 32);
        for (int it = gw; it < I_IN + I_OUT + I_Q; it += NGW) {
            int r = it;
            if (r < I_IN) { p0_transpose_item(w_in, D, INW, WIN, 0, scr, r, lane); continue; } r -= I_IN;
            if (r < I_OUT) { p0_transpose_item(w_out, D, D, WOUT, 0, scr, r, lane); continue; } r -= I_OUT;
            p0_transpose_item(w_query, D, QW, WQ, 0, scr, r, lane);
        }
    }
    SEAM(0);
    if (IN(1) && !(MK_SKIP & (1 << 1))) { for (int m = gw; m < T; m += NGW) norm_row(x + (size_t)m * D, norm1_g, MOD + (m / SEQ) * MODW, 0, D, XN + (size_t)m * D, lane); }
    SEAM(1);
    if (IN(2) && !(MK_SKIP & (1 << 2))) {
        pg8::Gemm g{XN, WIN, T, INW, D}; pg8::StaticOrder S; S.init(T, INW, G, bx);
        pg8::EpiBf16<0> E{Z, INW, nullptr, 0, 0, 1.f};
        pg8::gemm_phase<pg8::EpiBf16<0>, pg8::StaticOrder, true, true>(L + RING_OFF, g, S, E);
    }
    SEAM(2);
    if (IN(3) && !(MK_SKIP & (1 << 3))) {
        constexpr int NCHAIN = BATCH * NH * 2;
        if (bx < NCHAIN) {
            scan::chain(L, Z, mu_prev, mu_next, w_decay0, w_decay_up, a_gate0, a_gate_up, k_k, k_a, r_k, Y, BON, bx, tid, wave, lane);
        } else {
            const int wid = (bx - NCHAIN) * NWAVES + wave, nworkers = (G - NCHAIN) * NWAVES;
            LAS unsigned char* vt = L + wave * attn::WAVE_LDS;
            for (int u = wid; u < BATCH * NH * 96; u += nworkers) {
                const int x = u & 31, p = (u >> 5) % 3, bh = u / 96;
                const int d = (p == 0) ? 1 : (p == 1 ? 4 : 16), nb = 32 / d, r = x / nb, qb = x % nb;
                bf16* Ob = (p == 0) ? MIX : (p == 1 ? MIX + AW : O3); const int opitch = (p == 2) ? AW : D;
                attn::unit(vt, Z, q_norm_g, k_norm_g, Ob, opitch, LSE + (size_t)p * T * NH, bh >> 3, bh & 7, d, r, qb, nb, lane);
            }
        }
    }
    SEAM(3);
    if (IN(4) && !(MK_SKIP & (1 << 4))) { fin::phase(L, Z, mu_prev, mu_next, g_up, Y, BON, k_a, r_k, lnx_g, lnx_b, MIX, O3, LSE, bx, G, tid, wave, lane); }
    SEAM(4);
    if (IN(5) && !(MK_SKIP & (1 << 5))) {
        pg8::Gemm g{MIX, WOUT, T, D, D}; pg8::StaticOrder S; S.init(T, D, G, bx);
        EpiRes E{x, MOD, 2 * D, out, D};
        pg8::gemm_phase<EpiRes, pg8::StaticOrder, true, true>(L + RING_OFF, g, S, E);
    }
    SEAM(5);
    if (IN(6) && !(MK_SKIP & (1 << 6))) { for (int m = gw; m < T; m += NGW) norm_row(out + (size_t)m * D, norm2_g, MOD + (m / SEQ) * MODW, 3 * D, 4 * D, XN + (size_t)m * D, lane);
        const size_t gtid = (size_t)bx * NWAVES * 64 + tid, gthreads = (size_t)G * NWAVES * 64;
        peer::convert_table(peer_u, UT, (size_t)NKEYS * NKEYS * D / 8, gtid, gthreads); peer::convert_table(peer_v, VT, (size_t)NKEYS * NKEYS * D / 8, gtid, gthreads); }
    SEAM(6);
    if (IN(7) && !(MK_SKIP & (1 << 7))) {
        pg8::Gemm g{XN, WQ, T, QW, D}; pg8::StaticOrder S; S.init(T, QW, G, bx);
        pg8::EpiBf16<0> E{Q, QW, nullptr, 0, 0, 1.f};
        pg8::gemm_phase<pg8::EpiBf16<0>, pg8::StaticOrder, true, true>(L + RING_OFF, g, S, E);
    }
    SEAM(7);
    if (IN(8) && !(MK_SKIP & (1 << 8))) { __syncthreads(); peer::setup_keys(L, keys1, keys2, tid); __syncthreads();
        for (int bt = gw; bt < T * PH / 16; bt += NGW) peer::select_batch(L, Q, IDX, GATE, bt, lane); }
    SEAM(8);
    {
        const int sl = bx & 7, wv = (bx >> 3) * NWAVES + wave, nwv = (G >> 3) * NWAVES;
        if (IN(9) && !(MK_SKIP & (1 << 9))) { for (int tok = wv; tok < T; tok += nwv) peer::ffn_u_token(XN, IDX, UT, PART, sl, tok, lane); }
        SEAM(9);
        if (IN(10) && !(MK_SKIP & (1 << 10))) {
            for (size_t i = (size_t)bx * NWAVES * 64 + tid; i < (size_t)T * HK; i += (size_t)G * NWAVES * 64) {
                float d = 0.f;
#pragma unroll
                for (int s8 = 0; s8 < 8; ++s8) d += PART[(size_t)s8 * T * HK + i];
                GATE[i] = GATE[i] * peer::gelu_erf(d);
            }
        }
        SEAM(10);
        if (IN(11) && !(MK_SKIP & (1 << 11))) { for (int tok = wv; tok < T; tok += nwv) peer::ffn_v_token(IDX, GATE, VT, MOD, out, sl, tok, lane); }
    }
#undef IN
#undef SEAM
}

extern "C" void kernel_launch(void* const* d_in, const int* in_sizes, int n_in, void* d_out, int out_size, void* d_ws, size_t ws_size, hipStream_t stream) {
    static int grid = 0;
    if (grid == 0) {
        if (n_in != 27 || in_sizes[0] != T * D || out_size != T * D || ws_size < WS_END) { fprintf(stderr, "kernel_launch: unexpected problem (n_in %d, in0 %d, out %d, ws %zu); nothing launched\n", n_in, n_in > 0 ? in_sizes[0] : -1, out_size, ws_size); grid = -1; return; }
        int dev = 0, cus = 0, per_cu = 0;
        if (hipGetDevice(&dev) != hipSuccess || hipDeviceGetAttribute(&cus, hipDeviceAttributeMultiprocessorCount, dev) != hipSuccess) { fprintf(stderr, "kernel_launch: device query failed\n"); grid = -1; return; }
        if (hipFuncSetAttribute((const void*)mk_fwd, hipFuncAttributeMaxDynamicSharedMemorySize, LDS_BYTES) != hipSuccess) { fprintf(stderr, "kernel_launch: hipFuncSetAttribute failed\n"); grid = -1; return; }
        if (hipOccupancyMaxActiveBlocksPerMultiprocessor(&per_cu, (const void*)mk_fwd, NWAVES * 64, LDS_BYTES) != hipSuccess || per_cu < 1)
            fprintf(stderr, "kernel_launch: note: occupancy query reports %d workgroups per CU\n", per_cu);
        (void)hipGetLastError();
        grid = cus;
    }
    if (grid < 0) return;
    if (hipMemsetAsync((char*)d_ws + WS_CTL, 0, CTL_ZERO_BYTES, stream) != hipSuccess) { fprintf(stderr, "kernel_launch: hipMemsetAsync failed\n"); return; }
    Args a{};
    for (int i = 0; i < 27; ++i) a.in[i] = (const float*)d_in[i];
    a.out = (float*)d_out; a.ws = (unsigned char*)d_ws;
#ifndef MK_RANGES
#define MK_RANGES {{0, N_PHASES}}
#endif
    static const int ranges[][2] = MK_RANGES;
    const int nl = (int)(sizeof(ranges) / sizeof(ranges[0]));
    for (int li = 0; li < nl; ++li) {
        a.ph_lo = ranges[li][0]; a.ph_hi = ranges[li][1]; a.li = li;
        hipLaunchKernelGGL(mk_fwd, dim3(grid), dim3(NWAVES * 64), LDS_BYTES, stream, a);
        const hipError_t le = hipPeekAtLastError();
        if (le != hipSuccess) { fprintf(stderr, "kernel_launch: launch %d failed: %s\n", li, hipGetErrorName(le)); break; }
    }
}
```

```cpp
#include <hip/hip_runtime.h>
#include <cstdio>
#include <cstdint>
#include <cmath>
namespace pg8 {
#define PG8_LAS __attribute__((address_space(3)))
typedef unsigned short bf16_t;
typedef short bf16x8 __attribute__((ext_vector_type(8)));
typedef float f32x4 __attribute__((ext_vector_type(4)));
typedef unsigned u32x4 __attribute__((ext_vector_type(4)));
constexpr int BM = 256, BK = 64, HALF = 128, HTB = HALF * BK * 2  , STAGE_BYTES = 8 * HTB, NXCD = 8, WGM = 8;

__host__ __device__ __forceinline__ int lds_byte(int r, int c) { const int st = (r >> 4) * 2 + (c >> 5), rr = r & 15, cc = c & 31, ob = rr * 64 + cc * 2; return st * 1024 + (ob ^ (((ob >> 9) & 1) << 5)); }
__host__ __device__ __forceinline__ void stage_rc(int b, int& R, int& C) { const int st = b / 1024, sb = b % 1024, swz = sb ^ (((sb >> 9) & 1) << 5); R = (st >> 1) * 16 + swz / 64; C = (st & 1) * 32 + (swz % 64) / 2; }
__host__ __device__ __forceinline__ int perm32(int rho) { const int n = rho >> 4, i = rho & 15; return 8 * (i >> 2) + 4 * n + (i & 3); }

struct Unit { int pm, pn; };
struct Gemm { const bf16_t* A; const bf16_t* Bt; int M, N, K; };

struct StaticOrder {
    int nM, nN, nwg, G, c;
    __host__ __device__ void init(int M, int N, int G_, int c_) { nM = M / BM; nN = N / BM; nwg = nM * nN; G = G_; c = c_; }
    __host__ __device__ bool next(int i, Unit& u) const {
        const long L = (long)i * G + c; if (L >= nwg) return false;
        int wgid = (int)L; { const int q = nwg / NXCD, r = nwg % NXCD, xcd = wgid % NXCD, off = wgid / NXCD; wgid = (xcd < r ? xcd * (q + 1) : r * (q + 1) + (xcd - r) * q) + off; }
        const int nig = WGM * nN, gid = wgid / nig, fm = gid * WGM, gsz = (nM - fm) < WGM ? (nM - fm) : WGM;
        u.pm = fm + ((wgid % nig) % gsz); u.pn = (wgid % nig) / gsz; return true;
    }
    __device__ __forceinline__ void a_ready(const Unit&) const {}
    __device__ __forceinline__ void done(const Unit&) const {}
};

__device__ __forceinline__ unsigned cvt_pk_bf16(float lo, float hi) { unsigned r; asm volatile("v_cvt_pk_bf16_f32 %0, %1, %2" : "=v"(r) : "v"(lo), "v"(hi)); return r; }
typedef float f32x2 __attribute__((ext_vector_type(2)));
__device__ __forceinline__ f32x2 gelu_pk(f32x2 v) {
    const f32x2 av = __builtin_elementwise_abs(v), d = av * 0.2316418882f + 1.0f;
    f32x2 t; t.x = __builtin_amdgcn_rcpf(d.x); t.y = __builtin_amdgcn_rcpf(d.y);
    f32x2 q = t * 0.5307027145f + (-0.7265760135f); q = q * t + 0.7107068705f; q = q * t + (-0.142248368f); q = q * t + 0.127414796f; q = q * t;
    const f32x2 s = (v * v) * (-0.72134752044f);
    f32x2 e; e.x = __builtin_amdgcn_exp2f(s.x); e.y = __builtin_amdgcn_exp2f(s.y);
    const f32x2 m = v * (q * e), r = v - m;
    f32x2 o; o.x = v.x < 0.f ? m.x : r.x; o.y = v.y < 0.f ? m.y : r.y; return o;
}

template <int ACT  > struct EpiBf16 {
    static constexpr bool PERM = true, AFTER_DRAIN = false; static_assert(ACT == 0 || ACT == 1, "EpiBf16: ACT is 0 (none) or 1 (gelu_pk)");
    bf16_t* O; int ldc; const float* bias; int split_cols; size_t split_stride; float scale0;
    __device__ __forceinline__ void operator()(const f32x4 (&acc)[2][2][4][2], const Unit& u, int wr, int wc, int fr, int fq) const {
        const int row0 = u.pm * BM + wr * 64 + fr; int colt = u.pn * BM; bf16_t* base = O;
        float sc = 1.f; if (split_cols) { const int t = colt / split_cols; base += (size_t)t * split_stride; colt -= t * split_cols; if (t == 0) sc = scale0; }
        const int col0 = colt + wc * 32 + 8 * fq, bcol0 = u.pn * BM + wc * 32 + 8 * fq;
        f32x4 bv[2][2];
#pragma unroll
        for (int bj = 0; bj < 2; ++bj)
#pragma unroll
            for (int n = 0; n < 2; ++n) bv[bj][n] = bias ? *(const f32x4*)(bias + bcol0 + bj * HALF + 4 * n) : (f32x4){0.f, 0.f, 0.f, 0.f};
#pragma unroll
        for (int ai = 0; ai < 2; ++ai)
#pragma unroll
            for (int m = 0; m < 4; ++m) { bf16_t* rowp = base + (size_t)(row0 + ai * HALF + m * 16) * ldc + col0;
#pragma unroll
                for (int bj = 0; bj < 2; ++bj) { f32x4 v0 = acc[ai][bj][m][0] + bv[bj][0], v1 = acc[ai][bj][m][1] + bv[bj][1];
                    if (ACT == 1) { f32x2 a = gelu_pk((f32x2){v0[0], v0[1]}), b = gelu_pk((f32x2){v0[2], v0[3]}), c = gelu_pk((f32x2){v1[0], v1[1]}), d = gelu_pk((f32x2){v1[2], v1[3]});
                        v0 = (f32x4){a.x, a.y, b.x, b.y}; v1 = (f32x4){c.x, c.y, d.x, d.y}; }
                    v0 = v0 * sc; v1 = v1 * sc; u32x4 w; w.x = cvt_pk_bf16(v0[0], v0[1]); w.y = cvt_pk_bf16(v0[2], v0[3]); w.z = cvt_pk_bf16(v1[0], v1[1]); w.w = cvt_pk_bf16(v1[2], v1[3]);
                    *(u32x4*)(rowp + bj * HALF) = w; } }
    }
};

template <class Epi, class Sched, bool ALIGN_EPI = false, bool SP2 = false>
__device__ __forceinline__ void gemm_phase(PG8_LAS unsigned char* lds, const Gemm g, const Sched& S, const Epi& E) {
    const int tid = threadIdx.x, wid = __builtin_amdgcn_readfirstlane(tid >> 6), lane = tid & 63, wr = wid >> 2, wc = wid & 3, fr = lane & 15, fq = lane >> 4;
    const int K = g.K, nt = K / BK;
    unsigned voffA[2], voffB[2];
#pragma unroll
    for (int i = 0; i < 2; ++i) { int R, C; stage_rc(tid * 16 + i * 8192, R, C); const int Rb = Epi::PERM ? ((R & ~31) + perm32(R & 31)) : R;
        voffA[i] = (unsigned)(R * K + C) * 2u; voffB[i] = (unsigned)(Rb * K + C) * 2u; }
    const size_t kstep = (size_t)(BK * 2);
    const size_t hstep = (size_t)HALF * K * 2;
    const size_t tstep = 2 * hstep;
    const unsigned ldsw = (unsigned)wid * 1024u;
    const int aoff = lds_byte(wr * 64 + fr, fq * 8), boff = lds_byte(wc * 32 + fr, fq * 8);
#define PG8_SA(b, h) (((b) * 2 + (h)) * HTB)
#define PG8_SB(b, h) ((4 + (b) * 2 + (h)) * HTB)
#define PG8_STAGE(bufoff, gbase, voff) do { _Pragma("unroll") for (int _i = 0; _i < 2; ++_i) \
        __builtin_amdgcn_global_load_lds((const unsigned*)((const char*)(gbase) + (voff)[_i]), (PG8_LAS unsigned*)(lds + (bufoff) + ldsw + _i * 8192), 16, 0, 0); } while (0)
#define PG8_LDA(dst, b, h) do { _Pragma("unroll") for (int m = 0; m < 4; ++m) _Pragma("unroll") for (int k = 0; k < 2; ++k) dst[m][k] = *(const PG8_LAS bf16x8*)(lds + PG8_SA(b, h) + aoff + m * 2048 + k * 1024); } while (0)
#define PG8_LDB(dst, b, h) do { _Pragma("unroll") for (int n = 0; n < 2; ++n) _Pragma("unroll") for (int k = 0; k < 2; ++k) dst[n][k] = *(const PG8_LAS bf16x8*)(lds + PG8_SB(b, h) + boff + n * 2048 + k * 1024); } while (0)
#define PG8_MMA(ai, bj, At, Bt) do { __builtin_amdgcn_s_setprio(1); _Pragma("unroll") for (int m = 0; m < 4; ++m) _Pragma("unroll") for (int n = 0; n < 2; ++n) _Pragma("unroll") for (int k = 0; k < 2; ++k) \
        acc[ai][bj][m][n] = __builtin_amdgcn_mfma_f32_16x16x32_bf16(Bt[n][k], At[m][k], acc[ai][bj][m][n], 0, 0, 0); __builtin_amdgcn_s_setprio(0); } while (0)
#define PG8_WAIT_V(n) asm volatile("s_waitcnt vmcnt(" #n ")" ::: "memory")
#define PG8_WAIT_L(n) asm volatile("s_waitcnt lgkmcnt(" #n ")" ::: "memory")
#define PG8_BAR __builtin_amdgcn_s_barrier()
#define PG8_SCHED __builtin_amdgcn_sched_barrier(0)
    Unit cur, nxt; int ui = 0;
    if (!S.next(0, cur)) return;
    f32x4 acc[2][2][4][2];
#pragma unroll
    for (int a = 0; a < 2; ++a)
#pragma unroll
        for (int b = 0; b < 2; ++b)
#pragma unroll
            for (int m = 0; m < 4; ++m)
#pragma unroll
                for (int n = 0; n < 2; ++n) acc[a][b][m][n] = (f32x4){0.f, 0.f, 0.f, 0.f};
    bf16x8 At[4][2], B0[2][2], B1[2][2];
    const char* cA = (const char*)g.A + (size_t)cur.pm * tstep; const char* cB = (const char*)g.Bt + (size_t)cur.pn * tstep;
    S.a_ready(cur);
    if constexpr (SP2) {
        PG8_STAGE(PG8_SB(0, 0), cB, voffB); PG8_STAGE(PG8_SB(0, 1), cB + hstep, voffB); PG8_STAGE(PG8_SA(0, 0), cA, voffA); PG8_STAGE(PG8_SA(0, 1), cA + hstep, voffA);
        if (wr == 1) PG8_BAR;
        PG8_WAIT_V(2); PG8_BAR;
        PG8_STAGE(PG8_SB(1, 0), cB + kstep, voffB); PG8_STAGE(PG8_SA(1, 0), cA + kstep, voffA); PG8_STAGE(PG8_SB(1, 1), cB + hstep + kstep, voffB);
        PG8_WAIT_V(6); PG8_BAR;
    } else {
        PG8_STAGE(PG8_SB(0, 0), cB, voffB); PG8_STAGE(PG8_SA(0, 0), cA, voffA); PG8_STAGE(PG8_SB(0, 1), cB + hstep, voffB); PG8_STAGE(PG8_SA(0, 1), cA + hstep, voffA);
        if (wr == 1) PG8_BAR;
        PG8_WAIT_V(4); PG8_BAR;
        PG8_STAGE(PG8_SB(1, 0), cB + kstep, voffB); PG8_STAGE(PG8_SA(1, 0), cA + kstep, voffA); PG8_STAGE(PG8_SB(1, 1), cB + hstep + kstep, voffB);
        PG8_WAIT_V(6); PG8_BAR;
    }
    for (;;) {
        const bool has_next = S.next(ui + 1, nxt);
        const char* nA = has_next ? (const char*)g.A + (size_t)nxt.pm * tstep : cA; const char* nB = has_next ? (const char*)g.Bt + (size_t)nxt.pn * tstep : cB;
        for (int t = 0; t < nt; t += 2) {
            const bool last = (t == nt - 2);
            const char* a1 = cA + (size_t)(t + 1) * kstep;
            const char* a2 = last ? nA : cA + (size_t)(t + 2) * kstep; const char* b2 = last ? nB : cB + (size_t)(t + 2) * kstep;
            const char* a3 = a2 + kstep; const char* b3 = b2 + kstep;
            if (last && has_next) S.a_ready(nxt);
            if constexpr (SP2) {
            PG8_LDB(B0, 0, 0); PG8_LDB(B1, 0, 1); PG8_SCHED; PG8_LDA(At, 0, 0); PG8_STAGE(PG8_SA(1, 1), a1 + hstep, voffA);
            PG8_WAIT_V(8); PG8_WAIT_L(0); PG8_BAR; PG8_MMA(0, 0, At, B0); PG8_MMA(0, 1, At, B1); PG8_BAR; PG8_SCHED;
            PG8_LDA(At, 0, 1); PG8_STAGE(PG8_SB(0, 0), b2, voffB); PG8_STAGE(PG8_SB(0, 1), b2 + hstep, voffB); PG8_STAGE(PG8_SA(0, 0), a2, voffA);
            PG8_WAIT_V(8); PG8_WAIT_L(0); PG8_BAR; PG8_MMA(1, 0, At, B0); PG8_MMA(1, 1, At, B1); PG8_BAR; PG8_SCHED;
            PG8_LDB(B0, 1, 0); PG8_LDB(B1, 1, 1); PG8_SCHED; PG8_LDA(At, 1, 0); PG8_STAGE(PG8_SA(0, 1), a2 + hstep, voffA);
            PG8_WAIT_V(8); PG8_WAIT_L(0); PG8_BAR; PG8_MMA(0, 0, At, B0); PG8_MMA(0, 1, At, B1); PG8_BAR; PG8_SCHED;
            PG8_LDA(At, 1, 1); PG8_STAGE(PG8_SB(1, 0), b3, voffB); PG8_STAGE(PG8_SB(1, 1), b3 + hstep, voffB); PG8_STAGE(PG8_SA(1, 0), a3, voffA);
            PG8_WAIT_V(8); PG8_WAIT_L(0); PG8_BAR; PG8_MMA(1, 0, At, B0); PG8_MMA(1, 1, At, B1); PG8_BAR; PG8_SCHED;
            } else {
            PG8_LDB(B0, 0, 0); PG8_SCHED; PG8_LDA(At, 0, 0); PG8_STAGE(PG8_SA(1, 1), a1 + hstep, voffA);
            PG8_WAIT_L(8); PG8_BAR; PG8_WAIT_L(0); PG8_MMA(0, 0, At, B0); PG8_BAR; PG8_SCHED;
            PG8_LDB(B1, 0, 1); PG8_STAGE(PG8_SB(0, 0), b2, voffB);
            PG8_BAR; PG8_WAIT_L(0); PG8_MMA(0, 1, At, B1); PG8_BAR;
            PG8_LDA(At, 0, 1); PG8_STAGE(PG8_SA(0, 0), a2, voffA);
            PG8_BAR; PG8_WAIT_L(0); PG8_MMA(1, 0, At, B0); PG8_BAR; PG8_SCHED;
            PG8_STAGE(PG8_SB(0, 1), b2 + hstep, voffB);
            PG8_WAIT_V(6); PG8_BAR; PG8_MMA(1, 1, At, B1); PG8_BAR;
            PG8_LDB(B0, 1, 0); PG8_SCHED; PG8_LDA(At, 1, 0); PG8_STAGE(PG8_SA(0, 1), a2 + hstep, voffA);
            PG8_WAIT_L(8); PG8_BAR; PG8_WAIT_L(0); PG8_MMA(0, 0, At, B0); PG8_BAR; PG8_SCHED;
            PG8_LDB(B1, 1, 1); PG8_STAGE(PG8_SB(1, 0), b3, voffB);
            PG8_BAR; PG8_WAIT_L(0); PG8_MMA(0, 1, At, B1); PG8_BAR;
            PG8_LDA(At, 1, 1); PG8_STAGE(PG8_SA(1, 0), a3, voffA);
            PG8_BAR; PG8_WAIT_L(0); PG8_MMA(1, 0, At, B0); PG8_BAR; PG8_SCHED;
            PG8_STAGE(PG8_SB(1, 1), b3 + hstep, voffB);
            PG8_WAIT_V(6); PG8_BAR; PG8_MMA(1, 1, At, B1); PG8_BAR;
            }
        }
        if constexpr (ALIGN_EPI) { if (wr == 0) PG8_BAR; }
        if constexpr (!Epi::AFTER_DRAIN) { E(acc, cur, wr, wc, fr, fq); S.done(cur); }
        if (!has_next) break;
#pragma unroll
        for (int a = 0; a < 2; ++a)
#pragma unroll
            for (int b = 0; b < 2; ++b)
#pragma unroll
                for (int m = 0; m < 4; ++m)
#pragma unroll
                    for (int n = 0; n < 2; ++n) acc[a][b][m][n] = (f32x4){0.f, 0.f, 0.f, 0.f};
        cur = nxt; cA = nA; cB = nB; ++ui;
        if constexpr (ALIGN_EPI) { if (wr == 1) PG8_BAR; }
    }
    PG8_WAIT_V(0);
    if constexpr (!ALIGN_EPI) { if (wr == 0) PG8_BAR; }
    PG8_BAR;
    if constexpr (Epi::AFTER_DRAIN) { E.fused(acc, cur, wr, wc, fr, fq, lds, wid, lane); S.done(cur); }
#undef PG8_SA
#undef PG8_SB
#undef PG8_STAGE
#undef PG8_LDA
#undef PG8_LDB
#undef PG8_MMA
#undef PG8_WAIT_V
#undef PG8_WAIT_L
#undef PG8_BAR
#undef PG8_SCHED
}
}
#define GAS __attribute__((address_space(1)))
#define LAS __attribute__((address_space(3)))
typedef unsigned short bf16;
typedef unsigned v4u __attribute__((ext_vector_type(4)));
typedef float f32x4 __attribute__((ext_vector_type(4)));
typedef short bf16x8 __attribute__((ext_vector_type(8)));
typedef GAS unsigned gu32;
typedef GAS unsigned long long gu64;
#define RLX_AGENT __ATOMIC_RELAXED, __HIP_MEMORY_SCOPE_AGENT
#define LDS_WAIT() asm volatile("s_waitcnt lgkmcnt(0)" ::: "memory")
#define VM_WAIT() asm volatile("s_waitcnt vmcnt(0)" ::: "memory")
__device__ __forceinline__ unsigned long long rt() { return __builtin_amdgcn_s_memrealtime(); }
__device__ __forceinline__ unsigned f2bf(float f) { unsigned u = __builtin_bit_cast(unsigned, f); return (u + 0x7fffu + ((u >> 16) & 1u)) >> 16; }
__device__ __forceinline__ unsigned pk2(float lo, float hi) { return f2bf(lo) | (f2bf(hi) << 16); }

#define XB_TMO      128
#define XB_XCNT(j)  (256  + 64 * (j))
#define XB_XSUB(j)  (1280 + 64 * (j))
#define XB_XGEN(j)  (2304 + 64 * (j))
#define XB_TOP      3328
#define XB_TOPGEN   3392
#define XCD_BAR_WORDS 3456
#define XB_SPIN_CAP (1u << 18)

__device__ __forceinline__ unsigned xb_ld(unsigned* p)              { return __hip_atomic_load(p, __ATOMIC_RELAXED, __HIP_MEMORY_SCOPE_AGENT); }
__device__ __forceinline__ unsigned xb_add(unsigned* p, unsigned v) { return __hip_atomic_fetch_add(p, v, __ATOMIC_RELAXED, __HIP_MEMORY_SCOPE_AGENT); }
__device__ __forceinline__ unsigned xb_xcc_id() { return (unsigned)__builtin_amdgcn_s_getreg((3 << 11) | 20) & 0xFu; }
#define XB_SPIN(cond, bar) do { unsigned _sp = 0; while (cond) { __builtin_amdgcn_s_sleep(1); \
    if ((++_sp & 255u) == 0u) { if (xb_ld(&(bar)[XB_TMO])) break; if (_sp > XB_SPIN_CAP) { atomicAdd(&(bar)[XB_TMO], 1u); break; } } } } while (0)

struct XcdBarrier {
    unsigned* bar; unsigned x;
    volatile LAS unsigned* st;
};

__device__ __forceinline__ XcdBarrier xcd_barrier_post(unsigned* bar, volatile LAS unsigned* st) {
    XcdBarrier b; b.bar = bar; b.x = xb_xcc_id(); b.st = st;
    if (threadIdx.x == 0) (void)xb_add(&bar[XB_XCNT(b.x)], 1u);
    return b;
}
__device__ __forceinline__ void xcd_barrier_complete(unsigned* bar, unsigned x, unsigned& nloc, unsigned& nx) {
    const unsigned G = gridDim.x * gridDim.y * gridDim.z;
    unsigned sum, cnt, mine, sp = 0u;
    for (;;) {
        sum = 0u; cnt = 0u; mine = 0u;
#pragma unroll
        for (unsigned j = 0; j < 16; ++j) { const unsigned c = xb_ld(&bar[XB_XCNT(j)]); sum += c; cnt += (c > 0u) ? 1u : 0u; mine = (j == x) ? c : mine; }
        if (sum == G) break;
        __builtin_amdgcn_s_sleep(1);
        if ((++sp & 255u) == 0u) { if (xb_ld(&bar[XB_TMO])) break; if (sp > XB_SPIN_CAP) { atomicAdd(&bar[XB_TMO], 1u); break; } }
    }
    nloc = mine > 0u ? mine : 1u; nx = cnt > 0u ? cnt : 1u;
}

__device__ __forceinline__ void xcd_barrier(const XcdBarrier& b) {
    asm volatile("s_waitcnt vmcnt(0)" ::: "memory");
    __syncthreads();
    if (threadIdx.x == 0) {
        unsigned* bar = b.bar;
        __builtin_amdgcn_s_waitcnt(0);
        unsigned nloc = b.st[0], nx = b.st[1];
        if (nloc == 0u) { xcd_barrier_complete(bar, b.x, nloc, nx); b.st[0] = nloc; b.st[1] = nx; }
        const unsigned old = xb_add(&bar[XB_XSUB(b.x)], 1u);
        const unsigned gen = old / nloc;
        if (old + 1u == (gen + 1u) * nloc) {
            __builtin_amdgcn_fence(__ATOMIC_RELEASE, "agent");
            asm volatile("s_waitcnt vmcnt(0)" ::: "memory");
            const unsigned og = xb_add(&bar[XB_TOP], 1u);
            const unsigned tg = og / nx;
            if (og + 1u == (tg + 1u) * nx) xb_add(&bar[XB_TOPGEN], 1u);
            else XB_SPIN(xb_ld(&bar[XB_TOPGEN]) == tg, bar);
            __builtin_amdgcn_fence(__ATOMIC_ACQUIRE, "agent");
            xb_add(&bar[XB_XGEN(b.x)], 1u);
            asm volatile("s_waitcnt vmcnt(0)" ::: "memory");
        } else {
            XB_SPIN(xb_ld(&bar[XB_XGEN(b.x)]) == gen, bar);
            __builtin_amdgcn_fence(__ATOMIC_ACQUIRE, "agent");
            asm volatile("s_waitcnt vmcnt(0)" ::: "memory");
        }
    }
    __syncthreads();
}
constexpr int NWAVES = 8;
constexpr int D = 1024, BATCH = 8, SEQ = 2048, T = BATCH * SEQ;
constexpr int AW = 512, RW = 512, NH = 8;
constexpr int DL = 64, AL = 64, GL = 128;
constexpr int SHIFTW = 3 * RW + DL + AL + GL;
constexpr int INW = 3 * AW + SHIFTW;
constexpr int NKEYS = 128, PH = 8, PKD = 256, TOPK = 16, HK = PH * TOPK;
constexpr int QW = PH * PKD;
constexpr int MODW = 6 * D;

constexpr size_t MiB = 1u << 20;
constexpr size_t WS_CTL = 0, CTL_ZERO_BYTES = 1 * MiB;
constexpr size_t WS_MOD = 1 * MiB;
constexpr size_t WS_KEYS = 1 * MiB + 512 * 1024;
constexpr size_t WS_WIN = 2 * MiB;
constexpr size_t WS_WOUT = 9 * MiB;
constexpr size_t WS_WQ = 11 * MiB;
constexpr size_t WS_XN = 16 * MiB;
constexpr size_t WS_O3 = 16 * MiB;
constexpr size_t WS_LSE = 32 * MiB;
constexpr size_t WS_Z = 48 * MiB;
constexpr size_t WS_MIX = 152 * MiB;
constexpr size_t WS_Y = 184 * MiB;
constexpr size_t WS_Q = 48 * MiB;
constexpr size_t WS_IDX = 112 * MiB;
constexpr size_t WS_GATE = 120 * MiB;
constexpr size_t WS_PART = 48 * MiB;
constexpr size_t WS_UT = 152 * MiB;
constexpr size_t WS_VT = 184 * MiB;
constexpr size_t WS_BON = 248 * MiB;
constexpr size_t WS_END = 249 * MiB;
constexpr int CW_BAR = 4096;
constexpr int MAX_LAUNCHES = 12;

constexpr int RING_OFF = 0, RING_BYTES = 139264;
constexpr int LDSCTL_OFF = RING_BYTES, MISC_OFF = LDSCTL_OFF + 320;
constexpr int LDS_BYTES = 147456;
static_assert(MISC_OFF + 128 <= LDS_BYTES, "LDS map");

typedef GAS float gf32;
typedef GAS f32x4 gf32x4;

__device__ __forceinline__ float bf2f(bf16 v) { return __uint_as_float(((unsigned)v) << 16); }
__device__ __forceinline__ float wave_sum(float v) {
#pragma unroll
    for (int o = 1; o < 64; o <<= 1) v += __shfl_xor(v, o);
    return v;
}
#define WAVE_LDS_SYNC() do { asm volatile("s_waitcnt lgkmcnt(0)" ::: "memory"); __builtin_amdgcn_wave_barrier(); } while (0)

__device__ __forceinline__ void p0_transpose_item(const float* W, int K, int N, bf16* WT, int row_off, LAS float* scr, int item, int lane) {
    const int nblk = N / 32, kb = item / nblk, nb = item % nblk, k0 = 64 * kb, n0 = 32 * nb;
#pragma unroll 8
    for (int i = 0; i < 32; ++i) { const int kk = 2 * i + (lane >> 5); scr[kk * 33 + (lane & 31)] = W[(size_t)(k0 + kk) * N + n0 + (lane & 31)]; }
    LDS_WAIT(); asm volatile("" ::: "memory");
    const int c = lane & 7;
#pragma unroll
    for (int j = 0; j < 4; ++j) { const int n = (lane >> 3) + 8 * j; const LAS float* s = scr + (8 * c) * 33 + n;
        v4u o; o.x = pk2(s[0 * 33], s[1 * 33]); o.y = pk2(s[2 * 33], s[3 * 33]); o.z = pk2(s[4 * 33], s[5 * 33]); o.w = pk2(s[6 * 33], s[7 * 33]);
        *(GAS v4u*)(WT + (size_t)(row_off + n0 + n) * K + k0 + 8 * c) = o; }
    LDS_WAIT(); asm volatile("" ::: "memory");
}

__device__ __forceinline__ void norm_row(const float* xrow, const float* g, const float* modb, int shift_off, int scale_off, bf16* orow, int lane) {
    const GAS f32x4* xr = (const GAS f32x4*)xrow + lane;
    f32x4 v[4]; float s = 0.f;
#pragma unroll
    for (int j = 0; j < 4; ++j) { v[j] = xr[64 * j]; s += (v[j].x * v[j].x + v[j].y * v[j].y) + (v[j].z * v[j].z + v[j].w * v[j].w); }
    const float rs = 1.0f / sqrtf(wave_sum(s) * (1.f / D) + 1e-6f);
    GAS unsigned long long* o8 = (GAS unsigned long long*)orow + lane;
#pragma unroll
    for (int j = 0; j < 4; ++j) {
        const int col = 256 * j + 4 * lane;
        const f32x4 g4 = *(const GAS f32x4*)(g + col), sc = *(const GAS f32x4*)(modb + scale_off + col), sh = *(const GAS f32x4*)(modb + shift_off + col);
        const f32x4 y = v[j] * rs * g4 * (sc + 1.0f) + sh;
        o8[64 * j] = (unsigned long long)pk2(y.x, y.y) | ((unsigned long long)pk2(y.z, y.w) << 32);
    }
}

struct EpiRes {
    static constexpr bool PERM = false, AFTER_DRAIN = false;
    const float* xres; const float* mod; int gate_off; float* out; int ldc;
    __device__ __forceinline__ void operator()(const pg8::f32x4 (&acc)[2][2][4][2], const pg8::Unit& u, int wr, int wc, int fr, int fq) const {
        const int col0 = u.pn * pg8::BM + wc * 32 + 4 * fq;
        const int b = (u.pm * pg8::BM) / SEQ;
        pg8::f32x4 gv[2][2];
#pragma unroll
        for (int bj = 0; bj < 2; ++bj)
#pragma unroll
            for (int n = 0; n < 2; ++n) gv[bj][n] = *(const pg8::f32x4*)(mod + b * MODW + gate_off + col0 + bj * pg8::HALF + n * 16);
#pragma unroll
        for (int ai = 0; ai < 2; ++ai)
#pragma unroll
            for (int m = 0; m < 4; ++m) { const size_t off = (size_t)(u.pm * pg8::BM + ai * pg8::HALF + wr * 64 + m * 16 + fr) * ldc + col0;
#pragma unroll
                for (int bj = 0; bj < 2; ++bj)
#pragma unroll
                    for (int n = 0; n < 2; ++n) { const pg8::f32x4 bs = *(const pg8::f32x4*)(xres + off + bj * pg8::HALF + n * 16);
                        *(pg8::f32x4*)(out + off + bj * pg8::HALF + n * 16) = bs + gv[bj][n] * acc[ai][bj][m][n]; } }
    }
};

namespace scan {
typedef unsigned u32x2 __attribute__((ext_vector_type(2)));
constexpr int SLOT = 1024, BUF_BYTES = 12800, NBUF = 8;
constexpr int OFF_LORA = NBUF * BUF_BYTES;
constexpr int OFF_CONST = OFF_LORA + 16 * SLOT;
constexpr int OFF_MT = OFF_CONST + 4096;
constexpr int SCAN_LDS = OFF_MT + 8 * 1024;
static_assert(SCAN_LDS <= 139264, "scan LDS map");
constexpr int S_KK = 0, S_R = 2, S_MT = 4, S_N = 5, S_BK = 6, S_V = 10, S_GC = 12;

typedef float f32x2n __attribute__((ext_vector_type(2)));
typedef __bf16 bf16x2n __attribute__((ext_vector_type(2)));
__device__ __forceinline__ unsigned cvtpk(float lo, float hi) { const f32x2n v = {lo, hi}; const bf16x2n b = __builtin_convertvector(v, bf16x2n); return __builtin_bit_cast(unsigned, b); }
__device__ __forceinline__ bf16x8 mkfrag(unsigned a, unsigned b, unsigned c, unsigned d) { v4u w; w.x = a; w.y = b; w.z = c; w.w = d; return __builtin_bit_cast(bf16x8, w); }
__device__ __forceinline__ bf16x8 frag8(const float (&lo)[4], const float (&hi)[4]) { return mkfrag(cvtpk(lo[0], lo[1]), cvtpk(lo[2], lo[3]), cvtpk(hi[0], hi[1]), cvtpk(hi[2], hi[3])); }
__device__ __forceinline__ f32x4 mma(bf16x8 a, bf16x8 b, f32x4 c) { return __builtin_amdgcn_mfma_f32_16x16x32_bf16(a, b, c, 0, 0, 0); }
template <int N> __device__ __forceinline__ float row_shr(float x) { return __int_as_float(__builtin_amdgcn_update_dpp(0, __float_as_int(x), 0x110 + N, 0xf, 0xf, true)); }
__device__ __forceinline__ float fsigmoid(float x) { return __builtin_amdgcn_rcpf(1.0f + __expf(-x)); }
__device__ __forceinline__ bf16 tobf(float x) { return (bf16)(cvtpk(x, x) & 0xffffu); }

__device__ __forceinline__ void setup(LAS unsigned char* L, int h, int dir, const float* mu_prev, const float* mu_next, const float* w_decay0, const float* w_decay_up,
                                      const float* a_gate0, const float* a_gate_up, const float* k_k, const float* k_a, const float* r_k, int tid) {
    LAS float* C = (LAS float*)(L + OFF_CONST);
    for (int i = tid; i < 320; i += 512) {
        const int grp = i >> 6, c = i & 63;
        const int col = (grp < 3) ? grp * RW + h * 64 + c : 3 * RW + (grp - 3) * 64 + c;
        C[i] = mu_prev[col]; C[320 + i] = mu_next[col];
    }
    if (tid < 64) { const int hc = h * 64 + tid; C[640 + tid] = w_decay0[dir * RW + hc]; C[704 + tid] = a_gate0[dir * RW + hc]; C[768 + tid] = k_k[hc]; C[832 + tid] = k_a[hc]; C[896 + tid] = r_k[hc]; }
    LAS bf16* F = (LAS bf16*)(L + OFF_LORA);
    for (int i = tid; i < 16 * 64 * 8; i += 512) {
        const int j = i & 7, l = (i >> 3) & 63, sl = i >> 9, m = sl & 1, ct = (sl >> 1) & 3, wa = sl >> 3;
        const int g = l >> 4, jj = 32 * m + (j < 4 ? 4 * g + j : 16 + 4 * g + j - 4), c = h * 64 + 16 * ct + (l & 15);
        const float v = wa ? a_gate_up[(size_t)(dir * AL + jj) * RW + c] : w_decay_up[(size_t)(dir * DL + jj) * RW + c];
        F[i] = (bf16)f2bf(v);
    }
}

__device__ __forceinline__ void helper_chunk(LAS unsigned char* L, LAS unsigned char* buf, LAS float* MT, const bf16* Z, float* BON, int b, int h, int dir, int n, int lane) {
    const int s = lane & 15, g = lane >> 4;
    const int cn = dir ? (SEQ / 16 - 1 - n) : n;
    const int t = cn * 16 + (dir ? 15 - s : s), tok = b * SEQ + t;
    const LAS float* C = (const LAS float*)(L + OFF_CONST);
    const bool hasp = t > 0, hasn = t < SEQ - 1;
    const bf16* zrow = Z + (size_t)tok * INW + 3 * AW;
    float rv[4][4], kv[4][4], vv[4][4], tw[4][4], xa[4][4];
    u32x2 zc[5][4], ze[5][4];
    {
        const int te = (s == 0) ? (dir ? t + 1 : t - 1) : ((s == 15) ? (dir ? t - 1 : t + 1) : t);
        const int tec = te < 0 ? 0 : (te > SEQ - 1 ? SEQ - 1 : te);
        const bf16* erow = Z + (size_t)(b * SEQ + tec) * INW + 3 * AW;
#pragma unroll
        for (int grp = 0; grp < 5; ++grp) {
            const int cbase = (grp < 3) ? grp * RW + h * 64 : 3 * RW + (grp - 3) * 64;
#pragma unroll
            for (int ct = 0; ct < 4; ++ct) { zc[grp][ct] = *(const u32x2*)(zrow + cbase + 16 * ct + 4 * g); ze[grp][ct] = *(const u32x2*)(erow + cbase + 16 * ct + 4 * g); }
        }
    }
    __builtin_amdgcn_sched_barrier(0);
#pragma unroll
    for (int grp = 0; grp < 5; ++grp) {
#pragma unroll
        for (int ct = 0; ct < 4; ++ct) {
            const u32x2 zcc = zc[grp][ct], zee = ze[grp][ct];
            u32x2 lo, up;
            lo.x = (unsigned)__builtin_amdgcn_update_dpp((int)zee.x, (int)zcc.x, 0x111, 0xf, 0xf, false); lo.y = (unsigned)__builtin_amdgcn_update_dpp((int)zee.y, (int)zcc.y, 0x111, 0xf, 0xf, false);
            up.x = (unsigned)__builtin_amdgcn_update_dpp((int)zee.x, (int)zcc.x, 0x101, 0xf, 0xf, false); up.y = (unsigned)__builtin_amdgcn_update_dpp((int)zee.y, (int)zcc.y, 0x101, 0xf, 0xf, false);
            u32x2 zp = dir ? up : lo, zn = dir ? lo : up;
            if (!hasp) { zp.x = 0u; zp.y = 0u; } if (!hasn) { zn.x = 0u; zn.y = 0u; }
            const f32x4 mp = *(const LAS f32x4*)(C + grp * 64 + 16 * ct + 4 * g), mn = *(const LAS f32x4*)(C + 320 + grp * 64 + 16 * ct + 4 * g);
            float zv[4] = {__uint_as_float(zcc.x << 16), __uint_as_float(zcc.x & 0xffff0000u), __uint_as_float(zcc.y << 16), __uint_as_float(zcc.y & 0xffff0000u)};
            float pv[4] = {__uint_as_float(zp.x << 16), __uint_as_float(zp.x & 0xffff0000u), __uint_as_float(zp.y << 16), __uint_as_float(zp.y & 0xffff0000u)};
            float nv[4] = {__uint_as_float(zn.x << 16), __uint_as_float(zn.x & 0xffff0000u), __uint_as_float(zn.y << 16), __uint_as_float(zn.y & 0xffff0000u)};
#pragma unroll
            for (int r = 0; r < 4; ++r) {
                const float o = zv[r] + mp[r] * (pv[r] - zv[r]) + mn[r] * (nv[r] - zv[r]);
                if (grp == 0) rv[ct][r] = o; else if (grp == 1) kv[ct][r] = o; else if (grp == 2) vv[ct][r] = o;
                else if (grp == 3) { const float e2 = __expf(2.0f * o); tw[ct][r] = 1.0f - 2.0f * __builtin_amdgcn_rcpf(e2 + 1.0f); } else xa[ct][r] = o;
            }
        }
    }
#pragma unroll
    for (int ct = 0; ct < 4; ++ct)
#pragma unroll
        for (int r = 0; r < 4; ++r)
            *(LAS bf16*)(buf + (S_V + (ct >> 1)) * SLOT + (4 * g + r + 16 * (s >> 2)) * 16 + (ct & 1) * 8 + 2 * (s & 3)) = tobf(vv[ct][r]);
    f32x4 accw[4], acca[4];
    { const bf16x8 tb0 = frag8(tw[0], tw[1]), tb1 = frag8(tw[2], tw[3]), xb0 = frag8(xa[0], xa[1]), xb1 = frag8(xa[2], xa[3]);
      const LAS bf16x8* F = (const LAS bf16x8*)(L + OFF_LORA);
#pragma unroll
      for (int ct = 0; ct < 4; ++ct) {
          f32x4 z4 = {0.f, 0.f, 0.f, 0.f};
          accw[ct] = mma(F[(0 * 8 + ct * 2 + 0) * 64 + lane], tb0, z4); accw[ct] = mma(F[(0 * 8 + ct * 2 + 1) * 64 + lane], tb1, accw[ct]);
          acca[ct] = mma(F[(1 * 8 + ct * 2 + 0) * 64 + lane], xb0, z4); acca[ct] = mma(F[(1 * 8 + ct * 2 + 1) * 64 + lane], xb1, acca[ct]);
      } }
    float ev[4][4], kk[4][4], kd[4][4], bb[4][4];
    float ss = 0.f, bon = 0.f;
#pragma unroll
    for (int ct = 0; ct < 4; ++ct) {
        const f32x4 w0 = *(const LAS f32x4*)(C + 640 + 16 * ct + 4 * g), a0 = *(const LAS f32x4*)(C + 704 + 16 * ct + 4 * g), kkw = *(const LAS f32x4*)(C + 768 + 16 * ct + 4 * g),
                    kaw = *(const LAS f32x4*)(C + 832 + 16 * ct + 4 * g), rkw = *(const LAS f32x4*)(C + 896 + 16 * ct + 4 * g);
#pragma unroll
        for (int r = 0; r < 4; ++r) {
            ev[ct][r] = 0.60653065971f * fsigmoid(accw[ct][r] + w0[r]);
            const float a = fsigmoid(acca[ct][r] + a0[r]);
            const float k = kv[ct][r];
            kk[ct][r] = k * kkw[r]; ss += kk[ct][r] * kk[ct][r];
            kd[ct][r] = k * (1.0f + (a - 1.0f) * kaw[r]);
            bb[ct][r] = a;
            bon += rv[ct][r] * k * a * kaw[r] * rkw[r];
        }
    }
    ss += __shfl_xor(ss, 16); ss += __shfl_xor(ss, 32);
    bon += __shfl_xor(bon, 16); bon += __shfl_xor(bon, 32);
    if (g == 0) BON[((size_t)dir * T + tok) * NH + h] = bon;
    const float rn = __builtin_amdgcn_rsqf(fmaxf(ss, 1e-12f));
    float KKs[4][4], Rs[4][4], Bt[4][4], Kt[4][4];
#pragma unroll
    for (int ct = 0; ct < 4; ++ct) {
        float gcv[4];
#pragma unroll
        for (int r = 0; r < 4; ++r) {
            const float e = ev[ct][r];
            float cum = e;
            cum += row_shr<1>(cum); cum += row_shr<2>(cum); cum += row_shr<4>(cum); cum += row_shr<8>(cum);
            const float cumC = __shfl(cum, (lane & 48) | 15);
            const float kkn = kk[ct][r] * rn, bv = kkn * bb[ct][r];
            const float ig = __expf(cum), rat = __expf(cum - cumC);
            KKs[ct][r] = kkn * __expf(e - cum); Rs[ct][r] = rv[ct][r] * __expf(-cum);
            Bt[ct][r] = bv * ig; Kt[ct][r] = kd[ct][r] * ig;
            gcv[r] = __expf(-cumC);
            LAS unsigned char* q = buf + (S_BK + ct) * SLOT + (4 * g + r + 16 * (s >> 2)) * 16 + 2 * (s & 3);
            *(LAS bf16*)q = tobf(bv * rat); *(LAS bf16*)(q + 8) = tobf(kd[ct][r] * rat);
        }
        if (s == 15) *(LAS f32x4*)(buf + S_GC * SLOT + (16 * ct + 4 * g) * 4) = (f32x4){gcv[0], gcv[1], gcv[2], gcv[3]};
    }
    const bf16x8 fKK0 = frag8(KKs[0], KKs[1]), fKK1 = frag8(KKs[2], KKs[3]), fR0 = frag8(Rs[0], Rs[1]), fR1 = frag8(Rs[2], Rs[3]);
    const bf16x8 fB0 = frag8(Bt[0], Bt[1]), fB1 = frag8(Bt[2], Bt[3]), fK0 = frag8(Kt[0], Kt[1]), fK1 = frag8(Kt[2], Kt[3]);
    *(LAS bf16x8*)(buf + (S_KK + 0) * SLOT + lane * 16) = fKK0; *(LAS bf16x8*)(buf + (S_KK + 1) * SLOT + lane * 16) = fKK1;
    *(LAS bf16x8*)(buf + (S_R + 0) * SLOT + lane * 16) = fR0;  *(LAS bf16x8*)(buf + (S_R + 1) * SLOT + lane * 16) = fR1;
    const f32x4 z4 = {0.f, 0.f, 0.f, 0.f};
    { f32x4 mab = mma(fKK0, fB0, z4); mab = mma(fKK1, fB1, mab);
      *(LAS f32x4*)(MT + s * 16 + 4 * g) = mab; }
    f32x4 mak = mma(fK0, fKK0, z4); mak = mma(fK1, fKK1, mak);
    f32x4 nrb = mma(fB0, fR0, z4); nrb = mma(fB1, fR1, nrb);
    f32x4 nrk = mma(fK0, fR0, z4); nrk = mma(fK1, fR1, nrk);
#pragma unroll
    for (int r = 0; r < 4; ++r) { const int i = 4 * g + r; if (!(i < s)) mak[r] = 0.f; if (!(i <= s)) { nrb[r] = 0.f; nrk[r] = 0.f; } }
    *(LAS v4u*)(buf + S_N * SLOT + lane * 16) = (v4u){cvtpk(nrb[0], nrb[1]), cvtpk(nrb[2], nrb[3]), cvtpk(nrk[0], nrk[1]), cvtpk(nrk[2], nrk[3])};
    asm volatile("s_waitcnt lgkmcnt(0)" ::: "memory"); __builtin_amdgcn_wave_barrier();
    float Tr[16];
#pragma unroll
    for (int j = 15; j >= 0; --j) {
        float acc = 0.f;
#pragma unroll
        for (int i = j + 1; i < 16; ++i) acc += Tr[i] * MT[j * 16 + i];
        Tr[j] = (j == s) ? 1.0f : -acc;
        if (j > s) Tr[j] = 0.f;
    }
    float t0 = 0.f, t1 = 0.f, t2 = 0.f, t3 = 0.f;
#pragma unroll
    for (int gg = 0; gg < 4; ++gg) if (g == gg) { t0 = Tr[4 * gg]; t1 = Tr[4 * gg + 1]; t2 = Tr[4 * gg + 2]; t3 = Tr[4 * gg + 3]; }
    *(LAS v4u*)(buf + S_MT * SLOT + lane * 16) = (v4u){cvtpk(mak[0], mak[1]), cvtpk(mak[2], mak[3]), cvtpk(-t0, -t1), cvtpk(-t2, -t3)};
    asm volatile("s_waitcnt lgkmcnt(0)" ::: "memory"); __builtin_amdgcn_wave_barrier();
}

__device__ __forceinline__ void rec_chunk(const LAS unsigned char* buf, f32x4 (&st)[4], float* Y, int b, int h, int dir, int n, int w, int lane) {
    const int g = lane >> 4, col = lane & 15;
    const bf16x8 fKK0 = *(const LAS bf16x8*)(buf + (S_KK + 0) * SLOT + lane * 16), fKK1 = *(const LAS bf16x8*)(buf + (S_KK + 1) * SLOT + lane * 16);
    const bf16x8 fR0 = *(const LAS bf16x8*)(buf + (S_R + 0) * SLOT + lane * 16), fR1 = *(const LAS bf16x8*)(buf + (S_R + 1) * SLOT + lane * 16);
    const v4u mt = *(const LAS v4u*)(buf + S_MT * SLOT + lane * 16);
    const bf16x8 fN = *(const LAS bf16x8*)(buf + S_N * SLOT + lane * 16);
    const u32x2 vf = *(const LAS u32x2*)(buf + (S_V + (w >> 1)) * SLOT + lane * 16 + (w & 1) * 8);
    const f32x4 z4 = {0.f, 0.f, 0.f, 0.f};
    const bf16x8 sb0 = mkfrag(cvtpk(st[0][0], st[0][1]), cvtpk(st[0][2], st[0][3]), cvtpk(st[1][0], st[1][1]), cvtpk(st[1][2], st[1][3]));
    const bf16x8 sb1 = mkfrag(cvtpk(st[2][0], st[2][1]), cvtpk(st[2][2], st[2][3]), cvtpk(st[3][0], st[3][1]), cvtpk(st[3][2], st[3][3]));
    f32x4 p1 = mma(fKK0, sb0, z4); p1 = mma(fKK1, sb1, p1);
    f32x4 p2 = mma(fR0, sb0, z4); p2 = mma(fR1, sb1, p2);
    const f32x4 x = mma(mkfrag(0u, 0u, mt.x, mt.y), mkfrag(0u, 0u, vf.x, vf.y), p1);
    const f32x4 u = mma(mkfrag(mt.z, mt.w, 0u, 0u), mkfrag(cvtpk(x[0], x[1]), cvtpk(x[2], x[3]), 0u, 0u), z4);
    const bf16x8 buv = mkfrag(cvtpk(u[0], u[1]), cvtpk(u[2], u[3]), vf.x, vf.y);
    const f32x4 y = mma(fN, buv, p2);
#pragma unroll
    for (int i = 0; i < 4; ++i) {
        const f32x4 gc = *(const LAS f32x4*)(buf + S_GC * SLOT + (16 * i + 4 * g) * 4);
        const bf16x8 fBK = *(const LAS bf16x8*)(buf + (S_BK + i) * SLOT + lane * 16);
        st[i] = mma(fBK, buv, st[i] * gc);
    }
    const int cn = dir ? (SEQ / 16 - 1 - n) : n;
#pragma unroll
    for (int r = 0; r < 4; ++r) { const int s = 4 * g + r, t = cn * 16 + (dir ? 15 - s : s);
        Y[((size_t)dir * T + (size_t)(b * SEQ + t)) * RW + h * 64 + 16 * w + col] = y[r]; }
}

__device__ __forceinline__ void chain(LAS unsigned char* L, const bf16* Z, const float* mu_prev, const float* mu_next, const float* w_decay0, const float* w_decay_up,
                                      const float* a_gate0, const float* a_gate_up, const float* k_k, const float* k_a, const float* r_k, float* Y, float* BON, int ch, int tid, int wave, int lane) {
    const int dir = ch & 1, h = (ch >> 1) & 7, b = ch >> 4;
    __syncthreads();
    setup(L, h, dir, mu_prev, mu_next, w_decay0, w_decay_up, a_gate0, a_gate_up, k_k, k_a, r_k, tid);
    __syncthreads();
    f32x4 st[4];
#pragma unroll
    for (int i = 0; i < 4; ++i) st[i] = (f32x4){0.f, 0.f, 0.f, 0.f};
    constexpr int NCH = SEQ / 16, NR = NCH / 8;
    for (int q = 0; q < NR; ++q) {
        helper_chunk(L, L + wave * BUF_BYTES, (LAS float*)(L + OFF_MT + wave * 1024), Z, BON, b, h, dir, 8 * q + wave, lane);
        __syncthreads();
        if (wave < 4) {
#pragma unroll 1
            for (int i = 0; i < 8; ++i) rec_chunk(L + i * BUF_BYTES, st, Y, b, h, dir, 8 * q + i, wave, lane);
        }
        __syncthreads();
    }
}
}

namespace attn {
typedef unsigned u32x2 __attribute__((ext_vector_type(2)));
constexpr int VT_STRIDE = 136;
constexpr int KF_OFF = 64 * VT_STRIDE;
constexpr int WAVE_LDS = KF_OFF + 8 * 1024;
constexpr float LOG2E = 1.44269504088896f, LN2 = 0.693147180559945f;
using scan::cvtpk; using scan::mkfrag; using scan::mma;

__device__ __forceinline__ void unpack8(const v4u w, float (&f)[8]) {
    f[0] = __uint_as_float(w.x << 16); f[1] = __uint_as_float(w.x & 0xffff0000u); f[2] = __uint_as_float(w.y << 16); f[3] = __uint_as_float(w.y & 0xffff0000u);
    f[4] = __uint_as_float(w.z << 16); f[5] = __uint_as_float(w.z & 0xffff0000u); f[6] = __uint_as_float(w.w << 16); f[7] = __uint_as_float(w.w & 0xffff0000u);
}

__device__ __forceinline__ void unit(LAS unsigned char* vt, const bf16* Z, const float* qg, const float* kg, bf16* Ob, int opitch, float* lse_out,
                                     int b, int h, int d, int r, int qb, int nb, int lane) {
    const int g = lane >> 4, c16 = lane & 15;
    const float slope2 = exp2f(-(float)(h + 1)) * LOG2E * (float)d;
    float gn[16];
#pragma unroll
    for (int m = 0; m < 2; ++m)
#pragma unroll
        for (int j = 0; j < 8; ++j) gn[m * 8 + j] = qg[32 * m + 8 * g + j] * kg[32 * m + 8 * g + j];
    bf16x8 qf[4][2];
#pragma unroll
    for (int qt = 0; qt < 4; ++qt) {
        const int tok = b * SEQ + (qb * 64 + 16 * qt + c16) * d + r;
        const bf16* qp = Z + (size_t)tok * INW + h * 64 + 8 * g;
        float f0[8], f1[8]; unpack8(*(const v4u*)qp, f0); unpack8(*(const v4u*)(qp + 32), f1);
        float ss = 0.f;
#pragma unroll
        for (int j = 0; j < 8; ++j) ss += f0[j] * f0[j] + f1[j] * f1[j];
        ss += __shfl_xor(ss, 16); ss += __shfl_xor(ss, 32);
        const float rs = (0.125f * LOG2E) / sqrtf(ss * (1.f / 64.f) + 1e-6f);
        qf[qt][0] = mkfrag(cvtpk(f0[0] * rs * gn[0], f0[1] * rs * gn[1]), cvtpk(f0[2] * rs * gn[2], f0[3] * rs * gn[3]), cvtpk(f0[4] * rs * gn[4], f0[5] * rs * gn[5]), cvtpk(f0[6] * rs * gn[6], f0[7] * rs * gn[7]));
        qf[qt][1] = mkfrag(cvtpk(f1[0] * rs * gn[8], f1[1] * rs * gn[9]), cvtpk(f1[2] * rs * gn[10], f1[3] * rs * gn[11]), cvtpk(f1[4] * rs * gn[12], f1[5] * rs * gn[13]), cvtpk(f1[6] * rs * gn[14], f1[7] * rs * gn[15]));
    }
    f32x4 oacc[4][4];
    float mrun[4], lrun[4];
#pragma unroll
    for (int qt = 0; qt < 4; ++qt) { mrun[qt] = -1e30f; lrun[qt] = 0.f;
#pragma unroll
        for (int dt = 0; dt < 4; ++dt) oacc[dt][qt] = (f32x4){0.f, 0.f, 0.f, 0.f}; }
    const f32x4 z4 = {0.f, 0.f, 0.f, 0.f};
#pragma unroll 1
    for (int kb = qb - 1; kb <= qb + 1; ++kb) {
        if (kb < 0 || kb >= nb) continue;
#pragma unroll
        for (int kblk = 0; kblk < 4; ++kblk) {
            const int tok = b * SEQ + (kb * 64 + 16 * kblk + c16) * d + r;
            const bf16* kp = Z + (size_t)tok * INW + AW + h * 64 + 8 * g;
            float f0[8], f1[8]; unpack8(*(const v4u*)kp, f0); unpack8(*(const v4u*)(kp + 32), f1);
            float ss = 0.f;
#pragma unroll
            for (int j = 0; j < 8; ++j) ss += f0[j] * f0[j] + f1[j] * f1[j];
            ss += __shfl_xor(ss, 16); ss += __shfl_xor(ss, 32);
            const float rsk = 1.0f / sqrtf(ss * (1.f / 64.f) + 1e-6f);
            *(LAS v4u*)(vt + KF_OFF + (kblk * 2 + 0) * 1024 + lane * 16) = (v4u){cvtpk(f0[0] * rsk, f0[1] * rsk), cvtpk(f0[2] * rsk, f0[3] * rsk), cvtpk(f0[4] * rsk, f0[5] * rsk), cvtpk(f0[6] * rsk, f0[7] * rsk)};
            *(LAS v4u*)(vt + KF_OFF + (kblk * 2 + 1) * 1024 + lane * 16) = (v4u){cvtpk(f1[0] * rsk, f1[1] * rsk), cvtpk(f1[2] * rsk, f1[3] * rsk), cvtpk(f1[4] * rsk, f1[5] * rsk), cvtpk(f1[6] * rsk, f1[7] * rsk)};
        }
#pragma unroll
        for (int i = 0; i < 8; ++i) {
            const int key = 8 * i + (lane >> 3), chunk = lane & 7;
            const int tok = b * SEQ + (kb * 64 + key) * d + r;
            const v4u w = *(const v4u*)(Z + (size_t)tok * INW + 2 * AW + h * 64 + 8 * chunk);
            LAS unsigned char* q = vt + (8 * chunk) * VT_STRIDE + 2 * key;
            *(LAS bf16*)(q + 0 * VT_STRIDE) = (bf16)(w.x & 0xffffu); *(LAS bf16*)(q + 1 * VT_STRIDE) = (bf16)(w.x >> 16);
            *(LAS bf16*)(q + 2 * VT_STRIDE) = (bf16)(w.y & 0xffffu); *(LAS bf16*)(q + 3 * VT_STRIDE) = (bf16)(w.y >> 16);
            *(LAS bf16*)(q + 4 * VT_STRIDE) = (bf16)(w.z & 0xffffu); *(LAS bf16*)(q + 5 * VT_STRIDE) = (bf16)(w.z >> 16);
            *(LAS bf16*)(q + 6 * VT_STRIDE) = (bf16)(w.w & 0xffffu); *(LAS bf16*)(q + 7 * VT_STRIDE) = (bf16)(w.w >> 16);
        }
        asm volatile("s_waitcnt lgkmcnt(0)" ::: "memory"); __builtin_amdgcn_wave_barrier();
        const int obase = (kb - qb) * 64;
#pragma unroll
        for (int qt = 0; qt < 4; ++qt) {
            f32x4 sa[4];
#pragma unroll
            for (int kblk = 0; kblk < 4; ++kblk) {
                const bf16x8 k0 = *(const LAS bf16x8*)(vt + KF_OFF + (kblk * 2 + 0) * 1024 + lane * 16), k1 = *(const LAS bf16x8*)(vt + KF_OFF + (kblk * 2 + 1) * 1024 + lane * 16);
                sa[kblk] = mma(k0, qf[qt][0], z4); sa[kblk] = mma(k1, qf[qt][1], sa[kblk]); }
            const int qi = 16 * qt + c16;
            float mx = -1e30f;
#pragma unroll
            for (int kblk = 0; kblk < 4; ++kblk)
#pragma unroll
                for (int reg = 0; reg < 4; ++reg) {
                    const int o = obase + 16 * kblk + 4 * g + reg - qi, ao = o < 0 ? -o : o;
                    float sv = sa[kblk][reg] - slope2 * (float)ao;
                    sv = (ao <= 64) ? sv : -1e30f;
                    sa[kblk][reg] = sv; mx = fmaxf(mx, sv);
                }
            mx = fmaxf(mx, __shfl_xor(mx, 16)); mx = fmaxf(mx, __shfl_xor(mx, 32));
            const float mn = fmaxf(mrun[qt], mx), alpha = exp2f(mrun[qt] - mn);
            mrun[qt] = mn;
            float ls = 0.f;
#pragma unroll
            for (int kblk = 0; kblk < 4; ++kblk)
#pragma unroll
                for (int reg = 0; reg < 4; ++reg) { const float p = exp2f(sa[kblk][reg] - mn); sa[kblk][reg] = p; ls += p; }
            lrun[qt] = lrun[qt] * alpha + ls;
            const bf16x8 pf0 = mkfrag(cvtpk(sa[0][0], sa[0][1]), cvtpk(sa[0][2], sa[0][3]), cvtpk(sa[1][0], sa[1][1]), cvtpk(sa[1][2], sa[1][3]));
            const bf16x8 pf1 = mkfrag(cvtpk(sa[2][0], sa[2][1]), cvtpk(sa[2][2], sa[2][3]), cvtpk(sa[3][0], sa[3][1]), cvtpk(sa[3][2], sa[3][3]));
#pragma unroll
            for (int dt = 0; dt < 4; ++dt) {
                const LAS unsigned char* vr = vt + (16 * dt + c16) * VT_STRIDE + 8 * g;
                const u32x2 a0 = *(const LAS u32x2*)(vr), a1 = *(const LAS u32x2*)(vr + 32), a2 = *(const LAS u32x2*)(vr + 64), a3 = *(const LAS u32x2*)(vr + 96);
                f32x4 oc = oacc[dt][qt] * alpha;
                oc = mma(mkfrag(a0.x, a0.y, a1.x, a1.y), pf0, oc);
                oc = mma(mkfrag(a2.x, a2.y, a3.x, a3.y), pf1, oc);
                oacc[dt][qt] = oc;
            }
            __builtin_amdgcn_sched_barrier(0);
        }
        asm volatile("s_waitcnt lgkmcnt(0)" ::: "memory"); __builtin_amdgcn_wave_barrier();
    }
#pragma unroll
    for (int qt = 0; qt < 4; ++qt) {
        float lt = lrun[qt]; lt += __shfl_xor(lt, 16); lt += __shfl_xor(lt, 32);
        const float inv = 1.0f / lt;
        const int tok = b * SEQ + (qb * 64 + 16 * qt + c16) * d + r;
        bf16* op = Ob + (size_t)tok * opitch + h * 64 + 4 * g;
#pragma unroll
        for (int dt = 0; dt < 4; ++dt) { const f32x4 o = oacc[dt][qt] * inv; u32x2 w; w.x = cvtpk(o[0], o[1]); w.y = cvtpk(o[2], o[3]); *(u32x2*)(op + 16 * dt) = w; }
        if (g == 0) lse_out[(size_t)tok * NH + h] = (mrun[qt] + log2f(lt)) * LN2;
    }
}
}

namespace peer {
using scan::cvtpk; using scan::mkfrag; using scan::mma;
constexpr int KEY_SLOTS = 64;

template <int CTRL> __device__ __forceinline__ unsigned dppu(unsigned x) { return (unsigned)__builtin_amdgcn_update_dpp((int)x, (int)x, CTRL, 0xf, 0xf, false); }
__device__ __forceinline__ unsigned umax(unsigned a, unsigned b) { return a > b ? a : b; }
__device__ __forceinline__ unsigned rowmax16(unsigned x) { x = umax(x, dppu<0xB1>(x)); x = umax(x, dppu<0x4E>(x)); x = umax(x, dppu<0x141>(x)); x = umax(x, dppu<0x140>(x)); return x; }
__device__ __forceinline__ float rowsum16(float x) {
    x += __uint_as_float(dppu<0xB1>(__float_as_uint(x))); x += __uint_as_float(dppu<0x4E>(__float_as_uint(x)));
    x += __uint_as_float(dppu<0x141>(__float_as_uint(x))); x += __uint_as_float(dppu<0x140>(__float_as_uint(x))); return x;
}
__device__ __forceinline__ unsigned ordkey(float f) { const unsigned u = __float_as_uint(f); return (u & 0x80000000u) ? ~u : (u | 0x80000000u); }
__device__ __forceinline__ float unordkey(unsigned k) { return __uint_as_float((k & 0x80000000u) ? (k ^ 0x80000000u) : ~k); }

__device__ __forceinline__ void setup_keys(LAS unsigned char* L, const float* keys1, const float* keys2, int tid) {
    LAS bf16* F = (LAS bf16*)L;
    for (int i = tid; i < KEY_SLOTS * 64 * 8; i += 512) {
        const int j = i & 7, l = (i >> 3) & 63, sl = i >> 9, ks = sl & 3, nt = (sl >> 2) & 7, sel = sl >> 5;
        const int n = 16 * nt + (l & 15), k = 32 * ks + 8 * (l >> 4) + j;
        F[i] = (bf16)f2bf((sel ? keys2 : keys1)[n * 128 + k]);
    }
}

__device__ __forceinline__ void top16(unsigned (&key)[8][4], unsigned (&win)[4], int c16) {
#pragma unroll 1
    for (int k = 0; k < TOPK; ++k) {
#pragma unroll
        for (int reg = 0; reg < 4; ++reg) {
            unsigned m = key[0][reg];
#pragma unroll
            for (int nt = 1; nt < 8; ++nt) m = umax(m, key[nt][reg]);
            m = rowmax16(m);
            win[reg] = (c16 == k) ? m : win[reg];
#pragma unroll
            for (int nt = 0; nt < 8; ++nt) key[nt][reg] = (key[nt][reg] == m) ? 0u : key[nt][reg];
        }
    }
}

__device__ __forceinline__ void select_batch(const LAS unsigned char* L, const bf16* Q, int* IDX, float* GATE, int batch, int lane) {
    const int g = lane >> 4, c16 = lane & 15;
    const LAS bf16x8* F = (const LAS bf16x8*)L;
    const bf16* qp = Q + (size_t)(batch * 16 + c16) * PKD + 8 * g;
    unsigned w1[4] = {0u, 0u, 0u, 0u}, w2[4] = {0u, 0u, 0u, 0u};
#pragma unroll
    for (int sel = 0; sel < 2; ++sel) {
        unsigned key[8][4];
        bf16x8 a[4];
#pragma unroll
        for (int ks = 0; ks < 4; ++ks) a[ks] = *(const bf16x8*)(qp + sel * 128 + 32 * ks);
#pragma unroll
        for (int nt = 0; nt < 8; ++nt) {
            f32x4 sc = {0.f, 0.f, 0.f, 0.f};
#pragma unroll
            for (int ks = 0; ks < 4; ++ks) sc = mma(a[ks], F[((sel * 8 + nt) * 4 + ks) * 64 + lane], sc);
#pragma unroll
            for (int reg = 0; reg < 4; ++reg) key[nt][reg] = (ordkey(sc[reg]) & ~127u) | (unsigned)(16 * nt + c16);
            __builtin_amdgcn_sched_barrier(0);
        }
        if (sel == 0) top16(key, w1, c16); else top16(key, w2, c16);
    }
    float f1[4], f2[4], cur2[4]; int ptr[4]; unsigned top[4];
#pragma unroll
    for (int reg = 0; reg < 4; ++reg) { f1[reg] = unordkey(w1[reg] & ~127u); f2[reg] = unordkey(w2[reg] & ~127u); ptr[reg] = 0; cur2[reg] = __shfl(f2[reg], lane & 48); top[reg] = 0u; }
#pragma unroll 1
    for (int k = 0; k < TOPK; ++k) {
#pragma unroll
        for (int reg = 0; reg < 4; ++reg) {
            const unsigned ck = (ptr[reg] < 16) ? ((ordkey(f1[reg] + cur2[reg]) & ~255u) | (unsigned)(c16 << 4) | (unsigned)ptr[reg]) : 0u;
            const unsigned m = rowmax16(ck);
            top[reg] = (c16 == k) ? m : top[reg];
            if ((int)((m >> 4) & 15u) == c16) ptr[reg] += 1;
            cur2[reg] = __shfl(f2[reg], (lane & 48) | (ptr[reg] & 15));
        }
    }
#pragma unroll
    for (int reg = 0; reg < 4; ++reg) {
        const int a = (top[reg] >> 4) & 15, bq = top[reg] & 15;
        const int e1 = (int)(__shfl(w1[reg], (lane & 48) | a) & 127u), e2 = (int)(__shfl(w2[reg], (lane & 48) | bq) & 127u);
        const float ts = unordkey(top[reg] & ~255u), mx = __shfl(ts, lane & 48);
        const float ex = __expf(ts - mx), sum = rowsum16(ex);
        const size_t o = (size_t)(batch * 16 + 4 * g + reg) * TOPK + c16;
        IDX[o] = e1 * NKEYS + e2; GATE[o] = ex / sum;
    }
}

__device__ __forceinline__ void convert_table(const float* src, bf16* dst, size_t n8, size_t gtid, size_t gthreads) {
    for (size_t i = gtid; i < n8; i += gthreads) {
        const f32x4 a = *(const f32x4*)(src + i * 8), b = *(const f32x4*)(src + i * 8 + 4);
        v4u o; o.x = cvtpk(a.x, a.y); o.y = cvtpk(a.z, a.w); o.z = cvtpk(b.x, b.y); o.w = cvtpk(b.z, b.w);
        *(v4u*)(dst + i * 8) = o;
    }
}

__device__ __forceinline__ float dot2bf(unsigned w, unsigned x, float acc) {
    typedef __bf16 bf2 __attribute__((ext_vector_type(2)));
    return __builtin_amdgcn_fdot2_f32_bf16(__builtin_bit_cast(bf2, w), __builtin_bit_cast(bf2, x), acc, false);
}
__device__ __forceinline__ float gelu_erf(float v) {
    const float av = fabsf(v), t = __builtin_amdgcn_rcpf(av * 0.2316418882f + 1.0f);
    float q = t * 0.5307027145f + (-0.7265760135f); q = q * t + 0.7107068705f; q = q * t + (-0.142248368f); q = q * t + 0.127414796f; q = q * t;
    const float e = __builtin_amdgcn_exp2f((v * v) * (-0.72134752044f));
    const float m = v * (q * e);
    return v < 0.f ? m : v - m;
}

__device__ __forceinline__ void ffn_u_token(const bf16* XN, const int* IDX, const bf16* UT, float* PART, int sl, int tok, int lane) {
    const int g = lane >> 4, c16 = lane & 15;
    const v4u x = *(const v4u*)(XN + (size_t)tok * D + 128 * sl + 8 * c16);
    const int id0 = IDX[(size_t)tok * HK + lane], id1 = IDX[(size_t)tok * HK + 64 + lane];
    float r0 = 0.f, r1 = 0.f;
#pragma unroll
    for (int i0 = 0; i0 < 32; i0 += 8) {
        v4u u[8];
#pragma unroll
        for (int k = 0; k < 8; ++k) { const int i = i0 + k; const int ex = __shfl((i < 16) ? id0 : id1, (4 * i + g) & 63); u[k] = *(const v4u*)(UT + (size_t)ex * D + 128 * sl + 8 * c16); }
#pragma unroll
        for (int k = 0; k < 8; ++k) { const int i = i0 + k;
            float dot = dot2bf(u[k].x, x.x, 0.f); dot = dot2bf(u[k].y, x.y, dot); dot = dot2bf(u[k].z, x.z, dot); dot = dot2bf(u[k].w, x.w, dot);
            dot = rowsum16(dot);
            if (c16 == (i & 15)) { if (i < 16) r0 = dot; else r1 = dot; } }
    }
    float* pp = PART + ((size_t)sl * T + tok) * HK + 4 * c16 + g;
    pp[0] = r0; pp[64] = r1;
}
__device__ __forceinline__ void ffn_v_token(const int* IDX, const float* COEF, const bf16* VT, const float* mod, float* out, int sl, int tok, int lane) {
    const int g = lane >> 4, c16 = lane & 15, b = tok / SEQ;
    const int id0 = IDX[(size_t)tok * HK + lane], id1 = IDX[(size_t)tok * HK + 64 + lane];
    const float cf0 = COEF[(size_t)tok * HK + lane], cf1 = COEF[(size_t)tok * HK + 64 + lane];
    float y[8];
#pragma unroll
    for (int k = 0; k < 8; ++k) y[k] = 0.f;
#pragma unroll
    for (int i0 = 0; i0 < 32; i0 += 8) {
        v4u v[8]; float cf[8];
#pragma unroll
        for (int k = 0; k < 8; ++k) { const int i = i0 + k; const int src = (4 * i + g) & 63; const int ex = __shfl((i < 16) ? id0 : id1, src); cf[k] = __shfl((i < 16) ? cf0 : cf1, src);
            v[k] = *(const v4u*)(VT + (size_t)ex * D + 128 * sl + 8 * c16); }
#pragma unroll
        for (int k = 0; k < 8; ++k) {
            y[0] += cf[k] * __uint_as_float(v[k].x << 16); y[1] += cf[k] * __uint_as_float(v[k].x & 0xffff0000u); y[2] += cf[k] * __uint_as_float(v[k].y << 16); y[3] += cf[k] * __uint_as_float(v[k].y & 0xffff0000u);
            y[4] += cf[k] * __uint_as_float(v[k].z << 16); y[5] += cf[k] * __uint_as_float(v[k].z & 0xffff0000u); y[6] += cf[k] * __uint_as_float(v[k].w << 16); y[7] += cf[k] * __uint_as_float(v[k].w & 0xffff0000u);
        }
    }
#pragma unroll
    for (int k = 0; k < 8; ++k) { y[k] += __shfl_xor(y[k], 16); y[k] += __shfl_xor(y[k], 32); }
    if (g == 0) {
        const int col = 128 * sl + 8 * c16; const size_t o = (size_t)tok * D + col;
        const f32x4 ga = *(const f32x4*)(mod + b * MODW + 5 * D + col), gb = *(const f32x4*)(mod + b * MODW + 5 * D + col + 4);
        f32x4 oa = *(const f32x4*)(out + o), ob = *(const f32x4*)(out + o + 4);
        oa.x += ga.x * y[0]; oa.y += ga.y * y[1]; oa.z += ga.z * y[2]; oa.w += ga.w * y[3];
        ob.x += gb.x * y[4]; ob.y += gb.y * y[5]; ob.z += gb.z * y[6]; ob.w += gb.w * y[7];
        *(f32x4*)(out + o) = oa; *(f32x4*)(out + o + 4) = ob;
    }
}
}

namespace fin {
using scan::cvtpk; using scan::mkfrag; using scan::mma;
typedef unsigned u32x2 __attribute__((ext_vector_type(2)));

__device__ __forceinline__ float shift3(const bf16* p, bool hasp, bool hasn, float mp, float mn) {
    const float z = bf2f(p[0]), zp = hasp ? bf2f(p[-INW]) : 0.f, zn = hasn ? bf2f(p[INW]) : 0.f;
    return z + mp * (zp - z) + mn * (zn - z);
}

__device__ __forceinline__ void unpack4(const u32x2 w, float (&f)[4]) {
    f[0] = __uint_as_float(w.x << 16); f[1] = __uint_as_float(w.x & 0xffff0000u); f[2] = __uint_as_float(w.y << 16); f[3] = __uint_as_float(w.y & 0xffff0000u);
}
__device__ __forceinline__ void phase(LAS unsigned char* L, const bf16* Z, const float* mu_prev, const float* mu_next, const float* g_up, const float* Y, const float* BON,
                                      const float* k_a, const float* r_k, const float* lnx_g, const float* lnx_b, bf16* mix, const bf16* O3, const float* LSE,
                                      int bx, int G, int tid, int wave, int lane) {
    const int g = lane >> 4, c16 = lane & 15, ch0 = 64 * wave + 4 * c16;
    LAS bf16* sg = (LAS bf16*)L;
    bf16x8 bf[4][4];
#pragma unroll
    for (int ks = 0; ks < 4; ++ks) {
        f32x4 rowv[8];
#pragma unroll
        for (int jj = 0; jj < 8; ++jj) rowv[jj] = *(const f32x4*)(g_up + (size_t)(32 * ks + 8 * g + jj) * RW + ch0);
#pragma unroll
        for (int nt = 0; nt < 4; ++nt) bf[nt][ks] = mkfrag(cvtpk(rowv[0][nt], rowv[1][nt]), cvtpk(rowv[2][nt], rowv[3][nt]), cvtpk(rowv[4][nt], rowv[5][nt]), cvtpk(rowv[6][nt], rowv[7][nt]));
    }
    const f32x4 mpr = *(const f32x4*)(mu_prev + ch0), mnr = *(const f32x4*)(mu_next + ch0), mpk = *(const f32x4*)(mu_prev + RW + ch0), mnk = *(const f32x4*)(mu_next + RW + ch0),
                mpv = *(const f32x4*)(mu_prev + 2 * RW + ch0), mnv = *(const f32x4*)(mu_next + 2 * RW + ch0);
    const f32x4 ka1 = *(const f32x4*)(k_a + ch0), rk1 = *(const f32x4*)(r_k + ch0), lg = *(const f32x4*)(lnx_g + ch0), lb = *(const f32x4*)(lnx_b + ch0);
    const int j0 = (tid & 31) * 4;
    const f32x4 mpg = *(const f32x4*)(mu_prev + 3 * RW + DL + AL + j0), mng = *(const f32x4*)(mu_next + 3 * RW + DL + AL + j0);
    for (int tb = bx; tb < T / 16; tb += G) {
        const int tok0 = tb * 16;
        __syncthreads();
        {
            const int tl = tid >> 5, tok = tok0 + tl, t = tok % SEQ;
            const bf16* p = Z + (size_t)tok * INW + 3 * AW + 3 * RW + DL + AL + j0;
            const bool hasp = t > 0, hasn = t < SEQ - 1;
            float zc[4], zp[4], zn[4];
            unpack4(*(const u32x2*)p, zc); unpack4(*(const u32x2*)(hasp ? p - INW : p), zp); unpack4(*(const u32x2*)(hasn ? p + INW : p), zn);
            float o[4];
#pragma unroll
            for (int e = 0; e < 4; ++e) { const float pv = hasp ? zp[e] : 0.f, nv = hasn ? zn[e] : 0.f; const float v = zc[e] + mpg[e] * (pv - zc[e]) + mng[e] * (nv - zc[e]); o[e] = __builtin_amdgcn_rcpf(1.0f + __expf(-v)); }
            u32x2 w; w.x = cvtpk(o[0], o[1]); w.y = cvtpk(o[2], o[3]);
            *(LAS u32x2*)(sg + tl * 128 + j0) = w;
        }
        __syncthreads();
        f32x4 ga[4];
        {
            bf16x8 af[4];
#pragma unroll
            for (int ks = 0; ks < 4; ++ks) af[ks] = *(const LAS bf16x8*)(sg + c16 * 128 + 32 * ks + 8 * g);
#pragma unroll
            for (int nt = 0; nt < 4; ++nt) { f32x4 a = {0.f, 0.f, 0.f, 0.f};
#pragma unroll
                for (int ks = 0; ks < 4; ++ks) a = mma(af[ks], bf[nt][ks], a);
                ga[nt] = a; }
        }
#pragma unroll
        for (int reg = 0; reg < 4; ++reg) {
            const int tok = tok0 + 4 * g + reg, t = tok % SEQ;
            const bool hasp = t > 0, hasn = t < SEQ - 1;
            const bf16* zr = Z + (size_t)tok * INW + 3 * AW + ch0;
            const size_t o = (size_t)tok * RW + ch0;
            const f32x4 y0 = *(const f32x4*)(Y + o), y1 = *(const f32x4*)(Y + (size_t)T * RW + o);
            float rc[4], rp[4], rn[4], kc[4], kp[4], kn[4], vc[4], vp[4], vn[4];
            unpack4(*(const u32x2*)zr, rc); unpack4(*(const u32x2*)(hasp ? zr - INW : zr), rp); unpack4(*(const u32x2*)(hasn ? zr + INW : zr), rn);
            unpack4(*(const u32x2*)(zr + RW), kc); unpack4(*(const u32x2*)(hasp ? zr + RW - INW : zr + RW), kp); unpack4(*(const u32x2*)(hasn ? zr + RW + INW : zr + RW), kn);
            unpack4(*(const u32x2*)(zr + 2 * RW), vc); unpack4(*(const u32x2*)(hasp ? zr + 2 * RW - INW : zr + 2 * RW), vp); unpack4(*(const u32x2*)(hasn ? zr + 2 * RW + INW : zr + 2 * RW), vn);
            bf16* mp = mix + (size_t)tok * D + ch0;
            float o1[4], o2[4], o3[4];
            unpack4(*(const u32x2*)mp, o1); unpack4(*(const u32x2*)(mp + AW), o2); unpack4(*(const u32x2*)(O3 + (size_t)tok * AW + ch0), o3);
            const float l1 = LSE[(size_t)tok * NH + wave], l2 = LSE[((size_t)T + tok) * NH + wave], l3 = LSE[((size_t)2 * T + tok) * NH + wave];
            const float bon = BON[(size_t)tok * NH + wave] + BON[((size_t)T + tok) * NH + wave];
            float yv[4], vv[4], s1 = 0.f, sb = 0.f;
#pragma unroll
            for (int nt = 0; nt < 4; ++nt) {
                yv[nt] = y0[nt] + y1[nt]; s1 += yv[nt];
                const float pr = hasp ? rp[nt] : 0.f, nr = hasn ? rn[nt] : 0.f, pk = hasp ? kp[nt] : 0.f, nk = hasn ? kn[nt] : 0.f, pvv = hasp ? vp[nt] : 0.f, nvv = hasn ? vn[nt] : 0.f;
                const float rr = rc[nt] + mpr[nt] * (pr - rc[nt]) + mnr[nt] * (nr - rc[nt]);
                const float kk = kc[nt] + mpk[nt] * (pk - kc[nt]) + mnk[nt] * (nk - kc[nt]);
                vv[nt] = vc[nt] + mpv[nt] * (pvv - vc[nt]) + mnv[nt] * (nvv - vc[nt]);
                sb += rr * kk * rk1[nt] * (1.0f - ka1[nt]);
            }
            const float mean = peer::rowsum16(s1) * (1.f / 64.f);
            float s2 = 0.f;
#pragma unroll
            for (int nt = 0; nt < 4; ++nt) s2 += (yv[nt] - mean) * (yv[nt] - mean);
            const float rstd = __builtin_amdgcn_rsqf(peer::rowsum16(s2) * (1.f / 64.f) + 64e-5f);
            const float bs = peer::rowsum16(sb) + 0.5f * bon;
            const float lm = fmaxf(l1, fmaxf(l2, l3)), w1 = __expf(l1 - lm), w2 = __expf(l2 - lm), w3 = __expf(l3 - lm), wi = __builtin_amdgcn_rcpf(w1 + w2 + w3);
            float att[4], rw[4];
#pragma unroll
            for (int nt = 0; nt < 4; ++nt) {
                att[nt] = (w1 * o1[nt] + w2 * o2[nt] + w3 * o3[nt]) * wi;
                rw[nt] = ((yv[nt] - mean) * rstd * lg[nt] + lb[nt] + bs * vv[nt]) * ga[nt][reg];
            }
            u32x2 wa, wr; wa.x = cvtpk(att[0], att[1]); wa.y = cvtpk(att[2], att[3]); wr.x = cvtpk(rw[0], rw[1]); wr.y = cvtpk(rw[2], rw[3]);
            *(u32x2*)mp = wa; *(u32x2*)(mp + AW) = wr;
        }
    }
}
}

#ifndef MK_SKIP
#define MK_SKIP 0
#endif
constexpr int N_PHASES = 12;
struct Args { const float* in[27]; float* out; unsigned char* ws; int ph_lo, ph_hi, li, pad; };

__global__ void __launch_bounds__(NWAVES * 64, 2) mk_fwd(Args args) {
    extern __shared__ __attribute__((aligned(16))) unsigned char lds[];
    LAS unsigned char* L = (LAS unsigned char*)lds;
    volatile LAS unsigned* MISC = (volatile LAS unsigned*)(L + MISC_OFF);
    const int tid = threadIdx.x, lane = tid & 63, wave = __builtin_amdgcn_readfirstlane(tid >> 6);
    const int G = gridDim.x, bx = blockIdx.x;
    unsigned char* ws = args.ws;
    gu32* ctl = (gu32*)(ws + WS_CTL);
    const float* x = args.in[0]; const float* cvec = args.in[1]; const float* ada_w = args.in[2]; const float* ada_b = args.in[3];
    const float* norm1_g = args.in[4]; const float* w_in = args.in[5]; const float* mu_prev = args.in[6]; const float* mu_next = args.in[7];
    const float* q_norm_g = args.in[8]; const float* k_norm_g = args.in[9]; const float* w_decay0 = args.in[10]; const float* w_decay_up = args.in[11];
    const float* a_gate0 = args.in[12]; const float* a_gate_up = args.in[13]; const float* g_up = args.in[14]; const float* k_k = args.in[15];
    const float* k_a = args.in[16]; const float* r_k = args.in[17]; const float* lnx_g = args.in[18]; const float* lnx_b = args.in[19];
    const float* w_out = args.in[20]; const float* norm2_g = args.in[21]; const float* w_query = args.in[22]; const float* keys1 = args.in[23];
    const float* keys2 = args.in[24]; const float* peer_u = args.in[25]; const float* peer_v = args.in[26];
    float* out = args.out;
    float* MOD = (float*)(ws + WS_MOD); bf16* KEYS = (bf16*)(ws + WS_KEYS); bf16* WIN = (bf16*)(ws + WS_WIN); bf16* WOUT = (bf16*)(ws + WS_WOUT); bf16* WQ = (bf16*)(ws + WS_WQ);
    bf16* XN = (bf16*)(ws + WS_XN); bf16* Z = (bf16*)(ws + WS_Z); bf16* MIX = (bf16*)(ws + WS_MIX); float* Y = (float*)(ws + WS_Y); bf16* Q = (bf16*)(ws + WS_Q);
    int* IDX = (int*)(ws + WS_IDX); float* GATE = (float*)(ws + WS_GATE); float* BON = (float*)(ws + WS_BON);
    bf16* O3 = (bf16*)(ws + WS_O3); float* LSE = (float*)(ws + WS_LSE); bf16* UT = (bf16*)(ws + WS_UT); bf16* VT = (bf16*)(ws + WS_VT); float* PART = (float*)(ws + WS_PART);

    for (int u = tid; u < (LDS_BYTES - LDSCTL_OFF) / 4; u += NWAVES * 64) ((LAS unsigned*)(L + LDSCTL_OFF))[u] = 0u;
    __syncthreads();
    XcdBarrier bar = xcd_barrier_post((unsigned*)(ctl + CW_BAR) + args.li * XCD_BAR_WORDS, MISC + 8);
    const int lo = args.ph_lo, hi = args.ph_hi;
#define IN(k) (lo <= (k) && (k) < hi)
#define SEAM(k) do { if (IN(k) && IN((k) + 1)) xcd_barrier(bar); } while (0)
    const int gw = bx * NWAVES + wave, NGW = G * NWAVES;

    if (IN(0) && !(MK_SKIP & (1 << 0))) {
        if (bx < MODW / 64) {
            LAS float* sc = (LAS float*)L; LAS float* part = (LAS float*)(L + 32768);
            for (int i = tid; i < BATCH * D; i += NWAVES * 64) { const float cv = cvec[i]; sc[i] = cv / (1.f + expf(-cv)); }
            __syncthreads();
            const int j0 = bx * 64;
            float acc[BATCH];
#pragma unroll
            for (int b = 0; b < BATCH; ++b) acc[b] = 0.f;
            for (int i = wave * 128; i < wave * 128 + 128; ++i) { const float w = ada_w[(size_t)i * MODW + j0 + lane];
#pragma unroll
                for (int b = 0; b < BATCH; ++b) acc[b] += sc[b * D + i] * w; }
#pragma unroll
            for (int b = 0; b < BATCH; ++b) part[(wave * 8 + b) * 64 + lane] = acc[b];
            __syncthreads();
            { const int b = tid >> 6; float s = 0.f;
#pragma unroll
              for (int w = 0; w < 8; ++w) s += part[(w * 8 + b) * 64 + lane];
              MOD[b * MODW + j0 + lane] = s + ada_b[j0 + lane]; }
            __syncthreads();
        }
        LAS float* scr = (LAS float*)(L + RING_OFF + wave * 16384);
        constexpr int I_IN = (D / 64) * (INW / 32), I_OUT = (D / 64) * (D / 32), I_Q = (D / 64) * (QW / 32);
        for (int it = gw; it < I_IN + I_OUT + I_Q; it += NGW) {
            int r = it;
            if (r < I_IN) { p0_transpose_item(w_in, D, INW, WIN, 0, scr, r, lane); continue; } r -= I_IN;
            if (r < I_OUT) { p0_transpose_item(w_out, D, D, WOUT, 0, scr, r, lane); continue; } r -= I_OUT;
            p0_transpose_item(w_query, D, QW, WQ, 0, scr, r, lane);
        }
    }
    SEAM(0);
    if (IN(1) && !(MK_SKIP & (1 << 1))) { for (int m = gw; m < T; m += NGW) norm_row(x + (size_t)m * D, norm1_g, MOD + (m / SEQ) * MODW, 0, D, XN + (size_t)m * D, lane); }
    SEAM(1);
    if (IN(2) && !(MK_SKIP & (1 << 2))) {
        pg8::Gemm g{XN, WIN, T, INW, D}; pg8::StaticOrder S; S.init(T, INW, G, bx);
        pg8::EpiBf16<0> E{Z, INW, nullptr, 0, 0, 1.f};
        pg8::gemm_phase<pg8::EpiBf16<0>, pg8::StaticOrder, true, true>(L + RING_OFF, g, S, E);
    }
    SEAM(2);
    if (IN(3) && !(MK_SKIP & (1 << 3))) {
        constexpr int NCHAIN = BATCH * NH * 2;
        if (bx < NCHAIN) {
            scan::chain(L, Z, mu_prev, mu_next, w_decay0, w_decay_up, a_gate0, a_gate_up, k_k, k_a, r_k, Y, BON, bx, tid, wave, lane);
        } else {
            const int wid = (bx - NCHAIN) * NWAVES + wave, nworkers = (G - NCHAIN) * NWAVES;
            LAS unsigned char* vt = L + wave * attn::WAVE_LDS;
            for (int u = wid; u < BATCH * NH * 96; u += nworkers) {
                const int x = u & 31, p = (u >> 5) % 3, bh = u / 96;
                const int d = (p == 0) ? 1 : (p == 1 ? 4 : 16), nb = 32 / d, r = x / nb, qb = x % nb;
                bf16* Ob = (p == 0) ? MIX : (p == 1 ? MIX + AW : O3); const int opitch = (p == 2) ? AW : D;
                attn::unit(vt, Z, q_norm_g, k_norm_g, Ob, opitch, LSE + (size_t)p * T * NH, bh >> 3, bh & 7, d, r, qb, nb, lane);
            }
        }
    }
    SEAM(3);
    if (IN(4) && !(MK_SKIP & (1 << 4))) { fin::phase(L, Z, mu_prev, mu_next, g_up, Y, BON, k_a, r_k, lnx_g, lnx_b, MIX, O3, LSE, bx, G, tid, wave, lane); }
    SEAM(4);
    if (IN(5) && !(MK_SKIP & (1 << 5))) {
        pg8::Gemm g{MIX, WOUT, T, D, D}; pg8::StaticOrder S; S.init(T, D, G, bx);
        EpiRes E{x, MOD, 2 * D, out, D};
        pg8::gemm_phase<EpiRes, pg8::StaticOrder, true, true>(L + RING_OFF, g, S, E);
    }
    SEAM(5);
    if (IN(6) && !(MK_SKIP & (1 << 6))) { for (int m = gw; m < T; m += NGW) norm_row(out + (size_t)m * D, norm2_g, MOD + (m / SEQ) * MODW, 3 * D, 4 * D, XN + (size_t)m * D, lane);
        const size_t gtid = (size_t)bx * NWAVES * 64 + tid, gthreads = (size_t)G * NWAVES * 64;
        peer::convert_table(peer_u, UT, (size_t)NKEYS * NKEYS * D / 8, gtid, gthreads); peer::convert_table(peer_v, VT, (size_t)NKEYS * NKEYS * D / 8, gtid, gthreads); }
    SEAM(6);
    if (IN(7) && !(MK_SKIP & (1 << 7))) {
        pg8::Gemm g{XN, WQ, T, QW, D}; pg8::StaticOrder S; S.init(T, QW, G, bx);
        pg8::EpiBf16<0> E{Q, QW, nullptr, 0, 0, 1.f};
        pg8::gemm_phase<pg8::EpiBf16<0>, pg8::StaticOrder, true, true>(L + RING_OFF, g, S, E);
    }
    SEAM(7);
    if (IN(8) && !(MK_SKIP & (1 << 8))) { __syncthreads(); peer::setup_keys(L, keys1, keys2, tid); __syncthreads();
        for (int bt = gw; bt < T * PH / 16; bt += NGW) peer::select_batch(L, Q, IDX, GATE, bt, lane); }
    SEAM(8);
    {
        const int sl = bx & 7, wv = (bx >> 3) * NWAVES + wave, nwv = (G >> 3) * NWAVES;
        if (IN(9) && !(MK_SKIP & (1 << 9))) { for (int tok = wv; tok < T; tok += nwv) peer::ffn_u_token(XN, IDX, UT, PART, sl, tok, lane); }
        SEAM(9);
        if (IN(10) && !(MK_SKIP & (1 << 10))) {
            for (size_t i = (size_t)bx * NWAVES * 64 + tid; i < (size_t)T * HK; i += (size_t)G * NWAVES * 64) {
                float d = 0.f;
#pragma unroll
                for (int s8 = 0; s8 < 8; ++s8) d += PART[(size_t)s8 * T * HK + i];
                GATE[i] = GATE[i] * peer::gelu_erf(d);
            }
        }
        SEAM(10);
        if (IN(11) && !(MK_SKIP & (1 << 11))) { for (int tok = wv; tok < T; tok += nwv) peer::ffn_v_token(IDX, GATE, VT, MOD, out, sl, tok, lane); }
    }
#undef IN
#undef SEAM
}

extern "C" void kernel_launch(void* const* d_in, const int* in_sizes, int n_in, void* d_out, int out_size, void* d_ws, size_t ws_size, hipStream_t stream) {
    static int grid = 0;
    if (grid == 0) {
        if (n_in != 27 || in_sizes[0] != T * D || out_size != T * D || ws_size < WS_END) { fprintf(stderr, "kernel_launch: unexpected problem (n_in %d, in0 %d, out %d, ws %zu); nothing launched\n", n_in, n_in > 0 ? in_sizes[0] : -1, out_size, ws_size); grid = -1; return; }
        int dev = 0, cus = 0, per_cu = 0;
        if (hipGetDevice(&dev) != hipSuccess || hipDeviceGetAttribute(&cus, hipDeviceAttributeMultiprocessorCount, dev) != hipSuccess) { fprintf(stderr, "kernel_launch: device query failed\n"); grid = -1; return; }
        if (hipFuncSetAttribute((const void*)mk_fwd, hipFuncAttributeMaxDynamicSharedMemorySize, LDS_BYTES) != hipSuccess) { fprintf(stderr, "kernel_launch: hipFuncSetAttribute failed\n"); grid = -1; return; }
        if (hipOccupancyMaxActiveBlocksPerMultiprocessor(&per_cu, (const void*)mk_fwd, NWAVES * 64, LDS_BYTES) != hipSuccess || per_cu < 1)
            fprintf(stderr, "kernel_launch: note: occupancy query reports %d workgroups per CU\n", per_cu);
        (void)hipGetLastError();
        grid = cus;
    }
    if (grid < 0) return;
    if (hipMemsetAsync((char*)d_ws + WS_CTL, 0, CTL_ZERO_BYTES, stream) != hipSuccess) { fprintf(stderr, "kernel_launch: hipMemsetAsync failed\n"); return; }
    Args a{};
    for (int i = 0; i < 27; ++i) a.in[i] = (const float*)d_in[i];
    a.out = (float*)d_out; a.ws = (unsigned char*)d_ws;
#ifndef MK_RANGES
#define MK_RANGES {{0, N_PHASES}}
#endif
    static const int ranges[][2] = MK_RANGES;
    const int nl = (int)(sizeof(ranges) / sizeof(ranges[0]));
    for (int li = 0; li < nl; ++li) {
        a.ph_lo = ranges[li][0]; a.ph_hi = ranges[li][1]; a.li = li;
        hipLaunchKernelGGL(mk_fwd, dim3(grid), dim3(NWAVES * 64), LDS_BYTES, stream, a);
        const hipError_t le = hipPeekAtLastError();
        if (le != hipSuccess) { fprintf(stderr, "kernel_launch: launch %d failed: %s\n", li, hipGetErrorName(le)); break; }
    }
}
```

```cpp
#include <hip/hip_runtime.h>
#include <cstdio>
#include <cstdint>
#include <cmath>
namespace pg8 {
#define PG8_LAS __attribute__((address_space(3)))
typedef unsigned short bf16_t;
typedef short bf16x8 __attribute__((ext_vector_type(8)));
typedef float f32x4 __attribute__((ext_vector_type(4)));
typedef unsigned u32x4 __attribute__((ext_vector_type(4)));
constexpr int BM = 256, BK = 64, HALF = 128, HTB = HALF * BK * 2  , STAGE_BYTES = 8 * HTB, NXCD = 8, WGM = 8;

__host__ __device__ __forceinline__ int lds_byte(int r, int c) { const int st = (r >> 4) * 2 + (c >> 5), rr = r & 15, cc = c & 31, ob = rr * 64 + cc * 2; return st * 1024 + (ob ^ (((ob >> 9) & 1) << 5)); }
__host__ __device__ __forceinline__ void stage_rc(int b, int& R, int& C) { const int st = b / 1024, sb = b % 1024, swz = sb ^ (((sb >> 9) & 1) << 5); R = (st >> 1) * 16 + swz / 64; C = (st & 1) * 32 + (swz % 64) / 2; }
__host__ __device__ __forceinline__ int perm32(int rho) { const int n = rho >> 4, i = rho & 15; return 8 * (i >> 2) + 4 * n + (i & 3); }

struct Unit { int pm, pn; };
struct Gemm { const bf16_t* A; const bf16_t* Bt; int M, N, K; };

struct StaticOrder {
    int nM, nN, nwg, G, c;
    __host__ __device__ void init(int M, int N, int G_, int c_) { nM = M / BM; nN = N / BM; nwg = nM * nN; G = G_; c = c_; }
    __host__ __device__ bool next(int i, Unit& u) const {
        const long L = (long)i * G + c; if (L >= nwg) return false;
        int wgid = (int)L; { const int q = nwg / NXCD, r = nwg % NXCD, xcd = wgid % NXCD, off = wgid / NXCD; wgid = (xcd < r ? xcd * (q + 1) : r * (q + 1) + (xcd - r) * q) + off; }
        const int nig = WGM * nN, gid = wgid / nig, fm = gid * WGM, gsz = (nM - fm) < WGM ? (nM - fm) : WGM;
        u.pm = fm + ((wgid % nig) % gsz); u.pn = (wgid % nig) / gsz; return true;
    }
    __device__ __forceinline__ void a_ready(const Unit&) const {}
    __device__ __forceinline__ void done(const Unit&) const {}
};

__device__ __forceinline__ unsigned cvt_pk_bf16(float lo, float hi) { unsigned r; asm volatile("v_cvt_pk_bf16_f32 %0, %1, %2" : "=v"(r) : "v"(lo), "v"(hi)); return r; }
typedef float f32x2 __attribute__((ext_vector_type(2)));
__device__ __forceinline__ f32x2 gelu_pk(f32x2 v) {
    const f32x2 av = __builtin_elementwise_abs(v), d = av * 0.2316418882f + 1.0f;
    f32x2 t; t.x = __builtin_amdgcn_rcpf(d.x); t.y = __builtin_amdgcn_rcpf(d.y);
    f32x2 q = t * 0.5307027145f + (-0.7265760135f); q = q * t + 0.7107068705f; q = q * t + (-0.142248368f); q = q * t + 0.127414796f; q = q * t;
    const f32x2 s = (v * v) * (-0.72134752044f);
    f32x2 e; e.x = __builtin_amdgcn_exp2f(s.x); e.y = __builtin_amdgcn_exp2f(s.y);
    const f32x2 m = v * (q * e), r = v - m;
    f32x2 o; o.x = v.x < 0.f ? m.x : r.x; o.y = v.y < 0.f ? m.y : r.y; return o;
}

template <int ACT  > struct EpiBf16 {
    static constexpr bool PERM = true, AFTER_DRAIN = false; static_assert(ACT == 0 || ACT == 1, "EpiBf16: ACT is 0 (none) or 1 (gelu_pk)");
    bf16_t* O; int ldc; const float* bias; int split_cols; size_t split_stride; float scale0;
    __device__ __forceinline__ void operator()(const f32x4 (&acc)[2][2][4][2], const Unit& u, int wr, int wc, int fr, int fq) const {
        const int row0 = u.pm * BM + wr * 64 + fr; int colt = u.pn * BM; bf16_t* base = O;
        float sc = 1.f; if (split_cols) { const int t = colt / split_cols; base += (size_t)t * split_stride; colt -= t * split_cols; if (t == 0) sc = scale0; }
        const int col0 = colt + wc * 32 + 8 * fq, bcol0 = u.pn * BM + wc * 32 + 8 * fq;
        f32x4 bv[2][2];
#pragma unroll
        for (int bj = 0; bj < 2; ++bj)
#pragma unroll
            for (int n = 0; n < 2; ++n) bv[bj][n] = bias ? *(const f32x4*)(bias + bcol0 + bj * HALF + 4 * n) : (f32x4){0.f, 0.f, 0.f, 0.f};
#pragma unroll
        for (int ai = 0; ai < 2; ++ai)
#pragma unroll
            for (int m = 0; m < 4; ++m) { bf16_t* rowp = base + (size_t)(row0 + ai * HALF + m * 16) * ldc + col0;
#pragma unroll
                for (int bj = 0; bj < 2; ++bj) { f32x4 v0 = acc[ai][bj][m][0] + bv[bj][0], v1 = acc[ai][bj][m][1] + bv[bj][1];
                    if (ACT == 1) { f32x2 a = gelu_pk((f32x2){v0[0], v0[1]}), b = gelu_pk((f32x2){v0[2], v0[3]}), c = gelu_pk((f32x2){v1[0], v1[1]}), d = gelu_pk((f32x2){v1[2], v1[3]});
                        v0 = (f32x4){a.x, a.y, b.x, b.y}; v1 = (f32x4){c.x, c.y, d.x, d.y}; }
                    v0 = v0 * sc; v1 = v1 * sc; u32x4 w; w.x = cvt_pk_bf16(v0[0], v0[1]); w.y = cvt_pk_bf16(v0[2], v0[3]); w.z = cvt_pk_bf16(v1[0], v1[1]); w.w = cvt_pk_bf16(v1[2], v1[3]);
                    *(u32x4*)(rowp + bj * HALF) = w; } }
    }
};

template <class Epi, class Sched, bool ALIGN_EPI = false, bool SP2 = false>
__device__ __forceinline__ void gemm_phase(PG8_LAS unsigned char* lds, const Gemm g, const Sched& S, const Epi& E) {
    const int tid = threadIdx.x, wid = __builtin_amdgcn_readfirstlane(tid >> 6), lane = tid & 63, wr = wid >> 2, wc = wid & 3, fr = lane & 15, fq = lane >> 4;
    const int K = g.K, nt = K / BK;
    unsigned voffA[2], voffB[2];
#pragma unroll
    for (int i = 0; i < 2; ++i) { int R, C; stage_rc(tid * 16 + i * 8192, R, C); const int Rb = Epi::PERM ? ((R & ~31) + perm32(R & 31)) : R;
        voffA[i] = (unsigned)(R * K + C) * 2u; voffB[i] = (unsigned)(Rb * K + C) * 2u; }
    const size_t kstep = (size_t)(BK * 2);
    const size_t hstep = (size_t)HALF * K * 2;
    const size_t tstep = 2 * hstep;
    const unsigned ldsw = (unsigned)wid * 1024u;
    const int aoff = lds_byte(wr * 64 + fr, fq * 8), boff = lds_byte(wc * 32 + fr, fq * 8);
#define PG8_SA(b, h) (((b) * 2 + (h)) * HTB)
#define PG8_SB(b, h) ((4 + (b) * 2 + (h)) * HTB)
#define PG8_STAGE(bufoff, gbase, voff) do { _Pragma("unroll") for (int _i = 0; _i < 2; ++_i) \
        __builtin_amdgcn_global_load_lds((const unsigned*)((const char*)(gbase) + (voff)[_i]), (PG8_LAS unsigned*)(lds + (bufoff) + ldsw + _i * 8192), 16, 0, 0); } while (0)
#define PG8_LDA(dst, b, h) do { _Pragma("unroll") for (int m = 0; m < 4; ++m) _Pragma("unroll") for (int k = 0; k < 2; ++k) dst[m][k] = *(const PG8_LAS bf16x8*)(lds + PG8_SA(b, h) + aoff + m * 2048 + k * 1024); } while (0)
#define PG8_LDB(dst, b, h) do { _Pragma("unroll") for (int n = 0; n < 2; ++n) _Pragma("unroll") for (int k = 0; k < 2; ++k) dst[n][k] = *(const PG8_LAS bf16x8*)(lds + PG8_SB(b, h) + boff + n * 2048 + k * 1024); } while (0)
#define PG8_MMA(ai, bj, At, Bt) do { __builtin_amdgcn_s_setprio(1); _Pragma("unroll") for (int m = 0; m < 4; ++m) _Pragma("unroll") for (int n = 0; n < 2; ++n) _Pragma("unroll") for (int k = 0; k < 2; ++k) \
        acc[ai][bj][m][n] = __builtin_amdgcn_mfma_f32_16x16x32_bf16(Bt[n][k], At[m][k], acc[ai][bj][m][n], 0, 0, 0); __builtin_amdgcn_s_setprio(0); } while (0)
#define PG8_WAIT_V(n) asm volatile("s_waitcnt vmcnt(" #n ")" ::: "memory")
#define PG8_WAIT_L(n) asm volatile("s_waitcnt lgkmcnt(" #n ")" ::: "memory")
#define PG8_BAR __builtin_amdgcn_s_barrier()
#define PG8_SCHED __builtin_amdgcn_sched_barrier(0)
    Unit cur, nxt; int ui = 0;
    if (!S.next(0, cur)) return;
    f32x4 acc[2][2][4][2];
#pragma unroll
    for (int a = 0; a < 2; ++a)
#pragma unroll
        for (int b = 0; b < 2; ++b)
#pragma unroll
            for (int m = 0; m < 4; ++m)
#pragma unroll
                for (int n = 0; n < 2; ++n) acc[a][b][m][n] = (f32x4){0.f, 0.f, 0.f, 0.f};
    bf16x8 At[4][2], B0[2][2], B1[2][2];
    const char* cA = (const char*)g.A + (size_t)cur.pm * tstep; const char* cB = (const char*)g.Bt + (size_t)cur.pn * tstep;
    S.a_ready(cur);
    if constexpr (SP2) {
        PG8_STAGE(PG8_SB(0, 0), cB, voffB); PG8_STAGE(PG8_SB(0, 1), cB + hstep, voffB); PG8_STAGE(PG8_SA(0, 0), cA, voffA); PG8_STAGE(PG8_SA(0, 1), cA + hstep, voffA);
        if (wr == 1) PG8_BAR;
        PG8_WAIT_V(2); PG8_BAR;
        PG8_STAGE(PG8_SB(1, 0), cB + kstep, voffB); PG8_STAGE(PG8_SA(1, 0), cA + kstep, voffA); PG8_STAGE(PG8_SB(1, 1), cB + hstep + kstep, voffB);
        PG8_WAIT_V(6); PG8_BAR;
    } else {
        PG8_STAGE(PG8_SB(0, 0), cB, voffB); PG8_STAGE(PG8_SA(0, 0), cA, voffA); PG8_STAGE(PG8_SB(0, 1), cB + hstep, voffB); PG8_STAGE(PG8_SA(0, 1), cA + hstep, voffA);
        if (wr == 1) PG8_BAR;
        PG8_WAIT_V(4); PG8_BAR;
        PG8_STAGE(PG8_SB(1, 0), cB + kstep, voffB); PG8_STAGE(PG8_SA(1, 0), cA + kstep, voffA); PG8_STAGE(PG8_SB(1, 1), cB + hstep + kstep, voffB);
        PG8_WAIT_V(6); PG8_BAR;
    }
    for (;;) {
        const bool has_next = S.next(ui + 1, nxt);
        const char* nA = has_next ? (const char*)g.A + (size_t)nxt.pm * tstep : cA; const char* nB = has_next ? (const char*)g.Bt + (size_t)nxt.pn * tstep : cB;
        for (int t = 0; t < nt; t += 2) {
            const bool last = (t == nt - 2);
            const char* a1 = cA + (size_t)(t + 1) * kstep;
            const char* a2 = last ? nA : cA + (size_t)(t + 2) * kstep; const char* b2 = last ? nB : cB + (size_t)(t + 2) * kstep;
            const char* a3 = a2 + kstep; const char* b3 = b2 + kstep;
            if (last && has_next) S.a_ready(nxt);
            if constexpr (SP2) {
            PG8_LDB(B0, 0, 0); PG8_LDB(B1, 0, 1); PG8_SCHED; PG8_LDA(At, 0, 0); PG8_STAGE(PG8_SA(1, 1), a1 + hstep, voffA);
            PG8_WAIT_V(8); PG8_WAIT_L(0); PG8_BAR; PG8_MMA(0, 0, At, B0); PG8_MMA(0, 1, At, B1); PG8_BAR; PG8_SCHED;
            PG8_LDA(At, 0, 1); PG8_STAGE(PG8_SB(0, 0), b2, voffB); PG8_STAGE(PG8_SB(0, 1), b2 + hstep, voffB); PG8_STAGE(PG8_SA(0, 0), a2, voffA);
            PG8_WAIT_V(8); PG8_WAIT_L(0); PG8_BAR; PG8_MMA(1, 0, At, B0); PG8_MMA(1, 1, At, B1); PG8_BAR; PG8_SCHED;
            PG8_LDB(B0, 1, 0); PG8_LDB(B1, 1, 1); PG8_SCHED; PG8_LDA(At, 1, 0); PG8_STAGE(PG8_SA(0, 1), a2 + hstep, voffA);
            PG8_WAIT_V(8); PG8_WAIT_L(0); PG8_BAR; PG8_MMA(0, 0, At, B0); PG8_MMA(0, 1, At, B1); PG8_BAR; PG8_SCHED;
            PG8_LDA(At, 1, 1); PG8_STAGE(PG8_SB(1, 0), b3, voffB); PG8_STAGE(PG8_SB(1, 1), b3 + hstep, voffB); PG8_STAGE(PG8_SA(1, 0), a3, voffA);
            PG8_WAIT_V(8); PG8_WAIT_L(0); PG8_BAR; PG8_MMA(1, 0, At, B0); PG8_MMA(1, 1, At, B1); PG8_BAR; PG8_SCHED;
            } else {
            PG8_LDB(B0, 0, 0); PG8_SCHED; PG8_LDA(At, 0, 0); PG8_STAGE(PG8_SA(1, 1), a1 + hstep, voffA);
            PG8_WAIT_L(8); PG8_BAR; PG8_WAIT_L(0); PG8_MMA(0, 0, At, B0); PG8_BAR; PG8_SCHED;
            PG8_LDB(B1, 0, 1); PG8_STAGE(PG8_SB(0, 0), b2, voffB);
            PG8_BAR; PG8_WAIT_L(0); PG8_MMA(0, 1, At, B1); PG8_BAR;
            PG8_LDA(At, 0, 1); PG8_STAGE(PG8_SA(0, 0), a2, voffA);
            PG8_BAR; PG8_WAIT_L(0); PG8_MMA(1, 0, At, B0); PG8_BAR; PG8_SCHED;
            PG8_STAGE(PG8_SB(0, 1), b2 + hstep, voffB);
            PG8_WAIT_V(6); PG8_BAR; PG8_MMA(1, 1, At, B1); PG8_BAR;
            PG8_LDB(B0, 1, 0); PG8_SCHED; PG8_LDA(At, 1, 0); PG8_STAGE(PG8_SA(0, 1), a2 + hstep, voffA);
            PG8_WAIT_L(8); PG8_BAR; PG8_WAIT_L(0); PG8_MMA(0, 0, At, B0); PG8_BAR; PG8_SCHED;
            PG8_LDB(B1, 1, 1); PG8_STAGE(PG8_SB(1, 0), b3, voffB);
            PG8_BAR; PG8_WAIT_L(0); PG8_MMA(0, 1, At, B1); PG8_BAR;
            PG8_LDA(At, 1, 1); PG8_STAGE(PG8_SA(1, 0), a3, voffA);
            PG8_BAR; PG8_WAIT_L(0); PG8_MMA(1, 0, At, B0); PG8_BAR; PG8_SCHED;
            PG8_STAGE(PG8_SB(1, 1), b3 + hstep, voffB);
            PG8_WAIT_V(6); PG8_BAR; PG8_MMA(1, 1, At, B1); PG8_BAR;
            }
        }
        if constexpr (ALIGN_EPI) { if (wr == 0) PG8_BAR; }
        if constexpr (!Epi::AFTER_DRAIN) { E(acc, cur, wr, wc, fr, fq); S.done(cur); }
        if (!has_next) break;
#pragma unroll
        for (int a = 0; a < 2; ++a)
#pragma unroll
            for (int b = 0; b < 2; ++b)
#pragma unroll
                for (int m = 0; m < 4; ++m)
#pragma unroll
                    for (int n = 0; n < 2; ++n) acc[a][b][m][n] = (f32x4){0.f, 0.f, 0.f, 0.f};
        cur = nxt; cA = nA; cB = nB; ++ui;
        if constexpr (ALIGN_EPI) { if (wr == 1) PG8_BAR; }
    }
    PG8_WAIT_V(0);
    if constexpr (!ALIGN_EPI) { if (wr == 0) PG8_BAR; }
    PG8_BAR;
    if constexpr (Epi::AFTER_DRAIN) { E.fused(acc, cur, wr, wc, fr, fq, lds, wid, lane); S.done(cur); }
#undef PG8_SA
#undef PG8_SB
#undef PG8_STAGE
#undef PG8_LDA
#undef PG8_LDB
#undef PG8_MMA
#undef PG8_WAIT_V
#undef PG8_WAIT_L
#undef PG8_BAR
#undef PG8_SCHED
}
}
#define GAS __attribute__((address_space(1)))
#define LAS __attribute__((address_space(3)))
typedef unsigned short bf16;
typedef unsigned v4u __attribute__((ext_vector_type(4)));
typedef float f32x4 __attribute__((ext_vector_type(4)));
typedef short bf16x8 __attribute__((ext_vector_type(8)));
typedef GAS unsigned gu32;
typedef GAS unsigned long long gu64;
#define RLX_AGENT __ATOMIC_RELAXED, __HIP_MEMORY_SCOPE_AGENT
#define LDS_WAIT() asm volatile("s_waitcnt lgkmcnt(0)" ::: "memory")
#define VM_WAIT() asm volatile("s_waitcnt vmcnt(0)" ::: "memory")
__device__ __forceinline__ unsigned long long rt() { return __builtin_amdgcn_s_memrealtime(); }
__device__ __forceinline__ unsigned f2bf(float f) { unsigned u = __builtin_bit_cast(unsigned, f); return (u + 0x7fffu + ((u >> 16) & 1u)) >> 16; }
__device__ __forceinline__ unsigned pk2(float lo, float hi) { return f2bf(lo) | (f2bf(hi) << 16); }

#define XB_TMO      128
#define XB_XCNT(j)  (256  + 64 * (j))
#define XB_XSUB(j)  (1280 + 64 * (j))
#define XB_XGEN(j)  (2304 + 64 * (j))
#define XB_TOP      3328
#define XB_TOPGEN   3392
#define XCD_BAR_WORDS 3456
#define XB_SPIN_CAP (1u << 18)

__device__ __forceinline__ unsigned xb_ld(unsigned* p)              { return __hip_atomic_load(p, __ATOMIC_RELAXED, __HIP_MEMORY_SCOPE_AGENT); }
__device__ __forceinline__ unsigned xb_add(unsigned* p, unsigned v) { return __hip_atomic_fetch_add(p, v, __ATOMIC_RELAXED, __HIP_MEMORY_SCOPE_AGENT); }
__device__ __forceinline__ unsigned xb_xcc_id() { return (unsigned)__builtin_amdgcn_s_getreg((3 << 11) | 20) & 0xFu; }
#define XB_SPIN(cond, bar) do { unsigned _sp = 0; while (cond) { __builtin_amdgcn_s_sleep(1); \
    if ((++_sp & 255u) == 0u) { if (xb_ld(&(bar)[XB_TMO])) break; if (_sp > XB_SPIN_CAP) { atomicAdd(&(bar)[XB_TMO], 1u); break; } } } } while (0)

struct XcdBarrier {
    unsigned* bar; unsigned x;
    volatile LAS unsigned* st;
};

__device__ __forceinline__ XcdBarrier xcd_barrier_post(unsigned* bar, volatile LAS unsigned* st) {
    XcdBarrier b; b.bar = bar; b.x = xb_xcc_id(); b.st = st;
    if (threadIdx.x == 0) (void)xb_add(&bar[XB_XCNT(b.x)], 1u);
    return b;
}
__device__ __forceinline__ void xcd_barrier_complete(unsigned* bar, unsigned x, unsigned& nloc, unsigned& nx) {
    const unsigned G = gridDim.x * gridDim.y * gridDim.z;
    unsigned sum, cnt, mine, sp = 0u;
    for (;;) {
        sum = 0u; cnt = 0u; mine = 0u;
#pragma unroll
        for (unsigned j = 0; j < 16; ++j) { const unsigned c = xb_ld(&bar[XB_XCNT(j)]); sum += c; cnt += (c > 0u) ? 1u : 0u; mine = (j == x) ? c : mine; }
        if (sum == G) break;
        __builtin_amdgcn_s_sleep(1);
        if ((++sp & 255u) == 0u) { if (xb_ld(&bar[XB_TMO])) break; if (sp > XB_SPIN_CAP) { atomicAdd(&bar[XB_TMO], 1u); break; } }
    }
    nloc = mine > 0u ? mine : 1u; nx = cnt > 0u ? cnt : 1u;
}

__device__ __forceinline__ void xcd_barrier(const XcdBarrier& b) {
    asm volatile("s_waitcnt vmcnt(0)" ::: "memory");
    __syncthreads();
    if (threadIdx.x == 0) {
        unsigned* bar = b.bar;
        __builtin_amdgcn_s_waitcnt(0);
        unsigned nloc = b.st[0], nx = b.st[1];
        if (nloc == 0u) { xcd_barrier_complete(bar, b.x, nloc, nx); b.st[0] = nloc; b.st[1] = nx; }
        const unsigned old = xb_add(&bar[XB_XSUB(b.x)], 1u);
        const unsigned gen = old / nloc;
        if (old + 1u == (gen + 1u) * nloc) {
            __builtin_amdgcn_fence(__ATOMIC_RELEASE, "agent");
            asm volatile("s_waitcnt vmcnt(0)" ::: "memory");
            const unsigned og = xb_add(&bar[XB_TOP], 1u);
            const unsigned tg = og / nx;
            if (og + 1u == (tg + 1u) * nx) xb_add(&bar[XB_TOPGEN], 1u);
            else XB_SPIN(xb_ld(&bar[XB_TOPGEN]) == tg, bar);
            __builtin_amdgcn_fence(__ATOMIC_ACQUIRE, "agent");
            xb_add(&bar[XB_XGEN(b.x)], 1u);
            asm volatile("s_waitcnt vmcnt(0)" ::: "memory");
        } else {
            XB_SPIN(xb_ld(&bar[XB_XGEN(b.x)]) == gen, bar);
            __builtin_amdgcn_fence(__ATOMIC_ACQUIRE, "agent");
            asm volatile("s_waitcnt vmcnt(0)" ::: "memory");
        }
    }
    __syncthreads();
}
constexpr int NWAVES = 8;
constexpr int D = 1024, BATCH = 8, SEQ = 2048, T = BATCH * SEQ;
constexpr int AW = 512, RW = 512, NH = 8;
constexpr int DL = 64, AL = 64, GL = 128;
constexpr int SHIFTW = 3 * RW + DL + AL + GL;
constexpr int INW = 3 * AW + SHIFTW;
constexpr int NKEYS = 128, PH = 8, PKD = 256, TOPK = 16, HK = PH * TOPK;
constexpr int QW = PH * PKD;
constexpr int MODW = 6 * D;

constexpr size_t MiB = 1u << 20;
constexpr size_t WS_CTL = 0, CTL_ZERO_BYTES = 1 * MiB;
constexpr size_t WS_MOD = 1 * MiB;
constexpr size_t WS_KEYS = 1 * MiB + 512 * 1024;
constexpr size_t WS_WIN = 2 * MiB;
constexpr size_t WS_WOUT = 9 * MiB;
constexpr size_t WS_WQ = 11 * MiB;
constexpr size_t WS_XN = 16 * MiB;
constexpr size_t WS_O3 = 16 * MiB;
constexpr size_t WS_LSE = 32 * MiB;
constexpr size_t WS_Z = 48 * MiB;
constexpr size_t WS_MIX = 152 * MiB;
constexpr size_t WS_Y = 184 * MiB;
constexpr size_t WS_Q = 48 * MiB;
constexpr size_t WS_IDX = 112 * MiB;
constexpr size_t WS_GATE = 120 * MiB;
constexpr size_t WS_PART = 48 * MiB;
constexpr size_t WS_UT = 152 * MiB;
constexpr size_t WS_SU = 168 * MiB;
constexpr size_t WS_VT = 184 * MiB;
constexpr size_t WS_BON = 248 * MiB;
constexpr size_t WS_END = 249 * MiB;
constexpr int CW_BAR = 4096;
constexpr int MAX_LAUNCHES = 12;

constexpr int RING_OFF = 0, RING_BYTES = 139264;
constexpr int LDSCTL_OFF = RING_BYTES, MISC_OFF = LDSCTL_OFF + 320;
constexpr int LDS_BYTES = 147456;
static_assert(MISC_OFF + 128 <= LDS_BYTES, "LDS map");

typedef GAS float gf32;
typedef GAS f32x4 gf32x4;

__device__ __forceinline__ float bf2f(bf16 v) { return __uint_as_float(((unsigned)v) << 16); }
__device__ __forceinline__ float wave_sum(float v) {
#pragma unroll
    for (int o = 1; o < 64; o <<= 1) v += __shfl_xor(v, o);
    return v;
}
#define WAVE_LDS_SYNC() do { asm volatile("s_waitcnt lgkmcnt(0)" ::: "memory"); __builtin_amdgcn_wave_barrier(); } while (0)

__device__ __forceinline__ void p0_transpose_item(const float* W, int K, int N, bf16* WT, int row_off, LAS float* scr, int item, int lane) {
    const int nblk = N / 32, kb = item / nblk, nb = item % nblk, k0 = 64 * kb, n0 = 32 * nb;
#pragma unroll 8
    for (int i = 0; i < 32; ++i) { const int kk = 2 * i + (lane >> 5); scr[kk * 33 + (lane & 31)] = W[(size_t)(k0 + kk) * N + n0 + (lane & 31)]; }
    LDS_WAIT(); asm volatile("" ::: "memory");
    const int c = lane & 7;
#pragma unroll
    for (int j = 0; j < 4; ++j) { const int n = (lane >> 3) + 8 * j; const LAS float* s = scr + (8 * c) * 33 + n;
        v4u o; o.x = pk2(s[0 * 33], s[1 * 33]); o.y = pk2(s[2 * 33], s[3 * 33]); o.z = pk2(s[4 * 33], s[5 * 33]); o.w = pk2(s[6 * 33], s[7 * 33]);
        *(GAS v4u*)(WT + (size_t)(row_off + n0 + n) * K + k0 + 8 * c) = o; }
    LDS_WAIT(); asm volatile("" ::: "memory");
}

__device__ __forceinline__ void norm_row(const float* xrow, const float* g, const float* modb, int shift_off, int scale_off, bf16* orow, int lane) {
    const GAS f32x4* xr = (const GAS f32x4*)xrow + lane;
    f32x4 v[4]; float s = 0.f;
#pragma unroll
    for (int j = 0; j < 4; ++j) { v[j] = xr[64 * j]; s += (v[j].x * v[j].x + v[j].y * v[j].y) + (v[j].z * v[j].z + v[j].w * v[j].w); }
    const float rs = 1.0f / sqrtf(wave_sum(s) * (1.f / D) + 1e-6f);
    GAS unsigned long long* o8 = (GAS unsigned long long*)orow + lane;
#pragma unroll
    for (int j = 0; j < 4; ++j) {
        const int col = 256 * j + 4 * lane;
        const f32x4 g4 = *(const GAS f32x4*)(g + col), sc = *(const GAS f32x4*)(modb + scale_off + col), sh = *(const GAS f32x4*)(modb + shift_off + col);
        const f32x4 y = v[j] * rs * g4 * (sc + 1.0f) + sh;
        o8[64 * j] = (unsigned long long)pk2(y.x, y.y) | ((unsigned long long)pk2(y.z, y.w) << 32);
    }
}

struct EpiRes {
    static constexpr bool PERM = false, AFTER_DRAIN = false;
    const float* xres; const float* mod; int gate_off; float* out; int ldc;
    __device__ __forceinline__ void operator()(const pg8::f32x4 (&acc)[2][2][4][2], const pg8::Unit& u, int wr, int wc, int fr, int fq) const {
        const int col0 = u.pn * pg8::BM + wc * 32 + 4 * fq;
        const int b = (u.pm * pg8::BM) / SEQ;
        pg8::f32x4 gv[2][2];
#pragma unroll
        for (int bj = 0; bj < 2; ++bj)
#pragma unroll
            for (int n = 0; n < 2; ++n) gv[bj][n] = *(const pg8::f32x4*)(mod + b * MODW + gate_off + col0 + bj * pg8::HALF + n * 16);
#pragma unroll
        for (int ai = 0; ai < 2; ++ai)
#pragma unroll
            for (int m = 0; m < 4; ++m) { const size_t off = (size_t)(u.pm * pg8::BM + ai * pg8::HALF + wr * 64 + m * 16 + fr) * ldc + col0;
#pragma unroll
                for (int bj = 0; bj < 2; ++bj)
#pragma unroll
                    for (int n = 0; n < 2; ++n) { const pg8::f32x4 bs = *(const pg8::f32x4*)(xres + off + bj * pg8::HALF + n * 16);
                        *(pg8::f32x4*)(out + off + bj * pg8::HALF + n * 16) = bs + gv[bj][n] * acc[ai][bj][m][n]; } }
    }
};

namespace scan {
typedef unsigned u32x2 __attribute__((ext_vector_type(2)));
constexpr int SLOT = 1024, BUF_BYTES = 12800, NBUF = 8;
constexpr int OFF_LORA = NBUF * BUF_BYTES;
constexpr int OFF_CONST = OFF_LORA + 16 * SLOT;
constexpr int OFF_MT = OFF_CONST + 4096;
constexpr int SCAN_LDS = OFF_MT + 8 * 1024;
static_assert(SCAN_LDS <= 139264, "scan LDS map");
constexpr int S_KK = 0, S_R = 2, S_MT = 4, S_N = 5, S_BK = 6, S_V = 10, S_GC = 12;

typedef float f32x2n __attribute__((ext_vector_type(2)));
typedef __bf16 bf16x2n __attribute__((ext_vector_type(2)));
__device__ __forceinline__ unsigned cvtpk(float lo, float hi) { const f32x2n v = {lo, hi}; const bf16x2n b = __builtin_convertvector(v, bf16x2n); return __builtin_bit_cast(unsigned, b); }
__device__ __forceinline__ bf16x8 mkfrag(unsigned a, unsigned b, unsigned c, unsigned d) { v4u w; w.x = a; w.y = b; w.z = c; w.w = d; return __builtin_bit_cast(bf16x8, w); }
__device__ __forceinline__ bf16x8 frag8(const float (&lo)[4], const float (&hi)[4]) { return mkfrag(cvtpk(lo[0], lo[1]), cvtpk(lo[2], lo[3]), cvtpk(hi[0], hi[1]), cvtpk(hi[2], hi[3])); }
__device__ __forceinline__ f32x4 mma(bf16x8 a, bf16x8 b, f32x4 c) { return __builtin_amdgcn_mfma_f32_16x16x32_bf16(a, b, c, 0, 0, 0); }
template <int N> __device__ __forceinline__ float row_shr(float x) { return __int_as_float(__builtin_amdgcn_update_dpp(0, __float_as_int(x), 0x110 + N, 0xf, 0xf, true)); }
__device__ __forceinline__ float fsigmoid(float x) { return __builtin_amdgcn_rcpf(1.0f + __expf(-x)); }
__device__ __forceinline__ bf16 tobf(float x) { return (bf16)(cvtpk(x, x) & 0xffffu); }

__device__ __forceinline__ void setup(LAS unsigned char* L, int h, int dir, const float* mu_prev, const float* mu_next, const float* w_decay0, const float* w_decay_up,
                                      const float* a_gate0, const float* a_gate_up, const float* k_k, const float* k_a, const float* r_k, int tid) {
    LAS float* C = (LAS float*)(L + OFF_CONST);
    for (int i = tid; i < 320; i += 512) {
        const int grp = i >> 6, c = i & 63;
        const int col = (grp < 3) ? grp * RW + h * 64 + c : 3 * RW + (grp - 3) * 64 + c;
        C[i] = mu_prev[col]; C[320 + i] = mu_next[col];
    }
    if (tid < 64) { const int hc = h * 64 + tid; C[640 + tid] = w_decay0[dir * RW + hc]; C[704 + tid] = a_gate0[dir * RW + hc]; C[768 + tid] = k_k[hc]; C[832 + tid] = k_a[hc]; C[896 + tid] = r_k[hc]; }
    LAS bf16* F = (LAS bf16*)(L + OFF_LORA);
    for (int i = tid; i < 16 * 64 * 8; i += 512) {
        const int j = i & 7, l = (i >> 3) & 63, sl = i >> 9, m = sl & 1, ct = (sl >> 1) & 3, wa = sl >> 3;
        const int g = l >> 4, jj = 32 * m + (j < 4 ? 4 * g + j : 16 + 4 * g + j - 4), c = h * 64 + 16 * ct + (l & 15);
        const float v = wa ? a_gate_up[(size_t)(dir * AL + jj) * RW + c] : w_decay_up[(size_t)(dir * DL + jj) * RW + c];
        F[i] = (bf16)f2bf(v);
    }
}

__device__ __forceinline__ void helper_chunk(LAS unsigned char* L, LAS unsigned char* buf, LAS float* MT, const bf16* Z, float* BON, int b, int h, int dir, int n, int lane) {
    const int s = lane & 15, g = lane >> 4;
    const int cn = dir ? (SEQ / 16 - 1 - n) : n;
    const int t = cn * 16 + (dir ? 15 - s : s), tok = b * SEQ + t;
    const LAS float* C = (const LAS float*)(L + OFF_CONST);
    const bool hasp = t > 0, hasn = t < SEQ - 1;
    const bf16* zrow = Z + (size_t)tok * INW + 3 * AW;
    float rv[4][4], kv[4][4], vv[4][4], tw[4][4], xa[4][4];
    u32x2 zc[5][4], ze[5][4];
    {
        const int te = (s == 0) ? (dir ? t + 1 : t - 1) : ((s == 15) ? (dir ? t - 1 : t + 1) : t);
        const int tec = te < 0 ? 0 : (te > SEQ - 1 ? SEQ - 1 : te);
        const bf16* erow = Z + (size_t)(b * SEQ + tec) * INW + 3 * AW;
#pragma unroll
        for (int grp = 0; grp < 5; ++grp) {
            const int cbase = (grp < 3) ? grp * RW + h * 64 : 3 * RW + (grp - 3) * 64;
#pragma unroll
            for (int ct = 0; ct < 4; ++ct) { zc[grp][ct] = *(const u32x2*)(zrow + cbase + 16 * ct + 4 * g); ze[grp][ct] = *(const u32x2*)(erow + cbase + 16 * ct + 4 * g); }
        }
    }
    __builtin_amdgcn_sched_barrier(0);
#pragma unroll
    for (int grp = 0; grp < 5; ++grp) {
#pragma unroll
        for (int ct = 0; ct < 4; ++ct) {
            const u32x2 zcc = zc[grp][ct], zee = ze[grp][ct];
            u32x2 lo, up;
            lo.x = (unsigned)__builtin_amdgcn_update_dpp((int)zee.x, (int)zcc.x, 0x111, 0xf, 0xf, false); lo.y = (unsigned)__builtin_amdgcn_update_dpp((int)zee.y, (int)zcc.y, 0x111, 0xf, 0xf, false);
            up.x = (unsigned)__builtin_amdgcn_update_dpp((int)zee.x, (int)zcc.x, 0x101, 0xf, 0xf, false); up.y = (unsigned)__builtin_amdgcn_update_dpp((int)zee.y, (int)zcc.y, 0x101, 0xf, 0xf, false);
            u32x2 zp = dir ? up : lo, zn = dir ? lo : up;
            if (!hasp) { zp.x = 0u; zp.y = 0u; } if (!hasn) { zn.x = 0u; zn.y = 0u; }
            const f32x4 mp = *(const LAS f32x4*)(C + grp * 64 + 16 * ct + 4 * g), mn = *(const LAS f32x4*)(C + 320 + grp * 64 + 16 * ct + 4 * g);
            float zv[4] = {__uint_as_float(zcc.x << 16), __uint_as_float(zcc.x & 0xffff0000u), __uint_as_float(zcc.y << 16), __uint_as_float(zcc.y & 0xffff0000u)};
            float pv[4] = {__uint_as_float(zp.x << 16), __uint_as_float(zp.x & 0xffff0000u), __uint_as_float(zp.y << 16), __uint_as_float(zp.y & 0xffff0000u)};
            float nv[4] = {__uint_as_float(zn.x << 16), __uint_as_float(zn.x & 0xffff0000u), __uint_as_float(zn.y << 16), __uint_as_float(zn.y & 0xffff0000u)};
#pragma unroll
            for (int r = 0; r < 4; ++r) {
                const float o = zv[r] + mp[r] * (pv[r] - zv[r]) + mn[r] * (nv[r] - zv[r]);
                if (grp == 0) rv[ct][r] = o; else if (grp == 1) kv[ct][r] = o; else if (grp == 2) vv[ct][r] = o;
                else if (grp == 3) { const float e2 = __expf(2.0f * o); tw[ct][r] = 1.0f - 2.0f * __builtin_amdgcn_rcpf(e2 + 1.0f); } else xa[ct][r] = o;
            }
        }
    }
#pragma unroll
    for (int ct = 0; ct < 4; ++ct)
#pragma unroll
        for (int r = 0; r < 4; ++r)
            *(LAS bf16*)(buf + (S_V + (ct >> 1)) * SLOT + (4 * g + r + 16 * (s >> 2)) * 16 + (ct & 1) * 8 + 2 * (s & 3)) = tobf(vv[ct][r]);
    f32x4 accw[4], acca[4];
    { const bf16x8 tb0 = frag8(tw[0], tw[1]), tb1 = frag8(tw[2], tw[3]), xb0 = frag8(xa[0], xa[1]), xb1 = frag8(xa[2], xa[3]);
      const LAS bf16x8* F = (const LAS bf16x8*)(L + OFF_LORA);
#pragma unroll
      for (int ct = 0; ct < 4; ++ct) {
          f32x4 z4 = {0.f, 0.f, 0.f, 0.f};
          accw[ct] = mma(F[(0 * 8 + ct * 2 + 0) * 64 + lane], tb0, z4); accw[ct] = mma(F[(0 * 8 + ct * 2 + 1) * 64 + lane], tb1, accw[ct]);
          acca[ct] = mma(F[(1 * 8 + ct * 2 + 0) * 64 + lane], xb0, z4); acca[ct] = mma(F[(1 * 8 + ct * 2 + 1) * 64 + lane], xb1, acca[ct]);
      } }
    float ev[4][4], kk[4][4], kd[4][4], bb[4][4];
    float ss = 0.f, bon = 0.f;
#pragma unroll
    for (int ct = 0; ct < 4; ++ct) {
        const f32x4 w0 = *(const LAS f32x4*)(C + 640 + 16 * ct + 4 * g), a0 = *(const LAS f32x4*)(C + 704 + 16 * ct + 4 * g), kkw = *(const LAS f32x4*)(C + 768 + 16 * ct + 4 * g),
                    kaw = *(const LAS f32x4*)(C + 832 + 16 * ct + 4 * g), rkw = *(const LAS f32x4*)(C + 896 + 16 * ct + 4 * g);
#pragma unroll
        for (int r = 0; r < 4; ++r) {
            ev[ct][r] = 0.60653065971f * fsigmoid(accw[ct][r] + w0[r]);
            const float a = fsigmoid(acca[ct][r] + a0[r]);
            const float k = kv[ct][r];
            kk[ct][r] = k * kkw[r]; ss += kk[ct][r] * kk[ct][r];
            kd[ct][r] = k * (1.0f + (a - 1.0f) * kaw[r]);
            bb[ct][r] = a;
            bon += rv[ct][r] * k * a * kaw[r] * rkw[r];
        }
    }
    ss += __shfl_xor(ss, 16); ss += __shfl_xor(ss, 32);
    bon += __shfl_xor(bon, 16); bon += __shfl_xor(bon, 32);
    if (g == 0) BON[((size_t)dir * T + tok) * NH + h] = bon;
    const float rn = __builtin_amdgcn_rsqf(fmaxf(ss, 1e-12f));
    float KKs[4][4], Rs[4][4], Bt[4][4], Kt[4][4];
#pragma unroll
    for (int ct = 0; ct < 4; ++ct) {
        float gcv[4];
#pragma unroll
        for (int r = 0; r < 4; ++r) {
            const float e = ev[ct][r];
            float cum = e;
            cum += row_shr<1>(cum); cum += row_shr<2>(cum); cum += row_shr<4>(cum); cum += row_shr<8>(cum);
            const float cumC = __shfl(cum, (lane & 48) | 15);
            const float kkn = kk[ct][r] * rn, bv = kkn * bb[ct][r];
            const float ig = __expf(cum), rat = __expf(cum - cumC);
            KKs[ct][r] = kkn * __expf(e - cum); Rs[ct][r] = rv[ct][r] * __expf(-cum);
            Bt[ct][r] = bv * ig; Kt[ct][r] = kd[ct][r] * ig;
            gcv[r] = __expf(-cumC);
            LAS unsigned char* q = buf + (S_BK + ct) * SLOT + (4 * g + r + 16 * (s >> 2)) * 16 + 2 * (s & 3);
            *(LAS bf16*)q = tobf(bv * rat); *(LAS bf16*)(q + 8) = tobf(kd[ct][r] * rat);
        }
        if (s == 15) *(LAS f32x4*)(buf + S_GC * SLOT + (16 * ct + 4 * g) * 4) = (f32x4){gcv[0], gcv[1], gcv[2], gcv[3]};
    }
    const bf16x8 fKK0 = frag8(KKs[0], KKs[1]), fKK1 = frag8(KKs[2], KKs[3]), fR0 = frag8(Rs[0], Rs[1]), fR1 = frag8(Rs[2], Rs[3]);
    const bf16x8 fB0 = frag8(Bt[0], Bt[1]), fB1 = frag8(Bt[2], Bt[3]), fK0 = frag8(Kt[0], Kt[1]), fK1 = frag8(Kt[2], Kt[3]);
    *(LAS bf16x8*)(buf + (S_KK + 0) * SLOT + lane * 16) = fKK0; *(LAS bf16x8*)(buf + (S_KK + 1) * SLOT + lane * 16) = fKK1;
    *(LAS bf16x8*)(buf + (S_R + 0) * SLOT + lane * 16) = fR0;  *(LAS bf16x8*)(buf + (S_R + 1) * SLOT + lane * 16) = fR1;
    const f32x4 z4 = {0.f, 0.f, 0.f, 0.f};
    { f32x4 mab = mma(fKK0, fB0, z4); mab = mma(fKK1, fB1, mab);
      *(LAS f32x4*)(MT + s * 16 + 4 * g) = mab; }
    f32x4 mak = mma(fK0, fKK0, z4); mak = mma(fK1, fKK1, mak);
    f32x4 nrb = mma(fB0, fR0, z4); nrb = mma(fB1, fR1, nrb);
    f32x4 nrk = mma(fK0, fR0, z4); nrk = mma(fK1, fR1, nrk);
#pragma unroll
    for (int r = 0; r < 4; ++r) { const int i = 4 * g + r; if (!(i < s)) mak[r] = 0.f; if (!(i <= s)) { nrb[r] = 0.f; nrk[r] = 0.f; } }
    *(LAS v4u*)(buf + S_N * SLOT + lane * 16) = (v4u){cvtpk(nrb[0], nrb[1]), cvtpk(nrb[2], nrb[3]), cvtpk(nrk[0], nrk[1]), cvtpk(nrk[2], nrk[3])};
    asm volatile("s_waitcnt lgkmcnt(0)" ::: "memory"); __builtin_amdgcn_wave_barrier();
    float Tr[16];
#pragma unroll
    for (int j = 15; j >= 0; --j) {
        float acc = 0.f;
#pragma unroll
        for (int i = j + 1; i < 16; ++i) acc += Tr[i] * MT[j * 16 + i];
        Tr[j] = (j == s) ? 1.0f : -acc;
        if (j > s) Tr[j] = 0.f;
    }
    float t0 = 0.f, t1 = 0.f, t2 = 0.f, t3 = 0.f;
#pragma unroll
    for (int gg = 0; gg < 4; ++gg) if (g == gg) { t0 = Tr[4 * gg]; t1 = Tr[4 * gg + 1]; t2 = Tr[4 * gg + 2]; t3 = Tr[4 * gg + 3]; }
    *(LAS v4u*)(buf + S_MT * SLOT + lane * 16) = (v4u){cvtpk(mak[0], mak[1]), cvtpk(mak[2], mak[3]), cvtpk(-t0, -t1), cvtpk(-t2, -t3)};
    asm volatile("s_waitcnt lgkmcnt(0)" ::: "memory"); __builtin_amdgcn_wave_barrier();
}

__device__ __forceinline__ void rec_chunk(const LAS unsigned char* buf, f32x4 (&st)[4], float* Y, int b, int h, int dir, int n, int w, int lane) {
    const int g = lane >> 4, col = lane & 15;
    const bf16x8 fKK0 = *(const LAS bf16x8*)(buf + (S_KK + 0) * SLOT + lane * 16), fKK1 = *(const LAS bf16x8*)(buf + (S_KK + 1) * SLOT + lane * 16);
    const bf16x8 fR0 = *(const LAS bf16x8*)(buf + (S_R + 0) * SLOT + lane * 16), fR1 = *(const LAS bf16x8*)(buf + (S_R + 1) * SLOT + lane * 16);
    const v4u mt = *(const LAS v4u*)(buf + S_MT * SLOT + lane * 16);
    const bf16x8 fN = *(const LAS bf16x8*)(buf + S_N * SLOT + lane * 16);
    const u32x2 vf = *(const LAS u32x2*)(buf + (S_V + (w >> 1)) * SLOT + lane * 16 + (w & 1) * 8);
    const f32x4 z4 = {0.f, 0.f, 0.f, 0.f};
    const bf16x8 sb0 = mkfrag(cvtpk(st[0][0], st[0][1]), cvtpk(st[0][2], st[0][3]), cvtpk(st[1][0], st[1][1]), cvtpk(st[1][2], st[1][3]));
    const bf16x8 sb1 = mkfrag(cvtpk(st[2][0], st[2][1]), cvtpk(st[2][2], st[2][3]), cvtpk(st[3][0], st[3][1]), cvtpk(st[3][2], st[3][3]));
    f32x4 p1 = mma(fKK0, sb0, z4); p1 = mma(fKK1, sb1, p1);
    f32x4 p2 = mma(fR0, sb0, z4); p2 = mma(fR1, sb1, p2);
    const f32x4 x = mma(mkfrag(0u, 0u, mt.x, mt.y), mkfrag(0u, 0u, vf.x, vf.y), p1);
    const f32x4 u = mma(mkfrag(mt.z, mt.w, 0u, 0u), mkfrag(cvtpk(x[0], x[1]), cvtpk(x[2], x[3]), 0u, 0u), z4);
    const bf16x8 buv = mkfrag(cvtpk(u[0], u[1]), cvtpk(u[2], u[3]), vf.x, vf.y);
    const f32x4 y = mma(fN, buv, p2);
#pragma unroll
    for (int i = 0; i < 4; ++i) {
        const f32x4 gc = *(const LAS f32x4*)(buf + S_GC * SLOT + (16 * i + 4 * g) * 4);
        const bf16x8 fBK = *(const LAS bf16x8*)(buf + (S_BK + i) * SLOT + lane * 16);
        st[i] = mma(fBK, buv, st[i] * gc);
    }
    const int cn = dir ? (SEQ / 16 - 1 - n) : n;
#pragma unroll
    for (int r = 0; r < 4; ++r) { const int s = 4 * g + r, t = cn * 16 + (dir ? 15 - s : s);
        Y[((size_t)dir * T + (size_t)(b * SEQ + t)) * RW + h * 64 + 16 * w + col] = y[r]; }
}

__device__ __forceinline__ void chain(LAS unsigned char* L, const bf16* Z, const float* mu_prev, const float* mu_next, const float* w_decay0, const float* w_decay_up,
                                      const float* a_gate0, const float* a_gate_up, const float* k_k, const float* k_a, const float* r_k, float* Y, float* BON, int ch, int tid, int wave, int lane) {
    const int dir = ch & 1, h = (ch >> 1) & 7, b = ch >> 4;
    __syncthreads();
    setup(L, h, dir, mu_prev, mu_next, w_decay0, w_decay_up, a_gate0, a_gate_up, k_k, k_a, r_k, tid);
    __syncthreads();
    f32x4 st[4];
#pragma unroll
    for (int i = 0; i < 4; ++i) st[i] = (f32x4){0.f, 0.f, 0.f, 0.f};
    constexpr int NCH = SEQ / 16, NR = NCH / 8;
    for (int q = 0; q < NR; ++q) {
        helper_chunk(L, L + wave * BUF_BYTES, (LAS float*)(L + OFF_MT + wave * 1024), Z, BON, b, h, dir, 8 * q + wave, lane);
        __syncthreads();
        if (wave < 4) {
#pragma unroll 1
            for (int i = 0; i < 8; ++i) rec_chunk(L + i * BUF_BYTES, st, Y, b, h, dir, 8 * q + i, wave, lane);
        }
        __syncthreads();
    }
}
}

namespace attn {
typedef unsigned u32x2 __attribute__((ext_vector_type(2)));
constexpr int VT_STRIDE = 136;
constexpr int KF_OFF = 64 * VT_STRIDE;
constexpr int WAVE_LDS = KF_OFF + 8 * 1024;
constexpr float LOG2E = 1.44269504088896f, LN2 = 0.693147180559945f;
using scan::cvtpk; using scan::mkfrag; using scan::mma;

__device__ __forceinline__ void unpack8(const v4u w, float (&f)[8]) {
    f[0] = __uint_as_float(w.x << 16); f[1] = __uint_as_float(w.x & 0xffff0000u); f[2] = __uint_as_float(w.y << 16); f[3] = __uint_as_float(w.y & 0xffff0000u);
    f[4] = __uint_as_float(w.z << 16); f[5] = __uint_as_float(w.z & 0xffff0000u); f[6] = __uint_as_float(w.w << 16); f[7] = __uint_as_float(w.w & 0xffff0000u);
}

__device__ __forceinline__ void unit(LAS unsigned char* vt, const bf16* Z, const float* qg, const float* kg, bf16* Ob, int opitch, float* lse_out,
                                     int b, int h, int d, int r, int qb, int nb, int lane) {
    const int g = lane >> 4, c16 = lane & 15;
    const float slope2 = exp2f(-(float)(h + 1)) * LOG2E * (float)d;
    float gn[16];
#pragma unroll
    for (int m = 0; m < 2; ++m)
#pragma unroll
        for (int j = 0; j < 8; ++j) gn[m * 8 + j] = qg[32 * m + 8 * g + j] * kg[32 * m + 8 * g + j];
    bf16x8 qf[4][2];
#pragma unroll
    for (int qt = 0; qt < 4; ++qt) {
        const int tok = b * SEQ + (qb * 64 + 16 * qt + c16) * d + r;
        const bf16* qp = Z + (size_t)tok * INW + h * 64 + 8 * g;
        float f0[8], f1[8]; unpack8(*(const v4u*)qp, f0); unpack8(*(const v4u*)(qp + 32), f1);
        float ss = 0.f;
#pragma unroll
        for (int j = 0; j < 8; ++j) ss += f0[j] * f0[j] + f1[j] * f1[j];
        ss += __shfl_xor(ss, 16); ss += __shfl_xor(ss, 32);
        const float rs = (0.125f * LOG2E) / sqrtf(ss * (1.f / 64.f) + 1e-6f);
        qf[qt][0] = mkfrag(cvtpk(f0[0] * rs * gn[0], f0[1] * rs * gn[1]), cvtpk(f0[2] * rs * gn[2], f0[3] * rs * gn[3]), cvtpk(f0[4] * rs * gn[4], f0[5] * rs * gn[5]), cvtpk(f0[6] * rs * gn[6], f0[7] * rs * gn[7]));
        qf[qt][1] = mkfrag(cvtpk(f1[0] * rs * gn[8], f1[1] * rs * gn[9]), cvtpk(f1[2] * rs * gn[10], f1[3] * rs * gn[11]), cvtpk(f1[4] * rs * gn[12], f1[5] * rs * gn[13]), cvtpk(f1[6] * rs * gn[14], f1[7] * rs * gn[15]));
    }
    f32x4 oacc[4][4];
    float mrun[4], lrun[4];
#pragma unroll
    for (int qt = 0; qt < 4; ++qt) { mrun[qt] = -1e30f; lrun[qt] = 0.f;
#pragma unroll
        for (int dt = 0; dt < 4; ++dt) oacc[dt][qt] = (f32x4){0.f, 0.f, 0.f, 0.f}; }
    const f32x4 z4 = {0.f, 0.f, 0.f, 0.f};
#pragma unroll 1
    for (int kb = qb - 1; kb <= qb + 1; ++kb) {
        if (kb < 0 || kb >= nb) continue;
#pragma unroll
        for (int kblk = 0; kblk < 4; ++kblk) {
            const int tok = b * SEQ + (kb * 64 + 16 * kblk + c16) * d + r;
            const bf16* kp = Z + (size_t)tok * INW + AW + h * 64 + 8 * g;
            float f0[8], f1[8]; unpack8(*(const v4u*)kp, f0); unpack8(*(const v4u*)(kp + 32), f1);
            float ss = 0.f;
#pragma unroll
            for (int j = 0; j < 8; ++j) ss += f0[j] * f0[j] + f1[j] * f1[j];
            ss += __shfl_xor(ss, 16); ss += __shfl_xor(ss, 32);
            const float rsk = 1.0f / sqrtf(ss * (1.f / 64.f) + 1e-6f);
            *(LAS v4u*)(vt + KF_OFF + (kblk * 2 + 0) * 1024 + lane * 16) = (v4u){cvtpk(f0[0] * rsk, f0[1] * rsk), cvtpk(f0[2] * rsk, f0[3] * rsk), cvtpk(f0[4] * rsk, f0[5] * rsk), cvtpk(f0[6] * rsk, f0[7] * rsk)};
            *(LAS v4u*)(vt + KF_OFF + (kblk * 2 + 1) * 1024 + lane * 16) = (v4u){cvtpk(f1[0] * rsk, f1[1] * rsk), cvtpk(f1[2] * rsk, f1[3] * rsk), cvtpk(f1[4] * rsk, f1[5] * rsk), cvtpk(f1[6] * rsk, f1[7] * rsk)};
        }
#pragma unroll
        for (int i = 0; i < 8; ++i) {
            const int key = 8 * i + (lane >> 3), chunk = lane & 7;
            const int tok = b * SEQ + (kb * 64 + key) * d + r;
            const v4u w = *(const v4u*)(Z + (size_t)tok * INW + 2 * AW + h * 64 + 8 * chunk);
            LAS unsigned char* q = vt + (8 * chunk) * VT_STRIDE + 2 * key;
            *(LAS bf16*)(q + 0 * VT_STRIDE) = (bf16)(w.x & 0xffffu); *(LAS bf16*)(q + 1 * VT_STRIDE) = (bf16)(w.x >> 16);
            *(LAS bf16*)(q + 2 * VT_STRIDE) = (bf16)(w.y & 0xffffu); *(LAS bf16*)(q + 3 * VT_STRIDE) = (bf16)(w.y >> 16);
            *(LAS bf16*)(q + 4 * VT_STRIDE) = (bf16)(w.z & 0xffffu); *(LAS bf16*)(q + 5 * VT_STRIDE) = (bf16)(w.z >> 16);
            *(LAS bf16*)(q + 6 * VT_STRIDE) = (bf16)(w.w & 0xffffu); *(LAS bf16*)(q + 7 * VT_STRIDE) = (bf16)(w.w >> 16);
        }
        asm volatile("s_waitcnt lgkmcnt(0)" ::: "memory"); __builtin_amdgcn_wave_barrier();
        const int obase = (kb - qb) * 64;
#pragma unroll
        for (int qt = 0; qt < 4; ++qt) {
            f32x4 sa[4];
#pragma unroll
            for (int kblk = 0; kblk < 4; ++kblk) {
                const bf16x8 k0 = *(const LAS bf16x8*)(vt + KF_OFF + (kblk * 2 + 0) * 1024 + lane * 16), k1 = *(const LAS bf16x8*)(vt + KF_OFF + (kblk * 2 + 1) * 1024 + lane * 16);
                sa[kblk] = mma(k0, qf[qt][0], z4); sa[kblk] = mma(k1, qf[qt][1], sa[kblk]); }
            const int qi = 16 * qt + c16;
            float mx = -1e30f;
#pragma unroll
            for (int kblk = 0; kblk < 4; ++kblk)
#pragma unroll
                for (int reg = 0; reg < 4; ++reg) {
                    const int o = obase + 16 * kblk + 4 * g + reg - qi, ao = o < 0 ? -o : o;
                    float sv = sa[kblk][reg] - slope2 * (float)ao;
                    sv = (ao <= 64) ? sv : -1e30f;
                    sa[kblk][reg] = sv; mx = fmaxf(mx, sv);
                }
            mx = fmaxf(mx, __shfl_xor(mx, 16)); mx = fmaxf(mx, __shfl_xor(mx, 32));
            const float mn = fmaxf(mrun[qt], mx), alpha = exp2f(mrun[qt] - mn);
            mrun[qt] = mn;
            float ls = 0.f;
#pragma unroll
            for (int kblk = 0; kblk < 4; ++kblk)
#pragma unroll
                for (int reg = 0; reg < 4; ++reg) { const float p = exp2f(sa[kblk][reg] - mn); sa[kblk][reg] = p; ls += p; }
            lrun[qt] = lrun[qt] * alpha + ls;
            const bf16x8 pf0 = mkfrag(cvtpk(sa[0][0], sa[0][1]), cvtpk(sa[0][2], sa[0][3]), cvtpk(sa[1][0], sa[1][1]), cvtpk(sa[1][2], sa[1][3]));
            const bf16x8 pf1 = mkfrag(cvtpk(sa[2][0], sa[2][1]), cvtpk(sa[2][2], sa[2][3]), cvtpk(sa[3][0], sa[3][1]), cvtpk(sa[3][2], sa[3][3]));
#pragma unroll
            for (int dt = 0; dt < 4; ++dt) {
                const LAS unsigned char* vr = vt + (16 * dt + c16) * VT_STRIDE + 8 * g;
                const u32x2 a0 = *(const LAS u32x2*)(vr), a1 = *(const LAS u32x2*)(vr + 32), a2 = *(const LAS u32x2*)(vr + 64), a3 = *(const LAS u32x2*)(vr + 96);
                f32x4 oc = oacc[dt][qt] * alpha;
                oc = mma(mkfrag(a0.x, a0.y, a1.x, a1.y), pf0, oc);
                oc = mma(mkfrag(a2.x, a2.y, a3.x, a3.y), pf1, oc);
                oacc[dt][qt] = oc;
            }
            __builtin_amdgcn_sched_barrier(0);
        }
        asm volatile("s_waitcnt lgkmcnt(0)" ::: "memory"); __builtin_amdgcn_wave_barrier();
    }
#pragma unroll
    for (int qt = 0; qt < 4; ++qt) {
        float lt = lrun[qt]; lt += __shfl_xor(lt, 16); lt += __shfl_xor(lt, 32);
        const float inv = 1.0f / lt;
        const int tok = b * SEQ + (qb * 64 + 16 * qt + c16) * d + r;
        bf16* op = Ob + (size_t)tok * opitch + h * 64 + 4 * g;
#pragma unroll
        for (int dt = 0; dt < 4; ++dt) { const f32x4 o = oacc[dt][qt] * inv; u32x2 w; w.x = cvtpk(o[0], o[1]); w.y = cvtpk(o[2], o[3]); *(u32x2*)(op + 16 * dt) = w; }
        if (g == 0) lse_out[(size_t)tok * NH + h] = (mrun[qt] + log2f(lt)) * LN2;
    }
}
}

namespace peer {
using scan::cvtpk; using scan::mkfrag; using scan::mma;
constexpr int KEY_SLOTS = 64;

template <int CTRL> __device__ __forceinline__ unsigned dppu(unsigned x) { return (unsigned)__builtin_amdgcn_update_dpp((int)x, (int)x, CTRL, 0xf, 0xf, false); }
__device__ __forceinline__ unsigned umax(unsigned a, unsigned b) { return a > b ? a : b; }
__device__ __forceinline__ unsigned rowmax16(unsigned x) { x = umax(x, dppu<0xB1>(x)); x = umax(x, dppu<0x4E>(x)); x = umax(x, dppu<0x141>(x)); x = umax(x, dppu<0x140>(x)); return x; }
__device__ __forceinline__ float rowsum16(float x) {
    x += __uint_as_float(dppu<0xB1>(__float_as_uint(x))); x += __uint_as_float(dppu<0x4E>(__float_as_uint(x)));
    x += __uint_as_float(dppu<0x141>(__float_as_uint(x))); x += __uint_as_float(dppu<0x140>(__float_as_uint(x))); return x;
}
__device__ __forceinline__ unsigned ordkey(float f) { const unsigned u = __float_as_uint(f); return (u & 0x80000000u) ? ~u : (u | 0x80000000u); }
__device__ __forceinline__ float unordkey(unsigned k) { return __uint_as_float((k & 0x80000000u) ? (k ^ 0x80000000u) : ~k); }

__device__ __forceinline__ void setup_keys(LAS unsigned char* L, const float* keys1, const float* keys2, int tid) {
    LAS bf16* F = (LAS bf16*)L;
    for (int i = tid; i < KEY_SLOTS * 64 * 8; i += 512) {
        const int j = i & 7, l = (i >> 3) & 63, sl = i >> 9, ks = sl & 3, nt = (sl >> 2) & 7, sel = sl >> 5;
        const int n = 16 * nt + (l & 15), k = 32 * ks + 8 * (l >> 4) + j;
        F[i] = (bf16)f2bf((sel ? keys2 : keys1)[n * 128 + k]);
    }
}

#define CE_(a, b) do { const unsigned hi_ = umax(a, b), lo_ = (a < b) ? a : b; a = hi_; b = lo_; } while (0)
__device__ __forceinline__ void top16(unsigned (&key)[8][4], unsigned (&win)[4], int c16) {
#pragma unroll
    for (int reg = 0; reg < 4; ++reg) {
        CE_(key[0][reg], key[1][reg]); CE_(key[2][reg], key[3][reg]); CE_(key[4][reg], key[5][reg]); CE_(key[6][reg], key[7][reg]);
        CE_(key[0][reg], key[2][reg]); CE_(key[1][reg], key[3][reg]); CE_(key[4][reg], key[6][reg]); CE_(key[5][reg], key[7][reg]);
        CE_(key[1][reg], key[2][reg]); CE_(key[5][reg], key[6][reg]);
        CE_(key[0][reg], key[4][reg]); CE_(key[1][reg], key[5][reg]); CE_(key[2][reg], key[6][reg]); CE_(key[3][reg], key[7][reg]);
        CE_(key[2][reg], key[4][reg]); CE_(key[3][reg], key[5][reg]);
        CE_(key[1][reg], key[2][reg]); CE_(key[3][reg], key[4][reg]); CE_(key[5][reg], key[6][reg]);
    }
#pragma unroll 1
    for (int k = 0; k < TOPK; ++k) {
#pragma unroll
        for (int reg = 0; reg < 4; ++reg) {
            const unsigned m = rowmax16(key[0][reg]);
            win[reg] = (c16 == k) ? m : win[reg];
            const bool pop = key[0][reg] == m;
#pragma unroll
            for (int nt = 0; nt < 7; ++nt) key[nt][reg] = pop ? key[nt + 1][reg] : key[nt][reg];
            key[7][reg] = pop ? 0u : key[7][reg];
        }
    }
}
#undef CE_

__device__ __forceinline__ void select_batch(const LAS unsigned char* L, const bf16* Q, int* IDX, float* GATE, int batch, int lane) {
    const int g = lane >> 4, c16 = lane & 15;
    const LAS bf16x8* F = (const LAS bf16x8*)L;
    const bf16* qp = Q + (size_t)(batch * 16 + c16) * PKD + 8 * g;
    unsigned w1[4] = {0u, 0u, 0u, 0u}, w2[4] = {0u, 0u, 0u, 0u};
#pragma unroll
    for (int sel = 0; sel < 2; ++sel) {
        unsigned key[8][4];
        bf16x8 a[4];
#pragma unroll
        for (int ks = 0; ks < 4; ++ks) a[ks] = *(const bf16x8*)(qp + sel * 128 + 32 * ks);
#pragma unroll
        for (int nt = 0; nt < 8; ++nt) {
            f32x4 sc = {0.f, 0.f, 0.f, 0.f};
#pragma unroll
            for (int ks = 0; ks < 4; ++ks) sc = mma(a[ks], F[((sel * 8 + nt) * 4 + ks) * 64 + lane], sc);
#pragma unroll
            for (int reg = 0; reg < 4; ++reg) key[nt][reg] = (ordkey(sc[reg]) & ~127u) | (unsigned)(16 * nt + c16);
            __builtin_amdgcn_sched_barrier(0);
        }
        if (sel == 0) top16(key, w1, c16); else top16(key, w2, c16);
    }
    float f1[4], f2[4], cur2[4]; int ptr[4]; unsigned top[4];
#pragma unroll
    for (int reg = 0; reg < 4; ++reg) { f1[reg] = unordkey(w1[reg] & ~127u); f2[reg] = unordkey(w2[reg] & ~127u); ptr[reg] = 0; cur2[reg] = __shfl(f2[reg], lane & 48); top[reg] = 0u; }
#pragma unroll 1
    for (int k = 0; k < TOPK; ++k) {
#pragma unroll
        for (int reg = 0; reg < 4; ++reg) {
            const unsigned ck = (ptr[reg] < 16) ? ((ordkey(f1[reg] + cur2[reg]) & ~255u) | (unsigned)(c16 << 4) | (unsigned)ptr[reg]) : 0u;
            const unsigned m = rowmax16(ck);
            top[reg] = (c16 == k) ? m : top[reg];
            if ((int)((m >> 4) & 15u) == c16) ptr[reg] += 1;
            cur2[reg] = __shfl(f2[reg], (lane & 48) | (ptr[reg] & 15));
        }
    }
#pragma unroll
    for (int reg = 0; reg < 4; ++reg) {
        const int a = (top[reg] >> 4) & 15, bq = top[reg] & 15;
        const int e1 = (int)(__shfl(w1[reg], (lane & 48) | a) & 127u), e2 = (int)(__shfl(w2[reg], (lane & 48) | bq) & 127u);
        const float ts = unordkey(top[reg] & ~255u), mx = __shfl(ts, lane & 48);
        const float ex = __expf(ts - mx), sum = rowsum16(ex);
        const size_t o = (size_t)(batch * 16 + 4 * g + reg) * TOPK + c16;
        IDX[o] = e1 * NKEYS + e2; GATE[o] = ex / sum;
    }
}

__device__ __forceinline__ void convert_table(const float* src, bf16* dst, size_t n8, size_t gtid, size_t gthreads) {
    for (size_t i = gtid; i < n8; i += gthreads) {
        const f32x4 a = *(const f32x4*)(src + i * 8), b = *(const f32x4*)(src + i * 8 + 4);
        v4u o; o.x = cvtpk(a.x, a.y); o.y = cvtpk(a.z, a.w); o.z = cvtpk(b.x, b.y); o.w = cvtpk(b.z, b.w);
        *(v4u*)(dst + i * 8) = o;
    }
}

__device__ __forceinline__ float dot2bf(unsigned w, unsigned x, float acc) {
    typedef __bf16 bf2 __attribute__((ext_vector_type(2)));
    return __builtin_amdgcn_fdot2_f32_bf16(__builtin_bit_cast(bf2, w), __builtin_bit_cast(bf2, x), acc, false);
}
__device__ __forceinline__ float gelu_erf(float v) {
    const float av = fabsf(v), t = __builtin_amdgcn_rcpf(av * 0.2316418882f + 1.0f);
    float q = t * 0.5307027145f + (-0.7265760135f); q = q * t + 0.7107068705f; q = q * t + (-0.142248368f); q = q * t + 0.127414796f; q = q * t;
    const float e = __builtin_amdgcn_exp2f((v * v) * (-0.72134752044f));
    const float m = v * (q * e);
    return v < 0.f ? m : v - m;
}

typedef float f32x2c __attribute__((ext_vector_type(2)));
__device__ __forceinline__ void convert_rows_fp8(const float* src, unsigned char* dst, float* scale, int rows, int gw, int ngw, int lane) {
    for (int rrow = gw; rrow < rows; rrow += ngw) {
        const float* p = src + (size_t)rrow * D + 16 * lane;
        const f32x4 a = *(const f32x4*)p, b = *(const f32x4*)(p + 4), c = *(const f32x4*)(p + 8), d = *(const f32x4*)(p + 12);
        float m = fmaxf(fmaxf(fmaxf(fabsf(a.x), fabsf(a.y)), fmaxf(fabsf(a.z), fabsf(a.w))), fmaxf(fmaxf(fabsf(b.x), fabsf(b.y)), fmaxf(fabsf(b.z), fabsf(b.w))));
        m = fmaxf(m, fmaxf(fmaxf(fmaxf(fabsf(c.x), fabsf(c.y)), fmaxf(fabsf(c.z), fabsf(c.w))), fmaxf(fmaxf(fabsf(d.x), fabsf(d.y)), fmaxf(fabsf(d.z), fabsf(d.w)))));
#pragma unroll
        for (int o = 1; o < 64; o <<= 1) m = fmaxf(m, __shfl_xor(m, o));
        m = fmaxf(m, 1e-30f);
        const float inv = 448.0f / m;
        v4u w;
        w.x = (unsigned)__builtin_amdgcn_cvt_pk_fp8_f32(a.z * inv, a.w * inv, __builtin_amdgcn_cvt_pk_fp8_f32(a.x * inv, a.y * inv, 0, false), true);
        w.y = (unsigned)__builtin_amdgcn_cvt_pk_fp8_f32(b.z * inv, b.w * inv, __builtin_amdgcn_cvt_pk_fp8_f32(b.x * inv, b.y * inv, 0, false), true);
        w.z = (unsigned)__builtin_amdgcn_cvt_pk_fp8_f32(c.z * inv, c.w * inv, __builtin_amdgcn_cvt_pk_fp8_f32(c.x * inv, c.y * inv, 0, false), true);
        w.w = (unsigned)__builtin_amdgcn_cvt_pk_fp8_f32(d.z * inv, d.w * inv, __builtin_amdgcn_cvt_pk_fp8_f32(d.x * inv, d.y * inv, 0, false), true);
        *(v4u*)(dst + (size_t)rrow * D + 16 * lane) = w;
        if (lane == 0) scale[rrow] = m * (1.0f / 448.0f);
    }
}
__device__ __forceinline__ float sum8(float x) {
    x += __uint_as_float(dppu<0xB1>(__float_as_uint(x))); x += __uint_as_float(dppu<0x4E>(__float_as_uint(x))); x += __uint_as_float(dppu<0x141>(__float_as_uint(x))); return x;
}
__device__ __forceinline__ float dot16_fp8(const v4u q, const float (&x)[16]) {
    float d = 0.f;
    const f32x2c a0 = __builtin_amdgcn_cvt_pk_f32_fp8((int)q.x, false), a1 = __builtin_amdgcn_cvt_pk_f32_fp8((int)q.x, true), b0 = __builtin_amdgcn_cvt_pk_f32_fp8((int)q.y, false), b1 = __builtin_amdgcn_cvt_pk_f32_fp8((int)q.y, true);
    const f32x2c c0 = __builtin_amdgcn_cvt_pk_f32_fp8((int)q.z, false), c1 = __builtin_amdgcn_cvt_pk_f32_fp8((int)q.z, true), d0 = __builtin_amdgcn_cvt_pk_f32_fp8((int)q.w, false), d1 = __builtin_amdgcn_cvt_pk_f32_fp8((int)q.w, true);
    d += a0.x * x[0]; d += a0.y * x[1]; d += a1.x * x[2]; d += a1.y * x[3]; d += b0.x * x[4]; d += b0.y * x[5]; d += b1.x * x[6]; d += b1.y * x[7];
    d += c0.x * x[8]; d += c0.y * x[9]; d += c1.x * x[10]; d += c1.y * x[11]; d += d0.x * x[12]; d += d0.y * x[13]; d += d1.x * x[14]; d += d1.y * x[15];
    return d;
}
__device__ __forceinline__ void axpy16_fp8(const v4u q, float cf, float (&y)[16]) {
    const f32x2c a0 = __builtin_amdgcn_cvt_pk_f32_fp8((int)q.x, false), a1 = __builtin_amdgcn_cvt_pk_f32_fp8((int)q.x, true), b0 = __builtin_amdgcn_cvt_pk_f32_fp8((int)q.y, false), b1 = __builtin_amdgcn_cvt_pk_f32_fp8((int)q.y, true);
    const f32x2c c0 = __builtin_amdgcn_cvt_pk_f32_fp8((int)q.z, false), c1 = __builtin_amdgcn_cvt_pk_f32_fp8((int)q.z, true), d0 = __builtin_amdgcn_cvt_pk_f32_fp8((int)q.w, false), d1 = __builtin_amdgcn_cvt_pk_f32_fp8((int)q.w, true);
    y[0] += cf * a0.x; y[1] += cf * a0.y; y[2] += cf * a1.x; y[3] += cf * a1.y; y[4] += cf * b0.x; y[5] += cf * b0.y; y[6] += cf * b1.x; y[7] += cf * b1.y;
    y[8] += cf * c0.x; y[9] += cf * c0.y; y[10] += cf * c1.x; y[11] += cf * c1.y; y[12] += cf * d0.x; y[13] += cf * d0.y; y[14] += cf * d1.x; y[15] += cf * d1.y;
}

#define FFN_X16(x, xw0, xw1) float x[16]; \
        x[0] = __uint_as_float(xw0.x << 16); x[1] = __uint_as_float(xw0.x & 0xffff0000u); x[2] = __uint_as_float(xw0.y << 16); x[3] = __uint_as_float(xw0.y & 0xffff0000u); \
        x[4] = __uint_as_float(xw0.z << 16); x[5] = __uint_as_float(xw0.z & 0xffff0000u); x[6] = __uint_as_float(xw0.w << 16); x[7] = __uint_as_float(xw0.w & 0xffff0000u); \
        x[8] = __uint_as_float(xw1.x << 16); x[9] = __uint_as_float(xw1.x & 0xffff0000u); x[10] = __uint_as_float(xw1.y << 16); x[11] = __uint_as_float(xw1.y & 0xffff0000u); \
        x[12] = __uint_as_float(xw1.z << 16); x[13] = __uint_as_float(xw1.z & 0xffff0000u); x[14] = __uint_as_float(xw1.w << 16); x[15] = __uint_as_float(xw1.w & 0xffff0000u);
#define FFN_ISSUE_U(q, idv) do { _Pragma("unroll") for (int i = 0; i < 8; ++i) { const int ex_ = __shfl(idv, 8 * i + eg); \
            q[i] = *(const v4u*)(UT8 + (size_t)ex_ * D + 128 * sl + 16 * ch); } } while (0)
#define FFN_DOT_U(q, x, r) do { _Pragma("unroll") for (int i = 0; i < 8; ++i) { const float dot_ = sum8(dot16_fp8(q[i], x)); if (ch == i) r = dot_; } } while (0)
__device__ __forceinline__ void ffn_u_pass(const bf16* XN, const int* IDX, const unsigned char* UT8, float* PART, int sl, int wv, int nwv, int lane) {
    const int eg = lane >> 3, ch = lane & 7;
    v4u qA[8], qB[8];
    int t = wv; if (t >= T) return;
    int i0 = IDX[(size_t)t * HK + lane], i1 = IDX[(size_t)t * HK + 64 + lane], n0 = 0, n1 = 0;
    v4u x0 = *(const v4u*)(XN + (size_t)t * D + 128 * sl + 16 * ch), x1 = *(const v4u*)(XN + (size_t)t * D + 128 * sl + 16 * ch + 8), xn0 = x0, xn1 = x1;
    FFN_ISSUE_U(qA, i0);
#pragma unroll 1
    for (;;) {
        const int tn = t + nwv; const bool more = tn < T;
        if (more) { n0 = IDX[(size_t)tn * HK + lane]; n1 = IDX[(size_t)tn * HK + 64 + lane]; const bf16* xp = XN + (size_t)tn * D + 128 * sl + 16 * ch; xn0 = *(const v4u*)xp; xn1 = *(const v4u*)(xp + 8); }
        FFN_ISSUE_U(qB, i1);
        float r0 = 0.f, r1 = 0.f;
        { FFN_X16(x, x0, x1) FFN_DOT_U(qA, x, r0); }
        if (more) FFN_ISSUE_U(qA, n0);
        { FFN_X16(x, x0, x1) FFN_DOT_U(qB, x, r1); }
        float* pp = PART + ((size_t)sl * T + t) * HK + 8 * ch + eg; pp[0] = r0; pp[64] = r1;
        if (!more) break;
        i0 = n0; i1 = n1; x0 = xn0; x1 = xn1; t = tn;
    }
}
#define FFN_ISSUE_V(q, cf, idv, cv) do { _Pragma("unroll") for (int i = 0; i < 8; ++i) { const int ex_ = __shfl(idv, 8 * i + eg); cf[i] = __shfl(cv, 8 * i + eg); \
            q[i] = *(const v4u*)(VT8 + (size_t)ex_ * D + 128 * sl + 16 * ch); } } while (0)
__device__ __forceinline__ void ffn_v_pass(const int* IDX, const float* COEF, const unsigned char* VT8, const float* mod, float* out, int sl, int wv, int nwv, int lane) {
    const int eg = lane >> 3, ch = lane & 7, col = 128 * sl + 16 * ch;
    v4u qA[8], qB[8]; float cfA[8], cfB[8];
    int t = wv; if (t >= T) return;
    int i0 = IDX[(size_t)t * HK + lane], i1 = IDX[(size_t)t * HK + 64 + lane], n0 = 0, n1 = 0;
    float c0 = COEF[(size_t)t * HK + lane], c1 = COEF[(size_t)t * HK + 64 + lane], cn0 = 0.f, cn1 = 0.f;
    FFN_ISSUE_V(qA, cfA, i0, c0);
#pragma unroll 1
    for (;;) {
        const int tn = t + nwv; const bool more = tn < T;
        if (more) { n0 = IDX[(size_t)tn * HK + lane]; n1 = IDX[(size_t)tn * HK + 64 + lane]; cn0 = COEF[(size_t)tn * HK + lane]; cn1 = COEF[(size_t)tn * HK + 64 + lane]; }
        FFN_ISSUE_V(qB, cfB, i1, c1);
        const size_t o = (size_t)t * D + col; const int b = t / SEQ;
        f32x4 oa[4];
#pragma unroll
        for (int k4 = 0; k4 < 4; ++k4) oa[k4] = *(const f32x4*)(out + o + 4 * k4);
        float y[16];
#pragma unroll
        for (int k = 0; k < 16; ++k) y[k] = 0.f;
#pragma unroll
        for (int i = 0; i < 8; ++i) { axpy16_fp8(qA[i], cfA[i], y); if (i & 1) __builtin_amdgcn_sched_barrier(0); }
        if (more) FFN_ISSUE_V(qA, cfA, n0, cn0);
#pragma unroll
        for (int i = 0; i < 8; ++i) { axpy16_fp8(qB[i], cfB[i], y); if (i & 1) __builtin_amdgcn_sched_barrier(0); }
#pragma unroll
        for (int k = 0; k < 16; ++k) { y[k] += __uint_as_float(dppu<0x128>(__float_as_uint(y[k]))); y[k] += __shfl_xor(y[k], 16); y[k] += __shfl_xor(y[k], 32); }
        if (eg == 0) {
#pragma unroll
            for (int k4 = 0; k4 < 4; ++k4) { f32x4 w = oa[k4]; const f32x4 ga = *(const f32x4*)(mod + b * MODW + 5 * D + col + 4 * k4);
                w.x += ga.x * y[4 * k4]; w.y += ga.y * y[4 * k4 + 1]; w.z += ga.z * y[4 * k4 + 2]; w.w += ga.w * y[4 * k4 + 3]; *(f32x4*)(out + o + 4 * k4) = w; } }
        if (!more) break;
        i0 = n0; i1 = n1; c0 = cn0; c1 = cn1; t = tn;
    }
}
}

namespace fin {
using scan::cvtpk; using scan::mkfrag; using scan::mma;
typedef unsigned u32x2 __attribute__((ext_vector_type(2)));

__device__ __forceinline__ float shift3(const bf16* p, bool hasp, bool hasn, float mp, float mn) {
    const float z = bf2f(p[0]), zp = hasp ? bf2f(p[-INW]) : 0.f, zn = hasn ? bf2f(p[INW]) : 0.f;
    return z + mp * (zp - z) + mn * (zn - z);
}

__device__ __forceinline__ void unpack4(const u32x2 w, float (&f)[4]) {
    f[0] = __uint_as_float(w.x << 16); f[1] = __uint_as_float(w.x & 0xffff0000u); f[2] = __uint_as_float(w.y << 16); f[3] = __uint_as_float(w.y & 0xffff0000u);
}
__device__ __forceinline__ void phase(LAS unsigned char* L, const bf16* Z, const float* mu_prev, const float* mu_next, const float* g_up, const float* Y, const float* BON,
                                      const float* k_a, const float* r_k, const float* lnx_g, const float* lnx_b, bf16* mix, const bf16* O3, const float* LSE,
                                      int bx, int G, int tid, int wave, int lane) {
    const int g = lane >> 4, c16 = lane & 15, ch0 = 64 * wave + 4 * c16;
    LAS bf16* sg = (LAS bf16*)L;
    bf16x8 bf[4][4];
#pragma unroll
    for (int ks = 0; ks < 4; ++ks) {
        f32x4 rowv[8];
#pragma unroll
        for (int jj = 0; jj < 8; ++jj) rowv[jj] = *(const f32x4*)(g_up + (size_t)(32 * ks + 8 * g + jj) * RW + ch0);
#pragma unroll
        for (int nt = 0; nt < 4; ++nt) bf[nt][ks] = mkfrag(cvtpk(rowv[0][nt], rowv[1][nt]), cvtpk(rowv[2][nt], rowv[3][nt]), cvtpk(rowv[4][nt], rowv[5][nt]), cvtpk(rowv[6][nt], rowv[7][nt]));
    }
    const f32x4 mpr = *(const f32x4*)(mu_prev + ch0), mnr = *(const f32x4*)(mu_next + ch0), mpk = *(const f32x4*)(mu_prev + RW + ch0), mnk = *(const f32x4*)(mu_next + RW + ch0),
                mpv = *(const f32x4*)(mu_prev + 2 * RW + ch0), mnv = *(const f32x4*)(mu_next + 2 * RW + ch0);
    const f32x4 ka1 = *(const f32x4*)(k_a + ch0), rk1 = *(const f32x4*)(r_k + ch0), lg = *(const f32x4*)(lnx_g + ch0), lb = *(const f32x4*)(lnx_b + ch0);
    const int j0 = (tid & 31) * 4;
    const f32x4 mpg = *(const f32x4*)(mu_prev + 3 * RW + DL + AL + j0), mng = *(const f32x4*)(mu_next + 3 * RW + DL + AL + j0);
    for (int tb = bx; tb < T / 16; tb += G) {
        const int tok0 = tb * 16;
        __syncthreads();
        {
            const int tl = tid >> 5, tok = tok0 + tl, t = tok % SEQ;
            const bf16* p = Z + (size_t)tok * INW + 3 * AW + 3 * RW + DL + AL + j0;
            const bool hasp = t > 0, hasn = t < SEQ - 1;
            float zc[4], zp[4], zn[4];
            unpack4(*(const u32x2*)p, zc); unpack4(*(const u32x2*)(hasp ? p - INW : p), zp); unpack4(*(const u32x2*)(hasn ? p + INW : p), zn);
            float o[4];
#pragma unroll
            for (int e = 0; e < 4; ++e) { const float pv = hasp ? zp[e] : 0.f, nv = hasn ? zn[e] : 0.f; const float v = zc[e] + mpg[e] * (pv - zc[e]) + mng[e] * (nv - zc[e]); o[e] = __builtin_amdgcn_rcpf(1.0f + __expf(-v)); }
            u32x2 w; w.x = cvtpk(o[0], o[1]); w.y = cvtpk(o[2], o[3]);
            *(LAS u32x2*)(sg + tl * 128 + j0) = w;
        }
        __syncthreads();
        f32x4 ga[4];
        {
            bf16x8 af[4];
#pragma unroll
            for (int ks = 0; ks < 4; ++ks) af[ks] = *(const LAS bf16x8*)(sg + c16 * 128 + 32 * ks + 8 * g);
#pragma unroll
            for (int nt = 0; nt < 4; ++nt) { f32x4 a = {0.f, 0.f, 0.f, 0.f};
#pragma unroll
                for (int ks = 0; ks < 4; ++ks) a = mma(af[ks], bf[nt][ks], a);
                ga[nt] = a; }
        }
#pragma unroll
        for (int reg = 0; reg < 4; ++reg) {
            const int tok = tok0 + 4 * g + reg, t = tok % SEQ;
            const bool hasp = t > 0, hasn = t < SEQ - 1;
            const bf16* zr = Z + (size_t)tok * INW + 3 * AW + ch0;
            const size_t o = (size_t)tok * RW + ch0;
            const f32x4 y0 = *(const f32x4*)(Y + o), y1 = *(const f32x4*)(Y + (size_t)T * RW + o);
            float rc[4], rp[4], rn[4], kc[4], kp[4], kn[4], vc[4], vp[4], vn[4];
            unpack4(*(const u32x2*)zr, rc); unpack4(*(const u32x2*)(hasp ? zr - INW : zr), rp); unpack4(*(const u32x2*)(hasn ? zr + INW : zr), rn);
            unpack4(*(const u32x2*)(zr + RW), kc); unpack4(*(const u32x2*)(hasp ? zr + RW - INW : zr + RW), kp); unpack4(*(const u32x2*)(hasn ? zr + RW + INW : zr + RW), kn);
            unpack4(*(const u32x2*)(zr + 2 * RW), vc); unpack4(*(const u32x2*)(hasp ? zr + 2 * RW - INW : zr + 2 * RW), vp); unpack4(*(const u32x2*)(hasn ? zr + 2 * RW + INW : zr + 2 * RW), vn);
            bf16* mp = mix + (size_t)tok * D + ch0;
            float o1[4], o2[4], o3[4];
            unpack4(*(const u32x2*)mp, o1); unpack4(*(const u32x2*)(mp + AW), o2); unpack4(*(const u32x2*)(O3 + (size_t)tok * AW + ch0), o3);
            const float l1 = LSE[(size_t)tok * NH + wave], l2 = LSE[((size_t)T + tok) * NH + wave], l3 = LSE[((size_t)2 * T + tok) * NH + wave];
            const float bon = BON[(size_t)tok * NH + wave] + BON[((size_t)T + tok) * NH + wave];
            float yv[4], vv[4], s1 = 0.f, sb = 0.f;
#pragma unroll
            for (int nt = 0; nt < 4; ++nt) {
                yv[nt] = y0[nt] + y1[nt]; s1 += yv[nt];
                const float pr = hasp ? rp[nt] : 0.f, nr = hasn ? rn[nt] : 0.f, pk = hasp ? kp[nt] : 0.f, nk = hasn ? kn[nt] : 0.f, pvv = hasp ? vp[nt] : 0.f, nvv = hasn ? vn[nt] : 0.f;
                const float rr = rc[nt] + mpr[nt] * (pr - rc[nt]) + mnr[nt] * (nr - rc[nt]);
                const float kk = kc[nt] + mpk[nt] * (pk - kc[nt]) + mnk[nt] * (nk - kc[nt]);
                vv[nt] = vc[nt] + mpv[nt] * (pvv - vc[nt]) + mnv[nt] * (nvv - vc[nt]);
                sb += rr * kk * rk1[nt] * (1.0f - ka1[nt]);
            }
            const float mean = peer::rowsum16(s1) * (1.f / 64.f);
            float s2 = 0.f;
#pragma unroll
            for (int nt = 0; nt < 4; ++nt) s2 += (yv[nt] - mean) * (yv[nt] - mean);
            const float rstd = __builtin_amdgcn_rsqf(peer::rowsum16(s2) * (1.f / 64.f) + 64e-5f);
            const float bs = peer::rowsum16(sb) + 0.5f * bon;
            const float lm = fmaxf(l1, fmaxf(l2, l3)), w1 = __expf(l1 - lm), w2 = __expf(l2 - lm), w3 = __expf(l3 - lm), wi = __builtin_amdgcn_rcpf(w1 + w2 + w3);
            float att[4], rw[4];
#pragma unroll
            for (int nt = 0; nt < 4; ++nt) {
                att[nt] = (w1 * o1[nt] + w2 * o2[nt] + w3 * o3[nt]) * wi;
                rw[nt] = ((yv[nt] - mean) * rstd * lg[nt] + lb[nt] + bs * vv[nt]) * ga[nt][reg];
            }
            u32x2 wa, wr; wa.x = cvtpk(att[0], att[1]); wa.y = cvtpk(att[2], att[3]); wr.x = cvtpk(rw[0], rw[1]); wr.y = cvtpk(rw[2], rw[3]);
            *(u32x2*)mp = wa; *(u32x2*)(mp + AW) = wr;
        }
    }
}
}

#ifndef MK_SKIP
#define MK_SKIP 0
#endif
constexpr int N_PHASES = 12;
struct Args { const float* in[27]; float* out; unsigned char* ws; int ph_lo, ph_hi, li, pad; };

__global__ void __launch_bounds__(NWAVES * 64, 2) mk_fwd(Args args) {
    extern __shared__ __attribute__((aligned(16))) unsigned char lds[];
    LAS unsigned char* L = (LAS unsigned char*)lds;
    volatile LAS unsigned* MISC = (volatile LAS unsigned*)(L + MISC_OFF);
    const int tid = threadIdx.x, lane = tid & 63, wave = __builtin_amdgcn_readfirstlane(tid >> 6);
    const int G = gridDim.x, bx = blockIdx.x;
    unsigned char* ws = args.ws;
    gu32* ctl = (gu32*)(ws + WS_CTL);
    const float* x = args.in[0]; const float* cvec = args.in[1]; const float* ada_w = args.in[2]; const float* ada_b = args.in[3];
    const float* norm1_g = args.in[4]; const float* w_in = args.in[5]; const float* mu_prev = args.in[6]; const float* mu_next = args.in[7];
    const float* q_norm_g = args.in[8]; const float* k_norm_g = args.in[9]; const float* w_decay0 = args.in[10]; const float* w_decay_up = args.in[11];
    const float* a_gate0 = args.in[12]; const float* a_gate_up = args.in[13]; const float* g_up = args.in[14]; const float* k_k = args.in[15];
    const float* k_a = args.in[16]; const float* r_k = args.in[17]; const float* lnx_g = args.in[18]; const float* lnx_b = args.in[19];
    const float* w_out = args.in[20]; const float* norm2_g = args.in[21]; const float* w_query = args.in[22]; const float* keys1 = args.in[23];
    const float* keys2 = args.in[24]; const float* peer_u = args.in[25]; const float* peer_v = args.in[26];
    float* out = args.out;
    float* MOD = (float*)(ws + WS_MOD); bf16* KEYS = (bf16*)(ws + WS_KEYS); bf16* WIN = (bf16*)(ws + WS_WIN); bf16* WOUT = (bf16*)(ws + WS_WOUT); bf16* WQ = (bf16*)(ws + WS_WQ);
    bf16* XN = (bf16*)(ws + WS_XN); bf16* Z = (bf16*)(ws + WS_Z); bf16* MIX = (bf16*)(ws + WS_MIX); float* Y = (float*)(ws + WS_Y); bf16* Q = (bf16*)(ws + WS_Q);
    int* IDX = (int*)(ws + WS_IDX); float* GATE = (float*)(ws + WS_GATE); float* BON = (float*)(ws + WS_BON);
    bf16* O3 = (bf16*)(ws + WS_O3); float* LSE = (float*)(ws + WS_LSE); unsigned char* UT8 = ws + WS_UT; unsigned char* VT8 = ws + WS_VT; float* SU = (float*)(ws + WS_SU); float* SV = (float*)(ws + WS_SU + 65536); float* PART = (float*)(ws + WS_PART);

    for (int u = tid; u < (LDS_BYTES - LDSCTL_OFF) / 4; u += NWAVES * 64) ((LAS unsigned*)(L + LDSCTL_OFF))[u] = 0u;
    __syncthreads();
    XcdBarrier bar = xcd_barrier_post((unsigned*)(ctl + CW_BAR) + args.li * XCD_BAR_WORDS, MISC + 8);
    const int lo = args.ph_lo, hi = args.ph_hi;
#define IN(k) (lo <= (k) && (k) < hi)
#define SEAM(k) do { if (IN(k) && IN((k) + 1)) xcd_barrier(bar); } while (0)
    const int gw = bx * NWAVES + wave, NGW = G * NWAVES;

    if (IN(0) && !(MK_SKIP & (1 << 0))) {
        if (bx < MODW / 64) {
            LAS float* sc = (LAS float*)L; LAS float* part = (LAS float*)(L + 32768);
            for (int i = tid; i < BATCH * D; i += NWAVES * 64) { const float cv = cvec[i]; sc[i] = cv / (1.f + expf(-cv)); }
            __syncthreads();
            const int j0 = bx * 64;
            float acc[BATCH];
#pragma unroll
            for (int b = 0; b < BATCH; ++b) acc[b] = 0.f;
            for (int i = wave * 128; i < wave * 128 + 128; ++i) { const float w = ada_w[(size_t)i * MODW + j0 + lane];
#pragma unroll
                for (int b = 0; b < BATCH; ++b) acc[b] += sc[b * D + i] * w; }
#pragma unroll
            for (int b = 0; b < BATCH; ++b) part[(wave * 8 + b) * 64 + lane] = acc[b];
            __syncthreads();
            { const int b = tid >> 6; float s = 0.f;
#pragma unroll
              for (int w = 0; w < 8; ++w) s += part[(w * 8 + b) * 64 + lane];
              MOD[b * MODW + j0 + lane] = s + ada_b[j0 + lane]; }
            __syncthreads();
        }
        LAS float* scr = (LAS float*)(L + RING_OFF + wave * 16384);
        constexpr int I_IN = (D / 64) * (INW / 32), I_OUT = (D / 64) * (D / 32), I_Q = (D / 64) * (QW / 32);
        for (int it = gw; it < I_IN + I_OUT + I_Q; it += NGW) {
            int r = it;
            if (r < I_IN) { p0_transpose_item(w_in, D, INW, WIN, 0, scr, r, lane); continue; } r -= I_IN;
            if (r < I_OUT) { p0_transpose_item(w_out, D, D, WOUT, 0, scr, r, lane); continue; } r -= I_OUT;
            p0_transpose_item(w_query, D, QW, WQ, 0, scr, r, lane);
        }
    }
    SEAM(0);
    if (IN(1) && !(MK_SKIP & (1 << 1))) { for (int m = gw; m < T; m += NGW) norm_row(x + (size_t)m * D, norm1_g, MOD + (m / SEQ) * MODW, 0, D, XN + (size_t)m * D, lane); }
    SEAM(1);
    if (IN(2) && !(MK_SKIP & (1 << 2))) {
        pg8::Gemm g{XN, WIN, T, INW, D}; pg8::StaticOrder S; S.init(T, INW, G, bx);
        pg8::EpiBf16<0> E{Z, INW, nullptr, 0, 0, 1.f};
        pg8::gemm_phase<pg8::EpiBf16<0>, pg8::StaticOrder, true, true>(L + RING_OFF, g, S, E);
    }
    SEAM(2);
    if (IN(3) && !(MK_SKIP & (1 << 3))) {
        constexpr int NCHAIN = BATCH * NH * 2;
        if (bx < NCHAIN) {
            scan::chain(L, Z, mu_prev, mu_next, w_decay0, w_decay_up, a_gate0, a_gate_up, k_k, k_a, r_k, Y, BON, bx, tid, wave, lane);
        } else {
            const int wid = (bx - NCHAIN) * NWAVES + wave, nworkers = (G - NCHAIN) * NWAVES;
            LAS unsigned char* vt = L + wave * attn::WAVE_LDS;
            for (int u = wid; u < BATCH * NH * 96; u += nworkers) {
                const int x = u & 31, p = (u >> 5) % 3, bh = u / 96;
                const int d = (p == 0) ? 1 : (p == 1 ? 4 : 16), nb = 32 / d, r = x / nb, qb = x % nb;
                bf16* Ob = (p == 0) ? MIX : (p == 1 ? MIX + AW : O3); const int opitch = (p == 2) ? AW : D;
                attn::unit(vt, Z, q_norm_g, k_norm_g, Ob, opitch, LSE + (size_t)p * T * NH, bh >> 3, bh & 7, d, r, qb, nb, lane);
            }
        }
    }
    SEAM(3);
    if (IN(4) && !(MK_SKIP & (1 << 4))) { fin::phase(L, Z, mu_prev, mu_next, g_up, Y, BON, k_a, r_k, lnx_g, lnx_b, MIX, O3, LSE, bx, G, tid, wave, lane); }
    SEAM(4);
    if (IN(5) && !(MK_SKIP & (1 << 5))) {
        pg8::Gemm g{MIX, WOUT, T, D, D}; pg8::StaticOrder S; S.init(T, D, G, bx);
        EpiRes E{x, MOD, 2 * D, out, D};
        pg8::gemm_phase<EpiRes, pg8::StaticOrder, true, true>(L + RING_OFF, g, S, E);
    }
    SEAM(5);
    if (IN(6) && !(MK_SKIP & (1 << 6))) { for (int m = gw; m < T; m += NGW) norm_row(out + (size_t)m * D, norm2_g, MOD + (m / SEQ) * MODW, 3 * D, 4 * D, XN + (size_t)m * D, lane);
        peer::convert_rows_fp8(peer_u, UT8, SU, NKEYS * NKEYS, gw, NGW, lane); peer::convert_rows_fp8(peer_v, VT8, SV, NKEYS * NKEYS, gw, NGW, lane); }
    SEAM(6);
    if (IN(7) && !(MK_SKIP & (1 << 7))) {
        pg8::Gemm g{XN, WQ, T, QW, D}; pg8::StaticOrder S; S.init(T, QW, G, bx);
        pg8::EpiBf16<0> E{Q, QW, nullptr, 0, 0, 1.f};
        pg8::gemm_phase<pg8::EpiBf16<0>, pg8::StaticOrder, true, true>(L + RING_OFF, g, S, E);
    }
    SEAM(7);
    if (IN(8) && !(MK_SKIP & (1 << 8))) { __syncthreads(); peer::setup_keys(L, keys1, keys2, tid); __syncthreads();
        for (int bt = gw; bt < T * PH / 16; bt += NGW) peer::select_batch(L, Q, IDX, GATE, bt, lane); }
    SEAM(8);
    {
        const int sl = bx & 7, wv = (bx >> 3) * NWAVES + wave, nwv = (G >> 3) * NWAVES;
        if (IN(9) && !(MK_SKIP & (1 << 9))) { peer::ffn_u_pass(XN, IDX, UT8, PART, sl, wv, nwv, lane); }
        SEAM(9);
        if (IN(10) && !(MK_SKIP & (1 << 10))) {
            for (size_t i = (size_t)bx * NWAVES * 64 + tid; i < (size_t)T * HK; i += (size_t)G * NWAVES * 64) {
                float d = 0.f;
#pragma unroll
                for (int s8 = 0; s8 < 8; ++s8) d += PART[(size_t)s8 * T * HK + i];
                const int ex = IDX[i];
                GATE[i] = GATE[i] * peer::gelu_erf(d * SU[ex]) * SV[ex];
            }
        }
        SEAM(10);
        if (IN(11) && !(MK_SKIP & (1 << 11))) { peer::ffn_v_pass(IDX, GATE, VT8, MOD, out, sl, wv, nwv, lane); }
    }
#undef IN
#undef SEAM
}

extern "C" void kernel_launch(void* const* d_in, const int* in_sizes, int n_in, void* d_out, int out_size, void* d_ws, size_t ws_size, hipStream_t stream) {
    static int grid = 0;
    if (grid == 0) {
        if (n_in != 27 || in_sizes[0] != T * D || out_size != T * D || ws_size < WS_END) { fprintf(stderr, "kernel_launch: unexpected problem (n_in %d, in0 %d, out %d, ws %zu); nothing launched\n", n_in, n_in > 0 ? in_sizes[0] : -1, out_size, ws_size); grid = -1; return; }
        int dev = 0, cus = 0, per_cu = 0;
        if (hipGetDevice(&dev) != hipSuccess || hipDeviceGetAttribute(&cus, hipDeviceAttributeMultiprocessorCount, dev) != hipSuccess) { fprintf(stderr, "kernel_launch: device query failed\n"); grid = -1; return; }
        if (hipFuncSetAttribute((const void*)mk_fwd, hipFuncAttributeMaxDynamicSharedMemorySize, LDS_BYTES) != hipSuccess) { fprintf(stderr, "kernel_launch: hipFuncSetAttribute failed\n"); grid = -1; return; }
        if (hipOccupancyMaxActiveBlocksPerMultiprocessor(&per_cu, (const void*)mk_fwd, NWAVES * 64, LDS_BYTES) != hipSuccess || per_cu < 1)
            fprintf(stderr, "kernel_launch: note: occupancy query reports %d workgroups per CU\n", per_cu);
        (void)hipGetLastError();
        grid = cus;
    }
    if (grid < 0) return;
    if (hipMemsetAsync((char*)d_ws + WS_CTL, 0, CTL_ZERO_BYTES, stream) != hipSuccess) { fprintf(stderr, "kernel_launch: hipMemsetAsync failed\n"); return; }
    Args a{};
    for (int i = 0; i < 27; ++i) a.in[i] = (const float*)d_in[i];
    a.out = (float*)d_out; a.ws = (unsigned char*)d_ws;
#ifndef MK_RANGES
#define MK_RANGES {{0, N_PHASES}}
#endif
    static const int ranges[][2] = MK_RANGES;
    const int nl = (int)(sizeof(ranges) / sizeof(ranges[0]));
    for (int li = 0; li < nl; ++li) {
        a.ph_lo = ranges[li][0]; a.ph_hi = ranges[li][1]; a.li = li;
        hipLaunchKernelGGL(mk_fwd, dim3(grid), dim3(NWAVES * 64), LDS_BYTES, stream, a);
        const hipError_t le = hipPeekAtLastError();
        if (le != hipSuccess) { fprintf(stderr, "kernel_launch: launch %d failed: %s\n", li, hipGetErrorName(le)); break; }
    }
}
```

```cpp
#include <hip/hip_runtime.h>
#include <cstdio>
#include <cstdint>
#include <cmath>
namespace pg8 {
#define PG8_LAS __attribute__((address_space(3)))
typedef unsigned short bf16_t;
typedef short bf16x8 __attribute__((ext_vector_type(8)));
typedef float f32x4 __attribute__((ext_vector_type(4)));
typedef unsigned u32x4 __attribute__((ext_vector_type(4)));
constexpr int BM = 256, BK = 64, HALF = 128, HTB = HALF * BK * 2  , STAGE_BYTES = 8 * HTB, NXCD = 8, WGM = 8;

__host__ __device__ __forceinline__ int lds_byte(int r, int c) { const int st = (r >> 4) * 2 + (c >> 5), rr = r & 15, cc = c & 31, ob = rr * 64 + cc * 2; return st * 1024 + (ob ^ (((ob >> 9) & 1) << 5)); }
__host__ __device__ __forceinline__ void stage_rc(int b, int& R, int& C) { const int st = b / 1024, sb = b % 1024, swz = sb ^ (((sb >> 9) & 1) << 5); R = (st >> 1) * 16 + swz / 64; C = (st & 1) * 32 + (swz % 64) / 2; }
__host__ __device__ __forceinline__ int perm32(int rho) { const int n = rho >> 4, i = rho & 15; return 8 * (i >> 2) + 4 * n + (i & 3); }

struct Unit { int pm, pn; };
struct Gemm { const bf16_t* A; const bf16_t* Bt; int M, N, K; };

struct StaticOrder {
    int nM, nN, nwg, G, c;
    __host__ __device__ void init(int M, int N, int G_, int c_) { nM = M / BM; nN = N / BM; nwg = nM * nN; G = G_; c = c_; }
    __host__ __device__ bool next(int i, Unit& u) const {
        const long L = (long)i * G + c; if (L >= nwg) return false;
        int wgid = (int)L; { const int q = nwg / NXCD, r = nwg % NXCD, xcd = wgid % NXCD, off = wgid / NXCD; wgid = (xcd < r ? xcd * (q + 1) : r * (q + 1) + (xcd - r) * q) + off; }
        const int nig = WGM * nN, gid = wgid / nig, fm = gid * WGM, gsz = (nM - fm) < WGM ? (nM - fm) : WGM;
        u.pm = fm + ((wgid % nig) % gsz); u.pn = (wgid % nig) / gsz; return true;
    }
    __device__ __forceinline__ void a_ready(const Unit&) const {}
    __device__ __forceinline__ void done(const Unit&) const {}
};

__device__ __forceinline__ unsigned cvt_pk_bf16(float lo, float hi) { unsigned r; asm volatile("v_cvt_pk_bf16_f32 %0, %1, %2" : "=v"(r) : "v"(lo), "v"(hi)); return r; }
typedef float f32x2 __attribute__((ext_vector_type(2)));
__device__ __forceinline__ f32x2 gelu_pk(f32x2 v) {
    const f32x2 av = __builtin_elementwise_abs(v), d = av * 0.2316418882f + 1.0f;
    f32x2 t; t.x = __builtin_amdgcn_rcpf(d.x); t.y = __builtin_amdgcn_rcpf(d.y);
    f32x2 q = t * 0.5307027145f + (-0.7265760135f); q = q * t + 0.7107068705f; q = q * t + (-0.142248368f); q = q * t + 0.127414796f; q = q * t;
    const f32x2 s = (v * v) * (-0.72134752044f);
    f32x2 e; e.x = __builtin_amdgcn_exp2f(s.x); e.y = __builtin_amdgcn_exp2f(s.y);
    const f32x2 m = v * (q * e), r = v - m;
    f32x2 o; o.x = v.x < 0.f ? m.x : r.x; o.y = v.y < 0.f ? m.y : r.y; return o;
}

template <int ACT  > struct EpiBf16 {
    static constexpr bool PERM = true, AFTER_DRAIN = false; static_assert(ACT == 0 || ACT == 1, "EpiBf16: ACT is 0 (none) or 1 (gelu_pk)");
    bf16_t* O; int ldc; const float* bias; int split_cols; size_t split_stride; float scale0;
    __device__ __forceinline__ void operator()(const f32x4 (&acc)[2][2][4][2], const Unit& u, int wr, int wc, int fr, int fq) const {
        const int row0 = u.pm * BM + wr * 64 + fr; int colt = u.pn * BM; bf16_t* base = O;
        float sc = 1.f; if (split_cols) { const int t = colt / split_cols; base += (size_t)t * split_stride; colt -= t * split_cols; if (t == 0) sc = scale0; }
        const int col0 = colt + wc * 32 + 8 * fq, bcol0 = u.pn * BM + wc * 32 + 8 * fq;
        f32x4 bv[2][2];
#pragma unroll
        for (int bj = 0; bj < 2; ++bj)
#pragma unroll
            for (int n = 0; n < 2; ++n) bv[bj][n] = bias ? *(const f32x4*)(bias + bcol0 + bj * HALF + 4 * n) : (f32x4){0.f, 0.f, 0.f, 0.f};
#pragma unroll
        for (int ai = 0; ai < 2; ++ai)
#pragma unroll
            for (int m = 0; m < 4; ++m) { bf16_t* rowp = base + (size_t)(row0 + ai * HALF + m * 16) * ldc + col0;
#pragma unroll
                for (int bj = 0; bj < 2; ++bj) { f32x4 v0 = acc[ai][bj][m][0] + bv[bj][0], v1 = acc[ai][bj][m][1] + bv[bj][1];
                    if (ACT == 1) { f32x2 a = gelu_pk((f32x2){v0[0], v0[1]}), b = gelu_pk((f32x2){v0[2], v0[3]}), c = gelu_pk((f32x2){v1[0], v1[1]}), d = gelu_pk((f32x2){v1[2], v1[3]});
                        v0 = (f32x4){a.x, a.y, b.x, b.y}; v1 = (f32x4){c.x, c.y, d.x, d.y}; }
                    v0 = v0 * sc; v1 = v1 * sc; u32x4 w; w.x = cvt_pk_bf16(v0[0], v0[1]); w.y = cvt_pk_bf16(v0[2], v0[3]); w.z = cvt_pk_bf16(v1[0], v1[1]); w.w = cvt_pk_bf16(v1[2], v1[3]);
                    *(u32x4*)(rowp + bj * HALF) = w; } }
    }
};

template <class Epi, class Sched, bool ALIGN_EPI = false, bool SP2 = false>
__device__ __forceinline__ void gemm_phase(PG8_LAS unsigned char* lds, const Gemm g, const Sched& S, const Epi& E) {
    const int tid = threadIdx.x, wid = __builtin_amdgcn_readfirstlane(tid >> 6), lane = tid & 63, wr = wid >> 2, wc = wid & 3, fr = lane & 15, fq = lane >> 4;
    const int K = g.K, nt = K / BK;
    unsigned voffA[2], voffB[2];
#pragma unroll
    for (int i = 0; i < 2; ++i) { int R, C; stage_rc(tid * 16 + i * 8192, R, C); const int Rb = Epi::PERM ? ((R & ~31) + perm32(R & 31)) : R;
        voffA[i] = (unsigned)(R * K + C) * 2u; voffB[i] = (unsigned)(Rb * K + C) * 2u; }
    const size_t kstep = (size_t)(BK * 2);
    const size_t hstep = (size_t)HALF * K * 2;
    const size_t tstep = 2 * hstep;
    const unsigned ldsw = (unsigned)wid * 1024u;
    const int aoff = lds_byte(wr * 64 + fr, fq * 8), boff = lds_byte(wc * 32 + fr, fq * 8);
#define PG8_SA(b, h) (((b) * 2 + (h)) * HTB)
#define PG8_SB(b, h) ((4 + (b) * 2 + (h)) * HTB)
#define PG8_STAGE(bufoff, gbase, voff) do { _Pragma("unroll") for (int _i = 0; _i < 2; ++_i) \
        __builtin_amdgcn_global_load_lds((const unsigned*)((const char*)(gbase) + (voff)[_i]), (PG8_LAS unsigned*)(lds + (bufoff) + ldsw + _i * 8192), 16, 0, 0); } while (0)
#define PG8_LDA(dst, b, h) do { _Pragma("unroll") for (int m = 0; m < 4; ++m) _Pragma("unroll") for (int k = 0; k < 2; ++k) dst[m][k] = *(const PG8_LAS bf16x8*)(lds + PG8_SA(b, h) + aoff + m * 2048 + k * 1024); } while (0)
#define PG8_LDB(dst, b, h) do { _Pragma("unroll") for (int n = 0; n < 2; ++n) _Pragma("unroll") for (int k = 0; k < 2; ++k) dst[n][k] = *(const PG8_LAS bf16x8*)(lds + PG8_SB(b, h) + boff + n * 2048 + k * 1024); } while (0)
#define PG8_MMA(ai, bj, At, Bt) do { __builtin_amdgcn_s_setprio(1); _Pragma("unroll") for (int m = 0; m < 4; ++m) _Pragma("unroll") for (int n = 0; n < 2; ++n) _Pragma("unroll") for (int k = 0; k < 2; ++k) \
        acc[ai][bj][m][n] = __builtin_amdgcn_mfma_f32_16x16x32_bf16(Bt[n][k], At[m][k], acc[ai][bj][m][n], 0, 0, 0); __builtin_amdgcn_s_setprio(0); } while (0)
#define PG8_WAIT_V(n) asm volatile("s_waitcnt vmcnt(" #n ")" ::: "memory")
#define PG8_WAIT_L(n) asm volatile("s_waitcnt lgkmcnt(" #n ")" ::: "memory")
#define PG8_BAR __builtin_amdgcn_s_barrier()
#define PG8_SCHED __builtin_amdgcn_sched_barrier(0)
    Unit cur, nxt; int ui = 0;
    if (!S.next(0, cur)) return;
    f32x4 acc[2][2][4][2];
#pragma unroll
    for (int a = 0; a < 2; ++a)
#pragma unroll
        for (int b = 0; b < 2; ++b)
#pragma unroll
            for (int m = 0; m < 4; ++m)
#pragma unroll
                for (int n = 0; n < 2; ++n) acc[a][b][m][n] = (f32x4){0.f, 0.f, 0.f, 0.f};
    bf16x8 At[4][2], B0[2][2], B1[2][2];
    const char* cA = (const char*)g.A + (size_t)cur.pm * tstep; const char* cB = (const char*)g.Bt + (size_t)cur.pn * tstep;
    S.a_ready(cur);
    if constexpr (SP2) {
        PG8_STAGE(PG8_SB(0, 0), cB, voffB); PG8_STAGE(PG8_SB(0, 1), cB + hstep, voffB); PG8_STAGE(PG8_SA(0, 0), cA, voffA); PG8_STAGE(PG8_SA(0, 1), cA + hstep, voffA);
        if (wr == 1) PG8_BAR;
        PG8_WAIT_V(2); PG8_BAR;
        PG8_STAGE(PG8_SB(1, 0), cB + kstep, voffB); PG8_STAGE(PG8_SA(1, 0), cA + kstep, voffA); PG8_STAGE(PG8_SB(1, 1), cB + hstep + kstep, voffB);
        PG8_WAIT_V(6); PG8_BAR;
    } else {
        PG8_STAGE(PG8_SB(0, 0), cB, voffB); PG8_STAGE(PG8_SA(0, 0), cA, voffA); PG8_STAGE(PG8_SB(0, 1), cB + hstep, voffB); PG8_STAGE(PG8_SA(0, 1), cA + hstep, voffA);
        if (wr == 1) PG8_BAR;
        PG8_WAIT_V(4); PG8_BAR;
        PG8_STAGE(PG8_SB(1, 0), cB + kstep, voffB); PG8_STAGE(PG8_SA(1, 0), cA + kstep, voffA); PG8_STAGE(PG8_SB(1, 1), cB + hstep + kstep, voffB);
        PG8_WAIT_V(6); PG8_BAR;
    }
    for (;;) {
        const bool has_next = S.next(ui + 1, nxt);
        const char* nA = has_next ? (const char*)g.A + (size_t)nxt.pm * tstep : cA; const char* nB = has_next ? (const char*)g.Bt + (size_t)nxt.pn * tstep : cB;
        for (int t = 0; t < nt; t += 2) {
            const bool last = (t == nt - 2);
            const char* a1 = cA + (size_t)(t + 1) * kstep;
            const char* a2 = last ? nA : cA + (size_t)(t + 2) * kstep; const char* b2 = last ? nB : cB + (size_t)(t + 2) * kstep;
            const char* a3 = a2 + kstep; const char* b3 = b2 + kstep;
            if (last && has_next) S.a_ready(nxt);
            if constexpr (SP2) {
            PG8_LDB(B0, 0, 0); PG8_LDB(B1, 0, 1); PG8_SCHED; PG8_LDA(At, 0, 0); PG8_STAGE(PG8_SA(1, 1), a1 + hstep, voffA);
            PG8_WAIT_V(8); PG8_WAIT_L(0); PG8_BAR; PG8_MMA(0, 0, At, B0); PG8_MMA(0, 1, At, B1); PG8_BAR; PG8_SCHED;
            PG8_LDA(At, 0, 1); PG8_STAGE(PG8_SB(0, 0), b2, voffB); PG8_STAGE(PG8_SB(0, 1), b2 + hstep, voffB); PG8_STAGE(PG8_SA(0, 0), a2, voffA);
            PG8_WAIT_V(8); PG8_WAIT_L(0); PG8_BAR; PG8_MMA(1, 0, At, B0); PG8_MMA(1, 1, At, B1); PG8_BAR; PG8_SCHED;
            PG8_LDB(B0, 1, 0); PG8_LDB(B1, 1, 1); PG8_SCHED; PG8_LDA(At, 1, 0); PG8_STAGE(PG8_SA(0, 1), a2 + hstep, voffA);
            PG8_WAIT_V(8); PG8_WAIT_L(0); PG8_BAR; PG8_MMA(0, 0, At, B0); PG8_MMA(0, 1, At, B1); PG8_BAR; PG8_SCHED;
            PG8_LDA(At, 1, 1); PG8_STAGE(PG8_SB(1, 0), b3, voffB); PG8_STAGE(PG8_SB(1, 1), b3 + hstep, voffB); PG8_STAGE(PG8_SA(1, 0), a3, voffA);
            PG8_WAIT_V(8); PG8_WAIT_L(0); PG8_BAR; PG8_MMA(1, 0, At, B0); PG8_MMA(1, 1, At, B1); PG8_BAR; PG8_SCHED;
            } else {
            PG8_LDB(B0, 0, 0); PG8_SCHED; PG8_LDA(At, 0, 0); PG8_STAGE(PG8_SA(1, 1), a1 + hstep, voffA);
            PG8_WAIT_L(8); PG8_BAR; PG8_WAIT_L(0); PG8_MMA(0, 0, At, B0); PG8_BAR; PG8_SCHED;
            PG8_LDB(B1, 0, 1); PG8_STAGE(PG8_SB(0, 0), b2, voffB);
            PG8_BAR; PG8_WAIT_L(0); PG8_MMA(0, 1, At, B1); PG8_BAR;
            PG8_LDA(At, 0, 1); PG8_STAGE(PG8_SA(0, 0), a2, voffA);
            PG8_BAR; PG8_WAIT_L(0); PG8_MMA(1, 0, At, B0); PG8_BAR; PG8_SCHED;
            PG8_STAGE(PG8_SB(0, 1), b2 + hstep, voffB);
            PG8_WAIT_V(6); PG8_BAR; PG8_MMA(1, 1, At, B1); PG8_BAR;
            PG8_LDB(B0, 1, 0); PG8_SCHED; PG8_LDA(At, 1, 0); PG8_STAGE(PG8_SA(0, 1), a2 + hstep, voffA);
            PG8_WAIT_L(8); PG8_BAR; PG8_WAIT_L(0); PG8_MMA(0, 0, At, B0); PG8_BAR; PG8_SCHED;
            PG8_LDB(B1, 1, 1); PG8_STAGE(PG8_SB(1, 0), b3, voffB);
            PG8_BAR; PG8_WAIT_L(0); PG8_MMA(0, 1, At, B1); PG8_BAR;
            PG8_LDA(At, 1, 1); PG8_STAGE(PG8_SA(1, 0), a3, voffA);
            PG8_BAR; PG8_WAIT_L(0); PG8_MMA(1, 0, At, B0); PG8_BAR; PG8_SCHED;
            PG8_STAGE(PG8_SB(1, 1), b3 + hstep, voffB);
            PG8_WAIT_V(6); PG8_BAR; PG8_MMA(1, 1, At, B1); PG8_BAR;
            }
        }
        if constexpr (ALIGN_EPI) { if (wr == 0) PG8_BAR; }
        if constexpr (!Epi::AFTER_DRAIN) { E(acc, cur, wr, wc, fr, fq); S.done(cur); }
        if (!has_next) break;
#pragma unroll
        for (int a = 0; a < 2; ++a)
#pragma unroll
            for (int b = 0; b < 2; ++b)
#pragma unroll
                for (int m = 0; m < 4; ++m)
#pragma unroll
                    for (int n = 0; n < 2; ++n) acc[a][b][m][n] = (f32x4){0.f, 0.f, 0.f, 0.f};
        cur = nxt; cA = nA; cB = nB; ++ui;
        if constexpr (ALIGN_EPI) { if (wr == 1) PG8_BAR; }
    }
    PG8_WAIT_V(0);
    if constexpr (!ALIGN_EPI) { if (wr == 0) PG8_BAR; }
    PG8_BAR;
    if constexpr (Epi::AFTER_DRAIN) { E.fused(acc, cur, wr, wc, fr, fq, lds, wid, lane); S.done(cur); }
#undef PG8_SA
#undef PG8_SB
#undef PG8_STAGE
#undef PG8_LDA
#undef PG8_LDB
#undef PG8_MMA
#undef PG8_WAIT_V
#undef PG8_WAIT_L
#undef PG8_BAR
#undef PG8_SCHED
}
}
#define GAS __attribute__((address_space(1)))
#define LAS __attribute__((address_space(3)))
typedef unsigned short bf16;
typedef unsigned v4u __attribute__((ext_vector_type(4)));
typedef float f32x4 __attribute__((ext_vector_type(4)));
typedef short bf16x8 __attribute__((ext_vector_type(8)));
typedef GAS unsigned gu32;
typedef GAS unsigned long long gu64;
#define RLX_AGENT __ATOMIC_RELAXED, __HIP_MEMORY_SCOPE_AGENT
#define LDS_WAIT() asm volatile("s_waitcnt lgkmcnt(0)" ::: "memory")
#define VM_WAIT() asm volatile("s_waitcnt vmcnt(0)" ::: "memory")
__device__ __forceinline__ unsigned long long rt() { return __builtin_amdgcn_s_memrealtime(); }
__device__ __forceinline__ unsigned f2bf(float f) { unsigned u = __builtin_bit_cast(unsigned, f); return (u + 0x7fffu + ((u >> 16) & 1u)) >> 16; }
__device__ __forceinline__ unsigned pk2(float lo, float hi) { return f2bf(lo) | (f2bf(hi) << 16); }

#define XB_TMO      128
#define XB_XCNT(j)  (256  + 64 * (j))
#define XB_XSUB(j)  (1280 + 64 * (j))
#define XB_XGEN(j)  (2304 + 64 * (j))
#define XB_TOP      3328
#define XB_TOPGEN   3392
#define XCD_BAR_WORDS 3456
#define XB_SPIN_CAP (1u << 18)

__device__ __forceinline__ unsigned xb_ld(unsigned* p)              { return __hip_atomic_load(p, __ATOMIC_RELAXED, __HIP_MEMORY_SCOPE_AGENT); }
__device__ __forceinline__ unsigned xb_add(unsigned* p, unsigned v) { return __hip_atomic_fetch_add(p, v, __ATOMIC_RELAXED, __HIP_MEMORY_SCOPE_AGENT); }
__device__ __forceinline__ unsigned xb_xcc_id() { return (unsigned)__builtin_amdgcn_s_getreg((3 << 11) | 20) & 0xFu; }
#define XB_SPIN(cond, bar) do { unsigned _sp = 0; while (cond) { __builtin_amdgcn_s_sleep(1); \
    if ((++_sp & 255u) == 0u) { if (xb_ld(&(bar)[XB_TMO])) break; if (_sp > XB_SPIN_CAP) { atomicAdd(&(bar)[XB_TMO], 1u); break; } } } } while (0)

struct XcdBarrier {
    unsigned* bar; unsigned x;
    volatile LAS unsigned* st;
};

__device__ __forceinline__ XcdBarrier xcd_barrier_post(unsigned* bar, volatile LAS unsigned* st) {
    XcdBarrier b; b.bar = bar; b.x = xb_xcc_id(); b.st = st;
    if (threadIdx.x == 0) (void)xb_add(&bar[XB_XCNT(b.x)], 1u);
    return b;
}
__device__ __forceinline__ void xcd_barrier_complete(unsigned* bar, unsigned x, unsigned& nloc, unsigned& nx) {
    const unsigned G = gridDim.x * gridDim.y * gridDim.z;
    unsigned sum, cnt, mine, sp = 0u;
    for (;;) {
        sum = 0u; cnt = 0u; mine = 0u;
#pragma unroll
        for (unsigned j = 0; j < 16; ++j) { const unsigned c = xb_ld(&bar[XB_XCNT(j)]); sum += c; cnt += (c > 0u) ? 1u : 0u; mine = (j == x) ? c : mine; }
        if (sum == G) break;
        __builtin_amdgcn_s_sleep(1);
        if ((++sp & 255u) == 0u) { if (xb_ld(&bar[XB_TMO])) break; if (sp > XB_SPIN_CAP) { atomicAdd(&bar[XB_TMO], 1u); break; } }
    }
    nloc = mine > 0u ? mine : 1u; nx = cnt > 0u ? cnt : 1u;
}

__device__ __forceinline__ void xcd_barrier(const XcdBarrier& b) {
    asm volatile("s_waitcnt vmcnt(0)" ::: "memory");
    __syncthreads();
    if (threadIdx.x == 0) {
        unsigned* bar = b.bar;
        __builtin_amdgcn_s_waitcnt(0);
        unsigned nloc = b.st[0], nx = b.st[1];
        if (nloc == 0u) { xcd_barrier_complete(bar, b.x, nloc, nx); b.st[0] = nloc; b.st[1] = nx; }
        const unsigned old = xb_add(&bar[XB_XSUB(b.x)], 1u);
        const unsigned gen = old / nloc;
        if (old + 1u == (gen + 1u) * nloc) {
            __builtin_amdgcn_fence(__ATOMIC_RELEASE, "agent");
            asm volatile("s_waitcnt vmcnt(0)" ::: "memory");
            const unsigned og = xb_add(&bar[XB_TOP], 1u);
            const unsigned tg = og / nx;
            if (og + 1u == (tg + 1u) * nx) xb_add(&bar[XB_TOPGEN], 1u);
            else XB_SPIN(xb_ld(&bar[XB_TOPGEN]) == tg, bar);
            __builtin_amdgcn_fence(__ATOMIC_ACQUIRE, "agent");
            xb_add(&bar[XB_XGEN(b.x)], 1u);
            asm volatile("s_waitcnt vmcnt(0)" ::: "memory");
        } else {
            XB_SPIN(xb_ld(&bar[XB_XGEN(b.x)]) == gen, bar);
            __builtin_amdgcn_fence(__ATOMIC_ACQUIRE, "agent");
            asm volatile("s_waitcnt vmcnt(0)" ::: "memory");
        }
    }
    __syncthreads();
}
constexpr int NWAVES = 8;
constexpr int D = 1024, BATCH = 8, SEQ = 2048, T = BATCH * SEQ;
constexpr int AW = 512, RW = 512, NH = 8;
constexpr int DL = 64, AL = 64, GL = 128;
constexpr int SHIFTW = 3 * RW + DL + AL + GL;
constexpr int INW = 3 * AW + SHIFTW;
constexpr int NKEYS = 128, PH = 8, PKD = 256, TOPK = 16, HK = PH * TOPK;
constexpr int QW = PH * PKD;
constexpr int MODW = 6 * D;

constexpr size_t MiB = 1u << 20;
constexpr size_t WS_CTL = 0, CTL_ZERO_BYTES = 1 * MiB;
constexpr size_t WS_MOD = 1 * MiB;
constexpr size_t WS_KEYS = 1 * MiB + 512 * 1024;
constexpr size_t WS_WIN = 2 * MiB;
constexpr size_t WS_WOUT = 9 * MiB;
constexpr size_t WS_WQ = 11 * MiB;
constexpr size_t WS_XN = 16 * MiB;
constexpr size_t WS_O3 = 16 * MiB;
constexpr size_t WS_LSE = 32 * MiB;
constexpr size_t WS_Z = 48 * MiB;
constexpr size_t WS_MIX = 152 * MiB;
constexpr size_t WS_Y = 184 * MiB;
constexpr size_t WS_Q = 48 * MiB;
constexpr size_t WS_IDX = 112 * MiB;
constexpr size_t WS_GATE = 120 * MiB;
constexpr size_t WS_PART = 48 * MiB;
constexpr size_t WS_UT = 152 * MiB;
constexpr size_t WS_SU = 168 * MiB;
constexpr size_t WS_VT = 184 * MiB;
constexpr size_t WS_BON = 248 * MiB;
constexpr size_t WS_END = 249 * MiB;
constexpr int CW_WORK = 1024;
constexpr int CW_BAR = 4096;
constexpr int MAX_LAUNCHES = 12;

constexpr int RING_OFF = 0, RING_BYTES = 139264;
constexpr int LDSCTL_OFF = RING_BYTES, MISC_OFF = LDSCTL_OFF + 320;
constexpr int LDS_BYTES = 147456;
static_assert(MISC_OFF + 128 <= LDS_BYTES, "LDS map");

typedef GAS float gf32;
typedef GAS f32x4 gf32x4;

__device__ __forceinline__ float bf2f(bf16 v) { return __uint_as_float(((unsigned)v) << 16); }
__device__ __forceinline__ float wave_sum(float v) {
#pragma unroll
    for (int o = 1; o < 64; o <<= 1) v += __shfl_xor(v, o);
    return v;
}
#define WAVE_LDS_SYNC() do { asm volatile("s_waitcnt lgkmcnt(0)" ::: "memory"); __builtin_amdgcn_wave_barrier(); } while (0)

__device__ __forceinline__ void p0_transpose_item(const float* W, int K, int N, bf16* WT, int row_off, LAS float* scr, int item, int lane) {
    const int nblk = N / 32, kb = item / nblk, nb = item % nblk, k0 = 64 * kb, n0 = 32 * nb;
#pragma unroll 8
    for (int i = 0; i < 32; ++i) { const int kk = 2 * i + (lane >> 5); scr[kk * 33 + (lane & 31)] = W[(size_t)(k0 + kk) * N + n0 + (lane & 31)]; }
    LDS_WAIT(); asm volatile("" ::: "memory");
    const int c = lane & 7;
#pragma unroll
    for (int j = 0; j < 4; ++j) { const int n = (lane >> 3) + 8 * j; const LAS float* s = scr + (8 * c) * 33 + n;
        v4u o; o.x = pk2(s[0 * 33], s[1 * 33]); o.y = pk2(s[2 * 33], s[3 * 33]); o.z = pk2(s[4 * 33], s[5 * 33]); o.w = pk2(s[6 * 33], s[7 * 33]);
        *(GAS v4u*)(WT + (size_t)(row_off + n0 + n) * K + k0 + 8 * c) = o; }
    LDS_WAIT(); asm volatile("" ::: "memory");
}

__device__ __forceinline__ void norm_row(const float* xrow, const float* g, const float* modb, int shift_off, int scale_off, bf16* orow, int lane) {
    const GAS f32x4* xr = (const GAS f32x4*)xrow + lane;
    f32x4 v[4]; float s = 0.f;
#pragma unroll
    for (int j = 0; j < 4; ++j) { v[j] = xr[64 * j]; s += (v[j].x * v[j].x + v[j].y * v[j].y) + (v[j].z * v[j].z + v[j].w * v[j].w); }
    const float rs = 1.0f / sqrtf(wave_sum(s) * (1.f / D) + 1e-6f);
    GAS unsigned long long* o8 = (GAS unsigned long long*)orow + lane;
#pragma unroll
    for (int j = 0; j < 4; ++j) {
        const int col = 256 * j + 4 * lane;
        const f32x4 g4 = *(const GAS f32x4*)(g + col), sc = *(const GAS f32x4*)(modb + scale_off + col), sh = *(const GAS f32x4*)(modb + shift_off + col);
        const f32x4 y = v[j] * rs * g4 * (sc + 1.0f) + sh;
        o8[64 * j] = (unsigned long long)pk2(y.x, y.y) | ((unsigned long long)pk2(y.z, y.w) << 32);
    }
}

struct EpiRes {
    static constexpr bool PERM = false, AFTER_DRAIN = false;
    const float* xres; const float* mod; int gate_off; float* out; int ldc;
    __device__ __forceinline__ void operator()(const pg8::f32x4 (&acc)[2][2][4][2], const pg8::Unit& u, int wr, int wc, int fr, int fq) const {
        const int col0 = u.pn * pg8::BM + wc * 32 + 4 * fq;
        const int b = (u.pm * pg8::BM) / SEQ;
        pg8::f32x4 gv[2][2];
#pragma unroll
        for (int bj = 0; bj < 2; ++bj)
#pragma unroll
            for (int n = 0; n < 2; ++n) gv[bj][n] = *(const pg8::f32x4*)(mod + b * MODW + gate_off + col0 + bj * pg8::HALF + n * 16);
#pragma unroll
        for (int ai = 0; ai < 2; ++ai)
#pragma unroll
            for (int m = 0; m < 4; ++m) { const size_t off = (size_t)(u.pm * pg8::BM + ai * pg8::HALF + wr * 64 + m * 16 + fr) * ldc + col0;
#pragma unroll
                for (int bj = 0; bj < 2; ++bj)
#pragma unroll
                    for (int n = 0; n < 2; ++n) { const pg8::f32x4 bs = *(const pg8::f32x4*)(xres + off + bj * pg8::HALF + n * 16);
                        *(pg8::f32x4*)(out + off + bj * pg8::HALF + n * 16) = bs + gv[bj][n] * acc[ai][bj][m][n]; } }
    }
};

namespace scan {
typedef unsigned u32x2 __attribute__((ext_vector_type(2)));
constexpr int SLOT = 1024, BUF_BYTES = 12800, NBUF = 8;
constexpr int OFF_LORA = NBUF * BUF_BYTES;
constexpr int OFF_CONST = OFF_LORA + 16 * SLOT;
constexpr int OFF_MT = OFF_CONST + 5120;
constexpr int SCAN_LDS = OFF_MT + 8 * 1024;
static_assert(SCAN_LDS <= 139264, "scan LDS map");
constexpr int S_KK = 0, S_R = 2, S_MT = 4, S_N = 5, S_BK = 6, S_V = 10, S_GC = 12;

typedef float f32x2n __attribute__((ext_vector_type(2)));
typedef __bf16 bf16x2n __attribute__((ext_vector_type(2)));
__device__ __forceinline__ unsigned cvtpk(float lo, float hi) { const f32x2n v = {lo, hi}; const bf16x2n b = __builtin_convertvector(v, bf16x2n); return __builtin_bit_cast(unsigned, b); }
__device__ __forceinline__ bf16x8 mkfrag(unsigned a, unsigned b, unsigned c, unsigned d) { v4u w; w.x = a; w.y = b; w.z = c; w.w = d; return __builtin_bit_cast(bf16x8, w); }
__device__ __forceinline__ bf16x8 frag8(const float (&lo)[4], const float (&hi)[4]) { return mkfrag(cvtpk(lo[0], lo[1]), cvtpk(lo[2], lo[3]), cvtpk(hi[0], hi[1]), cvtpk(hi[2], hi[3])); }
__device__ __forceinline__ f32x4 mma(bf16x8 a, bf16x8 b, f32x4 c) { return __builtin_amdgcn_mfma_f32_16x16x32_bf16(a, b, c, 0, 0, 0); }
template <int N> __device__ __forceinline__ float row_shr(float x) { return __int_as_float(__builtin_amdgcn_update_dpp(0, __float_as_int(x), 0x110 + N, 0xf, 0xf, true)); }
__device__ __forceinline__ float fsigmoid(float x) { return __builtin_amdgcn_rcpf(1.0f + __expf(-x)); }
__device__ __forceinline__ bf16 tobf(float x) { return (bf16)(cvtpk(x, x) & 0xffffu); }

__device__ __forceinline__ void setup(LAS unsigned char* L, int h, int dir, const float* mu_prev, const float* mu_next, const float* w_decay0, const float* w_decay_up,
                                      const float* a_gate0, const float* a_gate_up, const float* k_k, const float* k_a, const float* r_k, int tid) {
    LAS float* C = (LAS float*)(L + OFF_CONST);
    for (int i = tid; i < 320; i += 512) {
        const int grp = i >> 6, c = i & 63;
        const int col = (grp < 3) ? grp * RW + h * 64 + c : 3 * RW + (grp - 3) * 64 + c;
        C[i] = mu_prev[col]; C[320 + i] = mu_next[col]; C[960 + i] = 1.0f - mu_prev[col] - mu_next[col];
    }
    if (tid < 64) { const int hc = h * 64 + tid; C[640 + tid] = w_decay0[dir * RW + hc]; C[704 + tid] = a_gate0[dir * RW + hc]; C[768 + tid] = k_k[hc]; C[832 + tid] = k_a[hc]; C[896 + tid] = r_k[hc]; }
    LAS bf16* F = (LAS bf16*)(L + OFF_LORA);
    for (int i = tid; i < 16 * 64 * 8; i += 512) {
        const int j = i & 7, l = (i >> 3) & 63, sl = i >> 9, m = sl & 1, ct = (sl >> 1) & 3, wa = sl >> 3;
        const int g = l >> 4, jj = 32 * m + (j < 4 ? 4 * g + j : 16 + 4 * g + j - 4), c = h * 64 + 16 * ct + (l & 15);
        const float v = wa ? a_gate_up[(size_t)(dir * AL + jj) * RW + c] : w_decay_up[(size_t)(dir * DL + jj) * RW + c];
        F[i] = (bf16)f2bf(v);
    }
}

__device__ __forceinline__ void helper_chunk(LAS unsigned char* L, LAS unsigned char* buf, LAS float* MT, const bf16* Z, float* BON, int b, int h, int dir, int n, int lane) {
    const int s = lane & 15, g = lane >> 4;
    const int cn = dir ? (SEQ / 16 - 1 - n) : n;
    const int t = cn * 16 + (dir ? 15 - s : s), tok = b * SEQ + t;
    const LAS float* C = (const LAS float*)(L + OFF_CONST);
    const bool hasp = t > 0, hasn = t < SEQ - 1;
    float rv[4][4], kv[4][4], vv[4][4], tw[4][4], xa[4][4];
    constexpr int SROW = 136, SGRP = 18 * SROW;
    {
        v4u ld[12];
#pragma unroll
        for (int i = 0; i < 12; ++i) {
            int p = 8 * i + (lane >> 3); p = p < 90 ? p : 89;
            const int grp = p / 18, row = p - 18 * grp;
            const int st = (row < 16) ? row : (row == 16 ? -1 : 16);
            int tt = cn * 16 + (dir ? 15 - st : st); tt = tt < 0 ? 0 : (tt > SEQ - 1 ? SEQ - 1 : tt);
            const int cbase = (grp < 3) ? grp * RW + h * 64 : 3 * RW + (grp - 3) * 64;
            ld[i] = *(const v4u*)(Z + (size_t)(b * SEQ + tt) * INW + 3 * AW + cbase + 8 * (lane & 7));
        }
#pragma unroll
        for (int i = 0; i < 12; ++i) {
            int p = 8 * i + (lane >> 3); p = p < 90 ? p : 89;
            const int grp = p / 18, row = p - 18 * grp;
            LAS unsigned char* q = buf + grp * SGRP + row * SROW + 16 * (lane & 7);
            *(LAS u32x2*)q = (u32x2){ld[i].x, ld[i].y}; *(LAS u32x2*)(q + 8) = (u32x2){ld[i].z, ld[i].w};
        }
    }
    asm volatile("s_waitcnt lgkmcnt(0)" ::: "memory"); __builtin_amdgcn_wave_barrier();
    {
        const int rlo = (s == 0) ? 16 : s - 1, rup = (s == 15) ? 17 : s + 1;
        const int rp = dir ? rup : rlo, rn = dir ? rlo : rup;
        typedef float f32x2s __attribute__((ext_vector_type(2)));
        const unsigned pmask = hasp ? 0xffffffffu : 0u, nmask = hasn ? 0xffffffffu : 0u;
#pragma unroll
        for (int grp = 0; grp < 5; ++grp) {
#pragma unroll
            for (int ct = 0; ct < 4; ++ct) {
                const LAS unsigned char* q = buf + grp * SGRP + 32 * ct + 8 * g;
                const u32x2 zcc = *(const LAS u32x2*)(q + s * SROW);
                u32x2 zp = *(const LAS u32x2*)(q + rp * SROW), zn = *(const LAS u32x2*)(q + rn * SROW);
                zp.x &= pmask; zp.y &= pmask; zn.x &= nmask; zn.y &= nmask;
                const f32x4 mp = *(const LAS f32x4*)(C + grp * 64 + 16 * ct + 4 * g), mn = *(const LAS f32x4*)(C + 320 + grp * 64 + 16 * ct + 4 * g), mc = *(const LAS f32x4*)(C + 960 + grp * 64 + 16 * ct + 4 * g);
                const f32x2s z01 = {__uint_as_float(zcc.x << 16), __uint_as_float(zcc.x & 0xffff0000u)}, z23 = {__uint_as_float(zcc.y << 16), __uint_as_float(zcc.y & 0xffff0000u)};
                const f32x2s p01 = {__uint_as_float(zp.x << 16), __uint_as_float(zp.x & 0xffff0000u)}, p23 = {__uint_as_float(zp.y << 16), __uint_as_float(zp.y & 0xffff0000u)};
                const f32x2s n01 = {__uint_as_float(zn.x << 16), __uint_as_float(zn.x & 0xffff0000u)}, n23 = {__uint_as_float(zn.y << 16), __uint_as_float(zn.y & 0xffff0000u)};
                const f32x2s o01 = (f32x2s){mc[0], mc[1]} * z01 + (f32x2s){mp[0], mp[1]} * p01 + (f32x2s){mn[0], mn[1]} * n01;
                const f32x2s o23 = (f32x2s){mc[2], mc[3]} * z23 + (f32x2s){mp[2], mp[3]} * p23 + (f32x2s){mn[2], mn[3]} * n23;
                const float ov[4] = {o01.x, o01.y, o23.x, o23.y};
#pragma unroll
                for (int r = 0; r < 4; ++r) {
                    const float o = ov[r];
                    if (grp == 0) rv[ct][r] = o; else if (grp == 1) kv[ct][r] = o; else if (grp == 2) vv[ct][r] = o;
                    else if (grp == 3) { const float e2 = __expf(2.0f * o); tw[ct][r] = 1.0f - 2.0f * __builtin_amdgcn_rcpf(e2 + 1.0f); } else xa[ct][r] = o;
                }
            }
            __builtin_amdgcn_sched_barrier(0);
        }
    }
    asm volatile("s_waitcnt lgkmcnt(0)" ::: "memory"); __builtin_amdgcn_wave_barrier();
#pragma unroll
    for (int ct = 0; ct < 4; ++ct)
#pragma unroll
        for (int r = 0; r < 4; ++r)
            *(LAS bf16*)(buf + (S_V + (ct >> 1)) * SLOT + (4 * g + r + 16 * (s >> 2)) * 16 + (ct & 1) * 8 + 2 * (s & 3)) = tobf(vv[ct][r]);
    f32x4 accw[4], acca[4];
    { const bf16x8 tb0 = frag8(tw[0], tw[1]), tb1 = frag8(tw[2], tw[3]), xb0 = frag8(xa[0], xa[1]), xb1 = frag8(xa[2], xa[3]);
      const LAS bf16x8* F = (const LAS bf16x8*)(L + OFF_LORA);
#pragma unroll
      for (int ct = 0; ct < 4; ++ct) {
          f32x4 z4 = {0.f, 0.f, 0.f, 0.f};
          accw[ct] = mma(F[(0 * 8 + ct * 2 + 0) * 64 + lane], tb0, z4); accw[ct] = mma(F[(0 * 8 + ct * 2 + 1) * 64 + lane], tb1, accw[ct]);
          acca[ct] = mma(F[(1 * 8 + ct * 2 + 0) * 64 + lane], xb0, z4); acca[ct] = mma(F[(1 * 8 + ct * 2 + 1) * 64 + lane], xb1, acca[ct]);
      } }
    float ev[4][4], kk[4][4], kd[4][4], bb[4][4];
    float ss = 0.f, bon = 0.f;
#pragma unroll
    for (int ct = 0; ct < 4; ++ct) {
        const f32x4 w0 = *(const LAS f32x4*)(C + 640 + 16 * ct + 4 * g), a0 = *(const LAS f32x4*)(C + 704 + 16 * ct + 4 * g), kkw = *(const LAS f32x4*)(C + 768 + 16 * ct + 4 * g),
                    kaw = *(const LAS f32x4*)(C + 832 + 16 * ct + 4 * g), rkw = *(const LAS f32x4*)(C + 896 + 16 * ct + 4 * g);
#pragma unroll
        for (int r = 0; r < 4; ++r) {
            ev[ct][r] = 0.60653065971f * fsigmoid(accw[ct][r] + w0[r]);
            const float a = fsigmoid(acca[ct][r] + a0[r]);
            const float k = kv[ct][r];
            kk[ct][r] = k * kkw[r]; ss += kk[ct][r] * kk[ct][r];
            kd[ct][r] = k * (1.0f + (a - 1.0f) * kaw[r]);
            bb[ct][r] = a;
            bon += rv[ct][r] * k * a * kaw[r] * rkw[r];
        }
        __builtin_amdgcn_sched_barrier(0);
    }
    ss += __shfl_xor(ss, 16); ss += __shfl_xor(ss, 32);
    bon += __shfl_xor(bon, 16); bon += __shfl_xor(bon, 32);
    if (g == 0) BON[((size_t)dir * T + tok) * NH + h] = bon;
    const float rn = __builtin_amdgcn_rsqf(fmaxf(ss, 1e-12f));
    bf16x8 fKKm[2], fRm[2], fBm[2], fKm[2];
#pragma unroll
    for (int m = 0; m < 2; ++m) {
        float KKs[2][4], Rs[2][4], Bt[2][4], Kt[2][4];
#pragma unroll
        for (int c2 = 0; c2 < 2; ++c2) {
            const int ct = 2 * m + c2;
            float gcv[4];
#pragma unroll
            for (int r = 0; r < 4; ++r) {
                const float e = ev[ct][r];
                float cum = e;
                cum += row_shr<1>(cum); cum += row_shr<2>(cum); cum += row_shr<4>(cum); cum += row_shr<8>(cum);
                const float cumC = __shfl(cum, (lane & 48) | 15);
                const float kkn = kk[ct][r] * rn, bv = kkn * bb[ct][r];
                const float ig = __expf(cum), gs = __builtin_amdgcn_rcpf(ig), gC = __expf(-cumC), rat = ig * gC;
                KKs[c2][r] = kkn * gs * __expf(e); Rs[c2][r] = rv[ct][r] * gs;
                Bt[c2][r] = bv * ig; Kt[c2][r] = kd[ct][r] * ig;
                gcv[r] = gC;
                LAS unsigned char* q = buf + (S_BK + ct) * SLOT + (4 * g + r + 16 * (s >> 2)) * 16 + 2 * (s & 3);
                *(LAS bf16*)q = tobf(bv * rat); *(LAS bf16*)(q + 8) = tobf(kd[ct][r] * rat);
            }
            if (s == 15) *(LAS f32x4*)(buf + S_GC * SLOT + (16 * ct + 4 * g) * 4) = (f32x4){gcv[0], gcv[1], gcv[2], gcv[3]};
        }
        fKKm[m] = frag8(KKs[0], KKs[1]); fRm[m] = frag8(Rs[0], Rs[1]); fBm[m] = frag8(Bt[0], Bt[1]); fKm[m] = frag8(Kt[0], Kt[1]);
    }
    const bf16x8 fKK0 = fKKm[0], fKK1 = fKKm[1], fR0 = fRm[0], fR1 = fRm[1], fB0 = fBm[0], fB1 = fBm[1], fK0 = fKm[0], fK1 = fKm[1];
    *(LAS bf16x8*)(buf + (S_KK + 0) * SLOT + lane * 16) = fKK0; *(LAS bf16x8*)(buf + (S_KK + 1) * SLOT + lane * 16) = fKK1;
    *(LAS bf16x8*)(buf + (S_R + 0) * SLOT + lane * 16) = fR0;  *(LAS bf16x8*)(buf + (S_R + 1) * SLOT + lane * 16) = fR1;
    const f32x4 z4 = {0.f, 0.f, 0.f, 0.f};
    { f32x4 mab = mma(fKK0, fB0, z4); mab = mma(fKK1, fB1, mab);
      *(LAS f32x4*)(MT + s * 16 + 4 * g) = mab; }
    f32x4 mak = mma(fK0, fKK0, z4); mak = mma(fK1, fKK1, mak);
    f32x4 nrb = mma(fB0, fR0, z4); nrb = mma(fB1, fR1, nrb);
    f32x4 nrk = mma(fK0, fR0, z4); nrk = mma(fK1, fR1, nrk);
#pragma unroll
    for (int r = 0; r < 4; ++r) { const int i = 4 * g + r; if (!(i < s)) mak[r] = 0.f; if (!(i <= s)) { nrb[r] = 0.f; nrk[r] = 0.f; } }
    *(LAS v4u*)(buf + S_N * SLOT + lane * 16) = (v4u){cvtpk(nrb[0], nrb[1]), cvtpk(nrb[2], nrb[3]), cvtpk(nrk[0], nrk[1]), cvtpk(nrk[2], nrk[3])};
    asm volatile("s_waitcnt lgkmcnt(0)" ::: "memory"); __builtin_amdgcn_wave_barrier();
    float Tr[16];
#pragma unroll
    for (int j = 15; j >= 0; --j) {
        float acc0 = 0.f, acc1 = 0.f;
#pragma unroll
        for (int i4 = (j + 1) / 4; i4 < 4; ++i4) {
            const f32x4 mrow = *(const LAS f32x4*)(MT + j * 16 + 4 * i4);
#pragma unroll
            for (int e = 0; e < 4; ++e) { const int i = 4 * i4 + e; if (i > j) { if (e & 1) acc1 += Tr[i] * mrow[e]; else acc0 += Tr[i] * mrow[e]; } }
        }
        Tr[j] = (j == s) ? 1.0f : -(acc0 + acc1);
        if (j > s) Tr[j] = 0.f;
    }
    float t0 = 0.f, t1 = 0.f, t2 = 0.f, t3 = 0.f;
#pragma unroll
    for (int gg = 0; gg < 4; ++gg) if (g == gg) { t0 = Tr[4 * gg]; t1 = Tr[4 * gg + 1]; t2 = Tr[4 * gg + 2]; t3 = Tr[4 * gg + 3]; }
    *(LAS v4u*)(buf + S_MT * SLOT + lane * 16) = (v4u){cvtpk(mak[0], mak[1]), cvtpk(mak[2], mak[3]), cvtpk(-t0, -t1), cvtpk(-t2, -t3)};
    asm volatile("s_waitcnt lgkmcnt(0)" ::: "memory"); __builtin_amdgcn_wave_barrier();
}

__device__ __forceinline__ void rec_chunk(const LAS unsigned char* buf, f32x4 (&st)[4], float* Y, int b, int h, int dir, int n, int w, int lane) {
    const int g = lane >> 4, col = lane & 15;
    const bf16x8 fKK0 = *(const LAS bf16x8*)(buf + (S_KK + 0) * SLOT + lane * 16), fKK1 = *(const LAS bf16x8*)(buf + (S_KK + 1) * SLOT + lane * 16);
    const bf16x8 fR0 = *(const LAS bf16x8*)(buf + (S_R + 0) * SLOT + lane * 16), fR1 = *(const LAS bf16x8*)(buf + (S_R + 1) * SLOT + lane * 16);
    const v4u mt = *(const LAS v4u*)(buf + S_MT * SLOT + lane * 16);
    const bf16x8 fN = *(const LAS bf16x8*)(buf + S_N * SLOT + lane * 16);
    const u32x2 vf = *(const LAS u32x2*)(buf + (S_V + (w >> 1)) * SLOT + lane * 16 + (w & 1) * 8);
    const f32x4 z4 = {0.f, 0.f, 0.f, 0.f};
    const bf16x8 sb0 = mkfrag(cvtpk(st[0][0], st[0][1]), cvtpk(st[0][2], st[0][3]), cvtpk(st[1][0], st[1][1]), cvtpk(st[1][2], st[1][3]));
    const bf16x8 sb1 = mkfrag(cvtpk(st[2][0], st[2][1]), cvtpk(st[2][2], st[2][3]), cvtpk(st[3][0], st[3][1]), cvtpk(st[3][2], st[3][3]));
    f32x4 p1 = mma(fKK0, sb0, z4); p1 = mma(fKK1, sb1, p1);
    f32x4 p2 = mma(fR0, sb0, z4); p2 = mma(fR1, sb1, p2);
    const f32x4 x = mma(mkfrag(0u, 0u, mt.x, mt.y), mkfrag(0u, 0u, vf.x, vf.y), p1);
    const f32x4 u = mma(mkfrag(mt.z, mt.w, 0u, 0u), mkfrag(cvtpk(x[0], x[1]), cvtpk(x[2], x[3]), 0u, 0u), z4);
    const bf16x8 buv = mkfrag(cvtpk(u[0], u[1]), cvtpk(u[2], u[3]), vf.x, vf.y);
    const f32x4 y = mma(fN, buv, p2);
#pragma unroll
    for (int i = 0; i < 4; ++i) {
        const f32x4 gc = *(const LAS f32x4*)(buf + S_GC * SLOT + (16 * i + 4 * g) * 4);
        const bf16x8 fBK = *(const LAS bf16x8*)(buf + (S_BK + i) * SLOT + lane * 16);
        st[i] = mma(fBK, buv, st[i] * gc);
    }
    const int cn = dir ? (SEQ / 16 - 1 - n) : n;
#pragma unroll
    for (int r = 0; r < 4; ++r) { const int s = 4 * g + r, t = cn * 16 + (dir ? 15 - s : s);
        Y[((size_t)dir * T + (size_t)(b * SEQ + t)) * RW + h * 64 + 16 * w + col] = y[r]; }
}

__device__ __forceinline__ void chain(LAS unsigned char* L, const bf16* Z, const float* mu_prev, const float* mu_next, const float* w_decay0, const float* w_decay_up,
                                      const float* a_gate0, const float* a_gate_up, const float* k_k, const float* k_a, const float* r_k, float* Y, float* BON, int ch, int tid, int wave, int lane) {
    const int dir = ch & 1, h = (ch >> 1) & 7, b = ch >> 4;
    __syncthreads();
    setup(L, h, dir, mu_prev, mu_next, w_decay0, w_decay_up, a_gate0, a_gate_up, k_k, k_a, r_k, tid);
    __syncthreads();
    f32x4 st[4];
#pragma unroll
    for (int i = 0; i < 4; ++i) st[i] = (f32x4){0.f, 0.f, 0.f, 0.f};
    constexpr int NCH = SEQ / 16, NR = NCH / 8;
    for (int q = 0; q < NR; ++q) {
        helper_chunk(L, L + wave * BUF_BYTES, (LAS float*)(L + OFF_MT + wave * 1024), Z, BON, b, h, dir, 8 * q + wave, lane);
        __syncthreads();
        if (wave < 4) {
#pragma unroll 2
            for (int i = 0; i < 8; ++i) rec_chunk(L + i * BUF_BYTES, st, Y, b, h, dir, 8 * q + i, wave, lane);
        }
        __syncthreads();
    }
}
}

namespace attn {
typedef unsigned u32x2 __attribute__((ext_vector_type(2)));
constexpr int VT_STRIDE = 136;
constexpr int KF_OFF = 64 * VT_STRIDE;
constexpr int WAVE_LDS = KF_OFF + 8 * 1024;
constexpr float LOG2E = 1.44269504088896f, LN2 = 0.693147180559945f;
using scan::cvtpk; using scan::mkfrag; using scan::mma;

__device__ __forceinline__ void unpack8(const v4u w, float (&f)[8]) {
    f[0] = __uint_as_float(w.x << 16); f[1] = __uint_as_float(w.x & 0xffff0000u); f[2] = __uint_as_float(w.y << 16); f[3] = __uint_as_float(w.y & 0xffff0000u);
    f[4] = __uint_as_float(w.z << 16); f[5] = __uint_as_float(w.z & 0xffff0000u); f[6] = __uint_as_float(w.w << 16); f[7] = __uint_as_float(w.w & 0xffff0000u);
}

__device__ __forceinline__ void unit(LAS unsigned char* vt, const bf16* Z, const float* qg, const float* kg, bf16* Ob, int opitch, float* lse_out,
                                     int b, int h, int d, int r, int qb, int nb, int lane) {
    const int g = lane >> 4, c16 = lane & 15;
    const float slope2 = exp2f(-(float)(h + 1)) * LOG2E * (float)d;
    float gn[16];
#pragma unroll
    for (int m = 0; m < 2; ++m)
#pragma unroll
        for (int j = 0; j < 8; ++j) gn[m * 8 + j] = qg[32 * m + 8 * g + j] * kg[32 * m + 8 * g + j];
    bf16x8 qf[4][2];
#pragma unroll
    for (int qt = 0; qt < 4; ++qt) {
        const int tok = b * SEQ + (qb * 64 + 16 * qt + c16) * d + r;
        const bf16* qp = Z + (size_t)tok * INW + h * 64 + 8 * g;
        float f0[8], f1[8]; unpack8(*(const v4u*)qp, f0); unpack8(*(const v4u*)(qp + 32), f1);
        float ss = 0.f;
#pragma unroll
        for (int j = 0; j < 8; ++j) ss += f0[j] * f0[j] + f1[j] * f1[j];
        ss += __shfl_xor(ss, 16); ss += __shfl_xor(ss, 32);
        const float rs = (0.125f * LOG2E) / sqrtf(ss * (1.f / 64.f) + 1e-6f);
        qf[qt][0] = mkfrag(cvtpk(f0[0] * rs * gn[0], f0[1] * rs * gn[1]), cvtpk(f0[2] * rs * gn[2], f0[3] * rs * gn[3]), cvtpk(f0[4] * rs * gn[4], f0[5] * rs * gn[5]), cvtpk(f0[6] * rs * gn[6], f0[7] * rs * gn[7]));
        qf[qt][1] = mkfrag(cvtpk(f1[0] * rs * gn[8], f1[1] * rs * gn[9]), cvtpk(f1[2] * rs * gn[10], f1[3] * rs * gn[11]), cvtpk(f1[4] * rs * gn[12], f1[5] * rs * gn[13]), cvtpk(f1[6] * rs * gn[14], f1[7] * rs * gn[15]));
    }
    f32x4 oacc[4][4];
    float mrun[4], lrun[4];
#pragma unroll
    for (int qt = 0; qt < 4; ++qt) { mrun[qt] = -1e30f; lrun[qt] = 0.f;
#pragma unroll
        for (int dt = 0; dt < 4; ++dt) oacc[dt][qt] = (f32x4){0.f, 0.f, 0.f, 0.f}; }
    const f32x4 z4 = {0.f, 0.f, 0.f, 0.f};
#pragma unroll 1
    for (int kb = qb - 1; kb <= qb + 1; ++kb) {
        if (kb < 0 || kb >= nb) continue;
#pragma unroll
        for (int kblk = 0; kblk < 4; ++kblk) {
            const int tok = b * SEQ + (kb * 64 + 16 * kblk + c16) * d + r;
            const bf16* kp = Z + (size_t)tok * INW + AW + h * 64 + 8 * g;
            float f0[8], f1[8]; unpack8(*(const v4u*)kp, f0); unpack8(*(const v4u*)(kp + 32), f1);
            float ss = 0.f;
#pragma unroll
            for (int j = 0; j < 8; ++j) ss += f0[j] * f0[j] + f1[j] * f1[j];
            ss += __shfl_xor(ss, 16); ss += __shfl_xor(ss, 32);
            const float rsk = 1.0f / sqrtf(ss * (1.f / 64.f) + 1e-6f);
            *(LAS v4u*)(vt + KF_OFF + (kblk * 2 + 0) * 1024 + lane * 16) = (v4u){cvtpk(f0[0] * rsk, f0[1] * rsk), cvtpk(f0[2] * rsk, f0[3] * rsk), cvtpk(f0[4] * rsk, f0[5] * rsk), cvtpk(f0[6] * rsk, f0[7] * rsk)};
            *(LAS v4u*)(vt + KF_OFF + (kblk * 2 + 1) * 1024 + lane * 16) = (v4u){cvtpk(f1[0] * rsk, f1[1] * rsk), cvtpk(f1[2] * rsk, f1[3] * rsk), cvtpk(f1[4] * rsk, f1[5] * rsk), cvtpk(f1[6] * rsk, f1[7] * rsk)};
        }
#pragma unroll
        for (int i = 0; i < 8; ++i) {
            const int key = 8 * i + (lane >> 3), chunk = lane & 7;
            const int tok = b * SEQ + (kb * 64 + key) * d + r;
            const v4u w = *(const v4u*)(Z + (size_t)tok * INW + 2 * AW + h * 64 + 8 * chunk);
            LAS unsigned char* q = vt + (8 * chunk) * VT_STRIDE + 2 * key;
            *(LAS bf16*)(q + 0 * VT_STRIDE) = (bf16)(w.x & 0xffffu); *(LAS bf16*)(q + 1 * VT_STRIDE) = (bf16)(w.x >> 16);
            *(LAS bf16*)(q + 2 * VT_STRIDE) = (bf16)(w.y & 0xffffu); *(LAS bf16*)(q + 3 * VT_STRIDE) = (bf16)(w.y >> 16);
            *(LAS bf16*)(q + 4 * VT_STRIDE) = (bf16)(w.z & 0xffffu); *(LAS bf16*)(q + 5 * VT_STRIDE) = (bf16)(w.z >> 16);
            *(LAS bf16*)(q + 6 * VT_STRIDE) = (bf16)(w.w & 0xffffu); *(LAS bf16*)(q + 7 * VT_STRIDE) = (bf16)(w.w >> 16);
        }
        asm volatile("s_waitcnt lgkmcnt(0)" ::: "memory"); __builtin_amdgcn_wave_barrier();
        const int obase = (kb - qb) * 64;
#pragma unroll
        for (int qt = 0; qt < 4; ++qt) {
            f32x4 sa[4];
#pragma unroll
            for (int kblk = 0; kblk < 4; ++kblk) {
                const bf16x8 k0 = *(const LAS bf16x8*)(vt + KF_OFF + (kblk * 2 + 0) * 1024 + lane * 16), k1 = *(const LAS bf16x8*)(vt + KF_OFF + (kblk * 2 + 1) * 1024 + lane * 16);
                sa[kblk] = mma(k0, qf[qt][0], z4); sa[kblk] = mma(k1, qf[qt][1], sa[kblk]); }
            const int qi = 16 * qt + c16;
            float mx = -1e30f;
#pragma unroll
            for (int kblk = 0; kblk < 4; ++kblk)
#pragma unroll
                for (int reg = 0; reg < 4; ++reg) {
                    const int o = obase + 16 * kblk + 4 * g + reg - qi, ao = o < 0 ? -o : o;
                    float sv = sa[kblk][reg] - slope2 * (float)ao;
                    sv = (ao <= 64) ? sv : -1e30f;
                    sa[kblk][reg] = sv; mx = fmaxf(mx, sv);
                }
            mx = fmaxf(mx, __shfl_xor(mx, 16)); mx = fmaxf(mx, __shfl_xor(mx, 32));
            const float mn = fmaxf(mrun[qt], mx), alpha = exp2f(mrun[qt] - mn);
            mrun[qt] = mn;
            float ls = 0.f;
#pragma unroll
            for (int kblk = 0; kblk < 4; ++kblk)
#pragma unroll
                for (int reg = 0; reg < 4; ++reg) { const float p = exp2f(sa[kblk][reg] - mn); sa[kblk][reg] = p; ls += p; }
            lrun[qt] = lrun[qt] * alpha + ls;
            const bf16x8 pf0 = mkfrag(cvtpk(sa[0][0], sa[0][1]), cvtpk(sa[0][2], sa[0][3]), cvtpk(sa[1][0], sa[1][1]), cvtpk(sa[1][2], sa[1][3]));
            const bf16x8 pf1 = mkfrag(cvtpk(sa[2][0], sa[2][1]), cvtpk(sa[2][2], sa[2][3]), cvtpk(sa[3][0], sa[3][1]), cvtpk(sa[3][2], sa[3][3]));
#pragma unroll
            for (int dt = 0; dt < 4; ++dt) {
                const LAS unsigned char* vr = vt + (16 * dt + c16) * VT_STRIDE + 8 * g;
                const u32x2 a0 = *(const LAS u32x2*)(vr), a1 = *(const LAS u32x2*)(vr + 32), a2 = *(const LAS u32x2*)(vr + 64), a3 = *(const LAS u32x2*)(vr + 96);
                f32x4 oc = oacc[dt][qt] * alpha;
                oc = mma(mkfrag(a0.x, a0.y, a1.x, a1.y), pf0, oc);
                oc = mma(mkfrag(a2.x, a2.y, a3.x, a3.y), pf1, oc);
                oacc[dt][qt] = oc;
            }
            __builtin_amdgcn_sched_barrier(0);
        }
        asm volatile("s_waitcnt lgkmcnt(0)" ::: "memory"); __builtin_amdgcn_wave_barrier();
    }
#pragma unroll
    for (int qt = 0; qt < 4; ++qt) {
        float lt = lrun[qt]; lt += __shfl_xor(lt, 16); lt += __shfl_xor(lt, 32);
        const float inv = 1.0f / lt;
        const int tok = b * SEQ + (qb * 64 + 16 * qt + c16) * d + r;
        bf16* op = Ob + (size_t)tok * opitch + h * 64 + 4 * g;
#pragma unroll
        for (int dt = 0; dt < 4; ++dt) { const f32x4 o = oacc[dt][qt] * inv; u32x2 w; w.x = cvtpk(o[0], o[1]); w.y = cvtpk(o[2], o[3]); *(u32x2*)(op + 16 * dt) = w; }
        if (g == 0) lse_out[(size_t)tok * NH + h] = (mrun[qt] + log2f(lt)) * LN2;
    }
}
}

namespace peer {
using scan::cvtpk; using scan::mkfrag; using scan::mma;
constexpr int KEY_SLOTS = 64;

template <int CTRL> __device__ __forceinline__ unsigned dppu(unsigned x) { return (unsigned)__builtin_amdgcn_update_dpp((int)x, (int)x, CTRL, 0xf, 0xf, false); }
__device__ __forceinline__ unsigned umax(unsigned a, unsigned b) { return a > b ? a : b; }
__device__ __forceinline__ unsigned rowmax16(unsigned x) { x = umax(x, dppu<0xB1>(x)); x = umax(x, dppu<0x4E>(x)); x = umax(x, dppu<0x141>(x)); x = umax(x, dppu<0x140>(x)); return x; }
__device__ __forceinline__ float rowsum16(float x) {
    x += __uint_as_float(dppu<0xB1>(__float_as_uint(x))); x += __uint_as_float(dppu<0x4E>(__float_as_uint(x)));
    x += __uint_as_float(dppu<0x141>(__float_as_uint(x))); x += __uint_as_float(dppu<0x140>(__float_as_uint(x))); return x;
}
__device__ __forceinline__ unsigned ordkey(float f) { const unsigned u = __float_as_uint(f); return (u & 0x80000000u) ? ~u : (u | 0x80000000u); }
__device__ __forceinline__ float unordkey(unsigned k) { return __uint_as_float((k & 0x80000000u) ? (k ^ 0x80000000u) : ~k); }

__device__ __forceinline__ void setup_keys(LAS unsigned char* L, const float* keys1, const float* keys2, int tid) {
    LAS bf16* F = (LAS bf16*)L;
    for (int i = tid; i < KEY_SLOTS * 64 * 8; i += 512) {
        const int j = i & 7, l = (i >> 3) & 63, sl = i >> 9, ks = sl & 3, nt = (sl >> 2) & 7, sel = sl >> 5;
        const int n = 16 * nt + (l & 15), k = 32 * ks + 8 * (l >> 4) + j;
        F[i] = (bf16)f2bf((sel ? keys2 : keys1)[n * 128 + k]);
    }
}

#define CE_(a, b) do { const unsigned hi_ = umax(a, b), lo_ = (a < b) ? a : b; a = hi_; b = lo_; } while (0)
__device__ __forceinline__ void top16(unsigned (&key)[8][4], unsigned (&win)[4], int c16) {
#pragma unroll
    for (int reg = 0; reg < 4; ++reg) {
        CE_(key[0][reg], key[1][reg]); CE_(key[2][reg], key[3][reg]); CE_(key[4][reg], key[5][reg]); CE_(key[6][reg], key[7][reg]);
        CE_(key[0][reg], key[2][reg]); CE_(key[1][reg], key[3][reg]); CE_(key[4][reg], key[6][reg]); CE_(key[5][reg], key[7][reg]);
        CE_(key[1][reg], key[2][reg]); CE_(key[5][reg], key[6][reg]);
        CE_(key[0][reg], key[4][reg]); CE_(key[1][reg], key[5][reg]); CE_(key[2][reg], key[6][reg]); CE_(key[3][reg], key[7][reg]);
        CE_(key[2][reg], key[4][reg]); CE_(key[3][reg], key[5][reg]);
        CE_(key[1][reg], key[2][reg]); CE_(key[3][reg], key[4][reg]); CE_(key[5][reg], key[6][reg]);
    }
#pragma unroll 1
    for (int k = 0; k < TOPK; ++k) {
#pragma unroll
        for (int reg = 0; reg < 4; ++reg) {
            const unsigned m = rowmax16(key[0][reg]);
            win[reg] = (c16 == k) ? m : win[reg];
            const bool pop = key[0][reg] == m;
#pragma unroll
            for (int nt = 0; nt < 7; ++nt) key[nt][reg] = pop ? key[nt + 1][reg] : key[nt][reg];
            key[7][reg] = pop ? 0u : key[7][reg];
        }
    }
}
#undef CE_

__device__ __forceinline__ void select_batch(const LAS unsigned char* L, const bf16* Q, int* IDX, float* GATE, int batch, int lane) {
    const int g = lane >> 4, c16 = lane & 15;
    const LAS bf16x8* F = (const LAS bf16x8*)L;
    const bf16* qp = Q + (size_t)(batch * 16 + c16) * PKD + 8 * g;
    unsigned w1[4] = {0u, 0u, 0u, 0u}, w2[4] = {0u, 0u, 0u, 0u};
#pragma unroll
    for (int sel = 0; sel < 2; ++sel) {
        unsigned key[8][4];
        bf16x8 a[4];
#pragma unroll
        for (int ks = 0; ks < 4; ++ks) a[ks] = *(const bf16x8*)(qp + sel * 128 + 32 * ks);
#pragma unroll
        for (int nt = 0; nt < 8; ++nt) {
            f32x4 sc = {0.f, 0.f, 0.f, 0.f};
#pragma unroll
            for (int ks = 0; ks < 4; ++ks) sc = mma(a[ks], F[((sel * 8 + nt) * 4 + ks) * 64 + lane], sc);
#pragma unroll
            for (int reg = 0; reg < 4; ++reg) key[nt][reg] = (ordkey(sc[reg]) & ~127u) | (unsigned)(16 * nt + c16);
            __builtin_amdgcn_sched_barrier(0);
        }
        if (sel == 0) top16(key, w1, c16); else top16(key, w2, c16);
    }
    float f1[4], f2[4], cur2[4]; int ptr[4]; unsigned top[4];
#pragma unroll
    for (int reg = 0; reg < 4; ++reg) { f1[reg] = unordkey(w1[reg] & ~127u); f2[reg] = unordkey(w2[reg] & ~127u); ptr[reg] = 0; cur2[reg] = __shfl(f2[reg], lane & 48); top[reg] = 0u; }
#pragma unroll 1
    for (int k = 0; k < TOPK; ++k) {
#pragma unroll
        for (int reg = 0; reg < 4; ++reg) {
            const unsigned ck = (ptr[reg] < 16) ? ((ordkey(f1[reg] + cur2[reg]) & ~255u) | (unsigned)(c16 << 4) | (unsigned)ptr[reg]) : 0u;
            const unsigned m = rowmax16(ck);
            top[reg] = (c16 == k) ? m : top[reg];
            if ((int)((m >> 4) & 15u) == c16) ptr[reg] += 1;
            cur2[reg] = __shfl(f2[reg], (lane & 48) | (ptr[reg] & 15));
        }
    }
#pragma unroll
    for (int reg = 0; reg < 4; ++reg) {
        const int a = (top[reg] >> 4) & 15, bq = top[reg] & 15;
        const int e1 = (int)(__shfl(w1[reg], (lane & 48) | a) & 127u), e2 = (int)(__shfl(w2[reg], (lane & 48) | bq) & 127u);
        const float ts = unordkey(top[reg] & ~255u), mx = __shfl(ts, lane & 48);
        const float ex = __expf(ts - mx), sum = rowsum16(ex);
        const size_t o = (size_t)(batch * 16 + 4 * g + reg) * TOPK + c16;
        IDX[o] = e1 * NKEYS + e2; GATE[o] = ex / sum;
    }
}

__device__ __forceinline__ void convert_table(const float* src, bf16* dst, size_t n8, size_t gtid, size_t gthreads) {
    for (size_t i = gtid; i < n8; i += gthreads) {
        const f32x4 a = *(const f32x4*)(src + i * 8), b = *(const f32x4*)(src + i * 8 + 4);
        v4u o; o.x = cvtpk(a.x, a.y); o.y = cvtpk(a.z, a.w); o.z = cvtpk(b.x, b.y); o.w = cvtpk(b.z, b.w);
        *(v4u*)(dst + i * 8) = o;
    }
}

__device__ __forceinline__ float dot2bf(unsigned w, unsigned x, float acc) {
    typedef __bf16 bf2 __attribute__((ext_vector_type(2)));
    return __builtin_amdgcn_fdot2_f32_bf16(__builtin_bit_cast(bf2, w), __builtin_bit_cast(bf2, x), acc, false);
}
__device__ __forceinline__ float gelu_erf(float v) {
    const float av = fabsf(v), t = __builtin_amdgcn_rcpf(av * 0.2316418882f + 1.0f);
    float q = t * 0.5307027145f + (-0.7265760135f); q = q * t + 0.7107068705f; q = q * t + (-0.142248368f); q = q * t + 0.127414796f; q = q * t;
    const float e = __builtin_amdgcn_exp2f((v * v) * (-0.72134752044f));
    const float m = v * (q * e);
    return v < 0.f ? m : v - m;
}

typedef float f32x2c __attribute__((ext_vector_type(2)));
__device__ __forceinline__ void convert_rows_fp8(const float* src, unsigned char* dst, float* scale, int rows, int gw, int ngw, int lane) {
    for (int rrow = gw; rrow < rows; rrow += ngw) {
        const float* p = src + (size_t)rrow * D + 16 * lane;
        const f32x4 a = *(const f32x4*)p, b = *(const f32x4*)(p + 4), c = *(const f32x4*)(p + 8), d = *(const f32x4*)(p + 12);
        float m = fmaxf(fmaxf(fmaxf(fabsf(a.x), fabsf(a.y)), fmaxf(fabsf(a.z), fabsf(a.w))), fmaxf(fmaxf(fabsf(b.x), fabsf(b.y)), fmaxf(fabsf(b.z), fabsf(b.w))));
        m = fmaxf(m, fmaxf(fmaxf(fmaxf(fabsf(c.x), fabsf(c.y)), fmaxf(fabsf(c.z), fabsf(c.w))), fmaxf(fmaxf(fabsf(d.x), fabsf(d.y)), fmaxf(fabsf(d.z), fabsf(d.w)))));
#pragma unroll
        for (int o = 1; o < 64; o <<= 1) m = fmaxf(m, __shfl_xor(m, o));
        m = fmaxf(m, 1e-30f);
        const float inv = 448.0f / m;
        v4u w;
        w.x = (unsigned)__builtin_amdgcn_cvt_pk_fp8_f32(a.z * inv, a.w * inv, __builtin_amdgcn_cvt_pk_fp8_f32(a.x * inv, a.y * inv, 0, false), true);
        w.y = (unsigned)__builtin_amdgcn_cvt_pk_fp8_f32(b.z * inv, b.w * inv, __builtin_amdgcn_cvt_pk_fp8_f32(b.x * inv, b.y * inv, 0, false), true);
        w.z = (unsigned)__builtin_amdgcn_cvt_pk_fp8_f32(c.z * inv, c.w * inv, __builtin_amdgcn_cvt_pk_fp8_f32(c.x * inv, c.y * inv, 0, false), true);
        w.w = (unsigned)__builtin_amdgcn_cvt_pk_fp8_f32(d.z * inv, d.w * inv, __builtin_amdgcn_cvt_pk_fp8_f32(d.x * inv, d.y * inv, 0, false), true);
        *(v4u*)(dst + (size_t)rrow * D + 16 * lane) = w;
        if (lane == 0) scale[rrow] = m * (1.0f / 448.0f);
    }
}
__device__ __forceinline__ float sum8(float x) {
    x += __uint_as_float(dppu<0xB1>(__float_as_uint(x))); x += __uint_as_float(dppu<0x4E>(__float_as_uint(x))); x += __uint_as_float(dppu<0x141>(__float_as_uint(x))); return x;
}
__device__ __forceinline__ float dot16_fp8(const v4u q, const float (&x)[16]) {
    float d = 0.f;
    const f32x2c a0 = __builtin_amdgcn_cvt_pk_f32_fp8((int)q.x, false), a1 = __builtin_amdgcn_cvt_pk_f32_fp8((int)q.x, true), b0 = __builtin_amdgcn_cvt_pk_f32_fp8((int)q.y, false), b1 = __builtin_amdgcn_cvt_pk_f32_fp8((int)q.y, true);
    const f32x2c c0 = __builtin_amdgcn_cvt_pk_f32_fp8((int)q.z, false), c1 = __builtin_amdgcn_cvt_pk_f32_fp8((int)q.z, true), d0 = __builtin_amdgcn_cvt_pk_f32_fp8((int)q.w, false), d1 = __builtin_amdgcn_cvt_pk_f32_fp8((int)q.w, true);
    d += a0.x * x[0]; d += a0.y * x[1]; d += a1.x * x[2]; d += a1.y * x[3]; d += b0.x * x[4]; d += b0.y * x[5]; d += b1.x * x[6]; d += b1.y * x[7];
    d += c0.x * x[8]; d += c0.y * x[9]; d += c1.x * x[10]; d += c1.y * x[11]; d += d0.x * x[12]; d += d0.y * x[13]; d += d1.x * x[14]; d += d1.y * x[15];
    return d;
}
__device__ __forceinline__ void axpy16_fp8(const v4u q, float cf, float (&y)[16]) {
    const f32x2c a0 = __builtin_amdgcn_cvt_pk_f32_fp8((int)q.x, false), a1 = __builtin_amdgcn_cvt_pk_f32_fp8((int)q.x, true), b0 = __builtin_amdgcn_cvt_pk_f32_fp8((int)q.y, false), b1 = __builtin_amdgcn_cvt_pk_f32_fp8((int)q.y, true);
    const f32x2c c0 = __builtin_amdgcn_cvt_pk_f32_fp8((int)q.z, false), c1 = __builtin_amdgcn_cvt_pk_f32_fp8((int)q.z, true), d0 = __builtin_amdgcn_cvt_pk_f32_fp8((int)q.w, false), d1 = __builtin_amdgcn_cvt_pk_f32_fp8((int)q.w, true);
    y[0] += cf * a0.x; y[1] += cf * a0.y; y[2] += cf * a1.x; y[3] += cf * a1.y; y[4] += cf * b0.x; y[5] += cf * b0.y; y[6] += cf * b1.x; y[7] += cf * b1.y;
    y[8] += cf * c0.x; y[9] += cf * c0.y; y[10] += cf * c1.x; y[11] += cf * c1.y; y[12] += cf * d0.x; y[13] += cf * d0.y; y[14] += cf * d1.x; y[15] += cf * d1.y;
}

#define FFN_X16(x, xw0, xw1) float x[16]; \
        x[0] = __uint_as_float(xw0.x << 16); x[1] = __uint_as_float(xw0.x & 0xffff0000u); x[2] = __uint_as_float(xw0.y << 16); x[3] = __uint_as_float(xw0.y & 0xffff0000u); \
        x[4] = __uint_as_float(xw0.z << 16); x[5] = __uint_as_float(xw0.z & 0xffff0000u); x[6] = __uint_as_float(xw0.w << 16); x[7] = __uint_as_float(xw0.w & 0xffff0000u); \
        x[8] = __uint_as_float(xw1.x << 16); x[9] = __uint_as_float(xw1.x & 0xffff0000u); x[10] = __uint_as_float(xw1.y << 16); x[11] = __uint_as_float(xw1.y & 0xffff0000u); \
        x[12] = __uint_as_float(xw1.z << 16); x[13] = __uint_as_float(xw1.z & 0xffff0000u); x[14] = __uint_as_float(xw1.w << 16); x[15] = __uint_as_float(xw1.w & 0xffff0000u);
#define FFN_ISSUE_U(q, idv) do { _Pragma("unroll") for (int i = 0; i < 8; ++i) { const int ex_ = __shfl(idv, 8 * i + eg); \
            q[i] = *(const v4u*)(UT8 + (size_t)ex_ * D + 128 * sl + 16 * ch); } } while (0)
#define FFN_DOT_U(q, x, r) do { _Pragma("unroll") for (int i = 0; i < 8; ++i) { const float dot_ = sum8(dot16_fp8(q[i], x)); if (ch == i) r = dot_; } } while (0)
__device__ __forceinline__ void ffn_u_pass(const bf16* XN, const int* IDX, const unsigned char* UT8, float* PART, int sl, int wv, int nwv, int lane) {
    const int eg = lane >> 3, ch = lane & 7;
    v4u qA[8], qB[8];
    int t = wv; if (t >= T) return;
    int i0 = IDX[(size_t)t * HK + lane], i1 = IDX[(size_t)t * HK + 64 + lane], n0 = 0, n1 = 0;
    v4u x0 = *(const v4u*)(XN + (size_t)t * D + 128 * sl + 16 * ch), x1 = *(const v4u*)(XN + (size_t)t * D + 128 * sl + 16 * ch + 8), xn0 = x0, xn1 = x1;
    FFN_ISSUE_U(qA, i0);
#pragma unroll 1
    for (;;) {
        const int tn = t + nwv; const bool more = tn < T;
        if (more) { n0 = IDX[(size_t)tn * HK + lane]; n1 = IDX[(size_t)tn * HK + 64 + lane]; const bf16* xp = XN + (size_t)tn * D + 128 * sl + 16 * ch; xn0 = *(const v4u*)xp; xn1 = *(const v4u*)(xp + 8); }
        FFN_ISSUE_U(qB, i1);
        float r0 = 0.f, r1 = 0.f;
        { FFN_X16(x, x0, x1) FFN_DOT_U(qA, x, r0); }
        if (more) FFN_ISSUE_U(qA, n0);
        { FFN_X16(x, x0, x1) FFN_DOT_U(qB, x, r1); }
        float* pp = PART + ((size_t)sl * T + t) * HK + 8 * ch + eg; pp[0] = r0; pp[64] = r1;
        if (!more) break;
        i0 = n0; i1 = n1; x0 = xn0; x1 = xn1; t = tn;
    }
}
#define FFN_ISSUE_V(q, cf, idv, cv) do { _Pragma("unroll") for (int i = 0; i < 8; ++i) { const int ex_ = __shfl(idv, 8 * i + eg); cf[i] = __shfl(cv, 8 * i + eg); \
            q[i] = *(const v4u*)(VT8 + (size_t)ex_ * D + 128 * sl + 16 * ch); } } while (0)
__device__ __forceinline__ void ffn_v_pass(const int* IDX, const float* COEF, const unsigned char* VT8, const float* mod, float* out, int sl, int wv, int nwv, int lane) {
    const int eg = lane >> 3, ch = lane & 7, col = 128 * sl + 16 * ch;
    v4u qA[8], qB[8]; float cfA[8], cfB[8];
    int t = wv; if (t >= T) return;
    int i0 = IDX[(size_t)t * HK + lane], i1 = IDX[(size_t)t * HK + 64 + lane], n0 = 0, n1 = 0;
    float c0 = COEF[(size_t)t * HK + lane], c1 = COEF[(size_t)t * HK + 64 + lane], cn0 = 0.f, cn1 = 0.f;
    FFN_ISSUE_V(qA, cfA, i0, c0);
#pragma unroll 1
    for (;;) {
        const int tn = t + nwv; const bool more = tn < T;
        if (more) { n0 = IDX[(size_t)tn * HK + lane]; n1 = IDX[(size_t)tn * HK + 64 + lane]; cn0 = COEF[(size_t)tn * HK + lane]; cn1 = COEF[(size_t)tn * HK + 64 + lane]; }
        FFN_ISSUE_V(qB, cfB, i1, c1);
        const size_t o = (size_t)t * D + col; const int b = t / SEQ;
        float y[16];
#pragma unroll
        for (int k = 0; k < 16; ++k) y[k] = 0.f;
#pragma unroll
        for (int i = 0; i < 8; ++i) { axpy16_fp8(qA[i], cfA[i], y); if (i & 1) __builtin_amdgcn_sched_barrier(0); }
        if (more) FFN_ISSUE_V(qA, cfA, n0, cn0);
        f32x4 oa[4];
#pragma unroll
        for (int k4 = 0; k4 < 4; ++k4) oa[k4] = *(const f32x4*)(out + o + 4 * k4);
#pragma unroll
        for (int i = 0; i < 8; ++i) { axpy16_fp8(qB[i], cfB[i], y); if (i & 1) __builtin_amdgcn_sched_barrier(0); }
#pragma unroll
        for (int k = 0; k < 16; ++k) { y[k] += __uint_as_float(dppu<0x128>(__float_as_uint(y[k]))); y[k] += __shfl_xor(y[k], 16); y[k] += __shfl_xor(y[k], 32); }
        if (eg == 0) {
#pragma unroll
            for (int k4 = 0; k4 < 4; ++k4) { f32x4 w = oa[k4]; const f32x4 ga = *(const f32x4*)(mod + b * MODW + 5 * D + col + 4 * k4);
                w.x += ga.x * y[4 * k4]; w.y += ga.y * y[4 * k4 + 1]; w.z += ga.z * y[4 * k4 + 2]; w.w += ga.w * y[4 * k4 + 3]; *(f32x4*)(out + o + 4 * k4) = w; } }
        if (!more) break;
        i0 = n0; i1 = n1; c0 = cn0; c1 = cn1; t = tn;
    }
}
}

namespace fin {
using scan::cvtpk; using scan::mkfrag; using scan::mma;
typedef unsigned u32x2 __attribute__((ext_vector_type(2)));

__device__ __forceinline__ float shift3(const bf16* p, bool hasp, bool hasn, float mp, float mn) {
    const float z = bf2f(p[0]), zp = hasp ? bf2f(p[-INW]) : 0.f, zn = hasn ? bf2f(p[INW]) : 0.f;
    return z + mp * (zp - z) + mn * (zn - z);
}

__device__ __forceinline__ void unpack4(const u32x2 w, float (&f)[4]) {
    f[0] = __uint_as_float(w.x << 16); f[1] = __uint_as_float(w.x & 0xffff0000u); f[2] = __uint_as_float(w.y << 16); f[3] = __uint_as_float(w.y & 0xffff0000u);
}
__device__ __forceinline__ void phase(LAS unsigned char* L, const bf16* Z, const float* mu_prev, const float* mu_next, const float* g_up, const float* Y, const float* BON,
                                      const float* k_a, const float* r_k, const float* lnx_g, const float* lnx_b, bf16* mix, const bf16* O3, const float* LSE,
                                      int bx, int G, int tid, int wave, int lane) {
    const int g = lane >> 4, c16 = lane & 15, ch0 = 64 * wave + 4 * c16;
    LAS bf16* sg = (LAS bf16*)L;
    bf16x8 bf[4][4];
#pragma unroll
    for (int ks = 0; ks < 4; ++ks) {
        f32x4 rowv[8];
#pragma unroll
        for (int jj = 0; jj < 8; ++jj) rowv[jj] = *(const f32x4*)(g_up + (size_t)(32 * ks + 8 * g + jj) * RW + ch0);
#pragma unroll
        for (int nt = 0; nt < 4; ++nt) bf[nt][ks] = mkfrag(cvtpk(rowv[0][nt], rowv[1][nt]), cvtpk(rowv[2][nt], rowv[3][nt]), cvtpk(rowv[4][nt], rowv[5][nt]), cvtpk(rowv[6][nt], rowv[7][nt]));
    }
    const f32x4 mpr = *(const f32x4*)(mu_prev + ch0), mnr = *(const f32x4*)(mu_next + ch0), mpk = *(const f32x4*)(mu_prev + RW + ch0), mnk = *(const f32x4*)(mu_next + RW + ch0),
                mpv = *(const f32x4*)(mu_prev + 2 * RW + ch0), mnv = *(const f32x4*)(mu_next + 2 * RW + ch0);
    const f32x4 ka1 = *(const f32x4*)(k_a + ch0), rk1 = *(const f32x4*)(r_k + ch0), lg = *(const f32x4*)(lnx_g + ch0), lb = *(const f32x4*)(lnx_b + ch0);
    const int j0 = (tid & 31) * 4;
    const f32x4 mpg = *(const f32x4*)(mu_prev + 3 * RW + DL + AL + j0), mng = *(const f32x4*)(mu_next + 3 * RW + DL + AL + j0);
    for (int tb = bx; tb < T / 16; tb += G) {
        const int tok0 = tb * 16;
        __syncthreads();
        {
            const int tl = tid >> 5, tok = tok0 + tl, t = tok % SEQ;
            const bf16* p = Z + (size_t)tok * INW + 3 * AW + 3 * RW + DL + AL + j0;
            const bool hasp = t > 0, hasn = t < SEQ - 1;
            float zc[4], zp[4], zn[4];
            unpack4(*(const u32x2*)p, zc); unpack4(*(const u32x2*)(hasp ? p - INW : p), zp); unpack4(*(const u32x2*)(hasn ? p + INW : p), zn);
            float o[4];
#pragma unroll
            for (int e = 0; e < 4; ++e) { const float pv = hasp ? zp[e] : 0.f, nv = hasn ? zn[e] : 0.f; const float v = zc[e] + mpg[e] * (pv - zc[e]) + mng[e] * (nv - zc[e]); o[e] = __builtin_amdgcn_rcpf(1.0f + __expf(-v)); }
            u32x2 w; w.x = cvtpk(o[0], o[1]); w.y = cvtpk(o[2], o[3]);
            *(LAS u32x2*)(sg + tl * 128 + j0) = w;
        }
        __syncthreads();
        f32x4 ga[4];
        {
            bf16x8 af[4];
#pragma unroll
            for (int ks = 0; ks < 4; ++ks) af[ks] = *(const LAS bf16x8*)(sg + c16 * 128 + 32 * ks + 8 * g);
#pragma unroll
            for (int nt = 0; nt < 4; ++nt) { f32x4 a = {0.f, 0.f, 0.f, 0.f};
#pragma unroll
                for (int ks = 0; ks < 4; ++ks) a = mma(af[ks], bf[nt][ks], a);
                ga[nt] = a; }
        }
#pragma unroll
        for (int reg = 0; reg < 4; ++reg) {
            const int tok = tok0 + 4 * g + reg, t = tok % SEQ;
            const bool hasp = t > 0, hasn = t < SEQ - 1;
            const bf16* zr = Z + (size_t)tok * INW + 3 * AW + ch0;
            const size_t o = (size_t)tok * RW + ch0;
            const f32x4 y0 = *(const f32x4*)(Y + o), y1 = *(const f32x4*)(Y + (size_t)T * RW + o);
            float rc[4], rp[4], rn[4], kc[4], kp[4], kn[4], vc[4], vp[4], vn[4];
            unpack4(*(const u32x2*)zr, rc); unpack4(*(const u32x2*)(hasp ? zr - INW : zr), rp); unpack4(*(const u32x2*)(hasn ? zr + INW : zr), rn);
            unpack4(*(const u32x2*)(zr + RW), kc); unpack4(*(const u32x2*)(hasp ? zr + RW - INW : zr + RW), kp); unpack4(*(const u32x2*)(hasn ? zr + RW + INW : zr + RW), kn);
            unpack4(*(const u32x2*)(zr + 2 * RW), vc); unpack4(*(const u32x2*)(hasp ? zr + 2 * RW - INW : zr + 2 * RW), vp); unpack4(*(const u32x2*)(hasn ? zr + 2 * RW + INW : zr + 2 * RW), vn);
            bf16* mp = mix + (size_t)tok * D + ch0;
            float o1[4], o2[4], o3[4];
            unpack4(*(const u32x2*)mp, o1); unpack4(*(const u32x2*)(mp + AW), o2); unpack4(*(const u32x2*)(O3 + (size_t)tok * AW + ch0), o3);
            const float l1 = LSE[(size_t)tok * NH + wave], l2 = LSE[((size_t)T + tok) * NH + wave], l3 = LSE[((size_t)2 * T + tok) * NH + wave];
            const float bon = BON[(size_t)tok * NH + wave] + BON[((size_t)T + tok) * NH + wave];
            float yv[4], vv[4], s1 = 0.f, sb = 0.f;
#pragma unroll
            for (int nt = 0; nt < 4; ++nt) {
                yv[nt] = y0[nt] + y1[nt]; s1 += yv[nt];
                const float pr = hasp ? rp[nt] : 0.f, nr = hasn ? rn[nt] : 0.f, pk = hasp ? kp[nt] : 0.f, nk = hasn ? kn[nt] : 0.f, pvv = hasp ? vp[nt] : 0.f, nvv = hasn ? vn[nt] : 0.f;
                const float rr = rc[nt] + mpr[nt] * (pr - rc[nt]) + mnr[nt] * (nr - rc[nt]);
                const float kk = kc[nt] + mpk[nt] * (pk - kc[nt]) + mnk[nt] * (nk - kc[nt]);
                vv[nt] = vc[nt] + mpv[nt] * (pvv - vc[nt]) + mnv[nt] * (nvv - vc[nt]);
                sb += rr * kk * rk1[nt] * (1.0f - ka1[nt]);
            }
            const float mean = peer::rowsum16(s1) * (1.f / 64.f);
            float s2 = 0.f;
#pragma unroll
            for (int nt = 0; nt < 4; ++nt) s2 += (yv[nt] - mean) * (yv[nt] - mean);
            const float rstd = __builtin_amdgcn_rsqf(peer::rowsum16(s2) * (1.f / 64.f) + 64e-5f);
            const float bs = peer::rowsum16(sb) + 0.5f * bon;
            const float lm = fmaxf(l1, fmaxf(l2, l3)), w1 = __expf(l1 - lm), w2 = __expf(l2 - lm), w3 = __expf(l3 - lm), wi = __builtin_amdgcn_rcpf(w1 + w2 + w3);
            float att[4], rw[4];
#pragma unroll
            for (int nt = 0; nt < 4; ++nt) {
                att[nt] = (w1 * o1[nt] + w2 * o2[nt] + w3 * o3[nt]) * wi;
                rw[nt] = ((yv[nt] - mean) * rstd * lg[nt] + lb[nt] + bs * vv[nt]) * ga[nt][reg];
            }
            u32x2 wa, wr; wa.x = cvtpk(att[0], att[1]); wa.y = cvtpk(att[2], att[3]); wr.x = cvtpk(rw[0], rw[1]); wr.y = cvtpk(rw[2], rw[3]);
            *(u32x2*)mp = wa; *(u32x2*)(mp + AW) = wr;
            __builtin_amdgcn_sched_barrier(0);
        }
    }
}
}

#ifndef MK_SKIP
#define MK_SKIP 0
#endif
constexpr int N_PHASES = 12;
struct Args { const float* in[27]; float* out; unsigned char* ws; int ph_lo, ph_hi, li, pad; };

__global__ void __launch_bounds__(NWAVES * 64, 2) mk_fwd(Args args) {
    extern __shared__ __attribute__((aligned(16))) unsigned char lds[];
    LAS unsigned char* L = (LAS unsigned char*)lds;
    volatile LAS unsigned* MISC = (volatile LAS unsigned*)(L + MISC_OFF);
    const int tid = threadIdx.x, lane = tid & 63, wave = __builtin_amdgcn_readfirstlane(tid >> 6);
    const int G = gridDim.x, bx = blockIdx.x;
    unsigned char* ws = args.ws;
    gu32* ctl = (gu32*)(ws + WS_CTL);
    const float* x = args.in[0]; const float* cvec = args.in[1]; const float* ada_w = args.in[2]; const float* ada_b = args.in[3];
    const float* norm1_g = args.in[4]; const float* w_in = args.in[5]; const float* mu_prev = args.in[6]; const float* mu_next = args.in[7];
    const float* q_norm_g = args.in[8]; const float* k_norm_g = args.in[9]; const float* w_decay0 = args.in[10]; const float* w_decay_up = args.in[11];
    const float* a_gate0 = args.in[12]; const float* a_gate_up = args.in[13]; const float* g_up = args.in[14]; const float* k_k = args.in[15];
    const float* k_a = args.in[16]; const float* r_k = args.in[17]; const float* lnx_g = args.in[18]; const float* lnx_b = args.in[19];
    const float* w_out = args.in[20]; const float* norm2_g = args.in[21]; const float* w_query = args.in[22]; const float* keys1 = args.in[23];
    const float* keys2 = args.in[24]; const float* peer_u = args.in[25]; const float* peer_v = args.in[26];
    float* out = args.out;
    float* MOD = (float*)(ws + WS_MOD); bf16* KEYS = (bf16*)(ws + WS_KEYS); bf16* WIN = (bf16*)(ws + WS_WIN); bf16* WOUT = (bf16*)(ws + WS_WOUT); bf16* WQ = (bf16*)(ws + WS_WQ);
    bf16* XN = (bf16*)(ws + WS_XN); bf16* Z = (bf16*)(ws + WS_Z); bf16* MIX = (bf16*)(ws + WS_MIX); float* Y = (float*)(ws + WS_Y); bf16* Q = (bf16*)(ws + WS_Q);
    int* IDX = (int*)(ws + WS_IDX); float* GATE = (float*)(ws + WS_GATE); float* BON = (float*)(ws + WS_BON);
    bf16* O3 = (bf16*)(ws + WS_O3); float* LSE = (float*)(ws + WS_LSE); unsigned char* UT8 = ws + WS_UT; unsigned char* VT8 = ws + WS_VT; float* SU = (float*)(ws + WS_SU); float* SV = (float*)(ws + WS_SU + 65536); float* PART = (float*)(ws + WS_PART);

    for (int u = tid; u < (LDS_BYTES - LDSCTL_OFF) / 4; u += NWAVES * 64) ((LAS unsigned*)(L + LDSCTL_OFF))[u] = 0u;
    __syncthreads();
    XcdBarrier bar = xcd_barrier_post((unsigned*)(ctl + CW_BAR) + args.li * XCD_BAR_WORDS, MISC + 8);
    const int lo = args.ph_lo, hi = args.ph_hi;
#define IN(k) (lo <= (k) && (k) < hi)
#define SEAM(k) do { if (IN(k) && IN((k) + 1)) xcd_barrier(bar); } while (0)
    const int gw = bx * NWAVES + wave, NGW = G * NWAVES;

    if (IN(0) && !(MK_SKIP & (1 << 0))) {
        if (bx < MODW / 64) {
            LAS float* sc = (LAS float*)L; LAS float* part = (LAS float*)(L + 32768);
            for (int i = tid; i < BATCH * D; i += NWAVES * 64) { const float cv = cvec[i]; sc[i] = cv / (1.f + expf(-cv)); }
            __syncthreads();
            const int j0 = bx * 64;
            float acc[BATCH];
#pragma unroll
            for (int b = 0; b < BATCH; ++b) acc[b] = 0.f;
            for (int i = wave * 128; i < wave * 128 + 128; ++i) { const float w = ada_w[(size_t)i * MODW + j0 + lane];
#pragma unroll
                for (int b = 0; b < BATCH; ++b) acc[b] += sc[b * D + i] * w; }
#pragma unroll
            for (int b = 0; b < BATCH; ++b) part[(wave * 8 + b) * 64 + lane] = acc[b];
            __syncthreads();
            { const int b = tid >> 6; float s = 0.f;
#pragma unroll
              for (int w = 0; w < 8; ++w) s += part[(w * 8 + b) * 64 + lane];
              MOD[b * MODW + j0 + lane] = s + ada_b[j0 + lane]; }
            __syncthreads();
        }
        LAS float* scr = (LAS float*)(L + RING_OFF + wave * 16384);
        constexpr int I_IN = (D / 64) * (INW / 32), I_OUT = (D / 64) * (D / 32), I_Q = (D / 64) * (QW / 32);
        for (int it = gw; it < I_IN + I_OUT + I_Q; it += NGW) {
            int r = it;
            if (r < I_IN) { p0_transpose_item(w_in, D, INW, WIN, 0, scr, r, lane); continue; } r -= I_IN;
            if (r < I_OUT) { p0_transpose_item(w_out, D, D, WOUT, 0, scr, r, lane); continue; } r -= I_OUT;
            p0_transpose_item(w_query, D, QW, WQ, 0, scr, r, lane);
        }
    }
    SEAM(0);
    if (IN(1) && !(MK_SKIP & (1 << 1))) { for (int m = gw; m < T; m += NGW) norm_row(x + (size_t)m * D, norm1_g, MOD + (m / SEQ) * MODW, 0, D, XN + (size_t)m * D, lane); }
    SEAM(1);
    if (IN(2) && !(MK_SKIP & (1 << 2))) {
        pg8::Gemm g{XN, WIN, T, INW, D}; pg8::StaticOrder S; S.init(T, INW, G, bx);
        pg8::EpiBf16<0> E{Z, INW, nullptr, 0, 0, 1.f};
        pg8::gemm_phase<pg8::EpiBf16<0>, pg8::StaticOrder, true, true>(L + RING_OFF, g, S, E);
    }
    SEAM(2);
    if (IN(3) && !(MK_SKIP & (1 << 3))) {
        constexpr int NCHAIN = BATCH * NH * 2;
        if (bx < NCHAIN) scan::chain(L, Z, mu_prev, mu_next, w_decay0, w_decay_up, a_gate0, a_gate_up, k_k, k_a, r_k, Y, BON, bx, tid, wave, lane);
        {
            gu32* ucnt = ctl + CW_WORK + 64 * args.li;
            LAS unsigned char* vt = L + wave * attn::WAVE_LDS;
            for (;;) {
                unsigned uu = 0u;
                if (lane == 0) uu = __hip_atomic_fetch_add(ucnt, 1u, __ATOMIC_RELAXED, __HIP_MEMORY_SCOPE_AGENT);
                const int u = __builtin_amdgcn_readfirstlane((int)uu);
                if (u >= BATCH * NH * 96) break;
                const int x = u & 31, p = (u >> 5) % 3, bh = u / 96;
                const int d = (p == 0) ? 1 : (p == 1 ? 4 : 16), nb = 32 / d, r = x / nb, qb = x % nb;
                bf16* Ob = (p == 0) ? MIX : (p == 1 ? MIX + AW : O3); const int opitch = (p == 2) ? AW : D;
                attn::unit(vt, Z, q_norm_g, k_norm_g, Ob, opitch, LSE + (size_t)p * T * NH, bh >> 3, bh & 7, d, r, qb, nb, lane);
            }
        }
    }
    SEAM(3);
    if (IN(4) && !(MK_SKIP & (1 << 4))) { fin::phase(L, Z, mu_prev, mu_next, g_up, Y, BON, k_a, r_k, lnx_g, lnx_b, MIX, O3, LSE, bx, G, tid, wave, lane); }
    SEAM(4);
    if (IN(5) && !(MK_SKIP & (1 << 5))) {
        pg8::Gemm g{MIX, WOUT, T, D, D}; pg8::StaticOrder S; S.init(T, D, G, bx);
        EpiRes E{x, MOD, 2 * D, out, D};
        pg8::gemm_phase<EpiRes, pg8::StaticOrder, true, true>(L + RING_OFF, g, S, E);
    }
    SEAM(5);
    if (IN(6) && !(MK_SKIP & (1 << 6))) { for (int m = gw; m < T; m += NGW) norm_row(out + (size_t)m * D, norm2_g, MOD + (m / SEQ) * MODW, 3 * D, 4 * D, XN + (size_t)m * D, lane);
        peer::convert_rows_fp8(peer_u, UT8, SU, NKEYS * NKEYS, gw, NGW, lane); peer::convert_rows_fp8(peer_v, VT8, SV, NKEYS * NKEYS, gw, NGW, lane); }
    SEAM(6);
    if (IN(7) && !(MK_SKIP & (1 << 7))) {
        pg8::Gemm g{XN, WQ, T, QW, D}; pg8::StaticOrder S; S.init(T, QW, G, bx);
        pg8::EpiBf16<0> E{Q, QW, nullptr, 0, 0, 1.f};
        pg8::gemm_phase<pg8::EpiBf16<0>, pg8::StaticOrder, true, true>(L + RING_OFF, g, S, E);
    }
    SEAM(7);
    if (IN(8) && !(MK_SKIP & (1 << 8))) { __syncthreads(); peer::setup_keys(L, keys1, keys2, tid); __syncthreads();
        for (int bt = gw; bt < T * PH / 16; bt += NGW) peer::select_batch(L, Q, IDX, GATE, bt, lane); }
    SEAM(8);
    {
        const int sl = bx & 7, wv = (bx >> 3) * NWAVES + wave, nwv = (G >> 3) * NWAVES;
        if (IN(9) && !(MK_SKIP & (1 << 9))) { peer::ffn_u_pass(XN, IDX, UT8, PART, sl, wv, nwv, lane); }
        SEAM(9);
        if (IN(10) && !(MK_SKIP & (1 << 10))) {
            for (size_t i = (size_t)bx * NWAVES * 64 + tid; i < (size_t)T * HK; i += (size_t)G * NWAVES * 64) {
                float d = 0.f;
#pragma unroll
                for (int s8 = 0; s8 < 8; ++s8) d += PART[(size_t)s8 * T * HK + i];
                const int ex = IDX[i];
                GATE[i] = GATE[i] * peer::gelu_erf(d * SU[ex]) * SV[ex];
            }
        }
        SEAM(10);
        if (IN(11) && !(MK_SKIP & (1 << 11))) { peer::ffn_v_pass(IDX, GATE, VT8, MOD, out, sl, wv, nwv, lane); }
    }
#undef IN
#undef SEAM
}

extern "C" void kernel_launch(void* const* d_in, const int* in_sizes, int n_in, void* d_out, int out_size, void* d_ws, size_t ws_size, hipStream_t stream) {
    static int grid = 0;
    if (grid == 0) {
        if (n_in != 27 || in_sizes[0] != T * D || out_size != T * D || ws_size < WS_END) { fprintf(stderr, "kernel_launch: unexpected problem (n_in %d, in0 %d, out %d, ws %zu); nothing launched\n", n_in, n_in > 0 ? in_sizes[0] : -1, out_size, ws_size); grid = -1; return; }
        int dev = 0, cus = 0, per_cu = 0;
        if (hipGetDevice(&dev) != hipSuccess || hipDeviceGetAttribute(&cus, hipDeviceAttributeMultiprocessorCount, dev) != hipSuccess) { fprintf(stderr, "kernel_launch: device query failed\n"); grid = -1; return; }
        if (hipFuncSetAttribute((const void*)mk_fwd, hipFuncAttributeMaxDynamicSharedMemorySize, LDS_BYTES) != hipSuccess) { fprintf(stderr, "kernel_launch: hipFuncSetAttribute failed\n"); grid = -1; return; }
        if (hipOccupancyMaxActiveBlocksPerMultiprocessor(&per_cu, (const void*)mk_fwd, NWAVES * 64, LDS_BYTES) != hipSuccess || per_cu < 1)
            fprintf(stderr, "kernel_launch: note: occupancy query reports %d workgroups per CU\n", per_cu);
        (void)hipGetLastError();
        grid = cus;
    }
    if (grid < 0) return;
    if (hipMemsetAsync((char*)d_ws + WS_CTL, 0, CTL_ZERO_BYTES, stream) != hipSuccess) { fprintf(stderr, "kernel_launch: hipMemsetAsync failed\n"); return; }
    Args a{};
    for (int i = 0; i < 27; ++i) a.in[i] = (const float*)d_in[i];
    a.out = (float*)d_out; a.ws = (unsigned char*)d_ws;
#ifndef MK_RANGES
#define MK_RANGES {{0, N_PHASES}}
#endif
    static const int ranges[][2] = MK_RANGES;
    const int nl = (int)(sizeof(ranges) / sizeof(ranges[0]));
    for (int li = 0; li < nl; ++li) {
        a.ph_lo = ranges[li][0]; a.ph_hi = ranges[li][1]; a.li = li;
        hipLaunchKernelGGL(mk_fwd, dim3(grid), dim3(NWAVES * 64), LDS_BYTES, stream, a);
        const hipError_t le = hipPeekAtLastError();
        if (le != hipSuccess) { fprintf(stderr, "kernel_launch: launch %d failed: %s\n", li, hipGetErrorName(le)); break; }
    }
}
```

```cpp
#include <hip/hip_runtime.h>
#include <cstdio>
#include <cstdint>
#include <cmath>
namespace pg8 {
#define PG8_LAS __attribute__((address_space(3)))
typedef unsigned short bf16_t;
typedef short bf16x8 __attribute__((ext_vector_type(8)));
typedef float f32x4 __attribute__((ext_vector_type(4)));
typedef unsigned u32x4 __attribute__((ext_vector_type(4)));
constexpr int BM = 256, BK = 64, HALF = 128, HTB = HALF * BK * 2  , STAGE_BYTES = 8 * HTB, NXCD = 8, WGM = 8;

__host__ __device__ __forceinline__ int lds_byte(int r, int c) { const int st = (r >> 4) * 2 + (c >> 5), rr = r & 15, cc = c & 31, ob = rr * 64 + cc * 2; return st * 1024 + (ob ^ (((ob >> 9) & 1) << 5)); }
__host__ __device__ __forceinline__ void stage_rc(int b, int& R, int& C) { const int st = b / 1024, sb = b % 1024, swz = sb ^ (((sb >> 9) & 1) << 5); R = (st >> 1) * 16 + swz / 64; C = (st & 1) * 32 + (swz % 64) / 2; }
__host__ __device__ __forceinline__ int perm32(int rho) { const int n = rho >> 4, i = rho & 15; return 8 * (i >> 2) + 4 * n + (i & 3); }

struct Unit { int pm, pn; };
struct Gemm { const bf16_t* A; const bf16_t* Bt; int M, N, K; };

struct StaticOrder {
    int nM, nN, nwg, G, c;
    __host__ __device__ void init(int M, int N, int G_, int c_) { nM = M / BM; nN = N / BM; nwg = nM * nN; G = G_; c = c_; }
    __host__ __device__ bool next(int i, Unit& u) const {
        const long L = (long)i * G + c; if (L >= nwg) return false;
        int wgid = (int)L; { const int q = nwg / NXCD, r = nwg % NXCD, xcd = wgid % NXCD, off = wgid / NXCD; wgid = (xcd < r ? xcd * (q + 1) : r * (q + 1) + (xcd - r) * q) + off; }
        const int nig = WGM * nN, gid = wgid / nig, fm = gid * WGM, gsz = (nM - fm) < WGM ? (nM - fm) : WGM;
        u.pm = fm + ((wgid % nig) % gsz); u.pn = (wgid % nig) / gsz; return true;
    }
    __device__ __forceinline__ void a_ready(const Unit&) const {}
    __device__ __forceinline__ void done(const Unit&) const {}
};

__device__ __forceinline__ unsigned cvt_pk_bf16(float lo, float hi) { unsigned r; asm volatile("v_cvt_pk_bf16_f32 %0, %1, %2" : "=v"(r) : "v"(lo), "v"(hi)); return r; }
typedef float f32x2 __attribute__((ext_vector_type(2)));
__device__ __forceinline__ f32x2 gelu_pk(f32x2 v) {
    const f32x2 av = __builtin_elementwise_abs(v), d = av * 0.2316418882f + 1.0f;
    f32x2 t; t.x = __builtin_amdgcn_rcpf(d.x); t.y = __builtin_amdgcn_rcpf(d.y);
    f32x2 q = t * 0.5307027145f + (-0.7265760135f); q = q * t + 0.7107068705f; q = q * t + (-0.142248368f); q = q * t + 0.127414796f; q = q * t;
    const f32x2 s = (v * v) * (-0.72134752044f);
    f32x2 e; e.x = __builtin_amdgcn_exp2f(s.x); e.y = __builtin_amdgcn_exp2f(s.y);
    const f32x2 m = v * (q * e), r = v - m;
    f32x2 o; o.x = v.x < 0.f ? m.x : r.x; o.y = v.y < 0.f ? m.y : r.y; return o;
}

template <int ACT  > struct EpiBf16 {
    static constexpr bool PERM = true, AFTER_DRAIN = false; static_assert(ACT == 0 || ACT == 1, "EpiBf16: ACT is 0 (none) or 1 (gelu_pk)");
    bf16_t* O; int ldc; const float* bias; int split_cols; size_t split_stride; float scale0;
    __device__ __forceinline__ void operator()(const f32x4 (&acc)[2][2][4][2], const Unit& u, int wr, int wc, int fr, int fq) const {
        const int row0 = u.pm * BM + wr * 64 + fr; int colt = u.pn * BM; bf16_t* base = O;
        float sc = 1.f; if (split_cols) { const int t = colt / split_cols; base += (size_t)t * split_stride; colt -= t * split_cols; if (t == 0) sc = scale0; }
        const int col0 = colt + wc * 32 + 8 * fq, bcol0 = u.pn * BM + wc * 32 + 8 * fq;
        f32x4 bv[2][2];
#pragma unroll
        for (int bj = 0; bj < 2; ++bj)
#pragma unroll
            for (int n = 0; n < 2; ++n) bv[bj][n] = bias ? *(const f32x4*)(bias + bcol0 + bj * HALF + 4 * n) : (f32x4){0.f, 0.f, 0.f, 0.f};
#pragma unroll
        for (int ai = 0; ai < 2; ++ai)
#pragma unroll
            for (int m = 0; m < 4; ++m) { bf16_t* rowp = base + (size_t)(row0 + ai * HALF + m * 16) * ldc + col0;
#pragma unroll
                for (int bj = 0; bj < 2; ++bj) { f32x4 v0 = acc[ai][bj][m][0] + bv[bj][0], v1 = acc[ai][bj][m][1] + bv[bj][1];
                    if (ACT == 1) { f32x2 a = gelu_pk((f32x2){v0[0], v0[1]}), b = gelu_pk((f32x2){v0[2], v0[3]}), c = gelu_pk((f32x2){v1[0], v1[1]}), d = gelu_pk((f32x2){v1[2], v1[3]});
                        v0 = (f32x4){a.x, a.y, b.x, b.y}; v1 = (f32x4){c.x, c.y, d.x, d.y}; }
                    v0 = v0 * sc; v1 = v1 * sc; u32x4 w; w.x = cvt_pk_bf16(v0[0], v0[1]); w.y = cvt_pk_bf16(v0[2], v0[3]); w.z = cvt_pk_bf16(v1[0], v1[1]); w.w = cvt_pk_bf16(v1[2], v1[3]);
                    *(u32x4*)(rowp + bj * HALF) = w; } }
    }
};

template <class Epi, class Sched, bool ALIGN_EPI = false, bool SP2 = false>
__device__ __forceinline__ void gemm_phase(PG8_LAS unsigned char* lds, const Gemm g, const Sched& S, const Epi& E) {
    const int tid = threadIdx.x, wid = __builtin_amdgcn_readfirstlane(tid >> 6), lane = tid & 63, wr = wid >> 2, wc = wid & 3, fr = lane & 15, fq = lane >> 4;
    const int K = g.K, nt = K / BK;
    unsigned voffA[2], voffB[2];
#pragma unroll
    for (int i = 0; i < 2; ++i) { int R, C; stage_rc(tid * 16 + i * 8192, R, C); const int Rb = Epi::PERM ? ((R & ~31) + perm32(R & 31)) : R;
        voffA[i] = (unsigned)(R * K + C) * 2u; voffB[i] = (unsigned)(Rb * K + C) * 2u; }
    const size_t kstep = (size_t)(BK * 2);
    const size_t hstep = (size_t)HALF * K * 2;
    const size_t tstep = 2 * hstep;
    const unsigned ldsw = (unsigned)wid * 1024u;
    const int aoff = lds_byte(wr * 64 + fr, fq * 8), boff = lds_byte(wc * 32 + fr, fq * 8);
#define PG8_SA(b, h) (((b) * 2 + (h)) * HTB)
#define PG8_SB(b, h) ((4 + (b) * 2 + (h)) * HTB)
#define PG8_STAGE(bufoff, gbase, voff) do { _Pragma("unroll") for (int _i = 0; _i < 2; ++_i) \
        __builtin_amdgcn_global_load_lds((const unsigned*)((const char*)(gbase) + (voff)[_i]), (PG8_LAS unsigned*)(lds + (bufoff) + ldsw + _i * 8192), 16, 0, 0); } while (0)
#define PG8_LDA(dst, b, h) do { _Pragma("unroll") for (int m = 0; m < 4; ++m) _Pragma("unroll") for (int k = 0; k < 2; ++k) dst[m][k] = *(const PG8_LAS bf16x8*)(lds + PG8_SA(b, h) + aoff + m * 2048 + k * 1024); } while (0)
#define PG8_LDB(dst, b, h) do { _Pragma("unroll") for (int n = 0; n < 2; ++n) _Pragma("unroll") for (int k = 0; k < 2; ++k) dst[n][k] = *(const PG8_LAS bf16x8*)(lds + PG8_SB(b, h) + boff + n * 2048 + k * 1024); } while (0)
#define PG8_MMA(ai, bj, At, Bt) do { __builtin_amdgcn_s_setprio(1); _Pragma("unroll") for (int m = 0; m < 4; ++m) _Pragma("unroll") for (int n = 0; n < 2; ++n) _Pragma("unroll") for (int k = 0; k < 2; ++k) \
        acc[ai][bj][m][n] = __builtin_amdgcn_mfma_f32_16x16x32_bf16(Bt[n][k], At[m][k], acc[ai][bj][m][n], 0, 0, 0); __builtin_amdgcn_s_setprio(0); } while (0)
#define PG8_WAIT_V(n) asm volatile("s_waitcnt vmcnt(" #n ")" ::: "memory")
#define PG8_WAIT_L(n) asm volatile("s_waitcnt lgkmcnt(" #n ")" ::: "memory")
#define PG8_BAR __builtin_amdgcn_s_barrier()
#define PG8_SCHED __builtin_amdgcn_sched_barrier(0)
    Unit cur, nxt; int ui = 0;
    if (!S.next(0, cur)) return;
    f32x4 acc[2][2][4][2];
#pragma unroll
    for (int a = 0; a < 2; ++a)
#pragma unroll
        for (int b = 0; b < 2; ++b)
#pragma unroll
            for (int m = 0; m < 4; ++m)
#pragma unroll
                for (int n = 0; n < 2; ++n) acc[a][b][m][n] = (f32x4){0.f, 0.f, 0.f, 0.f};
    bf16x8 At[4][2], B0[2][2], B1[2][2];
    const char* cA = (const char*)g.A + (size_t)cur.pm * tstep; const char* cB = (const char*)g.Bt + (size_t)cur.pn * tstep;
    S.a_ready(cur);
    if constexpr (SP2) {
        PG8_STAGE(PG8_SB(0, 0), cB, voffB); PG8_STAGE(PG8_SB(0, 1), cB + hstep, voffB); PG8_STAGE(PG8_SA(0, 0), cA, voffA); PG8_STAGE(PG8_SA(0, 1), cA + hstep, voffA);
        if (wr == 1) PG8_BAR;
        PG8_WAIT_V(2); PG8_BAR;
        PG8_STAGE(PG8_SB(1, 0), cB + kstep, voffB); PG8_STAGE(PG8_SA(1, 0), cA + kstep, voffA); PG8_STAGE(PG8_SB(1, 1), cB + hstep + kstep, voffB);
        PG8_WAIT_V(6); PG8_BAR;
    } else {
        PG8_STAGE(PG8_SB(0, 0), cB, voffB); PG8_STAGE(PG8_SA(0, 0), cA, voffA); PG8_STAGE(PG8_SB(0, 1), cB + hstep, voffB); PG8_STAGE(PG8_SA(0, 1), cA + hstep, voffA);
        if (wr == 1) PG8_BAR;
        PG8_WAIT_V(4); PG8_BAR;
        PG8_STAGE(PG8_SB(1, 0), cB + kstep, voffB); PG8_STAGE(PG8_SA(1, 0), cA + kstep, voffA); PG8_STAGE(PG8_SB(1, 1), cB + hstep + kstep, voffB);
        PG8_WAIT_V(6); PG8_BAR;
    }
    for (;;) {
        const bool has_next = S.next(ui + 1, nxt);
        const char* nA = has_next ? (const char*)g.A + (size_t)nxt.pm * tstep : cA; const char* nB = has_next ? (const char*)g.Bt + (size_t)nxt.pn * tstep : cB;
        for (int t = 0; t < nt; t += 2) {
            const bool last = (t == nt - 2);
            const char* a1 = cA + (size_t)(t + 1) * kstep;
            const char* a2 = last ? nA : cA + (size_t)(t + 2) * kstep; const char* b2 = last ? nB : cB + (size_t)(t + 2) * kstep;
            const char* a3 = a2 + kstep; const char* b3 = b2 + kstep;
            if (last && has_next) S.a_ready(nxt);
            if constexpr (SP2) {
            PG8_LDB(B0, 0, 0); PG8_LDB(B1, 0, 1); PG8_SCHED; PG8_LDA(At, 0, 0); PG8_STAGE(PG8_SA(1, 1), a1 + hstep, voffA);
            PG8_WAIT_V(8); PG8_WAIT_L(0); PG8_BAR; PG8_MMA(0, 0, At, B0); PG8_MMA(0, 1, At, B1); PG8_BAR; PG8_SCHED;
            PG8_LDA(At, 0, 1); PG8_STAGE(PG8_SB(0, 0), b2, voffB); PG8_STAGE(PG8_SB(0, 1), b2 + hstep, voffB); PG8_STAGE(PG8_SA(0, 0), a2, voffA);
            PG8_WAIT_V(8); PG8_WAIT_L(0); PG8_BAR; PG8_MMA(1, 0, At, B0); PG8_MMA(1, 1, At, B1); PG8_BAR; PG8_SCHED;
            PG8_LDB(B0, 1, 0); PG8_LDB(B1, 1, 1); PG8_SCHED; PG8_LDA(At, 1, 0); PG8_STAGE(PG8_SA(0, 1), a2 + hstep, voffA);
            PG8_WAIT_V(8); PG8_WAIT_L(0); PG8_BAR; PG8_MMA(0, 0, At, B0); PG8_MMA(0, 1, At, B1); PG8_BAR; PG8_SCHED;
            PG8_LDA(At, 1, 1); PG8_STAGE(PG8_SB(1, 0), b3, voffB); PG8_STAGE(PG8_SB(1, 1), b3 + hstep, voffB); PG8_STAGE(PG8_SA(1, 0), a3, voffA);
            PG8_WAIT_V(8); PG8_WAIT_L(0); PG8_BAR; PG8_MMA(1, 0, At, B0); PG8_MMA(1, 1, At, B1); PG8_BAR; PG8_SCHED;
            } else {
            PG8_LDB(B0, 0, 0); PG8_SCHED; PG8_LDA(At, 0, 0); PG8_STAGE(PG8_SA(1, 1), a1 + hstep, voffA);
            PG8_WAIT_L(8); PG8_BAR; PG8_WAIT_L(0); PG8_MMA(0, 0, At, B0); PG8_BAR; PG8_SCHED;
            PG8_LDB(B1, 0, 1); PG8_STAGE(PG8_SB(0, 0), b2, voffB);
            PG8_BAR; PG8_WAIT_L(0); PG8_MMA(0, 1, At, B1); PG8_BAR;
            PG8_LDA(At, 0, 1); PG8_STAGE(PG8_SA(0, 0), a2, voffA);
            PG8_BAR; PG8_WAIT_L(0); PG8_MMA(1, 0, At, B0); PG8_BAR; PG8_SCHED;
            PG8_STAGE(PG8_SB(0, 1), b2 + hstep, voffB);
            PG8_WAIT_V(6); PG8_BAR; PG8_MMA(1, 1, At, B1); PG8_BAR;
            PG8_LDB(B0, 1, 0); PG8_SCHED; PG8_LDA(At, 1, 0); PG8_STAGE(PG8_SA(0, 1), a2 + hstep, voffA);
            PG8_WAIT_L(8); PG8_BAR; PG8_WAIT_L(0); PG8_MMA(0, 0, At, B0); PG8_BAR; PG8_SCHED;
            PG8_LDB(B1, 1, 1); PG8_STAGE(PG8_SB(1, 0), b3, voffB);
            PG8_BAR; PG8_WAIT_L(0); PG8_MMA(0, 1, At, B1); PG8_BAR;
            PG8_LDA(At, 1, 1); PG8_STAGE(PG8_SA(1, 0), a3, voffA);
            PG8_BAR; PG8_WAIT_L(0); PG8_MMA(1, 0, At, B0); PG8_BAR; PG8_SCHED;
            PG8_STAGE(PG8_SB(1, 1), b3 + hstep, voffB);
            PG8_WAIT_V(6); PG8_BAR; PG8_MMA(1, 1, At, B1); PG8_BAR;
            }
        }
        if constexpr (ALIGN_EPI) { if (wr == 0) PG8_BAR; }
        if constexpr (!Epi::AFTER_DRAIN) { E(acc, cur, wr, wc, fr, fq); S.done(cur); }
        if (!has_next) break;
#pragma unroll
        for (int a = 0; a < 2; ++a)
#pragma unroll
            for (int b = 0; b < 2; ++b)
#pragma unroll
                for (int m = 0; m < 4; ++m)
#pragma unroll
                    for (int n = 0; n < 2; ++n) acc[a][b][m][n] = (f32x4){0.f, 0.f, 0.f, 0.f};
        cur = nxt; cA = nA; cB = nB; ++ui;
        if constexpr (ALIGN_EPI) { if (wr == 1) PG8_BAR; }
    }
    PG8_WAIT_V(0);
    if constexpr (!ALIGN_EPI) { if (wr == 0) PG8_BAR; }
    PG8_BAR;
    if constexpr (Epi::AFTER_DRAIN) { E.fused(acc, cur, wr, wc, fr, fq, lds, wid, lane); S.done(cur); }
#undef PG8_SA
#undef PG8_SB
#undef PG8_STAGE
#undef PG8_LDA
#undef PG8_LDB
#undef PG8_MMA
#undef PG8_WAIT_V
#undef PG8_WAIT_L
#undef PG8_BAR
#undef PG8_SCHED
}
}
#define GAS __attribute__((address_space(1)))
#define LAS __attribute__((address_space(3)))
typedef unsigned short bf16;
typedef unsigned v4u __attribute__((ext_vector_type(4)));
typedef float f32x4 __attribute__((ext_vector_type(4)));
typedef short bf16x8 __attribute__((ext_vector_type(8)));
typedef GAS unsigned gu32;
typedef GAS unsigned long long gu64;
#define RLX_AGENT __ATOMIC_RELAXED, __HIP_MEMORY_SCOPE_AGENT
#define LDS_WAIT() asm volatile("s_waitcnt lgkmcnt(0)" ::: "memory")
#define VM_WAIT() asm volatile("s_waitcnt vmcnt(0)" ::: "memory")
__device__ __forceinline__ unsigned long long rt() { return __builtin_amdgcn_s_memrealtime(); }
__device__ __forceinline__ unsigned f2bf(float f) { unsigned u = __builtin_bit_cast(unsigned, f); return (u + 0x7fffu + ((u >> 16) & 1u)) >> 16; }
__device__ __forceinline__ unsigned pk2(float lo, float hi) { return f2bf(lo) | (f2bf(hi) << 16); }

#define XB_TMO      128
#define XB_XCNT(j)  (256  + 64 * (j))
#define XB_XSUB(j)  (1280 + 64 * (j))
#define XB_XGEN(j)  (2304 + 64 * (j))
#define XB_TOP      3328
#define XB_TOPGEN   3392
#define XCD_BAR_WORDS 3456
#define XB_SPIN_CAP (1u << 18)

__device__ __forceinline__ unsigned xb_ld(unsigned* p)              { return __hip_atomic_load(p, __ATOMIC_RELAXED, __HIP_MEMORY_SCOPE_AGENT); }
__device__ __forceinline__ unsigned xb_add(unsigned* p, unsigned v) { return __hip_atomic_fetch_add(p, v, __ATOMIC_RELAXED, __HIP_MEMORY_SCOPE_AGENT); }
__device__ __forceinline__ unsigned xb_xcc_id() { return (unsigned)__builtin_amdgcn_s_getreg((3 << 11) | 20) & 0xFu; }
#define XB_SPIN(cond, bar) do { unsigned _sp = 0; while (cond) { __builtin_amdgcn_s_sleep(1); \
    if ((++_sp & 255u) == 0u) { if (xb_ld(&(bar)[XB_TMO])) break; if (_sp > XB_SPIN_CAP) { atomicAdd(&(bar)[XB_TMO], 1u); break; } } } } while (0)

struct XcdBarrier {
    unsigned* bar; unsigned x;
    volatile LAS unsigned* st;
};

__device__ __forceinline__ XcdBarrier xcd_barrier_post(unsigned* bar, volatile LAS unsigned* st) {
    XcdBarrier b; b.bar = bar; b.x = xb_xcc_id(); b.st = st;
    if (threadIdx.x == 0) (void)xb_add(&bar[XB_XCNT(b.x)], 1u);
    return b;
}
__device__ __forceinline__ void xcd_barrier_complete(unsigned* bar, unsigned x, unsigned& nloc, unsigned& nx) {
    const unsigned G = gridDim.x * gridDim.y * gridDim.z;
    unsigned sum, cnt, mine, sp = 0u;
    for (;;) {
        sum = 0u; cnt = 0u; mine = 0u;
#pragma unroll
        for (unsigned j = 0; j < 16; ++j) { const unsigned c = xb_ld(&bar[XB_XCNT(j)]); sum += c; cnt += (c > 0u) ? 1u : 0u; mine = (j == x) ? c : mine; }
        if (sum == G) break;
        __builtin_amdgcn_s_sleep(1);
        if ((++sp & 255u) == 0u) { if (xb_ld(&bar[XB_TMO])) break; if (sp > XB_SPIN_CAP) { atomicAdd(&bar[XB_TMO], 1u); break; } }
    }
    nloc = mine > 0u ? mine : 1u; nx = cnt > 0u ? cnt : 1u;
}

__device__ __forceinline__ void xcd_barrier(const XcdBarrier& b) {
    asm volatile("s_waitcnt vmcnt(0)" ::: "memory");
    __syncthreads();
    if (threadIdx.x == 0) {
        unsigned* bar = b.bar;
        __builtin_amdgcn_s_waitcnt(0);
        unsigned nloc = b.st[0], nx = b.st[1];
        if (nloc == 0u) { xcd_barrier_complete(bar, b.x, nloc, nx); b.st[0] = nloc; b.st[1] = nx; }
        const unsigned old = xb_add(&bar[XB_XSUB(b.x)], 1u);
        const unsigned gen = old / nloc;
        if (old + 1u == (gen + 1u) * nloc) {
            __builtin_amdgcn_fence(__ATOMIC_RELEASE, "agent");
            asm volatile("s_waitcnt vmcnt(0)" ::: "memory");
            const unsigned og = xb_add(&bar[XB_TOP], 1u);
            const unsigned tg = og / nx;
            if (og + 1u == (tg + 1u) * nx) xb_add(&bar[XB_TOPGEN], 1u);
            else XB_SPIN(xb_ld(&bar[XB_TOPGEN]) == tg, bar);
            __builtin_amdgcn_fence(__ATOMIC_ACQUIRE, "agent");
            xb_add(&bar[XB_XGEN(b.x)], 1u);
            asm volatile("s_waitcnt vmcnt(0)" ::: "memory");
        } else {
            XB_SPIN(xb_ld(&bar[XB_XGEN(b.x)]) == gen, bar);
            __builtin_amdgcn_fence(__ATOMIC_ACQUIRE, "agent");
            asm volatile("s_waitcnt vmcnt(0)" ::: "memory");
        }
    }
    __syncthreads();
}
constexpr int NWAVES = 8;
constexpr int D = 1024, BATCH = 8, SEQ = 2048, T = BATCH * SEQ;
constexpr int AW = 512, RW = 512, NH = 8;
constexpr int DL = 64, AL = 64, GL = 128;
constexpr int SHIFTW = 3 * RW + DL + AL + GL;
constexpr int INW = 3 * AW + SHIFTW;
constexpr int NKEYS = 128, PH = 8, PKD = 256, TOPK = 16, HK = PH * TOPK;
constexpr int QW = PH * PKD;
constexpr int MODW = 6 * D;

constexpr size_t MiB = 1u << 20;
constexpr size_t WS_CTL = 0, CTL_ZERO_BYTES = 1 * MiB + 256 * 1024;
constexpr size_t WS_MOD = 1 * MiB;
constexpr size_t WS_KEYS = 1 * MiB + 512 * 1024;
constexpr size_t WS_WIN = 2 * MiB;
constexpr size_t WS_WOUT = 9 * MiB;
constexpr size_t WS_WQ = 11 * MiB;
constexpr size_t WS_XN = 16 * MiB;
constexpr size_t WS_O3 = 16 * MiB;
constexpr size_t WS_LSE = 32 * MiB;
constexpr size_t WS_Z = 48 * MiB;
constexpr size_t WS_MIX = 152 * MiB;
constexpr size_t WS_Y = 184 * MiB;
constexpr size_t WS_Q = 48 * MiB;
constexpr size_t WS_IDX = 112 * MiB;
constexpr size_t WS_GATE = 120 * MiB;
constexpr size_t WS_PART = 48 * MiB;
constexpr size_t WS_XQ = 128 * MiB;
constexpr size_t WS_UT = 216 * MiB;
constexpr size_t WS_SU = 249 * MiB;
constexpr size_t WS_VT = 232 * MiB;
constexpr size_t WS_BON = 248 * MiB;
constexpr size_t WS_END = 250 * MiB;
constexpr int CW_WORK = 1024;
constexpr int CW_WORK2 = 2048;
constexpr int CW_BAR = 4096;
constexpr int MAX_LAUNCHES = 12;

constexpr int RING_OFF = 0, RING_BYTES = 139264;
constexpr int LDSCTL_OFF = RING_BYTES, MISC_OFF = LDSCTL_OFF + 320;
constexpr int LDS_BYTES = 147456;
static_assert(MISC_OFF + 128 <= LDS_BYTES, "LDS map");

typedef GAS float gf32;
typedef GAS f32x4 gf32x4;

__device__ __forceinline__ float bf2f(bf16 v) { return __uint_as_float(((unsigned)v) << 16); }
__device__ __forceinline__ float wave_sum(float v) {
#pragma unroll
    for (int o = 1; o < 64; o <<= 1) v += __shfl_xor(v, o);
    return v;
}
#define WAVE_LDS_SYNC() do { asm volatile("s_waitcnt lgkmcnt(0)" ::: "memory"); __builtin_amdgcn_wave_barrier(); } while (0)

__device__ __forceinline__ void p0_transpose_item(const float* W, int K, int N, bf16* WT, int row_off, LAS float* scr, int item, int lane) {
    const int nblk = N / 32, kb = item / nblk, nb = item % nblk, k0 = 64 * kb, n0 = 32 * nb;
#pragma unroll 8
    for (int i = 0; i < 32; ++i) { const int kk = 2 * i + (lane >> 5); scr[kk * 33 + (lane & 31)] = W[(size_t)(k0 + kk) * N + n0 + (lane & 31)]; }
    LDS_WAIT(); asm volatile("" ::: "memory");
    const int c = lane & 7;
#pragma unroll
    for (int j = 0; j < 4; ++j) { const int n = (lane >> 3) + 8 * j; const LAS float* s = scr + (8 * c) * 33 + n;
        v4u o; o.x = pk2(s[0 * 33], s[1 * 33]); o.y = pk2(s[2 * 33], s[3 * 33]); o.z = pk2(s[4 * 33], s[5 * 33]); o.w = pk2(s[6 * 33], s[7 * 33]);
        *(GAS v4u*)(WT + (size_t)(row_off + n0 + n) * K + k0 + 8 * c) = o; }
    LDS_WAIT(); asm volatile("" ::: "memory");
}

__device__ __forceinline__ void norm_rows(const float* x, const float* g, const float* mod, int shift_off, int scale_off, bf16* o, int gw, int ngw, int lane) {
    f32x4 nx[4];
    if (gw < T) {
#pragma unroll
        for (int j = 0; j < 4; ++j) nx[j] = ((const GAS f32x4*)(x + (size_t)gw * D) + lane)[64 * j]; }
    for (int m = gw; m < T; m += ngw) {
        f32x4 v[4]; float s = 0.f;
#pragma unroll
        for (int j = 0; j < 4; ++j) { v[j] = nx[j]; s += (v[j].x * v[j].x + v[j].y * v[j].y) + (v[j].z * v[j].z + v[j].w * v[j].w); }
        if (m + ngw < T) {
#pragma unroll
            for (int j = 0; j < 4; ++j) nx[j] = ((const GAS f32x4*)(x + (size_t)(m + ngw) * D) + lane)[64 * j]; }
        const float* modb = mod + (m / SEQ) * MODW;
        const float rs = 1.0f / sqrtf(wave_sum(s) * (1.f / D) + 1e-6f);
        GAS unsigned long long* o8 = (GAS unsigned long long*)(o + (size_t)m * D) + lane;
#pragma unroll
        for (int j = 0; j < 4; ++j) {
            const int col = 256 * j + 4 * lane;
            const f32x4 g4 = *(const GAS f32x4*)(g + col), sc = *(const GAS f32x4*)(modb + scale_off + col), sh = *(const GAS f32x4*)(modb + shift_off + col);
            const f32x4 y = v[j] * rs * g4 * (sc + 1.0f) + sh;
            o8[64 * j] = (unsigned long long)pk2(y.x, y.y) | ((unsigned long long)pk2(y.z, y.w) << 32);
        }
    }
}
__device__ __forceinline__ void norm_rows_q(const float* x, const float* g, const float* mod, int shift_off, int scale_off, bf16* o, unsigned char* q, float* qscale, int gw, int ngw, int lane) {
    f32x4 nx[4];
    if (gw < T) {
#pragma unroll
        for (int j = 0; j < 4; ++j) nx[j] = ((const GAS f32x4*)(x + (size_t)gw * D) + lane)[64 * j]; }
    for (int m = gw; m < T; m += ngw) {
        f32x4 v[4]; float s = 0.f;
#pragma unroll
        for (int j = 0; j < 4; ++j) { v[j] = nx[j]; s += (v[j].x * v[j].x + v[j].y * v[j].y) + (v[j].z * v[j].z + v[j].w * v[j].w); }
        if (m + ngw < T) {
#pragma unroll
            for (int j = 0; j < 4; ++j) nx[j] = ((const GAS f32x4*)(x + (size_t)(m + ngw) * D) + lane)[64 * j]; }
        const float* modb = mod + (m / SEQ) * MODW;
        const float rs = 1.0f / sqrtf(wave_sum(s) * (1.f / D) + 1e-6f);
        GAS unsigned long long* o8 = (GAS unsigned long long*)(o + (size_t)m * D) + lane;
        float mx = 0.f;
#pragma unroll
        for (int j = 0; j < 4; ++j) {
            const int col = 256 * j + 4 * lane;
            const f32x4 g4 = *(const GAS f32x4*)(g + col), sc = *(const GAS f32x4*)(modb + scale_off + col), sh = *(const GAS f32x4*)(modb + shift_off + col);
            const f32x4 y = v[j] * rs * g4 * (sc + 1.0f) + sh;
            v[j] = y; mx = fmaxf(mx, fmaxf(fmaxf(fabsf(y.x), fabsf(y.y)), fmaxf(fabsf(y.z), fabsf(y.w))));
            o8[64 * j] = (unsigned long long)pk2(y.x, y.y) | ((unsigned long long)pk2(y.z, y.w) << 32);
        }
#pragma unroll
        for (int oo = 1; oo < 64; oo <<= 1) mx = fmaxf(mx, __shfl_xor(mx, oo));
        mx = fmaxf(mx, 1e-30f);
        const float inv = 127.0f / mx;
#pragma unroll
        for (int j = 0; j < 4; ++j) {
            const int ia = (int)rintf(v[j].x * inv), ib = (int)rintf(v[j].y * inv), ic = (int)rintf(v[j].z * inv), id = (int)rintf(v[j].w * inv);
            *(GAS unsigned*)(q + (size_t)m * D + 256 * j + 4 * lane) = (unsigned)(ia & 0xff) | ((unsigned)(ib & 0xff) << 8) | ((unsigned)(ic & 0xff) << 16) | ((unsigned)id << 24);
        }
        if (lane == 0) qscale[m] = mx * (1.0f / 127.0f);
    }
}

struct EpiRes {
    static constexpr bool PERM = false, AFTER_DRAIN = false;
    const float* xres; const float* mod; int gate_off; float* out; int ldc;
    __device__ __forceinline__ void operator()(const pg8::f32x4 (&acc)[2][2][4][2], const pg8::Unit& u, int wr, int wc, int fr, int fq) const {
        const int col0 = u.pn * pg8::BM + wc * 32 + 4 * fq;
        const int b = (u.pm * pg8::BM) / SEQ;
        pg8::f32x4 gv[2][2];
#pragma unroll
        for (int bj = 0; bj < 2; ++bj)
#pragma unroll
            for (int n = 0; n < 2; ++n) gv[bj][n] = *(const pg8::f32x4*)(mod + b * MODW + gate_off + col0 + bj * pg8::HALF + n * 16);
#pragma unroll
        for (int ai = 0; ai < 2; ++ai)
#pragma unroll
            for (int m = 0; m < 4; ++m) { const size_t off = (size_t)(u.pm * pg8::BM + ai * pg8::HALF + wr * 64 + m * 16 + fr) * ldc + col0;
#pragma unroll
                for (int bj = 0; bj < 2; ++bj)
#pragma unroll
                    for (int n = 0; n < 2; ++n) { const pg8::f32x4 bs = *(const pg8::f32x4*)(xres + off + bj * pg8::HALF + n * 16);
                        *(pg8::f32x4*)(out + off + bj * pg8::HALF + n * 16) = bs + gv[bj][n] * acc[ai][bj][m][n]; } }
    }
};

namespace scan {
typedef unsigned u32x2 __attribute__((ext_vector_type(2)));
constexpr int SLOT = 1024, BUF_BYTES = 12800, NBUF = 8;
constexpr int OFF_LORA = NBUF * BUF_BYTES;
constexpr int OFF_CONST = OFF_LORA + 16 * SLOT;
constexpr int OFF_MT = OFF_CONST + 5120;
constexpr int SCAN_LDS = OFF_MT + 8 * 1024;
static_assert(SCAN_LDS <= 139264, "scan LDS map");
constexpr int S_KK = 0, S_R = 2, S_MT = 4, S_N = 5, S_BK = 6, S_V = 10, S_GC = 12;

typedef float f32x2n __attribute__((ext_vector_type(2)));
typedef __bf16 bf16x2n __attribute__((ext_vector_type(2)));
__device__ __forceinline__ unsigned cvtpk(float lo, float hi) { const f32x2n v = {lo, hi}; const bf16x2n b = __builtin_convertvector(v, bf16x2n); return __builtin_bit_cast(unsigned, b); }
__device__ __forceinline__ bf16x8 mkfrag(unsigned a, unsigned b, unsigned c, unsigned d) { v4u w; w.x = a; w.y = b; w.z = c; w.w = d; return __builtin_bit_cast(bf16x8, w); }
__device__ __forceinline__ bf16x8 frag8(const float (&lo)[4], const float (&hi)[4]) { return mkfrag(cvtpk(lo[0], lo[1]), cvtpk(lo[2], lo[3]), cvtpk(hi[0], hi[1]), cvtpk(hi[2], hi[3])); }
__device__ __forceinline__ f32x4 mma(bf16x8 a, bf16x8 b, f32x4 c) { return __builtin_amdgcn_mfma_f32_16x16x32_bf16(a, b, c, 0, 0, 0); }
template <int N> __device__ __forceinline__ float row_shr(float x) { return __int_as_float(__builtin_amdgcn_update_dpp(0, __float_as_int(x), 0x110 + N, 0xf, 0xf, true)); }
__device__ __forceinline__ float fsigmoid(float x) { return __builtin_amdgcn_rcpf(1.0f + __expf(-x)); }
__device__ __forceinline__ bf16 tobf(float x) { return (bf16)(cvtpk(x, x) & 0xffffu); }

__device__ __forceinline__ void setup(LAS unsigned char* L, int h, int dir, const float* mu_prev, const float* mu_next, const float* w_decay0, const float* w_decay_up,
                                      const float* a_gate0, const float* a_gate_up, const float* k_k, const float* k_a, const float* r_k, int tid) {
    LAS float* C = (LAS float*)(L + OFF_CONST);
    for (int i = tid; i < 320; i += 512) {
        const int grp = i >> 6, c = i & 63;
        const int col = (grp < 3) ? grp * RW + h * 64 + c : 3 * RW + (grp - 3) * 64 + c;
        C[i] = mu_prev[col]; C[320 + i] = mu_next[col]; C[960 + i] = 1.0f - mu_prev[col] - mu_next[col];
    }
    if (tid < 64) { const int hc = h * 64 + tid; C[640 + tid] = w_decay0[dir * RW + hc]; C[704 + tid] = a_gate0[dir * RW + hc]; C[768 + tid] = k_k[hc]; C[832 + tid] = k_a[hc]; C[896 + tid] = r_k[hc]; }
    LAS bf16* F = (LAS bf16*)(L + OFF_LORA);
    for (int i = tid; i < 16 * 64 * 8; i += 512) {
        const int j = i & 7, l = (i >> 3) & 63, sl = i >> 9, m = sl & 1, ct = (sl >> 1) & 3, wa = sl >> 3;
        const int g = l >> 4, jj = 32 * m + (j < 4 ? 4 * g + j : 16 + 4 * g + j - 4), c = h * 64 + 16 * ct + (l & 15);
        const float v = wa ? a_gate_up[(size_t)(dir * AL + jj) * RW + c] : w_decay_up[(size_t)(dir * DL + jj) * RW + c];
        F[i] = (bf16)f2bf(v);
    }
}

__device__ __forceinline__ void helper_chunk(LAS unsigned char* L, LAS unsigned char* buf, LAS float* MT, const bf16* Z, float* BON, int b, int h, int dir, int n, int lane) {
    const int s = lane & 15, g = lane >> 4;
    const int cn = dir ? (SEQ / 16 - 1 - n) : n;
    const int t = cn * 16 + (dir ? 15 - s : s), tok = b * SEQ + t;
    const LAS float* C = (const LAS float*)(L + OFF_CONST);
    const bool hasp = t > 0, hasn = t < SEQ - 1;
    float rv[4][4], kv[4][4], vv[4][4], tw[4][4], xa[4][4];
    constexpr int SROW = 136, SGRP = 18 * SROW;
    {
        v4u ld[12];
#pragma unroll
        for (int i = 0; i < 12; ++i) {
            int p = 8 * i + (lane >> 3); p = p < 90 ? p : 89;
            const int grp = p / 18, row = p - 18 * grp;
            const int st = (row < 16) ? row : (row == 16 ? -1 : 16);
            int tt = cn * 16 + (dir ? 15 - st : st); tt = tt < 0 ? 0 : (tt > SEQ - 1 ? SEQ - 1 : tt);
            const int cbase = (grp < 3) ? grp * RW + h * 64 : 3 * RW + (grp - 3) * 64;
            ld[i] = *(const v4u*)(Z + (size_t)(b * SEQ + tt) * INW + 3 * AW + cbase + 8 * (lane & 7));
        }
#pragma unroll
        for (int i = 0; i < 12; ++i) {
            int p = 8 * i + (lane >> 3); p = p < 90 ? p : 89;
            const int grp = p / 18, row = p - 18 * grp;
            LAS unsigned char* q = buf + grp * SGRP + row * SROW + 16 * (lane & 7);
            *(LAS u32x2*)q = (u32x2){ld[i].x, ld[i].y}; *(LAS u32x2*)(q + 8) = (u32x2){ld[i].z, ld[i].w};
        }
    }
    asm volatile("s_waitcnt lgkmcnt(0)" ::: "memory"); __builtin_amdgcn_wave_barrier();
    {
        const int rlo = (s == 0) ? 16 : s - 1, rup = (s == 15) ? 17 : s + 1;
        const int rp = dir ? rup : rlo, rn = dir ? rlo : rup;
        typedef float f32x2s __attribute__((ext_vector_type(2)));
        const unsigned pmask = hasp ? 0xffffffffu : 0u, nmask = hasn ? 0xffffffffu : 0u;
#pragma unroll
        for (int grp = 0; grp < 5; ++grp) {
#pragma unroll
            for (int ct = 0; ct < 4; ++ct) {
                const LAS unsigned char* q = buf + grp * SGRP + 32 * ct + 8 * g;
                const u32x2 zcc = *(const LAS u32x2*)(q + s * SROW);
                u32x2 zp = *(const LAS u32x2*)(q + rp * SROW), zn = *(const LAS u32x2*)(q + rn * SROW);
                zp.x &= pmask; zp.y &= pmask; zn.x &= nmask; zn.y &= nmask;
                const f32x4 mp = *(const LAS f32x4*)(C + grp * 64 + 16 * ct + 4 * g), mn = *(const LAS f32x4*)(C + 320 + grp * 64 + 16 * ct + 4 * g), mc = *(const LAS f32x4*)(C + 960 + grp * 64 + 16 * ct + 4 * g);
                const f32x2s z01 = {__uint_as_float(zcc.x << 16), __uint_as_float(zcc.x & 0xffff0000u)}, z23 = {__uint_as_float(zcc.y << 16), __uint_as_float(zcc.y & 0xffff0000u)};
                const f32x2s p01 = {__uint_as_float(zp.x << 16), __uint_as_float(zp.x & 0xffff0000u)}, p23 = {__uint_as_float(zp.y << 16), __uint_as_float(zp.y & 0xffff0000u)};
                const f32x2s n01 = {__uint_as_float(zn.x << 16), __uint_as_float(zn.x & 0xffff0000u)}, n23 = {__uint_as_float(zn.y << 16), __uint_as_float(zn.y & 0xffff0000u)};
                const f32x2s o01 = (f32x2s){mc[0], mc[1]} * z01 + (f32x2s){mp[0], mp[1]} * p01 + (f32x2s){mn[0], mn[1]} * n01;
                const f32x2s o23 = (f32x2s){mc[2], mc[3]} * z23 + (f32x2s){mp[2], mp[3]} * p23 + (f32x2s){mn[2], mn[3]} * n23;
                const float ov[4] = {o01.x, o01.y, o23.x, o23.y};
#pragma unroll
                for (int r = 0; r < 4; ++r) {
                    const float o = ov[r];
                    if (grp == 0) rv[ct][r] = o; else if (grp == 1) kv[ct][r] = o; else if (grp == 2) vv[ct][r] = o;
                    else if (grp == 3) { const float e2 = __expf(2.0f * o); tw[ct][r] = 1.0f - 2.0f * __builtin_amdgcn_rcpf(e2 + 1.0f); } else xa[ct][r] = o;
                }
            }
            __builtin_amdgcn_sched_barrier(0);
        }
    }
    asm volatile("s_waitcnt lgkmcnt(0)" ::: "memory"); __builtin_amdgcn_wave_barrier();
#pragma unroll
    for (int ct = 0; ct < 4; ++ct)
#pragma unroll
        for (int r = 0; r < 4; ++r)
            *(LAS bf16*)(buf + (S_V + (ct >> 1)) * SLOT + (4 * g + r + 16 * (s >> 2)) * 16 + (ct & 1) * 8 + 2 * (s & 3)) = tobf(vv[ct][r]);
    f32x4 accw[4], acca[4];
    { const bf16x8 tb0 = frag8(tw[0], tw[1]), tb1 = frag8(tw[2], tw[3]), xb0 = frag8(xa[0], xa[1]), xb1 = frag8(xa[2], xa[3]);
      const LAS bf16x8* F = (const LAS bf16x8*)(L + OFF_LORA);
#pragma unroll
      for (int ct = 0; ct < 4; ++ct) {
          f32x4 z4 = {0.f, 0.f, 0.f, 0.f};
          accw[ct] = mma(F[(0 * 8 + ct * 2 + 0) * 64 + lane], tb0, z4); accw[ct] = mma(F[(0 * 8 + ct * 2 + 1) * 64 + lane], tb1, accw[ct]);
          acca[ct] = mma(F[(1 * 8 + ct * 2 + 0) * 64 + lane], xb0, z4); acca[ct] = mma(F[(1 * 8 + ct * 2 + 1) * 64 + lane], xb1, acca[ct]);
      } }
    float ev[4][4], kk[4][4], kd[4][4], bb[4][4];
    float ss = 0.f, bon = 0.f;
#pragma unroll
    for (int ct = 0; ct < 4; ++ct) {
        const f32x4 w0 = *(const LAS f32x4*)(C + 640 + 16 * ct + 4 * g), a0 = *(const LAS f32x4*)(C + 704 + 16 * ct + 4 * g), kkw = *(const LAS f32x4*)(C + 768 + 16 * ct + 4 * g),
                    kaw = *(const LAS f32x4*)(C + 832 + 16 * ct + 4 * g), rkw = *(const LAS f32x4*)(C + 896 + 16 * ct + 4 * g);
#pragma unroll
        for (int r = 0; r < 4; ++r) {
            ev[ct][r] = 0.60653065971f * fsigmoid(accw[ct][r] + w0[r]);
            const float a = fsigmoid(acca[ct][r] + a0[r]);
            const float k = kv[ct][r];
            kk[ct][r] = k * kkw[r]; ss += kk[ct][r] * kk[ct][r];
            kd[ct][r] = k * (1.0f + (a - 1.0f) * kaw[r]);
            bb[ct][r] = a;
            bon += rv[ct][r] * k * a * kaw[r] * rkw[r];
        }
        __builtin_amdgcn_sched_barrier(0);
    }
    ss += __shfl_xor(ss, 16); ss += __shfl_xor(ss, 32);
    bon += __shfl_xor(bon, 16); bon += __shfl_xor(bon, 32);
    if (g == 0) BON[((size_t)dir * T + tok) * NH + h] = bon;
    const float rn = __builtin_amdgcn_rsqf(fmaxf(ss, 1e-12f));
    bf16x8 fKKm[2], fRm[2], fBm[2], fKm[2];
#pragma unroll
    for (int m = 0; m < 2; ++m) {
        float KKs[2][4], Rs[2][4], Bt[2][4], Kt[2][4];
#pragma unroll
        for (int c2 = 0; c2 < 2; ++c2) {
            const int ct = 2 * m + c2;
            float gcv[4];
#pragma unroll
            for (int r = 0; r < 4; ++r) {
                const float e = ev[ct][r];
                float cum = e;
                cum += row_shr<1>(cum); cum += row_shr<2>(cum); cum += row_shr<4>(cum); cum += row_shr<8>(cum);
                const float cumC = __shfl(cum, (lane & 48) | 15);
                const float kkn = kk[ct][r] * rn, bv = kkn * bb[ct][r];
                const float ig = __expf(cum), gs = __builtin_amdgcn_rcpf(ig), gC = __expf(-cumC), rat = ig * gC;
                KKs[c2][r] = kkn * gs * __expf(e); Rs[c2][r] = rv[ct][r] * gs;
                Bt[c2][r] = bv * ig; Kt[c2][r] = kd[ct][r] * ig;
                gcv[r] = gC;
                LAS unsigned char* q = buf + (S_BK + ct) * SLOT + (4 * g + r + 16 * (s >> 2)) * 16 + 2 * (s & 3);
                *(LAS bf16*)q = tobf(bv * rat); *(LAS bf16*)(q + 8) = tobf(kd[ct][r] * rat);
            }
            if (s == 15) *(LAS f32x4*)(buf + S_GC * SLOT + (16 * ct + 4 * g) * 4) = (f32x4){gcv[0], gcv[1], gcv[2], gcv[3]};
        }
        fKKm[m] = frag8(KKs[0], KKs[1]); fRm[m] = frag8(Rs[0], Rs[1]); fBm[m] = frag8(Bt[0], Bt[1]); fKm[m] = frag8(Kt[0], Kt[1]);
    }
    const bf16x8 fKK0 = fKKm[0], fKK1 = fKKm[1], fR0 = fRm[0], fR1 = fRm[1], fB0 = fBm[0], fB1 = fBm[1], fK0 = fKm[0], fK1 = fKm[1];
    *(LAS bf16x8*)(buf + (S_KK + 0) * SLOT + lane * 16) = fKK0; *(LAS bf16x8*)(buf + (S_KK + 1) * SLOT + lane * 16) = fKK1;
    *(LAS bf16x8*)(buf + (S_R + 0) * SLOT + lane * 16) = fR0;  *(LAS bf16x8*)(buf + (S_R + 1) * SLOT + lane * 16) = fR1;
    const f32x4 z4 = {0.f, 0.f, 0.f, 0.f};
    { f32x4 mab = mma(fKK0, fB0, z4); mab = mma(fKK1, fB1, mab);
      *(LAS f32x4*)(MT + s * 16 + 4 * g) = mab; }
    f32x4 mak = mma(fK0, fKK0, z4); mak = mma(fK1, fKK1, mak);
    f32x4 nrb = mma(fB0, fR0, z4); nrb = mma(fB1, fR1, nrb);
    f32x4 nrk = mma(fK0, fR0, z4); nrk = mma(fK1, fR1, nrk);
#pragma unroll
    for (int r = 0; r < 4; ++r) { const int i = 4 * g + r; if (!(i < s)) mak[r] = 0.f; if (!(i <= s)) { nrb[r] = 0.f; nrk[r] = 0.f; } }
    *(LAS v4u*)(buf + S_N * SLOT + lane * 16) = (v4u){cvtpk(nrb[0], nrb[1]), cvtpk(nrb[2], nrb[3]), cvtpk(nrk[0], nrk[1]), cvtpk(nrk[2], nrk[3])};
    asm volatile("s_waitcnt lgkmcnt(0)" ::: "memory"); __builtin_amdgcn_wave_barrier();
    float Tr[16];
#pragma unroll
    for (int j = 15; j >= 0; --j) {
        float acc0 = 0.f, acc1 = 0.f;
#pragma unroll
        for (int i4 = (j + 1) / 4; i4 < 4; ++i4) {
            const f32x4 mrow = *(const LAS f32x4*)(MT + j * 16 + 4 * i4);
#pragma unroll
            for (int e = 0; e < 4; ++e) { const int i = 4 * i4 + e; if (i > j) { if (e & 1) acc1 += Tr[i] * mrow[e]; else acc0 += Tr[i] * mrow[e]; } }
        }
        Tr[j] = (j == s) ? 1.0f : -(acc0 + acc1);
        if (j > s) Tr[j] = 0.f;
    }
    float t0 = 0.f, t1 = 0.f, t2 = 0.f, t3 = 0.f;
#pragma unroll
    for (int gg = 0; gg < 4; ++gg) if (g == gg) { t0 = Tr[4 * gg]; t1 = Tr[4 * gg + 1]; t2 = Tr[4 * gg + 2]; t3 = Tr[4 * gg + 3]; }
    *(LAS v4u*)(buf + S_MT * SLOT + lane * 16) = (v4u){cvtpk(mak[0], mak[1]), cvtpk(mak[2], mak[3]), cvtpk(-t0, -t1), cvtpk(-t2, -t3)};
    asm volatile("s_waitcnt lgkmcnt(0)" ::: "memory"); __builtin_amdgcn_wave_barrier();
}

__device__ __forceinline__ void rec_chunk(const LAS unsigned char* buf, f32x4 (&st)[4], bf16* Y, int b, int h, int dir, int n, int w, int lane) {
    const int g = lane >> 4, col = lane & 15;
    const bf16x8 fKK0 = *(const LAS bf16x8*)(buf + (S_KK + 0) * SLOT + lane * 16), fKK1 = *(const LAS bf16x8*)(buf + (S_KK + 1) * SLOT + lane * 16);
    const bf16x8 fR0 = *(const LAS bf16x8*)(buf + (S_R + 0) * SLOT + lane * 16), fR1 = *(const LAS bf16x8*)(buf + (S_R + 1) * SLOT + lane * 16);
    const v4u mt = *(const LAS v4u*)(buf + S_MT * SLOT + lane * 16);
    const bf16x8 fN = *(const LAS bf16x8*)(buf + S_N * SLOT + lane * 16);
    const u32x2 vf = *(const LAS u32x2*)(buf + (S_V + (w >> 1)) * SLOT + lane * 16 + (w & 1) * 8);
    const f32x4 z4 = {0.f, 0.f, 0.f, 0.f};
    const bf16x8 sb0 = mkfrag(cvtpk(st[0][0], st[0][1]), cvtpk(st[0][2], st[0][3]), cvtpk(st[1][0], st[1][1]), cvtpk(st[1][2], st[1][3]));
    const bf16x8 sb1 = mkfrag(cvtpk(st[2][0], st[2][1]), cvtpk(st[2][2], st[2][3]), cvtpk(st[3][0], st[3][1]), cvtpk(st[3][2], st[3][3]));
    f32x4 p1 = mma(fKK0, sb0, z4); p1 = mma(fKK1, sb1, p1);
    f32x4 p2 = mma(fR0, sb0, z4); p2 = mma(fR1, sb1, p2);
    const f32x4 x = mma(mkfrag(0u, 0u, mt.x, mt.y), mkfrag(0u, 0u, vf.x, vf.y), p1);
    const f32x4 u = mma(mkfrag(mt.z, mt.w, 0u, 0u), mkfrag(cvtpk(x[0], x[1]), cvtpk(x[2], x[3]), 0u, 0u), z4);
    const bf16x8 buv = mkfrag(cvtpk(u[0], u[1]), cvtpk(u[2], u[3]), vf.x, vf.y);
    const f32x4 y = mma(fN, buv, p2);
#pragma unroll
    for (int i = 0; i < 4; ++i) {
        const f32x4 gc = *(const LAS f32x4*)(buf + S_GC * SLOT + (16 * i + 4 * g) * 4);
        const bf16x8 fBK = *(const LAS bf16x8*)(buf + (S_BK + i) * SLOT + lane * 16);
        st[i] = mma(fBK, buv, st[i] * gc);
    }
    const int cn = dir ? (SEQ / 16 - 1 - n) : n;
#pragma unroll
    for (int r = 0; r < 4; ++r) { const int s = 4 * g + r, t = cn * 16 + (dir ? 15 - s : s);
        Y[((size_t)dir * T + (size_t)(b * SEQ + t)) * RW + h * 64 + 16 * w + col] = tobf(y[r]); }
}

__device__ __forceinline__ void chain(LAS unsigned char* L, const bf16* Z, const float* mu_prev, const float* mu_next, const float* w_decay0, const float* w_decay_up,
                                      const float* a_gate0, const float* a_gate_up, const float* k_k, const float* k_a, const float* r_k, bf16* Y, float* BON, int ch, int tid, int wave, int lane) {
    const int dir = ch & 1, h = (ch >> 1) & 7, b = ch >> 4;
    __syncthreads();
    setup(L, h, dir, mu_prev, mu_next, w_decay0, w_decay_up, a_gate0, a_gate_up, k_k, k_a, r_k, tid);
    __syncthreads();
    f32x4 st[4];
#pragma unroll
    for (int i = 0; i < 4; ++i) st[i] = (f32x4){0.f, 0.f, 0.f, 0.f};
    constexpr int NCH = SEQ / 16, NR = NCH / 8;
    for (int q = 0; q < NR; ++q) {
        helper_chunk(L, L + wave * BUF_BYTES, (LAS float*)(L + OFF_MT + wave * 1024), Z, BON, b, h, dir, 8 * q + wave, lane);
        __syncthreads();
        if (wave < 4) {
#pragma unroll 2
            for (int i = 0; i < 8; ++i) rec_chunk(L + i * BUF_BYTES, st, Y, b, h, dir, 8 * q + i, wave, lane);
        }
        __syncthreads();
    }
}
}

namespace attn {
typedef unsigned u32x2 __attribute__((ext_vector_type(2)));
constexpr int VT_STRIDE = 136;
constexpr int KF_OFF = 64 * VT_STRIDE;
constexpr int WAVE_LDS = KF_OFF + 8 * 1024;
constexpr float LOG2E = 1.44269504088896f, LN2 = 0.693147180559945f;
using scan::cvtpk; using scan::mkfrag; using scan::mma;

__device__ __forceinline__ void unpack8(const v4u w, float (&f)[8]) {
    f[0] = __uint_as_float(w.x << 16); f[1] = __uint_as_float(w.x & 0xffff0000u); f[2] = __uint_as_float(w.y << 16); f[3] = __uint_as_float(w.y & 0xffff0000u);
    f[4] = __uint_as_float(w.z << 16); f[5] = __uint_as_float(w.z & 0xffff0000u); f[6] = __uint_as_float(w.w << 16); f[7] = __uint_as_float(w.w & 0xffff0000u);
}

__device__ __forceinline__ void unit(LAS unsigned char* vt, const bf16* Z, const float* qg, const float* kg, bf16* Ob, int opitch, float* lse_out,
                                     int b, int h, int d, int r, int qb, int nb, int lane) {
    const int g = lane >> 4, c16 = lane & 15;
    const float slope2 = exp2f(-(float)(h + 1)) * LOG2E * (float)d;
    float gn[16];
#pragma unroll
    for (int m = 0; m < 2; ++m)
#pragma unroll
        for (int j = 0; j < 8; ++j) gn[m * 8 + j] = qg[32 * m + 8 * g + j] * kg[32 * m + 8 * g + j];
    bf16x8 qf[4][2];
#pragma unroll
    for (int qt = 0; qt < 4; ++qt) {
        const int tok = b * SEQ + (qb * 64 + 16 * qt + c16) * d + r;
        const bf16* qp = Z + (size_t)tok * INW + h * 64 + 8 * g;
        float f0[8], f1[8]; unpack8(*(const v4u*)qp, f0); unpack8(*(const v4u*)(qp + 32), f1);
        float ss = 0.f;
#pragma unroll
        for (int j = 0; j < 8; ++j) ss += f0[j] * f0[j] + f1[j] * f1[j];
        ss += __shfl_xor(ss, 16); ss += __shfl_xor(ss, 32);
        const float rs = (0.125f * LOG2E) / sqrtf(ss * (1.f / 64.f) + 1e-6f);
        qf[qt][0] = mkfrag(cvtpk(f0[0] * rs * gn[0], f0[1] * rs * gn[1]), cvtpk(f0[2] * rs * gn[2], f0[3] * rs * gn[3]), cvtpk(f0[4] * rs * gn[4], f0[5] * rs * gn[5]), cvtpk(f0[6] * rs * gn[6], f0[7] * rs * gn[7]));
        qf[qt][1] = mkfrag(cvtpk(f1[0] * rs * gn[8], f1[1] * rs * gn[9]), cvtpk(f1[2] * rs * gn[10], f1[3] * rs * gn[11]), cvtpk(f1[4] * rs * gn[12], f1[5] * rs * gn[13]), cvtpk(f1[6] * rs * gn[14], f1[7] * rs * gn[15]));
    }
    f32x4 oacc[4][4];
    float mrun[4], lrun[4];
#pragma unroll
    for (int qt = 0; qt < 4; ++qt) { mrun[qt] = -1e30f; lrun[qt] = 0.f;
#pragma unroll
        for (int dt = 0; dt < 4; ++dt) oacc[dt][qt] = (f32x4){0.f, 0.f, 0.f, 0.f}; }
    const f32x4 z4 = {0.f, 0.f, 0.f, 0.f};
#pragma unroll 1
    for (int kb = qb - 1; kb <= qb + 1; ++kb) {
        if (kb < 0 || kb >= nb) continue;
#pragma unroll
        for (int kblk = 0; kblk < 4; ++kblk) {
            const int tok = b * SEQ + (kb * 64 + 16 * kblk + c16) * d + r;
            const bf16* kp = Z + (size_t)tok * INW + AW + h * 64 + 8 * g;
            float f0[8], f1[8]; unpack8(*(const v4u*)kp, f0); unpack8(*(const v4u*)(kp + 32), f1);
            float ss = 0.f;
#pragma unroll
            for (int j = 0; j < 8; ++j) ss += f0[j] * f0[j] + f1[j] * f1[j];
            ss += __shfl_xor(ss, 16); ss += __shfl_xor(ss, 32);
            const float rsk = 1.0f / sqrtf(ss * (1.f / 64.f) + 1e-6f);
            *(LAS v4u*)(vt + KF_OFF + (kblk * 2 + 0) * 1024 + lane * 16) = (v4u){cvtpk(f0[0] * rsk, f0[1] * rsk), cvtpk(f0[2] * rsk, f0[3] * rsk), cvtpk(f0[4] * rsk, f0[5] * rsk), cvtpk(f0[6] * rsk, f0[7] * rsk)};
            *(LAS v4u*)(vt + KF_OFF + (kblk * 2 + 1) * 1024 + lane * 16) = (v4u){cvtpk(f1[0] * rsk, f1[1] * rsk), cvtpk(f1[2] * rsk, f1[3] * rsk), cvtpk(f1[4] * rsk, f1[5] * rsk), cvtpk(f1[6] * rsk, f1[7] * rsk)};
        }
#pragma unroll
        for (int i = 0; i < 8; ++i) {
            const int key = 8 * i + (lane >> 3), chunk = lane & 7;
            const int tok = b * SEQ + (kb * 64 + key) * d + r;
            const v4u w = *(const v4u*)(Z + (size_t)tok * INW + 2 * AW + h * 64 + 8 * chunk);
            LAS unsigned char* q = vt + (8 * chunk) * VT_STRIDE + 2 * key;
            *(LAS bf16*)(q + 0 * VT_STRIDE) = (bf16)(w.x & 0xffffu); *(LAS bf16*)(q + 1 * VT_STRIDE) = (bf16)(w.x >> 16);
            *(LAS bf16*)(q + 2 * VT_STRIDE) = (bf16)(w.y & 0xffffu); *(LAS bf16*)(q + 3 * VT_STRIDE) = (bf16)(w.y >> 16);
            *(LAS bf16*)(q + 4 * VT_STRIDE) = (bf16)(w.z & 0xffffu); *(LAS bf16*)(q + 5 * VT_STRIDE) = (bf16)(w.z >> 16);
            *(LAS bf16*)(q + 6 * VT_STRIDE) = (bf16)(w.w & 0xffffu); *(LAS bf16*)(q + 7 * VT_STRIDE) = (bf16)(w.w >> 16);
        }
        asm volatile("s_waitcnt lgkmcnt(0)" ::: "memory"); __builtin_amdgcn_wave_barrier();
        const int obase = (kb - qb) * 64;
#pragma unroll
        for (int qt = 0; qt < 4; ++qt) {
            f32x4 sa[4];
#pragma unroll
            for (int kblk = 0; kblk < 4; ++kblk) {
                const bf16x8 k0 = *(const LAS bf16x8*)(vt + KF_OFF + (kblk * 2 + 0) * 1024 + lane * 16), k1 = *(const LAS bf16x8*)(vt + KF_OFF + (kblk * 2 + 1) * 1024 + lane * 16);
                sa[kblk] = mma(k0, qf[qt][0], z4); sa[kblk] = mma(k1, qf[qt][1], sa[kblk]); }
            const int qi = 16 * qt + c16;
            float mx = -1e30f;
#pragma unroll
            for (int kblk = 0; kblk < 4; ++kblk)
#pragma unroll
                for (int reg = 0; reg < 4; ++reg) {
                    const int o = obase + 16 * kblk + 4 * g + reg - qi, ao = o < 0 ? -o : o;
                    float sv = sa[kblk][reg] - slope2 * (float)ao;
                    sv = (ao <= 64) ? sv : -1e30f;
                    sa[kblk][reg] = sv; mx = fmaxf(mx, sv);
                }
            mx = fmaxf(mx, __shfl_xor(mx, 16)); mx = fmaxf(mx, __shfl_xor(mx, 32));
            const float mn = fmaxf(mrun[qt], mx), alpha = exp2f(mrun[qt] - mn);
            mrun[qt] = mn;
            float ls = 0.f;
#pragma unroll
            for (int kblk = 0; kblk < 4; ++kblk)
#pragma unroll
                for (int reg = 0; reg < 4; ++reg) { const float p = exp2f(sa[kblk][reg] - mn); sa[kblk][reg] = p; ls += p; }
            lrun[qt] = lrun[qt] * alpha + ls;
            const bf16x8 pf0 = mkfrag(cvtpk(sa[0][0], sa[0][1]), cvtpk(sa[0][2], sa[0][3]), cvtpk(sa[1][0], sa[1][1]), cvtpk(sa[1][2], sa[1][3]));
            const bf16x8 pf1 = mkfrag(cvtpk(sa[2][0], sa[2][1]), cvtpk(sa[2][2], sa[2][3]), cvtpk(sa[3][0], sa[3][1]), cvtpk(sa[3][2], sa[3][3]));
#pragma unroll
            for (int dt = 0; dt < 4; ++dt) {
                const LAS unsigned char* vr = vt + (16 * dt + c16) * VT_STRIDE + 8 * g;
                const u32x2 a0 = *(const LAS u32x2*)(vr), a1 = *(const LAS u32x2*)(vr + 32), a2 = *(const LAS u32x2*)(vr + 64), a3 = *(const LAS u32x2*)(vr + 96);
                f32x4 oc = oacc[dt][qt] * alpha;
                oc = mma(mkfrag(a0.x, a0.y, a1.x, a1.y), pf0, oc);
                oc = mma(mkfrag(a2.x, a2.y, a3.x, a3.y), pf1, oc);
                oacc[dt][qt] = oc;
            }
            __builtin_amdgcn_sched_barrier(0);
        }
        asm volatile("s_waitcnt lgkmcnt(0)" ::: "memory"); __builtin_amdgcn_wave_barrier();
    }
#pragma unroll
    for (int qt = 0; qt < 4; ++qt) {
        float lt = lrun[qt]; lt += __shfl_xor(lt, 16); lt += __shfl_xor(lt, 32);
        const float inv = 1.0f / lt;
        const int tok = b * SEQ + (qb * 64 + 16 * qt + c16) * d + r;
        bf16* op = Ob + (size_t)tok * opitch + h * 64 + 4 * g;
#pragma unroll
        for (int dt = 0; dt < 4; ++dt) { const f32x4 o = oacc[dt][qt] * inv; u32x2 w; w.x = cvtpk(o[0], o[1]); w.y = cvtpk(o[2], o[3]); *(u32x2*)(op + 16 * dt) = w; }
        if (g == 0) lse_out[(size_t)tok * NH + h] = (mrun[qt] + log2f(lt)) * LN2;
    }
}
}

namespace peer {
using scan::cvtpk; using scan::mkfrag; using scan::mma;
constexpr int KEY_SLOTS = 64;

template <int CTRL> __device__ __forceinline__ unsigned dppu(unsigned x) { return (unsigned)__builtin_amdgcn_update_dpp(0, (int)x, CTRL, 0xf, 0xf, true); }
__device__ __forceinline__ unsigned umax(unsigned a, unsigned b) { return a > b ? a : b; }
__device__ __forceinline__ unsigned rowmax16(unsigned x) { x = umax(x, dppu<0xB1>(x)); x = umax(x, dppu<0x4E>(x)); x = umax(x, dppu<0x141>(x)); x = umax(x, dppu<0x140>(x)); return x; }
__device__ __forceinline__ float rowsum16(float x) {
    x += __uint_as_float(dppu<0xB1>(__float_as_uint(x))); x += __uint_as_float(dppu<0x4E>(__float_as_uint(x)));
    x += __uint_as_float(dppu<0x141>(__float_as_uint(x))); x += __uint_as_float(dppu<0x140>(__float_as_uint(x))); return x;
}
__device__ __forceinline__ unsigned ordkey(float f) { const unsigned u = __float_as_uint(f); return (u & 0x80000000u) ? ~u : (u | 0x80000000u); }
__device__ __forceinline__ float unordkey(unsigned k) { return __uint_as_float((k & 0x80000000u) ? (k ^ 0x80000000u) : ~k); }

__device__ __forceinline__ void setup_keys(LAS unsigned char* L, const float* keys1, const float* keys2, int tid) {
    LAS bf16* F = (LAS bf16*)L;
    for (int i = tid; i < KEY_SLOTS * 64 * 8; i += 512) {
        const int j = i & 7, l = (i >> 3) & 63, sl = i >> 9, ks = sl & 3, nt = (sl >> 2) & 7, sel = sl >> 5;
        const int n = 16 * nt + (l & 15), k = 32 * ks + 8 * (l >> 4) + j;
        F[i] = (bf16)f2bf((sel ? keys2 : keys1)[n * 128 + k]);
    }
}

#define CE_(a, b) do { const unsigned hi_ = umax(a, b), lo_ = (a < b) ? a : b; a = hi_; b = lo_; } while (0)
__device__ __forceinline__ void top16(unsigned (&key)[8][4], unsigned (&win)[4], int c16) {
#pragma unroll
    for (int reg = 0; reg < 4; ++reg) {
        CE_(key[0][reg], key[1][reg]); CE_(key[2][reg], key[3][reg]); CE_(key[4][reg], key[5][reg]); CE_(key[6][reg], key[7][reg]);
        CE_(key[0][reg], key[2][reg]); CE_(key[1][reg], key[3][reg]); CE_(key[4][reg], key[6][reg]); CE_(key[5][reg], key[7][reg]);
        CE_(key[1][reg], key[2][reg]); CE_(key[5][reg], key[6][reg]);
        CE_(key[0][reg], key[4][reg]); CE_(key[1][reg], key[5][reg]); CE_(key[2][reg], key[6][reg]); CE_(key[3][reg], key[7][reg]);
        CE_(key[2][reg], key[4][reg]); CE_(key[3][reg], key[5][reg]);
        CE_(key[1][reg], key[2][reg]); CE_(key[3][reg], key[4][reg]); CE_(key[5][reg], key[6][reg]);
    }
#pragma unroll 1
    for (int k = 0; k < TOPK; ++k) {
#pragma unroll
        for (int reg = 0; reg < 4; ++reg) {
            const unsigned m = rowmax16(key[0][reg]);
            win[reg] = (c16 == k) ? m : win[reg];
            const bool pop = key[0][reg] == m;
#pragma unroll
            for (int nt = 0; nt < 7; ++nt) key[nt][reg] = pop ? key[nt + 1][reg] : key[nt][reg];
            key[7][reg] = pop ? 0u : key[7][reg];
        }
    }
}
#undef CE_

__device__ __forceinline__ void select_batch(const LAS unsigned char* L, const bf16* Q, int* IDX, float* GATE, int batch, int lane) {
    const int g = lane >> 4, c16 = lane & 15;
    const LAS bf16x8* F = (const LAS bf16x8*)L;
    const bf16* qp = Q + (size_t)(batch * 16 + c16) * PKD + 8 * g;
    unsigned w1[4] = {0u, 0u, 0u, 0u}, w2[4] = {0u, 0u, 0u, 0u};
#pragma unroll
    for (int sel = 0; sel < 2; ++sel) {
        unsigned key[8][4];
        bf16x8 a[4];
#pragma unroll
        for (int ks = 0; ks < 4; ++ks) a[ks] = *(const bf16x8*)(qp + sel * 128 + 32 * ks);
#pragma unroll
        for (int nt = 0; nt < 8; ++nt) {
            f32x4 sc = {0.f, 0.f, 0.f, 0.f};
#pragma unroll
            for (int ks = 0; ks < 4; ++ks) sc = mma(a[ks], F[((sel * 8 + nt) * 4 + ks) * 64 + lane], sc);
#pragma unroll
            for (int reg = 0; reg < 4; ++reg) key[nt][reg] = (ordkey(sc[reg]) & ~127u) | (unsigned)(16 * nt + c16);
            __builtin_amdgcn_sched_barrier(0);
        }
        if (sel == 0) top16(key, w1, c16); else top16(key, w2, c16);
    }
    float f1[4], f2[4], cur2[4]; int ptr[4]; unsigned top[4];
#pragma unroll
    for (int reg = 0; reg < 4; ++reg) { f1[reg] = unordkey(w1[reg] & ~127u); f2[reg] = unordkey(w2[reg] & ~127u); ptr[reg] = 0; cur2[reg] = __shfl(f2[reg], lane & 48); top[reg] = 0u; }
#pragma unroll 1
    for (int k = 0; k < TOPK; ++k) {
#pragma unroll
        for (int reg = 0; reg < 4; ++reg) {
            const unsigned ck = (ptr[reg] < 16) ? ((ordkey(f1[reg] + cur2[reg]) & ~255u) | (unsigned)(c16 << 4) | (unsigned)ptr[reg]) : 0u;
            const unsigned m = rowmax16(ck);
            top[reg] = (c16 == k) ? m : top[reg];
            if ((int)((m >> 4) & 15u) == c16) ptr[reg] += 1;
            cur2[reg] = __shfl(f2[reg], (lane & 48) | (ptr[reg] & 15));
        }
    }
#pragma unroll
    for (int reg = 0; reg < 4; ++reg) {
        const int a = (top[reg] >> 4) & 15, bq = top[reg] & 15;
        const int e1 = (int)(__shfl(w1[reg], (lane & 48) | a) & 127u), e2 = (int)(__shfl(w2[reg], (lane & 48) | bq) & 127u);
        const float ts = unordkey(top[reg] & ~255u), mx = __shfl(ts, lane & 48);
        const float ex = __expf(ts - mx), sum = rowsum16(ex);
        const size_t o = (size_t)(batch * 16 + 4 * g + reg) * TOPK + c16;
        IDX[o] = e1 * NKEYS + e2; GATE[o] = ex / sum;
    }
}

__device__ __forceinline__ void convert_table(const float* src, bf16* dst, size_t n8, size_t gtid, size_t gthreads) {
    for (size_t i = gtid; i < n8; i += gthreads) {
        const f32x4 a = *(const f32x4*)(src + i * 8), b = *(const f32x4*)(src + i * 8 + 4);
        v4u o; o.x = cvtpk(a.x, a.y); o.y = cvtpk(a.z, a.w); o.z = cvtpk(b.x, b.y); o.w = cvtpk(b.z, b.w);
        *(v4u*)(dst + i * 8) = o;
    }
}

__device__ __forceinline__ float dot2bf(unsigned w, unsigned x, float acc) {
    typedef __bf16 bf2 __attribute__((ext_vector_type(2)));
    return __builtin_amdgcn_fdot2_f32_bf16(__builtin_bit_cast(bf2, w), __builtin_bit_cast(bf2, x), acc, false);
}
__device__ __forceinline__ float gelu_erf(float v) {
    const float av = fabsf(v), t = __builtin_amdgcn_rcpf(av * 0.2316418882f + 1.0f);
    float q = t * 0.5307027145f + (-0.7265760135f); q = q * t + 0.7107068705f; q = q * t + (-0.142248368f); q = q * t + 0.127414796f; q = q * t;
    const float e = __builtin_amdgcn_exp2f((v * v) * (-0.72134752044f));
    const float m = v * (q * e);
    return v < 0.f ? m : v - m;
}

typedef float f32x2c __attribute__((ext_vector_type(2)));
__device__ __forceinline__ void convert_rows_fp8(const float* src, unsigned char* dst, float* scale, int rows, int gw, int ngw, int lane) {
    for (int rrow = gw; rrow < rows; rrow += ngw) {
        const float* p = src + (size_t)rrow * D + 16 * lane;
        const f32x4 a = *(const f32x4*)p, b = *(const f32x4*)(p + 4), c = *(const f32x4*)(p + 8), d = *(const f32x4*)(p + 12);
        float m = fmaxf(fmaxf(fmaxf(fabsf(a.x), fabsf(a.y)), fmaxf(fabsf(a.z), fabsf(a.w))), fmaxf(fmaxf(fabsf(b.x), fabsf(b.y)), fmaxf(fabsf(b.z), fabsf(b.w))));
        m = fmaxf(m, fmaxf(fmaxf(fmaxf(fabsf(c.x), fabsf(c.y)), fmaxf(fabsf(c.z), fabsf(c.w))), fmaxf(fmaxf(fabsf(d.x), fabsf(d.y)), fmaxf(fabsf(d.z), fabsf(d.w)))));
#pragma unroll
        for (int o = 1; o < 64; o <<= 1) m = fmaxf(m, __shfl_xor(m, o));
        m = fmaxf(m, 1e-30f);
        const float inv = 448.0f / m;
        v4u w;
        w.x = (unsigned)__builtin_amdgcn_cvt_pk_fp8_f32(a.z * inv, a.w * inv, __builtin_amdgcn_cvt_pk_fp8_f32(a.x * inv, a.y * inv, 0, false), true);
        w.y = (unsigned)__builtin_amdgcn_cvt_pk_fp8_f32(b.z * inv, b.w * inv, __builtin_amdgcn_cvt_pk_fp8_f32(b.x * inv, b.y * inv, 0, false), true);
        w.z = (unsigned)__builtin_amdgcn_cvt_pk_fp8_f32(c.z * inv, c.w * inv, __builtin_amdgcn_cvt_pk_fp8_f32(c.x * inv, c.y * inv, 0, false), true);
        w.w = (unsigned)__builtin_amdgcn_cvt_pk_fp8_f32(d.z * inv, d.w * inv, __builtin_amdgcn_cvt_pk_fp8_f32(d.x * inv, d.y * inv, 0, false), true);
        *(v4u*)(dst + (size_t)rrow * D + 16 * lane) = w;
        if (lane == 0) scale[rrow] = m * (1.0f / 448.0f);
    }
}
__device__ __forceinline__ unsigned pack_i8x4(float a, float b, float c, float d) {
    const int ia = (int)rintf(a), ib = (int)rintf(b), ic = (int)rintf(c), id = (int)rintf(d);
    return (unsigned)(ia & 0xff) | ((unsigned)(ib & 0xff) << 8) | ((unsigned)(ic & 0xff) << 16) | ((unsigned)id << 24);
}
__device__ __forceinline__ void convert_rows_i8(const float* src, unsigned char* dst, float* scale, int rows, int gw, int ngw, int lane) {
    for (int rrow = gw; rrow < rows; rrow += ngw) {
        const float* p = src + (size_t)rrow * D + 16 * lane;
        const f32x4 a = *(const f32x4*)p, b = *(const f32x4*)(p + 4), c = *(const f32x4*)(p + 8), d = *(const f32x4*)(p + 12);
        float m = fmaxf(fmaxf(fmaxf(fabsf(a.x), fabsf(a.y)), fmaxf(fabsf(a.z), fabsf(a.w))), fmaxf(fmaxf(fabsf(b.x), fabsf(b.y)), fmaxf(fabsf(b.z), fabsf(b.w))));
        m = fmaxf(m, fmaxf(fmaxf(fmaxf(fabsf(c.x), fabsf(c.y)), fmaxf(fabsf(c.z), fabsf(c.w))), fmaxf(fmaxf(fabsf(d.x), fabsf(d.y)), fmaxf(fabsf(d.z), fabsf(d.w)))));
#pragma unroll
        for (int o = 1; o < 64; o <<= 1) m = fmaxf(m, __shfl_xor(m, o));
        m = fmaxf(m, 1e-30f);
        const float inv = 127.0f / m;
        v4u w;
        w.x = pack_i8x4(a.x * inv, a.y * inv, a.z * inv, a.w * inv); w.y = pack_i8x4(b.x * inv, b.y * inv, b.z * inv, b.w * inv);
        w.z = pack_i8x4(c.x * inv, c.y * inv, c.z * inv, c.w * inv); w.w = pack_i8x4(d.x * inv, d.y * inv, d.z * inv, d.w * inv);
        *(v4u*)(dst + (size_t)rrow * D + 16 * lane) = w;
        if (lane == 0) scale[rrow] = m * (1.0f / 127.0f);
    }
}
__device__ __forceinline__ int isum8(int x) {
    x += (int)dppu<0xB1>((unsigned)x); x += (int)dppu<0x4E>((unsigned)x); x += (int)dppu<0x141>((unsigned)x); return x;
}
__device__ __forceinline__ float sum8(float x) {
    x += __uint_as_float(dppu<0xB1>(__float_as_uint(x))); x += __uint_as_float(dppu<0x4E>(__float_as_uint(x))); x += __uint_as_float(dppu<0x141>(__float_as_uint(x))); return x;
}
__device__ __forceinline__ float dot16_fp8(const v4u q, const f32x2c (&x)[8]) {
    f32x2c d = __builtin_amdgcn_cvt_pk_f32_fp8((int)q.x, false) * x[0];
    d = __builtin_elementwise_fma(__builtin_amdgcn_cvt_pk_f32_fp8((int)q.x, true), x[1], d);
    d = __builtin_elementwise_fma(__builtin_amdgcn_cvt_pk_f32_fp8((int)q.y, false), x[2], d);
    d = __builtin_elementwise_fma(__builtin_amdgcn_cvt_pk_f32_fp8((int)q.y, true), x[3], d);
    d = __builtin_elementwise_fma(__builtin_amdgcn_cvt_pk_f32_fp8((int)q.z, false), x[4], d);
    d = __builtin_elementwise_fma(__builtin_amdgcn_cvt_pk_f32_fp8((int)q.z, true), x[5], d);
    d = __builtin_elementwise_fma(__builtin_amdgcn_cvt_pk_f32_fp8((int)q.w, false), x[6], d);
    d = __builtin_elementwise_fma(__builtin_amdgcn_cvt_pk_f32_fp8((int)q.w, true), x[7], d);
    return d.x + d.y;
}
__device__ __forceinline__ void axpy16_fp8(const v4u q, float cf, f32x2c (&y)[8]) {
    const f32x2c c2 = {cf, cf};
    y[0] = __builtin_elementwise_fma(__builtin_amdgcn_cvt_pk_f32_fp8((int)q.x, false), c2, y[0]); y[1] = __builtin_elementwise_fma(__builtin_amdgcn_cvt_pk_f32_fp8((int)q.x, true), c2, y[1]);
    y[2] = __builtin_elementwise_fma(__builtin_amdgcn_cvt_pk_f32_fp8((int)q.y, false), c2, y[2]); y[3] = __builtin_elementwise_fma(__builtin_amdgcn_cvt_pk_f32_fp8((int)q.y, true), c2, y[3]);
    y[4] = __builtin_elementwise_fma(__builtin_amdgcn_cvt_pk_f32_fp8((int)q.z, false), c2, y[4]); y[5] = __builtin_elementwise_fma(__builtin_amdgcn_cvt_pk_f32_fp8((int)q.z, true), c2, y[5]);
    y[6] = __builtin_elementwise_fma(__builtin_amdgcn_cvt_pk_f32_fp8((int)q.w, false), c2, y[6]); y[7] = __builtin_elementwise_fma(__builtin_amdgcn_cvt_pk_f32_fp8((int)q.w, true), c2, y[7]);
}

#define FFN_ISSUE_U(q, idv) do { _Pragma("unroll") for (int i = 0; i < 8; ++i) { const int ex_ = __shfl(idv, 8 * i + eg); \
            q[i] = *(const v4u*)(UT8 + (((unsigned)ex_ << 10) + (unsigned)(128 * sl + 16 * ch))); } } while (0)
#define FFN_DOT_U(QQ, XX, r) do { const v4u xx_ = XX; _Pragma("unroll") for (int i = 0; i < 8; ++i) { const v4u qq_ = QQ[i]; \
            int d_ = __builtin_amdgcn_sdot4((int)qq_[0], (int)xx_[0], 0, false); d_ = __builtin_amdgcn_sdot4((int)qq_[1], (int)xx_[1], d_, false); \
            d_ = __builtin_amdgcn_sdot4((int)qq_[2], (int)xx_[2], d_, false); d_ = __builtin_amdgcn_sdot4((int)qq_[3], (int)xx_[3], d_, false); \
            d_ = isum8(d_); if (ch == i) r = d_; } } while (0)
__device__ __forceinline__ void ffn_u_pass(const unsigned char* XQ, const int* IDX, const unsigned char* UT8, int* PART, int sl, int wv, int nwv, int lane) {
    const int eg = lane >> 3, ch = lane & 7;
    v4u qA[8], qB[8];
    int t = wv; if (t >= T) return;
    int i0 = IDX[(size_t)t * HK + lane], i1 = IDX[(size_t)t * HK + 64 + lane], n0 = 0, n1 = 0;
    v4u x0 = *(const v4u*)(XQ + (size_t)t * D + 128 * sl + 16 * ch), xn0 = x0;
    FFN_ISSUE_U(qA, i0);
#pragma unroll 1
    for (;;) {
        const int tn = t + nwv; const bool more = tn < T;
        if (more) { n0 = IDX[(size_t)tn * HK + lane]; n1 = IDX[(size_t)tn * HK + 64 + lane]; xn0 = *(const v4u*)(XQ + (size_t)tn * D + 128 * sl + 16 * ch); }
        FFN_ISSUE_U(qB, i1);
        int r0 = 0, r1 = 0;
        FFN_DOT_U(qA, x0, r0);
        if (more) FFN_ISSUE_U(qA, n0);
        FFN_DOT_U(qB, x0, r1);
        int* pp = PART + ((size_t)sl * T + t) * HK + 8 * ch + eg; pp[0] = r0; pp[64] = r1;
        if (!more) break;
        i0 = n0; i1 = n1; x0 = xn0; t = tn;
    }
}
#define FFN_ISSUE_V(q, cf, idv, cv) do { _Pragma("unroll") for (int i = 0; i < 8; ++i) { const int ex_ = __shfl(idv, 8 * i + eg); cf[i] = __shfl(cv, 8 * i + eg); \
            q[i] = *(const v4u*)(VT8 + (((unsigned)ex_ << 10) + (unsigned)(128 * sl + 16 * ch))); } } while (0)
__device__ __forceinline__ void ffn_v_pass(const int* IDX, const float* COEF, const unsigned char* VT8, const float* mod, float* out, int sl, int wv, int nwv, int lane) {
    const int eg = lane >> 3, ch = lane & 7, col = 128 * sl + 16 * ch;
    v4u qA[8], qB[8]; float cfA[8], cfB[8];
    int t = wv; if (t >= T) return;
    int i0 = IDX[(size_t)t * HK + lane], i1 = IDX[(size_t)t * HK + 64 + lane], n0 = 0, n1 = 0;
    float c0 = COEF[(size_t)t * HK + lane], c1 = COEF[(size_t)t * HK + 64 + lane], cn0 = 0.f, cn1 = 0.f;
    FFN_ISSUE_V(qA, cfA, i0, c0);
#pragma unroll 1
    for (;;) {
        const int tn = t + nwv; const bool more = tn < T;
        if (more) { n0 = IDX[(size_t)tn * HK + lane]; n1 = IDX[(size_t)tn * HK + 64 + lane]; cn0 = COEF[(size_t)tn * HK + lane]; cn1 = COEF[(size_t)tn * HK + 64 + lane]; }
        FFN_ISSUE_V(qB, cfB, i1, c1);
        const size_t o = (size_t)t * D + col; const int b = t / SEQ;
        f32x2c y2[8];
#pragma unroll
        for (int k = 0; k < 8; ++k) y2[k] = (f32x2c){0.f, 0.f};
#pragma unroll
        for (int i = 0; i < 8; ++i) { axpy16_fp8(qA[i], cfA[i], y2); if (i & 1) __builtin_amdgcn_sched_barrier(0); }
        if (more) FFN_ISSUE_V(qA, cfA, n0, cn0);
        f32x4 oa[4];
#pragma unroll
        for (int k4 = 0; k4 < 4; ++k4) oa[k4] = *(const f32x4*)(out + o + 4 * k4);
#pragma unroll
        for (int i = 0; i < 8; ++i) { axpy16_fp8(qB[i], cfB[i], y2); if (i & 1) __builtin_amdgcn_sched_barrier(0); }
        float y[16];
#pragma unroll
        for (int k = 0; k < 8; ++k) { y[2 * k] = y2[k].x; y[2 * k + 1] = y2[k].y; }
#pragma unroll
        for (int k = 0; k < 16; ++k) { y[k] += __uint_as_float(dppu<0x128>(__float_as_uint(y[k]))); y[k] += __shfl_xor(y[k], 16); y[k] += __shfl_xor(y[k], 32); }
        if (eg == 0) {
#pragma unroll
            for (int k4 = 0; k4 < 4; ++k4) { f32x4 w = oa[k4]; const f32x4 ga = *(const f32x4*)(mod + b * MODW + 5 * D + col + 4 * k4);
                w.x += ga.x * y[4 * k4]; w.y += ga.y * y[4 * k4 + 1]; w.z += ga.z * y[4 * k4 + 2]; w.w += ga.w * y[4 * k4 + 3]; *(f32x4*)(out + o + 4 * k4) = w; } }
        if (!more) break;
        i0 = n0; i1 = n1; c0 = cn0; c1 = cn1; t = tn;
    }
}
}

namespace fin {
using scan::cvtpk; using scan::mkfrag; using scan::mma;
typedef unsigned u32x2 __attribute__((ext_vector_type(2)));

__device__ __forceinline__ float shift3(const bf16* p, bool hasp, bool hasn, float mp, float mn) {
    const float z = bf2f(p[0]), zp = hasp ? bf2f(p[-INW]) : 0.f, zn = hasn ? bf2f(p[INW]) : 0.f;
    return z + mp * (zp - z) + mn * (zn - z);
}

__device__ __forceinline__ void unpack4(const u32x2 w, float (&f)[4]) {
    f[0] = __uint_as_float(w.x << 16); f[1] = __uint_as_float(w.x & 0xffff0000u); f[2] = __uint_as_float(w.y << 16); f[3] = __uint_as_float(w.y & 0xffff0000u);
}
__device__ __forceinline__ void phase(LAS unsigned char* L, const bf16* Z, const float* mu_prev, const float* mu_next, const float* g_up, const bf16* Y, const float* BON,
                                      const float* k_a, const float* r_k, const float* lnx_g, const float* lnx_b, bf16* mix, const bf16* O3, const float* LSE,
                                      int bx, int G, int tid, int wave, int lane) {
    const int g = lane >> 4, c16 = lane & 15, ch0 = 64 * wave + 4 * c16;
    LAS bf16* sg = (LAS bf16*)L;
    bf16x8 bf[4][4];
#pragma unroll
    for (int ks = 0; ks < 4; ++ks) {
        f32x4 rowv[8];
#pragma unroll
        for (int jj = 0; jj < 8; ++jj) rowv[jj] = *(const f32x4*)(g_up + (size_t)(32 * ks + 8 * g + jj) * RW + ch0);
#pragma unroll
        for (int nt = 0; nt < 4; ++nt) bf[nt][ks] = mkfrag(cvtpk(rowv[0][nt], rowv[1][nt]), cvtpk(rowv[2][nt], rowv[3][nt]), cvtpk(rowv[4][nt], rowv[5][nt]), cvtpk(rowv[6][nt], rowv[7][nt]));
    }
    const f32x4 mpr = *(const f32x4*)(mu_prev + ch0), mnr = *(const f32x4*)(mu_next + ch0), mpk = *(const f32x4*)(mu_prev + RW + ch0), mnk = *(const f32x4*)(mu_next + RW + ch0),
                mpv = *(const f32x4*)(mu_prev + 2 * RW + ch0), mnv = *(const f32x4*)(mu_next + 2 * RW + ch0);
    const f32x4 ka1 = *(const f32x4*)(k_a + ch0), rk1 = *(const f32x4*)(r_k + ch0), lg = *(const f32x4*)(lnx_g + ch0), lb = *(const f32x4*)(lnx_b + ch0);
    const int j0 = (tid & 31) * 4;
    const f32x4 mpg = *(const f32x4*)(mu_prev + 3 * RW + DL + AL + j0), mng = *(const f32x4*)(mu_next + 3 * RW + DL + AL + j0);
    for (int tb = bx; tb < T / 16; tb += G) {
        const int tok0 = tb * 16;
        __syncthreads();
        {
            const int tl = tid >> 5, tok = tok0 + tl, t = tok % SEQ;
            const bf16* p = Z + (size_t)tok * INW + 3 * AW + 3 * RW + DL + AL + j0;
            const bool hasp = t > 0, hasn = t < SEQ - 1;
            float zc[4], zp[4], zn[4];
            unpack4(*(const u32x2*)p, zc); unpack4(*(const u32x2*)(hasp ? p - INW : p), zp); unpack4(*(const u32x2*)(hasn ? p + INW : p), zn);
            float o[4];
#pragma unroll
            for (int e = 0; e < 4; ++e) { const float pv = hasp ? zp[e] : 0.f, nv = hasn ? zn[e] : 0.f; const float v = zc[e] + mpg[e] * (pv - zc[e]) + mng[e] * (nv - zc[e]); o[e] = __builtin_amdgcn_rcpf(1.0f + __expf(-v)); }
            u32x2 w; w.x = cvtpk(o[0], o[1]); w.y = cvtpk(o[2], o[3]);
            *(LAS u32x2*)(sg + tl * 128 + j0) = w;
        }
        __syncthreads();
        f32x4 ga[4];
        {
            bf16x8 af[4];
#pragma unroll
            for (int ks = 0; ks < 4; ++ks) af[ks] = *(const LAS bf16x8*)(sg + c16 * 128 + 32 * ks + 8 * g);
#pragma unroll
            for (int nt = 0; nt < 4; ++nt) { f32x4 a = {0.f, 0.f, 0.f, 0.f};
#pragma unroll
                for (int ks = 0; ks < 4; ++ks) a = mma(af[ks], bf[nt][ks], a);
                ga[nt] = a; }
        }
#pragma unroll
        for (int reg = 0; reg < 4; ++reg) {
            const int tok = tok0 + 4 * g + reg, t = tok % SEQ;
            const bool hasp = t > 0, hasn = t < SEQ - 1;
            const bf16* zr = Z + (size_t)tok * INW + 3 * AW + ch0;
            const size_t o = (size_t)tok * RW + ch0;
            float y0[4], y1[4]; unpack4(*(const u32x2*)(Y + o), y0); unpack4(*(const u32x2*)(Y + (size_t)T * RW + o), y1);
            float rc[4], rp[4], rn[4], kc[4], kp[4], kn[4], vc[4], vp[4], vn[4];
            unpack4(*(const u32x2*)zr, rc); unpack4(*(const u32x2*)(hasp ? zr - INW : zr), rp); unpack4(*(const u32x2*)(hasn ? zr + INW : zr), rn);
            unpack4(*(const u32x2*)(zr + RW), kc); unpack4(*(const u32x2*)(hasp ? zr + RW - INW : zr + RW), kp); unpack4(*(const u32x2*)(hasn ? zr + RW + INW : zr + RW), kn);
            unpack4(*(const u32x2*)(zr + 2 * RW), vc); unpack4(*(const u32x2*)(hasp ? zr + 2 * RW - INW : zr + 2 * RW), vp); unpack4(*(const u32x2*)(hasn ? zr + 2 * RW + INW : zr + 2 * RW), vn);
            bf16* mp = mix + (size_t)tok * D + ch0;
            float o1[4], o2[4], o3[4];
            unpack4(*(const u32x2*)mp, o1); unpack4(*(const u32x2*)(mp + AW), o2); unpack4(*(const u32x2*)(O3 + (size_t)tok * AW + ch0), o3);
            const float l1 = LSE[(size_t)tok * NH + wave], l2 = LSE[((size_t)T + tok) * NH + wave], l3 = LSE[((size_t)2 * T + tok) * NH + wave];
            const float bon = BON[(size_t)tok * NH + wave] + BON[((size_t)T + tok) * NH + wave];
            float yv[4], vv[4], s1 = 0.f, sb = 0.f;
#pragma unroll
            for (int nt = 0; nt < 4; ++nt) {
                yv[nt] = y0[nt] + y1[nt]; s1 += yv[nt];
                const float pr = hasp ? rp[nt] : 0.f, nr = hasn ? rn[nt] : 0.f, pk = hasp ? kp[nt] : 0.f, nk = hasn ? kn[nt] : 0.f, pvv = hasp ? vp[nt] : 0.f, nvv = hasn ? vn[nt] : 0.f;
                const float rr = rc[nt] + mpr[nt] * (pr - rc[nt]) + mnr[nt] * (nr - rc[nt]);
                const float kk = kc[nt] + mpk[nt] * (pk - kc[nt]) + mnk[nt] * (nk - kc[nt]);
                vv[nt] = vc[nt] + mpv[nt] * (pvv - vc[nt]) + mnv[nt] * (nvv - vc[nt]);
                sb += rr * kk * rk1[nt] * (1.0f - ka1[nt]);
            }
            const float mean = peer::rowsum16(s1) * (1.f / 64.f);
            float s2 = 0.f;
#pragma unroll
            for (int nt = 0; nt < 4; ++nt) s2 += (yv[nt] - mean) * (yv[nt] - mean);
            const float rstd = __builtin_amdgcn_rsqf(peer::rowsum16(s2) * (1.f / 64.f) + 64e-5f);
            const float bs = peer::rowsum16(sb) + 0.5f * bon;
            const float lm = fmaxf(l1, fmaxf(l2, l3)), w1 = __expf(l1 - lm), w2 = __expf(l2 - lm), w3 = __expf(l3 - lm), wi = __builtin_amdgcn_rcpf(w1 + w2 + w3);
            float att[4], rw[4];
#pragma unroll
            for (int nt = 0; nt < 4; ++nt) {
                att[nt] = (w1 * o1[nt] + w2 * o2[nt] + w3 * o3[nt]) * wi;
                rw[nt] = ((yv[nt] - mean) * rstd * lg[nt] + lb[nt] + bs * vv[nt]) * ga[nt][reg];
            }
            u32x2 wa, wr; wa.x = cvtpk(att[0], att[1]); wa.y = cvtpk(att[2], att[3]); wr.x = cvtpk(rw[0], rw[1]); wr.y = cvtpk(rw[2], rw[3]);
            *(u32x2*)mp = wa; *(u32x2*)(mp + AW) = wr;
            __builtin_amdgcn_sched_barrier(0);
        }
    }
}
}

#ifndef MK_SKIP
#define MK_SKIP 0
#endif
constexpr int N_PHASES = 12;
struct Args { const float* in[27]; float* out; unsigned char* ws; int ph_lo, ph_hi, li, pad; };

__global__ void __launch_bounds__(NWAVES * 64, 2) mk_fwd(Args args) {
    extern __shared__ __attribute__((aligned(16))) unsigned char lds[];
    LAS unsigned char* L = (LAS unsigned char*)lds;
    volatile LAS unsigned* MISC = (volatile LAS unsigned*)(L + MISC_OFF);
    const int tid = threadIdx.x, lane = tid & 63, wave = __builtin_amdgcn_readfirstlane(tid >> 6);
    const int G = gridDim.x, bx = blockIdx.x;
    unsigned char* ws = args.ws;
    gu32* ctl = (gu32*)(ws + WS_CTL);
    const float* x = args.in[0]; const float* cvec = args.in[1]; const float* ada_w = args.in[2]; const float* ada_b = args.in[3];
    const float* norm1_g = args.in[4]; const float* w_in = args.in[5]; const float* mu_prev = args.in[6]; const float* mu_next = args.in[7];
    const float* q_norm_g = args.in[8]; const float* k_norm_g = args.in[9]; const float* w_decay0 = args.in[10]; const float* w_decay_up = args.in[11];
    const float* a_gate0 = args.in[12]; const float* a_gate_up = args.in[13]; const float* g_up = args.in[14]; const float* k_k = args.in[15];
    const float* k_a = args.in[16]; const float* r_k = args.in[17]; const float* lnx_g = args.in[18]; const float* lnx_b = args.in[19];
    const float* w_out = args.in[20]; const float* norm2_g = args.in[21]; const float* w_query = args.in[22]; const float* keys1 = args.in[23];
    const float* keys2 = args.in[24]; const float* peer_u = args.in[25]; const float* peer_v = args.in[26];
    float* out = args.out;
    float* MOD = (float*)(ws + WS_MOD); bf16* KEYS = (bf16*)(ws + WS_KEYS); bf16* WIN = (bf16*)(ws + WS_WIN); bf16* WOUT = (bf16*)(ws + WS_WOUT); bf16* WQ = (bf16*)(ws + WS_WQ);
    bf16* XN = (bf16*)(ws + WS_XN); bf16* Z = (bf16*)(ws + WS_Z); bf16* MIX = (bf16*)(ws + WS_MIX); bf16* Y = (bf16*)(ws + WS_Y); bf16* Q = (bf16*)(ws + WS_Q);
    int* IDX = (int*)(ws + WS_IDX); float* GATE = (float*)(ws + WS_GATE); float* BON = (float*)(ws + WS_BON);
    bf16* O3 = (bf16*)(ws + WS_O3); float* LSE = (float*)(ws + WS_LSE); unsigned char* UT8 = ws + WS_UT; unsigned char* VT8 = ws + WS_VT; float* SU = (float*)(ws + WS_SU); float* SV = (float*)(ws + WS_SU + 65536); unsigned char* XQ = ws + WS_XQ; float* SX = (float*)(ws + WS_XQ + 16 * MiB); float* PART = (float*)(ws + WS_PART);

    for (int u = tid; u < (LDS_BYTES - LDSCTL_OFF) / 4; u += NWAVES * 64) ((LAS unsigned*)(L + LDSCTL_OFF))[u] = 0u;
    __syncthreads();
    XcdBarrier bar = xcd_barrier_post((unsigned*)(ctl + CW_BAR) + args.li * XCD_BAR_WORDS, MISC + 8);
    const int lo = args.ph_lo, hi = args.ph_hi;
#define IN(k) (lo <= (k) && (k) < hi)
#define SEAM(k) do { if (IN(k) && IN((k) + 1)) xcd_barrier(bar); } while (0)
    const int gw = bx * NWAVES + wave, NGW = G * NWAVES;

    if (IN(0) && !(MK_SKIP & (1 << 0))) {
        if (bx < 2 * (MODW / 64)) {
            const int cg = bx % (MODW / 64), kh = bx / (MODW / 64);
            LAS float* sc = (LAS float*)L; LAS float* part = (LAS float*)(L + 32768);
            for (int i = tid; i < BATCH * D; i += NWAVES * 64) { const float cv = cvec[i]; sc[i] = cv / (1.f + expf(-cv)); }
            __syncthreads();
            const int j0 = cg * 64, i0 = kh * 512 + wave * 64;
            float acc[BATCH];
#pragma unroll
            for (int b = 0; b < BATCH; ++b) acc[b] = 0.f;
#pragma unroll 1
            for (int ii = 0; ii < 64; ii += 8) {
                float w[8];
#pragma unroll
                for (int e = 0; e < 8; ++e) w[e] = ada_w[(size_t)(i0 + ii + e) * MODW + j0 + lane];
#pragma unroll
                for (int e = 0; e < 8; ++e)
#pragma unroll
                    for (int b = 0; b < BATCH; ++b) acc[b] += sc[b * D + i0 + ii + e] * w[e];
            }
#pragma unroll
            for (int b = 0; b < BATCH; ++b) part[(wave * 8 + b) * 64 + lane] = acc[b];
            __syncthreads();
            { const int b = tid >> 6; float s = 0.f;
#pragma unroll
              for (int w = 0; w < 8; ++w) s += part[(w * 8 + b) * 64 + lane];
              if (kh == 0) s += ada_b[j0 + lane];
              atomicAdd(MOD + b * MODW + j0 + lane, s); }
            __syncthreads();
        }
        LAS float* scr = (LAS float*)(L + RING_OFF + wave * 16384);
        constexpr int I_IN = (D / 64) * (INW / 32), I_OUT = (D / 64) * (D / 32), I_Q = (D / 64) * (QW / 32);
        for (int it = gw; it < I_IN + I_OUT + I_Q; it += NGW) {
            int r = it;
            if (r < I_IN) { p0_transpose_item(w_in, D, INW, WIN, 0, scr, r, lane); continue; } r -= I_IN;
            if (r < I_OUT) { p0_transpose_item(w_out, D, D, WOUT, 0, scr, r, lane); continue; } r -= I_OUT;
            p0_transpose_item(w_query, D, QW, WQ, 0, scr, r, lane);
        }
    }
    SEAM(0);
    if (IN(1) && !(MK_SKIP & (1 << 1))) { norm_rows(x, norm1_g, MOD, 0, D, XN, gw, NGW, lane); }
    SEAM(1);
    if (IN(2) && !(MK_SKIP & (1 << 2))) {
        pg8::Gemm g{XN, WIN, T, INW, D}; pg8::StaticOrder S; S.init(T, INW, G, bx);
        pg8::EpiBf16<0> E{Z, INW, nullptr, 0, 0, 1.f};
        pg8::gemm_phase<pg8::EpiBf16<0>, pg8::StaticOrder, true, true>(L + RING_OFF, g, S, E);
    }
    SEAM(2);
    if (IN(3) && !(MK_SKIP & (1 << 3))) {
        constexpr int NCHAIN = BATCH * NH * 2;
        if (bx < NCHAIN) scan::chain(L, Z, mu_prev, mu_next, w_decay0, w_decay_up, a_gate0, a_gate_up, k_k, k_a, r_k, Y, BON, bx, tid, wave, lane);
        {
            gu32* ucnt = ctl + CW_WORK + 64 * args.li;
            LAS unsigned char* vt = L + wave * attn::WAVE_LDS;
            for (;;) {
                unsigned uu = 0u;
                if (lane == 0) uu = __hip_atomic_fetch_add(ucnt, 1u, __ATOMIC_RELAXED, __HIP_MEMORY_SCOPE_AGENT);
                const int u = __builtin_amdgcn_readfirstlane((int)uu);
                if (u >= BATCH * NH * 96) break;
                const int x = u & 31, p = (u >> 5) % 3, bh = u / 96;
                const int d = (p == 0) ? 1 : (p == 1 ? 4 : 16), nb = 32 / d, r = x / nb, qb = x % nb;
                bf16* Ob = (p == 0) ? MIX : (p == 1 ? MIX + AW : O3); const int opitch = (p == 2) ? AW : D;
                attn::unit(vt, Z, q_norm_g, k_norm_g, Ob, opitch, LSE + (size_t)p * T * NH, bh >> 3, bh & 7, d, r, qb, nb, lane);
            }
        }
        {
            gu32* ccnt = ctl + CW_WORK2 + 64 * args.li;
            for (;;) {
                unsigned uu = 0u;
                if (lane == 0) uu = __hip_atomic_fetch_add(ccnt, 1u, __ATOMIC_RELAXED, __HIP_MEMORY_SCOPE_AGENT);
                const int it = __builtin_amdgcn_readfirstlane((int)uu);
                if (it >= 1024) break;
                const int r0 = (it & 511) * 32;
                if (it < 512) peer::convert_rows_i8(peer_u + (size_t)r0 * D, UT8 + (size_t)r0 * D, SU + r0, 32, 0, 1, lane);
                else peer::convert_rows_fp8(peer_v + (size_t)r0 * D, VT8 + (size_t)r0 * D, SV + r0, 32, 0, 1, lane);
            }
        }
    }
    SEAM(3);
    if (IN(4) && !(MK_SKIP & (1 << 4))) { fin::phase(L, Z, mu_prev, mu_next, g_up, Y, BON, k_a, r_k, lnx_g, lnx_b, MIX, O3, LSE, bx, G, tid, wave, lane); }
    SEAM(4);
    if (IN(5) && !(MK_SKIP & (1 << 5))) {
        pg8::Gemm g{MIX, WOUT, T, D, D}; pg8::StaticOrder S; S.init(T, D, G, bx);
        EpiRes E{x, MOD, 2 * D, out, D};
        pg8::gemm_phase<EpiRes, pg8::StaticOrder, true, true>(L + RING_OFF, g, S, E);
    }
    SEAM(5);
    if (IN(6) && !(MK_SKIP & (1 << 6))) { norm_rows_q(out, norm2_g, MOD, 3 * D, 4 * D, XN, XQ, SX, gw, NGW, lane);
    }
    SEAM(6);
    if (IN(7) && !(MK_SKIP & (1 << 7))) {
        pg8::Gemm g{XN, WQ, T, QW, D}; pg8::StaticOrder S; S.init(T, QW, G, bx);
        pg8::EpiBf16<0> E{Q, QW, nullptr, 0, 0, 1.f};
        pg8::gemm_phase<pg8::EpiBf16<0>, pg8::StaticOrder, true, true>(L + RING_OFF, g, S, E);
    }
    SEAM(7);
    if (IN(8) && !(MK_SKIP & (1 << 8))) { __syncthreads(); peer::setup_keys(L, keys1, keys2, tid); __syncthreads();
        for (int bt = gw; bt < T * PH / 16; bt += NGW) peer::select_batch(L, Q, IDX, GATE, bt, lane); }
    SEAM(8);
    {
        const int sl = bx & 7, wv = (bx >> 3) * NWAVES + wave, nwv = (G >> 3) * NWAVES;
        if (IN(9) && !(MK_SKIP & (1 << 9))) { peer::ffn_u_pass(XQ, IDX, UT8, (int*)PART, sl, wv, nwv, lane); }
        SEAM(9);
        if (IN(10) && !(MK_SKIP & (1 << 10))) {
            for (size_t i = (size_t)bx * NWAVES * 64 + tid; i < (size_t)T * HK; i += (size_t)G * NWAVES * 64) {
                int di = 0;
#pragma unroll
                for (int s8 = 0; s8 < 8; ++s8) di += ((const int*)PART)[(size_t)s8 * T * HK + i];
                const int ex = IDX[i];
                GATE[i] = GATE[i] * peer::gelu_erf((float)di * SU[ex] * SX[i / HK]) * SV[ex];
            }
        }
        SEAM(10);
        if (IN(11) && !(MK_SKIP & (1 << 11))) { peer::ffn_v_pass(IDX, GATE, VT8, MOD, out, sl, wv, nwv, lane); }
    }
#undef IN
#undef SEAM
}

extern "C" void kernel_launch(void* const* d_in, const int* in_sizes, int n_in, void* d_out, int out_size, void* d_ws, size_t ws_size, hipStream_t stream) {
    static int grid = 0;
    if (grid == 0) {
        if (n_in != 27 || in_sizes[0] != T * D || out_size != T * D || ws_size < WS_END) { fprintf(stderr, "kernel_launch: unexpected problem (n_in %d, in0 %d, out %d, ws %zu); nothing launched\n", n_in, n_in > 0 ? in_sizes[0] : -1, out_size, ws_size); grid = -1; return; }
        int dev = 0, cus = 0, per_cu = 0;
        if (hipGetDevice(&dev) != hipSuccess || hipDeviceGetAttribute(&cus, hipDeviceAttributeMultiprocessorCount, dev) != hipSuccess) { fprintf(stderr, "kernel_launch: device query failed\n"); grid = -1; return; }
        if (hipFuncSetAttribute((const void*)mk_fwd, hipFuncAttributeMaxDynamicSharedMemorySize, LDS_BYTES) != hipSuccess) { fprintf(stderr, "kernel_launch: hipFuncSetAttribute failed\n"); grid = -1; return; }
        if (hipOccupancyMaxActiveBlocksPerMultiprocessor(&per_cu, (const void*)mk_fwd, NWAVES * 64, LDS_BYTES) != hipSuccess || per_cu < 1)
            fprintf(stderr, "kernel_launch: note: occupancy query reports %d workgroups per CU\n", per_cu);
        (void)hipGetLastError();
        grid = cus;
    }
    if (grid < 0) return;
    if (hipMemsetAsync((char*)d_ws + WS_CTL, 0, CTL_ZERO_BYTES, stream) != hipSuccess) { fprintf(stderr, "kernel_launch: hipMemsetAsync failed\n"); return; }
    Args a{};
    for (int i = 0; i < 27; ++i) a.in[i] = (const float*)d_in[i];
    a.out = (float*)d_out; a.ws = (unsigned char*)d_ws;
#ifndef MK_RANGES
#define MK_RANGES {{0, N_PHASES}}
#endif
    static const int ranges[][2] = MK_RANGES;
    const int nl = (int)(sizeof(ranges) / sizeof(ranges[0]));
    for (int li = 0; li < nl; ++li) {
        a.ph_lo = ranges[li][0]; a.ph_hi = ranges[li][1]; a.li = li;
        hipLaunchKernelGGL(mk_fwd, dim3(grid), dim3(NWAVES * 64), LDS_BYTES, stream, a);
        const hipError_t le = hipPeekAtLastError();
        if (le != hipSuccess) { fprintf(stderr, "kernel_launch: launch %d failed: %s\n", li, hipGetErrorName(le)); break; }
    }
}
```

```cpp
#include <hip/hip_runtime.h>
#include <cstdio>
#include <cstdint>
#include <cmath>
namespace pg8 {
#define PG8_LAS __attribute__((address_space(3)))
typedef unsigned short bf16_t;
typedef short bf16x8 __attribute__((ext_vector_type(8)));
typedef float f32x4 __attribute__((ext_vector_type(4)));
typedef unsigned u32x4 __attribute__((ext_vector_type(4)));
constexpr int BM = 256, BK = 64, HALF = 128, HTB = HALF * BK * 2  , STAGE_BYTES = 8 * HTB, NXCD = 8, WGM = 8;

__host__ __device__ __forceinline__ int lds_byte(int r, int c) { const int st = (r >> 4) * 2 + (c >> 5), rr = r & 15, cc = c & 31, ob = rr * 64 + cc * 2; return st * 1024 + (ob ^ (((ob >> 9) & 1) << 5)); }
__host__ __device__ __forceinline__ void stage_rc(int b, int& R, int& C) { const int st = b / 1024, sb = b % 1024, swz = sb ^ (((sb >> 9) & 1) << 5); R = (st >> 1) * 16 + swz / 64; C = (st & 1) * 32 + (swz % 64) / 2; }
__host__ __device__ __forceinline__ int perm32(int rho) { const int n = rho >> 4, i = rho & 15; return 8 * (i >> 2) + 4 * n + (i & 3); }

struct Unit { int pm, pn; };
struct Gemm { const bf16_t* A; const bf16_t* Bt; int M, N, K; };

struct StaticOrder {
    int nM, nN, nwg, G, c;
    __host__ __device__ void init(int M, int N, int G_, int c_) { nM = M / BM; nN = N / BM; nwg = nM * nN; G = G_; c = c_; }
    __host__ __device__ bool next(int i, Unit& u) const {
        const long L = (long)i * G + c; if (L >= nwg) return false;
        int wgid = (int)L; { const int q = nwg / NXCD, r = nwg % NXCD, xcd = wgid % NXCD, off = wgid / NXCD; wgid = (xcd < r ? xcd * (q + 1) : r * (q + 1) + (xcd - r) * q) + off; }
        const int nig = WGM * nN, gid = wgid / nig, fm = gid * WGM, gsz = (nM - fm) < WGM ? (nM - fm) : WGM;
        u.pm = fm + ((wgid % nig) % gsz); u.pn = (wgid % nig) / gsz; return true;
    }
    __device__ __forceinline__ void a_ready(const Unit&) const {}
    __device__ __forceinline__ void done(const Unit&) const {}
};

__device__ __forceinline__ unsigned cvt_pk_bf16(float lo, float hi) { unsigned r; asm volatile("v_cvt_pk_bf16_f32 %0, %1, %2" : "=v"(r) : "v"(lo), "v"(hi)); return r; }
typedef float f32x2 __attribute__((ext_vector_type(2)));
__device__ __forceinline__ f32x2 gelu_pk(f32x2 v) {
    const f32x2 av = __builtin_elementwise_abs(v), d = av * 0.2316418882f + 1.0f;
    f32x2 t; t.x = __builtin_amdgcn_rcpf(d.x); t.y = __builtin_amdgcn_rcpf(d.y);
    f32x2 q = t * 0.5307027145f + (-0.7265760135f); q = q * t + 0.7107068705f; q = q * t + (-0.142248368f); q = q * t + 0.127414796f; q = q * t;
    const f32x2 s = (v * v) * (-0.72134752044f);
    f32x2 e; e.x = __builtin_amdgcn_exp2f(s.x); e.y = __builtin_amdgcn_exp2f(s.y);
    const f32x2 m = v * (q * e), r = v - m;
    f32x2 o; o.x = v.x < 0.f ? m.x : r.x; o.y = v.y < 0.f ? m.y : r.y; return o;
}

template <int ACT  > struct EpiBf16 {
    static constexpr bool PERM = true, AFTER_DRAIN = false; static_assert(ACT == 0 || ACT == 1, "EpiBf16: ACT is 0 (none) or 1 (gelu_pk)");
    bf16_t* O; int ldc; const float* bias; int split_cols; size_t split_stride; float scale0;
    __device__ __forceinline__ void operator()(const f32x4 (&acc)[2][2][4][2], const Unit& u, int wr, int wc, int fr, int fq) const {
        const int row0 = u.pm * BM + wr * 64 + fr; int colt = u.pn * BM; bf16_t* base = O;
        float sc = 1.f; if (split_cols) { const int t = colt / split_cols; base += (size_t)t * split_stride; colt -= t * split_cols; if (t == 0) sc = scale0; }
        const int col0 = colt + wc * 32 + 8 * fq, bcol0 = u.pn * BM + wc * 32 + 8 * fq;
        f32x4 bv[2][2];
#pragma unroll
        for (int bj = 0; bj < 2; ++bj)
#pragma unroll
            for (int n = 0; n < 2; ++n) bv[bj][n] = bias ? *(const f32x4*)(bias + bcol0 + bj * HALF + 4 * n) : (f32x4){0.f, 0.f, 0.f, 0.f};
#pragma unroll
        for (int ai = 0; ai < 2; ++ai)
#pragma unroll
            for (int m = 0; m < 4; ++m) { bf16_t* rowp = base + (size_t)(row0 + ai * HALF + m * 16) * ldc + col0;
#pragma unroll
                for (int bj = 0; bj < 2; ++bj) { f32x4 v0 = acc[ai][bj][m][0] + bv[bj][0], v1 = acc[ai][bj][m][1] + bv[bj][1];
                    if (ACT == 1) { f32x2 a = gelu_pk((f32x2){v0[0], v0[1]}), b = gelu_pk((f32x2){v0[2], v0[3]}), c = gelu_pk((f32x2){v1[0], v1[1]}), d = gelu_pk((f32x2){v1[2], v1[3]});
                        v0 = (f32x4){a.x, a.y, b.x, b.y}; v1 = (f32x4){c.x, c.y, d.x, d.y}; }
                    v0 = v0 * sc; v1 = v1 * sc; u32x4 w; w.x = cvt_pk_bf16(v0[0], v0[1]); w.y = cvt_pk_bf16(v0[2], v0[3]); w.z = cvt_pk_bf16(v1[0], v1[1]); w.w = cvt_pk_bf16(v1[2], v1[3]);
                    *(u32x4*)(rowp + bj * HALF) = w; } }
    }
};

template <class Epi, class Sched, bool ALIGN_EPI = false, bool SP2 = false>
__device__ __forceinline__ void gemm_phase(PG8_LAS unsigned char* lds, const Gemm g, const Sched& S, const Epi& E) {
    const int tid = threadIdx.x, wid = __builtin_amdgcn_readfirstlane(tid >> 6), lane = tid & 63, wr = wid >> 2, wc = wid & 3, fr = lane & 15, fq = lane >> 4;
    const int K = g.K, nt = K / BK;
    unsigned voffA[2], voffB[2];
#pragma unroll
    for (int i = 0; i < 2; ++i) { int R, C; stage_rc(tid * 16 + i * 8192, R, C); const int Rb = Epi::PERM ? ((R & ~31) + perm32(R & 31)) : R;
        voffA[i] = (unsigned)(R * K + C) * 2u; voffB[i] = (unsigned)(Rb * K + C) * 2u; }
    const size_t kstep = (size_t)(BK * 2);
    const size_t hstep = (size_t)HALF * K * 2;
    const size_t tstep = 2 * hstep;
    const unsigned ldsw = (unsigned)wid * 1024u;
    const int aoff = lds_byte(wr * 64 + fr, fq * 8), boff = lds_byte(wc * 32 + fr, fq * 8);
#define PG8_SA(b, h) (((b) * 2 + (h)) * HTB)
#define PG8_SB(b, h) ((4 + (b) * 2 + (h)) * HTB)
#define PG8_STAGE(bufoff, gbase, voff) do { _Pragma("unroll") for (int _i = 0; _i < 2; ++_i) \
        __builtin_amdgcn_global_load_lds((const unsigned*)((const char*)(gbase) + (voff)[_i]), (PG8_LAS unsigned*)(lds + (bufoff) + ldsw + _i * 8192), 16, 0, 0); } while (0)
#define PG8_LDA(dst, b, h) do { _Pragma("unroll") for (int m = 0; m < 4; ++m) _Pragma("unroll") for (int k = 0; k < 2; ++k) dst[m][k] = *(const PG8_LAS bf16x8*)(lds + PG8_SA(b, h) + aoff + m * 2048 + k * 1024); } while (0)
#define PG8_LDB(dst, b, h) do { _Pragma("unroll") for (int n = 0; n < 2; ++n) _Pragma("unroll") for (int k = 0; k < 2; ++k) dst[n][k] = *(const PG8_LAS bf16x8*)(lds + PG8_SB(b, h) + boff + n * 2048 + k * 1024); } while (0)
#define PG8_MMA(ai, bj, At, Bt) do { __builtin_amdgcn_s_setprio(1); _Pragma("unroll") for (int m = 0; m < 4; ++m) _Pragma("unroll") for (int n = 0; n < 2; ++n) _Pragma("unroll") for (int k = 0; k < 2; ++k) \
        acc[ai][bj][m][n] = __builtin_amdgcn_mfma_f32_16x16x32_bf16(Bt[n][k], At[m][k], acc[ai][bj][m][n], 0, 0, 0); __builtin_amdgcn_s_setprio(0); } while (0)
#define PG8_WAIT_V(n) asm volatile("s_waitcnt vmcnt(" #n ")" ::: "memory")
#define PG8_WAIT_L(n) asm volatile("s_waitcnt lgkmcnt(" #n ")" ::: "memory")
#define PG8_BAR __builtin_amdgcn_s_barrier()
#define PG8_SCHED __builtin_amdgcn_sched_barrier(0)
    Unit cur, nxt; int ui = 0;
    if (!S.next(0, cur)) return;
    f32x4 acc[2][2][4][2];
#pragma unroll
    for (int a = 0; a < 2; ++a)
#pragma unroll
        for (int b = 0; b < 2; ++b)
#pragma unroll
            for (int m = 0; m < 4; ++m)
#pragma unroll
                for (int n = 0; n < 2; ++n) acc[a][b][m][n] = (f32x4){0.f, 0.f, 0.f, 0.f};
    bf16x8 At[4][2], B0[2][2], B1[2][2];
    const char* cA = (const char*)g.A + (size_t)cur.pm * tstep; const char* cB = (const char*)g.Bt + (size_t)cur.pn * tstep;
    S.a_ready(cur);
    if constexpr (SP2) {
        PG8_STAGE(PG8_SB(0, 0), cB, voffB); PG8_STAGE(PG8_SB(0, 1), cB + hstep, voffB); PG8_STAGE(PG8_SA(0, 0), cA, voffA); PG8_STAGE(PG8_SA(0, 1), cA + hstep, voffA);
        if (wr == 1) PG8_BAR;
        PG8_WAIT_V(2); PG8_BAR;
        PG8_STAGE(PG8_SB(1, 0), cB + kstep, voffB); PG8_STAGE(PG8_SA(1, 0), cA + kstep, voffA); PG8_STAGE(PG8_SB(1, 1), cB + hstep + kstep, voffB);
        PG8_WAIT_V(6); PG8_BAR;
    } else {
        PG8_STAGE(PG8_SB(0, 0), cB, voffB); PG8_STAGE(PG8_SA(0, 0), cA, voffA); PG8_STAGE(PG8_SB(0, 1), cB + hstep, voffB); PG8_STAGE(PG8_SA(0, 1), cA + hstep, voffA);
        if (wr == 1) PG8_BAR;
        PG8_WAIT_V(4); PG8_BAR;
        PG8_STAGE(PG8_SB(1, 0), cB + kstep, voffB); PG8_STAGE(PG8_SA(1, 0), cA + kstep, voffA); PG8_STAGE(PG8_SB(1, 1), cB + hstep + kstep, voffB);
        PG8_WAIT_V(6); PG8_BAR;
    }
    for (;;) {
        const bool has_next = S.next(ui + 1, nxt);
        const char* nA = has_next ? (const char*)g.A + (size_t)nxt.pm * tstep : cA; const char* nB = has_next ? (const char*)g.Bt + (size_t)nxt.pn * tstep : cB;
        for (int t = 0; t < nt; t += 2) {
            const bool last = (t == nt - 2);
            const char* a1 = cA + (size_t)(t + 1) * kstep;
            const char* a2 = last ? nA : cA + (size_t)(t + 2) * kstep; const char* b2 = last ? nB : cB + (size_t)(t + 2) * kstep;
            const char* a3 = a2 + kstep; const char* b3 = b2 + kstep;
            if (last && has_next) S.a_ready(nxt);
            if constexpr (SP2) {
            PG8_LDB(B0, 0, 0); PG8_LDB(B1, 0, 1); PG8_SCHED; PG8_LDA(At, 0, 0); PG8_STAGE(PG8_SA(1, 1), a1 + hstep, voffA);
            PG8_WAIT_V(8); PG8_WAIT_L(0); PG8_BAR; PG8_MMA(0, 0, At, B0); PG8_MMA(0, 1, At, B1); PG8_BAR; PG8_SCHED;
            PG8_LDA(At, 0, 1); PG8_STAGE(PG8_SB(0, 0), b2, voffB); PG8_STAGE(PG8_SB(0, 1), b2 + hstep, voffB); PG8_STAGE(PG8_SA(0, 0), a2, voffA);
            PG8_WAIT_V(8); PG8_WAIT_L(0); PG8_BAR; PG8_MMA(1, 0, At, B0); PG8_MMA(1, 1, At, B1); PG8_BAR; PG8_SCHED;
            PG8_LDB(B0, 1, 0); PG8_LDB(B1, 1, 1); PG8_SCHED; PG8_LDA(At, 1, 0); PG8_STAGE(PG8_SA(0, 1), a2 + hstep, voffA);
            PG8_WAIT_V(8); PG8_WAIT_L(0); PG8_BAR; PG8_MMA(0, 0, At, B0); PG8_MMA(0, 1, At, B1); PG8_BAR; PG8_SCHED;
            PG8_LDA(At, 1, 1); PG8_STAGE(PG8_SB(1, 0), b3, voffB); PG8_STAGE(PG8_SB(1, 1), b3 + hstep, voffB); PG8_STAGE(PG8_SA(1, 0), a3, voffA);
            PG8_WAIT_V(8); PG8_WAIT_L(0); PG8_BAR; PG8_MMA(1, 0, At, B0); PG8_MMA(1, 1, At, B1); PG8_BAR; PG8_SCHED;
            } else {
            PG8_LDB(B0, 0, 0); PG8_SCHED; PG8_LDA(At, 0, 0); PG8_STAGE(PG8_SA(1, 1), a1 + hstep, voffA);
            PG8_WAIT_L(8); PG8_BAR; PG8_WAIT_L(0); PG8_MMA(0, 0, At, B0); PG8_BAR; PG8_SCHED;
            PG8_LDB(B1, 0, 1); PG8_STAGE(PG8_SB(0, 0), b2, voffB);
            PG8_BAR; PG8_WAIT_L(0); PG8_MMA(0, 1, At, B1); PG8_BAR;
            PG8_LDA(At, 0, 1); PG8_STAGE(PG8_SA(0, 0), a2, voffA);
            PG8_BAR; PG8_WAIT_L(0); PG8_MMA(1, 0, At, B0); PG8_BAR; PG8_SCHED;
            PG8_STAGE(PG8_SB(0, 1), b2 + hstep, voffB);
            PG8_WAIT_V(6); PG8_BAR; PG8_MMA(1, 1, At, B1); PG8_BAR;
            PG8_LDB(B0, 1, 0); PG8_SCHED; PG8_LDA(At, 1, 0); PG8_STAGE(PG8_SA(0, 1), a2 + hstep, voffA);
            PG8_WAIT_L(8); PG8_BAR; PG8_WAIT_L(0); PG8_MMA(0, 0, At, B0); PG8_BAR; PG8_SCHED;
            PG8_LDB(B1, 1, 1); PG8_STAGE(PG8_SB(1, 0), b3, voffB);
            PG8_BAR; PG8_WAIT_L(0); PG8_MMA(0, 1, At, B1); PG8_BAR;
            PG8_LDA(At, 1, 1); PG8_STAGE(PG8_SA(1, 0), a3, voffA);
            PG8_BAR; PG8_WAIT_L(0); PG8_MMA(1, 0, At, B0); PG8_BAR; PG8_SCHED;
            PG8_STAGE(PG8_SB(1, 1), b3 + hstep, voffB);
            PG8_WAIT_V(6); PG8_BAR; PG8_MMA(1, 1, At, B1); PG8_BAR;
            }
        }
        if constexpr (ALIGN_EPI) { if (wr == 0) PG8_BAR; }
        if constexpr (!Epi::AFTER_DRAIN) { E(acc, cur, wr, wc, fr, fq); S.done(cur); }
        if (!has_next) break;
#pragma unroll
        for (int a = 0; a < 2; ++a)
#pragma unroll
            for (int b = 0; b < 2; ++b)
#pragma unroll
                for (int m = 0; m < 4; ++m)
#pragma unroll
                    for (int n = 0; n < 2; ++n) acc[a][b][m][n] = (f32x4){0.f, 0.f, 0.f, 0.f};
        cur = nxt; cA = nA; cB = nB; ++ui;
        if constexpr (ALIGN_EPI) { if (wr == 1) PG8_BAR; }
    }
    PG8_WAIT_V(0);
    if constexpr (!ALIGN_EPI) { if (wr == 0) PG8_BAR; }
    PG8_BAR;
    if constexpr (Epi::AFTER_DRAIN) { E.fused(acc, cur, wr, wc, fr, fq, lds, wid, lane); S.done(cur); }
#undef PG8_SA
#undef PG8_SB
#undef PG8_STAGE
#undef PG8_LDA
#undef PG8_LDB
#undef PG8_MMA
#undef PG8_WAIT_V
#undef PG8_WAIT_L
#undef PG8_BAR
#undef PG8_SCHED
}
}
#define GAS __attribute__((address_space(1)))
#define LAS __attribute__((address_space(3)))
typedef unsigned short bf16;
typedef unsigned v4u __attribute__((ext_vector_type(4)));
typedef float f32x4 __attribute__((ext_vector_type(4)));
typedef short bf16x8 __attribute__((ext_vector_type(8)));
typedef GAS unsigned gu32;
typedef GAS unsigned long long gu64;
#define RLX_AGENT __ATOMIC_RELAXED, __HIP_MEMORY_SCOPE_AGENT
#define LDS_WAIT() asm volatile("s_waitcnt lgkmcnt(0)" ::: "memory")
#define VM_WAIT() asm volatile("s_waitcnt vmcnt(0)" ::: "memory")
__device__ __forceinline__ unsigned long long rt() { return __builtin_amdgcn_s_memrealtime(); }
__device__ __forceinline__ unsigned f2bf(float f) { unsigned u = __builtin_bit_cast(unsigned, f); return (u + 0x7fffu + ((u >> 16) & 1u)) >> 16; }
__device__ __forceinline__ unsigned pk2(float lo, float hi) { return f2bf(lo) | (f2bf(hi) << 16); }

#define XB_TMO      128
#define XB_XCNT(j)  (256  + 64 * (j))
#define XB_XSUB(j)  (1280 + 64 * (j))
#define XB_XGEN(j)  (2304 + 64 * (j))
#define XB_TOP      3328
#define XB_TOPGEN   3392
#define XCD_BAR_WORDS 3456
#define XB_SPIN_CAP (1u << 18)

__device__ __forceinline__ unsigned xb_ld(unsigned* p)              { return __hip_atomic_load(p, __ATOMIC_RELAXED, __HIP_MEMORY_SCOPE_AGENT); }
__device__ __forceinline__ unsigned xb_add(unsigned* p, unsigned v) { return __hip_atomic_fetch_add(p, v, __ATOMIC_RELAXED, __HIP_MEMORY_SCOPE_AGENT); }
__device__ __forceinline__ unsigned xb_xcc_id() { return (unsigned)__builtin_amdgcn_s_getreg((3 << 11) | 20) & 0xFu; }
#define XB_SPIN(cond, bar) do { unsigned _sp = 0; while (cond) { __builtin_amdgcn_s_sleep(1); \
    if ((++_sp & 255u) == 0u) { if (xb_ld(&(bar)[XB_TMO])) break; if (_sp > XB_SPIN_CAP) { atomicAdd(&(bar)[XB_TMO], 1u); break; } } } } while (0)

struct XcdBarrier {
    unsigned* bar; unsigned x;
    volatile LAS unsigned* st;
};

__device__ __forceinline__ XcdBarrier xcd_barrier_post(unsigned* bar, volatile LAS unsigned* st) {
    XcdBarrier b; b.bar = bar; b.x = xb_xcc_id(); b.st = st;
    if (threadIdx.x == 0) (void)xb_add(&bar[XB_XCNT(b.x)], 1u);
    return b;
}
__device__ __forceinline__ void xcd_barrier_complete(unsigned* bar, unsigned x, unsigned& nloc, unsigned& nx) {
    const unsigned G = gridDim.x * gridDim.y * gridDim.z;
    unsigned sum, cnt, mine, sp = 0u;
    for (;;) {
        sum = 0u; cnt = 0u; mine = 0u;
#pragma unroll
        for (unsigned j = 0; j < 16; ++j) { const unsigned c = xb_ld(&bar[XB_XCNT(j)]); sum += c; cnt += (c > 0u) ? 1u : 0u; mine = (j == x) ? c : mine; }
        if (sum == G) break;
        __builtin_amdgcn_s_sleep(1);
        if ((++sp & 255u) == 0u) { if (xb_ld(&bar[XB_TMO])) break; if (sp > XB_SPIN_CAP) { atomicAdd(&bar[XB_TMO], 1u); break; } }
    }
    nloc = mine > 0u ? mine : 1u; nx = cnt > 0u ? cnt : 1u;
}

__device__ __forceinline__ void xcd_barrier(const XcdBarrier& b) {
    asm volatile("s_waitcnt vmcnt(0)" ::: "memory");
    __syncthreads();
    if (threadIdx.x == 0) {
        unsigned* bar = b.bar;
        __builtin_amdgcn_s_waitcnt(0);
        unsigned nloc = b.st[0], nx = b.st[1];
        if (nloc == 0u) { xcd_barrier_complete(bar, b.x, nloc, nx); b.st[0] = nloc; b.st[1] = nx; }
        const unsigned old = xb_add(&bar[XB_XSUB(b.x)], 1u);
        const unsigned gen = old / nloc;
        if (old + 1u == (gen + 1u) * nloc) {
            __builtin_amdgcn_fence(__ATOMIC_RELEASE, "agent");
            asm volatile("s_waitcnt vmcnt(0)" ::: "memory");
            const unsigned og = xb_add(&bar[XB_TOP], 1u);
            const unsigned tg = og / nx;
            if (og + 1u == (tg + 1u) * nx) xb_add(&bar[XB_TOPGEN], 1u);
            else XB_SPIN(xb_ld(&bar[XB_TOPGEN]) == tg, bar);
            __builtin_amdgcn_fence(__ATOMIC_ACQUIRE, "agent");
            xb_add(&bar[XB_XGEN(b.x)], 1u);
            asm volatile("s_waitcnt vmcnt(0)" ::: "memory");
        } else {
            XB_SPIN(xb_ld(&bar[XB_XGEN(b.x)]) == gen, bar);
            __builtin_amdgcn_fence(__ATOMIC_ACQUIRE, "agent");
            asm volatile("s_waitcnt vmcnt(0)" ::: "memory");
        }
    }
    __syncthreads();
}
constexpr int NWAVES = 8;
constexpr int D = 1024, BATCH = 8, SEQ = 2048, T = BATCH * SEQ;
constexpr int AW = 512, RW = 512, NH = 8;
constexpr int DL = 64, AL = 64, GL = 128;
constexpr int SHIFTW = 3 * RW + DL + AL + GL;
constexpr int INW = 3 * AW + SHIFTW;
constexpr int NKEYS = 128, PH = 8, PKD = 256, TOPK = 16, HK = PH * TOPK;
constexpr int QW = PH * PKD;
constexpr int MODW = 6 * D;

constexpr size_t MiB = 1u << 20;
constexpr size_t WS_CTL = 0, CTL_ZERO_BYTES = 1 * MiB + 256 * 1024;
constexpr size_t WS_MOD = 1 * MiB;
constexpr size_t WS_KEYS = 1 * MiB + 512 * 1024;
constexpr size_t WS_WIN = 2 * MiB;
constexpr size_t WS_WOUT = 9 * MiB;
constexpr size_t WS_WQ = 11 * MiB;
constexpr size_t WS_XN = 16 * MiB;
constexpr size_t WS_O3 = 16 * MiB;
constexpr size_t WS_LSE = 32 * MiB;
constexpr size_t WS_Z = 48 * MiB;
constexpr size_t WS_MIX = 152 * MiB;
constexpr size_t WS_Y = 184 * MiB;
constexpr size_t WS_Q = 48 * MiB;
constexpr size_t WS_IDX = 112 * MiB;
constexpr size_t WS_GATE = 120 * MiB;
constexpr size_t WS_PART = 48 * MiB;
constexpr size_t WS_XQ = 128 * MiB;
constexpr size_t WS_UT = 216 * MiB;
constexpr size_t WS_SU = 249 * MiB;
constexpr size_t WS_VT = 232 * MiB;
constexpr size_t WS_BON = 248 * MiB;
constexpr size_t WS_END = 250 * MiB;
constexpr int CW_WORK = 1024;
constexpr int CW_WORK2 = 2048;
constexpr int CW_BAR = 4096;
constexpr int MAX_LAUNCHES = 12;

constexpr int RING_OFF = 0, RING_BYTES = 139264;
constexpr int LDSCTL_OFF = RING_BYTES, MISC_OFF = LDSCTL_OFF + 320;
constexpr int LDS_BYTES = 147456;
static_assert(MISC_OFF + 128 <= LDS_BYTES, "LDS map");

typedef GAS float gf32;
typedef GAS f32x4 gf32x4;

__device__ __forceinline__ float bf2f(bf16 v) { return __uint_as_float(((unsigned)v) << 16); }
__device__ __forceinline__ float wave_sum(float v) {
#pragma unroll
    for (int o = 1; o < 64; o <<= 1) v += __shfl_xor(v, o);
    return v;
}
#define WAVE_LDS_SYNC() do { asm volatile("s_waitcnt lgkmcnt(0)" ::: "memory"); __builtin_amdgcn_wave_barrier(); } while (0)

__device__ __forceinline__ void p0_transpose_item(const float* W, int K, int N, bf16* WT, int row_off, LAS float* scr, int item, int lane) {
    const int nblk = N / 32, kb = item / nblk, nb = item % nblk, k0 = 64 * kb, n0 = 32 * nb;
#pragma unroll 8
    for (int i = 0; i < 32; ++i) { const int kk = 2 * i + (lane >> 5); scr[kk * 33 + (lane & 31)] = W[(size_t)(k0 + kk) * N + n0 + (lane & 31)]; }
    LDS_WAIT(); asm volatile("" ::: "memory");
    const int c = lane & 7;
#pragma unroll
    for (int j = 0; j < 4; ++j) { const int n = (lane >> 3) + 8 * j; const LAS float* s = scr + (8 * c) * 33 + n;
        v4u o; o.x = pk2(s[0 * 33], s[1 * 33]); o.y = pk2(s[2 * 33], s[3 * 33]); o.z = pk2(s[4 * 33], s[5 * 33]); o.w = pk2(s[6 * 33], s[7 * 33]);
        *(GAS v4u*)(WT + (size_t)(row_off + n0 + n) * K + k0 + 8 * c) = o; }
    LDS_WAIT(); asm volatile("" ::: "memory");
}

__device__ __forceinline__ void norm_rows(const float* x, const float* g, const float* mod, int shift_off, int scale_off, bf16* o, int gw, int ngw, int lane) {
    f32x4 nx[4];
    if (gw < T) {
#pragma unroll
        for (int j = 0; j < 4; ++j) nx[j] = ((const GAS f32x4*)(x + (size_t)gw * D) + lane)[64 * j]; }
    for (int m = gw; m < T; m += ngw) {
        f32x4 v[4]; float s = 0.f;
#pragma unroll
        for (int j = 0; j < 4; ++j) { v[j] = nx[j]; s += (v[j].x * v[j].x + v[j].y * v[j].y) + (v[j].z * v[j].z + v[j].w * v[j].w); }
        if (m + ngw < T) {
#pragma unroll
            for (int j = 0; j < 4; ++j) nx[j] = ((const GAS f32x4*)(x + (size_t)(m + ngw) * D) + lane)[64 * j]; }
        const float* modb = mod + (m / SEQ) * MODW;
        const float rs = 1.0f / sqrtf(wave_sum(s) * (1.f / D) + 1e-6f);
        GAS unsigned long long* o8 = (GAS unsigned long long*)(o + (size_t)m * D) + lane;
#pragma unroll
        for (int j = 0; j < 4; ++j) {
            const int col = 256 * j + 4 * lane;
            const f32x4 g4 = *(const GAS f32x4*)(g + col), sc = *(const GAS f32x4*)(modb + scale_off + col), sh = *(const GAS f32x4*)(modb + shift_off + col);
            const f32x4 y = v[j] * rs * g4 * (sc + 1.0f) + sh;
            o8[64 * j] = (unsigned long long)pk2(y.x, y.y) | ((unsigned long long)pk2(y.z, y.w) << 32);
        }
    }
}
__device__ __forceinline__ void norm_rows_q(const float* x, const float* g, const float* mod, int shift_off, int scale_off, bf16* o, unsigned char* q, float* qscale, int gw, int ngw, int lane) {
    f32x4 nx[4];
    if (gw < T) {
#pragma unroll
        for (int j = 0; j < 4; ++j) nx[j] = ((const GAS f32x4*)(x + (size_t)gw * D) + lane)[64 * j]; }
    for (int m = gw; m < T; m += ngw) {
        f32x4 v[4]; float s = 0.f;
#pragma unroll
        for (int j = 0; j < 4; ++j) { v[j] = nx[j]; s += (v[j].x * v[j].x + v[j].y * v[j].y) + (v[j].z * v[j].z + v[j].w * v[j].w); }
        if (m + ngw < T) {
#pragma unroll
            for (int j = 0; j < 4; ++j) nx[j] = ((const GAS f32x4*)(x + (size_t)(m + ngw) * D) + lane)[64 * j]; }
        const float* modb = mod + (m / SEQ) * MODW;
        const float rs = 1.0f / sqrtf(wave_sum(s) * (1.f / D) + 1e-6f);
        GAS unsigned long long* o8 = (GAS unsigned long long*)(o + (size_t)m * D) + lane;
        float mx = 0.f;
#pragma unroll
        for (int j = 0; j < 4; ++j) {
            const int col = 256 * j + 4 * lane;
            const f32x4 g4 = *(const GAS f32x4*)(g + col), sc = *(const GAS f32x4*)(modb + scale_off + col), sh = *(const GAS f32x4*)(modb + shift_off + col);
            const f32x4 y = v[j] * rs * g4 * (sc + 1.0f) + sh;
            v[j] = y; mx = fmaxf(mx, fmaxf(fmaxf(fabsf(y.x), fabsf(y.y)), fmaxf(fabsf(y.z), fabsf(y.w))));
            o8[64 * j] = (unsigned long long)pk2(y.x, y.y) | ((unsigned long long)pk2(y.z, y.w) << 32);
        }
#pragma unroll
        for (int oo = 1; oo < 64; oo <<= 1) mx = fmaxf(mx, __shfl_xor(mx, oo));
        mx = fmaxf(mx, 1e-30f);
        const float inv = 127.0f / mx;
#pragma unroll
        for (int j = 0; j < 4; ++j) {
            const int ia = (int)rintf(v[j].x * inv), ib = (int)rintf(v[j].y * inv), ic = (int)rintf(v[j].z * inv), id = (int)rintf(v[j].w * inv);
            *(GAS unsigned*)(q + (size_t)m * D + 256 * j + 4 * lane) = (unsigned)(ia & 0xff) | ((unsigned)(ib & 0xff) << 8) | ((unsigned)(ic & 0xff) << 16) | ((unsigned)id << 24);
        }
        if (lane == 0) qscale[m] = mx * (1.0f / 127.0f);
    }
}

struct EpiRes {
    static constexpr bool PERM = false, AFTER_DRAIN = false;
    const float* xres; const float* mod; int gate_off; float* out; int ldc;
    __device__ __forceinline__ void operator()(const pg8::f32x4 (&acc)[2][2][4][2], const pg8::Unit& u, int wr, int wc, int fr, int fq) const {
        const int col0 = u.pn * pg8::BM + wc * 32 + 4 * fq;
        const int b = (u.pm * pg8::BM) / SEQ;
        pg8::f32x4 gv[2][2];
#pragma unroll
        for (int bj = 0; bj < 2; ++bj)
#pragma unroll
            for (int n = 0; n < 2; ++n) gv[bj][n] = *(const pg8::f32x4*)(mod + b * MODW + gate_off + col0 + bj * pg8::HALF + n * 16);
#pragma unroll
        for (int ai = 0; ai < 2; ++ai)
#pragma unroll
            for (int m = 0; m < 4; ++m) { const size_t off = (size_t)(u.pm * pg8::BM + ai * pg8::HALF + wr * 64 + m * 16 + fr) * ldc + col0;
#pragma unroll
                for (int bj = 0; bj < 2; ++bj)
#pragma unroll
                    for (int n = 0; n < 2; ++n) { const pg8::f32x4 bs = *(const pg8::f32x4*)(xres + off + bj * pg8::HALF + n * 16);
                        *(pg8::f32x4*)(out + off + bj * pg8::HALF + n * 16) = bs + gv[bj][n] * acc[ai][bj][m][n]; } }
    }
};

namespace scan {
typedef unsigned u32x2 __attribute__((ext_vector_type(2)));
constexpr int SLOT = 1024, BUF_BYTES = 12800, NBUF = 8;
constexpr int OFF_LORA = NBUF * BUF_BYTES;
constexpr int OFF_CONST = OFF_LORA + 16 * SLOT;
constexpr int OFF_MT = OFF_CONST + 5120;
constexpr int SCAN_LDS = OFF_MT + 8 * 1024;
static_assert(SCAN_LDS <= 139264, "scan LDS map");
constexpr int S_KK = 0, S_R = 2, S_MT = 4, S_N = 5, S_BK = 6, S_V = 10, S_GC = 12;

typedef float f32x2n __attribute__((ext_vector_type(2)));
typedef __bf16 bf16x2n __attribute__((ext_vector_type(2)));
__device__ __forceinline__ unsigned cvtpk(float lo, float hi) { const f32x2n v = {lo, hi}; const bf16x2n b = __builtin_convertvector(v, bf16x2n); return __builtin_bit_cast(unsigned, b); }
__device__ __forceinline__ bf16x8 mkfrag(unsigned a, unsigned b, unsigned c, unsigned d) { v4u w; w.x = a; w.y = b; w.z = c; w.w = d; return __builtin_bit_cast(bf16x8, w); }
__device__ __forceinline__ bf16x8 frag8(const float (&lo)[4], const float (&hi)[4]) { return mkfrag(cvtpk(lo[0], lo[1]), cvtpk(lo[2], lo[3]), cvtpk(hi[0], hi[1]), cvtpk(hi[2], hi[3])); }
__device__ __forceinline__ f32x4 mma(bf16x8 a, bf16x8 b, f32x4 c) { return __builtin_amdgcn_mfma_f32_16x16x32_bf16(a, b, c, 0, 0, 0); }
template <int N> __device__ __forceinline__ float row_shr(float x) { return __int_as_float(__builtin_amdgcn_update_dpp(0, __float_as_int(x), 0x110 + N, 0xf, 0xf, true)); }
__device__ __forceinline__ float fsigmoid(float x) { return __builtin_amdgcn_rcpf(1.0f + __expf(-x)); }
__device__ __forceinline__ bf16 tobf(float x) { return (bf16)(cvtpk(x, x) & 0xffffu); }

__device__ __forceinline__ void setup(LAS unsigned char* L, int h, int dir, const float* mu_prev, const float* mu_next, const float* w_decay0, const float* w_decay_up,
                                      const float* a_gate0, const float* a_gate_up, const float* k_k, const float* k_a, const float* r_k, int tid) {
    LAS float* C = (LAS float*)(L + OFF_CONST);
    for (int i = tid; i < 320; i += 512) {
        const int grp = i >> 6, c = i & 63;
        const int col = (grp < 3) ? grp * RW + h * 64 + c : 3 * RW + (grp - 3) * 64 + c;
        C[i] = mu_prev[col]; C[320 + i] = mu_next[col]; C[960 + i] = 1.0f - mu_prev[col] - mu_next[col];
    }
    if (tid < 64) { const int hc = h * 64 + tid; C[640 + tid] = w_decay0[dir * RW + hc]; C[704 + tid] = a_gate0[dir * RW + hc]; C[768 + tid] = k_k[hc]; C[832 + tid] = k_a[hc]; C[896 + tid] = r_k[hc]; }
    LAS bf16* F = (LAS bf16*)(L + OFF_LORA);
    for (int i = tid; i < 16 * 64 * 8; i += 512) {
        const int j = i & 7, l = (i >> 3) & 63, sl = i >> 9, m = sl & 1, ct = (sl >> 1) & 3, wa = sl >> 3;
        const int g = l >> 4, jj = 32 * m + (j < 4 ? 4 * g + j : 16 + 4 * g + j - 4), c = h * 64 + 16 * ct + (l & 15);
        const float v = wa ? a_gate_up[(size_t)(dir * AL + jj) * RW + c] : w_decay_up[(size_t)(dir * DL + jj) * RW + c];
        F[i] = (bf16)f2bf(v);
    }
}

__device__ __forceinline__ void helper_chunk(LAS unsigned char* L, LAS unsigned char* buf, LAS float* MT, const bf16* Z, float* BON, int b, int h, int dir, int n, int lane) {
    const int s = lane & 15, g = lane >> 4;
    const int cn = dir ? (SEQ / 16 - 1 - n) : n;
    const int t = cn * 16 + (dir ? 15 - s : s), tok = b * SEQ + t;
    const LAS float* C = (const LAS float*)(L + OFF_CONST);
    const bool hasp = t > 0, hasn = t < SEQ - 1;
    float rv[4][4], kv[4][4], vv[4][4], tw[4][4], xa[4][4];
    constexpr int SROW = 136, SGRP = 18 * SROW;
    {
        v4u ld[12];
#pragma unroll
        for (int i = 0; i < 12; ++i) {
            int p = 8 * i + (lane >> 3); p = p < 90 ? p : 89;
            const int grp = p / 18, row = p - 18 * grp;
            const int st = (row < 16) ? row : (row == 16 ? -1 : 16);
            int tt = cn * 16 + (dir ? 15 - st : st); tt = tt < 0 ? 0 : (tt > SEQ - 1 ? SEQ - 1 : tt);
            const int cbase = (grp < 3) ? grp * RW + h * 64 : 3 * RW + (grp - 3) * 64;
            ld[i] = *(const v4u*)(Z + (size_t)(b * SEQ + tt) * INW + 3 * AW + cbase + 8 * (lane & 7));
        }
#pragma unroll
        for (int i = 0; i < 12; ++i) {
            int p = 8 * i + (lane >> 3); p = p < 90 ? p : 89;
            const int grp = p / 18, row = p - 18 * grp;
            LAS unsigned char* q = buf + grp * SGRP + row * SROW + 16 * (lane & 7);
            *(LAS u32x2*)q = (u32x2){ld[i].x, ld[i].y}; *(LAS u32x2*)(q + 8) = (u32x2){ld[i].z, ld[i].w};
        }
    }
    asm volatile("s_waitcnt lgkmcnt(0)" ::: "memory"); __builtin_amdgcn_wave_barrier();
    {
        const int rlo = (s == 0) ? 16 : s - 1, rup = (s == 15) ? 17 : s + 1;
        const int rp = dir ? rup : rlo, rn = dir ? rlo : rup;
        typedef float f32x2s __attribute__((ext_vector_type(2)));
        const unsigned pmask = hasp ? 0xffffffffu : 0u, nmask = hasn ? 0xffffffffu : 0u;
#pragma unroll
        for (int grp = 0; grp < 5; ++grp) {
#pragma unroll
            for (int ct = 0; ct < 4; ++ct) {
                const LAS unsigned char* q = buf + grp * SGRP + 32 * ct + 8 * g;
                const u32x2 zcc = *(const LAS u32x2*)(q + s * SROW);
                u32x2 zp = *(const LAS u32x2*)(q + rp * SROW), zn = *(const LAS u32x2*)(q + rn * SROW);
                zp.x &= pmask; zp.y &= pmask; zn.x &= nmask; zn.y &= nmask;
                const f32x4 mp = *(const LAS f32x4*)(C + grp * 64 + 16 * ct + 4 * g), mn = *(const LAS f32x4*)(C + 320 + grp * 64 + 16 * ct + 4 * g), mc = *(const LAS f32x4*)(C + 960 + grp * 64 + 16 * ct + 4 * g);
                const f32x2s z01 = {__uint_as_float(zcc.x << 16), __uint_as_float(zcc.x & 0xffff0000u)}, z23 = {__uint_as_float(zcc.y << 16), __uint_as_float(zcc.y & 0xffff0000u)};
                const f32x2s p01 = {__uint_as_float(zp.x << 16), __uint_as_float(zp.x & 0xffff0000u)}, p23 = {__uint_as_float(zp.y << 16), __uint_as_float(zp.y & 0xffff0000u)};
                const f32x2s n01 = {__uint_as_float(zn.x << 16), __uint_as_float(zn.x & 0xffff0000u)}, n23 = {__uint_as_float(zn.y << 16), __uint_as_float(zn.y & 0xffff0000u)};
                const f32x2s o01 = (f32x2s){mc[0], mc[1]} * z01 + (f32x2s){mp[0], mp[1]} * p01 + (f32x2s){mn[0], mn[1]} * n01;
                const f32x2s o23 = (f32x2s){mc[2], mc[3]} * z23 + (f32x2s){mp[2], mp[3]} * p23 + (f32x2s){mn[2], mn[3]} * n23;
                const float ov[4] = {o01.x, o01.y, o23.x, o23.y};
#pragma unroll
                for (int r = 0; r < 4; ++r) {
                    const float o = ov[r];
                    if (grp == 0) rv[ct][r] = o; else if (grp == 1) kv[ct][r] = o; else if (grp == 2) vv[ct][r] = o;
                    else if (grp == 3) { const float e2 = __expf(2.0f * o); tw[ct][r] = 1.0f - 2.0f * __builtin_amdgcn_rcpf(e2 + 1.0f); } else xa[ct][r] = o;
                }
            }
            __builtin_amdgcn_sched_barrier(0);
        }
    }
    asm volatile("s_waitcnt lgkmcnt(0)" ::: "memory"); __builtin_amdgcn_wave_barrier();
#pragma unroll
    for (int ct = 0; ct < 4; ++ct)
#pragma unroll
        for (int r = 0; r < 4; ++r)
            *(LAS bf16*)(buf + (S_V + (ct >> 1)) * SLOT + (4 * g + r + 16 * (s >> 2)) * 16 + (ct & 1) * 8 + 2 * (s & 3)) = tobf(vv[ct][r]);
    f32x4 accw[4], acca[4];
    { const bf16x8 tb0 = frag8(tw[0], tw[1]), tb1 = frag8(tw[2], tw[3]), xb0 = frag8(xa[0], xa[1]), xb1 = frag8(xa[2], xa[3]);
      const LAS bf16x8* F = (const LAS bf16x8*)(L + OFF_LORA);
#pragma unroll
      for (int ct = 0; ct < 4; ++ct) {
          f32x4 z4 = {0.f, 0.f, 0.f, 0.f};
          accw[ct] = mma(F[(0 * 8 + ct * 2 + 0) * 64 + lane], tb0, z4); accw[ct] = mma(F[(0 * 8 + ct * 2 + 1) * 64 + lane], tb1, accw[ct]);
          acca[ct] = mma(F[(1 * 8 + ct * 2 + 0) * 64 + lane], xb0, z4); acca[ct] = mma(F[(1 * 8 + ct * 2 + 1) * 64 + lane], xb1, acca[ct]);
      } }
    float ev[4][4], kk[4][4], kd[4][4], bb[4][4];
    float ss = 0.f, bon = 0.f;
#pragma unroll
    for (int ct = 0; ct < 4; ++ct) {
        const f32x4 w0 = *(const LAS f32x4*)(C + 640 + 16 * ct + 4 * g), a0 = *(const LAS f32x4*)(C + 704 + 16 * ct + 4 * g), kkw = *(const LAS f32x4*)(C + 768 + 16 * ct + 4 * g),
                    kaw = *(const LAS f32x4*)(C + 832 + 16 * ct + 4 * g), rkw = *(const LAS f32x4*)(C + 896 + 16 * ct + 4 * g);
#pragma unroll
        for (int r = 0; r < 4; ++r) {
            ev[ct][r] = 0.60653065971f * fsigmoid(accw[ct][r] + w0[r]);
            const float a = fsigmoid(acca[ct][r] + a0[r]);
            const float k = kv[ct][r];
            kk[ct][r] = k * kkw[r]; ss += kk[ct][r] * kk[ct][r];
            kd[ct][r] = k * (1.0f + (a - 1.0f) * kaw[r]);
            bb[ct][r] = a;
            bon += rv[ct][r] * k * a * kaw[r] * rkw[r];
        }
        __builtin_amdgcn_sched_barrier(0);
    }
    ss += __shfl_xor(ss, 16); ss += __shfl_xor(ss, 32);
    bon += __shfl_xor(bon, 16); bon += __shfl_xor(bon, 32);
    if (g == 0) BON[((size_t)dir * T + tok) * NH + h] = bon;
    const float rn = __builtin_amdgcn_rsqf(fmaxf(ss, 1e-12f));
    bf16x8 fKKm[2], fRm[2], fBm[2], fKm[2];
#pragma unroll
    for (int m = 0; m < 2; ++m) {
        float KKs[2][4], Rs[2][4], Bt[2][4], Kt[2][4];
#pragma unroll
        for (int c2 = 0; c2 < 2; ++c2) {
            const int ct = 2 * m + c2;
            float gcv[4];
#pragma unroll
            for (int r = 0; r < 4; ++r) {
                const float e = ev[ct][r];
                float cum = e;
                cum += row_shr<1>(cum); cum += row_shr<2>(cum); cum += row_shr<4>(cum); cum += row_shr<8>(cum);
                const float cumC = __shfl(cum, (lane & 48) | 15);
                const float kkn = kk[ct][r] * rn, bv = kkn * bb[ct][r];
                const float ig = __expf(cum), gs = __builtin_amdgcn_rcpf(ig), gC = __expf(-cumC), rat = ig * gC;
                KKs[c2][r] = kkn * gs * __expf(e); Rs[c2][r] = rv[ct][r] * gs;
                Bt[c2][r] = bv * ig; Kt[c2][r] = kd[ct][r] * ig;
                gcv[r] = gC;
                LAS unsigned char* q = buf + (S_BK + ct) * SLOT + (4 * g + r + 16 * (s >> 2)) * 16 + 2 * (s & 3);
                *(LAS bf16*)q = tobf(bv * rat); *(LAS bf16*)(q + 8) = tobf(kd[ct][r] * rat);
            }
            if (s == 15) *(LAS f32x4*)(buf + S_GC * SLOT + (16 * ct + 4 * g) * 4) = (f32x4){gcv[0], gcv[1], gcv[2], gcv[3]};
        }
        fKKm[m] = frag8(KKs[0], KKs[1]); fRm[m] = frag8(Rs[0], Rs[1]); fBm[m] = frag8(Bt[0], Bt[1]); fKm[m] = frag8(Kt[0], Kt[1]);
    }
    const bf16x8 fKK0 = fKKm[0], fKK1 = fKKm[1], fR0 = fRm[0], fR1 = fRm[1], fB0 = fBm[0], fB1 = fBm[1], fK0 = fKm[0], fK1 = fKm[1];
    *(LAS bf16x8*)(buf + (S_KK + 0) * SLOT + lane * 16) = fKK0; *(LAS bf16x8*)(buf + (S_KK + 1) * SLOT + lane * 16) = fKK1;
    *(LAS bf16x8*)(buf + (S_R + 0) * SLOT + lane * 16) = fR0;  *(LAS bf16x8*)(buf + (S_R + 1) * SLOT + lane * 16) = fR1;
    const f32x4 z4 = {0.f, 0.f, 0.f, 0.f};
    { f32x4 mab = mma(fKK0, fB0, z4); mab = mma(fKK1, fB1, mab);
      *(LAS f32x4*)(MT + s * 16 + 4 * g) = mab; }
    f32x4 mak = mma(fK0, fKK0, z4); mak = mma(fK1, fKK1, mak);
    f32x4 nrb = mma(fB0, fR0, z4); nrb = mma(fB1, fR1, nrb);
    f32x4 nrk = mma(fK0, fR0, z4); nrk = mma(fK1, fR1, nrk);
#pragma unroll
    for (int r = 0; r < 4; ++r) { const int i = 4 * g + r; if (!(i < s)) mak[r] = 0.f; if (!(i <= s)) { nrb[r] = 0.f; nrk[r] = 0.f; } }
    *(LAS v4u*)(buf + S_N * SLOT + lane * 16) = (v4u){cvtpk(nrb[0], nrb[1]), cvtpk(nrb[2], nrb[3]), cvtpk(nrk[0], nrk[1]), cvtpk(nrk[2], nrk[3])};
    asm volatile("s_waitcnt lgkmcnt(0)" ::: "memory"); __builtin_amdgcn_wave_barrier();
    float Tr[16];
#pragma unroll
    for (int j = 15; j >= 0; --j) {
        float acc0 = 0.f, acc1 = 0.f;
#pragma unroll
        for (int i4 = (j + 1) / 4; i4 < 4; ++i4) {
            const f32x4 mrow = *(const LAS f32x4*)(MT + j * 16 + 4 * i4);
#pragma unroll
            for (int e = 0; e < 4; ++e) { const int i = 4 * i4 + e; if (i > j) { if (e & 1) acc1 += Tr[i] * mrow[e]; else acc0 += Tr[i] * mrow[e]; } }
        }
        Tr[j] = (j == s) ? 1.0f : -(acc0 + acc1);
        if (j > s) Tr[j] = 0.f;
    }
    float t0 = 0.f, t1 = 0.f, t2 = 0.f, t3 = 0.f;
#pragma unroll
    for (int gg = 0; gg < 4; ++gg) if (g == gg) { t0 = Tr[4 * gg]; t1 = Tr[4 * gg + 1]; t2 = Tr[4 * gg + 2]; t3 = Tr[4 * gg + 3]; }
    *(LAS v4u*)(buf + S_MT * SLOT + lane * 16) = (v4u){cvtpk(mak[0], mak[1]), cvtpk(mak[2], mak[3]), cvtpk(-t0, -t1), cvtpk(-t2, -t3)};
    asm volatile("s_waitcnt lgkmcnt(0)" ::: "memory"); __builtin_amdgcn_wave_barrier();
}

__device__ __forceinline__ void rec_chunk(const LAS unsigned char* buf, f32x4 (&st)[4], bf16* Y, int b, int h, int dir, int n, int w, int lane) {
    const int g = lane >> 4, col = lane & 15;
    const bf16x8 fKK0 = *(const LAS bf16x8*)(buf + (S_KK + 0) * SLOT + lane * 16), fKK1 = *(const LAS bf16x8*)(buf + (S_KK + 1) * SLOT + lane * 16);
    const bf16x8 fR0 = *(const LAS bf16x8*)(buf + (S_R + 0) * SLOT + lane * 16), fR1 = *(const LAS bf16x8*)(buf + (S_R + 1) * SLOT + lane * 16);
    const v4u mt = *(const LAS v4u*)(buf + S_MT * SLOT + lane * 16);
    const bf16x8 fN = *(const LAS bf16x8*)(buf + S_N * SLOT + lane * 16);
    const u32x2 vf = *(const LAS u32x2*)(buf + (S_V + (w >> 1)) * SLOT + lane * 16 + (w & 1) * 8);
    const f32x4 z4 = {0.f, 0.f, 0.f, 0.f};
    const bf16x8 sb0 = mkfrag(cvtpk(st[0][0], st[0][1]), cvtpk(st[0][2], st[0][3]), cvtpk(st[1][0], st[1][1]), cvtpk(st[1][2], st[1][3]));
    const bf16x8 sb1 = mkfrag(cvtpk(st[2][0], st[2][1]), cvtpk(st[2][2], st[2][3]), cvtpk(st[3][0], st[3][1]), cvtpk(st[3][2], st[3][3]));
    f32x4 p1 = mma(fKK0, sb0, z4); p1 = mma(fKK1, sb1, p1);
    f32x4 p2 = mma(fR0, sb0, z4); p2 = mma(fR1, sb1, p2);
    const f32x4 x = mma(mkfrag(0u, 0u, mt.x, mt.y), mkfrag(0u, 0u, vf.x, vf.y), p1);
    const f32x4 u = mma(mkfrag(mt.z, mt.w, 0u, 0u), mkfrag(cvtpk(x[0], x[1]), cvtpk(x[2], x[3]), 0u, 0u), z4);
    const bf16x8 buv = mkfrag(cvtpk(u[0], u[1]), cvtpk(u[2], u[3]), vf.x, vf.y);
    const f32x4 y = mma(fN, buv, p2);
#pragma unroll
    for (int i = 0; i < 4; ++i) {
        const f32x4 gc = *(const LAS f32x4*)(buf + S_GC * SLOT + (16 * i + 4 * g) * 4);
        const bf16x8 fBK = *(const LAS bf16x8*)(buf + (S_BK + i) * SLOT + lane * 16);
        st[i] = mma(fBK, buv, st[i] * gc);
    }
    const int cn = dir ? (SEQ / 16 - 1 - n) : n;
#pragma unroll
    for (int r = 0; r < 4; ++r) { const int s = 4 * g + r, t = cn * 16 + (dir ? 15 - s : s);
        Y[((size_t)dir * T + (size_t)(b * SEQ + t)) * RW + h * 64 + 16 * w + col] = tobf(y[r]); }
}

__device__ __forceinline__ void chain(LAS unsigned char* L, const bf16* Z, const float* mu_prev, const float* mu_next, const float* w_decay0, const float* w_decay_up,
                                      const float* a_gate0, const float* a_gate_up, const float* k_k, const float* k_a, const float* r_k, bf16* Y, float* BON, int ch, int tid, int wave, int lane) {
    const int dir = ch & 1, h = (ch >> 1) & 7, b = ch >> 4;
    __syncthreads();
    setup(L, h, dir, mu_prev, mu_next, w_decay0, w_decay_up, a_gate0, a_gate_up, k_k, k_a, r_k, tid);
    __syncthreads();
    f32x4 st[4];
#pragma unroll
    for (int i = 0; i < 4; ++i) st[i] = (f32x4){0.f, 0.f, 0.f, 0.f};
    constexpr int NCH = SEQ / 16, NR = NCH / 8;
    for (int q = 0; q < NR; ++q) {
        helper_chunk(L, L + wave * BUF_BYTES, (LAS float*)(L + OFF_MT + wave * 1024), Z, BON, b, h, dir, 8 * q + wave, lane);
        __syncthreads();
        if (wave < 4) {
#pragma unroll 4
            for (int i = 0; i < 8; ++i) rec_chunk(L + i * BUF_BYTES, st, Y, b, h, dir, 8 * q + i, wave, lane);
        }
        __syncthreads();
    }
}
}

namespace attn {
typedef unsigned u32x2 __attribute__((ext_vector_type(2)));
constexpr int VT_STRIDE = 136;
constexpr int KF_OFF = 64 * VT_STRIDE;
constexpr int WAVE_LDS = KF_OFF + 8 * 1024;
constexpr float LOG2E = 1.44269504088896f, LN2 = 0.693147180559945f;
using scan::cvtpk; using scan::mkfrag; using scan::mma;

__device__ __forceinline__ void unpack8(const v4u w, float (&f)[8]) {
    f[0] = __uint_as_float(w.x << 16); f[1] = __uint_as_float(w.x & 0xffff0000u); f[2] = __uint_as_float(w.y << 16); f[3] = __uint_as_float(w.y & 0xffff0000u);
    f[4] = __uint_as_float(w.z << 16); f[5] = __uint_as_float(w.z & 0xffff0000u); f[6] = __uint_as_float(w.w << 16); f[7] = __uint_as_float(w.w & 0xffff0000u);
}

__device__ __forceinline__ void unit(LAS unsigned char* vt, const bf16* Z, const float* qg, const float* kg, bf16* Ob, int opitch, float* lse_out,
                                     int b, int h, int d, int r, int qb, int nb, int lane) {
    const int g = lane >> 4, c16 = lane & 15;
    const float slope2 = exp2f(-(float)(h + 1)) * LOG2E * (float)d;
    float gn[16];
#pragma unroll
    for (int m = 0; m < 2; ++m)
#pragma unroll
        for (int j = 0; j < 8; ++j) gn[m * 8 + j] = qg[32 * m + 8 * g + j] * kg[32 * m + 8 * g + j];
    bf16x8 qf[4][2];
#pragma unroll
    for (int qt = 0; qt < 4; ++qt) {
        const int tok = b * SEQ + (qb * 64 + 16 * qt + c16) * d + r;
        const bf16* qp = Z + (size_t)tok * INW + h * 64 + 8 * g;
        float f0[8], f1[8]; unpack8(*(const v4u*)qp, f0); unpack8(*(const v4u*)(qp + 32), f1);
        float ss = 0.f;
#pragma unroll
        for (int j = 0; j < 8; ++j) ss += f0[j] * f0[j] + f1[j] * f1[j];
        ss += __shfl_xor(ss, 16); ss += __shfl_xor(ss, 32);
        const float rs = (0.125f * LOG2E) / sqrtf(ss * (1.f / 64.f) + 1e-6f);
        qf[qt][0] = mkfrag(cvtpk(f0[0] * rs * gn[0], f0[1] * rs * gn[1]), cvtpk(f0[2] * rs * gn[2], f0[3] * rs * gn[3]), cvtpk(f0[4] * rs * gn[4], f0[5] * rs * gn[5]), cvtpk(f0[6] * rs * gn[6], f0[7] * rs * gn[7]));
        qf[qt][1] = mkfrag(cvtpk(f1[0] * rs * gn[8], f1[1] * rs * gn[9]), cvtpk(f1[2] * rs * gn[10], f1[3] * rs * gn[11]), cvtpk(f1[4] * rs * gn[12], f1[5] * rs * gn[13]), cvtpk(f1[6] * rs * gn[14], f1[7] * rs * gn[15]));
    }
    f32x4 oacc[4][4];
    float mrun[4], lrun[4];
#pragma unroll
    for (int qt = 0; qt < 4; ++qt) { mrun[qt] = -1e30f; lrun[qt] = 0.f;
#pragma unroll
        for (int dt = 0; dt < 4; ++dt) oacc[dt][qt] = (f32x4){0.f, 0.f, 0.f, 0.f}; }
    const f32x4 z4 = {0.f, 0.f, 0.f, 0.f};
#pragma unroll 1
    for (int kb = qb - 1; kb <= qb + 1; ++kb) {
        if (kb < 0 || kb >= nb) continue;
#pragma unroll
        for (int kblk = 0; kblk < 4; ++kblk) {
            const int tok = b * SEQ + (kb * 64 + 16 * kblk + c16) * d + r;
            const bf16* kp = Z + (size_t)tok * INW + AW + h * 64 + 8 * g;
            float f0[8], f1[8]; unpack8(*(const v4u*)kp, f0); unpack8(*(const v4u*)(kp + 32), f1);
            float ss = 0.f;
#pragma unroll
            for (int j = 0; j < 8; ++j) ss += f0[j] * f0[j] + f1[j] * f1[j];
            ss += __shfl_xor(ss, 16); ss += __shfl_xor(ss, 32);
            const float rsk = 1.0f / sqrtf(ss * (1.f / 64.f) + 1e-6f);
            *(LAS v4u*)(vt + KF_OFF + (kblk * 2 + 0) * 1024 + lane * 16) = (v4u){cvtpk(f0[0] * rsk, f0[1] * rsk), cvtpk(f0[2] * rsk, f0[3] * rsk), cvtpk(f0[4] * rsk, f0[5] * rsk), cvtpk(f0[6] * rsk, f0[7] * rsk)};
            *(LAS v4u*)(vt + KF_OFF + (kblk * 2 + 1) * 1024 + lane * 16) = (v4u){cvtpk(f1[0] * rsk, f1[1] * rsk), cvtpk(f1[2] * rsk, f1[3] * rsk), cvtpk(f1[4] * rsk, f1[5] * rsk), cvtpk(f1[6] * rsk, f1[7] * rsk)};
        }
#pragma unroll
        for (int i = 0; i < 8; ++i) {
            const int key = 8 * i + (lane >> 3), chunk = lane & 7;
            const int tok = b * SEQ + (kb * 64 + key) * d + r;
            const v4u w = *(const v4u*)(Z + (size_t)tok * INW + 2 * AW + h * 64 + 8 * chunk);
            LAS unsigned char* q = vt + (8 * chunk) * VT_STRIDE + 2 * key;
            *(LAS bf16*)(q + 0 * VT_STRIDE) = (bf16)(w.x & 0xffffu); *(LAS bf16*)(q + 1 * VT_STRIDE) = (bf16)(w.x >> 16);
            *(LAS bf16*)(q + 2 * VT_STRIDE) = (bf16)(w.y & 0xffffu); *(LAS bf16*)(q + 3 * VT_STRIDE) = (bf16)(w.y >> 16);
            *(LAS bf16*)(q + 4 * VT_STRIDE) = (bf16)(w.z & 0xffffu); *(LAS bf16*)(q + 5 * VT_STRIDE) = (bf16)(w.z >> 16);
            *(LAS bf16*)(q + 6 * VT_STRIDE) = (bf16)(w.w & 0xffffu); *(LAS bf16*)(q + 7 * VT_STRIDE) = (bf16)(w.w >> 16);
        }
        asm volatile("s_waitcnt lgkmcnt(0)" ::: "memory"); __builtin_amdgcn_wave_barrier();
        const int obase = (kb - qb) * 64;
#pragma unroll
        for (int qt = 0; qt < 4; ++qt) {
            f32x4 sa[4];
#pragma unroll
            for (int kblk = 0; kblk < 4; ++kblk) {
                const bf16x8 k0 = *(const LAS bf16x8*)(vt + KF_OFF + (kblk * 2 + 0) * 1024 + lane * 16), k1 = *(const LAS bf16x8*)(vt + KF_OFF + (kblk * 2 + 1) * 1024 + lane * 16);
                sa[kblk] = mma(k0, qf[qt][0], z4); sa[kblk] = mma(k1, qf[qt][1], sa[kblk]); }
            const int qi = 16 * qt + c16;
            float mx = -1e30f;
#pragma unroll
            for (int kblk = 0; kblk < 4; ++kblk)
#pragma unroll
                for (int reg = 0; reg < 4; ++reg) {
                    const int o = obase + 16 * kblk + 4 * g + reg - qi, ao = o < 0 ? -o : o;
                    float sv = sa[kblk][reg] - slope2 * (float)ao;
                    sv = (ao <= 64) ? sv : -1e30f;
                    sa[kblk][reg] = sv; mx = fmaxf(mx, sv);
                }
            mx = fmaxf(mx, __shfl_xor(mx, 16)); mx = fmaxf(mx, __shfl_xor(mx, 32));
            const float mn = fmaxf(mrun[qt], mx), alpha = exp2f(mrun[qt] - mn);
            mrun[qt] = mn;
            float ls = 0.f;
#pragma unroll
            for (int kblk = 0; kblk < 4; ++kblk)
#pragma unroll
                for (int reg = 0; reg < 4; ++reg) { const float p = exp2f(sa[kblk][reg] - mn); sa[kblk][reg] = p; ls += p; }
            lrun[qt] = lrun[qt] * alpha + ls;
            const bf16x8 pf0 = mkfrag(cvtpk(sa[0][0], sa[0][1]), cvtpk(sa[0][2], sa[0][3]), cvtpk(sa[1][0], sa[1][1]), cvtpk(sa[1][2], sa[1][3]));
            const bf16x8 pf1 = mkfrag(cvtpk(sa[2][0], sa[2][1]), cvtpk(sa[2][2], sa[2][3]), cvtpk(sa[3][0], sa[3][1]), cvtpk(sa[3][2], sa[3][3]));
#pragma unroll
            for (int dt = 0; dt < 4; ++dt) {
                const LAS unsigned char* vr = vt + (16 * dt + c16) * VT_STRIDE + 8 * g;
                const u32x2 a0 = *(const LAS u32x2*)(vr), a1 = *(const LAS u32x2*)(vr + 32), a2 = *(const LAS u32x2*)(vr + 64), a3 = *(const LAS u32x2*)(vr + 96);
                f32x4 oc = oacc[dt][qt] * alpha;
                oc = mma(mkfrag(a0.x, a0.y, a1.x, a1.y), pf0, oc);
                oc = mma(mkfrag(a2.x, a2.y, a3.x, a3.y), pf1, oc);
                oacc[dt][qt] = oc;
            }
            __builtin_amdgcn_sched_barrier(0);
        }
        asm volatile("s_waitcnt lgkmcnt(0)" ::: "memory"); __builtin_amdgcn_wave_barrier();
    }
#pragma unroll
    for (int qt = 0; qt < 4; ++qt) {
        float lt = lrun[qt]; lt += __shfl_xor(lt, 16); lt += __shfl_xor(lt, 32);
        const float inv = 1.0f / lt;
        const int tok = b * SEQ + (qb * 64 + 16 * qt + c16) * d + r;
        bf16* op = Ob + (size_t)tok * opitch + h * 64 + 4 * g;
#pragma unroll
        for (int dt = 0; dt < 4; ++dt) { const f32x4 o = oacc[dt][qt] * inv; u32x2 w; w.x = cvtpk(o[0], o[1]); w.y = cvtpk(o[2], o[3]); *(u32x2*)(op + 16 * dt) = w; }
        if (g == 0) lse_out[(size_t)tok * NH + h] = (mrun[qt] + log2f(lt)) * LN2;
    }
}
}

namespace peer {
using scan::cvtpk; using scan::mkfrag; using scan::mma;
constexpr int KEY_SLOTS = 64;

template <int CTRL> __device__ __forceinline__ unsigned dppu(unsigned x) { return (unsigned)__builtin_amdgcn_update_dpp(0, (int)x, CTRL, 0xf, 0xf, true); }
__device__ __forceinline__ unsigned umax(unsigned a, unsigned b) { return a > b ? a : b; }
__device__ __forceinline__ unsigned rowmax16(unsigned x) { x = umax(x, dppu<0xB1>(x)); x = umax(x, dppu<0x4E>(x)); x = umax(x, dppu<0x141>(x)); x = umax(x, dppu<0x140>(x)); return x; }
__device__ __forceinline__ float rowsum16(float x) {
    x += __uint_as_float(dppu<0xB1>(__float_as_uint(x))); x += __uint_as_float(dppu<0x4E>(__float_as_uint(x)));
    x += __uint_as_float(dppu<0x141>(__float_as_uint(x))); x += __uint_as_float(dppu<0x140>(__float_as_uint(x))); return x;
}
__device__ __forceinline__ unsigned ordkey(float f) { const unsigned u = __float_as_uint(f); return (u & 0x80000000u) ? ~u : (u | 0x80000000u); }
__device__ __forceinline__ float unordkey(unsigned k) { return __uint_as_float((k & 0x80000000u) ? (k ^ 0x80000000u) : ~k); }

__device__ __forceinline__ void setup_keys(LAS unsigned char* L, const float* keys1, const float* keys2, int tid) {
    LAS bf16* F = (LAS bf16*)L;
    for (int i = tid; i < KEY_SLOTS * 64 * 8; i += 512) {
        const int j = i & 7, l = (i >> 3) & 63, sl = i >> 9, ks = sl & 3, nt = (sl >> 2) & 7, sel = sl >> 5;
        const int n = 16 * nt + (l & 15), k = 32 * ks + 8 * (l >> 4) + j;
        F[i] = (bf16)f2bf((sel ? keys2 : keys1)[n * 128 + k]);
    }
}

#define CE_(a, b) do { const unsigned hi_ = umax(a, b), lo_ = (a < b) ? a : b; a = hi_; b = lo_; } while (0)
__device__ __forceinline__ void top16(unsigned (&key)[8][4], unsigned (&win)[4], int c16) {
#pragma unroll
    for (int reg = 0; reg < 4; ++reg) {
        CE_(key[0][reg], key[1][reg]); CE_(key[2][reg], key[3][reg]); CE_(key[4][reg], key[5][reg]); CE_(key[6][reg], key[7][reg]);
        CE_(key[0][reg], key[2][reg]); CE_(key[1][reg], key[3][reg]); CE_(key[4][reg], key[6][reg]); CE_(key[5][reg], key[7][reg]);
        CE_(key[1][reg], key[2][reg]); CE_(key[5][reg], key[6][reg]);
        CE_(key[0][reg], key[4][reg]); CE_(key[1][reg], key[5][reg]); CE_(key[2][reg], key[6][reg]); CE_(key[3][reg], key[7][reg]);
        CE_(key[2][reg], key[4][reg]); CE_(key[3][reg], key[5][reg]);
        CE_(key[1][reg], key[2][reg]); CE_(key[3][reg], key[4][reg]); CE_(key[5][reg], key[6][reg]);
    }
#pragma unroll 1
    for (int k = 0; k < TOPK; ++k) {
#pragma unroll
        for (int reg = 0; reg < 4; ++reg) {
            const unsigned m = rowmax16(key[0][reg]);
            win[reg] = (c16 == k) ? m : win[reg];
            const bool pop = key[0][reg] == m;
#pragma unroll
            for (int nt = 0; nt < 7; ++nt) key[nt][reg] = pop ? key[nt + 1][reg] : key[nt][reg];
            key[7][reg] = pop ? 0u : key[7][reg];
        }
    }
}
#undef CE_

__device__ __forceinline__ void select_batch(const LAS unsigned char* L, const bf16* Q, int* IDX, float* GATE, int batch, int lane) {
    const int g = lane >> 4, c16 = lane & 15;
    const LAS bf16x8* F = (const LAS bf16x8*)L;
    const bf16* qp = Q + (size_t)(batch * 16 + c16) * PKD + 8 * g;
    unsigned w1[4] = {0u, 0u, 0u, 0u}, w2[4] = {0u, 0u, 0u, 0u};
#pragma unroll
    for (int sel = 0; sel < 2; ++sel) {
        unsigned key[8][4];
        bf16x8 a[4];
#pragma unroll
        for (int ks = 0; ks < 4; ++ks) a[ks] = *(const bf16x8*)(qp + sel * 128 + 32 * ks);
#pragma unroll
        for (int nt = 0; nt < 8; ++nt) {
            f32x4 sc = {0.f, 0.f, 0.f, 0.f};
#pragma unroll
            for (int ks = 0; ks < 4; ++ks) sc = mma(a[ks], F[((sel * 8 + nt) * 4 + ks) * 64 + lane], sc);
#pragma unroll
            for (int reg = 0; reg < 4; ++reg) key[nt][reg] = (ordkey(sc[reg]) & ~127u) | (unsigned)(16 * nt + c16);
            __builtin_amdgcn_sched_barrier(0);
        }
        if (sel == 0) top16(key, w1, c16); else top16(key, w2, c16);
    }
    float f1[4], f2[4], cur2[4]; int ptr[4]; unsigned top[4];
#pragma unroll
    for (int reg = 0; reg < 4; ++reg) { f1[reg] = unordkey(w1[reg] & ~127u); f2[reg] = unordkey(w2[reg] & ~127u); ptr[reg] = 0; cur2[reg] = __shfl(f2[reg], lane & 48); top[reg] = 0u; }
#pragma unroll 1
    for (int k = 0; k < TOPK; ++k) {
#pragma unroll
        for (int reg = 0; reg < 4; ++reg) {
            const unsigned ck = (ptr[reg] < 16) ? ((ordkey(f1[reg] + cur2[reg]) & ~255u) | (unsigned)(c16 << 4) | (unsigned)ptr[reg]) : 0u;
            const unsigned m = rowmax16(ck);
            top[reg] = (c16 == k) ? m : top[reg];
            if ((int)((m >> 4) & 15u) == c16) ptr[reg] += 1;
            cur2[reg] = __shfl(f2[reg], (lane & 48) | (ptr[reg] & 15));
        }
    }
#pragma unroll
    for (int reg = 0; reg < 4; ++reg) {
        const int a = (top[reg] >> 4) & 15, bq = top[reg] & 15;
        const int e1 = (int)(__shfl(w1[reg], (lane & 48) | a) & 127u), e2 = (int)(__shfl(w2[reg], (lane & 48) | bq) & 127u);
        const float ts = unordkey(top[reg] & ~255u), mx = __shfl(ts, lane & 48);
        const float ex = __expf(ts - mx), sum = rowsum16(ex);
        const size_t o = (size_t)(batch * 16 + 4 * g + reg) * TOPK + c16;
        IDX[o] = e1 * NKEYS + e2; GATE[o] = ex / sum;
    }
}

__device__ __forceinline__ void convert_table(const float* src, bf16* dst, size_t n8, size_t gtid, size_t gthreads) {
    for (size_t i = gtid; i < n8; i += gthreads) {
        const f32x4 a = *(const f32x4*)(src + i * 8), b = *(const f32x4*)(src + i * 8 + 4);
        v4u o; o.x = cvtpk(a.x, a.y); o.y = cvtpk(a.z, a.w); o.z = cvtpk(b.x, b.y); o.w = cvtpk(b.z, b.w);
        *(v4u*)(dst + i * 8) = o;
    }
}

__device__ __forceinline__ float dot2bf(unsigned w, unsigned x, float acc) {
    typedef __bf16 bf2 __attribute__((ext_vector_type(2)));
    return __builtin_amdgcn_fdot2_f32_bf16(__builtin_bit_cast(bf2, w), __builtin_bit_cast(bf2, x), acc, false);
}
__device__ __forceinline__ float gelu_erf(float v) {
    const float av = fabsf(v), t = __builtin_amdgcn_rcpf(av * 0.2316418882f + 1.0f);
    float q = t * 0.5307027145f + (-0.7265760135f); q = q * t + 0.7107068705f; q = q * t + (-0.142248368f); q = q * t + 0.127414796f; q = q * t;
    const float e = __builtin_amdgcn_exp2f((v * v) * (-0.72134752044f));
    const float m = v * (q * e);
    return v < 0.f ? m : v - m;
}

typedef float f32x2c __attribute__((ext_vector_type(2)));
__device__ __forceinline__ void convert_rows_fp8(const float* src, unsigned char* dst, float* scale, int rows, int gw, int ngw, int lane) {
    for (int rrow = gw; rrow < rows; rrow += ngw) {
        const float* p = src + (size_t)rrow * D + 16 * lane;
        const f32x4 a = *(const f32x4*)p, b = *(const f32x4*)(p + 4), c = *(const f32x4*)(p + 8), d = *(const f32x4*)(p + 12);
        float m = fmaxf(fmaxf(fmaxf(fabsf(a.x), fabsf(a.y)), fmaxf(fabsf(a.z), fabsf(a.w))), fmaxf(fmaxf(fabsf(b.x), fabsf(b.y)), fmaxf(fabsf(b.z), fabsf(b.w))));
        m = fmaxf(m, fmaxf(fmaxf(fmaxf(fabsf(c.x), fabsf(c.y)), fmaxf(fabsf(c.z), fabsf(c.w))), fmaxf(fmaxf(fabsf(d.x), fabsf(d.y)), fmaxf(fabsf(d.z), fabsf(d.w)))));
#pragma unroll
        for (int o = 1; o < 64; o <<= 1) m = fmaxf(m, __shfl_xor(m, o));
        m = fmaxf(m, 1e-30f);
        const float inv = 448.0f / m;
        v4u w;
        w.x = (unsigned)__builtin_amdgcn_cvt_pk_fp8_f32(a.z * inv, a.w * inv, __builtin_amdgcn_cvt_pk_fp8_f32(a.x * inv, a.y * inv, 0, false), true);
        w.y = (unsigned)__builtin_amdgcn_cvt_pk_fp8_f32(b.z * inv, b.w * inv, __builtin_amdgcn_cvt_pk_fp8_f32(b.x * inv, b.y * inv, 0, false), true);
        w.z = (unsigned)__builtin_amdgcn_cvt_pk_fp8_f32(c.z * inv, c.w * inv, __builtin_amdgcn_cvt_pk_fp8_f32(c.x * inv, c.y * inv, 0, false), true);
        w.w = (unsigned)__builtin_amdgcn_cvt_pk_fp8_f32(d.z * inv, d.w * inv, __builtin_amdgcn_cvt_pk_fp8_f32(d.x * inv, d.y * inv, 0, false), true);
        *(v4u*)(dst + (size_t)rrow * D + 16 * lane) = w;
        if (lane == 0) scale[rrow] = m * (1.0f / 448.0f);
    }
}
__device__ __forceinline__ unsigned pack_i8x4(float a, float b, float c, float d) {
    const int ia = (int)rintf(a), ib = (int)rintf(b), ic = (int)rintf(c), id = (int)rintf(d);
    return (unsigned)(ia & 0xff) | ((unsigned)(ib & 0xff) << 8) | ((unsigned)(ic & 0xff) << 16) | ((unsigned)id << 24);
}
__device__ __forceinline__ void convert_rows_i8(const float* src, unsigned char* dst, float* scale, int rows, int gw, int ngw, int lane) {
    for (int rrow = gw; rrow < rows; rrow += ngw) {
        const float* p = src + (size_t)rrow * D + 16 * lane;
        const f32x4 a = *(const f32x4*)p, b = *(const f32x4*)(p + 4), c = *(const f32x4*)(p + 8), d = *(const f32x4*)(p + 12);
        float m = fmaxf(fmaxf(fmaxf(fabsf(a.x), fabsf(a.y)), fmaxf(fabsf(a.z), fabsf(a.w))), fmaxf(fmaxf(fabsf(b.x), fabsf(b.y)), fmaxf(fabsf(b.z), fabsf(b.w))));
        m = fmaxf(m, fmaxf(fmaxf(fmaxf(fabsf(c.x), fabsf(c.y)), fmaxf(fabsf(c.z), fabsf(c.w))), fmaxf(fmaxf(fabsf(d.x), fabsf(d.y)), fmaxf(fabsf(d.z), fabsf(d.w)))));
#pragma unroll
        for (int o = 1; o < 64; o <<= 1) m = fmaxf(m, __shfl_xor(m, o));
        m = fmaxf(m, 1e-30f);
        const float inv = 127.0f / m;
        v4u w;
        w.x = pack_i8x4(a.x * inv, a.y * inv, a.z * inv, a.w * inv); w.y = pack_i8x4(b.x * inv, b.y * inv, b.z * inv, b.w * inv);
        w.z = pack_i8x4(c.x * inv, c.y * inv, c.z * inv, c.w * inv); w.w = pack_i8x4(d.x * inv, d.y * inv, d.z * inv, d.w * inv);
        *(v4u*)(dst + (size_t)rrow * D + 16 * lane) = w;
        if (lane == 0) scale[rrow] = m * (1.0f / 127.0f);
    }
}
__device__ __forceinline__ int isum8(int x) {
    x += (int)dppu<0xB1>((unsigned)x); x += (int)dppu<0x4E>((unsigned)x); x += (int)dppu<0x141>((unsigned)x); return x;
}
__device__ __forceinline__ float sum8(float x) {
    x += __uint_as_float(dppu<0xB1>(__float_as_uint(x))); x += __uint_as_float(dppu<0x4E>(__float_as_uint(x))); x += __uint_as_float(dppu<0x141>(__float_as_uint(x))); return x;
}
__device__ __forceinline__ float dot16_fp8(const v4u q, const f32x2c (&x)[8]) {
    f32x2c d = __builtin_amdgcn_cvt_pk_f32_fp8((int)q.x, false) * x[0];
    d = __builtin_elementwise_fma(__builtin_amdgcn_cvt_pk_f32_fp8((int)q.x, true), x[1], d);
    d = __builtin_elementwise_fma(__builtin_amdgcn_cvt_pk_f32_fp8((int)q.y, false), x[2], d);
    d = __builtin_elementwise_fma(__builtin_amdgcn_cvt_pk_f32_fp8((int)q.y, true), x[3], d);
    d = __builtin_elementwise_fma(__builtin_amdgcn_cvt_pk_f32_fp8((int)q.z, false), x[4], d);
    d = __builtin_elementwise_fma(__builtin_amdgcn_cvt_pk_f32_fp8((int)q.z, true), x[5], d);
    d = __builtin_elementwise_fma(__builtin_amdgcn_cvt_pk_f32_fp8((int)q.w, false), x[6], d);
    d = __builtin_elementwise_fma(__builtin_amdgcn_cvt_pk_f32_fp8((int)q.w, true), x[7], d);
    return d.x + d.y;
}
__device__ __forceinline__ void axpy16_fp8(const v4u q, float cf, f32x2c (&y)[8]) {
    const f32x2c c2 = {cf, cf};
    y[0] = __builtin_elementwise_fma(__builtin_amdgcn_cvt_pk_f32_fp8((int)q.x, false), c2, y[0]); y[1] = __builtin_elementwise_fma(__builtin_amdgcn_cvt_pk_f32_fp8((int)q.x, true), c2, y[1]);
    y[2] = __builtin_elementwise_fma(__builtin_amdgcn_cvt_pk_f32_fp8((int)q.y, false), c2, y[2]); y[3] = __builtin_elementwise_fma(__builtin_amdgcn_cvt_pk_f32_fp8((int)q.y, true), c2, y[3]);
    y[4] = __builtin_elementwise_fma(__builtin_amdgcn_cvt_pk_f32_fp8((int)q.z, false), c2, y[4]); y[5] = __builtin_elementwise_fma(__builtin_amdgcn_cvt_pk_f32_fp8((int)q.z, true), c2, y[5]);
    y[6] = __builtin_elementwise_fma(__builtin_amdgcn_cvt_pk_f32_fp8((int)q.w, false), c2, y[6]); y[7] = __builtin_elementwise_fma(__builtin_amdgcn_cvt_pk_f32_fp8((int)q.w, true), c2, y[7]);
}

#define FFN_ISSUE_U(q, idv) do { _Pragma("unroll") for (int i = 0; i < 8; ++i) { const int ex_ = __shfl(idv, 8 * i + eg); \
            q[i] = *(const v4u*)(UT8 + (((unsigned)ex_ << 10) + (unsigned)(128 * sl + 16 * ch))); } } while (0)
#define FFN_DOT_U(QQ, XX, r) do { const v4u xx_ = XX; _Pragma("unroll") for (int i = 0; i < 8; ++i) { const v4u qq_ = QQ[i]; \
            int d_ = __builtin_amdgcn_sdot4((int)qq_[0], (int)xx_[0], 0, false); d_ = __builtin_amdgcn_sdot4((int)qq_[1], (int)xx_[1], d_, false); \
            d_ = __builtin_amdgcn_sdot4((int)qq_[2], (int)xx_[2], d_, false); d_ = __builtin_amdgcn_sdot4((int)qq_[3], (int)xx_[3], d_, false); \
            d_ = isum8(d_); if (ch == i) r = d_; } } while (0)
__device__ __forceinline__ void ffn_u_pass(const unsigned char* XQ, const int* IDX, const unsigned char* UT8, int* PART, int sl, int wv, int nwv, int lane) {
    const int eg = lane >> 3, ch = lane & 7;
    v4u qA[8], qB[8];
    int t = wv; if (t >= T) return;
    int i0 = IDX[(size_t)t * HK + lane], i1 = IDX[(size_t)t * HK + 64 + lane], n0 = 0, n1 = 0;
    v4u x0 = *(const v4u*)(XQ + (size_t)t * D + 128 * sl + 16 * ch), xn0 = x0;
    FFN_ISSUE_U(qA, i0);
#pragma unroll 1
    for (;;) {
        const int tn = t + nwv; const bool more = tn < T;
        if (more) { n0 = IDX[(size_t)tn * HK + lane]; n1 = IDX[(size_t)tn * HK + 64 + lane]; xn0 = *(const v4u*)(XQ + (size_t)tn * D + 128 * sl + 16 * ch); }
        FFN_ISSUE_U(qB, i1);
        int r0 = 0, r1 = 0;
        FFN_DOT_U(qA, x0, r0);
        if (more) FFN_ISSUE_U(qA, n0);
        FFN_DOT_U(qB, x0, r1);
        int* pp = PART + ((size_t)sl * T + t) * HK + 8 * ch + eg; pp[0] = r0; pp[64] = r1;
        if (!more) break;
        i0 = n0; i1 = n1; x0 = xn0; t = tn;
    }
}
#define FFN_ISSUE_V(q, cf, idv, cv) do { _Pragma("unroll") for (int i = 0; i < 8; ++i) { const int ex_ = __shfl(idv, 8 * i + eg); cf[i] = __shfl(cv, 8 * i + eg); \
            q[i] = *(const v4u*)(VT8 + (((unsigned)ex_ << 10) + (unsigned)(128 * sl + 16 * ch))); } } while (0)
__device__ __forceinline__ void ffn_v_pass(const int* IDX, const float* COEF, const unsigned char* VT8, const float* mod, float* out, int sl, int wv, int nwv, int lane) {
    const int eg = lane >> 3, ch = lane & 7, col = 128 * sl + 16 * ch;
    v4u qA[8], qB[8]; float cfA[8], cfB[8];
    int t = wv; if (t >= T) return;
    int i0 = IDX[(size_t)t * HK + lane], i1 = IDX[(size_t)t * HK + 64 + lane], n0 = 0, n1 = 0;
    float c0 = COEF[(size_t)t * HK + lane], c1 = COEF[(size_t)t * HK + 64 + lane], cn0 = 0.f, cn1 = 0.f;
    FFN_ISSUE_V(qA, cfA, i0, c0);
#pragma unroll 1
    for (;;) {
        const int tn = t + nwv; const bool more = tn < T;
        if (more) { n0 = IDX[(size_t)tn * HK + lane]; n1 = IDX[(size_t)tn * HK + 64 + lane]; cn0 = COEF[(size_t)tn * HK + lane]; cn1 = COEF[(size_t)tn * HK + 64 + lane]; }
        FFN_ISSUE_V(qB, cfB, i1, c1);
        const size_t o = (size_t)t * D + col; const int b = t / SEQ;
        f32x2c y2[8];
#pragma unroll
        for (int k = 0; k < 8; ++k) y2[k] = (f32x2c){0.f, 0.f};
#pragma unroll
        for (int i = 0; i < 8; ++i) { axpy16_fp8(qA[i], cfA[i], y2); if (i & 1) __builtin_amdgcn_sched_barrier(0); }
        if (more) FFN_ISSUE_V(qA, cfA, n0, cn0);
        f32x4 oa[4];
#pragma unroll
        for (int k4 = 0; k4 < 4; ++k4) oa[k4] = *(const f32x4*)(out + o + 4 * k4);
#pragma unroll
        for (int i = 0; i < 8; ++i) { axpy16_fp8(qB[i], cfB[i], y2); if (i & 1) __builtin_amdgcn_sched_barrier(0); }
        float y[16];
#pragma unroll
        for (int k = 0; k < 8; ++k) { y[2 * k] = y2[k].x; y[2 * k + 1] = y2[k].y; }
#pragma unroll
        for (int k = 0; k < 16; ++k) { y[k] += __uint_as_float(dppu<0x128>(__float_as_uint(y[k]))); y[k] += __shfl_xor(y[k], 16); y[k] += __shfl_xor(y[k], 32); }
        if (eg == 0) {
#pragma unroll
            for (int k4 = 0; k4 < 4; ++k4) { f32x4 w = oa[k4]; const f32x4 ga = *(const f32x4*)(mod + b * MODW + 5 * D + col + 4 * k4);
                w.x += ga.x * y[4 * k4]; w.y += ga.y * y[4 * k4 + 1]; w.z += ga.z * y[4 * k4 + 2]; w.w += ga.w * y[4 * k4 + 3]; *(f32x4*)(out + o + 4 * k4) = w; } }
        if (!more) break;
        i0 = n0; i1 = n1; c0 = cn0; c1 = cn1; t = tn;
    }
}
}

namespace fin {
using scan::cvtpk; using scan::mkfrag; using scan::mma;
typedef unsigned u32x2 __attribute__((ext_vector_type(2)));

__device__ __forceinline__ float shift3(const bf16* p, bool hasp, bool hasn, float mp, float mn) {
    const float z = bf2f(p[0]), zp = hasp ? bf2f(p[-INW]) : 0.f, zn = hasn ? bf2f(p[INW]) : 0.f;
    return z + mp * (zp - z) + mn * (zn - z);
}

__device__ __forceinline__ void unpack4(const u32x2 w, float (&f)[4]) {
    f[0] = __uint_as_float(w.x << 16); f[1] = __uint_as_float(w.x & 0xffff0000u); f[2] = __uint_as_float(w.y << 16); f[3] = __uint_as_float(w.y & 0xffff0000u);
}
__device__ __forceinline__ void phase(LAS unsigned char* L, const bf16* Z, const float* mu_prev, const float* mu_next, const float* g_up, const bf16* Y, const float* BON,
                                      const float* k_a, const float* r_k, const float* lnx_g, const float* lnx_b, bf16* mix, const bf16* O3, const float* LSE,
                                      int bx, int G, int tid, int wave, int lane) {
    const int g = lane >> 4, c16 = lane & 15, ch0 = 64 * wave + 4 * c16;
    LAS bf16* sg = (LAS bf16*)L;
    bf16x8 bf[4][4];
#pragma unroll
    for (int ks = 0; ks < 4; ++ks) {
        f32x4 rowv[8];
#pragma unroll
        for (int jj = 0; jj < 8; ++jj) rowv[jj] = *(const f32x4*)(g_up + (size_t)(32 * ks + 8 * g + jj) * RW + ch0);
#pragma unroll
        for (int nt = 0; nt < 4; ++nt) bf[nt][ks] = mkfrag(cvtpk(rowv[0][nt], rowv[1][nt]), cvtpk(rowv[2][nt], rowv[3][nt]), cvtpk(rowv[4][nt], rowv[5][nt]), cvtpk(rowv[6][nt], rowv[7][nt]));
    }
    const f32x4 mpr = *(const f32x4*)(mu_prev + ch0), mnr = *(const f32x4*)(mu_next + ch0), mpk = *(const f32x4*)(mu_prev + RW + ch0), mnk = *(const f32x4*)(mu_next + RW + ch0),
                mpv = *(const f32x4*)(mu_prev + 2 * RW + ch0), mnv = *(const f32x4*)(mu_next + 2 * RW + ch0);
    const f32x4 ka1 = *(const f32x4*)(k_a + ch0), rk1 = *(const f32x4*)(r_k + ch0), lg = *(const f32x4*)(lnx_g + ch0), lb = *(const f32x4*)(lnx_b + ch0);
    const int j0 = (tid & 31) * 4;
    const f32x4 mpg = *(const f32x4*)(mu_prev + 3 * RW + DL + AL + j0), mng = *(const f32x4*)(mu_next + 3 * RW + DL + AL + j0);
    for (int tb = bx; tb < T / 16; tb += G) {
        const int tok0 = tb * 16;
        __syncthreads();
        {
            const int tl = tid >> 5, tok = tok0 + tl, t = tok % SEQ;
            const bf16* p = Z + (size_t)tok * INW + 3 * AW + 3 * RW + DL + AL + j0;
            const bool hasp = t > 0, hasn = t < SEQ - 1;
            float zc[4], zp[4], zn[4];
            unpack4(*(const u32x2*)p, zc); unpack4(*(const u32x2*)(hasp ? p - INW : p), zp); unpack4(*(const u32x2*)(hasn ? p + INW : p), zn);
            float o[4];
#pragma unroll
            for (int e = 0; e < 4; ++e) { const float pv = hasp ? zp[e] : 0.f, nv = hasn ? zn[e] : 0.f; const float v = zc[e] + mpg[e] * (pv - zc[e]) + mng[e] * (nv - zc[e]); o[e] = __builtin_amdgcn_rcpf(1.0f + __expf(-v)); }
            u32x2 w; w.x = cvtpk(o[0], o[1]); w.y = cvtpk(o[2], o[3]);
            *(LAS u32x2*)(sg + tl * 128 + j0) = w;
        }
        __syncthreads();
        f32x4 ga[4];
        {
            bf16x8 af[4];
#pragma unroll
            for (int ks = 0; ks < 4; ++ks) af[ks] = *(const LAS bf16x8*)(sg + c16 * 128 + 32 * ks + 8 * g);
#pragma unroll
            for (int nt = 0; nt < 4; ++nt) { f32x4 a = {0.f, 0.f, 0.f, 0.f};
#pragma unroll
                for (int ks = 0; ks < 4; ++ks) a = mma(af[ks], bf[nt][ks], a);
                ga[nt] = a; }
        }
#pragma unroll
        for (int reg = 0; reg < 4; ++reg) {
            const int tok = tok0 + 4 * g + reg, t = tok % SEQ;
            const bool hasp = t > 0, hasn = t < SEQ - 1;
            const bf16* zr = Z + (size_t)tok * INW + 3 * AW + ch0;
            const size_t o = (size_t)tok * RW + ch0;
            float y0[4], y1[4]; unpack4(*(const u32x2*)(Y + o), y0); unpack4(*(const u32x2*)(Y + (size_t)T * RW + o), y1);
            float rc[4], rp[4], rn[4], kc[4], kp[4], kn[4], vc[4], vp[4], vn[4];
            unpack4(*(const u32x2*)zr, rc); unpack4(*(const u32x2*)(hasp ? zr - INW : zr), rp); unpack4(*(const u32x2*)(hasn ? zr + INW : zr), rn);
            unpack4(*(const u32x2*)(zr + RW), kc); unpack4(*(const u32x2*)(hasp ? zr + RW - INW : zr + RW), kp); unpack4(*(const u32x2*)(hasn ? zr + RW + INW : zr + RW), kn);
            unpack4(*(const u32x2*)(zr + 2 * RW), vc); unpack4(*(const u32x2*)(hasp ? zr + 2 * RW - INW : zr + 2 * RW), vp); unpack4(*(const u32x2*)(hasn ? zr + 2 * RW + INW : zr + 2 * RW), vn);
            bf16* mp = mix + (size_t)tok * D + ch0;
            float o1[4], o2[4], o3[4];
            unpack4(*(const u32x2*)mp, o1); unpack4(*(const u32x2*)(mp + AW), o2); unpack4(*(const u32x2*)(O3 + (size_t)tok * AW + ch0), o3);
            const float l1 = LSE[(size_t)tok * NH + wave], l2 = LSE[((size_t)T + tok) * NH + wave], l3 = LSE[((size_t)2 * T + tok) * NH + wave];
            const float bon = BON[(size_t)tok * NH + wave] + BON[((size_t)T + tok) * NH + wave];
            float yv[4], vv[4], s1 = 0.f, sb = 0.f;
#pragma unroll
            for (int nt = 0; nt < 4; ++nt) {
                yv[nt] = y0[nt] + y1[nt]; s1 += yv[nt];
                const float pr = hasp ? rp[nt] : 0.f, nr = hasn ? rn[nt] : 0.f, pk = hasp ? kp[nt] : 0.f, nk = hasn ? kn[nt] : 0.f, pvv = hasp ? vp[nt] : 0.f, nvv = hasn ? vn[nt] : 0.f;
                const float rr = rc[nt] + mpr[nt] * (pr - rc[nt]) + mnr[nt] * (nr - rc[nt]);
                const float kk = kc[nt] + mpk[nt] * (pk - kc[nt]) + mnk[nt] * (nk - kc[nt]);
                vv[nt] = vc[nt] + mpv[nt] * (pvv - vc[nt]) + mnv[nt] * (nvv - vc[nt]);
                sb += rr * kk * rk1[nt] * (1.0f - ka1[nt]);
            }
            const float mean = peer::rowsum16(s1) * (1.f / 64.f);
            float s2 = 0.f;
#pragma unroll
            for (int nt = 0; nt < 4; ++nt) s2 += (yv[nt] - mean) * (yv[nt] - mean);
            const float rstd = __builtin_amdgcn_rsqf(peer::rowsum16(s2) * (1.f / 64.f) + 64e-5f);
            const float bs = peer::rowsum16(sb) + 0.5f * bon;
            const float lm = fmaxf(l1, fmaxf(l2, l3)), w1 = __expf(l1 - lm), w2 = __expf(l2 - lm), w3 = __expf(l3 - lm), wi = __builtin_amdgcn_rcpf(w1 + w2 + w3);
            float att[4], rw[4];
#pragma unroll
            for (int nt = 0; nt < 4; ++nt) {
                att[nt] = (w1 * o1[nt] + w2 * o2[nt] + w3 * o3[nt]) * wi;
                rw[nt] = ((yv[nt] - mean) * rstd * lg[nt] + lb[nt] + bs * vv[nt]) * ga[nt][reg];
            }
            u32x2 wa, wr; wa.x = cvtpk(att[0], att[1]); wa.y = cvtpk(att[2], att[3]); wr.x = cvtpk(rw[0], rw[1]); wr.y = cvtpk(rw[2], rw[3]);
            *(u32x2*)mp = wa; *(u32x2*)(mp + AW) = wr;
            __builtin_amdgcn_sched_barrier(0);
        }
    }
}
}

#ifndef MK_SKIP
#define MK_SKIP 0
#endif
constexpr int N_PHASES = 12;
struct Args { const float* in[27]; float* out; unsigned char* ws; int ph_lo, ph_hi, li, pad; };

__global__ void __launch_bounds__(NWAVES * 64, 2) mk_fwd(Args args) {
    extern __shared__ __attribute__((aligned(16))) unsigned char lds[];
    LAS unsigned char* L = (LAS unsigned char*)lds;
    volatile LAS unsigned* MISC = (volatile LAS unsigned*)(L + MISC_OFF);
    const int tid = threadIdx.x, lane = tid & 63, wave = __builtin_amdgcn_readfirstlane(tid >> 6);
    const int G = gridDim.x, bx = blockIdx.x;
    unsigned char* ws = args.ws;
    gu32* ctl = (gu32*)(ws + WS_CTL);
    const float* x = args.in[0]; const float* cvec = args.in[1]; const float* ada_w = args.in[2]; const float* ada_b = args.in[3];
    const float* norm1_g = args.in[4]; const float* w_in = args.in[5]; const float* mu_prev = args.in[6]; const float* mu_next = args.in[7];
    const float* q_norm_g = args.in[8]; const float* k_norm_g = args.in[9]; const float* w_decay0 = args.in[10]; const float* w_decay_up = args.in[11];
    const float* a_gate0 = args.in[12]; const float* a_gate_up = args.in[13]; const float* g_up = args.in[14]; const float* k_k = args.in[15];
    const float* k_a = args.in[16]; const float* r_k = args.in[17]; const float* lnx_g = args.in[18]; const float* lnx_b = args.in[19];
    const float* w_out = args.in[20]; const float* norm2_g = args.in[21]; const float* w_query = args.in[22]; const float* keys1 = args.in[23];
    const float* keys2 = args.in[24]; const float* peer_u = args.in[25]; const float* peer_v = args.in[26];
    float* out = args.out;
    float* MOD = (float*)(ws + WS_MOD); bf16* KEYS = (bf16*)(ws + WS_KEYS); bf16* WIN = (bf16*)(ws + WS_WIN); bf16* WOUT = (bf16*)(ws + WS_WOUT); bf16* WQ = (bf16*)(ws + WS_WQ);
    bf16* XN = (bf16*)(ws + WS_XN); bf16* Z = (bf16*)(ws + WS_Z); bf16* MIX = (bf16*)(ws + WS_MIX); bf16* Y = (bf16*)(ws + WS_Y); bf16* Q = (bf16*)(ws + WS_Q);
    int* IDX = (int*)(ws + WS_IDX); float* GATE = (float*)(ws + WS_GATE); float* BON = (float*)(ws + WS_BON);
    bf16* O3 = (bf16*)(ws + WS_O3); float* LSE = (float*)(ws + WS_LSE); unsigned char* UT8 = ws + WS_UT; unsigned char* VT8 = ws + WS_VT; float* SU = (float*)(ws + WS_SU); float* SV = (float*)(ws + WS_SU + 65536); unsigned char* XQ = ws + WS_XQ; float* SX = (float*)(ws + WS_XQ + 16 * MiB); float* PART = (float*)(ws + WS_PART);

    for (int u = tid; u < (LDS_BYTES - LDSCTL_OFF) / 4; u += NWAVES * 64) ((LAS unsigned*)(L + LDSCTL_OFF))[u] = 0u;
    __syncthreads();
    XcdBarrier bar = xcd_barrier_post((unsigned*)(ctl + CW_BAR) + args.li * XCD_BAR_WORDS, MISC + 8);
    const int lo = args.ph_lo, hi = args.ph_hi;
#define IN(k) (lo <= (k) && (k) < hi)
#define SEAM(k) do { if (IN(k) && IN((k) + 1)) xcd_barrier(bar); } while (0)
    const int gw = bx * NWAVES + wave, NGW = G * NWAVES;

    if (IN(0) && !(MK_SKIP & (1 << 0))) {
        if (bx < 2 * (MODW / 64)) {
            const int cg = bx % (MODW / 64), kh = bx / (MODW / 64);
            LAS float* sc = (LAS float*)L; LAS float* part = (LAS float*)(L + 32768);
            for (int i = tid; i < BATCH * D; i += NWAVES * 64) { const float cv = cvec[i]; sc[i] = cv / (1.f + expf(-cv)); }
            __syncthreads();
            const int j0 = cg * 64, i0 = kh * 512 + wave * 64;
            float acc[BATCH];
#pragma unroll
            for (int b = 0; b < BATCH; ++b) acc[b] = 0.f;
#pragma unroll 1
            for (int ii = 0; ii < 64; ii += 8) {
                float w[8];
#pragma unroll
                for (int e = 0; e < 8; ++e) w[e] = ada_w[(size_t)(i0 + ii + e) * MODW + j0 + lane];
#pragma unroll
                for (int e = 0; e < 8; ++e)
#pragma unroll
                    for (int b = 0; b < BATCH; ++b) acc[b] += sc[b * D + i0 + ii + e] * w[e];
            }
#pragma unroll
            for (int b = 0; b < BATCH; ++b) part[(wave * 8 + b) * 64 + lane] = acc[b];
            __syncthreads();
            { const int b = tid >> 6; float s = 0.f;
#pragma unroll
              for (int w = 0; w < 8; ++w) s += part[(w * 8 + b) * 64 + lane];
              if (kh == 0) s += ada_b[j0 + lane];
              atomicAdd(MOD + b * MODW + j0 + lane, s); }
            __syncthreads();
        }
        LAS float* scr = (LAS float*)(L + RING_OFF + wave * 16384);
        constexpr int I_IN = (D / 64) * (INW / 32), I_OUT = (D / 64) * (D / 32), I_Q = (D / 64) * (QW / 32);
        for (int it = gw; it < I_IN + I_OUT + I_Q; it += NGW) {
            int r = it;
            if (r < I_IN) { p0_transpose_item(w_in, D, INW, WIN, 0, scr, r, lane); continue; } r -= I_IN;
            if (r < I_OUT) { p0_transpose_item(w_out, D, D, WOUT, 0, scr, r, lane); continue; } r -= I_OUT;
            p0_transpose_item(w_query, D, QW, WQ, 0, scr, r, lane);
        }
    }
    SEAM(0);
    if (IN(1) && !(MK_SKIP & (1 << 1))) { norm_rows(x, norm1_g, MOD, 0, D, XN, gw, NGW, lane); }
    SEAM(1);
    if (IN(2) && !(MK_SKIP & (1 << 2))) {
        pg8::Gemm g{XN, WIN, T, INW, D}; pg8::StaticOrder S; S.init(T, INW, G, bx);
        pg8::EpiBf16<0> E{Z, INW, nullptr, 0, 0, 1.f};
        pg8::gemm_phase<pg8::EpiBf16<0>, pg8::StaticOrder, true, true>(L + RING_OFF, g, S, E);
    }
    SEAM(2);
    if (IN(3) && !(MK_SKIP & (1 << 3))) {
        constexpr int NCHAIN = BATCH * NH * 2;
        if (bx < NCHAIN) scan::chain(L, Z, mu_prev, mu_next, w_decay0, w_decay_up, a_gate0, a_gate_up, k_k, k_a, r_k, Y, BON, bx, tid, wave, lane);
        {
            gu32* ucnt = ctl + CW_WORK + 64 * args.li;
            LAS unsigned char* vt = L + wave * attn::WAVE_LDS;
            for (;;) {
                unsigned uu = 0u;
                if (lane == 0) uu = __hip_atomic_fetch_add(ucnt, 1u, __ATOMIC_RELAXED, __HIP_MEMORY_SCOPE_AGENT);
                const int u = __builtin_amdgcn_readfirstlane((int)uu);
                if (u >= BATCH * NH * 96) break;
                const int x = u & 31, p = (u >> 5) % 3, bh = u / 96;
                const int d = (p == 0) ? 1 : (p == 1 ? 4 : 16), nb = 32 / d, r = x / nb, qb = x % nb;
                bf16* Ob = (p == 0) ? MIX : (p == 1 ? MIX + AW : O3); const int opitch = (p == 2) ? AW : D;
                attn::unit(vt, Z, q_norm_g, k_norm_g, Ob, opitch, LSE + (size_t)p * T * NH, bh >> 3, bh & 7, d, r, qb, nb, lane);
            }
        }
        {
            gu32* ccnt = ctl + CW_WORK2 + 64 * args.li;
            for (;;) {
                unsigned uu = 0u;
                if (lane == 0) uu = __hip_atomic_fetch_add(ccnt, 1u, __ATOMIC_RELAXED, __HIP_MEMORY_SCOPE_AGENT);
                const int it = __builtin_amdgcn_readfirstlane((int)uu);
                if (it >= 1024) break;
                const int r0 = (it & 511) * 32;
                if (it < 512) peer::convert_rows_i8(peer_u + (size_t)r0 * D, UT8 + (size_t)r0 * D, SU + r0, 32, 0, 1, lane);
                else peer::convert_rows_fp8(peer_v + (size_t)r0 * D, VT8 + (size_t)r0 * D, SV + r0, 32, 0, 1, lane);
            }
        }
    }
    SEAM(3);
    if (IN(4) && !(MK_SKIP & (1 << 4))) { fin::phase(L, Z, mu_prev, mu_next, g_up, Y, BON, k_a, r_k, lnx_g, lnx_b, MIX, O3, LSE, bx, G, tid, wave, lane); }
    SEAM(4);
    if (IN(5) && !(MK_SKIP & (1 << 5))) {
        pg8::Gemm g{MIX, WOUT, T, D, D}; pg8::StaticOrder S; S.init(T, D, G, bx);
        EpiRes E{x, MOD, 2 * D, out, D};
        pg8::gemm_phase<EpiRes, pg8::StaticOrder, true, true>(L + RING_OFF, g, S, E);
    }
    SEAM(5);
    if (IN(6) && !(MK_SKIP & (1 << 6))) { norm_rows_q(out, norm2_g, MOD, 3 * D, 4 * D, XN, XQ, SX, gw, NGW, lane);
    }
    SEAM(6);
    if (IN(7) && !(MK_SKIP & (1 << 7))) {
        pg8::Gemm g{XN, WQ, T, QW, D}; pg8::StaticOrder S; S.init(T, QW, G, bx);
        pg8::EpiBf16<0> E{Q, QW, nullptr, 0, 0, 1.f};
        pg8::gemm_phase<pg8::EpiBf16<0>, pg8::StaticOrder, true, true>(L + RING_OFF, g, S, E);
    }
    SEAM(7);
    if (IN(8) && !(MK_SKIP & (1 << 8))) { __syncthreads(); peer::setup_keys(L, keys1, keys2, tid); __syncthreads();
        for (int bt = gw; bt < T * PH / 16; bt += NGW) peer::select_batch(L, Q, IDX, GATE, bt, lane); }
    SEAM(8);
    {
        const int sl = bx & 7, wv = (bx >> 3) * NWAVES + wave, nwv = (G >> 3) * NWAVES;
        if (IN(9) && !(MK_SKIP & (1 << 9))) { peer::ffn_u_pass(XQ, IDX, UT8, (int*)PART, sl, wv, nwv, lane); }
        SEAM(9);
        if (IN(10) && !(MK_SKIP & (1 << 10))) {
            for (size_t i = (size_t)bx * NWAVES * 64 + tid; i < (size_t)T * HK; i += (size_t)G * NWAVES * 64) {
                int di = 0;
#pragma unroll
                for (int s8 = 0; s8 < 8; ++s8) di += ((const int*)PART)[(size_t)s8 * T * HK + i];
                const int ex = IDX[i];
                GATE[i] = GATE[i] * peer::gelu_erf((float)di * SU[ex] * SX[i / HK]) * SV[ex];
            }
        }
        SEAM(10);
        if (IN(11) && !(MK_SKIP & (1 << 11))) { peer::ffn_v_pass(IDX, GATE, VT8, MOD, out, sl, wv, nwv, lane); }
    }
#undef IN
#undef SEAM
}

extern "C" void kernel_launch(void* const* d_in, const int* in_sizes, int n_in, void* d_out, int out_size, void* d_ws, size_t ws_size, hipStream_t stream) {
    static int grid = 0;
    if (grid == 0) {
        if (n_in != 27 || in_sizes[0] != T * D || out_size != T * D || ws_size < WS_END) { fprintf(stderr, "kernel_launch: unexpected problem (n_in %d, in0 %d, out %d, ws %zu); nothing launched\n", n_in, n_in > 0 ? in_sizes[0] : -1, out_size, ws_size); grid = -1; return; }
        int dev = 0, cus = 0, per_cu = 0;
        if (hipGetDevice(&dev) != hipSuccess || hipDeviceGetAttribute(&cus, hipDeviceAttributeMultiprocessorCount, dev) != hipSuccess) { fprintf(stderr, "kernel_launch: device query failed\n"); grid = -1; return; }
        if (hipFuncSetAttribute((const void*)mk_fwd, hipFuncAttributeMaxDynamicSharedMemorySize, LDS_BYTES) != hipSuccess) { fprintf(stderr, "kernel_launch: hipFuncSetAttribute failed\n"); grid = -1; return; }
        if (hipOccupancyMaxActiveBlocksPerMultiprocessor(&per_cu, (const void*)mk_fwd, NWAVES * 64, LDS_BYTES) != hipSuccess || per_cu < 1)
            fprintf(stderr, "kernel_launch: note: occupancy query reports %d workgroups per CU\n", per_cu);
        (void)hipGetLastError();
        grid = cus;
        if (grid % 8 != 0 || grid < 2 * (BATCH * NH * 2)) { fprintf(stderr, "kernel_launch: needs a CU count that is a multiple of 8 (XCD-sliced FFN passes) and >= 256 workgroups' worth of chains; got %d; nothing launched\n", grid); grid = -1; return; }
    }
    if (grid < 0) return;
    if (hipMemsetAsync((char*)d_ws + WS_CTL, 0, CTL_ZERO_BYTES, stream) != hipSuccess) { fprintf(stderr, "kernel_launch: hipMemsetAsync failed\n"); return; }
    Args a{};
    for (int i = 0; i < 27; ++i) a.in[i] = (const float*)d_in[i];
    a.out = (float*)d_out; a.ws = (unsigned char*)d_ws;
#ifndef MK_RANGES
#define MK_RANGES {{0, N_PHASES}}
#endif
    static const int ranges[][2] = MK_RANGES;
    const int nl = (int)(sizeof(ranges) / sizeof(ranges[0]));
    for (int li = 0; li < nl; ++li) {
        a.ph_lo = ranges[li][0]; a.ph_hi = ranges[li][1]; a.li = li;
        hipLaunchKernelGGL(mk_fwd, dim3(grid), dim3(NWAVES * 64), LDS_BYTES, stream, a);
        const hipError_t le = hipPeekAtLastError();
        if (le != hipSuccess) { fprintf(stderr, "kernel_launch: launch %d failed: %s\n", li, hipGetErrorName(le)); break; }
    }
}
```

```cpp
#include <hip/hip_runtime.h>
#include <cstdio>
#include <cstdint>
#include <cmath>
namespace pg8 {
#define PG8_LAS __attribute__((address_space(3)))
typedef unsigned short bf16_t;
typedef short bf16x8 __attribute__((ext_vector_type(8)));
typedef float f32x4 __attribute__((ext_vector_type(4)));
typedef unsigned u32x4 __attribute__((ext_vector_type(4)));
constexpr int BM = 256, BK = 64, HALF = 128, HTB = HALF * BK * 2  , STAGE_BYTES = 8 * HTB, NXCD = 8, WGM = 8;

__host__ __device__ __forceinline__ int lds_byte(int r, int c) { const int st = (r >> 4) * 2 + (c >> 5), rr = r & 15, cc = c & 31, ob = rr * 64 + cc * 2; return st * 1024 + (ob ^ (((ob >> 9) & 1) << 5)); }
__host__ __device__ __forceinline__ void stage_rc(int b, int& R, int& C) { const int st = b / 1024, sb = b % 1024, swz = sb ^ (((sb >> 9) & 1) << 5); R = (st >> 1) * 16 + swz / 64; C = (st & 1) * 32 + (swz % 64) / 2; }
__host__ __device__ __forceinline__ int perm32(int rho) { const int n = rho >> 4, i = rho & 15; return 8 * (i >> 2) + 4 * n + (i & 3); }

struct Unit { int pm, pn; };
struct Gemm { const bf16_t* A; const bf16_t* Bt; int M, N, K; };

struct StaticOrder {
    int nM, nN, nwg, G, c;
    __host__ __device__ void init(int M, int N, int G_, int c_) { nM = M / BM; nN = N / BM; nwg = nM * nN; G = G_; c = c_; }
    __host__ __device__ bool next(int i, Unit& u) const {
        const long L = (long)i * G + c; if (L >= nwg) return false;
        int wgid = (int)L; { const int q = nwg / NXCD, r = nwg % NXCD, xcd = wgid % NXCD, off = wgid / NXCD; wgid = (xcd < r ? xcd * (q + 1) : r * (q + 1) + (xcd - r) * q) + off; }
        const int nig = WGM * nN, gid = wgid / nig, fm = gid * WGM, gsz = (nM - fm) < WGM ? (nM - fm) : WGM;
        u.pm = fm + ((wgid % nig) % gsz); u.pn = (wgid % nig) / gsz; return true;
    }
    __device__ __forceinline__ void a_ready(const Unit&) const {}
    __device__ __forceinline__ void done(const Unit&) const {}
};

__device__ __forceinline__ unsigned cvt_pk_bf16(float lo, float hi) { unsigned r; asm volatile("v_cvt_pk_bf16_f32 %0, %1, %2" : "=v"(r) : "v"(lo), "v"(hi)); return r; }
typedef float f32x2 __attribute__((ext_vector_type(2)));
__device__ __forceinline__ f32x2 gelu_pk(f32x2 v) {
    const f32x2 av = __builtin_elementwise_abs(v), d = av * 0.2316418882f + 1.0f;
    f32x2 t; t.x = __builtin_amdgcn_rcpf(d.x); t.y = __builtin_amdgcn_rcpf(d.y);
    f32x2 q = t * 0.5307027145f + (-0.7265760135f); q = q * t + 0.7107068705f; q = q * t + (-0.142248368f); q = q * t + 0.127414796f; q = q * t;
    const f32x2 s = (v * v) * (-0.72134752044f);
    f32x2 e; e.x = __builtin_amdgcn_exp2f(s.x); e.y = __builtin_amdgcn_exp2f(s.y);
    const f32x2 m = v * (q * e), r = v - m;
    f32x2 o; o.x = v.x < 0.f ? m.x : r.x; o.y = v.y < 0.f ? m.y : r.y; return o;
}

template <int ACT  > struct EpiBf16 {
    static constexpr bool PERM = true, AFTER_DRAIN = false; static_assert(ACT == 0 || ACT == 1, "EpiBf16: ACT is 0 (none) or 1 (gelu_pk)");
    bf16_t* O; int ldc; const float* bias; int split_cols; size_t split_stride; float scale0;
    __device__ __forceinline__ void operator()(const f32x4 (&acc)[2][2][4][2], const Unit& u, int wr, int wc, int fr, int fq) const {
        const int row0 = u.pm * BM + wr * 64 + fr; int colt = u.pn * BM; bf16_t* base = O;
        float sc = 1.f; if (split_cols) { const int t = colt / split_cols; base += (size_t)t * split_stride; colt -= t * split_cols; if (t == 0) sc = scale0; }
        const int col0 = colt + wc * 32 + 8 * fq, bcol0 = u.pn * BM + wc * 32 + 8 * fq;
        f32x4 bv[2][2];
#pragma unroll
        for (int bj = 0; bj < 2; ++bj)
#pragma unroll
            for (int n = 0; n < 2; ++n) bv[bj][n] = bias ? *(const f32x4*)(bias + bcol0 + bj * HALF + 4 * n) : (f32x4){0.f, 0.f, 0.f, 0.f};
#pragma unroll
        for (int ai = 0; ai < 2; ++ai)
#pragma unroll
            for (int m = 0; m < 4; ++m) { bf16_t* rowp = base + (size_t)(row0 + ai * HALF + m * 16) * ldc + col0;
#pragma unroll
                for (int bj = 0; bj < 2; ++bj) { f32x4 v0 = acc[ai][bj][m][0] + bv[bj][0], v1 = acc[ai][bj][m][1] + bv[bj][1];
                    if (ACT == 1) { f32x2 a = gelu_pk((f32x2){v0[0], v0[1]}), b = gelu_pk((f32x2){v0[2], v0[3]}), c = gelu_pk((f32x2){v1[0], v1[1]}), d = gelu_pk((f32x2){v1[2], v1[3]});
                        v0 = (f32x4){a.x, a.y, b.x, b.y}; v1 = (f32x4){c.x, c.y, d.x, d.y}; }
                    v0 = v0 * sc; v1 = v1 * sc; u32x4 w; w.x = cvt_pk_bf16(v0[0], v0[1]); w.y = cvt_pk_bf16(v0[2], v0[3]); w.z = cvt_pk_bf16(v1[0], v1[1]); w.w = cvt_pk_bf16(v1[2], v1[3]);
                    *(u32x4*)(rowp + bj * HALF) = w; } }
    }
};

template <class Epi, class Sched, bool ALIGN_EPI = false, bool SP2 = false>
__device__ __forceinline__ void gemm_phase(PG8_LAS unsigned char* lds, const Gemm g, const Sched& S, const Epi& E) {
    const int tid = threadIdx.x, wid = __builtin_amdgcn_readfirstlane(tid >> 6), lane = tid & 63, wr = wid >> 2, wc = wid & 3, fr = lane & 15, fq = lane >> 4;
    const int K = g.K, nt = K / BK;
    unsigned voffA[2], voffB[2];
#pragma unroll
    for (int i = 0; i < 2; ++i) { int R, C; stage_rc(tid * 16 + i * 8192, R, C); const int Rb = Epi::PERM ? ((R & ~31) + perm32(R & 31)) : R;
        voffA[i] = (unsigned)(R * K + C) * 2u; voffB[i] = (unsigned)(Rb * K + C) * 2u; }
    const size_t kstep = (size_t)(BK * 2);
    const size_t hstep = (size_t)HALF * K * 2;
    const size_t tstep = 2 * hstep;
    const unsigned ldsw = (unsigned)wid * 1024u;
    const int aoff = lds_byte(wr * 64 + fr, fq * 8), boff = lds_byte(wc * 32 + fr, fq * 8);
#define PG8_SA(b, h) (((b) * 2 + (h)) * HTB)
#define PG8_SB(b, h) ((4 + (b) * 2 + (h)) * HTB)
#define PG8_STAGE(bufoff, gbase, voff) do { _Pragma("unroll") for (int _i = 0; _i < 2; ++_i) \
        __builtin_amdgcn_global_load_lds((const unsigned*)((const char*)(gbase) + (voff)[_i]), (PG8_LAS unsigned*)(lds + (bufoff) + ldsw + _i * 8192), 16, 0, 0); } while (0)
#define PG8_LDA(dst, b, h) do { _Pragma("unroll") for (int m = 0; m < 4; ++m) _Pragma("unroll") for (int k = 0; k < 2; ++k) dst[m][k] = *(const PG8_LAS bf16x8*)(lds + PG8_SA(b, h) + aoff + m * 2048 + k * 1024); } while (0)
#define PG8_LDB(dst, b, h) do { _Pragma("unroll") for (int n = 0; n < 2; ++n) _Pragma("unroll") for (int k = 0; k < 2; ++k) dst[n][k] = *(const PG8_LAS bf16x8*)(lds + PG8_SB(b, h) + boff + n * 2048 + k * 1024); } while (0)
#define PG8_MMA(ai, bj, At, Bt) do { __builtin_amdgcn_s_setprio(1); _Pragma("unroll") for (int m = 0; m < 4; ++m) _Pragma("unroll") for (int n = 0; n < 2; ++n) _Pragma("unroll") for (int k = 0; k < 2; ++k) \
        acc[ai][bj][m][n] = __builtin_amdgcn_mfma_f32_16x16x32_bf16(Bt[n][k], At[m][k], acc[ai][bj][m][n], 0, 0, 0); __builtin_amdgcn_s_setprio(0); } while (0)
#define PG8_WAIT_V(n) asm volatile("s_waitcnt vmcnt(" #n ")" ::: "memory")
#define PG8_WAIT_L(n) asm volatile("s_waitcnt lgkmcnt(" #n ")" ::: "memory")
#define PG8_BAR __builtin_amdgcn_s_barrier()
#define PG8_SCHED __builtin_amdgcn_sched_barrier(0)
    Unit cur, nxt; int ui = 0;
    if (!S.next(0, cur)) return;
    f32x4 acc[2][2][4][2];
#pragma unroll
    for (int a = 0; a < 2; ++a)
#pragma unroll
        for (int b = 0; b < 2; ++b)
#pragma unroll
            for (int m = 0; m < 4; ++m)
#pragma unroll
                for (int n = 0; n < 2; ++n) acc[a][b][m][n] = (f32x4){0.f, 0.f, 0.f, 0.f};
    bf16x8 At[4][2], B0[2][2], B1[2][2];
    const char* cA = (const char*)g.A + (size_t)cur.pm * tstep; const char* cB = (const char*)g.Bt + (size_t)cur.pn * tstep;
    S.a_ready(cur);
    if constexpr (SP2) {
        PG8_STAGE(PG8_SB(0, 0), cB, voffB); PG8_STAGE(PG8_SB(0, 1), cB + hstep, voffB); PG8_STAGE(PG8_SA(0, 0), cA, voffA); PG8_STAGE(PG8_SA(0, 1), cA + hstep, voffA);
        if (wr == 1) PG8_BAR;
        PG8_WAIT_V(2); PG8_BAR;
        PG8_STAGE(PG8_SB(1, 0), cB + kstep, voffB); PG8_STAGE(PG8_SA(1, 0), cA + kstep, voffA); PG8_STAGE(PG8_SB(1, 1), cB + hstep + kstep, voffB);
        PG8_WAIT_V(6); PG8_BAR;
    } else {
        PG8_STAGE(PG8_SB(0, 0), cB, voffB); PG8_STAGE(PG8_SA(0, 0), cA, voffA); PG8_STAGE(PG8_SB(0, 1), cB + hstep, voffB); PG8_STAGE(PG8_SA(0, 1), cA + hstep, voffA);
        if (wr == 1) PG8_BAR;
        PG8_WAIT_V(4); PG8_BAR;
        PG8_STAGE(PG8_SB(1, 0), cB + kstep, voffB); PG8_STAGE(PG8_SA(1, 0), cA + kstep, voffA); PG8_STAGE(PG8_SB(1, 1), cB + hstep + kstep, voffB);
        PG8_WAIT_V(6); PG8_BAR;
    }
    for (;;) {
        const bool has_next = S.next(ui + 1, nxt);
        const char* nA = has_next ? (const char*)g.A + (size_t)nxt.pm * tstep : cA; const char* nB = has_next ? (const char*)g.Bt + (size_t)nxt.pn * tstep : cB;
        for (int t = 0; t < nt; t += 2) {
            const bool last = (t == nt - 2);
            const char* a1 = cA + (size_t)(t + 1) * kstep;
            const char* a2 = last ? nA : cA + (size_t)(t + 2) * kstep; const char* b2 = last ? nB : cB + (size_t)(t + 2) * kstep;
            const char* a3 = a2 + kstep; const char* b3 = b2 + kstep;
            if (last && has_next) S.a_ready(nxt);
            if constexpr (SP2) {
            PG8_LDB(B0, 0, 0); PG8_LDB(B1, 0, 1); PG8_SCHED; PG8_LDA(At, 0, 0); PG8_STAGE(PG8_SA(1, 1), a1 + hstep, voffA);
            PG8_WAIT_V(8); PG8_WAIT_L(0); PG8_BAR; PG8_MMA(0, 0, At, B0); PG8_MMA(0, 1, At, B1); PG8_BAR; PG8_SCHED;
            PG8_LDA(At, 0, 1); PG8_STAGE(PG8_SB(0, 0), b2, voffB); PG8_STAGE(PG8_SB(0, 1), b2 + hstep, voffB); PG8_STAGE(PG8_SA(0, 0), a2, voffA);
            PG8_WAIT_V(8); PG8_WAIT_L(0); PG8_BAR; PG8_MMA(1, 0, At, B0); PG8_MMA(1, 1, At, B1); PG8_BAR; PG8_SCHED;
            PG8_LDB(B0, 1, 0); PG8_LDB(B1, 1, 1); PG8_SCHED; PG8_LDA(At, 1, 0); PG8_STAGE(PG8_SA(0, 1), a2 + hstep, voffA);
            PG8_WAIT_V(8); PG8_WAIT_L(0); PG8_BAR; PG8_MMA(0, 0, At, B0); PG8_MMA(0, 1, At, B1); PG8_BAR; PG8_SCHED;
            PG8_LDA(At, 1, 1); PG8_STAGE(PG8_SB(1, 0), b3, voffB); PG8_STAGE(PG8_SB(1, 1), b3 + hstep, voffB); PG8_STAGE(PG8_SA(1, 0), a3, voffA);
            PG8_WAIT_V(8); PG8_WAIT_L(0); PG8_BAR; PG8_MMA(1, 0, At, B0); PG8_MMA(1, 1, At, B1); PG8_BAR; PG8_SCHED;
            } else {
            PG8_LDB(B0, 0, 0); PG8_SCHED; PG8_LDA(At, 0, 0); PG8_STAGE(PG8_SA(1, 1), a1 + hstep, voffA);
            PG8_WAIT_L(8); PG8_BAR; PG8_WAIT_L(0); PG8_MMA(0, 0, At, B0); PG8_BAR; PG8_SCHED;
            PG8_LDB(B1, 0, 1); PG8_STAGE(PG8_SB(0, 0), b2, voffB);
            PG8_BAR; PG8_WAIT_L(0); PG8_MMA(0, 1, At, B1); PG8_BAR;
            PG8_LDA(At, 0, 1); PG8_STAGE(PG8_SA(0, 0), a2, voffA);
            PG8_BAR; PG8_WAIT_L(0); PG8_MMA(1, 0, At, B0); PG8_BAR; PG8_SCHED;
            PG8_STAGE(PG8_SB(0, 1), b2 + hstep, voffB);
            PG8_WAIT_V(6); PG8_BAR; PG8_MMA(1, 1, At, B1); PG8_BAR;
            PG8_LDB(B0, 1, 0); PG8_SCHED; PG8_LDA(At, 1, 0); PG8_STAGE(PG8_SA(0, 1), a2 + hstep, voffA);
            PG8_WAIT_L(8); PG8_BAR; PG8_WAIT_L(0); PG8_MMA(0, 0, At, B0); PG8_BAR; PG8_SCHED;
            PG8_LDB(B1, 1, 1); PG8_STAGE(PG8_SB(1, 0), b3, voffB);
            PG8_BAR; PG8_WAIT_L(0); PG8_MMA(0, 1, At, B1); PG8_BAR;
            PG8_LDA(At, 1, 1); PG8_STAGE(PG8_SA(1, 0), a3, voffA);
            PG8_BAR; PG8_WAIT_L(0); PG8_MMA(1, 0, At, B0); PG8_BAR; PG8_SCHED;
            PG8_STAGE(PG8_SB(1, 1), b3 + hstep, voffB);
            PG8_WAIT_V(6); PG8_BAR; PG8_MMA(1, 1, At, B1); PG8_BAR;
            }
        }
        if constexpr (ALIGN_EPI) { if (wr == 0) PG8_BAR; }
        if constexpr (!Epi::AFTER_DRAIN) { E(acc, cur, wr, wc, fr, fq); S.done(cur); }
        if (!has_next) break;
#pragma unroll
        for (int a = 0; a < 2; ++a)
#pragma unroll
            for (int b = 0; b < 2; ++b)
#pragma unroll
                for (int m = 0; m < 4; ++m)
#pragma unroll
                    for (int n = 0; n < 2; ++n) acc[a][b][m][n] = (f32x4){0.f, 0.f, 0.f, 0.f};
        cur = nxt; cA = nA; cB = nB; ++ui;
        if constexpr (ALIGN_EPI) { if (wr == 1) PG8_BAR; }
    }
    PG8_WAIT_V(0);
    if constexpr (!ALIGN_EPI) { if (wr == 0) PG8_BAR; }
    PG8_BAR;
    if constexpr (Epi::AFTER_DRAIN) { E.fused(acc, cur, wr, wc, fr, fq, lds, wid, lane); S.done(cur); }
#undef PG8_SA
#undef PG8_SB
#undef PG8_STAGE
#undef PG8_LDA
#undef PG8_LDB
#undef PG8_MMA
#undef PG8_WAIT_V
#undef PG8_WAIT_L
#undef PG8_BAR
#undef PG8_SCHED
}
}
#define GAS __attribute__((address_space(1)))
#define LAS __attribute__((address_space(3)))
typedef unsigned short bf16;
typedef unsigned v4u __attribute__((ext_vector_type(4)));
typedef float f32x4 __attribute__((ext_vector_type(4)));
typedef short bf16x8 __attribute__((ext_vector_type(8)));
typedef GAS unsigned gu32;
typedef GAS unsigned long long gu64;
#define RLX_AGENT __ATOMIC_RELAXED, __HIP_MEMORY_SCOPE_AGENT
#define LDS_WAIT() asm volatile("s_waitcnt lgkmcnt(0)" ::: "memory")
#define VM_WAIT() asm volatile("s_waitcnt vmcnt(0)" ::: "memory")
__device__ __forceinline__ unsigned long long rt() { return __builtin_amdgcn_s_memrealtime(); }
__device__ __forceinline__ unsigned f2bf(float f) { unsigned u = __builtin_bit_cast(unsigned, f); return (u + 0x7fffu + ((u >> 16) & 1u)) >> 16; }
__device__ __forceinline__ unsigned pk2(float lo, float hi) { return f2bf(lo) | (f2bf(hi) << 16); }

#define XB_TMO      128
#define XB_XCNT(j)  (256  + 64 * (j))
#define XB_XSUB(j)  (1280 + 64 * (j))
#define XB_XGEN(j)  (2304 + 64 * (j))
#define XB_TOP      3328
#define XB_TOPGEN   3392
#define XCD_BAR_WORDS 3456
#define XB_SPIN_CAP (1u << 18)

__device__ __forceinline__ unsigned xb_ld(unsigned* p)              { return __hip_atomic_load(p, __ATOMIC_RELAXED, __HIP_MEMORY_SCOPE_AGENT); }
__device__ __forceinline__ unsigned xb_add(unsigned* p, unsigned v) { return __hip_atomic_fetch_add(p, v, __ATOMIC_RELAXED, __HIP_MEMORY_SCOPE_AGENT); }
__device__ __forceinline__ unsigned xb_xcc_id() { return (unsigned)__builtin_amdgcn_s_getreg((3 << 11) | 20) & 0xFu; }
#define XB_SPIN(cond, bar) do { unsigned _sp = 0; while (cond) { __builtin_amdgcn_s_sleep(1); \
    if ((++_sp & 255u) == 0u) { if (xb_ld(&(bar)[XB_TMO])) break; if (_sp > XB_SPIN_CAP) { atomicAdd(&(bar)[XB_TMO], 1u); break; } } } } while (0)

struct XcdBarrier {
    unsigned* bar; unsigned x;
    volatile LAS unsigned* st;
};

__device__ __forceinline__ XcdBarrier xcd_barrier_post(unsigned* bar, volatile LAS unsigned* st) {
    XcdBarrier b; b.bar = bar; b.x = xb_xcc_id(); b.st = st;
    if (threadIdx.x == 0) (void)xb_add(&bar[XB_XCNT(b.x)], 1u);
    return b;
}
__device__ __forceinline__ void xcd_barrier_complete(unsigned* bar, unsigned x, unsigned& nloc, unsigned& nx) {
    const unsigned G = gridDim.x * gridDim.y * gridDim.z;
    unsigned sum, cnt, mine, sp = 0u;
    for (;;) {
        sum = 0u; cnt = 0u; mine = 0u;
#pragma unroll
        for (unsigned j = 0; j < 16; ++j) { const unsigned c = xb_ld(&bar[XB_XCNT(j)]); sum += c; cnt += (c > 0u) ? 1u : 0u; mine = (j == x) ? c : mine; }
        if (sum == G) break;
        __builtin_amdgcn_s_sleep(1);
        if ((++sp & 255u) == 0u) { if (xb_ld(&bar[XB_TMO])) break; if (sp > XB_SPIN_CAP) { atomicAdd(&bar[XB_TMO], 1u); break; } }
    }
    nloc = mine > 0u ? mine : 1u; nx = cnt > 0u ? cnt : 1u;
}

__device__ __forceinline__ void xcd_barrier(const XcdBarrier& b) {
    asm volatile("s_waitcnt vmcnt(0)" ::: "memory");
    __syncthreads();
    if (threadIdx.x == 0) {
        unsigned* bar = b.bar;
        __builtin_amdgcn_s_waitcnt(0);
        unsigned nloc = b.st[0], nx = b.st[1];
        if (nloc == 0u) { xcd_barrier_complete(bar, b.x, nloc, nx); b.st[0] = nloc; b.st[1] = nx; }
        const unsigned old = xb_add(&bar[XB_XSUB(b.x)], 1u);
        const unsigned gen = old / nloc;
        if (old + 1u == (gen + 1u) * nloc) {
            __builtin_amdgcn_fence(__ATOMIC_RELEASE, "agent");
            asm volatile("s_waitcnt vmcnt(0)" ::: "memory");
            const unsigned og = xb_add(&bar[XB_TOP], 1u);
            const unsigned tg = og / nx;
            if (og + 1u == (tg + 1u) * nx) xb_add(&bar[XB_TOPGEN], 1u);
            else XB_SPIN(xb_ld(&bar[XB_TOPGEN]) == tg, bar);
            __builtin_amdgcn_fence(__ATOMIC_ACQUIRE, "agent");
            xb_add(&bar[XB_XGEN(b.x)], 1u);
            asm volatile("s_waitcnt vmcnt(0)" ::: "memory");
        } else {
            XB_SPIN(xb_ld(&bar[XB_XGEN(b.x)]) == gen, bar);
            __builtin_amdgcn_fence(__ATOMIC_ACQUIRE, "agent");
            asm volatile("s_waitcnt vmcnt(0)" ::: "memory");
        }
    }
    __syncthreads();
}
constexpr int NWAVES = 8;
constexpr int D = 1024, BATCH = 8, SEQ = 2048, T = BATCH * SEQ;
constexpr int AW = 512, RW = 512, NH = 8;
constexpr int DL = 64, AL = 64, GL = 128;
constexpr int SHIFTW = 3 * RW + DL + AL + GL;
constexpr int INW = 3 * AW + SHIFTW;
constexpr int NKEYS = 128, PH = 8, PKD = 256, TOPK = 16, HK = PH * TOPK;
constexpr int QW = PH * PKD;
constexpr int MODW = 6 * D;

constexpr size_t MiB = 1u << 20;
constexpr size_t WS_CTL = 0, CTL_ZERO_BYTES = 1 * MiB + 256 * 1024;
constexpr size_t WS_MOD = 1 * MiB;
constexpr size_t WS_KEYS = 1 * MiB + 512 * 1024;
constexpr size_t WS_WIN = 2 * MiB;
constexpr size_t WS_WOUT = 9 * MiB;
constexpr size_t WS_WQ = 11 * MiB;
constexpr size_t WS_XN = 16 * MiB;
constexpr size_t WS_O3 = 16 * MiB;
constexpr size_t WS_LSE = 32 * MiB;
constexpr size_t WS_Z = 48 * MiB;
constexpr size_t WS_MIX = 152 * MiB;
constexpr size_t WS_Y = 184 * MiB;
constexpr size_t WS_Q = 48 * MiB;
constexpr size_t WS_IDX = 112 * MiB;
constexpr size_t WS_GATE = 120 * MiB;
constexpr size_t WS_PART = 48 * MiB;
constexpr size_t WS_XQ = 128 * MiB;
constexpr size_t WS_UT = 216 * MiB;
constexpr size_t WS_SU = 249 * MiB;
constexpr size_t WS_VT = 232 * MiB;
constexpr size_t WS_BON = 248 * MiB;
constexpr size_t WS_END = 250 * MiB;
constexpr int CW_WORK = 1024;
constexpr int CW_WORK2 = 2048;
constexpr int CW_BAR = 4096;
constexpr int MAX_LAUNCHES = 12;

constexpr int RING_OFF = 0, RING_BYTES = 139264;
constexpr int LDSCTL_OFF = RING_BYTES, MISC_OFF = LDSCTL_OFF + 320;
constexpr int LDS_BYTES = 147456;
static_assert(MISC_OFF + 128 <= LDS_BYTES, "LDS map");

typedef GAS float gf32;
typedef GAS f32x4 gf32x4;

__device__ __forceinline__ float bf2f(bf16 v) { return __uint_as_float(((unsigned)v) << 16); }
__device__ __forceinline__ float wave_sum(float v) {
#pragma unroll
    for (int o = 1; o < 64; o <<= 1) v += __shfl_xor(v, o);
    return v;
}
#define WAVE_LDS_SYNC() do { asm volatile("s_waitcnt lgkmcnt(0)" ::: "memory"); __builtin_amdgcn_wave_barrier(); } while (0)

__device__ __forceinline__ void p0_transpose_item(const float* W, int K, int N, bf16* WT, int row_off, LAS float* scr, int item, int lane) {
    const int nblk = N / 32, kb = item / nblk, nb = item % nblk, k0 = 64 * kb, n0 = 32 * nb;
#pragma unroll 8
    for (int i = 0; i < 32; ++i) { const int kk = 2 * i + (lane >> 5); scr[kk * 33 + (lane & 31)] = W[(size_t)(k0 + kk) * N + n0 + (lane & 31)]; }
    LDS_WAIT(); asm volatile("" ::: "memory");
    const int c = lane & 7;
#pragma unroll
    for (int j = 0; j < 4; ++j) { const int n = (lane >> 3) + 8 * j; const LAS float* s = scr + (8 * c) * 33 + n;
        v4u o; o.x = pk2(s[0 * 33], s[1 * 33]); o.y = pk2(s[2 * 33], s[3 * 33]); o.z = pk2(s[4 * 33], s[5 * 33]); o.w = pk2(s[6 * 33], s[7 * 33]);
        *(GAS v4u*)(WT + (size_t)(row_off + n0 + n) * K + k0 + 8 * c) = o; }
    LDS_WAIT(); asm volatile("" ::: "memory");
}

__device__ __forceinline__ void norm_rows(const float* x, const float* g, const float* mod, int shift_off, int scale_off, bf16* o, int gw, int ngw, int lane) {
    f32x4 nx[4];
    if (gw < T) {
#pragma unroll
        for (int j = 0; j < 4; ++j) nx[j] = ((const GAS f32x4*)(x + (size_t)gw * D) + lane)[64 * j]; }
    for (int m = gw; m < T; m += ngw) {
        f32x4 v[4]; float s = 0.f;
#pragma unroll
        for (int j = 0; j < 4; ++j) { v[j] = nx[j]; s += (v[j].x * v[j].x + v[j].y * v[j].y) + (v[j].z * v[j].z + v[j].w * v[j].w); }
        if (m + ngw < T) {
#pragma unroll
            for (int j = 0; j < 4; ++j) nx[j] = ((const GAS f32x4*)(x + (size_t)(m + ngw) * D) + lane)[64 * j]; }
        const float* modb = mod + (m / SEQ) * MODW;
        const float rs = 1.0f / sqrtf(wave_sum(s) * (1.f / D) + 1e-6f);
        GAS unsigned long long* o8 = (GAS unsigned long long*)(o + (size_t)m * D) + lane;
#pragma unroll
        for (int j = 0; j < 4; ++j) {
            const int col = 256 * j + 4 * lane;
            const f32x4 g4 = *(const GAS f32x4*)(g + col), sc = *(const GAS f32x4*)(modb + scale_off + col), sh = *(const GAS f32x4*)(modb + shift_off + col);
            const f32x4 y = v[j] * rs * g4 * (sc + 1.0f) + sh;
            o8[64 * j] = (unsigned long long)pk2(y.x, y.y) | ((unsigned long long)pk2(y.z, y.w) << 32);
        }
    }
}
__device__ __forceinline__ void norm_rows_q(const float* x, const float* g, const float* mod, int shift_off, int scale_off, bf16* o, unsigned char* q, float* qscale, int gw, int ngw, int lane) {
    f32x4 nx[4];
    if (gw < T) {
#pragma unroll
        for (int j = 0; j < 4; ++j) nx[j] = ((const GAS f32x4*)(x + (size_t)gw * D) + lane)[64 * j]; }
    for (int m = gw; m < T; m += ngw) {
        f32x4 v[4]; float s = 0.f;
#pragma unroll
        for (int j = 0; j < 4; ++j) { v[j] = nx[j]; s += (v[j].x * v[j].x + v[j].y * v[j].y) + (v[j].z * v[j].z + v[j].w * v[j].w); }
        if (m + ngw < T) {
#pragma unroll
            for (int j = 0; j < 4; ++j) nx[j] = ((const GAS f32x4*)(x + (size_t)(m + ngw) * D) + lane)[64 * j]; }
        const float* modb = mod + (m / SEQ) * MODW;
        const float rs = 1.0f / sqrtf(wave_sum(s) * (1.f / D) + 1e-6f);
        GAS unsigned long long* o8 = (GAS unsigned long long*)(o + (size_t)m * D) + lane;
        float mx = 0.f;
#pragma unroll
        for (int j = 0; j < 4; ++j) {
            const int col = 256 * j + 4 * lane;
            const f32x4 g4 = *(const GAS f32x4*)(g + col), sc = *(const GAS f32x4*)(modb + scale_off + col), sh = *(const GAS f32x4*)(modb + shift_off + col);
            const f32x4 y = v[j] * rs * g4 * (sc + 1.0f) + sh;
            v[j] = y; mx = fmaxf(mx, fmaxf(fmaxf(fabsf(y.x), fabsf(y.y)), fmaxf(fabsf(y.z), fabsf(y.w))));
            o8[64 * j] = (unsigned long long)pk2(y.x, y.y) | ((unsigned long long)pk2(y.z, y.w) << 32);
        }
#pragma unroll
        for (int oo = 1; oo < 64; oo <<= 1) mx = fmaxf(mx, __shfl_xor(mx, oo));
        mx = fmaxf(mx, 1e-30f);
        const float inv = 127.0f / mx;
#pragma unroll
        for (int j = 0; j < 4; ++j) {
            const int ia = (int)rintf(v[j].x * inv), ib = (int)rintf(v[j].y * inv), ic = (int)rintf(v[j].z * inv), id = (int)rintf(v[j].w * inv);
            *(GAS unsigned*)(q + (size_t)m * D + 256 * j + 4 * lane) = (unsigned)(ia & 0xff) | ((unsigned)(ib & 0xff) << 8) | ((unsigned)(ic & 0xff) << 16) | ((unsigned)id << 24);
        }
        if (lane == 0) qscale[m] = mx * (1.0f / 127.0f);
    }
}

struct EpiRes {
    static constexpr bool PERM = false, AFTER_DRAIN = false;
    const float* xres; const float* mod; int gate_off; float* out; int ldc;
    __device__ __forceinline__ void operator()(const pg8::f32x4 (&acc)[2][2][4][2], const pg8::Unit& u, int wr, int wc, int fr, int fq) const {
        const int col0 = u.pn * pg8::BM + wc * 32 + 4 * fq;
        const int b = (u.pm * pg8::BM) / SEQ;
        pg8::f32x4 gv[2][2];
#pragma unroll
        for (int bj = 0; bj < 2; ++bj)
#pragma unroll
            for (int n = 0; n < 2; ++n) gv[bj][n] = *(const pg8::f32x4*)(mod + b * MODW + gate_off + col0 + bj * pg8::HALF + n * 16);
#pragma unroll
        for (int ai = 0; ai < 2; ++ai)
#pragma unroll
            for (int m = 0; m < 4; ++m) { const size_t off = (size_t)(u.pm * pg8::BM + ai * pg8::HALF + wr * 64 + m * 16 + fr) * ldc + col0;
#pragma unroll
                for (int bj = 0; bj < 2; ++bj)
#pragma unroll
                    for (int n = 0; n < 2; ++n) { const pg8::f32x4 bs = *(const pg8::f32x4*)(xres + off + bj * pg8::HALF + n * 16);
                        *(pg8::f32x4*)(out + off + bj * pg8::HALF + n * 16) = bs + gv[bj][n] * acc[ai][bj][m][n]; } }
    }
};

namespace scan {
typedef unsigned u32x2 __attribute__((ext_vector_type(2)));
constexpr int SLOT = 1024, BUF_BYTES = 12800, NBUF = 8;
constexpr int OFF_LORA = NBUF * BUF_BYTES;
constexpr int OFF_CONST = OFF_LORA + 16 * SLOT;
constexpr int OFF_MT = OFF_CONST + 5120;
constexpr int SCAN_LDS = OFF_MT + 8 * 1024;
static_assert(SCAN_LDS <= 139264, "scan LDS map");
constexpr int S_KK = 0, S_R = 2, S_MT = 4, S_N = 5, S_BK = 6, S_V = 10, S_GC = 12;

typedef float f32x2n __attribute__((ext_vector_type(2)));
typedef __bf16 bf16x2n __attribute__((ext_vector_type(2)));
__device__ __forceinline__ unsigned cvtpk(float lo, float hi) { const f32x2n v = {lo, hi}; const bf16x2n b = __builtin_convertvector(v, bf16x2n); return __builtin_bit_cast(unsigned, b); }
__device__ __forceinline__ bf16x8 mkfrag(unsigned a, unsigned b, unsigned c, unsigned d) { v4u w; w.x = a; w.y = b; w.z = c; w.w = d; return __builtin_bit_cast(bf16x8, w); }
__device__ __forceinline__ bf16x8 frag8(const float (&lo)[4], const float (&hi)[4]) { return mkfrag(cvtpk(lo[0], lo[1]), cvtpk(lo[2], lo[3]), cvtpk(hi[0], hi[1]), cvtpk(hi[2], hi[3])); }
__device__ __forceinline__ f32x4 mma(bf16x8 a, bf16x8 b, f32x4 c) { return __builtin_amdgcn_mfma_f32_16x16x32_bf16(a, b, c, 0, 0, 0); }
template <int N> __device__ __forceinline__ float row_shr(float x) { return __int_as_float(__builtin_amdgcn_update_dpp(0, __float_as_int(x), 0x110 + N, 0xf, 0xf, true)); }
__device__ __forceinline__ float fsigmoid(float x) { return __builtin_amdgcn_rcpf(1.0f + __expf(-x)); }
__device__ __forceinline__ bf16 tobf(float x) { return (bf16)(cvtpk(x, x) & 0xffffu); }

__device__ __forceinline__ void setup(LAS unsigned char* L, int h, int dir, const float* mu_prev, const float* mu_next, const float* w_decay0, const float* w_decay_up,
                                      const float* a_gate0, const float* a_gate_up, const float* k_k, const float* k_a, const float* r_k, int tid) {
    LAS float* C = (LAS float*)(L + OFF_CONST);
    for (int i = tid; i < 320; i += 512) {
        const int grp = i >> 6, c = i & 63;
        const int col = (grp < 3) ? grp * RW + h * 64 + c : 3 * RW + (grp - 3) * 64 + c;
        C[i] = mu_prev[col]; C[320 + i] = mu_next[col]; C[960 + i] = 1.0f - mu_prev[col] - mu_next[col];
    }
    if (tid < 64) { const int hc = h * 64 + tid; C[640 + tid] = w_decay0[dir * RW + hc]; C[704 + tid] = a_gate0[dir * RW + hc]; C[768 + tid] = k_k[hc]; C[832 + tid] = k_a[hc]; C[896 + tid] = r_k[hc]; }
    LAS bf16* F = (LAS bf16*)(L + OFF_LORA);
    for (int i = tid; i < 16 * 64 * 8; i += 512) {
        const int j = i & 7, l = (i >> 3) & 63, sl = i >> 9, m = sl & 1, ct = (sl >> 1) & 3, wa = sl >> 3;
        const int g = l >> 4, jj = 32 * m + (j < 4 ? 4 * g + j : 16 + 4 * g + j - 4), c = h * 64 + 16 * ct + (l & 15);
        const float v = wa ? a_gate_up[(size_t)(dir * AL + jj) * RW + c] : w_decay_up[(size_t)(dir * DL + jj) * RW + c];
        F[i] = (bf16)f2bf(v);
    }
}

__device__ __forceinline__ void helper_chunk(LAS unsigned char* L, LAS unsigned char* buf, LAS float* MT, const bf16* Z, float* BON, int b, int h, int dir, int n, int lane) {
    const int s = lane & 15, g = lane >> 4;
    const int cn = dir ? (SEQ / 16 - 1 - n) : n;
    const int t = cn * 16 + (dir ? 15 - s : s), tok = b * SEQ + t;
    const LAS float* C = (const LAS float*)(L + OFF_CONST);
    const bool hasp = t > 0, hasn = t < SEQ - 1;
    float rv[4][4], kv[4][4], vv[4][4], tw[4][4], xa[4][4];
    constexpr int SROW = 136, SGRP = 18 * SROW;
    {
        v4u ld[12];
#pragma unroll
        for (int i = 0; i < 12; ++i) {
            int p = 8 * i + (lane >> 3); p = p < 90 ? p : 89;
            const int grp = p / 18, row = p - 18 * grp;
            const int st = (row < 16) ? row : (row == 16 ? -1 : 16);
            int tt = cn * 16 + (dir ? 15 - st : st); tt = tt < 0 ? 0 : (tt > SEQ - 1 ? SEQ - 1 : tt);
            const int cbase = (grp < 3) ? grp * RW + h * 64 : 3 * RW + (grp - 3) * 64;
            ld[i] = *(const v4u*)(Z + (size_t)(b * SEQ + tt) * INW + 3 * AW + cbase + 8 * (lane & 7));
        }
#pragma unroll
        for (int i = 0; i < 12; ++i) {
            int p = 8 * i + (lane >> 3); p = p < 90 ? p : 89;
            const int grp = p / 18, row = p - 18 * grp;
            LAS unsigned char* q = buf + grp * SGRP + row * SROW + 16 * (lane & 7);
            *(LAS u32x2*)q = (u32x2){ld[i].x, ld[i].y}; *(LAS u32x2*)(q + 8) = (u32x2){ld[i].z, ld[i].w};
        }
    }
    asm volatile("s_waitcnt lgkmcnt(0)" ::: "memory"); __builtin_amdgcn_wave_barrier();
    {
        const int rlo = (s == 0) ? 16 : s - 1, rup = (s == 15) ? 17 : s + 1;
        const int rp = dir ? rup : rlo, rn = dir ? rlo : rup;
        typedef float f32x2s __attribute__((ext_vector_type(2)));
        const unsigned pmask = hasp ? 0xffffffffu : 0u, nmask = hasn ? 0xffffffffu : 0u;
#pragma unroll
        for (int grp = 0; grp < 5; ++grp) {
#pragma unroll
            for (int ct = 0; ct < 4; ++ct) {
                const LAS unsigned char* q = buf + grp * SGRP + 32 * ct + 8 * g;
                const u32x2 zcc = *(const LAS u32x2*)(q + s * SROW);
                u32x2 zp = *(const LAS u32x2*)(q + rp * SROW), zn = *(const LAS u32x2*)(q + rn * SROW);
                zp.x &= pmask; zp.y &= pmask; zn.x &= nmask; zn.y &= nmask;
                const f32x4 mp = *(const LAS f32x4*)(C + grp * 64 + 16 * ct + 4 * g), mn = *(const LAS f32x4*)(C + 320 + grp * 64 + 16 * ct + 4 * g), mc = *(const LAS f32x4*)(C + 960 + grp * 64 + 16 * ct + 4 * g);
                const f32x2s z01 = {__uint_as_float(zcc.x << 16), __uint_as_float(zcc.x & 0xffff0000u)}, z23 = {__uint_as_float(zcc.y << 16), __uint_as_float(zcc.y & 0xffff0000u)};
                const f32x2s p01 = {__uint_as_float(zp.x << 16), __uint_as_float(zp.x & 0xffff0000u)}, p23 = {__uint_as_float(zp.y << 16), __uint_as_float(zp.y & 0xffff0000u)};
                const f32x2s n01 = {__uint_as_float(zn.x << 16), __uint_as_float(zn.x & 0xffff0000u)}, n23 = {__uint_as_float(zn.y << 16), __uint_as_float(zn.y & 0xffff0000u)};
                const f32x2s o01 = (f32x2s){mc[0], mc[1]} * z01 + (f32x2s){mp[0], mp[1]} * p01 + (f32x2s){mn[0], mn[1]} * n01;
                const f32x2s o23 = (f32x2s){mc[2], mc[3]} * z23 + (f32x2s){mp[2], mp[3]} * p23 + (f32x2s){mn[2], mn[3]} * n23;
                const float ov[4] = {o01.x, o01.y, o23.x, o23.y};
#pragma unroll
                for (int r = 0; r < 4; ++r) {
                    const float o = ov[r];
                    if (grp == 0) rv[ct][r] = o; else if (grp == 1) kv[ct][r] = o; else if (grp == 2) vv[ct][r] = o;
                    else if (grp == 3) { const float e2 = __expf(2.0f * o); tw[ct][r] = 1.0f - 2.0f * __builtin_amdgcn_rcpf(e2 + 1.0f); } else xa[ct][r] = o;
                }
            }
            __builtin_amdgcn_sched_barrier(0);
        }
    }
    asm volatile("s_waitcnt lgkmcnt(0)" ::: "memory"); __builtin_amdgcn_wave_barrier();
#pragma unroll
    for (int ct = 0; ct < 4; ++ct)
#pragma unroll
        for (int r = 0; r < 4; ++r)
            *(LAS bf16*)(buf + (S_V + (ct >> 1)) * SLOT + (4 * g + r + 16 * (s >> 2)) * 16 + (ct & 1) * 8 + 2 * (s & 3)) = tobf(vv[ct][r]);
    f32x4 accw[4], acca[4];
    { const bf16x8 tb0 = frag8(tw[0], tw[1]), tb1 = frag8(tw[2], tw[3]), xb0 = frag8(xa[0], xa[1]), xb1 = frag8(xa[2], xa[3]);
      const LAS bf16x8* F = (const LAS bf16x8*)(L + OFF_LORA);
#pragma unroll
      for (int ct = 0; ct < 4; ++ct) {
          f32x4 z4 = {0.f, 0.f, 0.f, 0.f};
          accw[ct] = mma(F[(0 * 8 + ct * 2 + 0) * 64 + lane], tb0, z4); accw[ct] = mma(F[(0 * 8 + ct * 2 + 1) * 64 + lane], tb1, accw[ct]);
          acca[ct] = mma(F[(1 * 8 + ct * 2 + 0) * 64 + lane], xb0, z4); acca[ct] = mma(F[(1 * 8 + ct * 2 + 1) * 64 + lane], xb1, acca[ct]);
      } }
    float ev[4][4], kk[4][4], kd[4][4], bb[4][4];
    float ss = 0.f, bon = 0.f;
#pragma unroll
    for (int ct = 0; ct < 4; ++ct) {
        const f32x4 w0 = *(const LAS f32x4*)(C + 640 + 16 * ct + 4 * g), a0 = *(const LAS f32x4*)(C + 704 + 16 * ct + 4 * g), kkw = *(const LAS f32x4*)(C + 768 + 16 * ct + 4 * g),
                    kaw = *(const LAS f32x4*)(C + 832 + 16 * ct + 4 * g), rkw = *(const LAS f32x4*)(C + 896 + 16 * ct + 4 * g);
#pragma unroll
        for (int r = 0; r < 4; ++r) {
            ev[ct][r] = 0.60653065971f * fsigmoid(accw[ct][r] + w0[r]);
            const float a = fsigmoid(acca[ct][r] + a0[r]);
            const float k = kv[ct][r];
            kk[ct][r] = k * kkw[r]; ss += kk[ct][r] * kk[ct][r];
            kd[ct][r] = k * (1.0f + (a - 1.0f) * kaw[r]);
            bb[ct][r] = a;
            bon += rv[ct][r] * k * a * kaw[r] * rkw[r];
        }
        __builtin_amdgcn_sched_barrier(0);
    }
    ss += __shfl_xor(ss, 16); ss += __shfl_xor(ss, 32);
    bon += __shfl_xor(bon, 16); bon += __shfl_xor(bon, 32);
    if (g == 0) BON[((size_t)dir * T + tok) * NH + h] = bon;
    const float rn = __builtin_amdgcn_rsqf(fmaxf(ss, 1e-12f));
    bf16x8 fKKm[2], fRm[2], fBm[2], fKm[2];
#pragma unroll
    for (int m = 0; m < 2; ++m) {
        float KKs[2][4], Rs[2][4], Bt[2][4], Kt[2][4];
#pragma unroll
        for (int c2 = 0; c2 < 2; ++c2) {
            const int ct = 2 * m + c2;
            float gcv[4];
#pragma unroll
            for (int r = 0; r < 4; ++r) {
                const float e = ev[ct][r];
                float cum = e;
                cum += row_shr<1>(cum); cum += row_shr<2>(cum); cum += row_shr<4>(cum); cum += row_shr<8>(cum);
                const float cumC = __shfl(cum, (lane & 48) | 15);
                const float kkn = kk[ct][r] * rn, bv = kkn * bb[ct][r];
                const float ig = __expf(cum), gs = __builtin_amdgcn_rcpf(ig), gC = __expf(-cumC), rat = ig * gC;
                KKs[c2][r] = kkn * gs * __expf(e); Rs[c2][r] = rv[ct][r] * gs;
                Bt[c2][r] = bv * ig; Kt[c2][r] = kd[ct][r] * ig;
                gcv[r] = gC;
                LAS unsigned char* q = buf + (S_BK + ct) * SLOT + (4 * g + r + 16 * (s >> 2)) * 16 + 2 * (s & 3);
                *(LAS bf16*)q = tobf(bv * rat); *(LAS bf16*)(q + 8) = tobf(kd[ct][r] * rat);
            }
            if (s == 15) *(LAS f32x4*)(buf + S_GC * SLOT + (16 * ct + 4 * g) * 4) = (f32x4){gcv[0], gcv[1], gcv[2], gcv[3]};
        }
        fKKm[m] = frag8(KKs[0], KKs[1]); fRm[m] = frag8(Rs[0], Rs[1]); fBm[m] = frag8(Bt[0], Bt[1]); fKm[m] = frag8(Kt[0], Kt[1]);
    }
    const bf16x8 fKK0 = fKKm[0], fKK1 = fKKm[1], fR0 = fRm[0], fR1 = fRm[1], fB0 = fBm[0], fB1 = fBm[1], fK0 = fKm[0], fK1 = fKm[1];
    *(LAS bf16x8*)(buf + (S_KK + 0) * SLOT + lane * 16) = fKK0; *(LAS bf16x8*)(buf + (S_KK + 1) * SLOT + lane * 16) = fKK1;
    *(LAS bf16x8*)(buf + (S_R + 0) * SLOT + lane * 16) = fR0;  *(LAS bf16x8*)(buf + (S_R + 1) * SLOT + lane * 16) = fR1;
    const f32x4 z4 = {0.f, 0.f, 0.f, 0.f};
    { f32x4 mab = mma(fKK0, fB0, z4); mab = mma(fKK1, fB1, mab);
      *(LAS f32x4*)(MT + s * 16 + 4 * g) = mab; }
    f32x4 mak = mma(fK0, fKK0, z4); mak = mma(fK1, fKK1, mak);
    f32x4 nrb = mma(fB0, fR0, z4); nrb = mma(fB1, fR1, nrb);
    f32x4 nrk = mma(fK0, fR0, z4); nrk = mma(fK1, fR1, nrk);
#pragma unroll
    for (int r = 0; r < 4; ++r) { const int i = 4 * g + r; if (!(i < s)) mak[r] = 0.f; if (!(i <= s)) { nrb[r] = 0.f; nrk[r] = 0.f; } }
    *(LAS v4u*)(buf + S_N * SLOT + lane * 16) = (v4u){cvtpk(nrb[0], nrb[1]), cvtpk(nrb[2], nrb[3]), cvtpk(nrk[0], nrk[1]), cvtpk(nrk[2], nrk[3])};
    asm volatile("s_waitcnt lgkmcnt(0)" ::: "memory"); __builtin_amdgcn_wave_barrier();
    float Tr[16];
#pragma unroll
    for (int j = 15; j >= 0; --j) {
        float acc0 = 0.f, acc1 = 0.f;
#pragma unroll
        for (int i4 = (j + 1) / 4; i4 < 4; ++i4) {
            const f32x4 mrow = *(const LAS f32x4*)(MT + j * 16 + 4 * i4);
#pragma unroll
            for (int e = 0; e < 4; ++e) { const int i = 4 * i4 + e; if (i > j) { if (e & 1) acc1 += Tr[i] * mrow[e]; else acc0 += Tr[i] * mrow[e]; } }
        }
        Tr[j] = (j == s) ? 1.0f : -(acc0 + acc1);
        if (j > s) Tr[j] = 0.f;
    }
    float t0 = 0.f, t1 = 0.f, t2 = 0.f, t3 = 0.f;
#pragma unroll
    for (int gg = 0; gg < 4; ++gg) if (g == gg) { t0 = Tr[4 * gg]; t1 = Tr[4 * gg + 1]; t2 = Tr[4 * gg + 2]; t3 = Tr[4 * gg + 3]; }
    *(LAS v4u*)(buf + S_MT * SLOT + lane * 16) = (v4u){cvtpk(mak[0], mak[1]), cvtpk(mak[2], mak[3]), cvtpk(-t0, -t1), cvtpk(-t2, -t3)};
    asm volatile("s_waitcnt lgkmcnt(0)" ::: "memory"); __builtin_amdgcn_wave_barrier();
}

__device__ __forceinline__ void rec_chunk(const LAS unsigned char* buf, f32x4 (&st)[4], bf16* Y, int b, int h, int dir, int n, int w, int lane) {
    const int g = lane >> 4, col = lane & 15;
    const bf16x8 fKK0 = *(const LAS bf16x8*)(buf + (S_KK + 0) * SLOT + lane * 16), fKK1 = *(const LAS bf16x8*)(buf + (S_KK + 1) * SLOT + lane * 16);
    const bf16x8 fR0 = *(const LAS bf16x8*)(buf + (S_R + 0) * SLOT + lane * 16), fR1 = *(const LAS bf16x8*)(buf + (S_R + 1) * SLOT + lane * 16);
    const v4u mt = *(const LAS v4u*)(buf + S_MT * SLOT + lane * 16);
    const bf16x8 fN = *(const LAS bf16x8*)(buf + S_N * SLOT + lane * 16);
    const u32x2 vf = *(const LAS u32x2*)(buf + (S_V + (w >> 1)) * SLOT + lane * 16 + (w & 1) * 8);
    const f32x4 z4 = {0.f, 0.f, 0.f, 0.f};
    const bf16x8 sb0 = mkfrag(cvtpk(st[0][0], st[0][1]), cvtpk(st[0][2], st[0][3]), cvtpk(st[1][0], st[1][1]), cvtpk(st[1][2], st[1][3]));
    const bf16x8 sb1 = mkfrag(cvtpk(st[2][0], st[2][1]), cvtpk(st[2][2], st[2][3]), cvtpk(st[3][0], st[3][1]), cvtpk(st[3][2], st[3][3]));
    f32x4 p1 = mma(fKK0, sb0, z4); p1 = mma(fKK1, sb1, p1);
    f32x4 p2 = mma(fR0, sb0, z4); p2 = mma(fR1, sb1, p2);
    const f32x4 x = mma(mkfrag(0u, 0u, mt.x, mt.y), mkfrag(0u, 0u, vf.x, vf.y), p1);
    const f32x4 u = mma(mkfrag(mt.z, mt.w, 0u, 0u), mkfrag(cvtpk(x[0], x[1]), cvtpk(x[2], x[3]), 0u, 0u), z4);
    const bf16x8 buv = mkfrag(cvtpk(u[0], u[1]), cvtpk(u[2], u[3]), vf.x, vf.y);
    const f32x4 y = mma(fN, buv, p2);
#pragma unroll
    for (int i = 0; i < 4; ++i) {
        const f32x4 gc = *(const LAS f32x4*)(buf + S_GC * SLOT + (16 * i + 4 * g) * 4);
        const bf16x8 fBK = *(const LAS bf16x8*)(buf + (S_BK + i) * SLOT + lane * 16);
        st[i] = mma(fBK, buv, st[i] * gc);
    }
    const int cn = dir ? (SEQ / 16 - 1 - n) : n;
#pragma unroll
    for (int r = 0; r < 4; ++r) { const int s = 4 * g + r, t = cn * 16 + (dir ? 15 - s : s);
        Y[((size_t)dir * T + (size_t)(b * SEQ + t)) * RW + h * 64 + 16 * w + col] = tobf(y[r]); }
}

__device__ __forceinline__ void chain(LAS unsigned char* L, const bf16* Z, const float* mu_prev, const float* mu_next, const float* w_decay0, const float* w_decay_up,
                                      const float* a_gate0, const float* a_gate_up, const float* k_k, const float* k_a, const float* r_k, bf16* Y, float* BON, int ch, int tid, int wave, int lane) {
    const int dir = ch & 1, h = (ch >> 1) & 7, b = ch >> 4;
    __syncthreads();
    setup(L, h, dir, mu_prev, mu_next, w_decay0, w_decay_up, a_gate0, a_gate_up, k_k, k_a, r_k, tid);
    __syncthreads();
    f32x4 st[4];
#pragma unroll
    for (int i = 0; i < 4; ++i) st[i] = (f32x4){0.f, 0.f, 0.f, 0.f};
    constexpr int NCH = SEQ / 16, NR = NCH / 8;
    for (int q = 0; q < NR; ++q) {
        helper_chunk(L, L + wave * BUF_BYTES, (LAS float*)(L + OFF_MT + wave * 1024), Z, BON, b, h, dir, 8 * q + wave, lane);
        __syncthreads();
        if (wave < 4) {
#pragma unroll 4
            for (int i = 0; i < 8; ++i) rec_chunk(L + i * BUF_BYTES, st, Y, b, h, dir, 8 * q + i, wave, lane);
        }
        __syncthreads();
    }
}
}

namespace attn {
typedef unsigned u32x2 __attribute__((ext_vector_type(2)));
constexpr int VT_STRIDE = 136;
constexpr int KF_OFF = 64 * VT_STRIDE;
constexpr int WAVE_LDS = KF_OFF + 8 * 1024;
constexpr float LOG2E = 1.44269504088896f, LN2 = 0.693147180559945f;
using scan::cvtpk; using scan::mkfrag; using scan::mma;

__device__ __forceinline__ void unpack8(const v4u w, float (&f)[8]) {
    f[0] = __uint_as_float(w.x << 16); f[1] = __uint_as_float(w.x & 0xffff0000u); f[2] = __uint_as_float(w.y << 16); f[3] = __uint_as_float(w.y & 0xffff0000u);
    f[4] = __uint_as_float(w.z << 16); f[5] = __uint_as_float(w.z & 0xffff0000u); f[6] = __uint_as_float(w.w << 16); f[7] = __uint_as_float(w.w & 0xffff0000u);
}

__device__ __forceinline__ void unit(LAS unsigned char* vt, const bf16* Z, const float* qg, const float* kg, bf16* Ob, int opitch, float* lse_out,
                                     int b, int h, int d, int r, int qb, int nb, int lane) {
    const int g = lane >> 4, c16 = lane & 15;
    const float slope2 = exp2f(-(float)(h + 1)) * LOG2E * (float)d;
    float gn[16];
#pragma unroll
    for (int m = 0; m < 2; ++m)
#pragma unroll
        for (int j = 0; j < 8; ++j) gn[m * 8 + j] = qg[32 * m + 8 * g + j] * kg[32 * m + 8 * g + j];
    bf16x8 qf[4][2];
#pragma unroll
    for (int qt = 0; qt < 4; ++qt) {
        const int tok = b * SEQ + (qb * 64 + 16 * qt + c16) * d + r;
        const bf16* qp = Z + (size_t)tok * INW + h * 64 + 8 * g;
        float f0[8], f1[8]; unpack8(*(const v4u*)qp, f0); unpack8(*(const v4u*)(qp + 32), f1);
        float ss = 0.f;
#pragma unroll
        for (int j = 0; j < 8; ++j) ss += f0[j] * f0[j] + f1[j] * f1[j];
        ss += __shfl_xor(ss, 16); ss += __shfl_xor(ss, 32);
        const float rs = (0.125f * LOG2E) / sqrtf(ss * (1.f / 64.f) + 1e-6f);
        qf[qt][0] = mkfrag(cvtpk(f0[0] * rs * gn[0], f0[1] * rs * gn[1]), cvtpk(f0[2] * rs * gn[2], f0[3] * rs * gn[3]), cvtpk(f0[4] * rs * gn[4], f0[5] * rs * gn[5]), cvtpk(f0[6] * rs * gn[6], f0[7] * rs * gn[7]));
        qf[qt][1] = mkfrag(cvtpk(f1[0] * rs * gn[8], f1[1] * rs * gn[9]), cvtpk(f1[2] * rs * gn[10], f1[3] * rs * gn[11]), cvtpk(f1[4] * rs * gn[12], f1[5] * rs * gn[13]), cvtpk(f1[6] * rs * gn[14], f1[7] * rs * gn[15]));
    }
    f32x4 oacc[4][4];
    float mrun[4], lrun[4];
#pragma unroll
    for (int qt = 0; qt < 4; ++qt) { mrun[qt] = -1e30f; lrun[qt] = 0.f;
#pragma unroll
        for (int dt = 0; dt < 4; ++dt) oacc[dt][qt] = (f32x4){0.f, 0.f, 0.f, 0.f}; }
    const f32x4 z4 = {0.f, 0.f, 0.f, 0.f};
#pragma unroll 1
    for (int kb = qb - 1; kb <= qb + 1; ++kb) {
        if (kb < 0 || kb >= nb) continue;
#pragma unroll
        for (int kblk = 0; kblk < 4; ++kblk) {
            const int tok = b * SEQ + (kb * 64 + 16 * kblk + c16) * d + r;
            const bf16* kp = Z + (size_t)tok * INW + AW + h * 64 + 8 * g;
            float f0[8], f1[8]; unpack8(*(const v4u*)kp, f0); unpack8(*(const v4u*)(kp + 32), f1);
            float ss = 0.f;
#pragma unroll
            for (int j = 0; j < 8; ++j) ss += f0[j] * f0[j] + f1[j] * f1[j];
            ss += __shfl_xor(ss, 16); ss += __shfl_xor(ss, 32);
            const float rsk = 1.0f / sqrtf(ss * (1.f / 64.f) + 1e-6f);
            *(LAS v4u*)(vt + KF_OFF + (kblk * 2 + 0) * 1024 + lane * 16) = (v4u){cvtpk(f0[0] * rsk, f0[1] * rsk), cvtpk(f0[2] * rsk, f0[3] * rsk), cvtpk(f0[4] * rsk, f0[5] * rsk), cvtpk(f0[6] * rsk, f0[7] * rsk)};
            *(LAS v4u*)(vt + KF_OFF + (kblk * 2 + 1) * 1024 + lane * 16) = (v4u){cvtpk(f1[0] * rsk, f1[1] * rsk), cvtpk(f1[2] * rsk, f1[3] * rsk), cvtpk(f1[4] * rsk, f1[5] * rsk), cvtpk(f1[6] * rsk, f1[7] * rsk)};
        }
#pragma unroll
        for (int i = 0; i < 8; ++i) {
            const int key = 8 * i + (lane >> 3), chunk = lane & 7;
            const int tok = b * SEQ + (kb * 64 + key) * d + r;
            const v4u w = *(const v4u*)(Z + (size_t)tok * INW + 2 * AW + h * 64 + 8 * chunk);
            LAS unsigned char* q = vt + (8 * chunk) * VT_STRIDE + 2 * key;
            *(LAS bf16*)(q + 0 * VT_STRIDE) = (bf16)(w.x & 0xffffu); *(LAS bf16*)(q + 1 * VT_STRIDE) = (bf16)(w.x >> 16);
            *(LAS bf16*)(q + 2 * VT_STRIDE) = (bf16)(w.y & 0xffffu); *(LAS bf16*)(q + 3 * VT_STRIDE) = (bf16)(w.y >> 16);
            *(LAS bf16*)(q + 4 * VT_STRIDE) = (bf16)(w.z & 0xffffu); *(LAS bf16*)(q + 5 * VT_STRIDE) = (bf16)(w.z >> 16);
            *(LAS bf16*)(q + 6 * VT_STRIDE) = (bf16)(w.w & 0xffffu); *(LAS bf16*)(q + 7 * VT_STRIDE) = (bf16)(w.w >> 16);
        }
        asm volatile("s_waitcnt lgkmcnt(0)" ::: "memory"); __builtin_amdgcn_wave_barrier();
        f32x4 bias[7];
        {
            const int obase = (kb - qb) * 64 + 4 * g - c16;
#pragma unroll
            for (int dk = 0; dk < 7; ++dk)
#pragma unroll
                for (int reg = 0; reg < 4; ++reg) { const int o = obase + 16 * (dk - 3) + reg, ao = o < 0 ? -o : o; bias[dk][reg] = (ao <= 64) ? -slope2 * (float)ao : -1e30f; }
        }
#pragma unroll
        for (int qt = 0; qt < 4; ++qt) {
            f32x4 sa[4];
#pragma unroll
            for (int kblk = 0; kblk < 4; ++kblk) {
                const bf16x8 k0 = *(const LAS bf16x8*)(vt + KF_OFF + (kblk * 2 + 0) * 1024 + lane * 16), k1 = *(const LAS bf16x8*)(vt + KF_OFF + (kblk * 2 + 1) * 1024 + lane * 16);
                sa[kblk] = mma(k0, qf[qt][0], bias[kblk - qt + 3]); sa[kblk] = mma(k1, qf[qt][1], sa[kblk]); }
            float mx = -1e30f;
#pragma unroll
            for (int kblk = 0; kblk < 4; ++kblk)
#pragma unroll
                for (int reg = 0; reg < 4; ++reg) mx = fmaxf(mx, sa[kblk][reg]);
            mx = fmaxf(mx, __shfl_xor(mx, 16)); mx = fmaxf(mx, __shfl_xor(mx, 32));
            const float mn = fmaxf(mrun[qt], mx), alpha = exp2f(mrun[qt] - mn);
            mrun[qt] = mn;
            float ls = 0.f;
#pragma unroll
            for (int kblk = 0; kblk < 4; ++kblk)
#pragma unroll
                for (int reg = 0; reg < 4; ++reg) { const float p = exp2f(sa[kblk][reg] - mn); sa[kblk][reg] = p; ls += p; }
            lrun[qt] = lrun[qt] * alpha + ls;
            const bf16x8 pf0 = mkfrag(cvtpk(sa[0][0], sa[0][1]), cvtpk(sa[0][2], sa[0][3]), cvtpk(sa[1][0], sa[1][1]), cvtpk(sa[1][2], sa[1][3]));
            const bf16x8 pf1 = mkfrag(cvtpk(sa[2][0], sa[2][1]), cvtpk(sa[2][2], sa[2][3]), cvtpk(sa[3][0], sa[3][1]), cvtpk(sa[3][2], sa[3][3]));
#pragma unroll
            for (int dt = 0; dt < 4; ++dt) {
                const LAS unsigned char* vr = vt + (16 * dt + c16) * VT_STRIDE + 8 * g;
                const u32x2 a0 = *(const LAS u32x2*)(vr), a1 = *(const LAS u32x2*)(vr + 32), a2 = *(const LAS u32x2*)(vr + 64), a3 = *(const LAS u32x2*)(vr + 96);
                f32x4 oc = oacc[dt][qt] * alpha;
                oc = mma(mkfrag(a0.x, a0.y, a1.x, a1.y), pf0, oc);
                oc = mma(mkfrag(a2.x, a2.y, a3.x, a3.y), pf1, oc);
                oacc[dt][qt] = oc;
            }
            __builtin_amdgcn_sched_barrier(0);
        }
        asm volatile("s_waitcnt lgkmcnt(0)" ::: "memory"); __builtin_amdgcn_wave_barrier();
    }
#pragma unroll
    for (int qt = 0; qt < 4; ++qt) {
        float lt = lrun[qt]; lt += __shfl_xor(lt, 16); lt += __shfl_xor(lt, 32);
        const float inv = 1.0f / lt;
        const int tok = b * SEQ + (qb * 64 + 16 * qt + c16) * d + r;
        bf16* op = Ob + (size_t)tok * opitch + h * 64 + 4 * g;
#pragma unroll
        for (int dt = 0; dt < 4; ++dt) { const f32x4 o = oacc[dt][qt] * inv; u32x2 w; w.x = cvtpk(o[0], o[1]); w.y = cvtpk(o[2], o[3]); *(u32x2*)(op + 16 * dt) = w; }
        if (g == 0) lse_out[(size_t)tok * NH + h] = (mrun[qt] + log2f(lt)) * LN2;
    }
}
}

namespace peer {
using scan::cvtpk; using scan::mkfrag; using scan::mma;
constexpr int KEY_SLOTS = 64;

template <int CTRL> __device__ __forceinline__ unsigned dppu(unsigned x) { return (unsigned)__builtin_amdgcn_update_dpp(0, (int)x, CTRL, 0xf, 0xf, true); }
__device__ __forceinline__ unsigned umax(unsigned a, unsigned b) { return a > b ? a : b; }
__device__ __forceinline__ unsigned rowmax16(unsigned x) { x = umax(x, dppu<0xB1>(x)); x = umax(x, dppu<0x4E>(x)); x = umax(x, dppu<0x141>(x)); x = umax(x, dppu<0x140>(x)); return x; }
__device__ __forceinline__ float rowsum16(float x) {
    x += __uint_as_float(dppu<0xB1>(__float_as_uint(x))); x += __uint_as_float(dppu<0x4E>(__float_as_uint(x)));
    x += __uint_as_float(dppu<0x141>(__float_as_uint(x))); x += __uint_as_float(dppu<0x140>(__float_as_uint(x))); return x;
}
__device__ __forceinline__ unsigned ordkey(float f) { const unsigned u = __float_as_uint(f); return (u & 0x80000000u) ? ~u : (u | 0x80000000u); }
__device__ __forceinline__ float unordkey(unsigned k) { return __uint_as_float((k & 0x80000000u) ? (k ^ 0x80000000u) : ~k); }

__device__ __forceinline__ void setup_keys(LAS unsigned char* L, const float* keys1, const float* keys2, int tid) {
    LAS bf16* F = (LAS bf16*)L;
    for (int i = tid; i < KEY_SLOTS * 64 * 8; i += 512) {
        const int j = i & 7, l = (i >> 3) & 63, sl = i >> 9, ks = sl & 3, nt = (sl >> 2) & 7, sel = sl >> 5;
        const int n = 16 * nt + (l & 15), k = 32 * ks + 8 * (l >> 4) + j;
        F[i] = (bf16)f2bf((sel ? keys2 : keys1)[n * 128 + k]);
    }
}

#define CE_(a, b) do { const unsigned hi_ = umax(a, b), lo_ = (a < b) ? a : b; a = hi_; b = lo_; } while (0)
__device__ __forceinline__ void top16(unsigned (&key)[8][4], unsigned (&win)[4], int c16) {
#pragma unroll
    for (int reg = 0; reg < 4; ++reg) {
        CE_(key[0][reg], key[1][reg]); CE_(key[2][reg], key[3][reg]); CE_(key[4][reg], key[5][reg]); CE_(key[6][reg], key[7][reg]);
        CE_(key[0][reg], key[2][reg]); CE_(key[1][reg], key[3][reg]); CE_(key[4][reg], key[6][reg]); CE_(key[5][reg], key[7][reg]);
        CE_(key[1][reg], key[2][reg]); CE_(key[5][reg], key[6][reg]);
        CE_(key[0][reg], key[4][reg]); CE_(key[1][reg], key[5][reg]); CE_(key[2][reg], key[6][reg]); CE_(key[3][reg], key[7][reg]);
        CE_(key[2][reg], key[4][reg]); CE_(key[3][reg], key[5][reg]);
        CE_(key[1][reg], key[2][reg]); CE_(key[3][reg], key[4][reg]); CE_(key[5][reg], key[6][reg]);
    }
#pragma unroll 1
    for (int k = 0; k < TOPK; ++k) {
#pragma unroll
        for (int reg = 0; reg < 4; ++reg) {
            const unsigned m = rowmax16(key[0][reg]);
            win[reg] = (c16 == k) ? m : win[reg];
            const bool pop = key[0][reg] == m;
#pragma unroll
            for (int nt = 0; nt < 7; ++nt) key[nt][reg] = pop ? key[nt + 1][reg] : key[nt][reg];
            key[7][reg] = pop ? 0u : key[7][reg];
        }
    }
}
#undef CE_

__device__ __forceinline__ void select_batch(const LAS unsigned char* L, const bf16* Q, int* IDX, float* GATE, int batch, int lane) {
    const int g = lane >> 4, c16 = lane & 15;
    const LAS bf16x8* F = (const LAS bf16x8*)L;
    const bf16* qp = Q + (size_t)(batch * 16 + c16) * PKD + 8 * g;
    unsigned w1[4] = {0u, 0u, 0u, 0u}, w2[4] = {0u, 0u, 0u, 0u};
#pragma unroll
    for (int sel = 0; sel < 2; ++sel) {
        unsigned key[8][4];
        bf16x8 a[4];
#pragma unroll
        for (int ks = 0; ks < 4; ++ks) a[ks] = *(const bf16x8*)(qp + sel * 128 + 32 * ks);
#pragma unroll
        for (int nt = 0; nt < 8; ++nt) {
            f32x4 sc = {0.f, 0.f, 0.f, 0.f};
#pragma unroll
            for (int ks = 0; ks < 4; ++ks) sc = mma(a[ks], F[((sel * 8 + nt) * 4 + ks) * 64 + lane], sc);
#pragma unroll
            for (int reg = 0; reg < 4; ++reg) key[nt][reg] = (ordkey(sc[reg]) & ~127u) | (unsigned)(16 * nt + c16);
            __builtin_amdgcn_sched_barrier(0);
        }
        if (sel == 0) top16(key, w1, c16); else top16(key, w2, c16);
    }
    float f1[4], f2[4], cur2[4]; int ptr[4]; unsigned top[4];
#pragma unroll
    for (int reg = 0; reg < 4; ++reg) { f1[reg] = unordkey(w1[reg] & ~127u); f2[reg] = unordkey(w2[reg] & ~127u); ptr[reg] = 0; cur2[reg] = __shfl(f2[reg], lane & 48); top[reg] = 0u; }
#pragma unroll 1
    for (int k = 0; k < TOPK; ++k) {
#pragma unroll
        for (int reg = 0; reg < 4; ++reg) {
            const unsigned ck = (ptr[reg] < 16) ? ((ordkey(f1[reg] + cur2[reg]) & ~255u) | (unsigned)(c16 << 4) | (unsigned)ptr[reg]) : 0u;
            const unsigned m = rowmax16(ck);
            top[reg] = (c16 == k) ? m : top[reg];
            if ((int)((m >> 4) & 15u) == c16) ptr[reg] += 1;
            cur2[reg] = __shfl(f2[reg], (lane & 48) | (ptr[reg] & 15));
        }
    }
#pragma unroll
    for (int reg = 0; reg < 4; ++reg) {
        const int a = (top[reg] >> 4) & 15, bq = top[reg] & 15;
        const int e1 = (int)(__shfl(w1[reg], (lane & 48) | a) & 127u), e2 = (int)(__shfl(w2[reg], (lane & 48) | bq) & 127u);
        const float ts = unordkey(top[reg] & ~255u), mx = __shfl(ts, lane & 48);
        const float ex = __expf(ts - mx), sum = rowsum16(ex);
        const size_t o = (size_t)(batch * 16 + 4 * g + reg) * TOPK + c16;
        IDX[o] = e1 * NKEYS + e2; GATE[o] = ex / sum;
    }
}

__device__ __forceinline__ void convert_table(const float* src, bf16* dst, size_t n8, size_t gtid, size_t gthreads) {
    for (size_t i = gtid; i < n8; i += gthreads) {
        const f32x4 a = *(const f32x4*)(src + i * 8), b = *(const f32x4*)(src + i * 8 + 4);
        v4u o; o.x = cvtpk(a.x, a.y); o.y = cvtpk(a.z, a.w); o.z = cvtpk(b.x, b.y); o.w = cvtpk(b.z, b.w);
        *(v4u*)(dst + i * 8) = o;
    }
}

__device__ __forceinline__ float dot2bf(unsigned w, unsigned x, float acc) {
    typedef __bf16 bf2 __attribute__((ext_vector_type(2)));
    return __builtin_amdgcn_fdot2_f32_bf16(__builtin_bit_cast(bf2, w), __builtin_bit_cast(bf2, x), acc, false);
}
__device__ __forceinline__ float gelu_erf(float v) {
    const float av = fabsf(v), t = __builtin_amdgcn_rcpf(av * 0.2316418882f + 1.0f);
    float q = t * 0.5307027145f + (-0.7265760135f); q = q * t + 0.7107068705f; q = q * t + (-0.142248368f); q = q * t + 0.127414796f; q = q * t;
    const float e = __builtin_amdgcn_exp2f((v * v) * (-0.72134752044f));
    const float m = v * (q * e);
    return v < 0.f ? m : v - m;
}

typedef float f32x2c __attribute__((ext_vector_type(2)));
__device__ __forceinline__ void convert_rows_fp8(const float* src, unsigned char* dst, float* scale, int rows, int gw, int ngw, int lane) {
    for (int rrow = gw; rrow < rows; rrow += ngw) {
        const float* p = src + (size_t)rrow * D + 16 * lane;
        const f32x4 a = *(const f32x4*)p, b = *(const f32x4*)(p + 4), c = *(const f32x4*)(p + 8), d = *(const f32x4*)(p + 12);
        float m = fmaxf(fmaxf(fmaxf(fabsf(a.x), fabsf(a.y)), fmaxf(fabsf(a.z), fabsf(a.w))), fmaxf(fmaxf(fabsf(b.x), fabsf(b.y)), fmaxf(fabsf(b.z), fabsf(b.w))));
        m = fmaxf(m, fmaxf(fmaxf(fmaxf(fabsf(c.x), fabsf(c.y)), fmaxf(fabsf(c.z), fabsf(c.w))), fmaxf(fmaxf(fabsf(d.x), fabsf(d.y)), fmaxf(fabsf(d.z), fabsf(d.w)))));
#pragma unroll
        for (int o = 1; o < 64; o <<= 1) m = fmaxf(m, __shfl_xor(m, o));
        m = fmaxf(m, 1e-30f);
        const float inv = 448.0f / m;
        v4u w;
        w.x = (unsigned)__builtin_amdgcn_cvt_pk_fp8_f32(a.z * inv, a.w * inv, __builtin_amdgcn_cvt_pk_fp8_f32(a.x * inv, a.y * inv, 0, false), true);
        w.y = (unsigned)__builtin_amdgcn_cvt_pk_fp8_f32(b.z * inv, b.w * inv, __builtin_amdgcn_cvt_pk_fp8_f32(b.x * inv, b.y * inv, 0, false), true);
        w.z = (unsigned)__builtin_amdgcn_cvt_pk_fp8_f32(c.z * inv, c.w * inv, __builtin_amdgcn_cvt_pk_fp8_f32(c.x * inv, c.y * inv, 0, false), true);
        w.w = (unsigned)__builtin_amdgcn_cvt_pk_fp8_f32(d.z * inv, d.w * inv, __builtin_amdgcn_cvt_pk_fp8_f32(d.x * inv, d.y * inv, 0, false), true);
        *(v4u*)(dst + (size_t)rrow * D + 16 * lane) = w;
        if (lane == 0) scale[rrow] = m * (1.0f / 448.0f);
    }
}
__device__ __forceinline__ unsigned pack_i8x4(float a, float b, float c, float d) {
    const int ia = (int)rintf(a), ib = (int)rintf(b), ic = (int)rintf(c), id = (int)rintf(d);
    return (unsigned)(ia & 0xff) | ((unsigned)(ib & 0xff) << 8) | ((unsigned)(ic & 0xff) << 16) | ((unsigned)id << 24);
}
__device__ __forceinline__ void convert_rows_i8(const float* src, unsigned char* dst, float* scale, int rows, int gw, int ngw, int lane) {
    for (int rrow = gw; rrow < rows; rrow += ngw) {
        const float* p = src + (size_t)rrow * D + 16 * lane;
        const f32x4 a = *(const f32x4*)p, b = *(const f32x4*)(p + 4), c = *(const f32x4*)(p + 8), d = *(const f32x4*)(p + 12);
        float m = fmaxf(fmaxf(fmaxf(fabsf(a.x), fabsf(a.y)), fmaxf(fabsf(a.z), fabsf(a.w))), fmaxf(fmaxf(fabsf(b.x), fabsf(b.y)), fmaxf(fabsf(b.z), fabsf(b.w))));
        m = fmaxf(m, fmaxf(fmaxf(fmaxf(fabsf(c.x), fabsf(c.y)), fmaxf(fabsf(c.z), fabsf(c.w))), fmaxf(fmaxf(fabsf(d.x), fabsf(d.y)), fmaxf(fabsf(d.z), fabsf(d.w)))));
#pragma unroll
        for (int o = 1; o < 64; o <<= 1) m = fmaxf(m, __shfl_xor(m, o));
        m = fmaxf(m, 1e-30f);
        const float inv = 127.0f / m;
        v4u w;
        w.x = pack_i8x4(a.x * inv, a.y * inv, a.z * inv, a.w * inv); w.y = pack_i8x4(b.x * inv, b.y * inv, b.z * inv, b.w * inv);
        w.z = pack_i8x4(c.x * inv, c.y * inv, c.z * inv, c.w * inv); w.w = pack_i8x4(d.x * inv, d.y * inv, d.z * inv, d.w * inv);
        *(v4u*)(dst + (size_t)rrow * D + 16 * lane) = w;
        if (lane == 0) scale[rrow] = m * (1.0f / 127.0f);
    }
}
__device__ __forceinline__ int isum8(int x) {
    x += (int)dppu<0xB1>((unsigned)x); x += (int)dppu<0x4E>((unsigned)x); x += (int)dppu<0x141>((unsigned)x); return x;
}
__device__ __forceinline__ float sum8(float x) {
    x += __uint_as_float(dppu<0xB1>(__float_as_uint(x))); x += __uint_as_float(dppu<0x4E>(__float_as_uint(x))); x += __uint_as_float(dppu<0x141>(__float_as_uint(x))); return x;
}
__device__ __forceinline__ float dot16_fp8(const v4u q, const f32x2c (&x)[8]) {
    f32x2c d = __builtin_amdgcn_cvt_pk_f32_fp8((int)q.x, false) * x[0];
    d = __builtin_elementwise_fma(__builtin_amdgcn_cvt_pk_f32_fp8((int)q.x, true), x[1], d);
    d = __builtin_elementwise_fma(__builtin_amdgcn_cvt_pk_f32_fp8((int)q.y, false), x[2], d);
    d = __builtin_elementwise_fma(__builtin_amdgcn_cvt_pk_f32_fp8((int)q.y, true), x[3], d);
    d = __builtin_elementwise_fma(__builtin_amdgcn_cvt_pk_f32_fp8((int)q.z, false), x[4], d);
    d = __builtin_elementwise_fma(__builtin_amdgcn_cvt_pk_f32_fp8((int)q.z, true), x[5], d);
    d = __builtin_elementwise_fma(__builtin_amdgcn_cvt_pk_f32_fp8((int)q.w, false), x[6], d);
    d = __builtin_elementwise_fma(__builtin_amdgcn_cvt_pk_f32_fp8((int)q.w, true), x[7], d);
    return d.x + d.y;
}
__device__ __forceinline__ void axpy16_fp8(const v4u q, float cf, f32x2c (&y)[8]) {
    const f32x2c c2 = {cf, cf};
    y[0] = __builtin_elementwise_fma(__builtin_amdgcn_cvt_pk_f32_fp8((int)q.x, false), c2, y[0]); y[1] = __builtin_elementwise_fma(__builtin_amdgcn_cvt_pk_f32_fp8((int)q.x, true), c2, y[1]);
    y[2] = __builtin_elementwise_fma(__builtin_amdgcn_cvt_pk_f32_fp8((int)q.y, false), c2, y[2]); y[3] = __builtin_elementwise_fma(__builtin_amdgcn_cvt_pk_f32_fp8((int)q.y, true), c2, y[3]);
    y[4] = __builtin_elementwise_fma(__builtin_amdgcn_cvt_pk_f32_fp8((int)q.z, false), c2, y[4]); y[5] = __builtin_elementwise_fma(__builtin_amdgcn_cvt_pk_f32_fp8((int)q.z, true), c2, y[5]);
    y[6] = __builtin_elementwise_fma(__builtin_amdgcn_cvt_pk_f32_fp8((int)q.w, false), c2, y[6]); y[7] = __builtin_elementwise_fma(__builtin_amdgcn_cvt_pk_f32_fp8((int)q.w, true), c2, y[7]);
}

#define FFN_ISSUE_U(q, idv) do { _Pragma("unroll") for (int i = 0; i < 8; ++i) { const int ex_ = __shfl(idv, 8 * i + eg); \
            q[i] = *(const v4u*)(UT8 + (((unsigned)ex_ << 10) + (unsigned)(128 * sl + 16 * ch))); } } while (0)
#define FFN_DOT_U(QQ, XX, r) do { const v4u xx_ = XX; _Pragma("unroll") for (int i = 0; i < 8; ++i) { const v4u qq_ = QQ[i]; \
            int d_ = __builtin_amdgcn_sdot4((int)qq_[0], (int)xx_[0], 0, false); d_ = __builtin_amdgcn_sdot4((int)qq_[1], (int)xx_[1], d_, false); \
            d_ = __builtin_amdgcn_sdot4((int)qq_[2], (int)xx_[2], d_, false); d_ = __builtin_amdgcn_sdot4((int)qq_[3], (int)xx_[3], d_, false); \
            d_ = isum8(d_); if (ch == i) r = d_; } } while (0)
__device__ __forceinline__ void ffn_u_pass(const unsigned char* XQ, const int* IDX, const unsigned char* UT8, int* PART, int sl, int wv, int nwv, int lane) {
    const int eg = lane >> 3, ch = lane & 7;
    v4u qA[8], qB[8];
    int t = wv; if (t >= T) return;
    int i0 = IDX[(size_t)t * HK + lane], i1 = IDX[(size_t)t * HK + 64 + lane], n0 = 0, n1 = 0;
    v4u x0 = *(const v4u*)(XQ + (size_t)t * D + 128 * sl + 16 * ch), xn0 = x0;
    FFN_ISSUE_U(qA, i0);
#pragma unroll 1
    for (;;) {
        const int tn = t + nwv; const bool more = tn < T;
        if (more) { n0 = IDX[(size_t)tn * HK + lane]; n1 = IDX[(size_t)tn * HK + 64 + lane]; xn0 = *(const v4u*)(XQ + (size_t)tn * D + 128 * sl + 16 * ch); }
        FFN_ISSUE_U(qB, i1);
        int r0 = 0, r1 = 0;
        FFN_DOT_U(qA, x0, r0);
        if (more) FFN_ISSUE_U(qA, n0);
        FFN_DOT_U(qB, x0, r1);
        int* pp = PART + ((size_t)sl * T + t) * HK + 8 * ch + eg; pp[0] = r0; pp[64] = r1;
        if (!more) break;
        i0 = n0; i1 = n1; x0 = xn0; t = tn;
    }
}
#define FFN_ISSUE_V(q, cf, idv, cv) do { _Pragma("unroll") for (int i = 0; i < 8; ++i) { const int ex_ = __shfl(idv, 8 * i + eg); cf[i] = __shfl(cv, 8 * i + eg); \
            q[i] = *(const v4u*)(VT8 + (((unsigned)ex_ << 10) + (unsigned)(128 * sl + 16 * ch))); } } while (0)
__device__ __forceinline__ void ffn_v_pass(const int* IDX, const float* COEF, const unsigned char* VT8, const float* mod, float* out, int sl, int wv, int nwv, int lane) {
    const int eg = lane >> 3, ch = lane & 7, col = 128 * sl + 16 * ch;
    v4u qA[8], qB[8]; float cfA[8], cfB[8];
    int t = wv; if (t >= T) return;
    int i0 = IDX[(size_t)t * HK + lane], i1 = IDX[(size_t)t * HK + 64 + lane], n0 = 0, n1 = 0;
    float c0 = COEF[(size_t)t * HK + lane], c1 = COEF[(size_t)t * HK + 64 + lane], cn0 = 0.f, cn1 = 0.f;
    FFN_ISSUE_V(qA, cfA, i0, c0);
#pragma unroll 1
    for (;;) {
        const int tn = t + nwv; const bool more = tn < T;
        if (more) { n0 = IDX[(size_t)tn * HK + lane]; n1 = IDX[(size_t)tn * HK + 64 + lane]; cn0 = COEF[(size_t)tn * HK + lane]; cn1 = COEF[(size_t)tn * HK + 64 + lane]; }
        FFN_ISSUE_V(qB, cfB, i1, c1);
        const size_t o = (size_t)t * D + col; const int b = t / SEQ;
        f32x2c y2[8];
#pragma unroll
        for (int k = 0; k < 8; ++k) y2[k] = (f32x2c){0.f, 0.f};
#pragma unroll
        for (int i = 0; i < 8; ++i) { axpy16_fp8(qA[i], cfA[i], y2); if (i & 1) __builtin_amdgcn_sched_barrier(0); }
        if (more) FFN_ISSUE_V(qA, cfA, n0, cn0);
        f32x4 oa[4];
#pragma unroll
        for (int k4 = 0; k4 < 4; ++k4) oa[k4] = *(const f32x4*)(out + o + 4 * k4);
#pragma unroll
        for (int i = 0; i < 8; ++i) { axpy16_fp8(qB[i], cfB[i], y2); if (i & 1) __builtin_amdgcn_sched_barrier(0); }
        float y[16];
#pragma unroll
        for (int k = 0; k < 8; ++k) { y[2 * k] = y2[k].x; y[2 * k + 1] = y2[k].y; }
#pragma unroll
        for (int k = 0; k < 16; ++k) { y[k] += __uint_as_float(dppu<0x128>(__float_as_uint(y[k]))); y[k] += __shfl_xor(y[k], 16); y[k] += __shfl_xor(y[k], 32); }
        if (eg == 0) {
#pragma unroll
            for (int k4 = 0; k4 < 4; ++k4) { f32x4 w = oa[k4]; const f32x4 ga = *(const f32x4*)(mod + b * MODW + 5 * D + col + 4 * k4);
                w.x += ga.x * y[4 * k4]; w.y += ga.y * y[4 * k4 + 1]; w.z += ga.z * y[4 * k4 + 2]; w.w += ga.w * y[4 * k4 + 3]; *(f32x4*)(out + o + 4 * k4) = w; } }
        if (!more) break;
        i0 = n0; i1 = n1; c0 = cn0; c1 = cn1; t = tn;
    }
}
}

namespace fin {
using scan::cvtpk; using scan::mkfrag; using scan::mma;
typedef unsigned u32x2 __attribute__((ext_vector_type(2)));

__device__ __forceinline__ float shift3(const bf16* p, bool hasp, bool hasn, float mp, float mn) {
    const float z = bf2f(p[0]), zp = hasp ? bf2f(p[-INW]) : 0.f, zn = hasn ? bf2f(p[INW]) : 0.f;
    return z + mp * (zp - z) + mn * (zn - z);
}

__device__ __forceinline__ void unpack4(const u32x2 w, float (&f)[4]) {
    f[0] = __uint_as_float(w.x << 16); f[1] = __uint_as_float(w.x & 0xffff0000u); f[2] = __uint_as_float(w.y << 16); f[3] = __uint_as_float(w.y & 0xffff0000u);
}
__device__ __forceinline__ void phase(LAS unsigned char* L, const bf16* Z, const float* mu_prev, const float* mu_next, const float* g_up, const bf16* Y, const float* BON,
                                      const float* k_a, const float* r_k, const float* lnx_g, const float* lnx_b, bf16* mix, const bf16* O3, const float* LSE,
                                      int bx, int G, int tid, int wave, int lane) {
    const int g = lane >> 4, c16 = lane & 15, ch0 = 64 * wave + 4 * c16;
    LAS bf16* sg = (LAS bf16*)L;
    bf16x8 bf[4][4];
#pragma unroll
    for (int ks = 0; ks < 4; ++ks) {
        f32x4 rowv[8];
#pragma unroll
        for (int jj = 0; jj < 8; ++jj) rowv[jj] = *(const f32x4*)(g_up + (size_t)(32 * ks + 8 * g + jj) * RW + ch0);
#pragma unroll
        for (int nt = 0; nt < 4; ++nt) bf[nt][ks] = mkfrag(cvtpk(rowv[0][nt], rowv[1][nt]), cvtpk(rowv[2][nt], rowv[3][nt]), cvtpk(rowv[4][nt], rowv[5][nt]), cvtpk(rowv[6][nt], rowv[7][nt]));
    }
    const f32x4 mpr = *(const f32x4*)(mu_prev + ch0), mnr = *(const f32x4*)(mu_next + ch0), mpk = *(const f32x4*)(mu_prev + RW + ch0), mnk = *(const f32x4*)(mu_next + RW + ch0),
                mpv = *(const f32x4*)(mu_prev + 2 * RW + ch0), mnv = *(const f32x4*)(mu_next + 2 * RW + ch0);
    const f32x4 ka1 = *(const f32x4*)(k_a + ch0), rk1 = *(const f32x4*)(r_k + ch0), lg = *(const f32x4*)(lnx_g + ch0), lb = *(const f32x4*)(lnx_b + ch0);
    const int j0 = (tid & 31) * 4;
    const f32x4 mpg = *(const f32x4*)(mu_prev + 3 * RW + DL + AL + j0), mng = *(const f32x4*)(mu_next + 3 * RW + DL + AL + j0);
    for (int tb = bx; tb < T / 16; tb += G) {
        const int tok0 = tb * 16;
        __syncthreads();
        {
            const int tl = tid >> 5, tok = tok0 + tl, t = tok % SEQ;
            const bf16* p = Z + (size_t)tok * INW + 3 * AW + 3 * RW + DL + AL + j0;
            const bool hasp = t > 0, hasn = t < SEQ - 1;
            float zc[4], zp[4], zn[4];
            unpack4(*(const u32x2*)p, zc); unpack4(*(const u32x2*)(hasp ? p - INW : p), zp); unpack4(*(const u32x2*)(hasn ? p + INW : p), zn);
            float o[4];
#pragma unroll
            for (int e = 0; e < 4; ++e) { const float pv = hasp ? zp[e] : 0.f, nv = hasn ? zn[e] : 0.f; const float v = zc[e] + mpg[e] * (pv - zc[e]) + mng[e] * (nv - zc[e]); o[e] = __builtin_amdgcn_rcpf(1.0f + __expf(-v)); }
            u32x2 w; w.x = cvtpk(o[0], o[1]); w.y = cvtpk(o[2], o[3]);
            *(LAS u32x2*)(sg + tl * 128 + j0) = w;
        }
        __syncthreads();
        f32x4 ga[4];
        {
            bf16x8 af[4];
#pragma unroll
            for (int ks = 0; ks < 4; ++ks) af[ks] = *(const LAS bf16x8*)(sg + c16 * 128 + 32 * ks + 8 * g);
#pragma unroll
            for (int nt = 0; nt < 4; ++nt) { f32x4 a = {0.f, 0.f, 0.f, 0.f};
#pragma unroll
                for (int ks = 0; ks < 4; ++ks) a = mma(af[ks], bf[nt][ks], a);
                ga[nt] = a; }
        }
#pragma unroll
        for (int reg = 0; reg < 4; ++reg) {
            const int tok = tok0 + 4 * g + reg, t = tok % SEQ;
            const bool hasp = t > 0, hasn = t < SEQ - 1;
            const bf16* zr = Z + (size_t)tok * INW + 3 * AW + ch0;
            const size_t o = (size_t)tok * RW + ch0;
            float y0[4], y1[4]; unpack4(*(const u32x2*)(Y + o), y0); unpack4(*(const u32x2*)(Y + (size_t)T * RW + o), y1);
            float rc[4], rp[4], rn[4], kc[4], kp[4], kn[4], vc[4], vp[4], vn[4];
            unpack4(*(const u32x2*)zr, rc); unpack4(*(const u32x2*)(hasp ? zr - INW : zr), rp); unpack4(*(const u32x2*)(hasn ? zr + INW : zr), rn);
            unpack4(*(const u32x2*)(zr + RW), kc); unpack4(*(const u32x2*)(hasp ? zr + RW - INW : zr + RW), kp); unpack4(*(const u32x2*)(hasn ? zr + RW + INW : zr + RW), kn);
            unpack4(*(const u32x2*)(zr + 2 * RW), vc); unpack4(*(const u32x2*)(hasp ? zr + 2 * RW - INW : zr + 2 * RW), vp); unpack4(*(const u32x2*)(hasn ? zr + 2 * RW + INW : zr + 2 * RW), vn);
            bf16* mp = mix + (size_t)tok * D + ch0;
            float o1[4], o2[4], o3[4];
            unpack4(*(const u32x2*)mp, o1); unpack4(*(const u32x2*)(mp + AW), o2); unpack4(*(const u32x2*)(O3 + (size_t)tok * AW + ch0), o3);
            const float l1 = LSE[(size_t)tok * NH + wave], l2 = LSE[((size_t)T + tok) * NH + wave], l3 = LSE[((size_t)2 * T + tok) * NH + wave];
            const float bon = BON[(size_t)tok * NH + wave] + BON[((size_t)T + tok) * NH + wave];
            float yv[4], vv[4], s1 = 0.f, sb = 0.f;
#pragma unroll
            for (int nt = 0; nt < 4; ++nt) {
                yv[nt] = y0[nt] + y1[nt]; s1 += yv[nt];
                const float pr = hasp ? rp[nt] : 0.f, nr = hasn ? rn[nt] : 0.f, pk = hasp ? kp[nt] : 0.f, nk = hasn ? kn[nt] : 0.f, pvv = hasp ? vp[nt] : 0.f, nvv = hasn ? vn[nt] : 0.f;
                const float rr = rc[nt] + mpr[nt] * (pr - rc[nt]) + mnr[nt] * (nr - rc[nt]);
                const float kk = kc[nt] + mpk[nt] * (pk - kc[nt]) + mnk[nt] * (nk - kc[nt]);
                vv[nt] = vc[nt] + mpv[nt] * (pvv - vc[nt]) + mnv[nt] * (nvv - vc[nt]);
                sb += rr * kk * rk1[nt] * (1.0f - ka1[nt]);
            }
            const float mean = peer::rowsum16(s1) * (1.f / 64.f);
            float s2 = 0.f;
#pragma unroll
            for (int nt = 0; nt < 4; ++nt) s2 += (yv[nt] - mean) * (yv[nt] - mean);
            const float rstd = __builtin_amdgcn_rsqf(peer::rowsum16(s2) * (1.f / 64.f) + 64e-5f);
            const float bs = peer::rowsum16(sb) + 0.5f * bon;
            const float lm = fmaxf(l1, fmaxf(l2, l3)), w1 = __expf(l1 - lm), w2 = __expf(l2 - lm), w3 = __expf(l3 - lm), wi = __builtin_amdgcn_rcpf(w1 + w2 + w3);
            float att[4], rw[4];
#pragma unroll
            for (int nt = 0; nt < 4; ++nt) {
                att[nt] = (w1 * o1[nt] + w2 * o2[nt] + w3 * o3[nt]) * wi;
                rw[nt] = ((yv[nt] - mean) * rstd * lg[nt] + lb[nt] + bs * vv[nt]) * ga[nt][reg];
            }
            u32x2 wa, wr; wa.x = cvtpk(att[0], att[1]); wa.y = cvtpk(att[2], att[3]); wr.x = cvtpk(rw[0], rw[1]); wr.y = cvtpk(rw[2], rw[3]);
            *(u32x2*)mp = wa; *(u32x2*)(mp + AW) = wr;
            __builtin_amdgcn_sched_barrier(0);
        }
    }
}
}

#ifndef MK_SKIP
#define MK_SKIP 0
#endif
constexpr int N_PHASES = 12;
struct Args { const float* in[27]; float* out; unsigned char* ws; int ph_lo, ph_hi, li, pad; };

__global__ void __launch_bounds__(NWAVES * 64, 2) mk_fwd(Args args) {
    extern __shared__ __attribute__((aligned(16))) unsigned char lds[];
    LAS unsigned char* L = (LAS unsigned char*)lds;
    volatile LAS unsigned* MISC = (volatile LAS unsigned*)(L + MISC_OFF);
    const int tid = threadIdx.x, lane = tid & 63, wave = __builtin_amdgcn_readfirstlane(tid >> 6);
    const int G = gridDim.x, bx = blockIdx.x;
    unsigned char* ws = args.ws;
    gu32* ctl = (gu32*)(ws + WS_CTL);
    const float* x = args.in[0]; const float* cvec = args.in[1]; const float* ada_w = args.in[2]; const float* ada_b = args.in[3];
    const float* norm1_g = args.in[4]; const float* w_in = args.in[5]; const float* mu_prev = args.in[6]; const float* mu_next = args.in[7];
    const float* q_norm_g = args.in[8]; const float* k_norm_g = args.in[9]; const float* w_decay0 = args.in[10]; const float* w_decay_up = args.in[11];
    const float* a_gate0 = args.in[12]; const float* a_gate_up = args.in[13]; const float* g_up = args.in[14]; const float* k_k = args.in[15];
    const float* k_a = args.in[16]; const float* r_k = args.in[17]; const float* lnx_g = args.in[18]; const float* lnx_b = args.in[19];
    const float* w_out = args.in[20]; const float* norm2_g = args.in[21]; const float* w_query = args.in[22]; const float* keys1 = args.in[23];
    const float* keys2 = args.in[24]; const float* peer_u = args.in[25]; const float* peer_v = args.in[26];
    float* out = args.out;
    float* MOD = (float*)(ws + WS_MOD); bf16* KEYS = (bf16*)(ws + WS_KEYS); bf16* WIN = (bf16*)(ws + WS_WIN); bf16* WOUT = (bf16*)(ws + WS_WOUT); bf16* WQ = (bf16*)(ws + WS_WQ);
    bf16* XN = (bf16*)(ws + WS_XN); bf16* Z = (bf16*)(ws + WS_Z); bf16* MIX = (bf16*)(ws + WS_MIX); bf16* Y = (bf16*)(ws + WS_Y); bf16* Q = (bf16*)(ws + WS_Q);
    int* IDX = (int*)(ws + WS_IDX); float* GATE = (float*)(ws + WS_GATE); float* BON = (float*)(ws + WS_BON);
    bf16* O3 = (bf16*)(ws + WS_O3); float* LSE = (float*)(ws + WS_LSE); unsigned char* UT8 = ws + WS_UT; unsigned char* VT8 = ws + WS_VT; float* SU = (float*)(ws + WS_SU); float* SV = (float*)(ws + WS_SU + 65536); unsigned char* XQ = ws + WS_XQ; float* SX = (float*)(ws + WS_XQ + 16 * MiB); float* PART = (float*)(ws + WS_PART);

    for (int u = tid; u < (LDS_BYTES - LDSCTL_OFF) / 4; u += NWAVES * 64) ((LAS unsigned*)(L + LDSCTL_OFF))[u] = 0u;
    __syncthreads();
    XcdBarrier bar = xcd_barrier_post((unsigned*)(ctl + CW_BAR) + args.li * XCD_BAR_WORDS, MISC + 8);
    const int lo = args.ph_lo, hi = args.ph_hi;
#define IN(k) (lo <= (k) && (k) < hi)
#define SEAM(k) do { if (IN(k) && IN((k) + 1)) xcd_barrier(bar); } while (0)
    const int gw = bx * NWAVES + wave, NGW = G * NWAVES;

    if (IN(0) && !(MK_SKIP & (1 << 0))) {
        if (bx < 2 * (MODW / 64)) {
            const int cg = bx % (MODW / 64), kh = bx / (MODW / 64);
            LAS float* sc = (LAS float*)L; LAS float* part = (LAS float*)(L + 32768);
            for (int i = tid; i < BATCH * D; i += NWAVES * 64) { const float cv = cvec[i]; sc[i] = cv / (1.f + expf(-cv)); }
            __syncthreads();
            const int j0 = cg * 64, i0 = kh * 512 + wave * 64;
            float acc[BATCH];
#pragma unroll
            for (int b = 0; b < BATCH; ++b) acc[b] = 0.f;
#pragma unroll 1
            for (int ii = 0; ii < 64; ii += 8) {
                float w[8];
#pragma unroll
                for (int e = 0; e < 8; ++e) w[e] = ada_w[(size_t)(i0 + ii + e) * MODW + j0 + lane];
#pragma unroll
                for (int e = 0; e < 8; ++e)
#pragma unroll
                    for (int b = 0; b < BATCH; ++b) acc[b] += sc[b * D + i0 + ii + e] * w[e];
            }
#pragma unroll
            for (int b = 0; b < BATCH; ++b) part[(wave * 8 + b) * 64 + lane] = acc[b];
            __syncthreads();
            { const int b = tid >> 6; float s = 0.f;
#pragma unroll
              for (int w = 0; w < 8; ++w) s += part[(w * 8 + b) * 64 + lane];
              if (kh == 0) s += ada_b[j0 + lane];
              atomicAdd(MOD + b * MODW + j0 + lane, s); }
            __syncthreads();
        }
        LAS float* scr = (LAS float*)(L + RING_OFF + wave * 16384);
        constexpr int I_IN = (D / 64) * (INW / 32), I_OUT = (D / 64) * (D / 32), I_Q = (D / 64) * (QW / 32);
        for (int it = gw; it < I_IN + I_OUT + I_Q; it += NGW) {
            int r = it;
            if (r < I_IN) { p0_transpose_item(w_in, D, INW, WIN, 0, scr, r, lane); continue; } r -= I_IN;
            if (r < I_OUT) { p0_transpose_item(w_out, D, D, WOUT, 0, scr, r, lane); continue; } r -= I_OUT;
            p0_transpose_item(w_query, D, QW, WQ, 0, scr, r, lane);
        }
    }
    SEAM(0);
    if (IN(1) && !(MK_SKIP & (1 << 1))) { norm_rows(x, norm1_g, MOD, 0, D, XN, gw, NGW, lane); }
    SEAM(1);
    if (IN(2) && !(MK_SKIP & (1 << 2))) {
        pg8::Gemm g{XN, WIN, T, INW, D}; pg8::StaticOrder S; S.init(T, INW, G, bx);
        pg8::EpiBf16<0> E{Z, INW, nullptr, 0, 0, 1.f};
        pg8::gemm_phase<pg8::EpiBf16<0>, pg8::StaticOrder, true, true>(L + RING_OFF, g, S, E);
    }
    SEAM(2);
    if (IN(3) && !(MK_SKIP & (1 << 3))) {
        constexpr int NCHAIN = BATCH * NH * 2;
        if (bx < NCHAIN) scan::chain(L, Z, mu_prev, mu_next, w_decay0, w_decay_up, a_gate0, a_gate_up, k_k, k_a, r_k, Y, BON, bx, tid, wave, lane);
        {
            gu32* ucnt = ctl + CW_WORK + 64 * args.li;
            LAS unsigned char* vt = L + wave * attn::WAVE_LDS;
            for (;;) {
                unsigned uu = 0u;
                if (lane == 0) uu = __hip_atomic_fetch_add(ucnt, 1u, __ATOMIC_RELAXED, __HIP_MEMORY_SCOPE_AGENT);
                const int u = __builtin_amdgcn_readfirstlane((int)uu);
                if (u >= BATCH * NH * 96) break;
                const int x = u & 31, p = (u >> 5) % 3, bh = u / 96;
                const int d = (p == 0) ? 1 : (p == 1 ? 4 : 16), nb = 32 / d, r = x / nb, qb = x % nb;
                bf16* Ob = (p == 0) ? MIX : (p == 1 ? MIX + AW : O3); const int opitch = (p == 2) ? AW : D;
                attn::unit(vt, Z, q_norm_g, k_norm_g, Ob, opitch, LSE + (size_t)p * T * NH, bh >> 3, bh & 7, d, r, qb, nb, lane);
            }
        }
        {
            gu32* ccnt = ctl + CW_WORK2 + 64 * args.li;
            for (;;) {
                unsigned uu = 0u;
                if (lane == 0) uu = __hip_atomic_fetch_add(ccnt, 1u, __ATOMIC_RELAXED, __HIP_MEMORY_SCOPE_AGENT);
                const int it = __builtin_amdgcn_readfirstlane((int)uu);
                if (it >= 1024) break;
                const int r0 = (it & 511) * 32;
                if (it < 512) peer::convert_rows_i8(peer_u + (size_t)r0 * D, UT8 + (size_t)r0 * D, SU + r0, 32, 0, 1, lane);
                else peer::convert_rows_fp8(peer_v + (size_t)r0 * D, VT8 + (size_t)r0 * D, SV + r0, 32, 0, 1, lane);
            }
        }
    }
    SEAM(3);
    if (IN(4) && !(MK_SKIP & (1 << 4))) { fin::phase(L, Z, mu_prev, mu_next, g_up, Y, BON, k_a, r_k, lnx_g, lnx_b, MIX, O3, LSE, bx, G, tid, wave, lane); }
    SEAM(4);
    if (IN(5) && !(MK_SKIP & (1 << 5))) {
        pg8::Gemm g{MIX, WOUT, T, D, D}; pg8::StaticOrder S; S.init(T, D, G, bx);
        EpiRes E{x, MOD, 2 * D, out, D};
        pg8::gemm_phase<EpiRes, pg8::StaticOrder, true, true>(L + RING_OFF, g, S, E);
    }
    SEAM(5);
    if (IN(6) && !(MK_SKIP & (1 << 6))) { norm_rows_q(out, norm2_g, MOD, 3 * D, 4 * D, XN, XQ, SX, gw, NGW, lane);
    }
    SEAM(6);
    if (IN(7) && !(MK_SKIP & (1 << 7))) {
        pg8::Gemm g{XN, WQ, T, QW, D}; pg8::StaticOrder S; S.init(T, QW, G, bx);
        pg8::EpiBf16<0> E{Q, QW, nullptr, 0, 0, 1.f};
        pg8::gemm_phase<pg8::EpiBf16<0>, pg8::StaticOrder, true, true>(L + RING_OFF, g, S, E);
    }
    SEAM(7);
    if (IN(8) && !(MK_SKIP & (1 << 8))) { __syncthreads(); peer::setup_keys(L, keys1, keys2, tid); __syncthreads();
        for (int bt = gw; bt < T * PH / 16; bt += NGW) peer::select_batch(L, Q, IDX, GATE, bt, lane); }
    SEAM(8);
    {
        const int sl = bx & 7, wv = (bx >> 3) * NWAVES + wave, nwv = (G >> 3) * NWAVES;
        if (IN(9) && !(MK_SKIP & (1 << 9))) { peer::ffn_u_pass(XQ, IDX, UT8, (int*)PART, sl, wv, nwv, lane); }
        SEAM(9);
        if (IN(10) && !(MK_SKIP & (1 << 10))) {
            for (size_t i = (size_t)bx * NWAVES * 64 + tid; i < (size_t)T * HK; i += (size_t)G * NWAVES * 64) {
                int di = 0;
#pragma unroll
                for (int s8 = 0; s8 < 8; ++s8) di += ((const int*)PART)[(size_t)s8 * T * HK + i];
                const int ex = IDX[i];
                GATE[i] = GATE[i] * peer::gelu_erf((float)di * SU[ex] * SX[i / HK]) * SV[ex];
            }
        }
        SEAM(10);
        if (IN(11) && !(MK_SKIP & (1 << 11))) { peer::ffn_v_pass(IDX, GATE, VT8, MOD, out, sl, wv, nwv, lane); }
    }
#undef IN
#undef SEAM
}

extern "C" void kernel_launch(void* const* d_in, const int* in_sizes, int n_in, void* d_out, int out_size, void* d_ws, size_t ws_size, hipStream_t stream) {
    static int grid = 0;
    if (grid == 0) {
        if (n_in != 27 || in_sizes[0] != T * D || out_size != T * D || ws_size < WS_END) { fprintf(stderr, "kernel_launch: unexpected problem (n_in %d, in0 %d, out %d, ws %zu); nothing launched\n", n_in, n_in > 0 ? in_sizes[0] : -1, out_size, ws_size); grid = -1; return; }
        int dev = 0, cus = 0, per_cu = 0;
        if (hipGetDevice(&dev) != hipSuccess || hipDeviceGetAttribute(&cus, hipDeviceAttributeMultiprocessorCount, dev) != hipSuccess) { fprintf(stderr, "kernel_launch: device query failed\n"); grid = -1; return; }
        if (hipFuncSetAttribute((const void*)mk_fwd, hipFuncAttributeMaxDynamicSharedMemorySize, LDS_BYTES) != hipSuccess) { fprintf(stderr, "kernel_launch: hipFuncSetAttribute failed\n"); grid = -1; return; }
        if (hipOccupancyMaxActiveBlocksPerMultiprocessor(&per_cu, (const void*)mk_fwd, NWAVES * 64, LDS_BYTES) != hipSuccess || per_cu < 1)
            fprintf(stderr, "kernel_launch: note: occupancy query reports %d workgroups per CU\n", per_cu);
        (void)hipGetLastError();
        grid = cus;
        if (grid % 8 != 0 || grid < 2 * (BATCH * NH * 2)) { fprintf(stderr, "kernel_launch: needs a CU count that is a multiple of 8 (XCD-sliced FFN passes) and >= 256 workgroups' worth of chains; got %d; nothing launched\n", grid); grid = -1; return; }
    }
    if (grid < 0) return;
    if (hipMemsetAsync((char*)d_ws + WS_CTL, 0, CTL_ZERO_BYTES, stream) != hipSuccess) { fprintf(stderr, "kernel_launch: hipMemsetAsync failed\n"); return; }
    Args a{};
    for (int i = 0; i < 27; ++i) a.in[i] = (const float*)d_in[i];
    a.out = (float*)d_out; a.ws = (unsigned char*)d_ws;
#ifndef MK_RANGES
#define MK_RANGES {{0, N_PHASES}}
#endif
    static const int ranges[][2] = MK_RANGES;
    const int nl = (int)(sizeof(ranges) / sizeof(ranges[0]));
    for (int li = 0; li < nl; ++li) {
        a.ph_lo = ranges[li][0]; a.ph_hi = ranges[li][1]; a.li = li;
        hipLaunchKernelGGL(mk_fwd, dim3(grid), dim3(NWAVES * 64), LDS_BYTES, stream, a);
        const hipError_t le = hipPeekAtLastError();
        if (le != hipSuccess) { fprintf(stderr, "kernel_launch: launch %d failed: %s\n", li, hipGetErrorName(le)); break; }
    }
}
```

```cpp
#include <hip/hip_runtime.h>
#include <cstdio>
#include <cstdint>
#include <cmath>
namespace pg8 {
#define PG8_LAS __attribute__((address_space(3)))
typedef unsigned short bf16_t;
typedef short bf16x8 __attribute__((ext_vector_type(8)));
typedef float f32x4 __attribute__((ext_vector_type(4)));
typedef unsigned u32x4 __attribute__((ext_vector_type(4)));
constexpr int BM = 256, BK = 64, HALF = 128, HTB = HALF * BK * 2  , STAGE_BYTES = 8 * HTB, NXCD = 8, WGM = 8;

__host__ __device__ __forceinline__ int lds_byte(int r, int c) { const int st = (r >> 4) * 2 + (c >> 5), rr = r & 15, cc = c & 31, ob = rr * 64 + cc * 2; return st * 1024 + (ob ^ (((ob >> 9) & 1) << 5)); }
__host__ __device__ __forceinline__ void stage_rc(int b, int& R, int& C) { const int st = b / 1024, sb = b % 1024, swz = sb ^ (((sb >> 9) & 1) << 5); R = (st >> 1) * 16 + swz / 64; C = (st & 1) * 32 + (swz % 64) / 2; }
__host__ __device__ __forceinline__ int perm32(int rho) { const int n = rho >> 4, i = rho & 15; return 8 * (i >> 2) + 4 * n + (i & 3); }

struct Unit { int pm, pn; };
struct Gemm { const bf16_t* A; const bf16_t* Bt; int M, N, K; };

struct StaticOrder {
    int nM, nN, nwg, G, c;
    __host__ __device__ void init(int M, int N, int G_, int c_) { nM = M / BM; nN = N / BM; nwg = nM * nN; G = G_; c = c_; }
    __host__ __device__ bool next(int i, Unit& u) const {
        const long L = (long)i * G + c; if (L >= nwg) return false;
        int wgid = (int)L; { const int q = nwg / NXCD, r = nwg % NXCD, xcd = wgid % NXCD, off = wgid / NXCD; wgid = (xcd < r ? xcd * (q + 1) : r * (q + 1) + (xcd - r) * q) + off; }
        const int nig = WGM * nN, gid = wgid / nig, fm = gid * WGM, gsz = (nM - fm) < WGM ? (nM - fm) : WGM;
        u.pm = fm + ((wgid % nig) % gsz); u.pn = (wgid % nig) / gsz; return true;
    }
    __device__ __forceinline__ void a_ready(const Unit&) const {}
    __device__ __forceinline__ void done(const Unit&) const {}
};

__device__ __forceinline__ unsigned cvt_pk_bf16(float lo, float hi) { unsigned r; asm volatile("v_cvt_pk_bf16_f32 %0, %1, %2" : "=v"(r) : "v"(lo), "v"(hi)); return r; }
typedef float f32x2 __attribute__((ext_vector_type(2)));
__device__ __forceinline__ f32x2 gelu_pk(f32x2 v) {
    const f32x2 av = __builtin_elementwise_abs(v), d = av * 0.2316418882f + 1.0f;
    f32x2 t; t.x = __builtin_amdgcn_rcpf(d.x); t.y = __builtin_amdgcn_rcpf(d.y);
    f32x2 q = t * 0.5307027145f + (-0.7265760135f); q = q * t + 0.7107068705f; q = q * t + (-0.142248368f); q = q * t + 0.127414796f; q = q * t;
    const f32x2 s = (v * v) * (-0.72134752044f);
    f32x2 e; e.x = __builtin_amdgcn_exp2f(s.x); e.y = __builtin_amdgcn_exp2f(s.y);
    const f32x2 m = v * (q * e), r = v - m;
    f32x2 o; o.x = v.x < 0.f ? m.x : r.x; o.y = v.y < 0.f ? m.y : r.y; return o;
}

template <int ACT  > struct EpiBf16 {
    static constexpr bool PERM = true, AFTER_DRAIN = false; static_assert(ACT == 0 || ACT == 1, "EpiBf16: ACT is 0 (none) or 1 (gelu_pk)");
    bf16_t* O; int ldc; const float* bias; int split_cols; size_t split_stride; float scale0;
    __device__ __forceinline__ void operator()(const f32x4 (&acc)[2][2][4][2], const Unit& u, int wr, int wc, int fr, int fq) const {
        const int row0 = u.pm * BM + wr * 64 + fr; int colt = u.pn * BM; bf16_t* base = O;
        float sc = 1.f; if (split_cols) { const int t = colt / split_cols; base += (size_t)t * split_stride; colt -= t * split_cols; if (t == 0) sc = scale0; }
        const int col0 = colt + wc * 32 + 8 * fq, bcol0 = u.pn * BM + wc * 32 + 8 * fq;
        f32x4 bv[2][2];
#pragma unroll
        for (int bj = 0; bj < 2; ++bj)
#pragma unroll
            for (int n = 0; n < 2; ++n) bv[bj][n] = bias ? *(const f32x4*)(bias + bcol0 + bj * HALF + 4 * n) : (f32x4){0.f, 0.f, 0.f, 0.f};
#pragma unroll
        for (int ai = 0; ai < 2; ++ai)
#pragma unroll
            for (int m = 0; m < 4; ++m) { bf16_t* rowp = base + (size_t)(row0 + ai * HALF + m * 16) * ldc + col0;
#pragma unroll
                for (int bj = 0; bj < 2; ++bj) { f32x4 v0 = acc[ai][bj][m][0] + bv[bj][0], v1 = acc[ai][bj][m][1] + bv[bj][1];
                    if (ACT == 1) { f32x2 a = gelu_pk((f32x2){v0[0], v0[1]}), b = gelu_pk((f32x2){v0[2], v0[3]}), c = gelu_pk((f32x2){v1[0], v1[1]}), d = gelu_pk((f32x2){v1[2], v1[3]});
                        v0 = (f32x4){a.x, a.y, b.x, b.y}; v1 = (f32x4){c.x, c.y, d.x, d.y}; }
                    v0 = v0 * sc; v1 = v1 * sc; u32x4 w; w.x = cvt_pk_bf16(v0[0], v0[1]); w.y = cvt_pk_bf16(v0[2], v0[3]); w.z = cvt_pk_bf16(v1[0], v1[1]); w.w = cvt_pk_bf16(v1[2], v1[3]);
                    *(u32x4*)(rowp + bj * HALF) = w; } }
    }
};

template <class Epi, class Sched, bool ALIGN_EPI = false, bool SP2 = false>
__device__ __forceinline__ void gemm_phase(PG8_LAS unsigned char* lds, const Gemm g, const Sched& S, const Epi& E) {
    const int tid = threadIdx.x, wid = __builtin_amdgcn_readfirstlane(tid >> 6), lane = tid & 63, wr = wid >> 2, wc = wid & 3, fr = lane & 15, fq = lane >> 4;
    const int K = g.K, nt = K / BK;
    unsigned voffA[2], voffB[2];
#pragma unroll
    for (int i = 0; i < 2; ++i) { int R, C; stage_rc(tid * 16 + i * 8192, R, C); const int Rb = Epi::PERM ? ((R & ~31) + perm32(R & 31)) : R;
        voffA[i] = (unsigned)(R * K + C) * 2u; voffB[i] = (unsigned)(Rb * K + C) * 2u; }
    const size_t kstep = (size_t)(BK * 2);
    const size_t hstep = (size_t)HALF * K * 2;
    const size_t tstep = 2 * hstep;
    const unsigned ldsw = (unsigned)wid * 1024u;
    const int aoff = lds_byte(wr * 64 + fr, fq * 8), boff = lds_byte(wc * 32 + fr, fq * 8);
#define PG8_SA(b, h) (((b) * 2 + (h)) * HTB)
#define PG8_SB(b, h) ((4 + (b) * 2 + (h)) * HTB)
#define PG8_STAGE(bufoff, gbase, voff) do { _Pragma("unroll") for (int _i = 0; _i < 2; ++_i) \
        __builtin_amdgcn_global_load_lds((const unsigned*)((const char*)(gbase) + (voff)[_i]), (PG8_LAS unsigned*)(lds + (bufoff) + ldsw + _i * 8192), 16, 0, 0); } while (0)
#define PG8_LDA(dst, b, h) do { _Pragma("unroll") for (int m = 0; m < 4; ++m) _Pragma("unroll") for (int k = 0; k < 2; ++k) dst[m][k] = *(const PG8_LAS bf16x8*)(lds + PG8_SA(b, h) + aoff + m * 2048 + k * 1024); } while (0)
#define PG8_LDB(dst, b, h) do { _Pragma("unroll") for (int n = 0; n < 2; ++n) _Pragma("unroll") for (int k = 0; k < 2; ++k) dst[n][k] = *(const PG8_LAS bf16x8*)(lds + PG8_SB(b, h) + boff + n * 2048 + k * 1024); } while (0)
#define PG8_MMA(ai, bj, At, Bt) do { __builtin_amdgcn_s_setprio(1); _Pragma("unroll") for (int m = 0; m < 4; ++m) _Pragma("unroll") for (int n = 0; n < 2; ++n) _Pragma("unroll") for (int k = 0; k < 2; ++k) \
        acc[ai][bj][m][n] = __builtin_amdgcn_mfma_f32_16x16x32_bf16(Bt[n][k], At[m][k], acc[ai][bj][m][n], 0, 0, 0); __builtin_amdgcn_s_setprio(0); } while (0)
#define PG8_WAIT_V(n) asm volatile("s_waitcnt vmcnt(" #n ")" ::: "memory")
#define PG8_WAIT_L(n) asm volatile("s_waitcnt lgkmcnt(" #n ")" ::: "memory")
#define PG8_BAR __builtin_amdgcn_s_barrier()
#define PG8_SCHED __builtin_amdgcn_sched_barrier(0)
    Unit cur, nxt; int ui = 0;
    if (!S.next(0, cur)) return;
    f32x4 acc[2][2][4][2];
#pragma unroll
    for (int a = 0; a < 2; ++a)
#pragma unroll
        for (int b = 0; b < 2; ++b)
#pragma unroll
            for (int m = 0; m < 4; ++m)
#pragma unroll
                for (int n = 0; n < 2; ++n) acc[a][b][m][n] = (f32x4){0.f, 0.f, 0.f, 0.f};
    bf16x8 At[4][2], B0[2][2], B1[2][2];
    const char* cA = (const char*)g.A + (size_t)cur.pm * tstep; const char* cB = (const char*)g.Bt + (size_t)cur.pn * tstep;
    S.a_ready(cur);
    if constexpr (SP2) {
        PG8_STAGE(PG8_SB(0, 0), cB, voffB); PG8_STAGE(PG8_SB(0, 1), cB + hstep, voffB); PG8_STAGE(PG8_SA(0, 0), cA, voffA); PG8_STAGE(PG8_SA(0, 1), cA + hstep, voffA);
        if (wr == 1) PG8_BAR;
        PG8_WAIT_V(2); PG8_BAR;
        PG8_STAGE(PG8_SB(1, 0), cB + kstep, voffB); PG8_STAGE(PG8_SA(1, 0), cA + kstep, voffA); PG8_STAGE(PG8_SB(1, 1), cB + hstep + kstep, voffB);
        PG8_WAIT_V(6); PG8_BAR;
    } else {
        PG8_STAGE(PG8_SB(0, 0), cB, voffB); PG8_STAGE(PG8_SA(0, 0), cA, voffA); PG8_STAGE(PG8_SB(0, 1), cB + hstep, voffB); PG8_STAGE(PG8_SA(0, 1), cA + hstep, voffA);
        if (wr == 1) PG8_BAR;
        PG8_WAIT_V(4); PG8_BAR;
        PG8_STAGE(PG8_SB(1, 0), cB + kstep, voffB); PG8_STAGE(PG8_SA(1, 0), cA + kstep, voffA); PG8_STAGE(PG8_SB(1, 1), cB + hstep + kstep, voffB);
        PG8_WAIT_V(6); PG8_BAR;
    }
    for (;;) {
        const bool has_next = S.next(ui + 1, nxt);
        const char* nA = has_next ? (const char*)g.A + (size_t)nxt.pm * tstep : cA; const char* nB = has_next ? (const char*)g.Bt + (size_t)nxt.pn * tstep : cB;
        for (int t = 0; t < nt; t += 2) {
            const bool last = (t == nt - 2);
            const char* a1 = cA + (size_t)(t + 1) * kstep;
            const char* a2 = last ? nA : cA + (size_t)(t + 2) * kstep; const char* b2 = last ? nB : cB + (size_t)(t + 2) * kstep;
            const char* a3 = a2 + kstep; const char* b3 = b2 + kstep;
            if (last && has_next) S.a_ready(nxt);
            if constexpr (SP2) {
            PG8_LDB(B0, 0, 0); PG8_LDB(B1, 0, 1); PG8_SCHED; PG8_LDA(At, 0, 0); PG8_STAGE(PG8_SA(1, 1), a1 + hstep, voffA);
            PG8_WAIT_V(8); PG8_WAIT_L(0); PG8_BAR; PG8_MMA(0, 0, At, B0); PG8_MMA(0, 1, At, B1); PG8_BAR; PG8_SCHED;
            PG8_LDA(At, 0, 1); PG8_STAGE(PG8_SB(0, 0), b2, voffB); PG8_STAGE(PG8_SB(0, 1), b2 + hstep, voffB); PG8_STAGE(PG8_SA(0, 0), a2, voffA);
            PG8_WAIT_V(8); PG8_WAIT_L(0); PG8_BAR; PG8_MMA(1, 0, At, B0); PG8_MMA(1, 1, At, B1); PG8_BAR; PG8_SCHED;
            PG8_LDB(B0, 1, 0); PG8_LDB(B1, 1, 1); PG8_SCHED; PG8_LDA(At, 1, 0); PG8_STAGE(PG8_SA(0, 1), a2 + hstep, voffA);
            PG8_WAIT_V(8); PG8_WAIT_L(0); PG8_BAR; PG8_MMA(0, 0, At, B0); PG8_MMA(0, 1, At, B1); PG8_BAR; PG8_SCHED;
            PG8_LDA(At, 1, 1); PG8_STAGE(PG8_SB(1, 0), b3, voffB); PG8_STAGE(PG8_SB(1, 1), b3 + hstep, voffB); PG8_STAGE(PG8_SA(1, 0), a3, voffA);
            PG8_WAIT_V(8); PG8_WAIT_L(0); PG8_BAR; PG8_MMA(1, 0, At, B0); PG8_MMA(1, 1, At, B1); PG8_BAR; PG8_SCHED;
            } else {
            PG8_LDB(B0, 0, 0); PG8_SCHED; PG8_LDA(At, 0, 0); PG8_STAGE(PG8_SA(1, 1), a1 + hstep, voffA);
            PG8_WAIT_L(8); PG8_BAR; PG8_WAIT_L(0); PG8_MMA(0, 0, At, B0); PG8_BAR; PG8_SCHED;
            PG8_LDB(B1, 0, 1); PG8_STAGE(PG8_SB(0, 0), b2, voffB);
            PG8_BAR; PG8_WAIT_L(0); PG8_MMA(0, 1, At, B1); PG8_BAR;
            PG8_LDA(At, 0, 1); PG8_STAGE(PG8_SA(0, 0), a2, voffA);
            PG8_BAR; PG8_WAIT_L(0); PG8_MMA(1, 0, At, B0); PG8_BAR; PG8_SCHED;
            PG8_STAGE(PG8_SB(0, 1), b2 + hstep, voffB);
            PG8_WAIT_V(6); PG8_BAR; PG8_MMA(1, 1, At, B1); PG8_BAR;
            PG8_LDB(B0, 1, 0); PG8_SCHED; PG8_LDA(At, 1, 0); PG8_STAGE(PG8_SA(0, 1), a2 + hstep, voffA);
            PG8_WAIT_L(8); PG8_BAR; PG8_WAIT_L(0); PG8_MMA(0, 0, At, B0); PG8_BAR; PG8_SCHED;
            PG8_LDB(B1, 1, 1); PG8_STAGE(PG8_SB(1, 0), b3, voffB);
            PG8_BAR; PG8_WAIT_L(0); PG8_MMA(0, 1, At, B1); PG8_BAR;
            PG8_LDA(At, 1, 1); PG8_STAGE(PG8_SA(1, 0), a3, voffA);
            PG8_BAR; PG8_WAIT_L(0); PG8_MMA(1, 0, At, B0); PG8_BAR; PG8_SCHED;
            PG8_STAGE(PG8_SB(1, 1), b3 + hstep, voffB);
            PG8_WAIT_V(6); PG8_BAR; PG8_MMA(1, 1, At, B1); PG8_BAR;
            }
        }
        if constexpr (ALIGN_EPI) { if (wr == 0) PG8_BAR; }
        if constexpr (!Epi::AFTER_DRAIN) { E(acc, cur, wr, wc, fr, fq); S.done(cur); }
        if (!has_next) break;
#pragma unroll
        for (int a = 0; a < 2; ++a)
#pragma unroll
            for (int b = 0; b < 2; ++b)
#pragma unroll
                for (int m = 0; m < 4; ++m)
#pragma unroll
                    for (int n = 0; n < 2; ++n) acc[a][b][m][n] = (f32x4){0.f, 0.f, 0.f, 0.f};
        cur = nxt; cA = nA; cB = nB; ++ui;
        if constexpr (ALIGN_EPI) { if (wr == 1) PG8_BAR; }
    }
    PG8_WAIT_V(0);
    if constexpr (!ALIGN_EPI) { if (wr == 0) PG8_BAR; }
    PG8_BAR;
    if constexpr (Epi::AFTER_DRAIN) { E.fused(acc, cur, wr, wc, fr, fq, lds, wid, lane); S.done(cur); }
#undef PG8_SA
#undef PG8_SB
#undef PG8_STAGE
#undef PG8_LDA
#undef PG8_LDB
#undef PG8_MMA
#undef PG8_WAIT_V
#undef PG8_WAIT_L
#undef PG8_BAR
#undef PG8_SCHED
}
}
#define GAS __attribute__((address_space(1)))
#define LAS __attribute__((address_space(3)))
typedef unsigned short bf16;
typedef unsigned v4u __attribute__((ext_vector_type(4)));
typedef float f32x4 __attribute__((ext_vector_type(4)));
typedef short bf16x8 __attribute__((ext_vector_type(8)));
typedef GAS unsigned gu32;
typedef GAS unsigned long long gu64;
#define RLX_AGENT __ATOMIC_RELAXED, __HIP_MEMORY_SCOPE_AGENT
#define LDS_WAIT() asm volatile("s_waitcnt lgkmcnt(0)" ::: "memory")
#define VM_WAIT() asm volatile("s_waitcnt vmcnt(0)" ::: "memory")
__device__ __forceinline__ unsigned long long rt() { return __builtin_amdgcn_s_memrealtime(); }
__device__ __forceinline__ unsigned f2bf(float f) { unsigned u = __builtin_bit_cast(unsigned, f); return (u + 0x7fffu + ((u >> 16) & 1u)) >> 16; }
__device__ __forceinline__ unsigned pk2(float lo, float hi) { return f2bf(lo) | (f2bf(hi) << 16); }

#define XB_TMO      128
#define XB_XCNT(j)  (256  + 64 * (j))
#define XB_XSUB(j)  (1280 + 64 * (j))
#define XB_XGEN(j)  (2304 + 64 * (j))
#define XB_TOP      3328
#define XB_TOPGEN   3392
#define XCD_BAR_WORDS 3456
#define XB_SPIN_CAP (1u << 18)

__device__ __forceinline__ unsigned xb_ld(unsigned* p)              { return __hip_atomic_load(p, __ATOMIC_RELAXED, __HIP_MEMORY_SCOPE_AGENT); }
__device__ __forceinline__ unsigned xb_add(unsigned* p, unsigned v) { return __hip_atomic_fetch_add(p, v, __ATOMIC_RELAXED, __HIP_MEMORY_SCOPE_AGENT); }
__device__ __forceinline__ unsigned xb_xcc_id() { return (unsigned)__builtin_amdgcn_s_getreg((3 << 11) | 20) & 0xFu; }
#define XB_SPIN(cond, bar) do { unsigned _sp = 0; while (cond) { __builtin_amdgcn_s_sleep(1); \
    if ((++_sp & 255u) == 0u) { if (xb_ld(&(bar)[XB_TMO])) break; if (_sp > XB_SPIN_CAP) { atomicAdd(&(bar)[XB_TMO], 1u); break; } } } } while (0)

struct XcdBarrier {
    unsigned* bar; unsigned x;
    volatile LAS unsigned* st;
};

__device__ __forceinline__ XcdBarrier xcd_barrier_post(unsigned* bar, volatile LAS unsigned* st) {
    XcdBarrier b; b.bar = bar; b.x = xb_xcc_id(); b.st = st;
    if (threadIdx.x == 0) (void)xb_add(&bar[XB_XCNT(b.x)], 1u);
    return b;
}
__device__ __forceinline__ void xcd_barrier_complete(unsigned* bar, unsigned x, unsigned& nloc, unsigned& nx) {
    const unsigned G = gridDim.x * gridDim.y * gridDim.z;
    unsigned sum, cnt, mine, sp = 0u;
    for (;;) {
        sum = 0u; cnt = 0u; mine = 0u;
#pragma unroll
        for (unsigned j = 0; j < 16; ++j) { const unsigned c = xb_ld(&bar[XB_XCNT(j)]); sum += c; cnt += (c > 0u) ? 1u : 0u; mine = (j == x) ? c : mine; }
        if (sum == G) break;
        __builtin_amdgcn_s_sleep(1);
        if ((++sp & 255u) == 0u) { if (xb_ld(&bar[XB_TMO])) break; if (sp > XB_SPIN_CAP) { atomicAdd(&bar[XB_TMO], 1u); break; } }
    }
    nloc = mine > 0u ? mine : 1u; nx = cnt > 0u ? cnt : 1u;
}

__device__ __forceinline__ void xcd_barrier(const XcdBarrier& b) {
    asm volatile("s_waitcnt vmcnt(0)" ::: "memory");
    __syncthreads();
    if (threadIdx.x == 0) {
        unsigned* bar = b.bar;
        __builtin_amdgcn_s_waitcnt(0);
        unsigned nloc = b.st[0], nx = b.st[1];
        if (nloc == 0u) { xcd_barrier_complete(bar, b.x, nloc, nx); b.st[0] = nloc; b.st[1] = nx; }
        const unsigned old = xb_add(&bar[XB_XSUB(b.x)], 1u);
        const unsigned gen = old / nloc;
        if (old + 1u == (gen + 1u) * nloc) {
            __builtin_amdgcn_fence(__ATOMIC_RELEASE, "agent");
            asm volatile("s_waitcnt vmcnt(0)" ::: "memory");
            const unsigned og = xb_add(&bar[XB_TOP], 1u);
            const unsigned tg = og / nx;
            if (og + 1u == (tg + 1u) * nx) xb_add(&bar[XB_TOPGEN], 1u);
            else XB_SPIN(xb_ld(&bar[XB_TOPGEN]) == tg, bar);
            __builtin_amdgcn_fence(__ATOMIC_ACQUIRE, "agent");
            xb_add(&bar[XB_XGEN(b.x)], 1u);
            asm volatile("s_waitcnt vmcnt(0)" ::: "memory");
        } else {
            XB_SPIN(xb_ld(&bar[XB_XGEN(b.x)]) == gen, bar);
            __builtin_amdgcn_fence(__ATOMIC_ACQUIRE, "agent");
            asm volatile("s_waitcnt vmcnt(0)" ::: "memory");
        }
    }
    __syncthreads();
}
constexpr int NWAVES = 8;
constexpr int D = 1024, BATCH = 8, SEQ = 2048, T = BATCH * SEQ;
constexpr int AW = 512, RW = 512, NH = 8;
constexpr int DL = 64, AL = 64, GL = 128;
constexpr int SHIFTW = 3 * RW + DL + AL + GL;
constexpr int INW = 3 * AW + SHIFTW;
constexpr int NKEYS = 128, PH = 8, PKD = 256, TOPK = 16, HK = PH * TOPK;
constexpr int QW = PH * PKD;
constexpr int MODW = 6 * D;

constexpr size_t MiB = 1u << 20;
constexpr size_t WS_CTL = 0, CTL_ZERO_BYTES = 1 * MiB + 256 * 1024;
constexpr size_t WS_MOD = 1 * MiB;
constexpr size_t WS_KEYS = 1 * MiB + 512 * 1024;
constexpr size_t WS_WIN = 2 * MiB;
constexpr size_t WS_WOUT = 9 * MiB;
constexpr size_t WS_WQ = 11 * MiB;
constexpr size_t WS_XN = 16 * MiB;
constexpr size_t WS_O3 = 16 * MiB;
constexpr size_t WS_LSE = 32 * MiB;
constexpr size_t WS_Z = 48 * MiB;
constexpr size_t WS_MIX = 152 * MiB;
constexpr size_t WS_Y = 184 * MiB;
constexpr size_t WS_Q = 48 * MiB;
constexpr size_t WS_IDX = 112 * MiB;
constexpr size_t WS_GATE = 120 * MiB;
constexpr size_t WS_PART = 48 * MiB;
constexpr size_t WS_XQ = 128 * MiB;
constexpr size_t WS_UT = 216 * MiB;
constexpr size_t WS_SU = 249 * MiB;
constexpr size_t WS_VT = 232 * MiB;
constexpr size_t WS_BON = 248 * MiB;
constexpr size_t WS_END = 250 * MiB;
constexpr int CW_WORK = 1024;
constexpr int CW_WORK2 = 2048;
constexpr int CW_BAR = 4096;
constexpr int MAX_LAUNCHES = 12;

constexpr int RING_OFF = 0, RING_BYTES = 139264;
constexpr int LDSCTL_OFF = RING_BYTES, MISC_OFF = LDSCTL_OFF + 320;
constexpr int LDS_BYTES = 147456;
static_assert(MISC_OFF + 128 <= LDS_BYTES, "LDS map");

typedef GAS float gf32;
typedef GAS f32x4 gf32x4;

__device__ __forceinline__ float bf2f(bf16 v) { return __uint_as_float(((unsigned)v) << 16); }
__device__ __forceinline__ float wave_sum(float v) {
#pragma unroll
    for (int o = 1; o < 64; o <<= 1) v += __shfl_xor(v, o);
    return v;
}
#define WAVE_LDS_SYNC() do { asm volatile("s_waitcnt lgkmcnt(0)" ::: "memory"); __builtin_amdgcn_wave_barrier(); } while (0)

__device__ __forceinline__ void p0_transpose_item(const float* W, int K, int N, bf16* WT, int row_off, LAS float* scr, int item, int lane) {
    const int nblk = N / 32, kb = item / nblk, nb = item % nblk, k0 = 64 * kb, n0 = 32 * nb;
#pragma unroll 8
    for (int i = 0; i < 32; ++i) { const int kk = 2 * i + (lane >> 5); scr[kk * 33 + (lane & 31)] = W[(size_t)(k0 + kk) * N + n0 + (lane & 31)]; }
    LDS_WAIT(); asm volatile("" ::: "memory");
    const int c = lane & 7;
#pragma unroll
    for (int j = 0; j < 4; ++j) { const int n = (lane >> 3) + 8 * j; const LAS float* s = scr + (8 * c) * 33 + n;
        v4u o; o.x = pk2(s[0 * 33], s[1 * 33]); o.y = pk2(s[2 * 33], s[3 * 33]); o.z = pk2(s[4 * 33], s[5 * 33]); o.w = pk2(s[6 * 33], s[7 * 33]);
        *(GAS v4u*)(WT + (size_t)(row_off + n0 + n) * K + k0 + 8 * c) = o; }
    LDS_WAIT(); asm volatile("" ::: "memory");
}

__device__ __forceinline__ void norm_rows(const float* x, const float* g, const float* mod, int shift_off, int scale_off, bf16* o, int gw, int ngw, int lane) {
    f32x4 nx[4];
    if (gw < T) {
#pragma unroll
        for (int j = 0; j < 4; ++j) nx[j] = ((const GAS f32x4*)(x + (size_t)gw * D) + lane)[64 * j]; }
    for (int m = gw; m < T; m += ngw) {
        f32x4 v[4]; float s = 0.f;
#pragma unroll
        for (int j = 0; j < 4; ++j) { v[j] = nx[j]; s += (v[j].x * v[j].x + v[j].y * v[j].y) + (v[j].z * v[j].z + v[j].w * v[j].w); }
        if (m + ngw < T) {
#pragma unroll
            for (int j = 0; j < 4; ++j) nx[j] = ((const GAS f32x4*)(x + (size_t)(m + ngw) * D) + lane)[64 * j]; }
        const float* modb = mod + (m / SEQ) * MODW;
        const float rs = 1.0f / sqrtf(wave_sum(s) * (1.f / D) + 1e-6f);
        GAS unsigned long long* o8 = (GAS unsigned long long*)(o + (size_t)m * D) + lane;
#pragma unroll
        for (int j = 0; j < 4; ++j) {
            const int col = 256 * j + 4 * lane;
            const f32x4 g4 = *(const GAS f32x4*)(g + col), sc = *(const GAS f32x4*)(modb + scale_off + col), sh = *(const GAS f32x4*)(modb + shift_off + col);
            const f32x4 y = v[j] * rs * g4 * (sc + 1.0f) + sh;
            o8[64 * j] = (unsigned long long)pk2(y.x, y.y) | ((unsigned long long)pk2(y.z, y.w) << 32);
        }
    }
}
__device__ __forceinline__ void norm_rows_q(const float* x, const float* g, const float* mod, int shift_off, int scale_off, bf16* o, unsigned char* q, float* qscale, int gw, int ngw, int lane) {
    f32x4 nx[4];
    if (gw < T) {
#pragma unroll
        for (int j = 0; j < 4; ++j) nx[j] = ((const GAS f32x4*)(x + (size_t)gw * D) + lane)[64 * j]; }
    for (int m = gw; m < T; m += ngw) {
        f32x4 v[4]; float s = 0.f;
#pragma unroll
        for (int j = 0; j < 4; ++j) { v[j] = nx[j]; s += (v[j].x * v[j].x + v[j].y * v[j].y) + (v[j].z * v[j].z + v[j].w * v[j].w); }
        if (m + ngw < T) {
#pragma unroll
            for (int j = 0; j < 4; ++j) nx[j] = ((const GAS f32x4*)(x + (size_t)(m + ngw) * D) + lane)[64 * j]; }
        const float* modb = mod + (m / SEQ) * MODW;
        const float rs = 1.0f / sqrtf(wave_sum(s) * (1.f / D) + 1e-6f);
        GAS unsigned long long* o8 = (GAS unsigned long long*)(o + (size_t)m * D) + lane;
        float mx = 0.f;
#pragma unroll
        for (int j = 0; j < 4; ++j) {
            const int col = 256 * j + 4 * lane;
            const f32x4 g4 = *(const GAS f32x4*)(g + col), sc = *(const GAS f32x4*)(modb + scale_off + col), sh = *(const GAS f32x4*)(modb + shift_off + col);
            const f32x4 y = v[j] * rs * g4 * (sc + 1.0f) + sh;
            v[j] = y; mx = fmaxf(mx, fmaxf(fmaxf(fabsf(y.x), fabsf(y.y)), fmaxf(fabsf(y.z), fabsf(y.w))));
            o8[64 * j] = (unsigned long long)pk2(y.x, y.y) | ((unsigned long long)pk2(y.z, y.w) << 32);
        }
#pragma unroll
        for (int oo = 1; oo < 64; oo <<= 1) mx = fmaxf(mx, __shfl_xor(mx, oo));
        mx = fmaxf(mx, 1e-30f);
        const float inv = 127.0f / mx;
#pragma unroll
        for (int j = 0; j < 4; ++j) {
            const int ia = (int)rintf(v[j].x * inv), ib = (int)rintf(v[j].y * inv), ic = (int)rintf(v[j].z * inv), id = (int)rintf(v[j].w * inv);
            *(GAS unsigned*)(q + (size_t)m * D + 256 * j + 4 * lane) = (unsigned)(ia & 0xff) | ((unsigned)(ib & 0xff) << 8) | ((unsigned)(ic & 0xff) << 16) | ((unsigned)id << 24);
        }
        if (lane == 0) qscale[m] = mx * (1.0f / 127.0f);
    }
}

struct EpiRes {
    static constexpr bool PERM = false, AFTER_DRAIN = false;
    const float* xres; const float* mod; int gate_off; float* out; int ldc;
    __device__ __forceinline__ void operator()(const pg8::f32x4 (&acc)[2][2][4][2], const pg8::Unit& u, int wr, int wc, int fr, int fq) const {
        const int col0 = u.pn * pg8::BM + wc * 32 + 4 * fq;
        const int b = (u.pm * pg8::BM) / SEQ;
        pg8::f32x4 gv[2][2];
#pragma unroll
        for (int bj = 0; bj < 2; ++bj)
#pragma unroll
            for (int n = 0; n < 2; ++n) gv[bj][n] = *(const pg8::f32x4*)(mod + b * MODW + gate_off + col0 + bj * pg8::HALF + n * 16);
#pragma unroll
        for (int ai = 0; ai < 2; ++ai)
#pragma unroll
            for (int m = 0; m < 4; ++m) { const size_t off = (size_t)(u.pm * pg8::BM + ai * pg8::HALF + wr * 64 + m * 16 + fr) * ldc + col0;
#pragma unroll
                for (int bj = 0; bj < 2; ++bj)
#pragma unroll
                    for (int n = 0; n < 2; ++n) { const pg8::f32x4 bs = *(const pg8::f32x4*)(xres + off + bj * pg8::HALF + n * 16);
                        *(pg8::f32x4*)(out + off + bj * pg8::HALF + n * 16) = bs + gv[bj][n] * acc[ai][bj][m][n]; } }
    }
};

namespace scan {
typedef unsigned u32x2 __attribute__((ext_vector_type(2)));
constexpr int SLOT = 1024, BUF_BYTES = 12800, NBUF = 8;
constexpr int OFF_LORA = NBUF * BUF_BYTES;
constexpr int OFF_CONST = OFF_LORA + 16 * SLOT;
constexpr int OFF_MT = OFF_CONST + 5120;
constexpr int SCAN_LDS = OFF_MT + 8 * 1024;
static_assert(SCAN_LDS <= 139264, "scan LDS map");
constexpr int S_KK = 0, S_R = 2, S_MT = 4, S_N = 5, S_BK = 6, S_V = 10, S_GC = 12;

typedef float f32x2n __attribute__((ext_vector_type(2)));
typedef __bf16 bf16x2n __attribute__((ext_vector_type(2)));
__device__ __forceinline__ unsigned cvtpk(float lo, float hi) { const f32x2n v = {lo, hi}; const bf16x2n b = __builtin_convertvector(v, bf16x2n); return __builtin_bit_cast(unsigned, b); }
__device__ __forceinline__ bf16x8 mkfrag(unsigned a, unsigned b, unsigned c, unsigned d) { v4u w; w.x = a; w.y = b; w.z = c; w.w = d; return __builtin_bit_cast(bf16x8, w); }
__device__ __forceinline__ bf16x8 frag8(const float (&lo)[4], const float (&hi)[4]) { return mkfrag(cvtpk(lo[0], lo[1]), cvtpk(lo[2], lo[3]), cvtpk(hi[0], hi[1]), cvtpk(hi[2], hi[3])); }
__device__ __forceinline__ f32x4 mma(bf16x8 a, bf16x8 b, f32x4 c) { return __builtin_amdgcn_mfma_f32_16x16x32_bf16(a, b, c, 0, 0, 0); }
template <int N> __device__ __forceinline__ float row_shr(float x) { return __int_as_float(__builtin_amdgcn_update_dpp(0, __float_as_int(x), 0x110 + N, 0xf, 0xf, true)); }
__device__ __forceinline__ float fsigmoid(float x) { return __builtin_amdgcn_rcpf(1.0f + __expf(-x)); }
__device__ __forceinline__ bf16 tobf(float x) { return (bf16)(cvtpk(x, x) & 0xffffu); }

__device__ __forceinline__ void setup(LAS unsigned char* L, int h, int dir, const float* mu_prev, const float* mu_next, const float* w_decay0, const float* w_decay_up,
                                      const float* a_gate0, const float* a_gate_up, const float* k_k, const float* k_a, const float* r_k, int tid) {
    LAS float* C = (LAS float*)(L + OFF_CONST);
    for (int i = tid; i < 320; i += 512) {
        const int grp = i >> 6, c = i & 63;
        const int col = (grp < 3) ? grp * RW + h * 64 + c : 3 * RW + (grp - 3) * 64 + c;
        C[i] = mu_prev[col]; C[320 + i] = mu_next[col]; C[960 + i] = 1.0f - mu_prev[col] - mu_next[col];
    }
    if (tid < 64) { const int hc = h * 64 + tid; C[640 + tid] = w_decay0[dir * RW + hc]; C[704 + tid] = a_gate0[dir * RW + hc]; C[768 + tid] = k_k[hc]; C[832 + tid] = k_a[hc]; C[896 + tid] = r_k[hc]; }
    LAS bf16* F = (LAS bf16*)(L + OFF_LORA);
    for (int i = tid; i < 16 * 64 * 8; i += 512) {
        const int j = i & 7, l = (i >> 3) & 63, sl = i >> 9, m = sl & 1, ct = (sl >> 1) & 3, wa = sl >> 3;
        const int g = l >> 4, jj = 32 * m + (j < 4 ? 4 * g + j : 16 + 4 * g + j - 4), c = h * 64 + 16 * ct + (l & 15);
        const float v = wa ? a_gate_up[(size_t)(dir * AL + jj) * RW + c] : w_decay_up[(size_t)(dir * DL + jj) * RW + c];
        F[i] = (bf16)f2bf(v);
    }
}

__device__ __forceinline__ void helper_chunk(LAS unsigned char* L, LAS unsigned char* buf, LAS float* MT, const bf16* Z, float* BON, int b, int h, int dir, int n, int lane) {
    const int s = lane & 15, g = lane >> 4;
    const int cn = dir ? (SEQ / 16 - 1 - n) : n;
    const int t = cn * 16 + (dir ? 15 - s : s), tok = b * SEQ + t;
    const LAS float* C = (const LAS float*)(L + OFF_CONST);
    const bool hasp = t > 0, hasn = t < SEQ - 1;
    float rv[4][4], kv[4][4], vv[4][4], tw[4][4], xa[4][4];
    constexpr int SROW = 136, SGRP = 18 * SROW;
    {
        v4u ld[12];
#pragma unroll
        for (int i = 0; i < 12; ++i) {
            int p = 8 * i + (lane >> 3); p = p < 90 ? p : 89;
            const int grp = p / 18, row = p - 18 * grp;
            const int st = (row < 16) ? row : (row == 16 ? -1 : 16);
            int tt = cn * 16 + (dir ? 15 - st : st); tt = tt < 0 ? 0 : (tt > SEQ - 1 ? SEQ - 1 : tt);
            const int cbase = (grp < 3) ? grp * RW + h * 64 : 3 * RW + (grp - 3) * 64;
            ld[i] = *(const v4u*)(Z + (size_t)(b * SEQ + tt) * INW + 3 * AW + cbase + 8 * (lane & 7));
        }
#pragma unroll
        for (int i = 0; i < 12; ++i) {
            int p = 8 * i + (lane >> 3); p = p < 90 ? p : 89;
            const int grp = p / 18, row = p - 18 * grp;
            LAS unsigned char* q = buf + grp * SGRP + row * SROW + 16 * (lane & 7);
            *(LAS u32x2*)q = (u32x2){ld[i].x, ld[i].y}; *(LAS u32x2*)(q + 8) = (u32x2){ld[i].z, ld[i].w};
        }
    }
    asm volatile("s_waitcnt lgkmcnt(0)" ::: "memory"); __builtin_amdgcn_wave_barrier();
    {
        const int rlo = (s == 0) ? 16 : s - 1, rup = (s == 15) ? 17 : s + 1;
        const int rp = dir ? rup : rlo, rn = dir ? rlo : rup;
        typedef float f32x2s __attribute__((ext_vector_type(2)));
        const unsigned pmask = hasp ? 0xffffffffu : 0u, nmask = hasn ? 0xffffffffu : 0u;
#pragma unroll
        for (int grp = 0; grp < 5; ++grp) {
#pragma unroll
            for (int ct = 0; ct < 4; ++ct) {
                const LAS unsigned char* q = buf + grp * SGRP + 32 * ct + 8 * g;
                const u32x2 zcc = *(const LAS u32x2*)(q + s * SROW);
                u32x2 zp = *(const LAS u32x2*)(q + rp * SROW), zn = *(const LAS u32x2*)(q + rn * SROW);
                zp.x &= pmask; zp.y &= pmask; zn.x &= nmask; zn.y &= nmask;
                const f32x4 mp = *(const LAS f32x4*)(C + grp * 64 + 16 * ct + 4 * g), mn = *(const LAS f32x4*)(C + 320 + grp * 64 + 16 * ct + 4 * g), mc = *(const LAS f32x4*)(C + 960 + grp * 64 + 16 * ct + 4 * g);
                const f32x2s z01 = {__uint_as_float(zcc.x << 16), __uint_as_float(zcc.x & 0xffff0000u)}, z23 = {__uint_as_float(zcc.y << 16), __uint_as_float(zcc.y & 0xffff0000u)};
                const f32x2s p01 = {__uint_as_float(zp.x << 16), __uint_as_float(zp.x & 0xffff0000u)}, p23 = {__uint_as_float(zp.y << 16), __uint_as_float(zp.y & 0xffff0000u)};
                const f32x2s n01 = {__uint_as_float(zn.x << 16), __uint_as_float(zn.x & 0xffff0000u)}, n23 = {__uint_as_float(zn.y << 16), __uint_as_float(zn.y & 0xffff0000u)};
                const f32x2s o01 = (f32x2s){mc[0], mc[1]} * z01 + (f32x2s){mp[0], mp[1]} * p01 + (f32x2s){mn[0], mn[1]} * n01;
                const f32x2s o23 = (f32x2s){mc[2], mc[3]} * z23 + (f32x2s){mp[2], mp[3]} * p23 + (f32x2s){mn[2], mn[3]} * n23;
                const float ov[4] = {o01.x, o01.y, o23.x, o23.y};
#pragma unroll
                for (int r = 0; r < 4; ++r) {
                    const float o = ov[r];
                    if (grp == 0) rv[ct][r] = o; else if (grp == 1) kv[ct][r] = o; else if (grp == 2) vv[ct][r] = o;
                    else if (grp == 3) { const float e2 = __expf(2.0f * o); tw[ct][r] = 1.0f - 2.0f * __builtin_amdgcn_rcpf(e2 + 1.0f); } else xa[ct][r] = o;
                }
            }
            __builtin_amdgcn_sched_barrier(0);
        }
    }
    asm volatile("s_waitcnt lgkmcnt(0)" ::: "memory"); __builtin_amdgcn_wave_barrier();
#pragma unroll
    for (int ct = 0; ct < 4; ++ct)
#pragma unroll
        for (int r = 0; r < 4; ++r)
            *(LAS bf16*)(buf + (S_V + (ct >> 1)) * SLOT + (4 * g + r + 16 * (s >> 2)) * 16 + (ct & 1) * 8 + 2 * (s & 3)) = tobf(vv[ct][r]);
    f32x4 accw[4], acca[4];
    { const bf16x8 tb0 = frag8(tw[0], tw[1]), tb1 = frag8(tw[2], tw[3]), xb0 = frag8(xa[0], xa[1]), xb1 = frag8(xa[2], xa[3]);
      const LAS bf16x8* F = (const LAS bf16x8*)(L + OFF_LORA);
#pragma unroll
      for (int ct = 0; ct < 4; ++ct) {
          f32x4 z4 = {0.f, 0.f, 0.f, 0.f};
          accw[ct] = mma(F[(0 * 8 + ct * 2 + 0) * 64 + lane], tb0, z4); accw[ct] = mma(F[(0 * 8 + ct * 2 + 1) * 64 + lane], tb1, accw[ct]);
          acca[ct] = mma(F[(1 * 8 + ct * 2 + 0) * 64 + lane], xb0, z4); acca[ct] = mma(F[(1 * 8 + ct * 2 + 1) * 64 + lane], xb1, acca[ct]);
      } }
    float ev[4][4], kk[4][4], kd[4][4], bb[4][4];
    float ss = 0.f, bon = 0.f;
#pragma unroll
    for (int ct = 0; ct < 4; ++ct) {
        const f32x4 w0 = *(const LAS f32x4*)(C + 640 + 16 * ct + 4 * g), a0 = *(const LAS f32x4*)(C + 704 + 16 * ct + 4 * g), kkw = *(const LAS f32x4*)(C + 768 + 16 * ct + 4 * g),
                    kaw = *(const LAS f32x4*)(C + 832 + 16 * ct + 4 * g), rkw = *(const LAS f32x4*)(C + 896 + 16 * ct + 4 * g);
#pragma unroll
        for (int r = 0; r < 4; ++r) {
            ev[ct][r] = 0.60653065971f * fsigmoid(accw[ct][r] + w0[r]);
            const float a = fsigmoid(acca[ct][r] + a0[r]);
            const float k = kv[ct][r];
            kk[ct][r] = k * kkw[r]; ss += kk[ct][r] * kk[ct][r];
            kd[ct][r] = k * (1.0f + (a - 1.0f) * kaw[r]);
            bb[ct][r] = a;
            bon += rv[ct][r] * k * a * kaw[r] * rkw[r];
        }
        __builtin_amdgcn_sched_barrier(0);
    }
    ss += __shfl_xor(ss, 16); ss += __shfl_xor(ss, 32);
    bon += __shfl_xor(bon, 16); bon += __shfl_xor(bon, 32);
    if (g == 0) BON[((size_t)dir * T + tok) * NH + h] = bon;
    const float rn = __builtin_amdgcn_rsqf(fmaxf(ss, 1e-12f));
    bf16x8 fKKm[2], fRm[2], fBm[2], fKm[2];
#pragma unroll
    for (int m = 0; m < 2; ++m) {
        float KKs[2][4], Rs[2][4], Bt[2][4], Kt[2][4];
#pragma unroll
        for (int c2 = 0; c2 < 2; ++c2) {
            const int ct = 2 * m + c2;
            float gcv[4];
#pragma unroll
            for (int r = 0; r < 4; ++r) {
                const float e = ev[ct][r];
                float cum = e;
                cum += row_shr<1>(cum); cum += row_shr<2>(cum); cum += row_shr<4>(cum); cum += row_shr<8>(cum);
                const float cumC = __shfl(cum, (lane & 48) | 15);
                const float kkn = kk[ct][r] * rn, bv = kkn * bb[ct][r];
                const float ig = __expf(cum), gs = __builtin_amdgcn_rcpf(ig), gC = __expf(-cumC), rat = ig * gC;
                KKs[c2][r] = kkn * gs * __expf(e); Rs[c2][r] = rv[ct][r] * gs;
                Bt[c2][r] = bv * ig; Kt[c2][r] = kd[ct][r] * ig;
                gcv[r] = gC;
                LAS unsigned char* q = buf + (S_BK + ct) * SLOT + (4 * g + r + 16 * (s >> 2)) * 16 + 2 * (s & 3);
                *(LAS bf16*)q = tobf(bv * rat); *(LAS bf16*)(q + 8) = tobf(kd[ct][r] * rat);
            }
            if (s == 15) *(LAS f32x4*)(buf + S_GC * SLOT + (16 * ct + 4 * g) * 4) = (f32x4){gcv[0], gcv[1], gcv[2], gcv[3]};
        }
        fKKm[m] = frag8(KKs[0], KKs[1]); fRm[m] = frag8(Rs[0], Rs[1]); fBm[m] = frag8(Bt[0], Bt[1]); fKm[m] = frag8(Kt[0], Kt[1]);
    }
    const bf16x8 fKK0 = fKKm[0], fKK1 = fKKm[1], fR0 = fRm[0], fR1 = fRm[1], fB0 = fBm[0], fB1 = fBm[1], fK0 = fKm[0], fK1 = fKm[1];
    *(LAS bf16x8*)(buf + (S_KK + 0) * SLOT + lane * 16) = fKK0; *(LAS bf16x8*)(buf + (S_KK + 1) * SLOT + lane * 16) = fKK1;
    *(LAS bf16x8*)(buf + (S_R + 0) * SLOT + lane * 16) = fR0;  *(LAS bf16x8*)(buf + (S_R + 1) * SLOT + lane * 16) = fR1;
    const f32x4 z4 = {0.f, 0.f, 0.f, 0.f};
    { f32x4 mab = mma(fKK0, fB0, z4); mab = mma(fKK1, fB1, mab);
      *(LAS f32x4*)(MT + s * 16 + 4 * g) = mab; }
    f32x4 mak = mma(fK0, fKK0, z4); mak = mma(fK1, fKK1, mak);
    f32x4 nrb = mma(fB0, fR0, z4); nrb = mma(fB1, fR1, nrb);
    f32x4 nrk = mma(fK0, fR0, z4); nrk = mma(fK1, fR1, nrk);
#pragma unroll
    for (int r = 0; r < 4; ++r) { const int i = 4 * g + r; if (!(i < s)) mak[r] = 0.f; if (!(i <= s)) { nrb[r] = 0.f; nrk[r] = 0.f; } }
    *(LAS v4u*)(buf + S_N * SLOT + lane * 16) = (v4u){cvtpk(nrb[0], nrb[1]), cvtpk(nrb[2], nrb[3]), cvtpk(nrk[0], nrk[1]), cvtpk(nrk[2], nrk[3])};
    asm volatile("s_waitcnt lgkmcnt(0)" ::: "memory"); __builtin_amdgcn_wave_barrier();
    float Tr[16];
#pragma unroll
    for (int j = 15; j >= 0; --j) {
        float acc0 = 0.f, acc1 = 0.f;
#pragma unroll
        for (int i4 = (j + 1) / 4; i4 < 4; ++i4) {
            const f32x4 mrow = *(const LAS f32x4*)(MT + j * 16 + 4 * i4);
#pragma unroll
            for (int e = 0; e < 4; ++e) { const int i = 4 * i4 + e; if (i > j) { if (e & 1) acc1 += Tr[i] * mrow[e]; else acc0 += Tr[i] * mrow[e]; } }
        }
        Tr[j] = (j == s) ? 1.0f : -(acc0 + acc1);
        if (j > s) Tr[j] = 0.f;
    }
    float t0 = 0.f, t1 = 0.f, t2 = 0.f, t3 = 0.f;
#pragma unroll
    for (int gg = 0; gg < 4; ++gg) if (g == gg) { t0 = Tr[4 * gg]; t1 = Tr[4 * gg + 1]; t2 = Tr[4 * gg + 2]; t3 = Tr[4 * gg + 3]; }
    *(LAS v4u*)(buf + S_MT * SLOT + lane * 16) = (v4u){cvtpk(mak[0], mak[1]), cvtpk(mak[2], mak[3]), cvtpk(-t0, -t1), cvtpk(-t2, -t3)};
    asm volatile("s_waitcnt lgkmcnt(0)" ::: "memory"); __builtin_amdgcn_wave_barrier();
}

__device__ __forceinline__ void rec_chunk(const LAS unsigned char* buf, f32x4 (&st)[4], bf16* Y, int b, int h, int dir, int n, int w, int lane) {
    const int g = lane >> 4, col = lane & 15;
    const bf16x8 fKK0 = *(const LAS bf16x8*)(buf + (S_KK + 0) * SLOT + lane * 16), fKK1 = *(const LAS bf16x8*)(buf + (S_KK + 1) * SLOT + lane * 16);
    const bf16x8 fR0 = *(const LAS bf16x8*)(buf + (S_R + 0) * SLOT + lane * 16), fR1 = *(const LAS bf16x8*)(buf + (S_R + 1) * SLOT + lane * 16);
    const v4u mt = *(const LAS v4u*)(buf + S_MT * SLOT + lane * 16);
    const bf16x8 fN = *(const LAS bf16x8*)(buf + S_N * SLOT + lane * 16);
    const u32x2 vf = *(const LAS u32x2*)(buf + (S_V + (w >> 1)) * SLOT + lane * 16 + (w & 1) * 8);
    const f32x4 z4 = {0.f, 0.f, 0.f, 0.f};
    const bf16x8 sb0 = mkfrag(cvtpk(st[0][0], st[0][1]), cvtpk(st[0][2], st[0][3]), cvtpk(st[1][0], st[1][1]), cvtpk(st[1][2], st[1][3]));
    const bf16x8 sb1 = mkfrag(cvtpk(st[2][0], st[2][1]), cvtpk(st[2][2], st[2][3]), cvtpk(st[3][0], st[3][1]), cvtpk(st[3][2], st[3][3]));
    f32x4 p1 = mma(fKK0, sb0, z4); p1 = mma(fKK1, sb1, p1);
    f32x4 p2 = mma(fR0, sb0, z4); p2 = mma(fR1, sb1, p2);
    const f32x4 x = mma(mkfrag(0u, 0u, mt.x, mt.y), mkfrag(0u, 0u, vf.x, vf.y), p1);
    const f32x4 u = mma(mkfrag(mt.z, mt.w, 0u, 0u), mkfrag(cvtpk(x[0], x[1]), cvtpk(x[2], x[3]), 0u, 0u), z4);
    const bf16x8 buv = mkfrag(cvtpk(u[0], u[1]), cvtpk(u[2], u[3]), vf.x, vf.y);
    const f32x4 y = mma(fN, buv, p2);
#pragma unroll
    for (int i = 0; i < 4; ++i) {
        const f32x4 gc = *(const LAS f32x4*)(buf + S_GC * SLOT + (16 * i + 4 * g) * 4);
        const bf16x8 fBK = *(const LAS bf16x8*)(buf + (S_BK + i) * SLOT + lane * 16);
        st[i] = mma(fBK, buv, st[i] * gc);
    }
    const int cn = dir ? (SEQ / 16 - 1 - n) : n;
#pragma unroll
    for (int r = 0; r < 4; ++r) { const int s = 4 * g + r, t = cn * 16 + (dir ? 15 - s : s);
        Y[((size_t)dir * T + (size_t)(b * SEQ + t)) * RW + h * 64 + 16 * w + col] = tobf(y[r]); }
}

__device__ __forceinline__ void chain(LAS unsigned char* L, const bf16* Z, const float* mu_prev, const float* mu_next, const float* w_decay0, const float* w_decay_up,
                                      const float* a_gate0, const float* a_gate_up, const float* k_k, const float* k_a, const float* r_k, bf16* Y, float* BON, int ch, int tid, int wave, int lane) {
    const int dir = ch & 1, h = (ch >> 1) & 7, b = ch >> 4;
    __syncthreads();
    setup(L, h, dir, mu_prev, mu_next, w_decay0, w_decay_up, a_gate0, a_gate_up, k_k, k_a, r_k, tid);
    __syncthreads();
    f32x4 st[4];
#pragma unroll
    for (int i = 0; i < 4; ++i) st[i] = (f32x4){0.f, 0.f, 0.f, 0.f};
    constexpr int NCH = SEQ / 16, NR = NCH / 8;
    for (int q = 0; q < NR; ++q) {
        helper_chunk(L, L + wave * BUF_BYTES, (LAS float*)(L + OFF_MT + wave * 1024), Z, BON, b, h, dir, 8 * q + wave, lane);
        __syncthreads();
        if (wave < 4) {
#pragma unroll 4
            for (int i = 0; i < 8; ++i) rec_chunk(L + i * BUF_BYTES, st, Y, b, h, dir, 8 * q + i, wave, lane);
        }
        __syncthreads();
    }
}
}

namespace attn {
typedef unsigned u32x2 __attribute__((ext_vector_type(2)));
constexpr int VT_STRIDE = 136;
constexpr int KF_OFF = 64 * VT_STRIDE;
constexpr int WAVE_LDS = KF_OFF + 8 * 1024;
constexpr float LOG2E = 1.44269504088896f, LN2 = 0.693147180559945f;
using scan::cvtpk; using scan::mkfrag; using scan::mma;

__device__ __forceinline__ void unpack8(const v4u w, float (&f)[8]) {
    f[0] = __uint_as_float(w.x << 16); f[1] = __uint_as_float(w.x & 0xffff0000u); f[2] = __uint_as_float(w.y << 16); f[3] = __uint_as_float(w.y & 0xffff0000u);
    f[4] = __uint_as_float(w.z << 16); f[5] = __uint_as_float(w.z & 0xffff0000u); f[6] = __uint_as_float(w.w << 16); f[7] = __uint_as_float(w.w & 0xffff0000u);
}

__device__ __forceinline__ void unit(LAS unsigned char* vt, const bf16* Z, const float* qg, const float* kg, bf16* Ob, int opitch, float* lse_out,
                                     int b, int h, int d, int r, int qb, int nb, int lane) {
    const int g = lane >> 4, c16 = lane & 15;
    const float slope2 = exp2f(-(float)(h + 1)) * LOG2E * (float)d;
    float gn[16];
#pragma unroll
    for (int m = 0; m < 2; ++m)
#pragma unroll
        for (int j = 0; j < 8; ++j) gn[m * 8 + j] = qg[32 * m + 8 * g + j] * kg[32 * m + 8 * g + j];
    bf16x8 qf[4][2];
#pragma unroll
    for (int qt = 0; qt < 4; ++qt) {
        const int tok = b * SEQ + (qb * 64 + 16 * qt + c16) * d + r;
        const bf16* qp = Z + (size_t)tok * INW + h * 64 + 8 * g;
        float f0[8], f1[8]; unpack8(*(const v4u*)qp, f0); unpack8(*(const v4u*)(qp + 32), f1);
        float ss = 0.f;
#pragma unroll
        for (int j = 0; j < 8; ++j) ss += f0[j] * f0[j] + f1[j] * f1[j];
        ss += __shfl_xor(ss, 16); ss += __shfl_xor(ss, 32);
        const float rs = (0.125f * LOG2E) / sqrtf(ss * (1.f / 64.f) + 1e-6f);
        qf[qt][0] = mkfrag(cvtpk(f0[0] * rs * gn[0], f0[1] * rs * gn[1]), cvtpk(f0[2] * rs * gn[2], f0[3] * rs * gn[3]), cvtpk(f0[4] * rs * gn[4], f0[5] * rs * gn[5]), cvtpk(f0[6] * rs * gn[6], f0[7] * rs * gn[7]));
        qf[qt][1] = mkfrag(cvtpk(f1[0] * rs * gn[8], f1[1] * rs * gn[9]), cvtpk(f1[2] * rs * gn[10], f1[3] * rs * gn[11]), cvtpk(f1[4] * rs * gn[12], f1[5] * rs * gn[13]), cvtpk(f1[6] * rs * gn[14], f1[7] * rs * gn[15]));
    }
    f32x4 oacc[4][4];
    float mrun[4], lrun[4];
#pragma unroll
    for (int qt = 0; qt < 4; ++qt) { mrun[qt] = -1e30f; lrun[qt] = 0.f;
#pragma unroll
        for (int dt = 0; dt < 4; ++dt) oacc[dt][qt] = (f32x4){0.f, 0.f, 0.f, 0.f}; }
    const f32x4 z4 = {0.f, 0.f, 0.f, 0.f};
#pragma unroll 1
    for (int kb = qb - 1; kb <= qb + 1; ++kb) {
        if (kb < 0 || kb >= nb) continue;
#pragma unroll
        for (int kblk = 0; kblk < 4; ++kblk) {
            const int tok = b * SEQ + (kb * 64 + 16 * kblk + c16) * d + r;
            const bf16* kp = Z + (size_t)tok * INW + AW + h * 64 + 8 * g;
            float f0[8], f1[8]; unpack8(*(const v4u*)kp, f0); unpack8(*(const v4u*)(kp + 32), f1);
            float ss = 0.f;
#pragma unroll
            for (int j = 0; j < 8; ++j) ss += f0[j] * f0[j] + f1[j] * f1[j];
            ss += __shfl_xor(ss, 16); ss += __shfl_xor(ss, 32);
            const float rsk = 1.0f / sqrtf(ss * (1.f / 64.f) + 1e-6f);
            *(LAS v4u*)(vt + KF_OFF + (kblk * 2 + 0) * 1024 + lane * 16) = (v4u){cvtpk(f0[0] * rsk, f0[1] * rsk), cvtpk(f0[2] * rsk, f0[3] * rsk), cvtpk(f0[4] * rsk, f0[5] * rsk), cvtpk(f0[6] * rsk, f0[7] * rsk)};
            *(LAS v4u*)(vt + KF_OFF + (kblk * 2 + 1) * 1024 + lane * 16) = (v4u){cvtpk(f1[0] * rsk, f1[1] * rsk), cvtpk(f1[2] * rsk, f1[3] * rsk), cvtpk(f1[4] * rsk, f1[5] * rsk), cvtpk(f1[6] * rsk, f1[7] * rsk)};
        }
#pragma unroll
        for (int i = 0; i < 8; ++i) {
            const int key = 8 * i + (lane >> 3), chunk = lane & 7;
            const int tok = b * SEQ + (kb * 64 + key) * d + r;
            const v4u w = *(const v4u*)(Z + (size_t)tok * INW + 2 * AW + h * 64 + 8 * chunk);
            LAS unsigned char* q = vt + (8 * chunk) * VT_STRIDE + 2 * key;
            *(LAS bf16*)(q + 0 * VT_STRIDE) = (bf16)(w.x & 0xffffu); *(LAS bf16*)(q + 1 * VT_STRIDE) = (bf16)(w.x >> 16);
            *(LAS bf16*)(q + 2 * VT_STRIDE) = (bf16)(w.y & 0xffffu); *(LAS bf16*)(q + 3 * VT_STRIDE) = (bf16)(w.y >> 16);
            *(LAS bf16*)(q + 4 * VT_STRIDE) = (bf16)(w.z & 0xffffu); *(LAS bf16*)(q + 5 * VT_STRIDE) = (bf16)(w.z >> 16);
            *(LAS bf16*)(q + 6 * VT_STRIDE) = (bf16)(w.w & 0xffffu); *(LAS bf16*)(q + 7 * VT_STRIDE) = (bf16)(w.w >> 16);
        }
        asm volatile("s_waitcnt lgkmcnt(0)" ::: "memory"); __builtin_amdgcn_wave_barrier();
        f32x4 bias[7];
        {
            const int obase = (kb - qb) * 64 + 4 * g - c16;
#pragma unroll
            for (int dk = 0; dk < 7; ++dk)
#pragma unroll
                for (int reg = 0; reg < 4; ++reg) { const int o = obase + 16 * (dk - 3) + reg, ao = o < 0 ? -o : o; bias[dk][reg] = (ao <= 64) ? -slope2 * (float)ao : -1e30f; }
        }
#pragma unroll
        for (int qt = 0; qt < 4; ++qt) {
            f32x4 sa[4];
#pragma unroll
            for (int kblk = 0; kblk < 4; ++kblk) {
                const bf16x8 k0 = *(const LAS bf16x8*)(vt + KF_OFF + (kblk * 2 + 0) * 1024 + lane * 16), k1 = *(const LAS bf16x8*)(vt + KF_OFF + (kblk * 2 + 1) * 1024 + lane * 16);
                sa[kblk] = mma(k0, qf[qt][0], bias[kblk - qt + 3]); sa[kblk] = mma(k1, qf[qt][1], sa[kblk]); }
            float mx = -1e30f;
#pragma unroll
            for (int kblk = 0; kblk < 4; ++kblk)
#pragma unroll
                for (int reg = 0; reg < 4; ++reg) mx = fmaxf(mx, sa[kblk][reg]);
            mx = fmaxf(mx, __shfl_xor(mx, 16)); mx = fmaxf(mx, __shfl_xor(mx, 32));
            const float mn = fmaxf(mrun[qt], mx), alpha = exp2f(mrun[qt] - mn);
            mrun[qt] = mn;
            float ls = 0.f;
#pragma unroll
            for (int kblk = 0; kblk < 4; ++kblk)
#pragma unroll
                for (int reg = 0; reg < 4; ++reg) { const float p = exp2f(sa[kblk][reg] - mn); sa[kblk][reg] = p; ls += p; }
            lrun[qt] = lrun[qt] * alpha + ls;
            const bf16x8 pf0 = mkfrag(cvtpk(sa[0][0], sa[0][1]), cvtpk(sa[0][2], sa[0][3]), cvtpk(sa[1][0], sa[1][1]), cvtpk(sa[1][2], sa[1][3]));
            const bf16x8 pf1 = mkfrag(cvtpk(sa[2][0], sa[2][1]), cvtpk(sa[2][2], sa[2][3]), cvtpk(sa[3][0], sa[3][1]), cvtpk(sa[3][2], sa[3][3]));
#pragma unroll
            for (int dt = 0; dt < 4; ++dt) {
                const LAS unsigned char* vr = vt + (16 * dt + c16) * VT_STRIDE + 8 * g;
                const u32x2 a0 = *(const LAS u32x2*)(vr), a1 = *(const LAS u32x2*)(vr + 32), a2 = *(const LAS u32x2*)(vr + 64), a3 = *(const LAS u32x2*)(vr + 96);
                f32x4 oc = oacc[dt][qt] * alpha;
                oc = mma(mkfrag(a0.x, a0.y, a1.x, a1.y), pf0, oc);
                oc = mma(mkfrag(a2.x, a2.y, a3.x, a3.y), pf1, oc);
                oacc[dt][qt] = oc;
            }
            __builtin_amdgcn_sched_barrier(0);
        }
        asm volatile("s_waitcnt lgkmcnt(0)" ::: "memory"); __builtin_amdgcn_wave_barrier();
    }
#pragma unroll
    for (int qt = 0; qt < 4; ++qt) {
        float lt = lrun[qt]; lt += __shfl_xor(lt, 16); lt += __shfl_xor(lt, 32);
        const float inv = 1.0f / lt;
        const int tok = b * SEQ + (qb * 64 + 16 * qt + c16) * d + r;
        bf16* op = Ob + (size_t)tok * opitch + h * 64 + 4 * g;
#pragma unroll
        for (int dt = 0; dt < 4; ++dt) { const f32x4 o = oacc[dt][qt] * inv; u32x2 w; w.x = cvtpk(o[0], o[1]); w.y = cvtpk(o[2], o[3]); *(u32x2*)(op + 16 * dt) = w; }
        if (g == 0) lse_out[(size_t)tok * NH + h] = (mrun[qt] + log2f(lt)) * LN2;
    }
}
}

namespace peer {
using scan::cvtpk; using scan::mkfrag; using scan::mma;
constexpr int KEY_SLOTS = 64;

template <int CTRL> __device__ __forceinline__ unsigned dppu(unsigned x) { return (unsigned)__builtin_amdgcn_update_dpp(0, (int)x, CTRL, 0xf, 0xf, true); }
__device__ __forceinline__ unsigned umax(unsigned a, unsigned b) { return a > b ? a : b; }
__device__ __forceinline__ unsigned rowmax16(unsigned x) { x = umax(x, dppu<0xB1>(x)); x = umax(x, dppu<0x4E>(x)); x = umax(x, dppu<0x141>(x)); x = umax(x, dppu<0x140>(x)); return x; }
__device__ __forceinline__ float rowsum16(float x) {
    x += __uint_as_float(dppu<0xB1>(__float_as_uint(x))); x += __uint_as_float(dppu<0x4E>(__float_as_uint(x)));
    x += __uint_as_float(dppu<0x141>(__float_as_uint(x))); x += __uint_as_float(dppu<0x140>(__float_as_uint(x))); return x;
}
__device__ __forceinline__ unsigned ordkey(float f) { const unsigned u = __float_as_uint(f); return (u & 0x80000000u) ? ~u : (u | 0x80000000u); }
__device__ __forceinline__ float unordkey(unsigned k) { return __uint_as_float((k & 0x80000000u) ? (k ^ 0x80000000u) : ~k); }

__device__ __forceinline__ void setup_keys(LAS unsigned char* L, const float* keys1, const float* keys2, int tid) {
    LAS bf16* F = (LAS bf16*)L;
    for (int i = tid; i < KEY_SLOTS * 64 * 8; i += 512) {
        const int j = i & 7, l = (i >> 3) & 63, sl = i >> 9, ks = sl & 3, nt = (sl >> 2) & 7, sel = sl >> 5;
        const int n = 16 * nt + (l & 15), k = 32 * ks + 8 * (l >> 4) + j;
        F[i] = (bf16)f2bf((sel ? keys2 : keys1)[n * 128 + k]);
    }
}

#define CE_(a, b) do { const unsigned hi_ = umax(a, b), lo_ = (a < b) ? a : b; a = hi_; b = lo_; } while (0)
__device__ __forceinline__ void top16(unsigned (&key)[8][4], unsigned (&win)[4], int c16) {
#pragma unroll
    for (int reg = 0; reg < 4; ++reg) {
        CE_(key[0][reg], key[1][reg]); CE_(key[2][reg], key[3][reg]); CE_(key[4][reg], key[5][reg]); CE_(key[6][reg], key[7][reg]);
        CE_(key[0][reg], key[2][reg]); CE_(key[1][reg], key[3][reg]); CE_(key[4][reg], key[6][reg]); CE_(key[5][reg], key[7][reg]);
        CE_(key[1][reg], key[2][reg]); CE_(key[5][reg], key[6][reg]);
        CE_(key[0][reg], key[4][reg]); CE_(key[1][reg], key[5][reg]); CE_(key[2][reg], key[6][reg]); CE_(key[3][reg], key[7][reg]);
        CE_(key[2][reg], key[4][reg]); CE_(key[3][reg], key[5][reg]);
        CE_(key[1][reg], key[2][reg]); CE_(key[3][reg], key[4][reg]); CE_(key[5][reg], key[6][reg]);
    }
#pragma unroll 1
    for (int k = 0; k < TOPK; ++k) {
#pragma unroll
        for (int reg = 0; reg < 4; ++reg) {
            const unsigned m = rowmax16(key[0][reg]);
            win[reg] = (c16 == k) ? m : win[reg];
            const bool pop = key[0][reg] == m;
#pragma unroll
            for (int nt = 0; nt < 7; ++nt) key[nt][reg] = pop ? key[nt + 1][reg] : key[nt][reg];
            key[7][reg] = pop ? 0u : key[7][reg];
        }
    }
}
#undef CE_

__device__ __forceinline__ void select_batch(const LAS unsigned char* L, const bf16* Q, int* IDX, float* GATE, int batch, int lane) {
    const int g = lane >> 4, c16 = lane & 15;
    const LAS bf16x8* F = (const LAS bf16x8*)L;
    const bf16* qp = Q + (size_t)(batch * 16 + c16) * PKD + 8 * g;
    unsigned w1[4] = {0u, 0u, 0u, 0u}, w2[4] = {0u, 0u, 0u, 0u};
#pragma unroll
    for (int sel = 0; sel < 2; ++sel) {
        unsigned key[8][4];
        bf16x8 a[4];
#pragma unroll
        for (int ks = 0; ks < 4; ++ks) a[ks] = *(const bf16x8*)(qp + sel * 128 + 32 * ks);
#pragma unroll
        for (int nt = 0; nt < 8; ++nt) {
            f32x4 sc = {0.f, 0.f, 0.f, 0.f};
#pragma unroll
            for (int ks = 0; ks < 4; ++ks) sc = mma(a[ks], F[((sel * 8 + nt) * 4 + ks) * 64 + lane], sc);
#pragma unroll
            for (int reg = 0; reg < 4; ++reg) key[nt][reg] = (ordkey(sc[reg]) & ~127u) | (unsigned)(16 * nt + c16);
            __builtin_amdgcn_sched_barrier(0);
        }
        if (sel == 0) top16(key, w1, c16); else top16(key, w2, c16);
    }
    float f1[4], f2[4], cur2[4]; int ptr[4]; unsigned top[4];
#pragma unroll
    for (int reg = 0; reg < 4; ++reg) { f1[reg] = unordkey(w1[reg] & ~127u); f2[reg] = unordkey(w2[reg] & ~127u); ptr[reg] = 0; cur2[reg] = __shfl(f2[reg], lane & 48); top[reg] = 0u; }
#pragma unroll 1
    for (int k = 0; k < TOPK; ++k) {
#pragma unroll
        for (int reg = 0; reg < 4; ++reg) {
            const unsigned ck = (ptr[reg] < 16) ? ((ordkey(f1[reg] + cur2[reg]) & ~255u) | (unsigned)(c16 << 4) | (unsigned)ptr[reg]) : 0u;
            const unsigned m = rowmax16(ck);
            top[reg] = (c16 == k) ? m : top[reg];
            if ((int)((m >> 4) & 15u) == c16) ptr[reg] += 1;
            cur2[reg] = __shfl(f2[reg], (lane & 48) | (ptr[reg] & 15));
        }
    }
#pragma unroll
    for (int reg = 0; reg < 4; ++reg) {
        const int a = (top[reg] >> 4) & 15, bq = top[reg] & 15;
        const int e1 = (int)(__shfl(w1[reg], (lane & 48) | a) & 127u), e2 = (int)(__shfl(w2[reg], (lane & 48) | bq) & 127u);
        const float ts = unordkey(top[reg] & ~255u), mx = __shfl(ts, lane & 48);
        const float ex = __expf(ts - mx), sum = rowsum16(ex);
        const size_t o = (size_t)(batch * 16 + 4 * g + reg) * TOPK + c16;
        IDX[o] = e1 * NKEYS + e2; GATE[o] = ex / sum;
    }
}

__device__ __forceinline__ void convert_table(const float* src, bf16* dst, size_t n8, size_t gtid, size_t gthreads) {
    for (size_t i = gtid; i < n8; i += gthreads) {
        const f32x4 a = *(const f32x4*)(src + i * 8), b = *(const f32x4*)(src + i * 8 + 4);
        v4u o; o.x = cvtpk(a.x, a.y); o.y = cvtpk(a.z, a.w); o.z = cvtpk(b.x, b.y); o.w = cvtpk(b.z, b.w);
        *(v4u*)(dst + i * 8) = o;
    }
}

__device__ __forceinline__ float dot2bf(unsigned w, unsigned x, float acc) {
    typedef __bf16 bf2 __attribute__((ext_vector_type(2)));
    return __builtin_amdgcn_fdot2_f32_bf16(__builtin_bit_cast(bf2, w), __builtin_bit_cast(bf2, x), acc, false);
}
__device__ __forceinline__ float gelu_erf(float v) {
    const float av = fabsf(v), t = __builtin_amdgcn_rcpf(av * 0.2316418882f + 1.0f);
    float q = t * 0.5307027145f + (-0.7265760135f); q = q * t + 0.7107068705f; q = q * t + (-0.142248368f); q = q * t + 0.127414796f; q = q * t;
    const float e = __builtin_amdgcn_exp2f((v * v) * (-0.72134752044f));
    const float m = v * (q * e);
    return v < 0.f ? m : v - m;
}

typedef float f32x2c __attribute__((ext_vector_type(2)));
__device__ __forceinline__ void convert_rows_fp8(const float* src, unsigned char* dst, float* scale, int rows, int gw, int ngw, int lane) {
    for (int rrow = gw; rrow < rows; rrow += ngw) {
        const float* p = src + (size_t)rrow * D + 16 * lane;
        const f32x4 a = *(const f32x4*)p, b = *(const f32x4*)(p + 4), c = *(const f32x4*)(p + 8), d = *(const f32x4*)(p + 12);
        float m = fmaxf(fmaxf(fmaxf(fabsf(a.x), fabsf(a.y)), fmaxf(fabsf(a.z), fabsf(a.w))), fmaxf(fmaxf(fabsf(b.x), fabsf(b.y)), fmaxf(fabsf(b.z), fabsf(b.w))));
        m = fmaxf(m, fmaxf(fmaxf(fmaxf(fabsf(c.x), fabsf(c.y)), fmaxf(fabsf(c.z), fabsf(c.w))), fmaxf(fmaxf(fabsf(d.x), fabsf(d.y)), fmaxf(fabsf(d.z), fabsf(d.w)))));
#pragma unroll
        for (int o = 1; o < 64; o <<= 1) m = fmaxf(m, __shfl_xor(m, o));
        m = fmaxf(m, 1e-30f);
        const float inv = 448.0f / m;
        v4u w;
        w.x = (unsigned)__builtin_amdgcn_cvt_pk_fp8_f32(a.z * inv, a.w * inv, __builtin_amdgcn_cvt_pk_fp8_f32(a.x * inv, a.y * inv, 0, false), true);
        w.y = (unsigned)__builtin_amdgcn_cvt_pk_fp8_f32(b.z * inv, b.w * inv, __builtin_amdgcn_cvt_pk_fp8_f32(b.x * inv, b.y * inv, 0, false), true);
        w.z = (unsigned)__builtin_amdgcn_cvt_pk_fp8_f32(c.z * inv, c.w * inv, __builtin_amdgcn_cvt_pk_fp8_f32(c.x * inv, c.y * inv, 0, false), true);
        w.w = (unsigned)__builtin_amdgcn_cvt_pk_fp8_f32(d.z * inv, d.w * inv, __builtin_amdgcn_cvt_pk_fp8_f32(d.x * inv, d.y * inv, 0, false), true);
        *(v4u*)(dst + (size_t)rrow * D + 16 * lane) = w;
        if (lane == 0) scale[rrow] = m * (1.0f / 448.0f);
    }
}
__device__ __forceinline__ unsigned pack_i8x4(float a, float b, float c, float d) {
    const int ia = (int)rintf(a), ib = (int)rintf(b), ic = (int)rintf(c), id = (int)rintf(d);
    return (unsigned)(ia & 0xff) | ((unsigned)(ib & 0xff) << 8) | ((unsigned)(ic & 0xff) << 16) | ((unsigned)id << 24);
}
__device__ __forceinline__ void convert_rows_i8(const float* src, unsigned char* dst, float* scale, int rows, int gw, int ngw, int lane) {
    for (int rrow = gw; rrow < rows; rrow += ngw) {
        const float* p = src + (size_t)rrow * D + 16 * lane;
        const f32x4 a = *(const f32x4*)p, b = *(const f32x4*)(p + 4), c = *(const f32x4*)(p + 8), d = *(const f32x4*)(p + 12);
        float m = fmaxf(fmaxf(fmaxf(fabsf(a.x), fabsf(a.y)), fmaxf(fabsf(a.z), fabsf(a.w))), fmaxf(fmaxf(fabsf(b.x), fabsf(b.y)), fmaxf(fabsf(b.z), fabsf(b.w))));
        m = fmaxf(m, fmaxf(fmaxf(fmaxf(fabsf(c.x), fabsf(c.y)), fmaxf(fabsf(c.z), fabsf(c.w))), fmaxf(fmaxf(fabsf(d.x), fabsf(d.y)), fmaxf(fabsf(d.z), fabsf(d.w)))));
#pragma unroll
        for (int o = 1; o < 64; o <<= 1) m = fmaxf(m, __shfl_xor(m, o));
        m = fmaxf(m, 1e-30f);
        const float inv = 127.0f / m;
        v4u w;
        w.x = pack_i8x4(a.x * inv, a.y * inv, a.z * inv, a.w * inv); w.y = pack_i8x4(b.x * inv, b.y * inv, b.z * inv, b.w * inv);
        w.z = pack_i8x4(c.x * inv, c.y * inv, c.z * inv, c.w * inv); w.w = pack_i8x4(d.x * inv, d.y * inv, d.z * inv, d.w * inv);
        *(v4u*)(dst + (size_t)rrow * D + 16 * lane) = w;
        if (lane == 0) scale[rrow] = m * (1.0f / 127.0f);
    }
}
__device__ __forceinline__ int isum8(int x) {
    x += (int)dppu<0xB1>((unsigned)x); x += (int)dppu<0x4E>((unsigned)x); x += (int)dppu<0x141>((unsigned)x); return x;
}
__device__ __forceinline__ float sum8(float x) {
    x += __uint_as_float(dppu<0xB1>(__float_as_uint(x))); x += __uint_as_float(dppu<0x4E>(__float_as_uint(x))); x += __uint_as_float(dppu<0x141>(__float_as_uint(x))); return x;
}
__device__ __forceinline__ float dot16_fp8(const v4u q, const f32x2c (&x)[8]) {
    f32x2c d = __builtin_amdgcn_cvt_pk_f32_fp8((int)q.x, false) * x[0];
    d = __builtin_elementwise_fma(__builtin_amdgcn_cvt_pk_f32_fp8((int)q.x, true), x[1], d);
    d = __builtin_elementwise_fma(__builtin_amdgcn_cvt_pk_f32_fp8((int)q.y, false), x[2], d);
    d = __builtin_elementwise_fma(__builtin_amdgcn_cvt_pk_f32_fp8((int)q.y, true), x[3], d);
    d = __builtin_elementwise_fma(__builtin_amdgcn_cvt_pk_f32_fp8((int)q.z, false), x[4], d);
    d = __builtin_elementwise_fma(__builtin_amdgcn_cvt_pk_f32_fp8((int)q.z, true), x[5], d);
    d = __builtin_elementwise_fma(__builtin_amdgcn_cvt_pk_f32_fp8((int)q.w, false), x[6], d);
    d = __builtin_elementwise_fma(__builtin_amdgcn_cvt_pk_f32_fp8((int)q.w, true), x[7], d);
    return d.x + d.y;
}
__device__ __forceinline__ void axpy16_fp8(const v4u q, float cf, f32x2c (&y)[8]) {
    const f32x2c c2 = {cf, cf};
    y[0] = __builtin_elementwise_fma(__builtin_amdgcn_cvt_pk_f32_fp8((int)q.x, false), c2, y[0]); y[1] = __builtin_elementwise_fma(__builtin_amdgcn_cvt_pk_f32_fp8((int)q.x, true), c2, y[1]);
    y[2] = __builtin_elementwise_fma(__builtin_amdgcn_cvt_pk_f32_fp8((int)q.y, false), c2, y[2]); y[3] = __builtin_elementwise_fma(__builtin_amdgcn_cvt_pk_f32_fp8((int)q.y, true), c2, y[3]);
    y[4] = __builtin_elementwise_fma(__builtin_amdgcn_cvt_pk_f32_fp8((int)q.z, false), c2, y[4]); y[5] = __builtin_elementwise_fma(__builtin_amdgcn_cvt_pk_f32_fp8((int)q.z, true), c2, y[5]);
    y[6] = __builtin_elementwise_fma(__builtin_amdgcn_cvt_pk_f32_fp8((int)q.w, false), c2, y[6]); y[7] = __builtin_elementwise_fma(__builtin_amdgcn_cvt_pk_f32_fp8((int)q.w, true), c2, y[7]);
}

#define FFN_ISSUE_U(q, idv) do { _Pragma("unroll") for (int i = 0; i < 8; ++i) { const int ex_ = __shfl(idv, 8 * i + eg); \
            q[i] = *(const v4u*)(UT8 + (((unsigned)ex_ << 10) + (unsigned)(128 * sl + 16 * ch))); } } while (0)
#define FFN_DOT_U(QQ, XX, r) do { const v4u xx_ = XX; _Pragma("unroll") for (int i = 0; i < 8; ++i) { const v4u qq_ = QQ[i]; \
            int d_ = __builtin_amdgcn_sdot4((int)qq_[0], (int)xx_[0], 0, false); d_ = __builtin_amdgcn_sdot4((int)qq_[1], (int)xx_[1], d_, false); \
            d_ = __builtin_amdgcn_sdot4((int)qq_[2], (int)xx_[2], d_, false); d_ = __builtin_amdgcn_sdot4((int)qq_[3], (int)xx_[3], d_, false); \
            d_ = isum8(d_); if (ch == i) r = d_; } } while (0)
__device__ __forceinline__ void ffn_u_pass(const unsigned char* XQ, const int* IDX, const unsigned char* UT8, int* PART, int sl, int wv, int nwv, int lane) {
    const int eg = lane >> 3, ch = lane & 7;
    v4u qA[8], qB[8];
    int t = wv; if (t >= T) return;
    int i0 = IDX[(size_t)t * HK + lane], i1 = IDX[(size_t)t * HK + 64 + lane], n0 = 0, n1 = 0;
    v4u x0 = *(const v4u*)(XQ + (size_t)t * D + 128 * sl + 16 * ch), xn0 = x0;
    FFN_ISSUE_U(qA, i0);
#pragma unroll 1
    for (;;) {
        const int tn = t + nwv; const bool more = tn < T;
        if (more) { n0 = IDX[(size_t)tn * HK + lane]; n1 = IDX[(size_t)tn * HK + 64 + lane]; xn0 = *(const v4u*)(XQ + (size_t)tn * D + 128 * sl + 16 * ch); }
        FFN_ISSUE_U(qB, i1);
        int r0 = 0, r1 = 0;
        FFN_DOT_U(qA, x0, r0);
        if (more) FFN_ISSUE_U(qA, n0);
        FFN_DOT_U(qB, x0, r1);
        int* pp = PART + ((size_t)sl * T + t) * HK + 8 * ch + eg; pp[0] = r0; pp[64] = r1;
        if (!more) break;
        i0 = n0; i1 = n1; x0 = xn0; t = tn;
    }
}
#define FFN_ISSUE_V(q, cf, pkv) do { _Pragma("unroll") for (int i = 0; i < 8; ++i) { const unsigned w_ = (unsigned)__shfl((int)(pkv), 8 * i + eg); cf[i] = __uint_as_float(w_ << 16); \
            q[i] = *(const v4u*)(VT8 + (((w_ >> 16) << 10) + (unsigned)(128 * sl + 16 * ch))); } } while (0)
typedef unsigned u32x2p __attribute__((ext_vector_type(2)));
__device__ __forceinline__ float swap32_add(float lo, float hi) { const u32x2p r = __builtin_amdgcn_permlane32_swap(__float_as_uint(lo), __float_as_uint(hi), false, false); return __uint_as_float(r.x) + __uint_as_float(r.y); }
__device__ __forceinline__ float swap16_add(float lo, float hi) { const u32x2p r = __builtin_amdgcn_permlane16_swap(__float_as_uint(lo), __float_as_uint(hi), false, false); return __uint_as_float(r.x) + __uint_as_float(r.y); }
__device__ __forceinline__ void ffn_v_pass(const unsigned* PK, const unsigned char* VT8, const float* mod, float* out, int sl, int wv, int nwv, int lane) {
    const int eg = lane >> 3, ch = lane & 7, col2 = 128 * sl + 16 * ch + 2 * eg;
    const bool b3 = (lane & 8) != 0;
    v4u qA[8], qB[8]; float cfA[8], cfB[8];
    int t = wv; if (t >= T) return;
    unsigned p0 = PK[(size_t)t * HK + lane], p1 = PK[(size_t)t * HK + 64 + lane], n0 = 0u, n1 = 0u;
    FFN_ISSUE_V(qA, cfA, p0);
#pragma unroll 1
    for (;;) {
        const int tn = t + nwv; const bool more = tn < T;
        if (more) { n0 = PK[(size_t)tn * HK + lane]; n1 = PK[(size_t)tn * HK + 64 + lane]; }
        FFN_ISSUE_V(qB, cfB, p1);
        f32x2c y2[8];
#pragma unroll
        for (int k = 0; k < 8; ++k) y2[k] = (f32x2c){0.f, 0.f};
#pragma unroll
        for (int i = 0; i < 8; ++i) { axpy16_fp8(qA[i], cfA[i], y2); if (i & 1) __builtin_amdgcn_sched_barrier(0); }
        if (more) FFN_ISSUE_V(qA, cfA, n0);
        const size_t o = (size_t)t * D + col2;
        const f32x2c oa = *(const f32x2c*)(out + o), ga = *(const f32x2c*)(mod + (t / SEQ) * MODW + 5 * D + col2);
#pragma unroll
        for (int i = 0; i < 8; ++i) { axpy16_fp8(qB[i], cfB[i], y2); if (i & 1) __builtin_amdgcn_sched_barrier(0); }
        float z[8], w[4];
#pragma unroll
        for (int k = 0; k < 4; ++k) { z[2 * k] = swap32_add(y2[k].x, y2[k + 4].x); z[2 * k + 1] = swap32_add(y2[k].y, y2[k + 4].y); }
#pragma unroll
        for (int k = 0; k < 4; ++k) w[k] = swap16_add(z[k], z[k + 4]);
        const float k0 = b3 ? w[2] : w[0], k1 = b3 ? w[3] : w[1], s0 = b3 ? w[0] : w[2], s1 = b3 ? w[1] : w[3];
        const float f0 = k0 + __uint_as_float(dppu<0x128>(__float_as_uint(s0))), f1 = k1 + __uint_as_float(dppu<0x128>(__float_as_uint(s1)));
        *(f32x2c*)(out + o) = (f32x2c){oa.x + ga.x * f0, oa.y + ga.y * f1};
        if (!more) break;
        p0 = n0; p1 = n1; t = tn;
    }
}
}

namespace fin {
using scan::cvtpk; using scan::mkfrag; using scan::mma;
typedef unsigned u32x2 __attribute__((ext_vector_type(2)));

__device__ __forceinline__ float shift3(const bf16* p, bool hasp, bool hasn, float mp, float mn) {
    const float z = bf2f(p[0]), zp = hasp ? bf2f(p[-INW]) : 0.f, zn = hasn ? bf2f(p[INW]) : 0.f;
    return z + mp * (zp - z) + mn * (zn - z);
}

__device__ __forceinline__ void unpack4(const u32x2 w, float (&f)[4]) {
    f[0] = __uint_as_float(w.x << 16); f[1] = __uint_as_float(w.x & 0xffff0000u); f[2] = __uint_as_float(w.y << 16); f[3] = __uint_as_float(w.y & 0xffff0000u);
}
__device__ __forceinline__ void phase(LAS unsigned char* L, const bf16* Z, const float* mu_prev, const float* mu_next, const float* g_up, const bf16* Y, const float* BON,
                                      const float* k_a, const float* r_k, const float* lnx_g, const float* lnx_b, bf16* mix, const bf16* O3, const float* LSE,
                                      int bx, int G, int tid, int wave, int lane) {
    const int g = lane >> 4, c16 = lane & 15, ch0 = 64 * wave + 4 * c16;
    LAS bf16* sg = (LAS bf16*)L;
    bf16x8 bf[4][4];
#pragma unroll
    for (int ks = 0; ks < 4; ++ks) {
        f32x4 rowv[8];
#pragma unroll
        for (int jj = 0; jj < 8; ++jj) rowv[jj] = *(const f32x4*)(g_up + (size_t)(32 * ks + 8 * g + jj) * RW + ch0);
#pragma unroll
        for (int nt = 0; nt < 4; ++nt) bf[nt][ks] = mkfrag(cvtpk(rowv[0][nt], rowv[1][nt]), cvtpk(rowv[2][nt], rowv[3][nt]), cvtpk(rowv[4][nt], rowv[5][nt]), cvtpk(rowv[6][nt], rowv[7][nt]));
    }
    const f32x4 mpr = *(const f32x4*)(mu_prev + ch0), mnr = *(const f32x4*)(mu_next + ch0), mpk = *(const f32x4*)(mu_prev + RW + ch0), mnk = *(const f32x4*)(mu_next + RW + ch0),
                mpv = *(const f32x4*)(mu_prev + 2 * RW + ch0), mnv = *(const f32x4*)(mu_next + 2 * RW + ch0);
    const f32x4 ka1 = *(const f32x4*)(k_a + ch0), rk1 = *(const f32x4*)(r_k + ch0), lg = *(const f32x4*)(lnx_g + ch0), lb = *(const f32x4*)(lnx_b + ch0);
    const int j0 = (tid & 31) * 4;
    const f32x4 mpg = *(const f32x4*)(mu_prev + 3 * RW + DL + AL + j0), mng = *(const f32x4*)(mu_next + 3 * RW + DL + AL + j0);
    for (int tb = bx; tb < T / 16; tb += G) {
        const int tok0 = tb * 16;
        __syncthreads();
        {
            const int tl = tid >> 5, tok = tok0 + tl, t = tok % SEQ;
            const bf16* p = Z + (size_t)tok * INW + 3 * AW + 3 * RW + DL + AL + j0;
            const bool hasp = t > 0, hasn = t < SEQ - 1;
            float zc[4], zp[4], zn[4];
            unpack4(*(const u32x2*)p, zc); unpack4(*(const u32x2*)(hasp ? p - INW : p), zp); unpack4(*(const u32x2*)(hasn ? p + INW : p), zn);
            float o[4];
#pragma unroll
            for (int e = 0; e < 4; ++e) { const float pv = hasp ? zp[e] : 0.f, nv = hasn ? zn[e] : 0.f; const float v = zc[e] + mpg[e] * (pv - zc[e]) + mng[e] * (nv - zc[e]); o[e] = __builtin_amdgcn_rcpf(1.0f + __expf(-v)); }
            u32x2 w; w.x = cvtpk(o[0], o[1]); w.y = cvtpk(o[2], o[3]);
            *(LAS u32x2*)(sg + tl * 128 + j0) = w;
        }
        __syncthreads();
        f32x4 ga[4];
        {
            bf16x8 af[4];
#pragma unroll
            for (int ks = 0; ks < 4; ++ks) af[ks] = *(const LAS bf16x8*)(sg + c16 * 128 + 32 * ks + 8 * g);
#pragma unroll
            for (int nt = 0; nt < 4; ++nt) { f32x4 a = {0.f, 0.f, 0.f, 0.f};
#pragma unroll
                for (int ks = 0; ks < 4; ++ks) a = mma(af[ks], bf[nt][ks], a);
                ga[nt] = a; }
        }
#pragma unroll
        for (int reg = 0; reg < 4; ++reg) {
            const int tok = tok0 + 4 * g + reg, t = tok % SEQ;
            const bool hasp = t > 0, hasn = t < SEQ - 1;
            const bf16* zr = Z + (size_t)tok * INW + 3 * AW + ch0;
            const size_t o = (size_t)tok * RW + ch0;
            float y0[4], y1[4]; unpack4(*(const u32x2*)(Y + o), y0); unpack4(*(const u32x2*)(Y + (size_t)T * RW + o), y1);
            float rc[4], rp[4], rn[4], kc[4], kp[4], kn[4], vc[4], vp[4], vn[4];
            unpack4(*(const u32x2*)zr, rc); unpack4(*(const u32x2*)(hasp ? zr - INW : zr), rp); unpack4(*(const u32x2*)(hasn ? zr + INW : zr), rn);
            unpack4(*(const u32x2*)(zr + RW), kc); unpack4(*(const u32x2*)(hasp ? zr + RW - INW : zr + RW), kp); unpack4(*(const u32x2*)(hasn ? zr + RW + INW : zr + RW), kn);
            unpack4(*(const u32x2*)(zr + 2 * RW), vc); unpack4(*(const u32x2*)(hasp ? zr + 2 * RW - INW : zr + 2 * RW), vp); unpack4(*(const u32x2*)(hasn ? zr + 2 * RW + INW : zr + 2 * RW), vn);
            bf16* mp = mix + (size_t)tok * D + ch0;
            float o1[4], o2[4], o3[4];
            unpack4(*(const u32x2*)mp, o1); unpack4(*(const u32x2*)(mp + AW), o2); unpack4(*(const u32x2*)(O3 + (size_t)tok * AW + ch0), o3);
            const float l1 = LSE[(size_t)tok * NH + wave], l2 = LSE[((size_t)T + tok) * NH + wave], l3 = LSE[((size_t)2 * T + tok) * NH + wave];
            const float bon = BON[(size_t)tok * NH + wave] + BON[((size_t)T + tok) * NH + wave];
            float yv[4], vv[4], s1 = 0.f, sb = 0.f;
#pragma unroll
            for (int nt = 0; nt < 4; ++nt) {
                yv[nt] = y0[nt] + y1[nt]; s1 += yv[nt];
                const float pr = hasp ? rp[nt] : 0.f, nr = hasn ? rn[nt] : 0.f, pk = hasp ? kp[nt] : 0.f, nk = hasn ? kn[nt] : 0.f, pvv = hasp ? vp[nt] : 0.f, nvv = hasn ? vn[nt] : 0.f;
                const float rr = rc[nt] + mpr[nt] * (pr - rc[nt]) + mnr[nt] * (nr - rc[nt]);
                const float kk = kc[nt] + mpk[nt] * (pk - kc[nt]) + mnk[nt] * (nk - kc[nt]);
                vv[nt] = vc[nt] + mpv[nt] * (pvv - vc[nt]) + mnv[nt] * (nvv - vc[nt]);
                sb += rr * kk * rk1[nt] * (1.0f - ka1[nt]);
            }
            const float mean = peer::rowsum16(s1) * (1.f / 64.f);
            float s2 = 0.f;
#pragma unroll
            for (int nt = 0; nt < 4; ++nt) s2 += (yv[nt] - mean) * (yv[nt] - mean);
            const float rstd = __builtin_amdgcn_rsqf(peer::rowsum16(s2) * (1.f / 64.f) + 64e-5f);
            const float bs = peer::rowsum16(sb) + 0.5f * bon;
            const float lm = fmaxf(l1, fmaxf(l2, l3)), w1 = __expf(l1 - lm), w2 = __expf(l2 - lm), w3 = __expf(l3 - lm), wi = __builtin_amdgcn_rcpf(w1 + w2 + w3);
            float att[4], rw[4];
#pragma unroll
            for (int nt = 0; nt < 4; ++nt) {
                att[nt] = (w1 * o1[nt] + w2 * o2[nt] + w3 * o3[nt]) * wi;
                rw[nt] = ((yv[nt] - mean) * rstd * lg[nt] + lb[nt] + bs * vv[nt]) * ga[nt][reg];
            }
            u32x2 wa, wr; wa.x = cvtpk(att[0], att[1]); wa.y = cvtpk(att[2], att[3]); wr.x = cvtpk(rw[0], rw[1]); wr.y = cvtpk(rw[2], rw[3]);
            *(u32x2*)mp = wa; *(u32x2*)(mp + AW) = wr;
            __builtin_amdgcn_sched_barrier(0);
        }
    }
}
}

#ifndef MK_SKIP
#define MK_SKIP 0
#endif
constexpr int N_PHASES = 12;
struct Args { const float* in[27]; float* out; unsigned char* ws; int ph_lo, ph_hi, li, pad; };

__global__ void __launch_bounds__(NWAVES * 64, 2) mk_fwd(Args args) {
    extern __shared__ __attribute__((aligned(16))) unsigned char lds[];
    LAS unsigned char* L = (LAS unsigned char*)lds;
    volatile LAS unsigned* MISC = (volatile LAS unsigned*)(L + MISC_OFF);
    const int tid = threadIdx.x, lane = tid & 63, wave = __builtin_amdgcn_readfirstlane(tid >> 6);
    const int G = gridDim.x, bx = blockIdx.x;
    unsigned char* ws = args.ws;
    gu32* ctl = (gu32*)(ws + WS_CTL);
    const float* x = args.in[0]; const float* cvec = args.in[1]; const float* ada_w = args.in[2]; const float* ada_b = args.in[3];
    const float* norm1_g = args.in[4]; const float* w_in = args.in[5]; const float* mu_prev = args.in[6]; const float* mu_next = args.in[7];
    const float* q_norm_g = args.in[8]; const float* k_norm_g = args.in[9]; const float* w_decay0 = args.in[10]; const float* w_decay_up = args.in[11];
    const float* a_gate0 = args.in[12]; const float* a_gate_up = args.in[13]; const float* g_up = args.in[14]; const float* k_k = args.in[15];
    const float* k_a = args.in[16]; const float* r_k = args.in[17]; const float* lnx_g = args.in[18]; const float* lnx_b = args.in[19];
    const float* w_out = args.in[20]; const float* norm2_g = args.in[21]; const float* w_query = args.in[22]; const float* keys1 = args.in[23];
    const float* keys2 = args.in[24]; const float* peer_u = args.in[25]; const float* peer_v = args.in[26];
    float* out = args.out;
    float* MOD = (float*)(ws + WS_MOD); bf16* KEYS = (bf16*)(ws + WS_KEYS); bf16* WIN = (bf16*)(ws + WS_WIN); bf16* WOUT = (bf16*)(ws + WS_WOUT); bf16* WQ = (bf16*)(ws + WS_WQ);
    bf16* XN = (bf16*)(ws + WS_XN); bf16* Z = (bf16*)(ws + WS_Z); bf16* MIX = (bf16*)(ws + WS_MIX); bf16* Y = (bf16*)(ws + WS_Y); bf16* Q = (bf16*)(ws + WS_Q);
    int* IDX = (int*)(ws + WS_IDX); float* GATE = (float*)(ws + WS_GATE); float* BON = (float*)(ws + WS_BON);
    bf16* O3 = (bf16*)(ws + WS_O3); float* LSE = (float*)(ws + WS_LSE); unsigned char* UT8 = ws + WS_UT; unsigned char* VT8 = ws + WS_VT; float* SU = (float*)(ws + WS_SU); float* SV = (float*)(ws + WS_SU + 65536); unsigned char* XQ = ws + WS_XQ; float* SX = (float*)(ws + WS_XQ + 16 * MiB); float* PART = (float*)(ws + WS_PART);

    for (int u = tid; u < (LDS_BYTES - LDSCTL_OFF) / 4; u += NWAVES * 64) ((LAS unsigned*)(L + LDSCTL_OFF))[u] = 0u;
    __syncthreads();
    XcdBarrier bar = xcd_barrier_post((unsigned*)(ctl + CW_BAR) + args.li * XCD_BAR_WORDS, MISC + 8);
    const int lo = args.ph_lo, hi = args.ph_hi;
#define IN(k) (lo <= (k) && (k) < hi)
#define SEAM(k) do { if (IN(k) && IN((k) + 1)) xcd_barrier(bar); } while (0)
    const int gw = bx * NWAVES + wave, NGW = G * NWAVES;

    if (IN(0) && !(MK_SKIP & (1 << 0))) {
        if (bx < 2 * (MODW / 64)) {
            const int cg = bx % (MODW / 64), kh = bx / (MODW / 64);
            LAS float* sc = (LAS float*)L; LAS float* part = (LAS float*)(L + 32768);
            for (int i = tid; i < BATCH * D; i += NWAVES * 64) { const float cv = cvec[i]; sc[i] = cv / (1.f + expf(-cv)); }
            __syncthreads();
            const int j0 = cg * 64, i0 = kh * 512 + wave * 64;
            float acc[BATCH];
#pragma unroll
            for (int b = 0; b < BATCH; ++b) acc[b] = 0.f;
#pragma unroll 1
            for (int ii = 0; ii < 64; ii += 8) {
                float w[8];
#pragma unroll
                for (int e = 0; e < 8; ++e) w[e] = ada_w[(size_t)(i0 + ii + e) * MODW + j0 + lane];
#pragma unroll
                for (int e = 0; e < 8; ++e)
#pragma unroll
                    for (int b = 0; b < BATCH; ++b) acc[b] += sc[b * D + i0 + ii + e] * w[e];
            }
#pragma unroll
            for (int b = 0; b < BATCH; ++b) part[(wave * 8 + b) * 64 + lane] = acc[b];
            __syncthreads();
            { const int b = tid >> 6; float s = 0.f;
#pragma unroll
              for (int w = 0; w < 8; ++w) s += part[(w * 8 + b) * 64 + lane];
              if (kh == 0) s += ada_b[j0 + lane];
              atomicAdd(MOD + b * MODW + j0 + lane, s); }
            __syncthreads();
        }
        LAS float* scr = (LAS float*)(L + RING_OFF + wave * 16384);
        constexpr int I_IN = (D / 64) * (INW / 32), I_OUT = (D / 64) * (D / 32), I_Q = (D / 64) * (QW / 32);
        for (int it = gw; it < I_IN + I_OUT + I_Q; it += NGW) {
            int r = it;
            if (r < I_IN) { p0_transpose_item(w_in, D, INW, WIN, 0, scr, r, lane); continue; } r -= I_IN;
            if (r < I_OUT) { p0_transpose_item(w_out, D, D, WOUT, 0, scr, r, lane); continue; } r -= I_OUT;
            p0_transpose_item(w_query, D, QW, WQ, 0, scr, r, lane);
        }
    }
    SEAM(0);
    if (IN(1) && !(MK_SKIP & (1 << 1))) { norm_rows(x, norm1_g, MOD, 0, D, XN, gw, NGW, lane); }
    SEAM(1);
    if (IN(2) && !(MK_SKIP & (1 << 2))) {
        pg8::Gemm g{XN, WIN, T, INW, D}; pg8::StaticOrder S; S.init(T, INW, G, bx);
        pg8::EpiBf16<0> E{Z, INW, nullptr, 0, 0, 1.f};
        pg8::gemm_phase<pg8::EpiBf16<0>, pg8::StaticOrder, true, true>(L + RING_OFF, g, S, E);
    }
    SEAM(2);
    if (IN(3) && !(MK_SKIP & (1 << 3))) {
        constexpr int NCHAIN = BATCH * NH * 2;
        if (bx < NCHAIN) scan::chain(L, Z, mu_prev, mu_next, w_decay0, w_decay_up, a_gate0, a_gate_up, k_k, k_a, r_k, Y, BON, bx, tid, wave, lane);
        {
            gu32* ucnt = ctl + CW_WORK + 64 * args.li;
            LAS unsigned char* vt = L + wave * attn::WAVE_LDS;
            for (;;) {
                unsigned uu = 0u;
                if (lane == 0) uu = __hip_atomic_fetch_add(ucnt, 1u, __ATOMIC_RELAXED, __HIP_MEMORY_SCOPE_AGENT);
                const int u = __builtin_amdgcn_readfirstlane((int)uu);
                if (u >= BATCH * NH * 96) break;
                const int x = u & 31, p = (u >> 5) % 3, bh = u / 96;
                const int d = (p == 0) ? 1 : (p == 1 ? 4 : 16), nb = 32 / d, r = x / nb, qb = x % nb;
                bf16* Ob = (p == 0) ? MIX : (p == 1 ? MIX + AW : O3); const int opitch = (p == 2) ? AW : D;
                attn::unit(vt, Z, q_norm_g, k_norm_g, Ob, opitch, LSE + (size_t)p * T * NH, bh >> 3, bh & 7, d, r, qb, nb, lane);
            }
        }
        {
            gu32* ccnt = ctl + CW_WORK2 + 64 * args.li;
            for (;;) {
                unsigned uu = 0u;
                if (lane == 0) uu = __hip_atomic_fetch_add(ccnt, 1u, __ATOMIC_RELAXED, __HIP_MEMORY_SCOPE_AGENT);
                const int it = __builtin_amdgcn_readfirstlane((int)uu);
                if (it >= 1024) break;
                const int r0 = (it & 511) * 32;
                if (it < 512) peer::convert_rows_i8(peer_u + (size_t)r0 * D, UT8 + (size_t)r0 * D, SU + r0, 32, 0, 1, lane);
                else peer::convert_rows_fp8(peer_v + (size_t)r0 * D, VT8 + (size_t)r0 * D, SV + r0, 32, 0, 1, lane);
            }
        }
    }
    SEAM(3);
    if (IN(4) && !(MK_SKIP & (1 << 4))) { fin::phase(L, Z, mu_prev, mu_next, g_up, Y, BON, k_a, r_k, lnx_g, lnx_b, MIX, O3, LSE, bx, G, tid, wave, lane); }
    SEAM(4);
    if (IN(5) && !(MK_SKIP & (1 << 5))) {
        pg8::Gemm g{MIX, WOUT, T, D, D}; pg8::StaticOrder S; S.init(T, D, G, bx);
        EpiRes E{x, MOD, 2 * D, out, D};
        pg8::gemm_phase<EpiRes, pg8::StaticOrder, true, true>(L + RING_OFF, g, S, E);
    }
    SEAM(5);
    if (IN(6) && !(MK_SKIP & (1 << 6))) { norm_rows_q(out, norm2_g, MOD, 3 * D, 4 * D, XN, XQ, SX, gw, NGW, lane);
    }
    SEAM(6);
    if (IN(7) && !(MK_SKIP & (1 << 7))) {
        pg8::Gemm g{XN, WQ, T, QW, D}; pg8::StaticOrder S; S.init(T, QW, G, bx);
        pg8::EpiBf16<0> E{Q, QW, nullptr, 0, 0, 1.f};
        pg8::gemm_phase<pg8::EpiBf16<0>, pg8::StaticOrder, true, true>(L + RING_OFF, g, S, E);
    }
    SEAM(7);
    if (IN(8) && !(MK_SKIP & (1 << 8))) { __syncthreads(); peer::setup_keys(L, keys1, keys2, tid); __syncthreads();
        for (int bt = gw; bt < T * PH / 16; bt += NGW) peer::select_batch(L, Q, IDX, GATE, bt, lane); }
    SEAM(8);
    {
        const int sl = bx & 7, wv = (bx >> 3) * NWAVES + wave, nwv = (G >> 3) * NWAVES;
        if (IN(9) && !(MK_SKIP & (1 << 9))) { peer::ffn_u_pass(XQ, IDX, UT8, (int*)PART, sl, wv, nwv, lane); }
        SEAM(9);
        if (IN(10) && !(MK_SKIP & (1 << 10))) {
            for (size_t i = (size_t)bx * NWAVES * 64 + tid; i < (size_t)T * HK; i += (size_t)G * NWAVES * 64) {
                int di = 0;
#pragma unroll
                for (int s8 = 0; s8 < 8; ++s8) di += ((const int*)PART)[(size_t)s8 * T * HK + i];
                const int ex = IDX[i];
                const float cf = GATE[i] * peer::gelu_erf((float)di * SU[ex] * SX[i / HK]) * SV[ex];
                ((unsigned*)GATE)[i] = ((unsigned)ex << 16) | f2bf(cf);
            }
        }
        SEAM(10);
        if (IN(11) && !(MK_SKIP & (1 << 11))) { peer::ffn_v_pass((const unsigned*)GATE, VT8, MOD, out, sl, wv, nwv, lane); }
    }
#undef IN
#undef SEAM
}

extern "C" void kernel_launch(void* const* d_in, const int* in_sizes, int n_in, void* d_out, int out_size, void* d_ws, size_t ws_size, hipStream_t stream) {
    static int grid = 0;
    if (grid == 0) {
        if (n_in != 27 || in_sizes[0] != T * D || out_size != T * D || ws_size < WS_END) { fprintf(stderr, "kernel_launch: unexpected problem (n_in %d, in0 %d, out %d, ws %zu); nothing launched\n", n_in, n_in > 0 ? in_sizes[0] : -1, out_size, ws_size); grid = -1; return; }
        int dev = 0, cus = 0, per_cu = 0;
        if (hipGetDevice(&dev) != hipSuccess || hipDeviceGetAttribute(&cus, hipDeviceAttributeMultiprocessorCount, dev) != hipSuccess) { fprintf(stderr, "kernel_launch: device query failed\n"); grid = -1; return; }
        if (hipFuncSetAttribute((const void*)mk_fwd, hipFuncAttributeMaxDynamicSharedMemorySize, LDS_BYTES) != hipSuccess) { fprintf(stderr, "kernel_launch: hipFuncSetAttribute failed\n"); grid = -1; return; }
        if (hipOccupancyMaxActiveBlocksPerMultiprocessor(&per_cu, (const void*)mk_fwd, NWAVES * 64, LDS_BYTES) != hipSuccess || per_cu < 1)
            fprintf(stderr, "kernel_launch: note: occupancy query reports %d workgroups per CU\n", per_cu);
        (void)hipGetLastError();
        grid = cus;
        if (grid % 8 != 0 || grid < 2 * (BATCH * NH * 2)) { fprintf(stderr, "kernel_launch: needs a CU count that is a multiple of 8 (XCD-sliced FFN passes) and >= 256 workgroups' worth of chains; got %d; nothing launched\n", grid); grid = -1; return; }
    }
    if (grid < 0) return;
    if (hipMemsetAsync((char*)d_ws + WS_CTL, 0, CTL_ZERO_BYTES, stream) != hipSuccess) { fprintf(stderr, "kernel_launch: hipMemsetAsync failed\n"); return; }
    Args a{};
    for (int i = 0; i < 27; ++i) a.in[i] = (const float*)d_in[i];
    a.out = (float*)d_out; a.ws = (unsigned char*)d_ws;
#ifndef MK_RANGES
#define MK_RANGES {{0, N_PHASES}}
#endif
    static const int ranges[][2] = MK_RANGES;
    const int nl = (int)(sizeof(ranges) / sizeof(ranges[0]));
    for (int li = 0; li < nl; ++li) {
        a.ph_lo = ranges[li][0]; a.ph_hi = ranges[li][1]; a.li = li;
        hipLaunchKernelGGL(mk_fwd, dim3(grid), dim3(NWAVES * 64), LDS_BYTES, stream, a);
        const hipError_t le = hipPeekAtLastError();
        if (le != hipSuccess) { fprintf(stderr, "kernel_launch: launch %d failed: %s\n", li, hipGetErrorName(le)); break; }
    }
}
```

```cpp
#include <hip/hip_runtime.h>
#include <cstdio>
#include <cstdint>
#include <cmath>
namespace pg8 {
#define PG8_LAS __attribute__((address_space(3)))
typedef unsigned short bf16_t;
typedef short bf16x8 __attribute__((ext_vector_type(8)));
typedef float f32x4 __attribute__((ext_vector_type(4)));
typedef unsigned u32x4 __attribute__((ext_vector_type(4)));
constexpr int BM = 256, BK = 64, HALF = 128, HTB = HALF * BK * 2  , STAGE_BYTES = 8 * HTB, NXCD = 8, WGM = 8;

__host__ __device__ __forceinline__ int lds_byte(int r, int c) { const int st = (r >> 4) * 2 + (c >> 5), rr = r & 15, cc = c & 31, ob = rr * 64 + cc * 2; return st * 1024 + (ob ^ (((ob >> 9) & 1) << 5)); }
__host__ __device__ __forceinline__ void stage_rc(int b, int& R, int& C) { const int st = b / 1024, sb = b % 1024, swz = sb ^ (((sb >> 9) & 1) << 5); R = (st >> 1) * 16 + swz / 64; C = (st & 1) * 32 + (swz % 64) / 2; }
__host__ __device__ __forceinline__ int perm32(int rho) { const int n = rho >> 4, i = rho & 15; return 8 * (i >> 2) + 4 * n + (i & 3); }

struct Unit { int pm, pn; };
struct Gemm { const bf16_t* A; const bf16_t* Bt; int M, N, K; };

struct StaticOrder {
    int nM, nN, nwg, G, c;
    __host__ __device__ void init(int M, int N, int G_, int c_) { nM = M / BM; nN = N / BM; nwg = nM * nN; G = G_; c = c_; }
    __host__ __device__ bool next(int i, Unit& u) const {
        const long L = (long)i * G + c; if (L >= nwg) return false;
        int wgid = (int)L; { const int q = nwg / NXCD, r = nwg % NXCD, xcd = wgid % NXCD, off = wgid / NXCD; wgid = (xcd < r ? xcd * (q + 1) : r * (q + 1) + (xcd - r) * q) + off; }
        const int nig = WGM * nN, gid = wgid / nig, fm = gid * WGM, gsz = (nM - fm) < WGM ? (nM - fm) : WGM;
        u.pm = fm + ((wgid % nig) % gsz); u.pn = (wgid % nig) / gsz; return true;
    }
    __device__ __forceinline__ void a_ready(const Unit&) const {}
    __device__ __forceinline__ void done(const Unit&) const {}
};

__device__ __forceinline__ unsigned cvt_pk_bf16(float lo, float hi) { unsigned r; asm volatile("v_cvt_pk_bf16_f32 %0, %1, %2" : "=v"(r) : "v"(lo), "v"(hi)); return r; }
typedef float f32x2 __attribute__((ext_vector_type(2)));
__device__ __forceinline__ f32x2 gelu_pk(f32x2 v) {
    const f32x2 av = __builtin_elementwise_abs(v), d = av * 0.2316418882f + 1.0f;
    f32x2 t; t.x = __builtin_amdgcn_rcpf(d.x); t.y = __builtin_amdgcn_rcpf(d.y);
    f32x2 q = t * 0.5307027145f + (-0.7265760135f); q = q * t + 0.7107068705f; q = q * t + (-0.142248368f); q = q * t + 0.127414796f; q = q * t;
    const f32x2 s = (v * v) * (-0.72134752044f);
    f32x2 e; e.x = __builtin_amdgcn_exp2f(s.x); e.y = __builtin_amdgcn_exp2f(s.y);
    const f32x2 m = v * (q * e), r = v - m;
    f32x2 o; o.x = v.x < 0.f ? m.x : r.x; o.y = v.y < 0.f ? m.y : r.y; return o;
}

template <int ACT  > struct EpiBf16 {
    static constexpr bool PERM = true, AFTER_DRAIN = false; static_assert(ACT == 0 || ACT == 1, "EpiBf16: ACT is 0 (none) or 1 (gelu_pk)");
    bf16_t* O; int ldc; const float* bias; int split_cols; size_t split_stride; float scale0;
    __device__ __forceinline__ void operator()(const f32x4 (&acc)[2][2][4][2], const Unit& u, int wr, int wc, int fr, int fq) const {
        const int row0 = u.pm * BM + wr * 64 + fr; int colt = u.pn * BM; bf16_t* base = O;
        float sc = 1.f; if (split_cols) { const int t = colt / split_cols; base += (size_t)t * split_stride; colt -= t * split_cols; if (t == 0) sc = scale0; }
        const int col0 = colt + wc * 32 + 8 * fq, bcol0 = u.pn * BM + wc * 32 + 8 * fq;
        f32x4 bv[2][2];
#pragma unroll
        for (int bj = 0; bj < 2; ++bj)
#pragma unroll
            for (int n = 0; n < 2; ++n) bv[bj][n] = bias ? *(const f32x4*)(bias + bcol0 + bj * HALF + 4 * n) : (f32x4){0.f, 0.f, 0.f, 0.f};
#pragma unroll
        for (int ai = 0; ai < 2; ++ai)
#pragma unroll
            for (int m = 0; m < 4; ++m) { bf16_t* rowp = base + (size_t)(row0 + ai * HALF + m * 16) * ldc + col0;
#pragma unroll
                for (int bj = 0; bj < 2; ++bj) { f32x4 v0 = acc[ai][bj][m][0] + bv[bj][0], v1 = acc[ai][bj][m][1] + bv[bj][1];
                    if (ACT == 1) { f32x2 a = gelu_pk((f32x2){v0[0], v0[1]}), b = gelu_pk((f32x2){v0[2], v0[3]}), c = gelu_pk((f32x2){v1[0], v1[1]}), d = gelu_pk((f32x2){v1[2], v1[3]});
                        v0 = (f32x4){a.x, a.y, b.x, b.y}; v1 = (f32x4){c.x, c.y, d.x, d.y}; }
                    v0 = v0 * sc; v1 = v1 * sc; u32x4 w; w.x = cvt_pk_bf16(v0[0], v0[1]); w.y = cvt_pk_bf16(v0[2], v0[3]); w.z = cvt_pk_bf16(v1[0], v1[1]); w.w = cvt_pk_bf16(v1[2], v1[3]);
                    *(u32x4*)(rowp + bj * HALF) = w; } }
    }
};

template <class Epi, class Sched, bool ALIGN_EPI = false, bool SP2 = false>
__device__ __forceinline__ void gemm_phase(PG8_LAS unsigned char* lds, const Gemm g, const Sched& S, const Epi& E) {
    const int tid = threadIdx.x, wid = __builtin_amdgcn_readfirstlane(tid >> 6), lane = tid & 63, wr = wid >> 2, wc = wid & 3, fr = lane & 15, fq = lane >> 4;
    const int K = g.K, nt = K / BK;
    unsigned voffA[2], voffB[2];
#pragma unroll
    for (int i = 0; i < 2; ++i) { int R, C; stage_rc(tid * 16 + i * 8192, R, C); const int Rb = Epi::PERM ? ((R & ~31) + perm32(R & 31)) : R;
        voffA[i] = (unsigned)(R * K + C) * 2u; voffB[i] = (unsigned)(Rb * K + C) * 2u; }
    const size_t kstep = (size_t)(BK * 2);
    const size_t hstep = (size_t)HALF * K * 2;
    const size_t tstep = 2 * hstep;
    const unsigned ldsw = (unsigned)wid * 1024u;
    const int aoff = lds_byte(wr * 64 + fr, fq * 8), boff = lds_byte(wc * 32 + fr, fq * 8);
#define PG8_SA(b, h) (((b) * 2 + (h)) * HTB)
#define PG8_SB(b, h) ((4 + (b) * 2 + (h)) * HTB)
#define PG8_STAGE(bufoff, gbase, voff) do { _Pragma("unroll") for (int _i = 0; _i < 2; ++_i) \
        __builtin_amdgcn_global_load_lds((const unsigned*)((const char*)(gbase) + (voff)[_i]), (PG8_LAS unsigned*)(lds + (bufoff) + ldsw + _i * 8192), 16, 0, 0); } while (0)
#define PG8_LDA(dst, b, h) do { _Pragma("unroll") for (int m = 0; m < 4; ++m) _Pragma("unroll") for (int k = 0; k < 2; ++k) dst[m][k] = *(const PG8_LAS bf16x8*)(lds + PG8_SA(b, h) + aoff + m * 2048 + k * 1024); } while (0)
#define PG8_LDB(dst, b, h) do { _Pragma("unroll") for (int n = 0; n < 2; ++n) _Pragma("unroll") for (int k = 0; k < 2; ++k) dst[n][k] = *(const PG8_LAS bf16x8*)(lds + PG8_SB(b, h) + boff + n * 2048 + k * 1024); } while (0)
#define PG8_MMA(ai, bj, At, Bt) do { __builtin_amdgcn_s_setprio(1); _Pragma("unroll") for (int m = 0; m < 4; ++m) _Pragma("unroll") for (int n = 0; n < 2; ++n) _Pragma("unroll") for (int k = 0; k < 2; ++k) \
        acc[ai][bj][m][n] = __builtin_amdgcn_mfma_f32_16x16x32_bf16(Bt[n][k], At[m][k], acc[ai][bj][m][n], 0, 0, 0); __builtin_amdgcn_s_setprio(0); } while (0)
#define PG8_WAIT_V(n) asm volatile("s_waitcnt vmcnt(" #n ")" ::: "memory")
#define PG8_WAIT_L(n) asm volatile("s_waitcnt lgkmcnt(" #n ")" ::: "memory")
#define PG8_BAR __builtin_amdgcn_s_barrier()
#define PG8_SCHED __builtin_amdgcn_sched_barrier(0)
    Unit cur, nxt; int ui = 0;
    if (!S.next(0, cur)) return;
    f32x4 acc[2][2][4][2];
#pragma unroll
    for (int a = 0; a < 2; ++a)
#pragma unroll
        for (int b = 0; b < 2; ++b)
#pragma unroll
            for (int m = 0; m < 4; ++m)
#pragma unroll
                for (int n = 0; n < 2; ++n) acc[a][b][m][n] = (f32x4){0.f, 0.f, 0.f, 0.f};
    bf16x8 At[4][2], B0[2][2], B1[2][2];
    const char* cA = (const char*)g.A + (size_t)cur.pm * tstep; const char* cB = (const char*)g.Bt + (size_t)cur.pn * tstep;
    S.a_ready(cur);
    if constexpr (SP2) {
        PG8_STAGE(PG8_SB(0, 0), cB, voffB); PG8_STAGE(PG8_SB(0, 1), cB + hstep, voffB); PG8_STAGE(PG8_SA(0, 0), cA, voffA); PG8_STAGE(PG8_SA(0, 1), cA + hstep, voffA);
        if (wr == 1) PG8_BAR;
        PG8_WAIT_V(2); PG8_BAR;
        PG8_STAGE(PG8_SB(1, 0), cB + kstep, voffB); PG8_STAGE(PG8_SA(1, 0), cA + kstep, voffA); PG8_STAGE(PG8_SB(1, 1), cB + hstep + kstep, voffB);
        PG8_WAIT_V(6); PG8_BAR;
    } else {
        PG8_STAGE(PG8_SB(0, 0), cB, voffB); PG8_STAGE(PG8_SA(0, 0), cA, voffA); PG8_STAGE(PG8_SB(0, 1), cB + hstep, voffB); PG8_STAGE(PG8_SA(0, 1), cA + hstep, voffA);
        if (wr == 1) PG8_BAR;
        PG8_WAIT_V(4); PG8_BAR;
        PG8_STAGE(PG8_SB(1, 0), cB + kstep, voffB); PG8_STAGE(PG8_SA(1, 0), cA + kstep, voffA); PG8_STAGE(PG8_SB(1, 1), cB + hstep + kstep, voffB);
        PG8_WAIT_V(6); PG8_BAR;
    }
    for (;;) {
        const bool has_next = S.next(ui + 1, nxt);
        const char* nA = has_next ? (const char*)g.A + (size_t)nxt.pm * tstep : cA; const char* nB = has_next ? (const char*)g.Bt + (size_t)nxt.pn * tstep : cB;
        for (int t = 0; t < nt; t += 2) {
            const bool last = (t == nt - 2);
            const char* a1 = cA + (size_t)(t + 1) * kstep;
            const char* a2 = last ? nA : cA + (size_t)(t + 2) * kstep; const char* b2 = last ? nB : cB + (size_t)(t + 2) * kstep;
            const char* a3 = a2 + kstep; const char* b3 = b2 + kstep;
            if (last && has_next) S.a_ready(nxt);
            if constexpr (SP2) {
            PG8_LDB(B0, 0, 0); PG8_LDB(B1, 0, 1); PG8_SCHED; PG8_LDA(At, 0, 0); PG8_STAGE(PG8_SA(1, 1), a1 + hstep, voffA);
            PG8_WAIT_V(8); PG8_WAIT_L(0); PG8_BAR; PG8_MMA(0, 0, At, B0); PG8_MMA(0, 1, At, B1); PG8_BAR; PG8_SCHED;
            PG8_LDA(At, 0, 1); PG8_STAGE(PG8_SB(0, 0), b2, voffB); PG8_STAGE(PG8_SB(0, 1), b2 + hstep, voffB); PG8_STAGE(PG8_SA(0, 0), a2, voffA);
            PG8_WAIT_V(8); PG8_WAIT_L(0); PG8_BAR; PG8_MMA(1, 0, At, B0); PG8_MMA(1, 1, At, B1); PG8_BAR; PG8_SCHED;
            PG8_LDB(B0, 1, 0); PG8_LDB(B1, 1, 1); PG8_SCHED; PG8_LDA(At, 1, 0); PG8_STAGE(PG8_SA(0, 1), a2 + hstep, voffA);
            PG8_WAIT_V(8); PG8_WAIT_L(0); PG8_BAR; PG8_MMA(0, 0, At, B0); PG8_MMA(0, 1, At, B1); PG8_BAR; PG8_SCHED;
            PG8_LDA(At, 1, 1); PG8_STAGE(PG8_SB(1, 0), b3, voffB); PG8_STAGE(PG8_SB(1, 1), b3 + hstep, voffB); PG8_STAGE(PG8_SA(1, 0), a3, voffA);
            PG8_WAIT_V(8); PG8_WAIT_L(0); PG8_BAR; PG8_MMA(1, 0, At, B0); PG8_MMA(1, 1, At, B1); PG8_BAR; PG8_SCHED;
            } else {
            PG8_LDB(B0, 0, 0); PG8_SCHED; PG8_LDA(At, 0, 0); PG8_STAGE(PG8_SA(1, 1), a1 + hstep, voffA);
            PG8_WAIT_L(8); PG8_BAR; PG8_WAIT_L(0); PG8_MMA(0, 0, At, B0); PG8_BAR; PG8_SCHED;
            PG8_LDB(B1, 0, 1); PG8_STAGE(PG8_SB(0, 0), b2, voffB);
            PG8_BAR; PG8_WAIT_L(0); PG8_MMA(0, 1, At, B1); PG8_BAR;
            PG8_LDA(At, 0, 1); PG8_STAGE(PG8_SA(0, 0), a2, voffA);
            PG8_BAR; PG8_WAIT_L(0); PG8_MMA(1, 0, At, B0); PG8_BAR; PG8_SCHED;
            PG8_STAGE(PG8_SB(0, 1), b2 + hstep, voffB);
            PG8_WAIT_V(6); PG8_BAR; PG8_MMA(1, 1, At, B1); PG8_BAR;
            PG8_LDB(B0, 1, 0); PG8_SCHED; PG8_LDA(At, 1, 0); PG8_STAGE(PG8_SA(0, 1), a2 + hstep, voffA);
            PG8_WAIT_L(8); PG8_BAR; PG8_WAIT_L(0); PG8_MMA(0, 0, At, B0); PG8_BAR; PG8_SCHED;
            PG8_LDB(B1, 1, 1); PG8_STAGE(PG8_SB(1, 0), b3, voffB);
            PG8_BAR; PG8_WAIT_L(0); PG8_MMA(0, 1, At, B1); PG8_BAR;
            PG8_LDA(At, 1, 1); PG8_STAGE(PG8_SA(1, 0), a3, voffA);
            PG8_BAR; PG8_WAIT_L(0); PG8_MMA(1, 0, At, B0); PG8_BAR; PG8_SCHED;
            PG8_STAGE(PG8_SB(1, 1), b3 + hstep, voffB);
            PG8_WAIT_V(6); PG8_BAR; PG8_MMA(1, 1, At, B1); PG8_BAR;
            }
        }
        if constexpr (ALIGN_EPI) { if (wr == 0) PG8_BAR; }
        if constexpr (!Epi::AFTER_DRAIN) { E(acc, cur, wr, wc, fr, fq); S.done(cur); }
        if (!has_next) break;
#pragma unroll
        for (int a = 0; a < 2; ++a)
#pragma unroll
            for (int b = 0; b < 2; ++b)
#pragma unroll
                for (int m = 0; m < 4; ++m)
#pragma unroll
                    for (int n = 0; n < 2; ++n) acc[a][b][m][n] = (f32x4){0.f, 0.f, 0.f, 0.f};
        cur = nxt; cA = nA; cB = nB; ++ui;
        if constexpr (ALIGN_EPI) { if (wr == 1) PG8_BAR; }
    }
    PG8_WAIT_V(0);
    if constexpr (!ALIGN_EPI) { if (wr == 0) PG8_BAR; }
    PG8_BAR;
    if constexpr (Epi::AFTER_DRAIN) { E.fused(acc, cur, wr, wc, fr, fq, lds, wid, lane); S.done(cur); }
#undef PG8_SA
#undef PG8_SB
#undef PG8_STAGE
#undef PG8_LDA
#undef PG8_LDB
#undef PG8_MMA
#undef PG8_WAIT_V
#undef PG8_WAIT_L
#undef PG8_BAR
#undef PG8_SCHED
}
}
#define GAS __attribute__((address_space(1)))
#define LAS __attribute__((address_space(3)))
typedef unsigned short bf16;
typedef unsigned v4u __attribute__((ext_vector_type(4)));
typedef float f32x4 __attribute__((ext_vector_type(4)));
typedef short bf16x8 __attribute__((ext_vector_type(8)));
typedef GAS unsigned gu32;
typedef GAS unsigned long long gu64;
#define RLX_AGENT __ATOMIC_RELAXED, __HIP_MEMORY_SCOPE_AGENT
#define LDS_WAIT() asm volatile("s_waitcnt lgkmcnt(0)" ::: "memory")
#define VM_WAIT() asm volatile("s_waitcnt vmcnt(0)" ::: "memory")
__device__ __forceinline__ unsigned long long rt() { return __builtin_amdgcn_s_memrealtime(); }
__device__ __forceinline__ unsigned f2bf(float f) { unsigned u = __builtin_bit_cast(unsigned, f); return (u + 0x7fffu + ((u >> 16) & 1u)) >> 16; }
__device__ __forceinline__ unsigned pk2(float lo, float hi) { return f2bf(lo) | (f2bf(hi) << 16); }

#define XB_TMO      128
#define XB_XCNT(j)  (256  + 64 * (j))
#define XB_XSUB(j)  (1280 + 64 * (j))
#define XB_XGEN(j)  (2304 + 64 * (j))
#define XB_TOP      3328
#define XB_TOPGEN   3392
#define XCD_BAR_WORDS 3456
#define XB_SPIN_CAP (1u << 18)

__device__ __forceinline__ unsigned xb_ld(unsigned* p)              { return __hip_atomic_load(p, __ATOMIC_RELAXED, __HIP_MEMORY_SCOPE_AGENT); }
__device__ __forceinline__ unsigned xb_add(unsigned* p, unsigned v) { return __hip_atomic_fetch_add(p, v, __ATOMIC_RELAXED, __HIP_MEMORY_SCOPE_AGENT); }
__device__ __forceinline__ unsigned xb_xcc_id() { return (unsigned)__builtin_amdgcn_s_getreg((3 << 11) | 20) & 0xFu; }
#define XB_SPIN(cond, bar) do { unsigned _sp = 0; while (cond) { __builtin_amdgcn_s_sleep(1); \
    if ((++_sp & 255u) == 0u) { if (xb_ld(&(bar)[XB_TMO])) break; if (_sp > XB_SPIN_CAP) { atomicAdd(&(bar)[XB_TMO], 1u); break; } } } } while (0)

struct XcdBarrier {
    unsigned* bar; unsigned x;
    volatile LAS unsigned* st;
};

__device__ __forceinline__ XcdBarrier xcd_barrier_post(unsigned* bar, volatile LAS unsigned* st) {
    XcdBarrier b; b.bar = bar; b.x = xb_xcc_id(); b.st = st;
    if (threadIdx.x == 0) (void)xb_add(&bar[XB_XCNT(b.x)], 1u);
    return b;
}
__device__ __forceinline__ void xcd_barrier_complete(unsigned* bar, unsigned x, unsigned& nloc, unsigned& nx) {
    const unsigned G = gridDim.x * gridDim.y * gridDim.z;
    unsigned sum, cnt, mine, sp = 0u;
    for (;;) {
        sum = 0u; cnt = 0u; mine = 0u;
#pragma unroll
        for (unsigned j = 0; j < 16; ++j) { const unsigned c = xb_ld(&bar[XB_XCNT(j)]); sum += c; cnt += (c > 0u) ? 1u : 0u; mine = (j == x) ? c : mine; }
        if (sum == G) break;
        __builtin_amdgcn_s_sleep(1);
        if ((++sp & 255u) == 0u) { if (xb_ld(&bar[XB_TMO])) break; if (sp > XB_SPIN_CAP) { atomicAdd(&bar[XB_TMO], 1u); break; } }
    }
    nloc = mine > 0u ? mine : 1u; nx = cnt > 0u ? cnt : 1u;
}

__device__ __forceinline__ void xcd_barrier(const XcdBarrier& b) {
    asm volatile("s_waitcnt vmcnt(0)" ::: "memory");
    __syncthreads();
    if (threadIdx.x == 0) {
        unsigned* bar = b.bar;
        __builtin_amdgcn_s_waitcnt(0);
        unsigned nloc = b.st[0], nx = b.st[1];
        if (nloc == 0u) { xcd_barrier_complete(bar, b.x, nloc, nx); b.st[0] = nloc; b.st[1] = nx; }
        const unsigned old = xb_add(&bar[XB_XSUB(b.x)], 1u);
        const unsigned gen = old / nloc;
        if (old + 1u == (gen + 1u) * nloc) {
            __builtin_amdgcn_fence(__ATOMIC_RELEASE, "agent");
            asm volatile("s_waitcnt vmcnt(0)" ::: "memory");
            const unsigned og = xb_add(&bar[XB_TOP], 1u);
            const unsigned tg = og / nx;
            if (og + 1u == (tg + 1u) * nx) xb_add(&bar[XB_TOPGEN], 1u);
            else XB_SPIN(xb_ld(&bar[XB_TOPGEN]) == tg, bar);
            __builtin_amdgcn_fence(__ATOMIC_ACQUIRE, "agent");
            xb_add(&bar[XB_XGEN(b.x)], 1u);
            asm volatile("s_waitcnt vmcnt(0)" ::: "memory");
        } else {
            XB_SPIN(xb_ld(&bar[XB_XGEN(b.x)]) == gen, bar);
            __builtin_amdgcn_fence(__ATOMIC_ACQUIRE, "agent");
            asm volatile("s_waitcnt vmcnt(0)" ::: "memory");
        }
    }
    __syncthreads();
}
constexpr int NWAVES = 8;
constexpr int D = 1024, BATCH = 8, SEQ = 2048, T = BATCH * SEQ;
constexpr int AW = 512, RW = 512, NH = 8;
constexpr int DL = 64, AL = 64, GL = 128;
constexpr int SHIFTW = 3 * RW + DL + AL + GL;
constexpr int INW = 3 * AW + SHIFTW;
constexpr int NKEYS = 128, PH = 8, PKD = 256, TOPK = 16, HK = PH * TOPK;
constexpr int QW = PH * PKD;
constexpr int MODW = 6 * D;

constexpr size_t MiB = 1u << 20;
constexpr size_t WS_CTL = 0, CTL_ZERO_BYTES = 1 * MiB + 256 * 1024;
constexpr size_t WS_MOD = 1 * MiB;
constexpr size_t WS_KEYS = 1 * MiB + 512 * 1024;
constexpr size_t WS_WIN = 2 * MiB;
constexpr size_t WS_WOUT = 9 * MiB;
constexpr size_t WS_WQ = 11 * MiB;
constexpr size_t WS_XN = 16 * MiB;
constexpr size_t WS_O3 = 16 * MiB;
constexpr size_t WS_LSE = 32 * MiB;
constexpr size_t WS_Z = 48 * MiB;
constexpr size_t WS_MIX = 152 * MiB;
constexpr size_t WS_Y = 184 * MiB;
constexpr size_t WS_Q = 48 * MiB;
constexpr size_t WS_IDX = 112 * MiB;
constexpr size_t WS_GATE = 120 * MiB;
constexpr size_t WS_PART = 48 * MiB;
constexpr size_t WS_XQ = 128 * MiB;
constexpr size_t WS_UT = 216 * MiB;
constexpr size_t WS_SU = 249 * MiB;
constexpr size_t WS_VT = 232 * MiB;
constexpr size_t WS_BON = 248 * MiB;
constexpr size_t WS_END = 250 * MiB;
constexpr int CW_WORK = 1024;
constexpr int CW_WORK2 = 2048;
constexpr int CW_BAR = 4096;
constexpr int MAX_LAUNCHES = 12;

constexpr int RING_OFF = 0, RING_BYTES = 139264;
constexpr int LDSCTL_OFF = RING_BYTES, MISC_OFF = LDSCTL_OFF + 320;
constexpr int LDS_BYTES = 147456;
static_assert(MISC_OFF + 128 <= LDS_BYTES, "LDS map");

typedef GAS float gf32;
typedef GAS f32x4 gf32x4;

__device__ __forceinline__ float bf2f(bf16 v) { return __uint_as_float(((unsigned)v) << 16); }
__device__ __forceinline__ float wave_sum(float v) {
#pragma unroll
    for (int o = 1; o < 64; o <<= 1) v += __shfl_xor(v, o);
    return v;
}
#define WAVE_LDS_SYNC() do { asm volatile("s_waitcnt lgkmcnt(0)" ::: "memory"); __builtin_amdgcn_wave_barrier(); } while (0)

__device__ __forceinline__ void p0_transpose_item(const float* W, int K, int N, bf16* WT, int row_off, LAS float* scr, int item, int lane) {
    const int nblk = N / 32, kb = item / nblk, nb = item % nblk, k0 = 64 * kb, n0 = 32 * nb;
#pragma unroll 8
    for (int i = 0; i < 32; ++i) { const int kk = 2 * i + (lane >> 5); scr[kk * 33 + (lane & 31)] = W[(size_t)(k0 + kk) * N + n0 + (lane & 31)]; }
    LDS_WAIT(); asm volatile("" ::: "memory");
    const int c = lane & 7;
#pragma unroll
    for (int j = 0; j < 4; ++j) { const int n = (lane >> 3) + 8 * j; const LAS float* s = scr + (8 * c) * 33 + n;
        v4u o; o.x = pk2(s[0 * 33], s[1 * 33]); o.y = pk2(s[2 * 33], s[3 * 33]); o.z = pk2(s[4 * 33], s[5 * 33]); o.w = pk2(s[6 * 33], s[7 * 33]);
        *(GAS v4u*)(WT + (size_t)(row_off + n0 + n) * K + k0 + 8 * c) = o; }
    LDS_WAIT(); asm volatile("" ::: "memory");
}

template <bool QUANT>
__device__ __forceinline__ void norm_rows_t(const float* x, const float* g, const float* mod, int shift_off, int scale_off, bf16* o, unsigned char* q, float* qscale, int gw, int ngw, int lane) {
    const int rpw = T / ngw, m0 = gw * rpw;
    const float* modb = mod + (m0 / SEQ) * MODW;
    f32x4 c1[4], c2[4];
#pragma unroll
    for (int j = 0; j < 4; ++j) { const int col = 256 * j + 4 * lane;
        c1[j] = *(const GAS f32x4*)(g + col) * (*(const GAS f32x4*)(modb + scale_off + col) + 1.0f); c2[j] = *(const GAS f32x4*)(modb + shift_off + col); }
    f32x4 nx[4];
#pragma unroll
    for (int j = 0; j < 4; ++j) nx[j] = ((const GAS f32x4*)(x + (size_t)m0 * D) + lane)[64 * j];
    for (int m = m0; m < m0 + rpw; ++m) {
        f32x4 v[4]; float s = 0.f;
#pragma unroll
        for (int j = 0; j < 4; ++j) { v[j] = nx[j]; s += (v[j].x * v[j].x + v[j].y * v[j].y) + (v[j].z * v[j].z + v[j].w * v[j].w); }
        if (m + 1 < m0 + rpw) {
#pragma unroll
            for (int j = 0; j < 4; ++j) nx[j] = ((const GAS f32x4*)(x + (size_t)(m + 1) * D) + lane)[64 * j]; }
        const float rs = 1.0f / sqrtf(wave_sum(s) * (1.f / D) + 1e-6f);
        GAS unsigned long long* o8 = (GAS unsigned long long*)(o + (size_t)m * D) + lane;
        float mx = 0.f;
#pragma unroll
        for (int j = 0; j < 4; ++j) {
            const f32x4 y = v[j] * rs * c1[j] + c2[j];
            if (QUANT) { v[j] = y; mx = fmaxf(mx, fmaxf(fmaxf(fabsf(y.x), fabsf(y.y)), fmaxf(fabsf(y.z), fabsf(y.w)))); }
            o8[64 * j] = (unsigned long long)pk2(y.x, y.y) | ((unsigned long long)pk2(y.z, y.w) << 32);
        }
        if (QUANT) {
#pragma unroll
            for (int oo = 1; oo < 64; oo <<= 1) mx = fmaxf(mx, __shfl_xor(mx, oo));
            mx = fmaxf(mx, 1e-30f);
            const float inv = 127.0f / mx;
#pragma unroll
            for (int j = 0; j < 4; ++j) {
                const int ia = (int)rintf(v[j].x * inv), ib = (int)rintf(v[j].y * inv), ic = (int)rintf(v[j].z * inv), id = (int)rintf(v[j].w * inv);
                *(GAS unsigned*)(q + (size_t)m * D + 256 * j + 4 * lane) = (unsigned)(ia & 0xff) | ((unsigned)(ib & 0xff) << 8) | ((unsigned)(ic & 0xff) << 16) | ((unsigned)id << 24);
            }
            if (lane == 0) qscale[m] = mx * (1.0f / 127.0f);
        }
    }
}

struct EpiRes {
    static constexpr bool PERM = false, AFTER_DRAIN = false;
    const float* xres; const float* mod; int gate_off; float* out; int ldc;
    __device__ __forceinline__ void operator()(const pg8::f32x4 (&acc)[2][2][4][2], const pg8::Unit& u, int wr, int wc, int fr, int fq) const {
        const int col0 = u.pn * pg8::BM + wc * 32 + 4 * fq;
        const int b = (u.pm * pg8::BM) / SEQ;
        pg8::f32x4 gv[2][2];
#pragma unroll
        for (int bj = 0; bj < 2; ++bj)
#pragma unroll
            for (int n = 0; n < 2; ++n) gv[bj][n] = *(const pg8::f32x4*)(mod + b * MODW + gate_off + col0 + bj * pg8::HALF + n * 16);
#pragma unroll
        for (int ai = 0; ai < 2; ++ai)
#pragma unroll
            for (int m = 0; m < 4; ++m) { const size_t off = (size_t)(u.pm * pg8::BM + ai * pg8::HALF + wr * 64 + m * 16 + fr) * ldc + col0;
#pragma unroll
                for (int bj = 0; bj < 2; ++bj)
#pragma unroll
                    for (int n = 0; n < 2; ++n) { const pg8::f32x4 bs = *(const pg8::f32x4*)(xres + off + bj * pg8::HALF + n * 16);
                        *(pg8::f32x4*)(out + off + bj * pg8::HALF + n * 16) = bs + gv[bj][n] * acc[ai][bj][m][n]; } }
    }
};

namespace scan {
typedef unsigned u32x2 __attribute__((ext_vector_type(2)));
constexpr int SLOT = 1024, BUF_BYTES = 12800, NBUF = 8;
constexpr int OFF_LORA = NBUF * BUF_BYTES;
constexpr int OFF_CONST = OFF_LORA + 16 * SLOT;
constexpr int OFF_MT = OFF_CONST + 5120;
constexpr int SCAN_LDS = OFF_MT + 8 * 1024;
static_assert(SCAN_LDS <= 139264, "scan LDS map");
constexpr int S_KK = 0, S_R = 2, S_MT = 4, S_N = 5, S_BK = 6, S_V = 10, S_GC = 12;

typedef float f32x2n __attribute__((ext_vector_type(2)));
typedef __bf16 bf16x2n __attribute__((ext_vector_type(2)));
__device__ __forceinline__ unsigned cvtpk(float lo, float hi) { const f32x2n v = {lo, hi}; const bf16x2n b = __builtin_convertvector(v, bf16x2n); return __builtin_bit_cast(unsigned, b); }
__device__ __forceinline__ bf16x8 mkfrag(unsigned a, unsigned b, unsigned c, unsigned d) { v4u w; w.x = a; w.y = b; w.z = c; w.w = d; return __builtin_bit_cast(bf16x8, w); }
__device__ __forceinline__ bf16x8 frag8(const float (&lo)[4], const float (&hi)[4]) { return mkfrag(cvtpk(lo[0], lo[1]), cvtpk(lo[2], lo[3]), cvtpk(hi[0], hi[1]), cvtpk(hi[2], hi[3])); }
__device__ __forceinline__ f32x4 mma(bf16x8 a, bf16x8 b, f32x4 c) { return __builtin_amdgcn_mfma_f32_16x16x32_bf16(a, b, c, 0, 0, 0); }
template <int N> __device__ __forceinline__ float row_shr(float x) { return __int_as_float(__builtin_amdgcn_update_dpp(0, __float_as_int(x), 0x110 + N, 0xf, 0xf, true)); }
__device__ __forceinline__ float fsigmoid(float x) { return __builtin_amdgcn_rcpf(1.0f + __expf(-x)); }
__device__ __forceinline__ bf16 tobf(float x) { return (bf16)(cvtpk(x, x) & 0xffffu); }

__device__ __forceinline__ void setup(LAS unsigned char* L, int h, int dir, const float* mu_prev, const float* mu_next, const float* w_decay0, const float* w_decay_up,
                                      const float* a_gate0, const float* a_gate_up, const float* k_k, const float* k_a, const float* r_k, int tid) {
    LAS float* C = (LAS float*)(L + OFF_CONST);
    for (int i = tid; i < 320; i += 512) {
        const int grp = i >> 6, c = i & 63;
        const int col = (grp < 3) ? grp * RW + h * 64 + c : 3 * RW + (grp - 3) * 64 + c;
        C[i] = mu_prev[col]; C[320 + i] = mu_next[col]; C[960 + i] = 1.0f - mu_prev[col] - mu_next[col];
    }
    if (tid < 64) { const int hc = h * 64 + tid; C[640 + tid] = w_decay0[dir * RW + hc]; C[704 + tid] = a_gate0[dir * RW + hc]; C[768 + tid] = k_k[hc]; C[832 + tid] = k_a[hc]; C[896 + tid] = r_k[hc]; }
    LAS bf16* F = (LAS bf16*)(L + OFF_LORA);
    for (int i = tid; i < 16 * 64 * 8; i += 512) {
        const int j = i & 7, l = (i >> 3) & 63, sl = i >> 9, m = sl & 1, ct = (sl >> 1) & 3, wa = sl >> 3;
        const int g = l >> 4, jj = 32 * m + (j < 4 ? 4 * g + j : 16 + 4 * g + j - 4), c = h * 64 + 16 * ct + (l & 15);
        const float v = wa ? a_gate_up[(size_t)(dir * AL + jj) * RW + c] : w_decay_up[(size_t)(dir * DL + jj) * RW + c];
        F[i] = (bf16)f2bf(v);
    }
}

__device__ __forceinline__ void helper_chunk(LAS unsigned char* L, LAS unsigned char* buf, LAS float* MT, const bf16* Z, float* BON, int b, int h, int dir, int n, int lane) {
    const int s = lane & 15, g = lane >> 4;
    const int cn = dir ? (SEQ / 16 - 1 - n) : n;
    const int t = cn * 16 + (dir ? 15 - s : s), tok = b * SEQ + t;
    const LAS float* C = (const LAS float*)(L + OFF_CONST);
    const bool hasp = t > 0, hasn = t < SEQ - 1;
    float rv[4][4], kv[4][4], vv[4][4], tw[4][4], xa[4][4];
    constexpr int SROW = 136, SGRP = 18 * SROW;
    {
        v4u ld[12];
#pragma unroll
        for (int i = 0; i < 12; ++i) {
            int p = 8 * i + (lane >> 3); p = p < 90 ? p : 89;
            const int grp = p / 18, row = p - 18 * grp;
            const int st = (row < 16) ? row : (row == 16 ? -1 : 16);
            int tt = cn * 16 + (dir ? 15 - st : st); tt = tt < 0 ? 0 : (tt > SEQ - 1 ? SEQ - 1 : tt);
            const int cbase = (grp < 3) ? grp * RW + h * 64 : 3 * RW + (grp - 3) * 64;
            ld[i] = *(const v4u*)(Z + (size_t)(b * SEQ + tt) * INW + 3 * AW + cbase + 8 * (lane & 7));
        }
#pragma unroll
        for (int i = 0; i < 12; ++i) {
            int p = 8 * i + (lane >> 3); p = p < 90 ? p : 89;
            const int grp = p / 18, row = p - 18 * grp;
            LAS unsigned char* q = buf + grp * SGRP + row * SROW + 16 * (lane & 7);
            *(LAS u32x2*)q = (u32x2){ld[i].x, ld[i].y}; *(LAS u32x2*)(q + 8) = (u32x2){ld[i].z, ld[i].w};
        }
    }
    asm volatile("s_waitcnt lgkmcnt(0)" ::: "memory"); __builtin_amdgcn_wave_barrier();
    {
        const int rlo = (s == 0) ? 16 : s - 1, rup = (s == 15) ? 17 : s + 1;
        const int rp = dir ? rup : rlo, rn = dir ? rlo : rup;
        typedef float f32x2s __attribute__((ext_vector_type(2)));
        const unsigned pmask = hasp ? 0xffffffffu : 0u, nmask = hasn ? 0xffffffffu : 0u;
#pragma unroll
        for (int grp = 0; grp < 5; ++grp) {
#pragma unroll
            for (int ct = 0; ct < 4; ++ct) {
                const LAS unsigned char* q = buf + grp * SGRP + 32 * ct + 8 * g;
                const u32x2 zcc = *(const LAS u32x2*)(q + s * SROW);
                u32x2 zp = *(const LAS u32x2*)(q + rp * SROW), zn = *(const LAS u32x2*)(q + rn * SROW);
                zp.x &= pmask; zp.y &= pmask; zn.x &= nmask; zn.y &= nmask;
                const f32x4 mp = *(const LAS f32x4*)(C + grp * 64 + 16 * ct + 4 * g), mn = *(const LAS f32x4*)(C + 320 + grp * 64 + 16 * ct + 4 * g), mc = *(const LAS f32x4*)(C + 960 + grp * 64 + 16 * ct + 4 * g);
                const f32x2s z01 = {__uint_as_float(zcc.x << 16), __uint_as_float(zcc.x & 0xffff0000u)}, z23 = {__uint_as_float(zcc.y << 16), __uint_as_float(zcc.y & 0xffff0000u)};
                const f32x2s p01 = {__uint_as_float(zp.x << 16), __uint_as_float(zp.x & 0xffff0000u)}, p23 = {__uint_as_float(zp.y << 16), __uint_as_float(zp.y & 0xffff0000u)};
                const f32x2s n01 = {__uint_as_float(zn.x << 16), __uint_as_float(zn.x & 0xffff0000u)}, n23 = {__uint_as_float(zn.y << 16), __uint_as_float(zn.y & 0xffff0000u)};
                const f32x2s o01 = (f32x2s){mc[0], mc[1]} * z01 + (f32x2s){mp[0], mp[1]} * p01 + (f32x2s){mn[0], mn[1]} * n01;
                const f32x2s o23 = (f32x2s){mc[2], mc[3]} * z23 + (f32x2s){mp[2], mp[3]} * p23 + (f32x2s){mn[2], mn[3]} * n23;
                const float ov[4] = {o01.x, o01.y, o23.x, o23.y};
#pragma unroll
                for (int r = 0; r < 4; ++r) {
                    const float o = ov[r];
                    if (grp == 0) rv[ct][r] = o; else if (grp == 1) kv[ct][r] = o; else if (grp == 2) vv[ct][r] = o;
                    else if (grp == 3) { const float e2 = __expf(2.0f * o); tw[ct][r] = 1.0f - 2.0f * __builtin_amdgcn_rcpf(e2 + 1.0f); } else xa[ct][r] = o;
                }
            }
            __builtin_amdgcn_sched_barrier(0);
        }
    }
    asm volatile("s_waitcnt lgkmcnt(0)" ::: "memory"); __builtin_amdgcn_wave_barrier();
#pragma unroll
    for (int ct = 0; ct < 4; ++ct)
#pragma unroll
        for (int r = 0; r < 4; ++r)
            *(LAS bf16*)(buf + (S_V + (ct >> 1)) * SLOT + (4 * g + r + 16 * (s >> 2)) * 16 + (ct & 1) * 8 + 2 * (s & 3)) = tobf(vv[ct][r]);
    f32x4 accw[4], acca[4];
    { const bf16x8 tb0 = frag8(tw[0], tw[1]), tb1 = frag8(tw[2], tw[3]), xb0 = frag8(xa[0], xa[1]), xb1 = frag8(xa[2], xa[3]);
      const LAS bf16x8* F = (const LAS bf16x8*)(L + OFF_LORA);
#pragma unroll
      for (int ct = 0; ct < 4; ++ct) {
          f32x4 z4 = {0.f, 0.f, 0.f, 0.f};
          accw[ct] = mma(F[(0 * 8 + ct * 2 + 0) * 64 + lane], tb0, z4); accw[ct] = mma(F[(0 * 8 + ct * 2 + 1) * 64 + lane], tb1, accw[ct]);
          acca[ct] = mma(F[(1 * 8 + ct * 2 + 0) * 64 + lane], xb0, z4); acca[ct] = mma(F[(1 * 8 + ct * 2 + 1) * 64 + lane], xb1, acca[ct]);
      } }
    float ev[4][4], kk[4][4], kd[4][4], bb[4][4];
    float ss = 0.f, bon = 0.f;
#pragma unroll
    for (int ct = 0; ct < 4; ++ct) {
        const f32x4 w0 = *(const LAS f32x4*)(C + 640 + 16 * ct + 4 * g), a0 = *(const LAS f32x4*)(C + 704 + 16 * ct + 4 * g), kkw = *(const LAS f32x4*)(C + 768 + 16 * ct + 4 * g),
                    kaw = *(const LAS f32x4*)(C + 832 + 16 * ct + 4 * g), rkw = *(const LAS f32x4*)(C + 896 + 16 * ct + 4 * g);
#pragma unroll
        for (int r = 0; r < 4; ++r) {
            ev[ct][r] = 0.60653065971f * fsigmoid(accw[ct][r] + w0[r]);
            const float a = fsigmoid(acca[ct][r] + a0[r]);
            const float k = kv[ct][r];
            kk[ct][r] = k * kkw[r]; ss += kk[ct][r] * kk[ct][r];
            kd[ct][r] = k * (1.0f + (a - 1.0f) * kaw[r]);
            bb[ct][r] = a;
            bon += rv[ct][r] * k * a * kaw[r] * rkw[r];
        }
        __builtin_amdgcn_sched_barrier(0);
    }
    ss += __shfl_xor(ss, 16); ss += __shfl_xor(ss, 32);
    bon += __shfl_xor(bon, 16); bon += __shfl_xor(bon, 32);
    if (g == 0) BON[((size_t)tok * NH + h) * 8 + 4 + dir] = bon;
    const float rn = __builtin_amdgcn_rsqf(fmaxf(ss, 1e-12f));
    bf16x8 fKKm[2], fRm[2], fBm[2], fKm[2];
#pragma unroll
    for (int m = 0; m < 2; ++m) {
        float KKs[2][4], Rs[2][4], Bt[2][4], Kt[2][4];
#pragma unroll
        for (int c2 = 0; c2 < 2; ++c2) {
            const int ct = 2 * m + c2;
            float gcv[4];
#pragma unroll
            for (int r = 0; r < 4; ++r) {
                const float e = ev[ct][r];
                float cum = e;
                cum += row_shr<1>(cum); cum += row_shr<2>(cum); cum += row_shr<4>(cum); cum += row_shr<8>(cum);
                const float cumC = __shfl(cum, (lane & 48) | 15);
                const float kkn = kk[ct][r] * rn, bv = kkn * bb[ct][r];
                const float ig = __expf(cum), gs = __builtin_amdgcn_rcpf(ig), gC = __expf(-cumC), rat = ig * gC;
                KKs[c2][r] = kkn * gs * __expf(e); Rs[c2][r] = rv[ct][r] * gs;
                Bt[c2][r] = bv * ig; Kt[c2][r] = kd[ct][r] * ig;
                gcv[r] = gC;
                LAS unsigned char* q = buf + (S_BK + ct) * SLOT + (4 * g + r + 16 * (s >> 2)) * 16 + 2 * (s & 3);
                *(LAS bf16*)q = tobf(bv * rat); *(LAS bf16*)(q + 8) = tobf(kd[ct][r] * rat);
            }
            if (s == 15) *(LAS f32x4*)(buf + S_GC * SLOT + (16 * ct + 4 * g) * 4) = (f32x4){gcv[0], gcv[1], gcv[2], gcv[3]};
        }
        fKKm[m] = frag8(KKs[0], KKs[1]); fRm[m] = frag8(Rs[0], Rs[1]); fBm[m] = frag8(Bt[0], Bt[1]); fKm[m] = frag8(Kt[0], Kt[1]);
    }
    const bf16x8 fKK0 = fKKm[0], fKK1 = fKKm[1], fR0 = fRm[0], fR1 = fRm[1], fB0 = fBm[0], fB1 = fBm[1], fK0 = fKm[0], fK1 = fKm[1];
    *(LAS bf16x8*)(buf + (S_KK + 0) * SLOT + lane * 16) = fKK0; *(LAS bf16x8*)(buf + (S_KK + 1) * SLOT + lane * 16) = fKK1;
    *(LAS bf16x8*)(buf + (S_R + 0) * SLOT + lane * 16) = fR0;  *(LAS bf16x8*)(buf + (S_R + 1) * SLOT + lane * 16) = fR1;
    const f32x4 z4 = {0.f, 0.f, 0.f, 0.f};
    { f32x4 mab = mma(fKK0, fB0, z4); mab = mma(fKK1, fB1, mab);
      *(LAS f32x4*)(MT + s * 16 + 4 * g) = mab; }
    f32x4 mak = mma(fK0, fKK0, z4); mak = mma(fK1, fKK1, mak);
    f32x4 nrb = mma(fB0, fR0, z4); nrb = mma(fB1, fR1, nrb);
    f32x4 nrk = mma(fK0, fR0, z4); nrk = mma(fK1, fR1, nrk);
#pragma unroll
    for (int r = 0; r < 4; ++r) { const int i = 4 * g + r; if (!(i < s)) mak[r] = 0.f; if (!(i <= s)) { nrb[r] = 0.f; nrk[r] = 0.f; } }
    *(LAS v4u*)(buf + S_N * SLOT + lane * 16) = (v4u){cvtpk(nrb[0], nrb[1]), cvtpk(nrb[2], nrb[3]), cvtpk(nrk[0], nrk[1]), cvtpk(nrk[2], nrk[3])};
    asm volatile("s_waitcnt lgkmcnt(0)" ::: "memory"); __builtin_amdgcn_wave_barrier();
    float Tr[16];
#pragma unroll
    for (int j = 15; j >= 0; --j) {
        float acc0 = 0.f, acc1 = 0.f;
#pragma unroll
        for (int i4 = (j + 1) / 4; i4 < 4; ++i4) {
            const f32x4 mrow = *(const LAS f32x4*)(MT + j * 16 + 4 * i4);
#pragma unroll
            for (int e = 0; e < 4; ++e) { const int i = 4 * i4 + e; if (i > j) { if (e & 1) acc1 += Tr[i] * mrow[e]; else acc0 += Tr[i] * mrow[e]; } }
        }
        Tr[j] = (j == s) ? 1.0f : -(acc0 + acc1);
        if (j > s) Tr[j] = 0.f;
    }
    float t0 = 0.f, t1 = 0.f, t2 = 0.f, t3 = 0.f;
#pragma unroll
    for (int gg = 0; gg < 4; ++gg) if (g == gg) { t0 = Tr[4 * gg]; t1 = Tr[4 * gg + 1]; t2 = Tr[4 * gg + 2]; t3 = Tr[4 * gg + 3]; }
    *(LAS v4u*)(buf + S_MT * SLOT + lane * 16) = (v4u){cvtpk(mak[0], mak[1]), cvtpk(mak[2], mak[3]), cvtpk(-t0, -t1), cvtpk(-t2, -t3)};
    asm volatile("s_waitcnt lgkmcnt(0)" ::: "memory"); __builtin_amdgcn_wave_barrier();
}

__device__ __forceinline__ void rec_chunk(const LAS unsigned char* buf, f32x4 (&st)[4], bf16* Y, int b, int h, int dir, int n, int w, int lane) {
    const int g = lane >> 4, col = lane & 15;
    const bf16x8 fKK0 = *(const LAS bf16x8*)(buf + (S_KK + 0) * SLOT + lane * 16), fKK1 = *(const LAS bf16x8*)(buf + (S_KK + 1) * SLOT + lane * 16);
    const bf16x8 fR0 = *(const LAS bf16x8*)(buf + (S_R + 0) * SLOT + lane * 16), fR1 = *(const LAS bf16x8*)(buf + (S_R + 1) * SLOT + lane * 16);
    const v4u mt = *(const LAS v4u*)(buf + S_MT * SLOT + lane * 16);
    const bf16x8 fN = *(const LAS bf16x8*)(buf + S_N * SLOT + lane * 16);
    const u32x2 vf = *(const LAS u32x2*)(buf + (S_V + (w >> 1)) * SLOT + lane * 16 + (w & 1) * 8);
    const f32x4 z4 = {0.f, 0.f, 0.f, 0.f};
    const bf16x8 sb0 = mkfrag(cvtpk(st[0][0], st[0][1]), cvtpk(st[0][2], st[0][3]), cvtpk(st[1][0], st[1][1]), cvtpk(st[1][2], st[1][3]));
    const bf16x8 sb1 = mkfrag(cvtpk(st[2][0], st[2][1]), cvtpk(st[2][2], st[2][3]), cvtpk(st[3][0], st[3][1]), cvtpk(st[3][2], st[3][3]));
    f32x4 p1 = mma(fKK0, sb0, z4); p1 = mma(fKK1, sb1, p1);
    f32x4 p2 = mma(fR0, sb0, z4); p2 = mma(fR1, sb1, p2);
    const f32x4 x = mma(mkfrag(0u, 0u, mt.x, mt.y), mkfrag(0u, 0u, vf.x, vf.y), p1);
    const f32x4 u = mma(mkfrag(mt.z, mt.w, 0u, 0u), mkfrag(cvtpk(x[0], x[1]), cvtpk(x[2], x[3]), 0u, 0u), z4);
    const bf16x8 buv = mkfrag(cvtpk(u[0], u[1]), cvtpk(u[2], u[3]), vf.x, vf.y);
    const f32x4 y = mma(fN, buv, p2);
#pragma unroll
    for (int i = 0; i < 4; ++i) {
        const f32x4 gc = *(const LAS f32x4*)(buf + S_GC * SLOT + (16 * i + 4 * g) * 4);
        const bf16x8 fBK = *(const LAS bf16x8*)(buf + (S_BK + i) * SLOT + lane * 16);
        st[i] = mma(fBK, buv, st[i] * gc);
    }
    const int cn = dir ? (SEQ / 16 - 1 - n) : n;
    float t0 = y[0], t1 = y[1], t2 = y[2], t3 = y[3];
    { const bool b0 = (col & 1) != 0, b1 = (col & 2) != 0;
      { const float s0 = b0 ? t0 : t1, s2 = b0 ? t2 : t3;
        const float r0 = __int_as_float(__builtin_amdgcn_update_dpp(0, __float_as_int(s0), 0xB1, 0xf, 0xf, true)), r2 = __int_as_float(__builtin_amdgcn_update_dpp(0, __float_as_int(s2), 0xB1, 0xf, 0xf, true));
        if (b0) { t0 = r0; t2 = r2; } else { t1 = r0; t3 = r2; } }
      { const float s0 = b1 ? t0 : t2, s1 = b1 ? t1 : t3;
        const float r0 = __int_as_float(__builtin_amdgcn_update_dpp(0, __float_as_int(s0), 0x4E, 0xf, 0xf, true)), r1 = __int_as_float(__builtin_amdgcn_update_dpp(0, __float_as_int(s1), 0x4E, 0xf, 0xf, true));
        if (b1) { t0 = r0; t1 = r1; } else { t2 = r0; t3 = r1; } } }
    { const int s = 4 * g + (col & 3), t = cn * 16 + (dir ? 15 - s : s);
      u32x2 wv; wv.x = cvtpk(t0, t1); wv.y = cvtpk(t2, t3);
      *(u32x2*)(Y + ((size_t)dir * T + (size_t)(b * SEQ + t)) * RW + h * 64 + 16 * w + (col & 12)) = wv; }
}

__device__ __forceinline__ void chain(LAS unsigned char* L, const bf16* Z, const float* mu_prev, const float* mu_next, const float* w_decay0, const float* w_decay_up,
                                      const float* a_gate0, const float* a_gate_up, const float* k_k, const float* k_a, const float* r_k, bf16* Y, float* BON, int ch, int tid, int wave, int lane) {
    const int dir = ch & 1, h = (ch >> 1) & 7, b = ch >> 4;
    __syncthreads();
    setup(L, h, dir, mu_prev, mu_next, w_decay0, w_decay_up, a_gate0, a_gate_up, k_k, k_a, r_k, tid);
    __syncthreads();
    f32x4 st[4];
#pragma unroll
    for (int i = 0; i < 4; ++i) st[i] = (f32x4){0.f, 0.f, 0.f, 0.f};
    constexpr int NCH = SEQ / 16, NR = NCH / 8;
    for (int q = 0; q < NR; ++q) {
        helper_chunk(L, L + wave * BUF_BYTES, (LAS float*)(L + OFF_MT + wave * 1024), Z, BON, b, h, dir, 8 * q + wave, lane);
        __syncthreads();
        if (wave < 4) {
#pragma unroll 4
            for (int i = 0; i < 8; ++i) rec_chunk(L + i * BUF_BYTES, st, Y, b, h, dir, 8 * q + i, wave, lane);
        }
        __syncthreads();
    }
}
}

namespace attn {
typedef unsigned u32x2 __attribute__((ext_vector_type(2)));
constexpr int VT_STRIDE = 136;
constexpr int KF_OFF = 64 * VT_STRIDE;
constexpr int WAVE_LDS = KF_OFF + 8 * 1024;
constexpr float LOG2E = 1.44269504088896f, LN2 = 0.693147180559945f;
using scan::cvtpk; using scan::mkfrag; using scan::mma;

__device__ __forceinline__ void unpack8(const v4u w, float (&f)[8]) {
    f[0] = __uint_as_float(w.x << 16); f[1] = __uint_as_float(w.x & 0xffff0000u); f[2] = __uint_as_float(w.y << 16); f[3] = __uint_as_float(w.y & 0xffff0000u);
    f[4] = __uint_as_float(w.z << 16); f[5] = __uint_as_float(w.z & 0xffff0000u); f[6] = __uint_as_float(w.w << 16); f[7] = __uint_as_float(w.w & 0xffff0000u);
}

__device__ __forceinline__ void unit(LAS unsigned char* vt, const bf16* Z, const float* qg, const float* kg, bf16* Ob, int opitch, float* lse_out,
                                     int b, int h, int d, int r, int qb, int nb, int lane) {
    const int g = lane >> 4, c16 = lane & 15;
    const float slope2 = exp2f(-(float)(h + 1)) * LOG2E * (float)d;
    float gn[16];
#pragma unroll
    for (int m = 0; m < 2; ++m)
#pragma unroll
        for (int j = 0; j < 8; ++j) gn[m * 8 + j] = qg[32 * m + 8 * g + j] * kg[32 * m + 8 * g + j];
    bf16x8 qf[4][2];
#pragma unroll
    for (int qt = 0; qt < 4; ++qt) {
        const int tok = b * SEQ + (qb * 64 + 16 * qt + c16) * d + r;
        const bf16* qp = Z + (size_t)tok * INW + h * 64 + 8 * g;
        float f0[8], f1[8]; unpack8(*(const v4u*)qp, f0); unpack8(*(const v4u*)(qp + 32), f1);
        float ss = 0.f;
#pragma unroll
        for (int j = 0; j < 8; ++j) ss += f0[j] * f0[j] + f1[j] * f1[j];
        ss += __shfl_xor(ss, 16); ss += __shfl_xor(ss, 32);
        const float rs = (0.125f * LOG2E) / sqrtf(ss * (1.f / 64.f) + 1e-6f);
        qf[qt][0] = mkfrag(cvtpk(f0[0] * rs * gn[0], f0[1] * rs * gn[1]), cvtpk(f0[2] * rs * gn[2], f0[3] * rs * gn[3]), cvtpk(f0[4] * rs * gn[4], f0[5] * rs * gn[5]), cvtpk(f0[6] * rs * gn[6], f0[7] * rs * gn[7]));
        qf[qt][1] = mkfrag(cvtpk(f1[0] * rs * gn[8], f1[1] * rs * gn[9]), cvtpk(f1[2] * rs * gn[10], f1[3] * rs * gn[11]), cvtpk(f1[4] * rs * gn[12], f1[5] * rs * gn[13]), cvtpk(f1[6] * rs * gn[14], f1[7] * rs * gn[15]));
    }
    f32x4 oacc[4][4];
    float mrun[4], lrun[4];
#pragma unroll
    for (int qt = 0; qt < 4; ++qt) { mrun[qt] = -1e30f; lrun[qt] = 0.f;
#pragma unroll
        for (int dt = 0; dt < 4; ++dt) oacc[dt][qt] = (f32x4){0.f, 0.f, 0.f, 0.f}; }
    const f32x4 z4 = {0.f, 0.f, 0.f, 0.f};
#pragma unroll 1
    for (int kb = qb - 1; kb <= qb + 1; ++kb) {
        if (kb < 0 || kb >= nb) continue;
#pragma unroll
        for (int kblk = 0; kblk < 4; ++kblk) {
            const int tok = b * SEQ + (kb * 64 + 16 * kblk + c16) * d + r;
            const bf16* kp = Z + (size_t)tok * INW + AW + h * 64 + 8 * g;
            float f0[8], f1[8]; unpack8(*(const v4u*)kp, f0); unpack8(*(const v4u*)(kp + 32), f1);
            float ss = 0.f;
#pragma unroll
            for (int j = 0; j < 8; ++j) ss += f0[j] * f0[j] + f1[j] * f1[j];
            ss += __shfl_xor(ss, 16); ss += __shfl_xor(ss, 32);
            const float rsk = 1.0f / sqrtf(ss * (1.f / 64.f) + 1e-6f);
            *(LAS v4u*)(vt + KF_OFF + (kblk * 2 + 0) * 1024 + lane * 16) = (v4u){cvtpk(f0[0] * rsk, f0[1] * rsk), cvtpk(f0[2] * rsk, f0[3] * rsk), cvtpk(f0[4] * rsk, f0[5] * rsk), cvtpk(f0[6] * rsk, f0[7] * rsk)};
            *(LAS v4u*)(vt + KF_OFF + (kblk * 2 + 1) * 1024 + lane * 16) = (v4u){cvtpk(f1[0] * rsk, f1[1] * rsk), cvtpk(f1[2] * rsk, f1[3] * rsk), cvtpk(f1[4] * rsk, f1[5] * rsk), cvtpk(f1[6] * rsk, f1[7] * rsk)};
        }
#pragma unroll
        for (int i = 0; i < 8; ++i) {
            const int key = 8 * i + (lane >> 3), chunk = lane & 7;
            const int tok = b * SEQ + (kb * 64 + key) * d + r;
            const v4u w = *(const v4u*)(Z + (size_t)tok * INW + 2 * AW + h * 64 + 8 * chunk);
            LAS unsigned char* q = vt + (8 * chunk) * VT_STRIDE + 2 * key;
            *(LAS bf16*)(q + 0 * VT_STRIDE) = (bf16)(w.x & 0xffffu); *(LAS bf16*)(q + 1 * VT_STRIDE) = (bf16)(w.x >> 16);
            *(LAS bf16*)(q + 2 * VT_STRIDE) = (bf16)(w.y & 0xffffu); *(LAS bf16*)(q + 3 * VT_STRIDE) = (bf16)(w.y >> 16);
            *(LAS bf16*)(q + 4 * VT_STRIDE) = (bf16)(w.z & 0xffffu); *(LAS bf16*)(q + 5 * VT_STRIDE) = (bf16)(w.z >> 16);
            *(LAS bf16*)(q + 6 * VT_STRIDE) = (bf16)(w.w & 0xffffu); *(LAS bf16*)(q + 7 * VT_STRIDE) = (bf16)(w.w >> 16);
        }
        asm volatile("s_waitcnt lgkmcnt(0)" ::: "memory"); __builtin_amdgcn_wave_barrier();
        f32x4 bias[7];
        {
            const int obase = (kb - qb) * 64 + 4 * g - c16;
#pragma unroll
            for (int dk = 0; dk < 7; ++dk)
#pragma unroll
                for (int reg = 0; reg < 4; ++reg) { const int o = obase + 16 * (dk - 3) + reg, ao = o < 0 ? -o : o; bias[dk][reg] = (ao <= 64) ? -slope2 * (float)ao : -1e30f; }
        }
#pragma unroll
        for (int qt = 0; qt < 4; ++qt) {
            f32x4 sa[4];
#pragma unroll
            for (int kblk = 0; kblk < 4; ++kblk) {
                const bf16x8 k0 = *(const LAS bf16x8*)(vt + KF_OFF + (kblk * 2 + 0) * 1024 + lane * 16), k1 = *(const LAS bf16x8*)(vt + KF_OFF + (kblk * 2 + 1) * 1024 + lane * 16);
                sa[kblk] = mma(k0, qf[qt][0], bias[kblk - qt + 3]); sa[kblk] = mma(k1, qf[qt][1], sa[kblk]); }
            float mx = -1e30f;
#pragma unroll
            for (int kblk = 0; kblk < 4; ++kblk)
#pragma unroll
                for (int reg = 0; reg < 4; ++reg) mx = fmaxf(mx, sa[kblk][reg]);
            mx = fmaxf(mx, __shfl_xor(mx, 16)); mx = fmaxf(mx, __shfl_xor(mx, 32));
            const float mn = fmaxf(mrun[qt], mx), alpha = exp2f(mrun[qt] - mn);
            mrun[qt] = mn;
            float ls = 0.f;
#pragma unroll
            for (int kblk = 0; kblk < 4; ++kblk)
#pragma unroll
                for (int reg = 0; reg < 4; ++reg) { const float p = exp2f(sa[kblk][reg] - mn); sa[kblk][reg] = p; ls += p; }
            lrun[qt] = lrun[qt] * alpha + ls;
            const bf16x8 pf0 = mkfrag(cvtpk(sa[0][0], sa[0][1]), cvtpk(sa[0][2], sa[0][3]), cvtpk(sa[1][0], sa[1][1]), cvtpk(sa[1][2], sa[1][3]));
            const bf16x8 pf1 = mkfrag(cvtpk(sa[2][0], sa[2][1]), cvtpk(sa[2][2], sa[2][3]), cvtpk(sa[3][0], sa[3][1]), cvtpk(sa[3][2], sa[3][3]));
#pragma unroll
            for (int dt = 0; dt < 4; ++dt) {
                const LAS unsigned char* vr = vt + (16 * dt + c16) * VT_STRIDE + 8 * g;
                const u32x2 a0 = *(const LAS u32x2*)(vr), a1 = *(const LAS u32x2*)(vr + 32), a2 = *(const LAS u32x2*)(vr + 64), a3 = *(const LAS u32x2*)(vr + 96);
                f32x4 oc = oacc[dt][qt] * alpha;
                oc = mma(mkfrag(a0.x, a0.y, a1.x, a1.y), pf0, oc);
                oc = mma(mkfrag(a2.x, a2.y, a3.x, a3.y), pf1, oc);
                oacc[dt][qt] = oc;
            }
            __builtin_amdgcn_sched_barrier(0);
        }
        asm volatile("s_waitcnt lgkmcnt(0)" ::: "memory"); __builtin_amdgcn_wave_barrier();
    }
#pragma unroll
    for (int qt = 0; qt < 4; ++qt) {
        float lt = lrun[qt]; lt += __shfl_xor(lt, 16); lt += __shfl_xor(lt, 32);
        const float inv = 1.0f / lt;
        const int tok = b * SEQ + (qb * 64 + 16 * qt + c16) * d + r;
        bf16* op = Ob + (size_t)tok * opitch + h * 64 + 4 * g;
#pragma unroll
        for (int dt = 0; dt < 4; ++dt) { const f32x4 o = oacc[dt][qt] * inv; u32x2 w; w.x = cvtpk(o[0], o[1]); w.y = cvtpk(o[2], o[3]); *(u32x2*)(op + 16 * dt) = w; }
        if (g == 0) lse_out[((size_t)tok * NH + h) * 8] = (mrun[qt] + log2f(lt)) * LN2;
    }
}
}

namespace peer {
using scan::cvtpk; using scan::mkfrag; using scan::mma;
constexpr int KEY_SLOTS = 64;

template <int CTRL> __device__ __forceinline__ unsigned dppu(unsigned x) { return (unsigned)__builtin_amdgcn_update_dpp(0, (int)x, CTRL, 0xf, 0xf, true); }
__device__ __forceinline__ unsigned umax(unsigned a, unsigned b) { return a > b ? a : b; }
__device__ __forceinline__ unsigned rowmax16(unsigned x) { x = umax(x, dppu<0xB1>(x)); x = umax(x, dppu<0x4E>(x)); x = umax(x, dppu<0x141>(x)); x = umax(x, dppu<0x140>(x)); return x; }
__device__ __forceinline__ float rowsum16(float x) {
    x += __uint_as_float(dppu<0xB1>(__float_as_uint(x))); x += __uint_as_float(dppu<0x4E>(__float_as_uint(x)));
    x += __uint_as_float(dppu<0x141>(__float_as_uint(x))); x += __uint_as_float(dppu<0x140>(__float_as_uint(x))); return x;
}
__device__ __forceinline__ unsigned ordkey(float f) { const unsigned u = __float_as_uint(f); return (u & 0x80000000u) ? ~u : (u | 0x80000000u); }
__device__ __forceinline__ float unordkey(unsigned k) { return __uint_as_float((k & 0x80000000u) ? (k ^ 0x80000000u) : ~k); }

__device__ __forceinline__ void setup_keys(LAS unsigned char* L, const float* keys1, const float* keys2, int tid) {
    LAS bf16* F = (LAS bf16*)L;
    for (int i = tid; i < KEY_SLOTS * 64 * 8; i += 512) {
        const int j = i & 7, l = (i >> 3) & 63, sl = i >> 9, ks = sl & 3, nt = (sl >> 2) & 7, sel = sl >> 5;
        const int n = 16 * nt + (l & 15), k = 32 * ks + 8 * (l >> 4) + j;
        F[i] = (bf16)f2bf((sel ? keys2 : keys1)[n * 128 + k]);
    }
}

#define CE_(a, b) do { const unsigned hi_ = umax(a, b), lo_ = (a < b) ? a : b; a = hi_; b = lo_; } while (0)
__device__ __forceinline__ void top16(unsigned (&key)[8][4], unsigned (&win)[4], int c16) {
#pragma unroll
    for (int reg = 0; reg < 4; ++reg) {
        CE_(key[0][reg], key[1][reg]); CE_(key[2][reg], key[3][reg]); CE_(key[4][reg], key[5][reg]); CE_(key[6][reg], key[7][reg]);
        CE_(key[0][reg], key[2][reg]); CE_(key[1][reg], key[3][reg]); CE_(key[4][reg], key[6][reg]); CE_(key[5][reg], key[7][reg]);
        CE_(key[1][reg], key[2][reg]); CE_(key[5][reg], key[6][reg]);
        CE_(key[0][reg], key[4][reg]); CE_(key[1][reg], key[5][reg]); CE_(key[2][reg], key[6][reg]); CE_(key[3][reg], key[7][reg]);
        CE_(key[2][reg], key[4][reg]); CE_(key[3][reg], key[5][reg]);
        CE_(key[1][reg], key[2][reg]); CE_(key[3][reg], key[4][reg]); CE_(key[5][reg], key[6][reg]);
    }
#pragma unroll 1
    for (int k = 0; k < TOPK; ++k) {
#pragma unroll
        for (int reg = 0; reg < 4; ++reg) {
            const unsigned m = rowmax16(key[0][reg]);
            win[reg] = (c16 == k) ? m : win[reg];
            const bool pop = key[0][reg] == m;
#pragma unroll
            for (int nt = 0; nt < 7; ++nt) key[nt][reg] = pop ? key[nt + 1][reg] : key[nt][reg];
            key[7][reg] = pop ? 0u : key[7][reg];
        }
    }
}
#undef CE_

__device__ __forceinline__ void select_batch(const LAS unsigned char* L, const bf16* Q, unsigned short* IDX, float* GATE, int batch, int lane) {
    const int g = lane >> 4, c16 = lane & 15;
    const LAS bf16x8* F = (const LAS bf16x8*)L;
    const bf16* qp = Q + (size_t)(batch * 16 + c16) * PKD + 8 * g;
    unsigned w1[4] = {0u, 0u, 0u, 0u}, w2[4] = {0u, 0u, 0u, 0u};
#pragma unroll
    for (int sel = 0; sel < 2; ++sel) {
        unsigned key[8][4];
        bf16x8 a[4];
#pragma unroll
        for (int ks = 0; ks < 4; ++ks) a[ks] = *(const bf16x8*)(qp + sel * 128 + 32 * ks);
#pragma unroll
        for (int nt = 0; nt < 8; ++nt) {
            f32x4 sc = {0.f, 0.f, 0.f, 0.f};
#pragma unroll
            for (int ks = 0; ks < 4; ++ks) sc = mma(a[ks], F[((sel * 8 + nt) * 4 + ks) * 64 + lane], sc);
#pragma unroll
            for (int reg = 0; reg < 4; ++reg) key[nt][reg] = (ordkey(sc[reg]) & ~127u) | (unsigned)(16 * nt + c16);
            __builtin_amdgcn_sched_barrier(0);
        }
        if (sel == 0) top16(key, w1, c16); else top16(key, w2, c16);
    }
    float f1[4], f2[4], cur2[4]; int ptr[4]; unsigned top[4];
#pragma unroll
    for (int reg = 0; reg < 4; ++reg) { f1[reg] = unordkey(w1[reg] & ~127u); f2[reg] = unordkey(w2[reg] & ~127u); ptr[reg] = 0; cur2[reg] = __shfl(f2[reg], lane & 48); top[reg] = 0u; }
#pragma unroll 1
    for (int k = 0; k < TOPK; ++k) {
#pragma unroll
        for (int reg = 0; reg < 4; ++reg) {
            const unsigned ck = (ptr[reg] < 16) ? ((ordkey(f1[reg] + cur2[reg]) & ~255u) | (unsigned)(c16 << 4) | (unsigned)ptr[reg]) : 0u;
            const unsigned m = rowmax16(ck);
            top[reg] = (c16 == k) ? m : top[reg];
            if ((int)((m >> 4) & 15u) == c16) ptr[reg] += 1;
            cur2[reg] = __shfl(f2[reg], (lane & 48) | (ptr[reg] & 15));
        }
    }
#pragma unroll
    for (int reg = 0; reg < 4; ++reg) {
        const int a = (top[reg] >> 4) & 15, bq = top[reg] & 15;
        const int e1 = (int)(__shfl(w1[reg], (lane & 48) | a) & 127u), e2 = (int)(__shfl(w2[reg], (lane & 48) | bq) & 127u);
        const float ts = unordkey(top[reg] & ~255u), mx = __shfl(ts, lane & 48);
        const float ex = __expf(ts - mx), sum = rowsum16(ex);
        const size_t o = (size_t)(batch * 16 + 4 * g + reg) * TOPK + c16;
        IDX[o] = (unsigned short)(e1 * NKEYS + e2); GATE[o] = ex / sum;
    }
}

__device__ __forceinline__ void convert_table(const float* src, bf16* dst, size_t n8, size_t gtid, size_t gthreads) {
    for (size_t i = gtid; i < n8; i += gthreads) {
        const f32x4 a = *(const f32x4*)(src + i * 8), b = *(const f32x4*)(src + i * 8 + 4);
        v4u o; o.x = cvtpk(a.x, a.y); o.y = cvtpk(a.z, a.w); o.z = cvtpk(b.x, b.y); o.w = cvtpk(b.z, b.w);
        *(v4u*)(dst + i * 8) = o;
    }
}

__device__ __forceinline__ float dot2bf(unsigned w, unsigned x, float acc) {
    typedef __bf16 bf2 __attribute__((ext_vector_type(2)));
    return __builtin_amdgcn_fdot2_f32_bf16(__builtin_bit_cast(bf2, w), __builtin_bit_cast(bf2, x), acc, false);
}
__device__ __forceinline__ float gelu_erf(float v) {
    const float av = fabsf(v), t = __builtin_amdgcn_rcpf(av * 0.2316418882f + 1.0f);
    float q = t * 0.5307027145f + (-0.7265760135f); q = q * t + 0.7107068705f; q = q * t + (-0.142248368f); q = q * t + 0.127414796f; q = q * t;
    const float e = __builtin_amdgcn_exp2f((v * v) * (-0.72134752044f));
    const float m = v * (q * e);
    return v < 0.f ? m : v - m;
}

typedef float f32x2c __attribute__((ext_vector_type(2)));
__device__ __forceinline__ void convert_rows_fp8(const float* src, unsigned char* dst, float* scale, int rows, int gw, int ngw, int lane) {
    for (int rrow = gw; rrow < rows; rrow += ngw) {
        const float* p = src + (size_t)rrow * D + 16 * lane;
        const f32x4 a = *(const f32x4*)p, b = *(const f32x4*)(p + 4), c = *(const f32x4*)(p + 8), d = *(const f32x4*)(p + 12);
        float m = fmaxf(fmaxf(fmaxf(fabsf(a.x), fabsf(a.y)), fmaxf(fabsf(a.z), fabsf(a.w))), fmaxf(fmaxf(fabsf(b.x), fabsf(b.y)), fmaxf(fabsf(b.z), fabsf(b.w))));
        m = fmaxf(m, fmaxf(fmaxf(fmaxf(fabsf(c.x), fabsf(c.y)), fmaxf(fabsf(c.z), fabsf(c.w))), fmaxf(fmaxf(fabsf(d.x), fabsf(d.y)), fmaxf(fabsf(d.z), fabsf(d.w)))));
#pragma unroll
        for (int o = 1; o < 64; o <<= 1) m = fmaxf(m, __shfl_xor(m, o));
        m = fmaxf(m, 1e-30f);
        const float inv = 448.0f / m;
        v4u w;
        w.x = (unsigned)__builtin_amdgcn_cvt_pk_fp8_f32(a.z * inv, a.w * inv, __builtin_amdgcn_cvt_pk_fp8_f32(a.x * inv, a.y * inv, 0, false), true);
        w.y = (unsigned)__builtin_amdgcn_cvt_pk_fp8_f32(b.z * inv, b.w * inv, __builtin_amdgcn_cvt_pk_fp8_f32(b.x * inv, b.y * inv, 0, false), true);
        w.z = (unsigned)__builtin_amdgcn_cvt_pk_fp8_f32(c.z * inv, c.w * inv, __builtin_amdgcn_cvt_pk_fp8_f32(c.x * inv, c.y * inv, 0, false), true);
        w.w = (unsigned)__builtin_amdgcn_cvt_pk_fp8_f32(d.z * inv, d.w * inv, __builtin_amdgcn_cvt_pk_fp8_f32(d.x * inv, d.y * inv, 0, false), true);
        *(v4u*)(dst + (size_t)rrow * D + 16 * lane) = w;
        if (lane == 0) scale[2 * rrow] = m * (1.0f / 448.0f);
    }
}
__device__ __forceinline__ unsigned pack_i8x4(float a, float b, float c, float d) {
    const int ia = (int)rintf(a), ib = (int)rintf(b), ic = (int)rintf(c), id = (int)rintf(d);
    return (unsigned)(ia & 0xff) | ((unsigned)(ib & 0xff) << 8) | ((unsigned)(ic & 0xff) << 16) | ((unsigned)id << 24);
}
__device__ __forceinline__ void convert_rows_i8(const float* src, unsigned char* dst, float* scale, int rows, int gw, int ngw, int lane) {
    for (int rrow = gw; rrow < rows; rrow += ngw) {
        const float* p = src + (size_t)rrow * D + 16 * lane;
        const f32x4 a = *(const f32x4*)p, b = *(const f32x4*)(p + 4), c = *(const f32x4*)(p + 8), d = *(const f32x4*)(p + 12);
        float m = fmaxf(fmaxf(fmaxf(fabsf(a.x), fabsf(a.y)), fmaxf(fabsf(a.z), fabsf(a.w))), fmaxf(fmaxf(fabsf(b.x), fabsf(b.y)), fmaxf(fabsf(b.z), fabsf(b.w))));
        m = fmaxf(m, fmaxf(fmaxf(fmaxf(fabsf(c.x), fabsf(c.y)), fmaxf(fabsf(c.z), fabsf(c.w))), fmaxf(fmaxf(fabsf(d.x), fabsf(d.y)), fmaxf(fabsf(d.z), fabsf(d.w)))));
#pragma unroll
        for (int o = 1; o < 64; o <<= 1) m = fmaxf(m, __shfl_xor(m, o));
        m = fmaxf(m, 1e-30f);
        const float inv = 127.0f / m;
        v4u w;
        w.x = pack_i8x4(a.x * inv, a.y * inv, a.z * inv, a.w * inv); w.y = pack_i8x4(b.x * inv, b.y * inv, b.z * inv, b.w * inv);
        w.z = pack_i8x4(c.x * inv, c.y * inv, c.z * inv, c.w * inv); w.w = pack_i8x4(d.x * inv, d.y * inv, d.z * inv, d.w * inv);
        *(v4u*)(dst + (size_t)rrow * D + 16 * lane) = w;
        if (lane == 0) scale[2 * rrow] = m * (1.0f / 127.0f);
    }
}
__device__ __forceinline__ int isum8(int x) {
    x += (int)dppu<0xB1>((unsigned)x); x += (int)dppu<0x4E>((unsigned)x); x += (int)dppu<0x141>((unsigned)x); return x;
}
__device__ __forceinline__ float sum8(float x) {
    x += __uint_as_float(dppu<0xB1>(__float_as_uint(x))); x += __uint_as_float(dppu<0x4E>(__float_as_uint(x))); x += __uint_as_float(dppu<0x141>(__float_as_uint(x))); return x;
}
__device__ __forceinline__ float dot16_fp8(const v4u q, const f32x2c (&x)[8]) {
    f32x2c d = __builtin_amdgcn_cvt_pk_f32_fp8((int)q.x, false) * x[0];
    d = __builtin_elementwise_fma(__builtin_amdgcn_cvt_pk_f32_fp8((int)q.x, true), x[1], d);
    d = __builtin_elementwise_fma(__builtin_amdgcn_cvt_pk_f32_fp8((int)q.y, false), x[2], d);
    d = __builtin_elementwise_fma(__builtin_amdgcn_cvt_pk_f32_fp8((int)q.y, true), x[3], d);
    d = __builtin_elementwise_fma(__builtin_amdgcn_cvt_pk_f32_fp8((int)q.z, false), x[4], d);
    d = __builtin_elementwise_fma(__builtin_amdgcn_cvt_pk_f32_fp8((int)q.z, true), x[5], d);
    d = __builtin_elementwise_fma(__builtin_amdgcn_cvt_pk_f32_fp8((int)q.w, false), x[6], d);
    d = __builtin_elementwise_fma(__builtin_amdgcn_cvt_pk_f32_fp8((int)q.w, true), x[7], d);
    return d.x + d.y;
}
__device__ __forceinline__ void axpy16_fp8(const v4u q, float cf, f32x2c (&y)[8]) {
    const f32x2c c2 = {cf, cf};
    y[0] = __builtin_elementwise_fma(__builtin_amdgcn_cvt_pk_f32_fp8((int)q.x, false), c2, y[0]); y[1] = __builtin_elementwise_fma(__builtin_amdgcn_cvt_pk_f32_fp8((int)q.x, true), c2, y[1]);
    y[2] = __builtin_elementwise_fma(__builtin_amdgcn_cvt_pk_f32_fp8((int)q.y, false), c2, y[2]); y[3] = __builtin_elementwise_fma(__builtin_amdgcn_cvt_pk_f32_fp8((int)q.y, true), c2, y[3]);
    y[4] = __builtin_elementwise_fma(__builtin_amdgcn_cvt_pk_f32_fp8((int)q.z, false), c2, y[4]); y[5] = __builtin_elementwise_fma(__builtin_amdgcn_cvt_pk_f32_fp8((int)q.z, true), c2, y[5]);
    y[6] = __builtin_elementwise_fma(__builtin_amdgcn_cvt_pk_f32_fp8((int)q.w, false), c2, y[6]); y[7] = __builtin_elementwise_fma(__builtin_amdgcn_cvt_pk_f32_fp8((int)q.w, true), c2, y[7]);
}

#define FFN_ISSUE_U(q, idw, HI) do { _Pragma("unroll") for (int i = 0; i < 8; ++i) { const unsigned w_ = (unsigned)__shfl((int)(idw), 8 * i + eg); const unsigned ex_ = (HI) ? (w_ >> 16) : (w_ & 0xffffu); \
            q[i] = *(const v4u*)(UT8 + ((ex_ << 10) + (unsigned)(128 * sl + 16 * ch))); } } while (0)
#define FFN_DOT_U(QQ, XX, r) do { const v4u xx_ = XX; _Pragma("unroll") for (int i = 0; i < 8; ++i) { const v4u qq_ = QQ[i]; \
            int d_ = __builtin_amdgcn_sdot4((int)qq_[0], (int)xx_[0], 0, false); d_ = __builtin_amdgcn_sdot4((int)qq_[1], (int)xx_[1], d_, false); \
            d_ = __builtin_amdgcn_sdot4((int)qq_[2], (int)xx_[2], d_, false); d_ = __builtin_amdgcn_sdot4((int)qq_[3], (int)xx_[3], d_, false); \
            d_ = isum8(d_); if (ch == i) r = d_; } } while (0)
__device__ __forceinline__ void ffn_u_pass(const unsigned char* XQ, const unsigned* IDW, const unsigned char* UT8, int* PART, int sl, int wv, int nwv, int lane) {
    typedef int i32x2 __attribute__((ext_vector_type(2)));
    const int eg = lane >> 3, ch = lane & 7;
    v4u qA[8], qB[8];
    int t = wv; if (t >= T) return;
    unsigned iw = IDW[(size_t)t * (HK / 2) + lane], nw = 0u;
    v4u x0 = *(const v4u*)(XQ + (size_t)t * D + 128 * sl + 16 * ch), xn0 = x0;
    FFN_ISSUE_U(qA, iw, false);
#pragma unroll 1
    for (;;) {
        const int tn = t + nwv; const bool more = tn < T;
        if (more) { nw = IDW[(size_t)tn * (HK / 2) + lane]; xn0 = *(const v4u*)(XQ + (size_t)tn * D + 128 * sl + 16 * ch); }
        FFN_ISSUE_U(qB, iw, true);
        int r0 = 0, r1 = 0;
        FFN_DOT_U(qA, x0, r0);
        if (more) FFN_ISSUE_U(qA, nw, false);
        FFN_DOT_U(qB, x0, r1);
        *(i32x2*)(PART + ((size_t)sl * T + t) * HK + 16 * ch + 2 * eg) = (i32x2){r0, r1};
        if (!more) break;
        iw = nw; x0 = xn0; t = tn;
    }
}
#define FFN_ISSUE_V(q, cf, pkv) do { _Pragma("unroll") for (int i = 0; i < 8; ++i) { const unsigned w_ = (unsigned)__shfl((int)(pkv), 8 * i + eg); cf[i] = __uint_as_float(w_ << 16); \
            q[i] = *(const v4u*)(VT8 + (((w_ >> 16) << 10) + (unsigned)(128 * sl + 16 * ch))); } } while (0)
typedef unsigned u32x2p __attribute__((ext_vector_type(2)));
__device__ __forceinline__ float swap32_add(float lo, float hi) { const u32x2p r = __builtin_amdgcn_permlane32_swap(__float_as_uint(lo), __float_as_uint(hi), false, false); return __uint_as_float(r.x) + __uint_as_float(r.y); }
__device__ __forceinline__ float swap16_add(float lo, float hi) { const u32x2p r = __builtin_amdgcn_permlane16_swap(__float_as_uint(lo), __float_as_uint(hi), false, false); return __uint_as_float(r.x) + __uint_as_float(r.y); }
__device__ __forceinline__ void ffn_v_pass(const unsigned* PK, const unsigned char* VT8, const float* mod, float* out, int sl, int wv, int nwv, int lane) {
    const int eg = lane >> 3, ch = lane & 7, col2 = 128 * sl + 16 * ch + 2 * eg;
    const bool b3 = (lane & 8) != 0;
    v4u qA[8], qB[8]; float cfA[8], cfB[8];
    int t = wv; if (t >= T) return;
    u32x2p pw = *(const u32x2p*)(PK + (size_t)t * HK + 2 * lane), nw = pw;
    f32x2c ga = {0.f, 0.f}; int gb = -1;
    FFN_ISSUE_V(qA, cfA, pw.x);
#pragma unroll 1
    for (;;) {
        const int tn = t + nwv; const bool more = tn < T;
        if (more) nw = *(const u32x2p*)(PK + (size_t)tn * HK + 2 * lane);
        FFN_ISSUE_V(qB, cfB, pw.y);
        f32x2c y2[8];
#pragma unroll
        for (int k = 0; k < 8; ++k) y2[k] = (f32x2c){0.f, 0.f};
#pragma unroll
        for (int i = 0; i < 8; ++i) { axpy16_fp8(qA[i], cfA[i], y2); if (i & 1) __builtin_amdgcn_sched_barrier(0); }
        if (more) FFN_ISSUE_V(qA, cfA, nw.x);
        const size_t o = (size_t)t * D + col2;
        const f32x2c oa = *(const f32x2c*)(out + o);
        if (t / SEQ != gb) { gb = t / SEQ; ga = *(const f32x2c*)(mod + gb * MODW + 5 * D + col2); }
#pragma unroll
        for (int i = 0; i < 8; ++i) { axpy16_fp8(qB[i], cfB[i], y2); if (i & 1) __builtin_amdgcn_sched_barrier(0); }
        float z[8], w[4];
#pragma unroll
        for (int k = 0; k < 4; ++k) { z[2 * k] = swap32_add(y2[k].x, y2[k + 4].x); z[2 * k + 1] = swap32_add(y2[k].y, y2[k + 4].y); }
#pragma unroll
        for (int k = 0; k < 4; ++k) w[k] = swap16_add(z[k], z[k + 4]);
        const float k0 = b3 ? w[2] : w[0], k1 = b3 ? w[3] : w[1], s0 = b3 ? w[0] : w[2], s1 = b3 ? w[1] : w[3];
        const float f0 = k0 + __uint_as_float(dppu<0x128>(__float_as_uint(s0))), f1 = k1 + __uint_as_float(dppu<0x128>(__float_as_uint(s1)));
        *(f32x2c*)(out + o) = (f32x2c){oa.x + ga.x * f0, oa.y + ga.y * f1};
        if (!more) break;
        pw = nw; t = tn;
    }
}
}

namespace fin {
using scan::cvtpk; using scan::mkfrag; using scan::mma;
typedef unsigned u32x2 __attribute__((ext_vector_type(2)));

__device__ __forceinline__ float shift3(const bf16* p, bool hasp, bool hasn, float mp, float mn) {
    const float z = bf2f(p[0]), zp = hasp ? bf2f(p[-INW]) : 0.f, zn = hasn ? bf2f(p[INW]) : 0.f;
    return z + mp * (zp - z) + mn * (zn - z);
}

__device__ __forceinline__ void unpack4(const u32x2 w, float (&f)[4]) {
    f[0] = __uint_as_float(w.x << 16); f[1] = __uint_as_float(w.x & 0xffff0000u); f[2] = __uint_as_float(w.y << 16); f[3] = __uint_as_float(w.y & 0xffff0000u);
}
__device__ __forceinline__ void phase(LAS unsigned char* L, const bf16* Z, const float* mu_prev, const float* mu_next, const float* g_up, const bf16* Y, const float* BON,
                                      const float* k_a, const float* r_k, const float* lnx_g, const float* lnx_b, bf16* mix, const bf16* O3, const float* LSE,
                                      int bx, int G, int tid, int wave, int lane) {
    const int g = lane >> 4, c16 = lane & 15, ch0 = 64 * wave + 4 * c16;
    LAS bf16* sg = (LAS bf16*)L;
    bf16x8 bf[4][4];
#pragma unroll
    for (int ks = 0; ks < 4; ++ks) {
        f32x4 rowv[8];
#pragma unroll
        for (int jj = 0; jj < 8; ++jj) rowv[jj] = *(const f32x4*)(g_up + (size_t)(32 * ks + 8 * g + jj) * RW + ch0);
#pragma unroll
        for (int nt = 0; nt < 4; ++nt) bf[nt][ks] = mkfrag(cvtpk(rowv[0][nt], rowv[1][nt]), cvtpk(rowv[2][nt], rowv[3][nt]), cvtpk(rowv[4][nt], rowv[5][nt]), cvtpk(rowv[6][nt], rowv[7][nt]));
    }
    const f32x4 mpr = *(const f32x4*)(mu_prev + ch0), mnr = *(const f32x4*)(mu_next + ch0), mpk = *(const f32x4*)(mu_prev + RW + ch0), mnk = *(const f32x4*)(mu_next + RW + ch0),
                mpv = *(const f32x4*)(mu_prev + 2 * RW + ch0), mnv = *(const f32x4*)(mu_next + 2 * RW + ch0);
    const f32x4 ka1 = *(const f32x4*)(k_a + ch0), rk1 = *(const f32x4*)(r_k + ch0), lg = *(const f32x4*)(lnx_g + ch0), lb = *(const f32x4*)(lnx_b + ch0);
    const int j0 = (tid & 31) * 4;
    const f32x4 mpg = *(const f32x4*)(mu_prev + 3 * RW + DL + AL + j0), mng = *(const f32x4*)(mu_next + 3 * RW + DL + AL + j0);
    for (int tb = bx; tb < T / 16; tb += G) {
        const int tok0 = tb * 16;
        __syncthreads();
        {
            const int tl = tid >> 5, tok = tok0 + tl, t = tok % SEQ;
            const bf16* p = Z + (size_t)tok * INW + 3 * AW + 3 * RW + DL + AL + j0;
            const bool hasp = t > 0, hasn = t < SEQ - 1;
            float zc[4], zp[4], zn[4];
            unpack4(*(const u32x2*)p, zc); unpack4(*(const u32x2*)(hasp ? p - INW : p), zp); unpack4(*(const u32x2*)(hasn ? p + INW : p), zn);
            float o[4];
#pragma unroll
            for (int e = 0; e < 4; ++e) { const float pv = hasp ? zp[e] : 0.f, nv = hasn ? zn[e] : 0.f; const float v = zc[e] + mpg[e] * (pv - zc[e]) + mng[e] * (nv - zc[e]); o[e] = __builtin_amdgcn_rcpf(1.0f + __expf(-v)); }
            u32x2 w; w.x = cvtpk(o[0], o[1]); w.y = cvtpk(o[2], o[3]);
            *(LAS u32x2*)(sg + tl * 128 + j0) = w;
        }
        __syncthreads();
        f32x4 ga[4];
        {
            bf16x8 af[4];
#pragma unroll
            for (int ks = 0; ks < 4; ++ks) af[ks] = *(const LAS bf16x8*)(sg + c16 * 128 + 32 * ks + 8 * g);
#pragma unroll
            for (int nt = 0; nt < 4; ++nt) { f32x4 a = {0.f, 0.f, 0.f, 0.f};
#pragma unroll
                for (int ks = 0; ks < 4; ++ks) a = mma(af[ks], bf[nt][ks], a);
                ga[nt] = a; }
        }
        const int tq = tok0 + 4 * g, t0s = tq % SEQ;
        u32x2 zr_[3][6];
#pragma unroll
        for (int grp = 0; grp < 3; ++grp)
#pragma unroll
            for (int rr = 0; rr < 6; ++rr) {
                const int tt = t0s - 1 + rr; const int tc = tt < 0 ? 0 : (tt > SEQ - 1 ? SEQ - 1 : tt);
                u32x2 w = *(const u32x2*)(Z + (size_t)(tq - t0s + tc) * INW + 3 * AW + grp * RW + ch0);
                if (tt < 0 || tt > SEQ - 1) { w.x = 0u; w.y = 0u; }
                zr_[grp][rr] = w;
            }
#pragma unroll
        for (int reg = 0; reg < 4; ++reg) {
            const int tok = tq + reg;
            const size_t o = (size_t)tok * RW + ch0;
            float y0[4], y1[4]; unpack4(*(const u32x2*)(Y + o), y0); unpack4(*(const u32x2*)(Y + (size_t)T * RW + o), y1);
            float rc[4], rp[4], rn[4], kc[4], kp[4], kn[4], vc[4], vp[4], vn[4];
            unpack4(zr_[0][reg + 1], rc); unpack4(zr_[0][reg], rp); unpack4(zr_[0][reg + 2], rn);
            unpack4(zr_[1][reg + 1], kc); unpack4(zr_[1][reg], kp); unpack4(zr_[1][reg + 2], kn);
            unpack4(zr_[2][reg + 1], vc); unpack4(zr_[2][reg], vp); unpack4(zr_[2][reg + 2], vn);
            bf16* mp = mix + (size_t)tok * D + ch0;
            float o1[4], o2[4], o3[4];
            unpack4(*(const u32x2*)mp, o1); unpack4(*(const u32x2*)(mp + AW), o2); unpack4(*(const u32x2*)(O3 + (size_t)tok * AW + ch0), o3);
            const f32x4 st0 = *(const f32x4*)(LSE + ((size_t)tok * NH + wave) * 8), st1 = *(const f32x4*)(LSE + ((size_t)tok * NH + wave) * 8 + 4);
            const float l1 = st0[0], l2 = st0[1], l3 = st0[2], bon = st1[0] + st1[1];
            float yv[4], vv[4], s1 = 0.f, sb = 0.f;
#pragma unroll
            for (int nt = 0; nt < 4; ++nt) {
                yv[nt] = y0[nt] + y1[nt]; s1 += yv[nt];
                const float rr = rc[nt] + mpr[nt] * (rp[nt] - rc[nt]) + mnr[nt] * (rn[nt] - rc[nt]);
                const float kk = kc[nt] + mpk[nt] * (kp[nt] - kc[nt]) + mnk[nt] * (kn[nt] - kc[nt]);
                vv[nt] = vc[nt] + mpv[nt] * (vp[nt] - vc[nt]) + mnv[nt] * (vn[nt] - vc[nt]);
                sb += rr * kk * rk1[nt] * (1.0f - ka1[nt]);
            }
            const float mean = peer::rowsum16(s1) * (1.f / 64.f);
            float s2 = 0.f;
#pragma unroll
            for (int nt = 0; nt < 4; ++nt) s2 += (yv[nt] - mean) * (yv[nt] - mean);
            const float rstd = __builtin_amdgcn_rsqf(peer::rowsum16(s2) * (1.f / 64.f) + 64e-5f);
            const float bs = peer::rowsum16(sb) + 0.5f * bon;
            const float lm = fmaxf(l1, fmaxf(l2, l3)), w1 = __expf(l1 - lm), w2 = __expf(l2 - lm), w3 = __expf(l3 - lm), wi = __builtin_amdgcn_rcpf(w1 + w2 + w3);
            float att[4], rw[4];
#pragma unroll
            for (int nt = 0; nt < 4; ++nt) {
                att[nt] = (w1 * o1[nt] + w2 * o2[nt] + w3 * o3[nt]) * wi;
                rw[nt] = ((yv[nt] - mean) * rstd * lg[nt] + lb[nt] + bs * vv[nt]) * ga[nt][reg];
            }
            u32x2 wa, wr; wa.x = cvtpk(att[0], att[1]); wa.y = cvtpk(att[2], att[3]); wr.x = cvtpk(rw[0], rw[1]); wr.y = cvtpk(rw[2], rw[3]);
            *(u32x2*)mp = wa; *(u32x2*)(mp + AW) = wr;
            __builtin_amdgcn_sched_barrier(0);
        }
    }
}
}

#ifndef MK_SKIP
#define MK_SKIP 0
#endif
constexpr int N_PHASES = 12;
struct Args { const float* in[27]; float* out; unsigned char* ws; int ph_lo, ph_hi, li, pad; };

__global__ void __launch_bounds__(NWAVES * 64, 2) mk_fwd(Args args) {
    extern __shared__ __attribute__((aligned(16))) unsigned char lds[];
    LAS unsigned char* L = (LAS unsigned char*)lds;
    volatile LAS unsigned* MISC = (volatile LAS unsigned*)(L + MISC_OFF);
    const int tid = threadIdx.x, lane = tid & 63, wave = __builtin_amdgcn_readfirstlane(tid >> 6);
    const int G = gridDim.x, bx = blockIdx.x;
    unsigned char* ws = args.ws;
    gu32* ctl = (gu32*)(ws + WS_CTL);
    const float* x = args.in[0]; const float* cvec = args.in[1]; const float* ada_w = args.in[2]; const float* ada_b = args.in[3];
    const float* norm1_g = args.in[4]; const float* w_in = args.in[5]; const float* mu_prev = args.in[6]; const float* mu_next = args.in[7];
    const float* q_norm_g = args.in[8]; const float* k_norm_g = args.in[9]; const float* w_decay0 = args.in[10]; const float* w_decay_up = args.in[11];
    const float* a_gate0 = args.in[12]; const float* a_gate_up = args.in[13]; const float* g_up = args.in[14]; const float* k_k = args.in[15];
    const float* k_a = args.in[16]; const float* r_k = args.in[17]; const float* lnx_g = args.in[18]; const float* lnx_b = args.in[19];
    const float* w_out = args.in[20]; const float* norm2_g = args.in[21]; const float* w_query = args.in[22]; const float* keys1 = args.in[23];
    const float* keys2 = args.in[24]; const float* peer_u = args.in[25]; const float* peer_v = args.in[26];
    float* out = args.out;
    float* MOD = (float*)(ws + WS_MOD); bf16* KEYS = (bf16*)(ws + WS_KEYS); bf16* WIN = (bf16*)(ws + WS_WIN); bf16* WOUT = (bf16*)(ws + WS_WOUT); bf16* WQ = (bf16*)(ws + WS_WQ);
    bf16* XN = (bf16*)(ws + WS_XN); bf16* Z = (bf16*)(ws + WS_Z); bf16* MIX = (bf16*)(ws + WS_MIX); bf16* Y = (bf16*)(ws + WS_Y); bf16* Q = (bf16*)(ws + WS_Q);
    unsigned short* IDX = (unsigned short*)(ws + WS_IDX); float* GATE = (float*)(ws + WS_GATE); float* BON = (float*)(ws + WS_BON);
    bf16* O3 = (bf16*)(ws + WS_O3); float* LSE = (float*)(ws + WS_LSE); unsigned char* UT8 = ws + WS_UT; unsigned char* VT8 = ws + WS_VT; float* SUV = (float*)(ws + WS_SU); unsigned char* XQ = ws + WS_XQ; float* SX = (float*)(ws + WS_XQ + 16 * MiB); float* PART = (float*)(ws + WS_PART);

    for (int u = tid; u < (LDS_BYTES - LDSCTL_OFF) / 4; u += NWAVES * 64) ((LAS unsigned*)(L + LDSCTL_OFF))[u] = 0u;
    __syncthreads();
    XcdBarrier bar = xcd_barrier_post((unsigned*)(ctl + CW_BAR) + args.li * XCD_BAR_WORDS, MISC + 8);
    const int lo = args.ph_lo, hi = args.ph_hi;
#define IN(k) (lo <= (k) && (k) < hi)
#define SEAM(k) do { if (IN(k) && IN((k) + 1)) xcd_barrier(bar); } while (0)
    const int gw = bx * NWAVES + wave, NGW = G * NWAVES;

    if (IN(0) && !(MK_SKIP & (1 << 0))) {
        if (bx < 2 * (MODW / 64)) {
            const int cg = bx % (MODW / 64), kh = bx / (MODW / 64);
            LAS float* sc = (LAS float*)L; LAS float* part = (LAS float*)(L + 32768);
            for (int i = tid; i < BATCH * D; i += NWAVES * 64) { const float cv = cvec[i]; sc[i] = cv / (1.f + expf(-cv)); }
            __syncthreads();
            const int j0 = cg * 64, i0 = kh * 512 + wave * 64;
            float acc[BATCH];
#pragma unroll
            for (int b = 0; b < BATCH; ++b) acc[b] = 0.f;
#pragma unroll 1
            for (int ii = 0; ii < 64; ii += 8) {
                float w[8];
#pragma unroll
                for (int e = 0; e < 8; ++e) w[e] = ada_w[(size_t)(i0 + ii + e) * MODW + j0 + lane];
#pragma unroll
                for (int e = 0; e < 8; ++e)
#pragma unroll
                    for (int b = 0; b < BATCH; ++b) acc[b] += sc[b * D + i0 + ii + e] * w[e];
            }
#pragma unroll
            for (int b = 0; b < BATCH; ++b) part[(wave * 8 + b) * 64 + lane] = acc[b];
            __syncthreads();
            { const int b = tid >> 6; float s = 0.f;
#pragma unroll
              for (int w = 0; w < 8; ++w) s += part[(w * 8 + b) * 64 + lane];
              if (kh == 0) s += ada_b[j0 + lane];
              atomicAdd(MOD + b * MODW + j0 + lane, s); }
            __syncthreads();
        }
        LAS float* scr = (LAS float*)(L + RING_OFF + wave * 16384);
        constexpr int I_IN = (D / 64) * (INW / 32), I_OUT = (D / 64) * (D / 32), I_Q = (D / 64) * (QW / 32);
        for (int it = gw; it < I_IN + I_OUT + I_Q; it += NGW) {
            int r = it;
            if (r < I_IN) { p0_transpose_item(w_in, D, INW, WIN, 0, scr, r, lane); continue; } r -= I_IN;
            if (r < I_OUT) { p0_transpose_item(w_out, D, D, WOUT, 0, scr, r, lane); continue; } r -= I_OUT;
            p0_transpose_item(w_query, D, QW, WQ, 0, scr, r, lane);
        }
    }
    SEAM(0);
    if (IN(1) && !(MK_SKIP & (1 << 1))) { norm_rows_t<false>(x, norm1_g, MOD, 0, D, XN, nullptr, nullptr, gw, NGW, lane); }
    SEAM(1);
    if (IN(2) && !(MK_SKIP & (1 << 2))) {
        pg8::Gemm g{XN, WIN, T, INW, D}; pg8::StaticOrder S; S.init(T, INW, G, bx);
        pg8::EpiBf16<0> E{Z, INW, nullptr, 0, 0, 1.f};
        pg8::gemm_phase<pg8::EpiBf16<0>, pg8::StaticOrder, true, true>(L + RING_OFF, g, S, E);
    }
    SEAM(2);
    if (IN(3) && !(MK_SKIP & (1 << 3))) {
        constexpr int NCHAIN = BATCH * NH * 2;
        if (bx < NCHAIN) scan::chain(L, Z, mu_prev, mu_next, w_decay0, w_decay_up, a_gate0, a_gate_up, k_k, k_a, r_k, Y, LSE, bx, tid, wave, lane);
        {
            gu32* ucnt = ctl + CW_WORK + 64 * args.li;
            LAS unsigned char* vt = L + wave * attn::WAVE_LDS;
            for (;;) {
                unsigned uu = 0u;
                if (lane == 0) uu = __hip_atomic_fetch_add(ucnt, 1u, __ATOMIC_RELAXED, __HIP_MEMORY_SCOPE_AGENT);
                const int u = __builtin_amdgcn_readfirstlane((int)uu);
                if (u >= BATCH * NH * 96) break;
                const int x = u & 31, p = (u >> 5) % 3, bh = u / 96;
                const int d = (p == 0) ? 1 : (p == 1 ? 4 : 16), nb = 32 / d, r = x / nb, qb = x % nb;
                bf16* Ob = (p == 0) ? MIX : (p == 1 ? MIX + AW : O3); const int opitch = (p == 2) ? AW : D;
                attn::unit(vt, Z, q_norm_g, k_norm_g, Ob, opitch, LSE + p, bh >> 3, bh & 7, d, r, qb, nb, lane);
            }
        }
        {
            gu32* ccnt = ctl + CW_WORK2 + 64 * args.li;
            for (;;) {
                unsigned uu = 0u;
                if (lane == 0) uu = __hip_atomic_fetch_add(ccnt, 1u, __ATOMIC_RELAXED, __HIP_MEMORY_SCOPE_AGENT);
                const int it = __builtin_amdgcn_readfirstlane((int)uu);
                if (it >= 1024) break;
                const int r0 = (it & 511) * 32;
                if (it < 512) peer::convert_rows_i8(peer_u + (size_t)r0 * D, UT8 + (size_t)r0 * D, SUV + 2 * r0, 32, 0, 1, lane);
                else peer::convert_rows_fp8(peer_v + (size_t)r0 * D, VT8 + (size_t)r0 * D, SUV + 2 * r0 + 1, 32, 0, 1, lane);
            }
        }
    }
    SEAM(3);
    if (IN(4) && !(MK_SKIP & (1 << 4))) { fin::phase(L, Z, mu_prev, mu_next, g_up, Y, LSE, k_a, r_k, lnx_g, lnx_b, MIX, O3, LSE, bx, G, tid, wave, lane); }
    SEAM(4);
    if (IN(5) && !(MK_SKIP & (1 << 5))) {
        pg8::Gemm g{MIX, WOUT, T, D, D}; pg8::StaticOrder S; S.init(T, D, G, bx);
        EpiRes E{x, MOD, 2 * D, out, D};
        pg8::gemm_phase<EpiRes, pg8::StaticOrder, true, true>(L + RING_OFF, g, S, E);
    }
    SEAM(5);
    if (IN(6) && !(MK_SKIP & (1 << 6))) { norm_rows_t<true>(out, norm2_g, MOD, 3 * D, 4 * D, XN, XQ, SX, gw, NGW, lane);
    }
    SEAM(6);
    if (IN(7) && !(MK_SKIP & (1 << 7))) {
        pg8::Gemm g{XN, WQ, T, QW, D}; pg8::StaticOrder S; S.init(T, QW, G, bx);
        pg8::EpiBf16<0> E{Q, QW, nullptr, 0, 0, 1.f};
        pg8::gemm_phase<pg8::EpiBf16<0>, pg8::StaticOrder, true, true>(L + RING_OFF, g, S, E);
    }
    SEAM(7);
    if (IN(8) && !(MK_SKIP & (1 << 8))) { __syncthreads(); peer::setup_keys(L, keys1, keys2, tid); __syncthreads();
        for (int bt = gw; bt < T * PH / 16; bt += NGW) peer::select_batch(L, Q, IDX, GATE, bt, lane); }
    SEAM(8);
    {
        const int sl = bx & 7, wv = (bx >> 3) * NWAVES + wave, nwv = (G >> 3) * NWAVES;
        if (IN(9) && !(MK_SKIP & (1 << 9))) { peer::ffn_u_pass(XQ, (const unsigned*)IDX, UT8, (int*)PART, sl, wv, nwv, lane); }
        SEAM(9);
        if (IN(10) && !(MK_SKIP & (1 << 10))) {
            typedef int i32x4 __attribute__((ext_vector_type(4)));
            typedef float f32x2m __attribute__((ext_vector_type(2)));
            typedef unsigned u32x2m __attribute__((ext_vector_type(2)));
            for (size_t i4 = (size_t)bx * NWAVES * 64 + tid; i4 < (size_t)T * HK / 4; i4 += (size_t)G * NWAVES * 64) {
                i32x4 di = ((const i32x4*)PART)[i4];
#pragma unroll
                for (int s8 = 1; s8 < 8; ++s8) di += ((const i32x4*)PART)[(size_t)s8 * T * HK / 4 + i4];
                const u32x2m ew = ((const u32x2m*)IDX)[i4]; const unsigned ex[4] = {ew.x & 0xffffu, ew.x >> 16, ew.y & 0xffffu, ew.y >> 16}; const f32x4 gt = ((const f32x4*)GATE)[i4];
                const float sx = SX[(i4 * 4) / HK];
                v4u w;
#pragma unroll
                for (int e = 0; e < 4; ++e) { const f32x2m suv = *(const f32x2m*)(SUV + 2 * ex[e]);
                    const float cf = gt[e] * peer::gelu_erf((float)di[e] * suv.x * sx) * suv.y;
                    w[e] = (ex[e] << 16) | f2bf(cf); }
                ((v4u*)GATE)[i4] = w;
            }
        }
        SEAM(10);
        if (IN(11) && !(MK_SKIP & (1 << 11))) { peer::ffn_v_pass((const unsigned*)GATE, VT8, MOD, out, sl, wv, nwv, lane); }
    }
#undef IN
#undef SEAM
}

extern "C" void kernel_launch(void* const* d_in, const int* in_sizes, int n_in, void* d_out, int out_size, void* d_ws, size_t ws_size, hipStream_t stream) {
    static int grid = 0;
    if (grid == 0) {
        if (n_in != 27 || in_sizes[0] != T * D || out_size != T * D || ws_size < WS_END) { fprintf(stderr, "kernel_launch: unexpected problem (n_in %d, in0 %d, out %d, ws %zu); nothing launched\n", n_in, n_in > 0 ? in_sizes[0] : -1, out_size, ws_size); grid = -1; return; }
        int dev = 0, cus = 0, per_cu = 0;
        if (hipGetDevice(&dev) != hipSuccess || hipDeviceGetAttribute(&cus, hipDeviceAttributeMultiprocessorCount, dev) != hipSuccess) { fprintf(stderr, "kernel_launch: device query failed\n"); grid = -1; return; }
        if (hipFuncSetAttribute((const void*)mk_fwd, hipFuncAttributeMaxDynamicSharedMemorySize, LDS_BYTES) != hipSuccess) { fprintf(stderr, "kernel_launch: hipFuncSetAttribute failed\n"); grid = -1; return; }
        if (hipOccupancyMaxActiveBlocksPerMultiprocessor(&per_cu, (const void*)mk_fwd, NWAVES * 64, LDS_BYTES) != hipSuccess || per_cu < 1)
            fprintf(stderr, "kernel_launch: note: occupancy query reports %d workgroups per CU\n", per_cu);
        (void)hipGetLastError();
        grid = cus;
        if (grid % 8 != 0 || grid < 2 * (BATCH * NH * 2) || T % (grid * NWAVES) != 0 || SEQ % (T / (grid * NWAVES)) != 0) { fprintf(stderr, "kernel_launch: needs a CU count that is a multiple of 8 (XCD-sliced FFN passes) and >= 256 workgroups' worth of chains; got %d; nothing launched\n", grid); grid = -1; return; }
    }
    if (grid < 0) return;
    if (hipMemsetAsync((char*)d_ws + WS_CTL, 0, CTL_ZERO_BYTES, stream) != hipSuccess) { fprintf(stderr, "kernel_launch: hipMemsetAsync failed\n"); return; }
    Args a{};
    for (int i = 0; i < 27; ++i) a.in[i] = (const float*)d_in[i];
    a.out = (float*)d_out; a.ws = (unsigned char*)d_ws;
#ifndef MK_RANGES
#define MK_RANGES {{0, N_PHASES}}
#endif
    static const int ranges[][2] = MK_RANGES;
    const int nl = (int)(sizeof(ranges) / sizeof(ranges[0]));
    for (int li = 0; li < nl; ++li) {
        a.ph_lo = ranges[li][0]; a.ph_hi = ranges[li][1]; a.li = li;
        hipLaunchKernelGGL(mk_fwd, dim3(grid), dim3(NWAVES * 64), LDS_BYTES, stream, a);
        const hipError_t le = hipPeekAtLastError();
        if (le != hipSuccess) { fprintf(stderr, "kernel_launch: launch %d failed: %s\n", li, hipGetErrorName(le)); break; }
    }
}
```
